# Optimizing an MI355X kernel written in HIP

```python
import math
import jax, jax.numpy as jnp
from jax import lax
import numpy as np

D_MODEL = 1024
BATCH = 16
SEQ = 2048
DEPTH = 4

HEAD_DIM = 64
ROT_DIM = HEAD_DIM // 4
ROPE_THETA = 500000.0
BLOCK = 128
NORM_EPS = 1e-6

RWKV_HEADS = 6
RWKV_WIDTH = RWKV_HEADS * HEAD_DIM
DECAY_RANK = 64
ICL_RANK = 64
GN_EPS = 64e-5
DECAY_SCALE = math.exp(-0.5)

DSA_HEADS = 4
DSA_WIDTH = DSA_HEADS * HEAD_DIM
IDX_HEADS = 8
IDX_DIM = 32
IDX_ROT_DIM = IDX_DIM // 4
DSA_TOPK = 256

DIL_WINDOWS = (128, 512, 2048)
DIL_RATES = (1, 4, 16)
DIL_GROUPS = 3
DIL_HEADS_PER_GROUP = 2
DIL_HEADS = DIL_GROUPS * DIL_HEADS_PER_GROUP
DIL_WIDTH = DIL_HEADS * HEAD_DIM

MIX_WIDTH = RWKV_WIDTH + DSA_WIDTH + DIL_WIDTH
PLE_DIM = 256

RWKV_COLS = (RWKV_WIDTH, RWKV_WIDTH, RWKV_WIDTH, RWKV_WIDTH, DECAY_RANK, ICL_RANK)
RWKV_IN_WIDTH = 4 * RWKV_WIDTH + DECAY_RANK + ICL_RANK
DSA_COLS = (DSA_WIDTH, HEAD_DIM, HEAD_DIM, IDX_HEADS * IDX_DIM, IDX_DIM, IDX_HEADS, DSA_WIDTH)
DSA_IN_WIDTH = 2 * DSA_WIDTH + 2 * HEAD_DIM + IDX_HEADS * IDX_DIM + IDX_DIM + IDX_HEADS
DIL_COLS = (DIL_WIDTH, DIL_WIDTH, DIL_WIDTH, DIL_WIDTH)
DIL_IN_WIDTH = 4 * DIL_WIDTH
IN_COLS = RWKV_IN_WIDTH + DSA_IN_WIDTH + DIL_IN_WIDTH

kernel_name = 'hymba_rwkv7_dsa_dilated_trunk'


def rms_norm(x, g):
    xf = x.astype(jnp.float32)
    y = xf * lax.rsqrt(jnp.mean(xf * xf, axis=-1, keepdims=True) + NORM_EPS)
    return (y * g.astype(jnp.float32)).astype(x.dtype)


def split_cols(z, widths):
    out, off = [], 0
    for w in widths:
        out.append(z[..., off:off + w])
        off += w
    return out


def rope_tables(seq, rot_dim):
    half = rot_dim // 2
    inv = ROPE_THETA ** (-jnp.arange(half, dtype=jnp.float32) / half)
    ang = jnp.arange(seq, dtype=jnp.float32)[:, None] * inv[None, :]
    return jnp.cos(ang), jnp.sin(ang)


def partial_rope(x, cos, sin):
    half = cos.shape[-1]
    c = cos[None, :, None, :].astype(x.dtype)
    s = sin[None, :, None, :].astype(x.dtype)
    x1, x2, rest = x[..., :half], x[..., half:2 * half], x[..., 2 * half:]
    return jnp.concatenate([x1 * c - x2 * s, x2 * c + x1 * s, rest], axis=-1)


def token_shift_mix(z, mu):
    prev = jnp.pad(z, ((0, 0), (1, 0), (0, 0)))[:, :-1]
    return z + (prev - z) * mu


def rwkv7_branch(z, mu, w0, w_up, a0, a_up, k_k, k_a, r_k, ln_g, ln_b):
    B, S, _ = z.shape
    f32 = jnp.float32
    z = token_shift_mix(z, mu)
    r, k, v, g, wd, ad = split_cols(z, RWKV_COLS)
    heads = lambda t: t.astype(f32).reshape(B, S, RWKV_HEADS, HEAD_DIM)
    per_head = lambda t: t.astype(f32).reshape(RWKV_HEADS, HEAD_DIM)
    w = jnp.exp(-DECAY_SCALE * jax.nn.sigmoid((w0 + jnp.tanh(wd) @ w_up).astype(f32)))
    a = jax.nn.sigmoid((a0 + ad @ a_up).astype(f32))
    r, k, v, w, a = heads(r), heads(k), heads(v), heads(w), heads(a)
    kk = k * per_head(k_k)
    kk = kk / jnp.maximum(jnp.linalg.norm(kk, axis=-1, keepdims=True), 1e-12)
    k = k * (1.0 + (a - 1.0) * per_head(k_a))

    def step(state, inp):
        r_t, w_t, k_t, v_t, kk_t, a_t = inp
        sa = jnp.einsum('bhvk,bhk->bhv', state, -kk_t)
        state = (state * w_t[:, :, None, :]
                 + sa[..., None] * (kk_t * a_t)[:, :, None, :]
                 + v_t[..., None] * k_t[:, :, None, :])
        return state, jnp.einsum('bhvk,bhk->bhv', state, r_t)

    seq_first = lambda t: jnp.moveaxis(t, 1, 0)
    s0 = jnp.zeros((B, RWKV_HEADS, HEAD_DIM, HEAD_DIM), f32)
    _, y = lax.scan(step, s0, (seq_first(r), seq_first(w), seq_first(k), seq_first(v), seq_first(kk), seq_first(a)))
    y = jnp.moveaxis(y, 0, 1)
    mean = jnp.mean(y, axis=-1, keepdims=True)
    var = jnp.mean(jnp.square(y - mean), axis=-1, keepdims=True)
    y = ((y - mean) * lax.rsqrt(var + GN_EPS)).reshape(B, S, RWKV_WIDTH) * ln_g.astype(f32) + ln_b.astype(f32)
    bonus = jnp.sum(r * k * r_k.astype(f32), axis=-1, keepdims=True) * v
    y = y + bonus.reshape(B, S, RWKV_WIDTH)
    return (y * jax.nn.silu(g.astype(f32))).astype(z.dtype)


def dsa_branch(z, cos, sin, icos, isin):
    B, S, _ = z.shape
    f32 = jnp.float32
    q, k, v, iq, ik, iw, g = split_cols(z, DSA_COLS)
    q = partial_rope(q.reshape(B, S, DSA_HEADS, HEAD_DIM), cos, sin)
    k = partial_rope(k[:, :, None, :], cos, sin)[:, :, 0]
    iq = partial_rope(iq.reshape(B, S, IDX_HEADS, IDX_DIM), icos, isin)
    ik = partial_rope(ik[:, :, None, :], icos, isin)[:, :, 0]
    iw = iw * (IDX_HEADS ** -0.5)
    topk = min(DSA_TOPK, S // 4)
    nb = S // BLOCK
    key_pos = jnp.arange(S)
    gather = jax.vmap(lambda table, idx: table[idx])

    def block_fn(args):
        qb, iqb, iwb, start = args
        qpos = start + jnp.arange(BLOCK)
        sc = jnp.einsum('bqhd,bsd->bqhs', iqb, ik).astype(f32) * (IDX_DIM ** -0.5)
        sc = jnp.einsum('bqhs,bqh->bqs', jax.nn.relu(sc), iwb.astype(f32))
        sc = jnp.where((key_pos[None, :] <= qpos[:, None])[None], sc, -jnp.inf)
        _, idx = lax.top_k(sc, topk)
        valid = idx <= qpos[None, :, None]
        ks = gather(k, idx)
        vs = gather(v, idx)
        att = jnp.einsum('bqhd,bqkd->bqhk', qb, ks).astype(f32) * (HEAD_DIM ** -0.5)
        att = jnp.where(valid[:, :, None, :], att, -jnp.inf)
        probs = jax.nn.softmax(att, axis=-1).astype(vs.dtype)
        return jnp.einsum('bqhk,bqkd->bqhd', probs, vs)

    blocks = lambda t: jnp.moveaxis(t.reshape(B, nb, BLOCK, *t.shape[2:]), 1, 0)
    out = lax.map(block_fn, (blocks(q), blocks(iq), blocks(iw), jnp.arange(nb) * BLOCK))
    out = jnp.moveaxis(out, 0, 1).reshape(B, S, DSA_WIDTH)
    return out * jax.nn.silu(g)


def banded_attention(q, k, v, max_steps):
    N, n, H, dh = q.shape
    nb = -(-n // BLOCK)
    pad = nb * BLOCK - n
    to_blocks = lambda t: jnp.pad(t, ((0, 0), (0, pad), (0, 0), (0, 0))).reshape(N, nb, BLOCK, H, dh)
    qb, kb, vb = to_blocks(q), to_blocks(k), to_blocks(v)
    prev = lambda t: jnp.concatenate([jnp.zeros_like(t[:, :1]), t[:, :-1]], axis=1)
    kc = jnp.concatenate([prev(kb), kb], axis=2)
    vc = jnp.concatenate([prev(vb), vb], axis=2)
    s = jnp.einsum('nbqhd,nbkhd->nbhqk', qb, kc).astype(jnp.float32) * (HEAD_DIM ** -0.5)
    qi = jnp.arange(BLOCK)[:, None] + BLOCK
    kj = jnp.arange(2 * BLOCK)[None, :]
    dist = qi - kj
    band = (dist >= 0) & (dist <= max_steps)
    has_prev = (jnp.arange(nb)[:, None, None] > 0) | (kj[None] >= BLOCK)
    mask = band[None] & has_prev
    s = jnp.where(mask[None, :, None], s, -jnp.inf)
    m = jnp.max(s, axis=-1, keepdims=True)
    e = jnp.exp(s - m)
    l = jnp.sum(e, axis=-1, keepdims=True)
    o = jnp.einsum('nbhqk,nbkhd->nbqhd', (e / l).astype(v.dtype), vc)
    lse = (m + jnp.log(l))[..., 0]
    o = o.reshape(N, nb * BLOCK, H, dh)[:, :n]
    lse = jnp.moveaxis(lse, 2, 3).reshape(N, nb * BLOCK, H)[:, :n]
    return o, lse


def dilated_group(q, k, v, rate, steps):
    B, S, H, dh = q.shape
    n = S // rate
    to_res = lambda t: jnp.swapaxes(t.reshape(B, n, rate, H, dh), 1, 2).reshape(B * rate, n, H, dh)
    o, lse = banded_attention(to_res(q), to_res(k), to_res(v), steps)
    o = jnp.swapaxes(o.reshape(B, rate, n, H, dh), 1, 2).reshape(B, S, H, dh)
    lse = jnp.swapaxes(lse.reshape(B, rate, n, H), 1, 2).reshape(B, S, H)
    return o, lse


def dilated_branch(z, cos, sin):
    B, S, _ = z.shape
    q, k, v, g = split_cols(z, DIL_COLS)
    heads = lambda t: t.reshape(B, S, DIL_HEADS, HEAD_DIM)
    q = partial_rope(heads(q), cos, sin)
    k = partial_rope(heads(k), cos, sin)
    v = heads(v)
    outs, lses = [], []
    for gi in range(DIL_GROUPS):
        hs = slice(gi * DIL_HEADS_PER_GROUP, (gi + 1) * DIL_HEADS_PER_GROUP)
        o, lse = dilated_group(q[:, :, hs], k[:, :, hs], v[:, :, hs], DIL_RATES[gi], DIL_WINDOWS[gi] // DIL_RATES[gi])
        outs.append(o)
        lses.append(lse)
    o = jnp.stack(outs, axis=2)
    alpha = jax.nn.softmax(jnp.stack(lses, axis=2), axis=2)
    o = (o * alpha[..., None].astype(o.dtype)).reshape(B, S, DIL_WIDTH)
    return o * jax.nn.silu(g)


def setup_inputs(seed: int = 0) -> dict:
    key = jax.random.key(seed)
    ks = jax.random.split(key, 20)
    f32 = jnp.float32
    nrm = lambda kk, shape, scale: scale * jax.random.normal(kk, shape, f32)
    L = DEPTH
    return {
        'x': nrm(ks[0], (BATCH, SEQ, D_MODEL), 1.0),
        'p': nrm(ks[1], (DEPTH, BATCH, SEQ, PLE_DIM), 1.0),
        'norm_g': 1.0 + nrm(ks[2], (L, D_MODEL), 0.05),
        'w_in': nrm(ks[3], (L, D_MODEL, IN_COLS), D_MODEL ** -0.5),
        'tshift_mu': jax.random.uniform(ks[4], (L, RWKV_IN_WIDTH), f32),
        'rwkv_w0': jax.random.uniform(ks[5], (L, RWKV_WIDTH), f32, -6.0, 1.0),
        'rwkv_w_up': nrm(ks[6], (L, DECAY_RANK, RWKV_WIDTH), DECAY_RANK ** -0.5),
        'rwkv_a0': nrm(ks[7], (L, RWKV_WIDTH), 0.5),
        'rwkv_a_up': nrm(ks[8], (L, ICL_RANK, RWKV_WIDTH), ICL_RANK ** -0.5),
        'rwkv_k_k': 0.85 + nrm(ks[9], (L, RWKV_WIDTH), 0.05),
        'rwkv_k_a': 1.0 + nrm(ks[10], (L, RWKV_WIDTH), 0.05),
        'rwkv_r_k': nrm(ks[11], (L, RWKV_HEADS, HEAD_DIM), 0.1),
        'rwkv_ln_g': 1.0 + nrm(ks[12], (L, RWKV_WIDTH), 0.05),
        'rwkv_ln_b': nrm(ks[13], (L, RWKV_WIDTH), 0.01),
        'w_out': nrm(ks[14], (L, MIX_WIDTH, D_MODEL), 0.5 * MIX_WIDTH ** -0.5),
        'ple_norm_g': 1.0 + nrm(ks[15], (L, D_MODEL), 0.05),
        'ple_w_gate': nrm(ks[16], (L, D_MODEL, D_MODEL), D_MODEL ** -0.5),
        'ple_w_proj': nrm(ks[17], (L, PLE_DIM, D_MODEL), 0.5 * PLE_DIM ** -0.5),
        'final_norm_g': 1.0 + nrm(ks[18], (D_MODEL,), 0.05),
    }


def reference(x, p, norm_g, w_in, tshift_mu, rwkv_w0, rwkv_w_up, rwkv_a0, rwkv_a_up, rwkv_k_k, rwkv_k_a,
              rwkv_r_k, rwkv_ln_g, rwkv_ln_b, w_out, ple_norm_g, ple_w_gate, ple_w_proj, final_norm_g):
    S = x.shape[1]
    cos, sin = rope_tables(S, ROT_DIM)
    icos, isin = rope_tables(S, IDX_ROT_DIM)
    for i in range(DEPTH):
        h = rms_norm(x, norm_g[i])
        z = h @ w_in[i]
        z_a, z_b, z_c = split_cols(z, (RWKV_IN_WIDTH, DSA_IN_WIDTH, DIL_IN_WIDTH))
        y_a = rwkv7_branch(z_a, tshift_mu[i], rwkv_w0[i], rwkv_w_up[i], rwkv_a0[i], rwkv_a_up[i],
                           rwkv_k_k[i], rwkv_k_a[i], rwkv_r_k[i], rwkv_ln_g[i], rwkv_ln_b[i])
        y_b = dsa_branch(z_b, cos, sin, icos, isin)
        y_c = dilated_branch(z_c, cos, sin)
        y = jnp.concatenate([y_a, y_b, y_c], axis=-1)
        x = x + y @ w_out[i]
        gate = jax.nn.sigmoid(rms_norm(x, ple_norm_g[i]) @ ple_w_gate[i])
        x = x + gate * (p[i] @ ple_w_proj[i])
    return rms_norm(x, final_norm_g)
```

```cpp
#include <hip/hip_runtime.h>
#include <cstdio>
#include <cstdint>
#include <cmath>
#include <cstring>

constexpr int BATCH = 16, SEQ = 2048, DM = 1024, DEPTH = 4, MTOK = BATCH * SEQ;
constexpr int ZP = 4136;
constexpr int NPAD = 4352;
constexpr int ZA_R = 0, ZA_K = 384, ZA_V = 768, ZA_G = 1152, ZA_WD = 1536, ZA_AD = 1600;
constexpr int ZB_Q = 1664, ZB_K = 1920, ZB_V = 1984, ZB_IQ = 2048, ZB_IK = 2304, ZB_IW = 2336, ZB_G = 2344;
constexpr int ZC_Q = 2600, ZC_K = 2984, ZC_V = 3368, ZC_G = 3752;
constexpr float LOG2E = 1.4426950408889634f;
constexpr float QSCALE = 0.125f * LOG2E;
constexpr float IQSCALE = 0.17677669529663687f;
constexpr float IWSCALE = 0.35355339059327373f;
constexpr float NORM_EPS = 1e-6f, GN_EPS = 64e-5f;
constexpr float DECAY_SCALE = 0.6065306597126334f;

typedef unsigned short bf16_t;
typedef short bf16x8 __attribute__((ext_vector_type(8)));
typedef float f32x4 __attribute__((ext_vector_type(4)));
typedef float f32x16 __attribute__((ext_vector_type(16)));
typedef unsigned u32x4 __attribute__((ext_vector_type(4)));
typedef unsigned u32x2 __attribute__((ext_vector_type(2)));

__device__ __forceinline__ unsigned f2bf(float f) { unsigned u = __builtin_bit_cast(unsigned, f); return (u + 0x7fffu + ((u >> 16) & 1u)) >> 16; }
__device__ __forceinline__ unsigned pk2(float lo, float hi) { return f2bf(lo) | (f2bf(hi) << 16); }
__device__ __forceinline__ float bf2f(unsigned short b) { return __builtin_bit_cast(float, (unsigned)b << 16); }
__device__ __forceinline__ float bflo(unsigned w) { return __builtin_bit_cast(float, w << 16); }
__device__ __forceinline__ float bfhi(unsigned w) { return __builtin_bit_cast(float, w & 0xffff0000u); }
__device__ __forceinline__ float sigmoidf_(float x) { return 1.0f / (1.0f + __expf(-x)); }
__device__ __forceinline__ float wave_sum(float v) {
#pragma unroll
    for (int o = 1; o < 64; o <<= 1) v += __shfl_xor(v, o);
    return v;
}
__device__ __forceinline__ float wave_max(float v) {
#pragma unroll
    for (int o = 1; o < 64; o <<= 1) v = fmaxf(v, __shfl_xor(v, o));
    return v;
}

constexpr size_t MiB = 1u << 20;
constexpr size_t WS_CTL = 0;
constexpr size_t WS_TAB16 = 1 * MiB;
constexpr size_t WS_TABI = WS_TAB16 + 128 * 1024;
constexpr size_t WS_SSQA = WS_TABI + 64 * 1024;
constexpr size_t WS_SSQB = WS_SSQA + 2 * MiB;
constexpr size_t WS_W = 6 * MiB;
constexpr size_t W_LAYER = 14 * MiB, W_IN = 0, W_OUT = 8912896, W_GATE = W_OUT + 2 * MiB, W_PROJ = W_GATE + 2 * MiB;
constexpr size_t WS_BUFA = 62 * MiB;
constexpr size_t WS_BUFB = 126 * MiB;
constexpr size_t WS_PB = 190 * MiB;
constexpr size_t WS_Z = 206 * MiB;
constexpr size_t WS_Z_END = WS_Z + (size_t)MTOK * ZP * 2;
constexpr size_t WS_MISC = 465 * MiB;
constexpr size_t WS_END = 512 * MiB;
static_assert(W_PROJ + 1024 * 256 * 2 <= W_LAYER && WS_W + 4 * W_LAYER <= WS_BUFA && WS_Z_END <= WS_MISC, "ws map");
namespace pg8 {
#define PG8_LAS __attribute__((address_space(3)))
typedef unsigned short bf16_t;
typedef short bf16x8 __attribute__((ext_vector_type(8)));
typedef float f32x4 __attribute__((ext_vector_type(4)));
typedef unsigned u32x4 __attribute__((ext_vector_type(4)));
constexpr int BM = 256, BK = 64, HALF = 128, HTB = HALF * BK * 2  , STAGE_BYTES = 8 * HTB, NXCD = 8, WGM = 8;

__host__ __device__ __forceinline__ int lds_byte(int r, int c) { const int st = (r >> 4) * 2 + (c >> 5), rr = r & 15, cc = c & 31, ob = rr * 64 + cc * 2; return st * 1024 + (ob ^ (((ob >> 9) & 1) << 5)); }
__host__ __device__ __forceinline__ void stage_rc(int b, int& R, int& C) { const int st = b / 1024, sb = b % 1024, swz = sb ^ (((sb >> 9) & 1) << 5); R = (st >> 1) * 16 + swz / 64; C = (st & 1) * 32 + (swz % 64) / 2; }
__host__ __device__ __forceinline__ int perm32(int rho) { const int n = rho >> 4, i = rho & 15; return 8 * (i >> 2) + 4 * n + (i & 3); }

struct Unit { int pm, pn; };
struct Gemm { const bf16_t* A; const bf16_t* Bt; int M, N, K; };

struct StaticOrder {
    int nM, nN, nwg, G, c;
    __host__ __device__ void init(int M, int N, int G_, int c_) { nM = M / BM; nN = N / BM; nwg = nM * nN; G = G_; c = c_; }
    __host__ __device__ bool next(int i, Unit& u) const {
        const long L = (long)i * G + c; if (L >= nwg) return false;
        int wgid = (int)L; { const int q = nwg / NXCD, r = nwg % NXCD, xcd = wgid % NXCD, off = wgid / NXCD; wgid = (xcd < r ? xcd * (q + 1) : r * (q + 1) + (xcd - r) * q) + off; }
        const int nig = WGM * nN, gid = wgid / nig, fm = gid * WGM, gsz = (nM - fm) < WGM ? (nM - fm) : WGM;
        u.pm = fm + ((wgid % nig) % gsz); u.pn = (wgid % nig) / gsz; return true;
    }
    __device__ __forceinline__ void a_ready(const Unit&) const {}
    __device__ __forceinline__ void done(const Unit&) const {}
};

__device__ __forceinline__ unsigned cvt_pk_bf16(float lo, float hi) { unsigned r; asm volatile("v_cvt_pk_bf16_f32 %0, %1, %2" : "=v"(r) : "v"(lo), "v"(hi)); return r; }
template <class Epi, class Sched, bool ALIGN_EPI = false, bool SP2 = false>
__device__ __forceinline__ void gemm_phase(PG8_LAS unsigned char* lds, const Gemm g, const Sched& S, const Epi& E) {
    const int tid = threadIdx.x, wid = __builtin_amdgcn_readfirstlane(tid >> 6), lane = tid & 63, wr = wid >> 2, wc = wid & 3, fr = lane & 15, fq = lane >> 4;
    const int K = g.K, nt = K / BK;
    unsigned voffA[2], voffB[2];
#pragma unroll
    for (int i = 0; i < 2; ++i) { int R, C; stage_rc(tid * 16 + i * 8192, R, C); const int Rb = Epi::PERM ? ((R & ~31) + perm32(R & 31)) : R;
        voffA[i] = (unsigned)(R * K + C) * 2u; voffB[i] = (unsigned)(Rb * K + C) * 2u; }
    const size_t kstep = (size_t)(BK * 2);
    const size_t hstep = (size_t)HALF * K * 2;
    const size_t tstep = 2 * hstep;
    const unsigned ldsw = (unsigned)wid * 1024u;
    const int aoff = lds_byte(wr * 64 + fr, fq * 8), boff = lds_byte(wc * 32 + fr, fq * 8);
#define PG8_SA(b, h) (((b) * 2 + (h)) * HTB)
#define PG8_SB(b, h) ((4 + (b) * 2 + (h)) * HTB)
#define PG8_STAGE(bufoff, gbase, voff) do { _Pragma("unroll") for (int _i = 0; _i < 2; ++_i) \
        __builtin_amdgcn_global_load_lds((const unsigned*)((const char*)(gbase) + (voff)[_i]), (PG8_LAS unsigned*)(lds + (bufoff) + ldsw + _i * 8192), 16, 0, 0); } while (0)
#define PG8_LDA(dst, b, h) do { _Pragma("unroll") for (int m = 0; m < 4; ++m) _Pragma("unroll") for (int k = 0; k < 2; ++k) dst[m][k] = *(const PG8_LAS bf16x8*)(lds + PG8_SA(b, h) + aoff + m * 2048 + k * 1024); } while (0)
#define PG8_LDB(dst, b, h) do { _Pragma("unroll") for (int n = 0; n < 2; ++n) _Pragma("unroll") for (int k = 0; k < 2; ++k) dst[n][k] = *(const PG8_LAS bf16x8*)(lds + PG8_SB(b, h) + boff + n * 2048 + k * 1024); } while (0)
#define PG8_MMA(ai, bj, At, Bt) do { __builtin_amdgcn_s_setprio(1); _Pragma("unroll") for (int m = 0; m < 4; ++m) _Pragma("unroll") for (int n = 0; n < 2; ++n) _Pragma("unroll") for (int k = 0; k < 2; ++k) \
        acc[ai][bj][m][n] = __builtin_amdgcn_mfma_f32_16x16x32_bf16(Bt[n][k], At[m][k], acc[ai][bj][m][n], 0, 0, 0); __builtin_amdgcn_s_setprio(0); } while (0)
#define PG8_WAIT_V(n) asm volatile("s_waitcnt vmcnt(" #n ")" ::: "memory")
#define PG8_WAIT_L(n) asm volatile("s_waitcnt lgkmcnt(" #n ")" ::: "memory")
#define PG8_BAR __builtin_amdgcn_s_barrier()
#define PG8_SCHED __builtin_amdgcn_sched_barrier(0)
    Unit cur, nxt; int ui = 0;
    if (!S.next(0, cur)) return;
    f32x4 acc[2][2][4][2];
#pragma unroll
    for (int a = 0; a < 2; ++a)
#pragma unroll
        for (int b = 0; b < 2; ++b)
#pragma unroll
            for (int m = 0; m < 4; ++m)
#pragma unroll
                for (int n = 0; n < 2; ++n) acc[a][b][m][n] = (f32x4){0.f, 0.f, 0.f, 0.f};
    bf16x8 At[4][2], B0[2][2], B1[2][2];
    const char* cA = (const char*)g.A + (size_t)cur.pm * tstep; const char* cB = (const char*)g.Bt + (size_t)cur.pn * tstep;
    S.a_ready(cur);
    if constexpr (SP2) {
        PG8_STAGE(PG8_SB(0, 0), cB, voffB); PG8_STAGE(PG8_SB(0, 1), cB + hstep, voffB); PG8_STAGE(PG8_SA(0, 0), cA, voffA); PG8_STAGE(PG8_SA(0, 1), cA + hstep, voffA);
        if (wr == 1) PG8_BAR;
        PG8_WAIT_V(2); PG8_BAR;
        PG8_STAGE(PG8_SB(1, 0), cB + kstep, voffB); PG8_STAGE(PG8_SA(1, 0), cA + kstep, voffA); PG8_STAGE(PG8_SB(1, 1), cB + hstep + kstep, voffB);
        PG8_WAIT_V(6); PG8_BAR;
    } else {
        PG8_STAGE(PG8_SB(0, 0), cB, voffB); PG8_STAGE(PG8_SA(0, 0), cA, voffA); PG8_STAGE(PG8_SB(0, 1), cB + hstep, voffB); PG8_STAGE(PG8_SA(0, 1), cA + hstep, voffA);
        if (wr == 1) PG8_BAR;
        PG8_WAIT_V(4); PG8_BAR;
        PG8_STAGE(PG8_SB(1, 0), cB + kstep, voffB); PG8_STAGE(PG8_SA(1, 0), cA + kstep, voffA); PG8_STAGE(PG8_SB(1, 1), cB + hstep + kstep, voffB);
        PG8_WAIT_V(6); PG8_BAR;
    }
    for (;;) {
        const bool has_next = S.next(ui + 1, nxt);
        const char* nA = has_next ? (const char*)g.A + (size_t)nxt.pm * tstep : cA; const char* nB = has_next ? (const char*)g.Bt + (size_t)nxt.pn * tstep : cB;
        for (int t = 0; t < nt; t += 2) {
            const bool last = (t == nt - 2);
            const char* a1 = cA + (size_t)(t + 1) * kstep;
            const char* a2 = last ? nA : cA + (size_t)(t + 2) * kstep; const char* b2 = last ? nB : cB + (size_t)(t + 2) * kstep;
            const char* a3 = a2 + kstep; const char* b3 = b2 + kstep;
            if (last && has_next) S.a_ready(nxt);
            if constexpr (SP2) {
            PG8_LDB(B0, 0, 0); PG8_LDB(B1, 0, 1); PG8_SCHED; PG8_LDA(At, 0, 0); PG8_STAGE(PG8_SA(1, 1), a1 + hstep, voffA);
            PG8_WAIT_V(8); PG8_WAIT_L(0); PG8_BAR; PG8_MMA(0, 0, At, B0); PG8_MMA(0, 1, At, B1); PG8_BAR; PG8_SCHED;
            PG8_LDA(At, 0, 1); PG8_STAGE(PG8_SB(0, 0), b2, voffB); PG8_STAGE(PG8_SB(0, 1), b2 + hstep, voffB); PG8_STAGE(PG8_SA(0, 0), a2, voffA);
            PG8_WAIT_V(8); PG8_WAIT_L(0); PG8_BAR; PG8_MMA(1, 0, At, B0); PG8_MMA(1, 1, At, B1); PG8_BAR; PG8_SCHED;
            PG8_LDB(B0, 1, 0); PG8_LDB(B1, 1, 1); PG8_SCHED; PG8_LDA(At, 1, 0); PG8_STAGE(PG8_SA(0, 1), a2 + hstep, voffA);
            PG8_WAIT_V(8); PG8_WAIT_L(0); PG8_BAR; PG8_MMA(0, 0, At, B0); PG8_MMA(0, 1, At, B1); PG8_BAR; PG8_SCHED;
            PG8_LDA(At, 1, 1); PG8_STAGE(PG8_SB(1, 0), b3, voffB); PG8_STAGE(PG8_SB(1, 1), b3 + hstep, voffB); PG8_STAGE(PG8_SA(1, 0), a3, voffA);
            PG8_WAIT_V(8); PG8_WAIT_L(0); PG8_BAR; PG8_MMA(1, 0, At, B0); PG8_MMA(1, 1, At, B1); PG8_BAR; PG8_SCHED;
            } else {
            PG8_LDB(B0, 0, 0); PG8_SCHED; PG8_LDA(At, 0, 0); PG8_STAGE(PG8_SA(1, 1), a1 + hstep, voffA);
            PG8_WAIT_L(8); PG8_BAR; PG8_WAIT_L(0); PG8_MMA(0, 0, At, B0); PG8_BAR; PG8_SCHED;
            PG8_LDB(B1, 0, 1); PG8_STAGE(PG8_SB(0, 0), b2, voffB);
            PG8_BAR; PG8_WAIT_L(0); PG8_MMA(0, 1, At, B1); PG8_BAR;
            PG8_LDA(At, 0, 1); PG8_STAGE(PG8_SA(0, 0), a2, voffA);
            PG8_BAR; PG8_WAIT_L(0); PG8_MMA(1, 0, At, B0); PG8_BAR; PG8_SCHED;
            PG8_STAGE(PG8_SB(0, 1), b2 + hstep, voffB);
            PG8_WAIT_V(6); PG8_BAR; PG8_MMA(1, 1, At, B1); PG8_BAR;
            PG8_LDB(B0, 1, 0); PG8_SCHED; PG8_LDA(At, 1, 0); PG8_STAGE(PG8_SA(0, 1), a2 + hstep, voffA);
            PG8_WAIT_L(8); PG8_BAR; PG8_WAIT_L(0); PG8_MMA(0, 0, At, B0); PG8_BAR; PG8_SCHED;
            PG8_LDB(B1, 1, 1); PG8_STAGE(PG8_SB(1, 0), b3, voffB);
            PG8_BAR; PG8_WAIT_L(0); PG8_MMA(0, 1, At, B1); PG8_BAR;
            PG8_LDA(At, 1, 1); PG8_STAGE(PG8_SA(1, 0), a3, voffA);
            PG8_BAR; PG8_WAIT_L(0); PG8_MMA(1, 0, At, B0); PG8_BAR; PG8_SCHED;
            PG8_STAGE(PG8_SB(1, 1), b3 + hstep, voffB);
            PG8_WAIT_V(6); PG8_BAR; PG8_MMA(1, 1, At, B1); PG8_BAR;
            }
        }
        if constexpr (ALIGN_EPI) { if (wr == 0) PG8_BAR; }
        if constexpr (!Epi::AFTER_DRAIN) { E(acc, cur, wr, wc, fr, fq); S.done(cur); }
        if (!has_next) break;
#pragma unroll
        for (int a = 0; a < 2; ++a)
#pragma unroll
            for (int b = 0; b < 2; ++b)
#pragma unroll
                for (int m = 0; m < 4; ++m)
#pragma unroll
                    for (int n = 0; n < 2; ++n) acc[a][b][m][n] = (f32x4){0.f, 0.f, 0.f, 0.f};
        cur = nxt; cA = nA; cB = nB; ++ui;
        if constexpr (ALIGN_EPI) { if (wr == 1) PG8_BAR; }
    }
    PG8_WAIT_V(0);
    if constexpr (!ALIGN_EPI) { if (wr == 0) PG8_BAR; }
    PG8_BAR;
    if constexpr (Epi::AFTER_DRAIN) { E.fused(acc, cur, wr, wc, fr, fq, lds, wid, lane); S.done(cur); }
#undef PG8_SA
#undef PG8_SB
#undef PG8_STAGE
#undef PG8_LDA
#undef PG8_LDB
#undef PG8_MMA
#undef PG8_WAIT_V
#undef PG8_WAIT_L
#undef PG8_BAR
#undef PG8_SCHED
}
}
#define GAS __attribute__((address_space(1)))
#define LAS __attribute__((address_space(3)))

__device__ __forceinline__ int zcol_src(int n, float& sc) {
    sc = 1.f;
    if (n < ZB_Q) return n;
    if (n < ZB_K) { int o = n - ZB_Q, h = o >> 6, d = o & 63; sc = QSCALE; if (d < 16) d = (d >> 1) + 8 * (d & 1); return ZB_Q + h * 64 + d; }
    if (n < ZB_V) { int d = n - ZB_K; if (d < 16) d = (d >> 1) + 8 * (d & 1); return ZB_K + d; }
    if (n < ZB_IQ) return n;
    if (n < ZB_IK) { int o = n - ZB_IQ, h = o >> 5, d = o & 31; sc = IQSCALE; if (d < 8) d = (d >> 1) + 4 * (d & 1); return ZB_IQ + h * 32 + d; }
    if (n < ZB_IW) { int d = n - ZB_IK; if (d < 8) d = (d >> 1) + 4 * (d & 1); return ZB_IK + d; }
    if (n < ZB_G) { sc = IWSCALE; return n; }
    if (n < ZC_Q) return n;
    if (n < ZC_K) { int o = n - ZC_Q, h = o >> 6, d = o & 63; sc = QSCALE; if (d < 16) d = (d >> 1) + 8 * (d & 1); return ZC_Q + h * 64 + d; }
    if (n < ZC_V) { int o = n - ZC_K, h = o >> 6, d = o & 63; if (d < 16) d = (d >> 1) + 8 * (d & 1); return ZC_K + h * 64 + d; }
    return n;
}

template <bool ZMAP>
__device__ __forceinline__ void transpose_item(const float* __restrict__ W, int K, int NW, bf16_t* WT, const float* __restrict__ kscale, LAS float* scr, int item, int nblk, int lane) {
    const int kb = item / nblk, nb = item % nblk, k0 = 64 * kb, n0 = 32 * nb;
    const int ncol = n0 + (lane & 31);
#pragma unroll 8
    for (int i = 0; i < 32; ++i) { const int kk = 2 * i + (lane >> 5);
        float v = 0.f; if (ncol < NW) { v = W[(size_t)(k0 + kk) * NW + ncol]; if (kscale) v *= kscale[k0 + kk]; }
        scr[kk * 33 + (lane & 31)] = v; }
    asm volatile("s_waitcnt lgkmcnt(0)" ::: "memory");
    const int c = lane & 7;
#pragma unroll
    for (int j = 0; j < 4; ++j) { const int n = (lane >> 3) + 8 * j; int sl = n; float sc = 1.f;
        if (ZMAP) { if (n0 + n < NW) sl = zcol_src(n0 + n, sc) - n0; else { sl = n; sc = 0.f; } }
        const LAS float* s = scr + (8 * c) * 33 + sl;
        u32x4 o; o.x = pk2(s[0 * 33] * sc, s[1 * 33] * sc); o.y = pk2(s[2 * 33] * sc, s[3 * 33] * sc); o.z = pk2(s[4 * 33] * sc, s[5 * 33] * sc); o.w = pk2(s[6 * 33] * sc, s[7 * 33] * sc);
        *(u32x4*)(WT + (size_t)(n0 + n) * K + k0 + 8 * c) = o; }
    asm volatile("s_waitcnt lgkmcnt(0)" ::: "memory");
}

struct PrepArgs { const float* w_in; const float* norm_g; const float* w_out; const float* ple_g; const float* w_gate; const float* w_proj; unsigned char* ws; };

__device__ __forceinline__ void prep_weights(const PrepArgs& a, int gw, int ngw, LAS float* scr, int lane) {
    constexpr int I_IN = 16 * (NPAD / 32), I_SQ = 16 * 32, I_PJ = 4 * 32, I_LAYER = I_IN + 2 * I_SQ + I_PJ;
    for (int it = gw; it < DEPTH * I_LAYER; it += ngw) {
        const int L = it / I_LAYER; int r = it % I_LAYER;
        unsigned char* wl = a.ws + WS_W + (size_t)L * W_LAYER;
        if (r < I_IN) { transpose_item<true>(a.w_in + (size_t)L * DM * ZP, DM, ZP, (bf16_t*)(wl + W_IN), a.norm_g + L * DM, scr, r, NPAD / 32, lane); continue; } r -= I_IN;
        if (r < I_SQ) { transpose_item<false>(a.w_out + (size_t)L * DM * DM, DM, DM, (bf16_t*)(wl + W_OUT), nullptr, scr, r, 32, lane); continue; } r -= I_SQ;
        if (r < I_SQ) { transpose_item<false>(a.w_gate + (size_t)L * DM * DM, DM, DM, (bf16_t*)(wl + W_GATE), a.ple_g + L * DM, scr, r, 32, lane); continue; } r -= I_SQ;
        transpose_item<false>(a.w_proj + (size_t)L * 256 * DM, 256, DM, (bf16_t*)(wl + W_PROJ), nullptr, scr, r, 32, lane);
    }
}

__device__ __forceinline__ void sincos_d(float ang, float& c, float& s) {
    const double a = (double)ang; const double n = rint(a * 0.63661977236758134308);
    double r = fma(-n, 1.57079632679489655800e+00, a); r = fma(-n, 6.12323399573676603587e-17, r);
    const double r2 = r * r;
    double sp = r2 * (1.0 / 6227020800.0) - 1.0 / 39916800.0; sp = sp * r2 + 1.0 / 362880.0; sp = sp * r2 - 1.0 / 5040.0; sp = sp * r2 + 1.0 / 120.0; sp = sp * r2 - 1.0 / 6.0; sp = sp * r2 * r + r;
    double cp = r2 * (1.0 / 479001600.0) - 1.0 / 3628800.0; cp = cp * r2 + 1.0 / 40320.0; cp = cp * r2 - 1.0 / 720.0; cp = cp * r2 + 1.0 / 24.0; cp = cp * r2 - 0.5; cp = cp * r2 + 1.0;
    const int q = ((int)n) & 3;
    const double sv = (q == 0) ? sp : (q == 1) ? cp : (q == 2) ? -sp : -cp;
    const double cv = (q == 0) ? cp : (q == 1) ? -sp : (q == 2) ? -cp : sp;
    c = (float)cv; s = (float)sv;
}
__device__ __forceinline__ void prep_tables(unsigned char* ws, int gtid, int nthreads) {
    const float inv8[8] = {1.0f, 0.1939227432012558f, 0.03760603070259094f, 0.007292664609849453f, 0.0014142135623842478f, 0.00027424818836152554f, 5.318296098266728e-05f, 1.0313386155758053e-05f};
    float* t16 = (float*)(ws + WS_TAB16); float* tI = (float*)(ws + WS_TABI);
    for (int e = gtid; e < SEQ * 8; e += nthreads) { const int pos = e >> 3, i = e & 7;
        float iv = inv8[0];
#pragma unroll
        for (int j = 1; j < 8; ++j) iv = (i == j) ? inv8[j] : iv;
        float c, s; sincos_d((float)pos * iv, c, s); t16[pos * 16 + i] = c; t16[pos * 16 + 8 + i] = s;
        if ((i & 1) == 0) { const int i4 = i >> 1; tI[pos * 8 + i4] = c; tI[pos * 8 + 4 + i4] = s; }
    }
}
__device__ __forceinline__ void x_row_to_bf16(const float* xrow, bf16_t* orow, float* ssq, int lane) {
    const f32x4* xr = (const f32x4*)xrow + lane;
    unsigned long long* o8 = (unsigned long long*)orow + lane;
#pragma unroll
    for (int j = 0; j < 4; ++j) { const f32x4 v = xr[64 * j];
        float s = (v.x * v.x + v.y * v.y) + (v.z * v.z + v.w * v.w);
        o8[64 * j] = (unsigned long long)pk2(v.x, v.y) | ((unsigned long long)pk2(v.z, v.w) << 32);
        s += __shfl_xor(s, 1); s += __shfl_xor(s, 2); s += __shfl_xor(s, 4); s += __shfl_xor(s, 8);
        if ((lane & 15) == 0) ssq[4 * j + (lane >> 4)] = s; }
}
__device__ __forceinline__ float row_rstd(const float* ssq_row) {
    const f32x4 a = *(const f32x4*)ssq_row, b = *(const f32x4*)(ssq_row + 4), c = *(const f32x4*)(ssq_row + 8), d = *(const f32x4*)(ssq_row + 12);
    const float s = ((a.x + a.y) + (a.z + a.w)) + ((b.x + b.y) + (b.z + b.w)) + ((c.x + c.y) + (c.z + c.w)) + ((d.x + d.y) + (d.z + d.w));
    return 1.0f / sqrtf(s * (1.0f / DM) + NORM_EPS);
}
namespace epi {
using pg8::Unit; using pg8::BM; using pg8::HALF;
__device__ __forceinline__ u32x4 pack8(const f32x4& a, const f32x4& b) { u32x4 w; w.x = pg8::cvt_pk_bf16(a[0], a[1]); w.y = pg8::cvt_pk_bf16(a[2], a[3]); w.z = pg8::cvt_pk_bf16(b[0], b[1]); w.w = pg8::cvt_pk_bf16(b[2], b[3]); return w; }
__device__ __forceinline__ int rope_class(int c0, int& fb) {
    fb = 0; int o;
    if (c0 >= ZB_Q && c0 < ZB_V) { o = (c0 - ZB_Q) & 63; if (o < 16) { fb = o >> 1; return 1; } return 0; }
    if (c0 >= ZB_IQ && c0 < ZB_IW) { o = (c0 - ZB_IQ) & 31; return o == 0 ? 2 : 0; }
    if (c0 >= ZC_Q && c0 < ZC_V) { o = (c0 - ZC_Q) & 63; if (o < 16) { fb = o >> 1; return 1; } return 0; }
    return 0;
}
struct EpiInProj {
    static constexpr bool PERM = true, AFTER_DRAIN = false;
    bf16_t* Z; const float* ssq; const float* tab16; const float* tabI;
    __device__ __forceinline__ void operator()(const f32x4 (&acc)[2][2][4][2], const Unit& u, int wr, int wc, int fr, int fq) const {
        const int row0 = u.pm * BM + wr * 64 + fr;
        float rs[2][4];
#pragma unroll
        for (int ai = 0; ai < 2; ++ai)
#pragma unroll
            for (int m = 0; m < 4; ++m) rs[ai][m] = row_rstd(ssq + (size_t)(row0 + ai * HALF + m * 16) * 16);
#pragma unroll
        for (int bj = 0; bj < 2; ++bj) {
            const int c0 = u.pn * BM + bj * HALF + wc * 32 + 8 * fq;
            if (c0 >= ZP) continue;
            int fb; const int rc = rope_class(c0, fb);
#pragma unroll
            for (int ai = 0; ai < 2; ++ai)
#pragma unroll
                for (int m = 0; m < 4; ++m) {
                    const int row = row0 + ai * HALF + m * 16;
                    f32x4 v0 = acc[ai][bj][m][0] * rs[ai][m], v1 = acc[ai][bj][m][1] * rs[ai][m];
                    if (rc) {
                        const int pos = row & (SEQ - 1);
                        const float* tp = (rc == 1) ? tab16 + pos * 16 + fb : tabI + pos * 8;
                        const f32x4 c = *(const f32x4*)tp, s = *(const f32x4*)(tp + (rc == 1 ? 8 : 4));
                        f32x4 a0, a1;
                        a0[0] = v0[0] * c[0] - v0[1] * s[0]; a0[1] = v0[1] * c[0] + v0[0] * s[0];
                        a0[2] = v0[2] * c[1] - v0[3] * s[1]; a0[3] = v0[3] * c[1] + v0[2] * s[1];
                        a1[0] = v1[0] * c[2] - v1[1] * s[2]; a1[1] = v1[1] * c[2] + v1[0] * s[2];
                        a1[2] = v1[2] * c[3] - v1[3] * s[3]; a1[3] = v1[3] * c[3] + v1[2] * s[3];
                        v0 = a0; v1 = a1;
                    }
                    *(u32x4*)(Z + (size_t)row * ZP + c0) = pack8(v0, v1);
                }
        }
    }
};
struct EpiOutProj {
    static constexpr bool PERM = true, AFTER_DRAIN = false;
    const float* xin; float* xout; bf16_t* xb; float* ssq_out;
    __device__ __forceinline__ void operator()(const f32x4 (&acc)[2][2][4][2], const Unit& u, int wr, int wc, int fr, int fq) const {
        const int row0 = u.pm * BM + wr * 64 + fr;
#pragma unroll
        for (int ai = 0; ai < 2; ++ai)
#pragma unroll
            for (int m = 0; m < 4; ++m) {
                const int row = row0 + ai * HALF + m * 16; float sq = 0.f;
#pragma unroll
                for (int bj = 0; bj < 2; ++bj) {
                    const size_t off = (size_t)row * DM + u.pn * BM + bj * HALF + wc * 32 + 8 * fq;
                    const f32x4 x0 = *(const f32x4*)(xin + off) + acc[ai][bj][m][0], x1 = *(const f32x4*)(xin + off + 4) + acc[ai][bj][m][1];
                    *(f32x4*)(xout + off) = x0; *(f32x4*)(xout + off + 4) = x1;
                    *(u32x4*)(xb + off) = pack8(x0, x1);
                    sq += ((x0[0] * x0[0] + x0[1] * x0[1]) + (x0[2] * x0[2] + x0[3] * x0[3])) + ((x1[0] * x1[0] + x1[1] * x1[1]) + (x1[2] * x1[2] + x1[3] * x1[3]));
                }
                sq += __shfl_xor(sq, 16); sq += __shfl_xor(sq, 32);
                if (fq == 0) ssq_out[(size_t)row * 16 + u.pn * 4 + wc] = sq;
            }
    }
};
struct EpiGate {
    static constexpr bool PERM = true, AFTER_DRAIN = false;
    float* xio; const float* pp; bf16_t* xb; const float* ssq_in; float* ssq_out;
    __device__ __forceinline__ void operator()(const f32x4 (&acc)[2][2][4][2], const Unit& u, int wr, int wc, int fr, int fq) const {
        const int row0 = u.pm * BM + wr * 64 + fr;
#pragma unroll
        for (int ai = 0; ai < 2; ++ai)
#pragma unroll
            for (int m = 0; m < 4; ++m) {
                const int row = row0 + ai * HALF + m * 16; float sq = 0.f;
                const float rs = row_rstd(ssq_in + (size_t)row * 16);
#pragma unroll
                for (int bj = 0; bj < 2; ++bj) {
                    const size_t off = (size_t)row * DM + u.pn * BM + bj * HALF + wc * 32 + 8 * fq;
                    f32x4 g0 = acc[ai][bj][m][0] * rs, g1 = acc[ai][bj][m][1] * rs;
#pragma unroll
                    for (int i = 0; i < 4; ++i) { g0[i] = 1.0f / (1.0f + __expf(-g0[i])); g1[i] = 1.0f / (1.0f + __expf(-g1[i])); }
                    const f32x4 x0 = *(const f32x4*)(xio + off) + g0 * *(const f32x4*)(pp + off), x1 = *(const f32x4*)(xio + off + 4) + g1 * *(const f32x4*)(pp + off + 4);
                    *(f32x4*)(xio + off) = x0; *(f32x4*)(xio + off + 4) = x1;
                    *(u32x4*)(xb + off) = pack8(x0, x1);
                    sq += ((x0[0] * x0[0] + x0[1] * x0[1]) + (x0[2] * x0[2] + x0[3] * x0[3])) + ((x1[0] * x1[0] + x1[1] * x1[1]) + (x1[2] * x1[2] + x1[3] * x1[3]));
                }
                sq += __shfl_xor(sq, 16); sq += __shfl_xor(sq, 32);
                if (fq == 0) ssq_out[(size_t)row * 16 + u.pn * 4 + wc] = sq;
            }
    }
};
struct EpiF32 {
    static constexpr bool PERM = true, AFTER_DRAIN = false;
    float* C;
    __device__ __forceinline__ void operator()(const f32x4 (&acc)[2][2][4][2], const Unit& u, int wr, int wc, int fr, int fq) const {
        const int row0 = u.pm * BM + wr * 64 + fr;
#pragma unroll
        for (int ai = 0; ai < 2; ++ai)
#pragma unroll
            for (int m = 0; m < 4; ++m)
#pragma unroll
                for (int bj = 0; bj < 2; ++bj) {
                    const size_t off = (size_t)(row0 + ai * HALF + m * 16) * DM + u.pn * BM + bj * HALF + wc * 32 + 8 * fq;
                    *(f32x4*)(C + off) = acc[ai][bj][m][0]; *(f32x4*)(C + off + 4) = acc[ai][bj][m][1];
                }
    }
};
}
struct MixArgs { const bf16_t* Z; bf16_t* Y; const float* mu; const float* w0; const float* w_up; const float* a0; const float* a_up; const float* k_k; const float* k_a; const float* r_k; const float* ln_g; const float* ln_b; };

__global__ void __launch_bounds__(256) rwkv_seq_kernel(MixArgs a) {
    constexpr int TB = 16;
    __shared__ float sr[TB][64], sw[TB][64], sk[TB][64], sv[TB][64], skk[TB][64], sb[TB][64], sg[TB][64], swd[TB][64], sad[TB][64], sy[TB][64];
    const int b = blockIdx.x / 6, h = blockIdx.x % 6, tid = threadIdx.x, lane = tid & 63, wv = tid >> 6;
    const int vrow = tid >> 2, kq = tid & 3;
    float st[16];
#pragma unroll
    for (int i = 0; i < 16; ++i) st[i] = 0.f;
    for (int t0 = 0; t0 < SEQ; t0 += TB) {
        for (int idx = tid; idx < TB * 64; idx += 256) {
            const int t = idx >> 6, c = idx & 63, tok = t0 + t;
            const bf16_t* zr = a.Z + (size_t)(b * SEQ + tok) * ZP; const bf16_t* zp = zr - ZP; const bool hp = tok > 0;
            auto mix = [&](int col) { const float cur = bf2f(zr[col]), prv = hp ? bf2f(zp[col]) : 0.f; return cur + (prv - cur) * a.mu[col]; };
            sr[t][c] = mix(ZA_R + h * 64 + c); sk[t][c] = mix(ZA_K + h * 64 + c); sv[t][c] = mix(ZA_V + h * 64 + c); sg[t][c] = mix(ZA_G + h * 64 + c);
            swd[t][c] = tanhf(mix(ZA_WD + c)); sad[t][c] = mix(ZA_AD + c);
        }
        __syncthreads();
        for (int idx = tid; idx < TB * 64; idx += 256) {
            const int t = idx >> 6, c = idx & 63, hc = h * 64 + c;
            float pw = a.w0[hc], pa = a.a0[hc];
            for (int j = 0; j < 64; ++j) { pw += swd[t][j] * a.w_up[j * 384 + hc]; pa += sad[t][j] * a.a_up[j * 384 + hc]; }
            const float w = __expf(-DECAY_SCALE * sigmoidf_(pw)), eta = sigmoidf_(pa);
            const float k = sk[t][c];
            sw[t][c] = w; sb[t][c] = eta; skk[t][c] = k * a.k_k[hc]; sk[t][c] = k * (1.f + (eta - 1.f) * a.k_a[hc]);
        }
        __syncthreads();
        for (int t = wv; t < TB; t += 4) {
            const float kr = skk[t][lane]; const float nrm = sqrtf(wave_sum(kr * kr)); const float kk = kr / fmaxf(nrm, 1e-12f);
            skk[t][lane] = kk; sb[t][lane] = kk * sb[t][lane];
        }
        __syncthreads();
        for (int t = 0; t < TB; ++t) {
            float sa = 0.f;
#pragma unroll
            for (int i = 0; i < 16; ++i) sa -= st[i] * skk[t][kq * 16 + i];
            sa += __shfl_xor(sa, 1); sa += __shfl_xor(sa, 2);
            const float vv = sv[t][vrow]; float yy = 0.f;
#pragma unroll
            for (int i = 0; i < 16; ++i) { const int kc = kq * 16 + i; st[i] = st[i] * sw[t][kc] + sa * sb[t][kc] + vv * sk[t][kc]; yy += st[i] * sr[t][kc]; }
            yy += __shfl_xor(yy, 1); yy += __shfl_xor(yy, 2);
            if (kq == 0) sy[t][vrow] = yy;
        }
        __syncthreads();
        for (int t = wv; t < TB; t += 4) {
            const int hc = h * 64 + lane;
            const float y = sy[t][lane]; const float mean = wave_sum(y) * (1.f / 64.f); const float d = y - mean; const float var = wave_sum(d * d) * (1.f / 64.f);
            const float yn = d * (1.0f / sqrtf(var + GN_EPS)) * a.ln_g[hc] + a.ln_b[hc];
            const float bonus = wave_sum(sr[t][lane] * sk[t][lane] * a.r_k[hc]) * sv[t][lane];
            const float g = sg[t][lane];
            a.Y[(size_t)(b * SEQ + t0 + t) * DM + hc] = (bf16_t)f2bf((yn + bonus) * g * sigmoidf_(g));
        }
        __syncthreads();
    }
}

__global__ void __launch_bounds__(256) dsa_simple_kernel(MixArgs a) {
    __shared__ float s_iq[4][256], s_iw[4][8], s_q[4][256], s_p[4][4][256];
    __shared__ unsigned s_key[4][SEQ];
    __shared__ int s_idx[4][256];
    const int wv = threadIdx.x >> 6, lane = threadIdx.x & 63;
    const int row = blockIdx.x * 4 + wv, b = row / SEQ, t = row % SEQ;
    const bf16_t* zr = a.Z + (size_t)row * ZP; const bf16_t* zb = a.Z + (size_t)b * SEQ * ZP;
    for (int i = lane; i < 256; i += 64) { s_iq[wv][i] = bf2f(zr[ZB_IQ + i]); s_q[wv][i] = bf2f(zr[ZB_Q + i]); }
    if (lane < 8) s_iw[wv][lane] = bf2f(zr[ZB_IW + lane]);
    __syncthreads();
    const int nj = (t >> 6) + 1;
    for (int j = 0; j < nj; ++j) {
        const int s = lane + 64 * j; unsigned u = 0u;
        if (s <= t) {
            const u32x4* kp = (const u32x4*)(zb + (size_t)s * ZP + ZB_IK); float ik[32];
#pragma unroll
            for (int q4 = 0; q4 < 4; ++q4) { const u32x4 w = kp[q4];
                ik[q4 * 8 + 0] = bflo(w.x); ik[q4 * 8 + 1] = bfhi(w.x); ik[q4 * 8 + 2] = bflo(w.y); ik[q4 * 8 + 3] = bfhi(w.y); ik[q4 * 8 + 4] = bflo(w.z); ik[q4 * 8 + 5] = bfhi(w.z); ik[q4 * 8 + 6] = bflo(w.w); ik[q4 * 8 + 7] = bfhi(w.w); }
            float sc = 0.f;
#pragma unroll
            for (int hh = 0; hh < 8; ++hh) { float d = 0.f;
#pragma unroll
                for (int dd = 0; dd < 32; ++dd) d += s_iq[wv][hh * 32 + dd] * ik[dd];
                sc += s_iw[wv][hh] * fmaxf(d, 0.f); }
            const unsigned bits = __builtin_bit_cast(unsigned, sc);
            u = (bits & 0x80000000u) ? ~bits : (bits | 0x80000000u);
        }
        s_key[wv][s] = u;
    }
    __syncthreads();
    int nsel;
    if (t < 256) { for (int s = lane; s <= t; s += 64) s_idx[wv][s] = s; nsel = t + 1; }
    else {
        unsigned prefix = 0u;
        for (int bit = 31; bit >= 0; --bit) { const unsigned cand = prefix | (1u << bit); int cnt = 0;
            for (int j = 0; j < nj; ++j) cnt += __popcll(__ballot(s_key[wv][lane + 64 * j] >= cand));
            if (cnt >= 256) prefix = cand; }
        int ngt = 0;
        for (int j = 0; j < nj; ++j) ngt += __popcll(__ballot(s_key[wv][lane + 64 * j] > prefix));
        const int need = 256 - ngt; int nt = 0, ns = 0;
        for (int j = 0; j < nj; ++j) { const unsigned u = s_key[wv][lane + 64 * j];
            const unsigned long long mt = __ballot(u == prefix); const int trank = nt + __popcll(mt & ((1ull << lane) - 1ull));
            const bool sel = (u > prefix) || (u == prefix && trank < need);
            const unsigned long long ms = __ballot(sel); const int slot = ns + __popcll(ms & ((1ull << lane) - 1ull));
            if (sel) s_idx[wv][slot] = lane + 64 * j;
            nt += __popcll(mt); ns += __popcll(ms); }
        nsel = ns;
    }
    __syncthreads();
    float lg[4][4];
#pragma unroll
    for (int i = 0; i < 4; ++i) { const int slot = lane + 64 * i;
#pragma unroll
        for (int hh = 0; hh < 4; ++hh) lg[i][hh] = -INFINITY;
        if (slot < nsel) { const int s = s_idx[wv][slot]; const u32x4* kp = (const u32x4*)(zb + (size_t)s * ZP + ZB_K);
            float acc4[4] = {0.f, 0.f, 0.f, 0.f};
#pragma unroll
            for (int q8 = 0; q8 < 8; ++q8) { const u32x4 w = kp[q8]; float kv[8] = {bflo(w.x), bfhi(w.x), bflo(w.y), bfhi(w.y), bflo(w.z), bfhi(w.z), bflo(w.w), bfhi(w.w)};
#pragma unroll
                for (int hh = 0; hh < 4; ++hh)
#pragma unroll
                    for (int e = 0; e < 8; ++e) acc4[hh] += s_q[wv][hh * 64 + q8 * 8 + e] * kv[e]; }
#pragma unroll
            for (int hh = 0; hh < 4; ++hh) lg[i][hh] = acc4[hh]; } }
#pragma unroll
    for (int hh = 0; hh < 4; ++hh) {
        float m = fmaxf(fmaxf(lg[0][hh], lg[1][hh]), fmaxf(lg[2][hh], lg[3][hh])); m = wave_max(m);
        float p[4], l = 0.f;
#pragma unroll
        for (int i = 0; i < 4; ++i) { p[i] = exp2f(lg[i][hh] - m); l += p[i]; }
        l = wave_sum(l); const float rl = 1.f / l;
#pragma unroll
        for (int i = 0; i < 4; ++i) s_p[wv][hh][lane + 64 * i] = p[i] * rl;
    }
    __syncthreads();
    float o[4] = {0.f, 0.f, 0.f, 0.f};
    for (int slot = 0; slot < nsel; ++slot) { const int s = s_idx[wv][slot]; const float vv = bf2f(zb[(size_t)s * ZP + ZB_V + lane]);
#pragma unroll
        for (int hh = 0; hh < 4; ++hh) o[hh] += s_p[wv][hh][slot] * vv; }
#pragma unroll
    for (int hh = 0; hh < 4; ++hh) { const float g = bf2f(zr[ZB_G + hh * 64 + lane]); a.Y[(size_t)row * DM + 384 + hh * 64 + lane] = (bf16_t)f2bf(o[hh] * g * sigmoidf_(g)); }
}

__global__ void __launch_bounds__(256) dil_simple_kernel(MixArgs a) {
    __shared__ float s_q[4][64], s_p[4][192];
    const int wv = threadIdx.x >> 6, lane = threadIdx.x & 63;
    const int wid = blockIdx.x * 4 + wv, row = wid >> 1, hg = wid & 1, b = row / SEQ, t = row % SEQ;
    const bf16_t* zr = a.Z + (size_t)row * ZP; const bf16_t* zb = a.Z + (size_t)b * SEQ * ZP;
    float og[3], lse[3];
#pragma unroll
    for (int gi = 0; gi < 3; ++gi) {
        const int head = gi * 2 + hg, rate = (gi == 0) ? 1 : (gi == 1) ? 4 : 16;
        const int ip = t / rate; const int nkeys = (ip < 128 ? ip : 128) + 1;
        __syncthreads();
        s_q[wv][lane] = bf2f(zr[ZC_Q + head * 64 + lane]);
        __syncthreads();
        float lg[3];
#pragma unroll
        for (int i = 0; i < 3; ++i) { const int j = lane + 64 * i; lg[i] = -INFINITY;
            if (j < nkeys) { const u32x4* kp = (const u32x4*)(zb + (size_t)(t - j * rate) * ZP + ZC_K + head * 64); float d = 0.f;
#pragma unroll
                for (int q8 = 0; q8 < 8; ++q8) { const u32x4 w = kp[q8]; const float kv[8] = {bflo(w.x), bfhi(w.x), bflo(w.y), bfhi(w.y), bflo(w.z), bfhi(w.z), bflo(w.w), bfhi(w.w)};
#pragma unroll
                    for (int e = 0; e < 8; ++e) d += s_q[wv][q8 * 8 + e] * kv[e]; }
                lg[i] = d; } }
        const float m = wave_max(fmaxf(fmaxf(lg[0], lg[1]), lg[2]));
        float p[3], l = 0.f;
#pragma unroll
        for (int i = 0; i < 3; ++i) { p[i] = exp2f(lg[i] - m); l += p[i]; }
        l = wave_sum(l); const float rl = 1.f / l;
#pragma unroll
        for (int i = 0; i < 3; ++i) s_p[wv][lane + 64 * i] = p[i] * rl;
        __syncthreads();
        float o = 0.f;
        for (int j = 0; j < nkeys; ++j) o += s_p[wv][j] * bf2f(zb[(size_t)(t - j * rate) * ZP + ZC_V + head * 64 + lane]);
        og[gi] = o; lse[gi] = m + log2f(l);
    }
    const float mx = fmaxf(fmaxf(lse[0], lse[1]), lse[2]);
    const float e0 = exp2f(lse[0] - mx), e1 = exp2f(lse[1] - mx), e2 = exp2f(lse[2] - mx); const float rs = 1.f / (e0 + e1 + e2);
    const float al[3] = {e0 * rs, e1 * rs, e2 * rs};
#pragma unroll
    for (int gi = 0; gi < 3; ++gi) { const int head = gi * 2 + hg; const float g = bf2f(zr[ZC_G + head * 64 + lane]);
        a.Y[(size_t)row * DM + 640 + head * 64 + lane] = (bf16_t)f2bf(og[gi] * al[gi] * g * sigmoidf_(g)); }
}
struct GemmArgs { const bf16_t* A; const bf16_t* Bt; int M, N, K, pad; };
template <class Epi> __global__ void __launch_bounds__(512, 2) gemm_kernel(GemmArgs ga, Epi e) {
    extern __shared__ __attribute__((aligned(16))) unsigned char lds[];
    pg8::Gemm g{ga.A, ga.Bt, ga.M, ga.N, ga.K}; const int M = ga.M, N = ga.N; pg8::StaticOrder S; S.init(M, N, gridDim.x, blockIdx.x);
    pg8::gemm_phase<Epi, pg8::StaticOrder, true, true>((PG8_LAS unsigned char*)lds, g, S, e);
}
__global__ void __launch_bounds__(512) prep_kernel(PrepArgs a, const float* x, bf16_t* xb, float* ssq) {
    __shared__ float scr[8][64 * 33];
    const int tid = threadIdx.x, lane = tid & 63, wv = tid >> 6, gw = blockIdx.x * 8 + wv, ngw = gridDim.x * 8;
    prep_tables(a.ws, blockIdx.x * 512 + tid, gridDim.x * 512);
    prep_weights(a, gw, ngw, (LAS float*)&scr[wv][0], lane);
    for (int m = gw; m < MTOK; m += ngw) x_row_to_bf16(x + (size_t)m * DM, xb + (size_t)m * DM, ssq + (size_t)m * 16, lane);
}
__global__ void __launch_bounds__(256) cvt_bf16_kernel(const float* src, bf16_t* dst, size_t n8) {
    for (size_t i = blockIdx.x * 256 + threadIdx.x; i < n8; i += gridDim.x * 256) {
        const f32x4 a = ((const f32x4*)src)[2 * i], b = ((const f32x4*)src)[2 * i + 1];
        u32x4 w; w.x = pk2(a.x, a.y); w.y = pk2(a.z, a.w); w.z = pk2(b.x, b.y); w.w = pk2(b.z, b.w); ((u32x4*)dst)[i] = w; }
}
__global__ void __launch_bounds__(256) final_norm_kernel(float* x, const float* ssq, const float* g) {
    const int lane = threadIdx.x & 63, gw = (blockIdx.x * 256 + threadIdx.x) >> 6, ngw = gridDim.x * 4;
    for (int m = gw; m < MTOK; m += ngw) { const float rs = row_rstd(ssq + (size_t)m * 16); f32x4* xr = (f32x4*)(x + (size_t)m * DM) + lane;
#pragma unroll
        for (int j = 0; j < 4; ++j) { const f32x4 gv = ((const f32x4*)g)[64 * j + lane]; xr[64 * j] = xr[64 * j] * rs * gv; } }
}

static GemmArgs mkg(const bf16_t* A, const bf16_t* Bt, int M, int N, int K) { GemmArgs g; memset(&g, 0, sizeof g); g.A = A; g.Bt = Bt; g.M = M; g.N = N; g.K = K; return g; }
extern "C" void kernel_launch(void* const* d_in, const int* in_sizes, int n_in, void* d_out, int out_size, void* d_ws, size_t ws_size, hipStream_t stream) {
    static int inited = 0;
    constexpr int GLDS = 131072;
    if (!inited) {
        if (n_in != 19 || out_size != MTOK * DM || ws_size < WS_END) { fprintf(stderr, "kernel_launch: unexpected shapes n_in %d out %d ws %zu\n", n_in, out_size, ws_size); inited = -1; return; }
        hipFuncSetAttribute((const void*)gemm_kernel<epi::EpiInProj>, hipFuncAttributeMaxDynamicSharedMemorySize, GLDS);
        hipFuncSetAttribute((const void*)gemm_kernel<epi::EpiOutProj>, hipFuncAttributeMaxDynamicSharedMemorySize, GLDS);
        hipFuncSetAttribute((const void*)gemm_kernel<epi::EpiGate>, hipFuncAttributeMaxDynamicSharedMemorySize, GLDS);
        hipFuncSetAttribute((const void*)gemm_kernel<epi::EpiF32>, hipFuncAttributeMaxDynamicSharedMemorySize, GLDS);
        inited = 1;
    }
    if (inited < 0) return;
    const float* x = (const float*)d_in[0]; const float* p = (const float*)d_in[1];
    const float* norm_g = (const float*)d_in[2]; const float* w_in = (const float*)d_in[3]; const float* mu = (const float*)d_in[4];
    const float* w0 = (const float*)d_in[5]; const float* w_up = (const float*)d_in[6]; const float* a0 = (const float*)d_in[7]; const float* a_up = (const float*)d_in[8];
    const float* k_k = (const float*)d_in[9]; const float* k_a = (const float*)d_in[10]; const float* r_k = (const float*)d_in[11]; const float* ln_g = (const float*)d_in[12]; const float* ln_b = (const float*)d_in[13];
    const float* w_out = (const float*)d_in[14]; const float* ple_g = (const float*)d_in[15]; const float* w_gate = (const float*)d_in[16]; const float* w_proj = (const float*)d_in[17]; const float* fin_g = (const float*)d_in[18];
    unsigned char* ws = (unsigned char*)d_ws; float* out = (float*)d_out;
    bf16_t* bufA = (bf16_t*)(ws + WS_BUFA); bf16_t* bufB = (bf16_t*)(ws + WS_BUFB); bf16_t* Z = (bf16_t*)(ws + WS_Z); float* PP = (float*)(ws + WS_Z); bf16_t* PB = (bf16_t*)(ws + WS_PB);
    float* ssqA = (float*)(ws + WS_SSQA); float* ssqB = (float*)(ws + WS_SSQB);
    const float* tab16 = (const float*)(ws + WS_TAB16); const float* tabI = (const float*)(ws + WS_TABI);
    PrepArgs pa; memset(&pa, 0, sizeof pa); pa.w_in = w_in; pa.norm_g = norm_g; pa.w_out = w_out; pa.ple_g = ple_g; pa.w_gate = w_gate; pa.w_proj = w_proj; pa.ws = ws;
    hipLaunchKernelGGL(prep_kernel, dim3(512), dim3(512), 0, stream, pa, x, bufA, ssqA);
    for (int L = 0; L < DEPTH; ++L) {
        bf16_t* cur = (L & 1) ? bufB : bufA; bf16_t* oth = (L & 1) ? bufA : bufB;
        const unsigned char* wl = ws + WS_W + (size_t)L * W_LAYER;
        hipLaunchKernelGGL(cvt_bf16_kernel, dim3(1024), dim3(256), 0, stream, p + (size_t)L * MTOK * 256, PB, (size_t)(MTOK * 256 / 8));
        { epi::EpiInProj e; memset(&e, 0, sizeof e); e.Z = Z; e.ssq = ssqA; e.tab16 = tab16; e.tabI = tabI;
          hipLaunchKernelGGL(gemm_kernel<epi::EpiInProj>, dim3(256), dim3(512), GLDS, stream, mkg((const bf16_t*)cur, (const bf16_t*)(wl + W_IN), MTOK, NPAD, DM), e); }
        MixArgs ma; memset(&ma, 0, sizeof ma); ma.Z = Z; ma.Y = oth; ma.mu = mu + L * 1664; ma.w0 = w0 + L * 384; ma.w_up = w_up + (size_t)L * 64 * 384; ma.a0 = a0 + L * 384; ma.a_up = a_up + (size_t)L * 64 * 384;
        ma.k_k = k_k + L * 384; ma.k_a = k_a + L * 384; ma.r_k = r_k + L * 384; ma.ln_g = ln_g + L * 384; ma.ln_b = ln_b + L * 384;
        hipLaunchKernelGGL(rwkv_seq_kernel, dim3(96), dim3(256), 0, stream, ma);
        hipLaunchKernelGGL(dsa_simple_kernel, dim3(MTOK / 4), dim3(256), 0, stream, ma);
        hipLaunchKernelGGL(dil_simple_kernel, dim3(MTOK / 2), dim3(256), 0, stream, ma);
        { epi::EpiOutProj e; memset(&e, 0, sizeof e); e.xin = (L == 0) ? x : out; e.xout = out; e.xb = cur; e.ssq_out = ssqB;
          hipLaunchKernelGGL(gemm_kernel<epi::EpiOutProj>, dim3(256), dim3(512), GLDS, stream, mkg((const bf16_t*)oth, (const bf16_t*)(wl + W_OUT), MTOK, DM, DM), e); }
        { epi::EpiF32 e; memset(&e, 0, sizeof e); e.C = PP;
          hipLaunchKernelGGL(gemm_kernel<epi::EpiF32>, dim3(256), dim3(512), GLDS, stream, mkg((const bf16_t*)PB, (const bf16_t*)(wl + W_PROJ), MTOK, DM, 256), e); }
        { epi::EpiGate e; memset(&e, 0, sizeof e); e.xio = out; e.pp = PP; e.xb = oth; e.ssq_in = ssqB; e.ssq_out = ssqA;
          hipLaunchKernelGGL(gemm_kernel<epi::EpiGate>, dim3(256), dim3(512), GLDS, stream, mkg((const bf16_t*)cur, (const bf16_t*)(wl + W_GATE), MTOK, DM, DM), e); }
    }
    hipLaunchKernelGGL(final_norm_kernel, dim3(2048), dim3(256), 0, stream, out, (const float*)ssqA, fin_g);
}
```

```cpp
#include <hip/hip_runtime.h>
#include <cstdio>
#include <cstdint>
#include <cmath>
#include <cstring>

constexpr int BATCH = 16, SEQ = 2048, DM = 1024, DEPTH = 4, MTOK = BATCH * SEQ;
constexpr int ZP = 4136;
constexpr int NPAD = 4352;
constexpr int ZA_R = 0, ZA_K = 384, ZA_V = 768, ZA_G = 1152, ZA_WD = 1536, ZA_AD = 1600;
constexpr int ZB_Q = 1664, ZB_K = 1920, ZB_V = 1984, ZB_IQ = 2048, ZB_IK = 2304, ZB_IW = 2336, ZB_G = 2344;
constexpr int ZC_Q = 2600, ZC_K = 2984, ZC_V = 3368, ZC_G = 3752;
constexpr float LOG2E = 1.4426950408889634f;
constexpr float QSCALE = 0.125f * LOG2E;
constexpr float IQSCALE = 0.17677669529663687f;
constexpr float IWSCALE = 0.35355339059327373f;
constexpr float NORM_EPS = 1e-6f, GN_EPS = 64e-5f;
constexpr float DECAY_SCALE = 0.6065306597126334f;

typedef unsigned short bf16_t;
typedef short bf16x8 __attribute__((ext_vector_type(8)));
typedef float f32x4 __attribute__((ext_vector_type(4)));
typedef float f32x16 __attribute__((ext_vector_type(16)));
typedef unsigned u32x4 __attribute__((ext_vector_type(4)));
typedef unsigned u32x2 __attribute__((ext_vector_type(2)));

__device__ __forceinline__ unsigned f2bf(float f) { unsigned u = __builtin_bit_cast(unsigned, f); return (u + 0x7fffu + ((u >> 16) & 1u)) >> 16; }
__device__ __forceinline__ unsigned pk2(float lo, float hi) { return f2bf(lo) | (f2bf(hi) << 16); }
__device__ __forceinline__ float bf2f(unsigned short b) { return __builtin_bit_cast(float, (unsigned)b << 16); }
__device__ __forceinline__ float bflo(unsigned w) { return __builtin_bit_cast(float, w << 16); }
__device__ __forceinline__ float bfhi(unsigned w) { return __builtin_bit_cast(float, w & 0xffff0000u); }
__device__ __forceinline__ float sigmoidf_(float x) { return 1.0f / (1.0f + __expf(-x)); }
__device__ __forceinline__ int opaque_tid() { int t = threadIdx.x; asm volatile("" : "+v"(t)); return t; }
__device__ __forceinline__ float wave_sum(float v) {
#pragma unroll
    for (int o = 1; o < 64; o <<= 1) v += __shfl_xor(v, o);
    return v;
}
__device__ __forceinline__ float wave_max(float v) {
#pragma unroll
    for (int o = 1; o < 64; o <<= 1) v = fmaxf(v, __shfl_xor(v, o));
    return v;
}

constexpr size_t MiB = 1u << 20;
constexpr size_t WS_CTL = 0;
constexpr size_t WS_TAB16 = 1 * MiB;
constexpr size_t WS_TABI = WS_TAB16 + 128 * 1024;
constexpr size_t WS_SSQA = WS_TABI + 64 * 1024;
constexpr size_t WS_SSQB = WS_SSQA + 2 * MiB;
constexpr size_t WS_W = 6 * MiB;
constexpr size_t W_LAYER = 14 * MiB, W_IN = 0, W_OUT = 8912896, W_GATE = W_OUT + 2 * MiB, W_PROJ = W_GATE + 2 * MiB;
constexpr size_t WS_BUFA = 62 * MiB;
constexpr size_t WS_BUFB = 126 * MiB;
constexpr size_t WS_PB = 190 * MiB;
constexpr size_t WS_Z = 206 * MiB;
constexpr size_t WS_Z_END = WS_Z + (size_t)MTOK * ZP * 2;
constexpr size_t WS_MISC = 465 * MiB;
constexpr size_t WS_END = 512 * MiB;
static_assert(W_PROJ + 1024 * 256 * 2 <= W_LAYER && WS_W + 4 * W_LAYER <= WS_BUFA && WS_Z_END <= WS_MISC, "ws map");
namespace pg8 {
#define PG8_LAS __attribute__((address_space(3)))
typedef unsigned short bf16_t;
typedef short bf16x8 __attribute__((ext_vector_type(8)));
typedef float f32x4 __attribute__((ext_vector_type(4)));
typedef unsigned u32x4 __attribute__((ext_vector_type(4)));
constexpr int BM = 256, BK = 64, HALF = 128, HTB = HALF * BK * 2  , STAGE_BYTES = 8 * HTB, NXCD = 8, WGM = 8;

__host__ __device__ __forceinline__ int lds_byte(int r, int c) { const int st = (r >> 4) * 2 + (c >> 5), rr = r & 15, cc = c & 31, ob = rr * 64 + cc * 2; return st * 1024 + (ob ^ (((ob >> 9) & 1) << 5)); }
__host__ __device__ __forceinline__ void stage_rc(int b, int& R, int& C) { const int st = b / 1024, sb = b % 1024, swz = sb ^ (((sb >> 9) & 1) << 5); R = (st >> 1) * 16 + swz / 64; C = (st & 1) * 32 + (swz % 64) / 2; }
__host__ __device__ __forceinline__ int perm32(int rho) { const int n = rho >> 4, i = rho & 15; return 8 * (i >> 2) + 4 * n + (i & 3); }

struct Unit { int pm, pn; };
struct Gemm { const bf16_t* A; const bf16_t* Bt; int M, N, K; };

struct StaticOrder {
    int nM, nN, nwg, G, c;
    __host__ __device__ void init(int M, int N, int G_, int c_) { nM = M / BM; nN = N / BM; nwg = nM * nN; G = G_; c = c_; }
    __host__ __device__ bool next(int i, Unit& u) const {
        const long L = (long)i * G + c; if (L >= nwg) return false;
        int wgid = (int)L; { const int q = nwg / NXCD, r = nwg % NXCD, xcd = wgid % NXCD, off = wgid / NXCD; wgid = (xcd < r ? xcd * (q + 1) : r * (q + 1) + (xcd - r) * q) + off; }
        const int nig = WGM * nN, gid = wgid / nig, fm = gid * WGM, gsz = (nM - fm) < WGM ? (nM - fm) : WGM;
        u.pm = fm + ((wgid % nig) % gsz); u.pn = (wgid % nig) / gsz; return true;
    }
    __device__ __forceinline__ void a_ready(const Unit&) const {}
    __device__ __forceinline__ void done(const Unit&) const {}
};

__device__ __forceinline__ unsigned cvt_pk_bf16(float lo, float hi) { unsigned r; asm volatile("v_cvt_pk_bf16_f32 %0, %1, %2" : "=v"(r) : "v"(lo), "v"(hi)); return r; }
template <class Epi, class Sched, bool ALIGN_EPI = false, bool SP2 = false>
__device__ __forceinline__ void gemm_phase(PG8_LAS unsigned char* lds, const Gemm g, const Sched& S, const Epi& E) {
    int tid_ = threadIdx.x; asm volatile("" : "+v"(tid_));
    const int tid = tid_, wid = __builtin_amdgcn_readfirstlane(tid >> 6), lane = tid & 63, wr = wid >> 2, wc = wid & 3, fr = lane & 15, fq = lane >> 4;
    const int K = g.K, nt = K / BK;
    unsigned voffA[2], voffB[2];
#pragma unroll
    for (int i = 0; i < 2; ++i) { int R, C; stage_rc(tid * 16 + i * 8192, R, C); const int Rb = Epi::PERM ? ((R & ~31) + perm32(R & 31)) : R;
        voffA[i] = (unsigned)(R * K + C) * 2u; voffB[i] = (unsigned)(Rb * K + C) * 2u; }
    const size_t kstep = (size_t)(BK * 2);
    const size_t hstep = (size_t)HALF * K * 2;
    const size_t tstep = 2 * hstep;
    const unsigned ldsw = (unsigned)wid * 1024u;
    const int aoff = lds_byte(wr * 64 + fr, fq * 8), boff = lds_byte(wc * 32 + fr, fq * 8);
#define PG8_SA(b, h) (((b) * 2 + (h)) * HTB)
#define PG8_SB(b, h) ((4 + (b) * 2 + (h)) * HTB)
#define PG8_STAGE(bufoff, gbase, voff) do { _Pragma("unroll") for (int _i = 0; _i < 2; ++_i) \
        __builtin_amdgcn_global_load_lds((const unsigned*)((const char*)(gbase) + (voff)[_i]), (PG8_LAS unsigned*)(lds + (bufoff) + ldsw + _i * 8192), 16, 0, 0); } while (0)
#define PG8_LDA(dst, b, h) do { _Pragma("unroll") for (int m = 0; m < 4; ++m) _Pragma("unroll") for (int k = 0; k < 2; ++k) dst[m][k] = *(const PG8_LAS bf16x8*)(lds + PG8_SA(b, h) + aoff + m * 2048 + k * 1024); } while (0)
#define PG8_LDB(dst, b, h) do { _Pragma("unroll") for (int n = 0; n < 2; ++n) _Pragma("unroll") for (int k = 0; k < 2; ++k) dst[n][k] = *(const PG8_LAS bf16x8*)(lds + PG8_SB(b, h) + boff + n * 2048 + k * 1024); } while (0)
#define PG8_MMA(ai, bj, At, Bt) do { __builtin_amdgcn_s_setprio(1); _Pragma("unroll") for (int m = 0; m < 4; ++m) _Pragma("unroll") for (int n = 0; n < 2; ++n) _Pragma("unroll") for (int k = 0; k < 2; ++k) \
        acc[ai][bj][m][n] = __builtin_amdgcn_mfma_f32_16x16x32_bf16(Bt[n][k], At[m][k], acc[ai][bj][m][n], 0, 0, 0); __builtin_amdgcn_s_setprio(0); } while (0)
#define PG8_WAIT_V(n) asm volatile("s_waitcnt vmcnt(" #n ")" ::: "memory")
#define PG8_WAIT_L(n) asm volatile("s_waitcnt lgkmcnt(" #n ")" ::: "memory")
#define PG8_BAR __builtin_amdgcn_s_barrier()
#define PG8_SCHED __builtin_amdgcn_sched_barrier(0)
    Unit cur, nxt; int ui = 0;
    if (!S.next(0, cur)) return;
    f32x4 acc[2][2][4][2];
#pragma unroll
    for (int a = 0; a < 2; ++a)
#pragma unroll
        for (int b = 0; b < 2; ++b)
#pragma unroll
            for (int m = 0; m < 4; ++m)
#pragma unroll
                for (int n = 0; n < 2; ++n) acc[a][b][m][n] = (f32x4){0.f, 0.f, 0.f, 0.f};
    bf16x8 At[4][2], B0[2][2], B1[2][2];
    const char* cA = (const char*)g.A + (size_t)cur.pm * tstep; const char* cB = (const char*)g.Bt + (size_t)cur.pn * tstep;
    S.a_ready(cur);
    if constexpr (SP2) {
        PG8_STAGE(PG8_SB(0, 0), cB, voffB); PG8_STAGE(PG8_SB(0, 1), cB + hstep, voffB); PG8_STAGE(PG8_SA(0, 0), cA, voffA); PG8_STAGE(PG8_SA(0, 1), cA + hstep, voffA);
        if (wr == 1) PG8_BAR;
        PG8_WAIT_V(2); PG8_BAR;
        PG8_STAGE(PG8_SB(1, 0), cB + kstep, voffB); PG8_STAGE(PG8_SA(1, 0), cA + kstep, voffA); PG8_STAGE(PG8_SB(1, 1), cB + hstep + kstep, voffB);
        PG8_WAIT_V(6); PG8_BAR;
    } else {
        PG8_STAGE(PG8_SB(0, 0), cB, voffB); PG8_STAGE(PG8_SA(0, 0), cA, voffA); PG8_STAGE(PG8_SB(0, 1), cB + hstep, voffB); PG8_STAGE(PG8_SA(0, 1), cA + hstep, voffA);
        if (wr == 1) PG8_BAR;
        PG8_WAIT_V(4); PG8_BAR;
        PG8_STAGE(PG8_SB(1, 0), cB + kstep, voffB); PG8_STAGE(PG8_SA(1, 0), cA + kstep, voffA); PG8_STAGE(PG8_SB(1, 1), cB + hstep + kstep, voffB);
        PG8_WAIT_V(6); PG8_BAR;
    }
    for (;;) {
        const bool has_next = S.next(ui + 1, nxt);
        const char* nA = has_next ? (const char*)g.A + (size_t)nxt.pm * tstep : cA; const char* nB = has_next ? (const char*)g.Bt + (size_t)nxt.pn * tstep : cB;
        for (int t = 0; t < nt; t += 2) {
            const bool last = (t == nt - 2);
            const char* a1 = cA + (size_t)(t + 1) * kstep;
            const char* a2 = last ? nA : cA + (size_t)(t + 2) * kstep; const char* b2 = last ? nB : cB + (size_t)(t + 2) * kstep;
            const char* a3 = a2 + kstep; const char* b3 = b2 + kstep;
            if (last && has_next) S.a_ready(nxt);
            if constexpr (SP2) {
            PG8_LDB(B0, 0, 0); PG8_LDB(B1, 0, 1); PG8_SCHED; PG8_LDA(At, 0, 0); PG8_STAGE(PG8_SA(1, 1), a1 + hstep, voffA);
            PG8_WAIT_V(8); PG8_WAIT_L(0); PG8_BAR; PG8_MMA(0, 0, At, B0); PG8_MMA(0, 1, At, B1); PG8_BAR; PG8_SCHED;
            PG8_LDA(At, 0, 1); PG8_STAGE(PG8_SB(0, 0), b2, voffB); PG8_STAGE(PG8_SB(0, 1), b2 + hstep, voffB); PG8_STAGE(PG8_SA(0, 0), a2, voffA);
            PG8_WAIT_V(8); PG8_WAIT_L(0); PG8_BAR; PG8_MMA(1, 0, At, B0); PG8_MMA(1, 1, At, B1); PG8_BAR; PG8_SCHED;
            PG8_LDB(B0, 1, 0); PG8_LDB(B1, 1, 1); PG8_SCHED; PG8_LDA(At, 1, 0); PG8_STAGE(PG8_SA(0, 1), a2 + hstep, voffA);
            PG8_WAIT_V(8); PG8_WAIT_L(0); PG8_BAR; PG8_MMA(0, 0, At, B0); PG8_MMA(0, 1, At, B1); PG8_BAR; PG8_SCHED;
            PG8_LDA(At, 1, 1); PG8_STAGE(PG8_SB(1, 0), b3, voffB); PG8_STAGE(PG8_SB(1, 1), b3 + hstep, voffB); PG8_STAGE(PG8_SA(1, 0), a3, voffA);
            PG8_WAIT_V(8); PG8_WAIT_L(0); PG8_BAR; PG8_MMA(1, 0, At, B0); PG8_MMA(1, 1, At, B1); PG8_BAR; PG8_SCHED;
            } else {
            PG8_LDB(B0, 0, 0); PG8_SCHED; PG8_LDA(At, 0, 0); PG8_STAGE(PG8_SA(1, 1), a1 + hstep, voffA);
            PG8_WAIT_L(8); PG8_BAR; PG8_WAIT_L(0); PG8_MMA(0, 0, At, B0); PG8_BAR; PG8_SCHED;
            PG8_LDB(B1, 0, 1); PG8_STAGE(PG8_SB(0, 0), b2, voffB);
            PG8_BAR; PG8_WAIT_L(0); PG8_MMA(0, 1, At, B1); PG8_BAR;
            PG8_LDA(At, 0, 1); PG8_STAGE(PG8_SA(0, 0), a2, voffA);
            PG8_BAR; PG8_WAIT_L(0); PG8_MMA(1, 0, At, B0); PG8_BAR; PG8_SCHED;
            PG8_STAGE(PG8_SB(0, 1), b2 + hstep, voffB);
            PG8_WAIT_V(6); PG8_BAR; PG8_MMA(1, 1, At, B1); PG8_BAR;
            PG8_LDB(B0, 1, 0); PG8_SCHED; PG8_LDA(At, 1, 0); PG8_STAGE(PG8_SA(0, 1), a2 + hstep, voffA);
            PG8_WAIT_L(8); PG8_BAR; PG8_WAIT_L(0); PG8_MMA(0, 0, At, B0); PG8_BAR; PG8_SCHED;
            PG8_LDB(B1, 1, 1); PG8_STAGE(PG8_SB(1, 0), b3, voffB);
            PG8_BAR; PG8_WAIT_L(0); PG8_MMA(0, 1, At, B1); PG8_BAR;
            PG8_LDA(At, 1, 1); PG8_STAGE(PG8_SA(1, 0), a3, voffA);
            PG8_BAR; PG8_WAIT_L(0); PG8_MMA(1, 0, At, B0); PG8_BAR; PG8_SCHED;
            PG8_STAGE(PG8_SB(1, 1), b3 + hstep, voffB);
            PG8_WAIT_V(6); PG8_BAR; PG8_MMA(1, 1, At, B1); PG8_BAR;
            }
        }
        if constexpr (ALIGN_EPI) { if (wr == 0) PG8_BAR; }
        if constexpr (!Epi::AFTER_DRAIN) { E(acc, cur, wr, wc, fr, fq); S.done(cur); }
        if (!has_next) break;
#pragma unroll
        for (int a = 0; a < 2; ++a)
#pragma unroll
            for (int b = 0; b < 2; ++b)
#pragma unroll
                for (int m = 0; m < 4; ++m)
#pragma unroll
                    for (int n = 0; n < 2; ++n) acc[a][b][m][n] = (f32x4){0.f, 0.f, 0.f, 0.f};
        cur = nxt; cA = nA; cB = nB; ++ui;
        if constexpr (ALIGN_EPI) { if (wr == 1) PG8_BAR; }
    }
    PG8_WAIT_V(0);
    if constexpr (!ALIGN_EPI) { if (wr == 0) PG8_BAR; }
    PG8_BAR;
    if constexpr (Epi::AFTER_DRAIN) { E.fused(acc, cur, wr, wc, fr, fq, lds, wid, lane); S.done(cur); }
#undef PG8_SA
#undef PG8_SB
#undef PG8_STAGE
#undef PG8_LDA
#undef PG8_LDB
#undef PG8_MMA
#undef PG8_WAIT_V
#undef PG8_WAIT_L
#undef PG8_BAR
#undef PG8_SCHED
}
}
#define GAS __attribute__((address_space(1)))
#define LAS __attribute__((address_space(3)))

__device__ __forceinline__ int zcol_src(int n, float& sc) {
    sc = 1.f;
    if (n < ZB_Q) return n;
    if (n < ZB_K) { int o = n - ZB_Q, h = o >> 6, d = o & 63; sc = QSCALE; if (d < 16) d = (d >> 1) + 8 * (d & 1); return ZB_Q + h * 64 + d; }
    if (n < ZB_V) { int d = n - ZB_K; if (d < 16) d = (d >> 1) + 8 * (d & 1); return ZB_K + d; }
    if (n < ZB_IQ) return n;
    if (n < ZB_IK) { int o = n - ZB_IQ, h = o >> 5, d = o & 31; sc = IQSCALE; if (d < 8) d = (d >> 1) + 4 * (d & 1); return ZB_IQ + h * 32 + d; }
    if (n < ZB_IW) { int d = n - ZB_IK; if (d < 8) d = (d >> 1) + 4 * (d & 1); return ZB_IK + d; }
    if (n < ZB_G) { sc = IWSCALE; return n; }
    if (n < ZC_Q) return n;
    if (n < ZC_K) { int o = n - ZC_Q, h = o >> 6, d = o & 63; sc = QSCALE; if (d < 16) d = (d >> 1) + 8 * (d & 1); return ZC_Q + h * 64 + d; }
    if (n < ZC_V) { int o = n - ZC_K, h = o >> 6, d = o & 63; if (d < 16) d = (d >> 1) + 8 * (d & 1); return ZC_K + h * 64 + d; }
    return n;
}

template <bool ZMAP>
__device__ __forceinline__ void transpose_item(const float* __restrict__ W, int K, int NW, bf16_t* WT, const float* __restrict__ kscale, LAS float* scr, int item, int nblk, int lane) {
    const int kb = item / nblk, nb = item % nblk, k0 = 64 * kb, n0 = 32 * nb;
    const int ncol = n0 + (lane & 31);
#pragma unroll 8
    for (int i = 0; i < 32; ++i) { const int kk = 2 * i + (lane >> 5);
        float v = 0.f; if (ncol < NW) { v = W[(size_t)(k0 + kk) * NW + ncol]; if (kscale) v *= kscale[k0 + kk]; }
        scr[kk * 33 + (lane & 31)] = v; }
    asm volatile("s_waitcnt lgkmcnt(0)" ::: "memory");
    const int c = lane & 7;
#pragma unroll
    for (int j = 0; j < 4; ++j) { const int n = (lane >> 3) + 8 * j; int sl = n; float sc = 1.f;
        if (ZMAP) { if (n0 + n < NW) sl = zcol_src(n0 + n, sc) - n0; else { sl = n; sc = 0.f; } }
        const LAS float* s = scr + (8 * c) * 33 + sl;
        u32x4 o; o.x = pk2(s[0 * 33] * sc, s[1 * 33] * sc); o.y = pk2(s[2 * 33] * sc, s[3 * 33] * sc); o.z = pk2(s[4 * 33] * sc, s[5 * 33] * sc); o.w = pk2(s[6 * 33] * sc, s[7 * 33] * sc);
        *(u32x4*)(WT + (size_t)(n0 + n) * K + k0 + 8 * c) = o; }
    asm volatile("s_waitcnt lgkmcnt(0)" ::: "memory");
}

struct PrepArgs { const float* w_in; const float* norm_g; const float* w_out; const float* ple_g; const float* w_gate; const float* w_proj; unsigned char* ws; };

__device__ __forceinline__ void prep_weights(const PrepArgs& a, int gw, int ngw, LAS float* scr, int lane) {
    constexpr int I_IN = 16 * (NPAD / 32), I_SQ = 16 * 32, I_PJ = 4 * 32, I_LAYER = I_IN + 2 * I_SQ + I_PJ;
    for (int it = gw; it < DEPTH * I_LAYER; it += ngw) {
        const int L = it / I_LAYER; int r = it % I_LAYER;
        unsigned char* wl = a.ws + WS_W + (size_t)L * W_LAYER;
        if (r < I_IN) { transpose_item<true>(a.w_in + (size_t)L * DM * ZP, DM, ZP, (bf16_t*)(wl + W_IN), a.norm_g + L * DM, scr, r, NPAD / 32, lane); continue; } r -= I_IN;
        if (r < I_SQ) { transpose_item<false>(a.w_out + (size_t)L * DM * DM, DM, DM, (bf16_t*)(wl + W_OUT), nullptr, scr, r, 32, lane); continue; } r -= I_SQ;
        if (r < I_SQ) { transpose_item<false>(a.w_gate + (size_t)L * DM * DM, DM, DM, (bf16_t*)(wl + W_GATE), a.ple_g + L * DM, scr, r, 32, lane); continue; } r -= I_SQ;
        transpose_item<false>(a.w_proj + (size_t)L * 256 * DM, 256, DM, (bf16_t*)(wl + W_PROJ), nullptr, scr, r, 32, lane);
    }
}

__device__ __forceinline__ void sincos_d(float ang, float& c, float& s) {
    const double a = (double)ang; const double n = rint(a * 0.63661977236758134308);
    double r = fma(-n, 1.57079632679489655800e+00, a); r = fma(-n, 6.12323399573676603587e-17, r);
    const double r2 = r * r;
    double sp = r2 * (1.0 / 6227020800.0) - 1.0 / 39916800.0; sp = sp * r2 + 1.0 / 362880.0; sp = sp * r2 - 1.0 / 5040.0; sp = sp * r2 + 1.0 / 120.0; sp = sp * r2 - 1.0 / 6.0; sp = sp * r2 * r + r;
    double cp = r2 * (1.0 / 479001600.0) - 1.0 / 3628800.0; cp = cp * r2 + 1.0 / 40320.0; cp = cp * r2 - 1.0 / 720.0; cp = cp * r2 + 1.0 / 24.0; cp = cp * r2 - 0.5; cp = cp * r2 + 1.0;
    const int q = ((int)n) & 3;
    const double sv = (q == 0) ? sp : (q == 1) ? cp : (q == 2) ? -sp : -cp;
    const double cv = (q == 0) ? cp : (q == 1) ? -sp : (q == 2) ? -cp : sp;
    c = (float)cv; s = (float)sv;
}
__device__ __forceinline__ void prep_tables(unsigned char* ws, int gtid, int nthreads) {
    const float inv8[8] = {1.0f, 0.1939227432012558f, 0.03760603070259094f, 0.007292664609849453f, 0.0014142135623842478f, 0.00027424818836152554f, 5.318296098266728e-05f, 1.0313386155758053e-05f};
    float* t16 = (float*)(ws + WS_TAB16); float* tI = (float*)(ws + WS_TABI);
    for (int e = gtid; e < SEQ * 8; e += nthreads) { const int pos = e >> 3, i = e & 7;
        float iv = inv8[0];
#pragma unroll
        for (int j = 1; j < 8; ++j) iv = (i == j) ? inv8[j] : iv;
        float c, s; sincos_d((float)pos * iv, c, s); t16[pos * 16 + i] = c; t16[pos * 16 + 8 + i] = s;
        if ((i & 1) == 0) { const int i4 = i >> 1; tI[pos * 8 + i4] = c; tI[pos * 8 + 4 + i4] = s; }
    }
}
__device__ __forceinline__ void x_row_to_bf16(const float* xrow, bf16_t* orow, float* ssq, int lane) {
    const f32x4* xr = (const f32x4*)xrow + lane;
    unsigned long long* o8 = (unsigned long long*)orow + lane;
#pragma unroll
    for (int j = 0; j < 4; ++j) { const f32x4 v = xr[64 * j];
        float s = (v.x * v.x + v.y * v.y) + (v.z * v.z + v.w * v.w);
        o8[64 * j] = (unsigned long long)pk2(v.x, v.y) | ((unsigned long long)pk2(v.z, v.w) << 32);
        s += __shfl_xor(s, 1); s += __shfl_xor(s, 2); s += __shfl_xor(s, 4); s += __shfl_xor(s, 8);
        if ((lane & 15) == 0) ssq[4 * j + (lane >> 4)] = s; }
}
__device__ __forceinline__ float row_rstd(const float* ssq_row) {
    const f32x4 a = *(const f32x4*)ssq_row, b = *(const f32x4*)(ssq_row + 4), c = *(const f32x4*)(ssq_row + 8), d = *(const f32x4*)(ssq_row + 12);
    const float s = ((a.x + a.y) + (a.z + a.w)) + ((b.x + b.y) + (b.z + b.w)) + ((c.x + c.y) + (c.z + c.w)) + ((d.x + d.y) + (d.z + d.w));
    return 1.0f / sqrtf(s * (1.0f / DM) + NORM_EPS);
}
namespace epi {
using pg8::Unit; using pg8::BM; using pg8::HALF;
__device__ __forceinline__ u32x4 pack8(const f32x4& a, const f32x4& b) { u32x4 w; w.x = pg8::cvt_pk_bf16(a[0], a[1]); w.y = pg8::cvt_pk_bf16(a[2], a[3]); w.z = pg8::cvt_pk_bf16(b[0], b[1]); w.w = pg8::cvt_pk_bf16(b[2], b[3]); return w; }
__device__ __forceinline__ int rope_class(int c0, int& fb) {
    fb = 0; int o;
    if (c0 >= ZB_Q && c0 < ZB_V) { o = (c0 - ZB_Q) & 63; if (o < 16) { fb = o >> 1; return 1; } return 0; }
    if (c0 >= ZB_IQ && c0 < ZB_IW) { o = (c0 - ZB_IQ) & 31; return o == 0 ? 2 : 0; }
    if (c0 >= ZC_Q && c0 < ZC_V) { o = (c0 - ZC_Q) & 63; if (o < 16) { fb = o >> 1; return 1; } return 0; }
    return 0;
}
struct EpiInProj {
    static constexpr bool PERM = true, AFTER_DRAIN = false;
    bf16_t* Z; const float* ssq; const float* tab16; const float* tabI;
    __device__ __forceinline__ void operator()(const f32x4 (&acc)[2][2][4][2], const Unit& u, int wr, int wc, int fr, int fq) const {
        const int row0 = u.pm * BM + wr * 64 + fr;
        const int c00 = u.pn * BM + wc * 32 + 8 * fq, c01 = c00 + HALF;
        int fb0, fb1; const int rc0 = rope_class(c00, fb0), rc1 = rope_class(c01, fb1);
#pragma unroll
        for (int ai = 0; ai < 2; ++ai)
#pragma unroll
            for (int m = 0; m < 4; ++m) {
                const int row = row0 + ai * HALF + m * 16;
                const float rs = row_rstd(ssq + (size_t)row * 16);
                const int pos = row & (SEQ - 1);
#pragma unroll
                for (int bj = 0; bj < 2; ++bj) {
                    const int c0 = bj ? c01 : c00, rc = bj ? rc1 : rc0, fb = bj ? fb1 : fb0;
                    if (c0 >= ZP) continue;
                    f32x4 v0 = acc[ai][bj][m][0] * rs, v1 = acc[ai][bj][m][1] * rs;
                    if (rc) {
                        const float* tp = (rc == 1) ? tab16 + pos * 16 + fb : tabI + pos * 8;
                        const f32x4 c = *(const f32x4*)tp, s = *(const f32x4*)(tp + (rc == 1 ? 8 : 4));
                        f32x4 a0, a1;
                        a0[0] = v0[0] * c[0] - v0[1] * s[0]; a0[1] = v0[1] * c[0] + v0[0] * s[0];
                        a0[2] = v0[2] * c[1] - v0[3] * s[1]; a0[3] = v0[3] * c[1] + v0[2] * s[1];
                        a1[0] = v1[0] * c[2] - v1[1] * s[2]; a1[1] = v1[1] * c[2] + v1[0] * s[2];
                        a1[2] = v1[2] * c[3] - v1[3] * s[3]; a1[3] = v1[3] * c[3] + v1[2] * s[3];
                        v0 = a0; v1 = a1;
                    }
                    *(u32x4*)(Z + (size_t)row * ZP + c0) = pack8(v0, v1);
                }
                asm volatile("" ::: "memory");
            }
    }
};
struct EpiOutProj {
    static constexpr bool PERM = true, AFTER_DRAIN = false;
    const float* xin; float* xout; bf16_t* xb; float* ssq_out;
    __device__ __forceinline__ void operator()(const f32x4 (&acc)[2][2][4][2], const Unit& u, int wr, int wc, int fr, int fq) const {
        const int row0 = u.pm * BM + wr * 64 + fr;
#pragma unroll
        for (int ai = 0; ai < 2; ++ai)
#pragma unroll
            for (int m = 0; m < 4; ++m) {
                const int row = row0 + ai * HALF + m * 16; float sq = 0.f;
#pragma unroll
                for (int bj = 0; bj < 2; ++bj) {
                    const size_t off = (size_t)row * DM + u.pn * BM + bj * HALF + wc * 32 + 8 * fq;
                    const f32x4 x0 = *(const f32x4*)(xin + off) + acc[ai][bj][m][0], x1 = *(const f32x4*)(xin + off + 4) + acc[ai][bj][m][1];
                    *(f32x4*)(xout + off) = x0; *(f32x4*)(xout + off + 4) = x1;
                    *(u32x4*)(xb + off) = pack8(x0, x1);
                    sq += ((x0[0] * x0[0] + x0[1] * x0[1]) + (x0[2] * x0[2] + x0[3] * x0[3])) + ((x1[0] * x1[0] + x1[1] * x1[1]) + (x1[2] * x1[2] + x1[3] * x1[3]));
                }
                sq += __shfl_xor(sq, 16); sq += __shfl_xor(sq, 32);
                if (fq == 0) ssq_out[(size_t)row * 16 + u.pn * 4 + wc] = sq;
            }
    }
};
struct EpiGate {
    static constexpr bool PERM = true, AFTER_DRAIN = false;
    float* xio; const float* pp; bf16_t* xb; const float* ssq_in; float* ssq_out;
    __device__ __forceinline__ void operator()(const f32x4 (&acc)[2][2][4][2], const Unit& u, int wr, int wc, int fr, int fq) const {
        const int row0 = u.pm * BM + wr * 64 + fr;
#pragma unroll
        for (int ai = 0; ai < 2; ++ai)
#pragma unroll
            for (int m = 0; m < 4; ++m) {
                const int row = row0 + ai * HALF + m * 16; float sq = 0.f;
                const float rs = row_rstd(ssq_in + (size_t)row * 16);
#pragma unroll
                for (int bj = 0; bj < 2; ++bj) {
                    const size_t off = (size_t)row * DM + u.pn * BM + bj * HALF + wc * 32 + 8 * fq;
                    f32x4 g0 = acc[ai][bj][m][0] * rs, g1 = acc[ai][bj][m][1] * rs;
#pragma unroll
                    for (int i = 0; i < 4; ++i) { g0[i] = 1.0f / (1.0f + __expf(-g0[i])); g1[i] = 1.0f / (1.0f + __expf(-g1[i])); }
                    const f32x4 x0 = *(const f32x4*)(xio + off) + g0 * *(const f32x4*)(pp + off), x1 = *(const f32x4*)(xio + off + 4) + g1 * *(const f32x4*)(pp + off + 4);
                    *(f32x4*)(xio + off) = x0; *(f32x4*)(xio + off + 4) = x1;
                    *(u32x4*)(xb + off) = pack8(x0, x1);
                    sq += ((x0[0] * x0[0] + x0[1] * x0[1]) + (x0[2] * x0[2] + x0[3] * x0[3])) + ((x1[0] * x1[0] + x1[1] * x1[1]) + (x1[2] * x1[2] + x1[3] * x1[3]));
                }
                sq += __shfl_xor(sq, 16); sq += __shfl_xor(sq, 32);
                if (fq == 0) ssq_out[(size_t)row * 16 + u.pn * 4 + wc] = sq;
            }
    }
};
struct EpiF32 {
    static constexpr bool PERM = true, AFTER_DRAIN = false;
    float* C;
    __device__ __forceinline__ void operator()(const f32x4 (&acc)[2][2][4][2], const Unit& u, int wr, int wc, int fr, int fq) const {
        const int row0 = u.pm * BM + wr * 64 + fr;
#pragma unroll
        for (int ai = 0; ai < 2; ++ai)
#pragma unroll
            for (int m = 0; m < 4; ++m)
#pragma unroll
                for (int bj = 0; bj < 2; ++bj) {
                    const size_t off = (size_t)(row0 + ai * HALF + m * 16) * DM + u.pn * BM + bj * HALF + wc * 32 + 8 * fq;
                    *(f32x4*)(C + off) = acc[ai][bj][m][0]; *(f32x4*)(C + off + 4) = acc[ai][bj][m][1];
                }
    }
};
}
typedef GAS unsigned gu32;
#define RLX_AGENT __ATOMIC_RELAXED, __HIP_MEMORY_SCOPE_AGENT
#define XB_TMO      128
#define XB_XCNT(j)  (256  + 64 * (j))
#define XB_XSUB(j)  (1280 + 64 * (j))
#define XB_XGEN(j)  (2304 + 64 * (j))
#define XB_TOP      3328
#define XB_TOPGEN   3392
#define XCD_BAR_WORDS 3456
#define XB_SPIN_CAP (1u << 27)

__device__ __forceinline__ unsigned xb_ld(unsigned* p)              { return __hip_atomic_load(p, __ATOMIC_RELAXED, __HIP_MEMORY_SCOPE_AGENT); }
__device__ __forceinline__ unsigned xb_add(unsigned* p, unsigned v) { return __hip_atomic_fetch_add(p, v, __ATOMIC_RELAXED, __HIP_MEMORY_SCOPE_AGENT); }
__device__ __forceinline__ unsigned xb_xcc_id() { return (unsigned)__builtin_amdgcn_s_getreg((3 << 11) | 20) & 0xFu; }
#define XB_SPIN(cond, bar) do { unsigned _sp = 0; while (cond) { __builtin_amdgcn_s_sleep(1); \
    if ((++_sp & 255u) == 0u) { if (xb_ld(&(bar)[XB_TMO])) break; if (_sp > XB_SPIN_CAP) { atomicAdd(&(bar)[XB_TMO], 1u); break; } } } } while (0)

struct XcdBarrier {
    unsigned* bar; unsigned x;
    volatile LAS unsigned* st;
};

__device__ __forceinline__ XcdBarrier xcd_barrier_post(unsigned* bar, volatile LAS unsigned* st) {
    XcdBarrier b; b.bar = bar; b.x = xb_xcc_id(); b.st = st;
    if (threadIdx.x == 0) (void)xb_add(&bar[XB_XCNT(b.x)], 1u);
    return b;
}
__device__ __forceinline__ void xcd_barrier_complete(unsigned* bar, unsigned x, unsigned& nloc, unsigned& nx) {
    const unsigned G = gridDim.x * gridDim.y * gridDim.z;
    unsigned sum, cnt, mine, sp = 0u;
    for (;;) {
        sum = 0u; cnt = 0u; mine = 0u;
#pragma unroll
        for (unsigned j = 0; j < 16; ++j) { const unsigned c = xb_ld(&bar[XB_XCNT(j)]); sum += c; cnt += (c > 0u) ? 1u : 0u; mine = (j == x) ? c : mine; }
        if (sum == G) break;
        __builtin_amdgcn_s_sleep(1);
        if ((++sp & 255u) == 0u) { if (xb_ld(&bar[XB_TMO])) break; if (sp > XB_SPIN_CAP) { atomicAdd(&bar[XB_TMO], 1u); break; } }
    }
    nloc = mine > 0u ? mine : 1u; nx = cnt > 0u ? cnt : 1u;
}

__device__ __forceinline__ void xcd_barrier(const XcdBarrier& b) {
    asm volatile("s_waitcnt vmcnt(0)" ::: "memory");
    __syncthreads();
    if (threadIdx.x == 0) {
        unsigned* bar = b.bar;
        __builtin_amdgcn_s_waitcnt(0);
        unsigned nloc = b.st[0], nx = b.st[1];
        if (nloc == 0u) { xcd_barrier_complete(bar, b.x, nloc, nx); b.st[0] = nloc; b.st[1] = nx; }
        const unsigned old = xb_add(&bar[XB_XSUB(b.x)], 1u);
        const unsigned gen = old / nloc;
        if (old + 1u == (gen + 1u) * nloc) {
            __builtin_amdgcn_fence(__ATOMIC_RELEASE, "agent");
            asm volatile("s_waitcnt vmcnt(0)" ::: "memory");
            const unsigned og = xb_add(&bar[XB_TOP], 1u);
            const unsigned tg = og / nx;
            if (og + 1u == (tg + 1u) * nx) xb_add(&bar[XB_TOPGEN], 1u);
            else XB_SPIN(xb_ld(&bar[XB_TOPGEN]) == tg, bar);
            __builtin_amdgcn_fence(__ATOMIC_ACQUIRE, "agent");
            xb_add(&bar[XB_XGEN(b.x)], 1u);
            asm volatile("s_waitcnt vmcnt(0)" ::: "memory");
        } else {
            XB_SPIN(xb_ld(&bar[XB_XGEN(b.x)]) == gen, bar);
            __builtin_amdgcn_fence(__ATOMIC_ACQUIRE, "agent");
            asm volatile("s_waitcnt vmcnt(0)" ::: "memory");
        }
    }
    __syncthreads();
}
struct MixArgs { const bf16_t* Z; bf16_t* Y; const float* mu; const float* w0; const float* w_up; const float* a0; const float* a_up; const float* k_k; const float* k_a; const float* r_k; const float* ln_g; const float* ln_b; };

__device__ __forceinline__ void rwkv_seq_phase(const MixArgs& a, unsigned char* ldsb, int chain  ) {
    constexpr int TB = 16;
    typedef float (*arr_t)[64];
    const int tid0 = opaque_tid();
    float* base = (float*)(ldsb + (tid0 >> 8) * 40960);
    arr_t sr = (arr_t)(base), sw = (arr_t)(base + 1024), sk = (arr_t)(base + 2048), sv = (arr_t)(base + 3072), skk = (arr_t)(base + 4096), sb = (arr_t)(base + 5120), sg = (arr_t)(base + 6144), swd = (arr_t)(base + 7168), sad = (arr_t)(base + 8192), sy = (arr_t)(base + 9216);
    const int b = chain / 6, h = chain % 6, tid = tid0 & 255, lane = tid & 63, wv = tid >> 6;
    const int vrow = tid >> 2, kq = tid & 3;
    float st[16];
#pragma unroll
    for (int i = 0; i < 16; ++i) st[i] = 0.f;
    for (int t0 = 0; t0 < SEQ; t0 += TB) {
        for (int idx = tid; idx < TB * 64; idx += 256) {
            const int t = idx >> 6, c = idx & 63, tok = t0 + t;
            const bf16_t* zr = a.Z + (size_t)(b * SEQ + tok) * ZP; const bf16_t* zp = zr - ZP; const bool hp = tok > 0;
            auto mix = [&](int col) { const float cur = bf2f(zr[col]), prv = hp ? bf2f(zp[col]) : 0.f; return cur + (prv - cur) * a.mu[col]; };
            sr[t][c] = mix(ZA_R + h * 64 + c); sk[t][c] = mix(ZA_K + h * 64 + c); sv[t][c] = mix(ZA_V + h * 64 + c); sg[t][c] = mix(ZA_G + h * 64 + c);
            swd[t][c] = tanhf(mix(ZA_WD + c)); sad[t][c] = mix(ZA_AD + c);
        }
        __syncthreads();
        for (int idx = tid; idx < TB * 64; idx += 256) {
            const int t = idx >> 6, c = idx & 63, hc = h * 64 + c;
            float pw = a.w0[hc], pa = a.a0[hc];
            for (int j = 0; j < 64; ++j) { pw += swd[t][j] * a.w_up[j * 384 + hc]; pa += sad[t][j] * a.a_up[j * 384 + hc]; }
            const float w = __expf(-DECAY_SCALE * sigmoidf_(pw)), eta = sigmoidf_(pa);
            const float k = sk[t][c];
            sw[t][c] = w; sb[t][c] = eta; skk[t][c] = k * a.k_k[hc]; sk[t][c] = k * (1.f + (eta - 1.f) * a.k_a[hc]);
        }
        __syncthreads();
        for (int t = wv; t < TB; t += 4) {
            const float kr = skk[t][lane]; const float nrm = sqrtf(wave_sum(kr * kr)); const float kk = kr / fmaxf(nrm, 1e-12f);
            skk[t][lane] = kk; sb[t][lane] = kk * sb[t][lane];
        }
        __syncthreads();
        for (int t = 0; t < TB; ++t) {
            float sa = 0.f;
#pragma unroll
            for (int i = 0; i < 16; ++i) sa -= st[i] * skk[t][kq * 16 + i];
            sa += __shfl_xor(sa, 1); sa += __shfl_xor(sa, 2);
            const float vv = sv[t][vrow]; float yy = 0.f;
#pragma unroll
            for (int i = 0; i < 16; ++i) { const int kc = kq * 16 + i; st[i] = st[i] * sw[t][kc] + sa * sb[t][kc] + vv * sk[t][kc]; yy += st[i] * sr[t][kc]; }
            yy += __shfl_xor(yy, 1); yy += __shfl_xor(yy, 2);
            if (kq == 0) sy[t][vrow] = yy;
        }
        __syncthreads();
        for (int t = wv; t < TB; t += 4) {
            const int hc = h * 64 + lane;
            const float y = sy[t][lane]; const float mean = wave_sum(y) * (1.f / 64.f); const float d = y - mean; const float var = wave_sum(d * d) * (1.f / 64.f);
            const float yn = d * (1.0f / sqrtf(var + GN_EPS)) * a.ln_g[hc] + a.ln_b[hc];
            const float bonus = wave_sum(sr[t][lane] * sk[t][lane] * a.r_k[hc]) * sv[t][lane];
            const float g = sg[t][lane];
            a.Y[(size_t)(b * SEQ + t0 + t) * DM + hc] = (bf16_t)f2bf((yn + bonus) * g * sigmoidf_(g));
        }
        __syncthreads();
    }
}

__device__ __forceinline__ void dsa_simple_unit(const MixArgs& a, unsigned char* ldsb, int row) {
    const int tid0 = opaque_tid(); const int wv = tid0 >> 6, lane = tid0 & 63;
    typedef float (*a256_t)[256]; typedef float (*a8_t)[8]; typedef float (*p_t)[4][256]; typedef unsigned (*key_t)[SEQ]; typedef int (*idx_t)[256];
    a256_t s_iq = (a256_t)(ldsb); a256_t s_q = (a256_t)(ldsb + 8192); a8_t s_iw = (a8_t)(ldsb + 16384); idx_t s_idx = (idx_t)(ldsb + 16384 + 256); p_t s_p = (p_t)(ldsb + 16384 + 256 + 8192); key_t s_key = (key_t)(ldsb + 16384 + 256 + 8192 + 32768);
    const int b = row / SEQ, t = row % SEQ;
    __syncthreads();
    const bf16_t* zr = a.Z + (size_t)row * ZP; const bf16_t* zb = a.Z + (size_t)b * SEQ * ZP;
    for (int i = lane; i < 256; i += 64) { s_iq[wv][i] = bf2f(zr[ZB_IQ + i]); s_q[wv][i] = bf2f(zr[ZB_Q + i]); }
    if (lane < 8) s_iw[wv][lane] = bf2f(zr[ZB_IW + lane]);
    __syncthreads();
    const int nj = (t >> 6) + 1;
    for (int j = 0; j < nj; ++j) {
        const int s = lane + 64 * j; unsigned u = 0u;
        if (s <= t) {
            const u32x4* kp = (const u32x4*)(zb + (size_t)s * ZP + ZB_IK); float ik[32];
#pragma unroll
            for (int q4 = 0; q4 < 4; ++q4) { const u32x4 w = kp[q4];
                ik[q4 * 8 + 0] = bflo(w.x); ik[q4 * 8 + 1] = bfhi(w.x); ik[q4 * 8 + 2] = bflo(w.y); ik[q4 * 8 + 3] = bfhi(w.y); ik[q4 * 8 + 4] = bflo(w.z); ik[q4 * 8 + 5] = bfhi(w.z); ik[q4 * 8 + 6] = bflo(w.w); ik[q4 * 8 + 7] = bfhi(w.w); }
            float sc = 0.f;
#pragma unroll
            for (int hh = 0; hh < 8; ++hh) { float d = 0.f;
#pragma unroll
                for (int dd = 0; dd < 32; ++dd) d += s_iq[wv][hh * 32 + dd] * ik[dd];
                sc += s_iw[wv][hh] * fmaxf(d, 0.f); }
            const unsigned bits = __builtin_bit_cast(unsigned, sc);
            u = (bits & 0x80000000u) ? ~bits : (bits | 0x80000000u);
        }
        s_key[wv][s] = u;
    }
    __syncthreads();
    int nsel;
    if (t < 256) { for (int s = lane; s <= t; s += 64) s_idx[wv][s] = s; nsel = t + 1; }
    else {
        unsigned prefix = 0u;
        for (int bit = 31; bit >= 0; --bit) { const unsigned cand = prefix | (1u << bit); int cnt = 0;
            for (int j = 0; j < nj; ++j) cnt += __popcll(__ballot(s_key[wv][lane + 64 * j] >= cand));
            if (cnt >= 256) prefix = cand; }
        int ngt = 0;
        for (int j = 0; j < nj; ++j) ngt += __popcll(__ballot(s_key[wv][lane + 64 * j] > prefix));
        const int need = 256 - ngt; int nt = 0, ns = 0;
        for (int j = 0; j < nj; ++j) { const unsigned u = s_key[wv][lane + 64 * j];
            const unsigned long long mt = __ballot(u == prefix); const int trank = nt + __popcll(mt & ((1ull << lane) - 1ull));
            const bool sel = (u > prefix) || (u == prefix && trank < need);
            const unsigned long long ms = __ballot(sel); const int slot = ns + __popcll(ms & ((1ull << lane) - 1ull));
            if (sel) s_idx[wv][slot] = lane + 64 * j;
            nt += __popcll(mt); ns += __popcll(ms); }
        nsel = ns;
    }
    __syncthreads();
    float lg[4][4];
#pragma unroll
    for (int i = 0; i < 4; ++i) { const int slot = lane + 64 * i;
#pragma unroll
        for (int hh = 0; hh < 4; ++hh) lg[i][hh] = -INFINITY;
        if (slot < nsel) { const int s = s_idx[wv][slot]; const u32x4* kp = (const u32x4*)(zb + (size_t)s * ZP + ZB_K);
            float acc4[4] = {0.f, 0.f, 0.f, 0.f};
#pragma unroll
            for (int q8 = 0; q8 < 8; ++q8) { const u32x4 w = kp[q8]; float kv[8] = {bflo(w.x), bfhi(w.x), bflo(w.y), bfhi(w.y), bflo(w.z), bfhi(w.z), bflo(w.w), bfhi(w.w)};
#pragma unroll
                for (int hh = 0; hh < 4; ++hh)
#pragma unroll
                    for (int e = 0; e < 8; ++e) acc4[hh] += s_q[wv][hh * 64 + q8 * 8 + e] * kv[e]; }
#pragma unroll
            for (int hh = 0; hh < 4; ++hh) lg[i][hh] = acc4[hh]; } }
#pragma unroll
    for (int hh = 0; hh < 4; ++hh) {
        float m = fmaxf(fmaxf(lg[0][hh], lg[1][hh]), fmaxf(lg[2][hh], lg[3][hh])); m = wave_max(m);
        float p[4], l = 0.f;
#pragma unroll
        for (int i = 0; i < 4; ++i) { p[i] = exp2f(lg[i][hh] - m); l += p[i]; }
        l = wave_sum(l); const float rl = 1.f / l;
#pragma unroll
        for (int i = 0; i < 4; ++i) s_p[wv][hh][lane + 64 * i] = p[i] * rl;
    }
    __syncthreads();
    float o[4] = {0.f, 0.f, 0.f, 0.f};
    for (int slot = 0; slot < nsel; ++slot) { const int s = s_idx[wv][slot]; const float vv = bf2f(zb[(size_t)s * ZP + ZB_V + lane]);
#pragma unroll
        for (int hh = 0; hh < 4; ++hh) o[hh] += s_p[wv][hh][slot] * vv; }
#pragma unroll
    for (int hh = 0; hh < 4; ++hh) { const float g = bf2f(zr[ZB_G + hh * 64 + lane]); a.Y[(size_t)row * DM + 384 + hh * 64 + lane] = (bf16_t)f2bf(o[hh] * g * sigmoidf_(g)); }
}

__device__ __forceinline__ void dil_simple_unit(const MixArgs& a, unsigned char* ldsb, int wid) {
    const int tid0 = opaque_tid(); const int wv = tid0 >> 6, lane = tid0 & 63;
    typedef float (*q_t)[64]; typedef float (*pp_t)[192];
    q_t s_q = (q_t)(ldsb); pp_t s_p = (pp_t)(ldsb + 2048);
    const int row = wid >> 1, hg = wid & 1, b = row / SEQ, t = row % SEQ;
    const bf16_t* zr = a.Z + (size_t)row * ZP; const bf16_t* zb = a.Z + (size_t)b * SEQ * ZP;
    float og[3], lse[3];
#pragma unroll
    for (int gi = 0; gi < 3; ++gi) {
        const int head = gi * 2 + hg, rate = (gi == 0) ? 1 : (gi == 1) ? 4 : 16;
        const int ip = t / rate; const int nkeys = (ip < 128 ? ip : 128) + 1;
        __syncthreads();
        s_q[wv][lane] = bf2f(zr[ZC_Q + head * 64 + lane]);
        __syncthreads();
        float lg[3];
#pragma unroll
        for (int i = 0; i < 3; ++i) { const int j = lane + 64 * i; lg[i] = -INFINITY;
            if (j < nkeys) { const u32x4* kp = (const u32x4*)(zb + (size_t)(t - j * rate) * ZP + ZC_K + head * 64); float d = 0.f;
#pragma unroll
                for (int q8 = 0; q8 < 8; ++q8) { const u32x4 w = kp[q8]; const float kv[8] = {bflo(w.x), bfhi(w.x), bflo(w.y), bfhi(w.y), bflo(w.z), bfhi(w.z), bflo(w.w), bfhi(w.w)};
#pragma unroll
                    for (int e = 0; e < 8; ++e) d += s_q[wv][q8 * 8 + e] * kv[e]; }
                lg[i] = d; } }
        const float m = wave_max(fmaxf(fmaxf(lg[0], lg[1]), lg[2]));
        float p[3], l = 0.f;
#pragma unroll
        for (int i = 0; i < 3; ++i) { p[i] = exp2f(lg[i] - m); l += p[i]; }
        l = wave_sum(l); const float rl = 1.f / l;
#pragma unroll
        for (int i = 0; i < 3; ++i) s_p[wv][lane + 64 * i] = p[i] * rl;
        __syncthreads();
        float o = 0.f;
        for (int j = 0; j < nkeys; ++j) o += s_p[wv][j] * bf2f(zb[(size_t)(t - j * rate) * ZP + ZC_V + head * 64 + lane]);
        og[gi] = o; lse[gi] = m + log2f(l);
    }
    const float mx = fmaxf(fmaxf(lse[0], lse[1]), lse[2]);
    const float e0 = exp2f(lse[0] - mx), e1 = exp2f(lse[1] - mx), e2 = exp2f(lse[2] - mx); const float rs = 1.f / (e0 + e1 + e2);
    const float al[3] = {e0 * rs, e1 * rs, e2 * rs};
#pragma unroll
    for (int gi = 0; gi < 3; ++gi) { const int head = gi * 2 + hg; const float g = bf2f(zr[ZC_G + head * 64 + lane]);
        a.Y[(size_t)row * DM + 640 + head * 64 + lane] = (bf16_t)f2bf(og[gi] * al[gi] * g * sigmoidf_(g)); }
}
constexpr int NWAVES = 8;
constexpr int RING_BYTES = 131072, LDSCTL_OFF = RING_BYTES, LDS_BYTES = 147456;
constexpr int CW_BAR = 4096;
struct Args { const float* in[19]; float* out; unsigned char* ws; };

__global__ void __launch_bounds__(NWAVES * 64, 2) mega_fwd(Args args) {
    extern __shared__ __attribute__((aligned(16))) unsigned char lds[];
    const int tid = threadIdx.x, lane = tid & 63, wave = __builtin_amdgcn_readfirstlane(tid >> 6);
    const int G = gridDim.x, bx = blockIdx.x;
    unsigned char* ws = args.ws;
    volatile LAS unsigned* MISC = (volatile LAS unsigned*)((LAS unsigned char*)lds + LDSCTL_OFF);
    for (int u = tid; u < (LDS_BYTES - LDSCTL_OFF) / 4; u += NWAVES * 64) ((LAS unsigned*)((LAS unsigned char*)lds + LDSCTL_OFF))[u] = 0u;
    __syncthreads();
    (void)xcd_barrier_post((unsigned*)(ws + WS_CTL) + CW_BAR, MISC + 8);
    volatile LAS unsigned long long* PTRS = (volatile LAS unsigned long long*)((LAS unsigned char*)lds + LDSCTL_OFF + 256);
    if (tid < 19) PTRS[tid] = (unsigned long long)(uintptr_t)args.in[tid];
    if (tid == 19) PTRS[19] = (unsigned long long)(uintptr_t)args.out;
    if (tid == 20) PTRS[20] = (unsigned long long)(uintptr_t)args.ws;
    __syncthreads();
#define ARGP(i) ((const float*)(uintptr_t)PTRS[i])
#define OUTP ((float*)(uintptr_t)PTRS[19])
#define WSP ((unsigned char*)(uintptr_t)PTRS[20])
#define GRID_BAR() do { XcdBarrier b_; b_.bar = (unsigned*)(WSP + WS_CTL) + CW_BAR; b_.x = xb_xcc_id(); b_.st = (volatile LAS unsigned*)((LAS unsigned char*)lds + LDSCTL_OFF) + 8; xcd_barrier(b_); } while (0)
    const int gw = bx * NWAVES + wave, ngw = G * NWAVES;
    int K1024 = DM, K256 = 256; asm volatile("" : "+s"(K1024), "+s"(K256));
    {
        const float* x = args.in[0]; bf16_t* bufA = (bf16_t*)(ws + WS_BUFA); float* ssqA = (float*)(ws + WS_SSQA);
        PrepArgs pa; pa.w_in = args.in[3]; pa.norm_g = args.in[2]; pa.w_out = args.in[14]; pa.ple_g = args.in[15]; pa.w_gate = args.in[16]; pa.w_proj = args.in[17]; pa.ws = ws;
        prep_tables(ws, bx * NWAVES * 64 + tid, G * NWAVES * 64);
        prep_weights(pa, gw, ngw, (LAS float*)((LAS unsigned char*)lds + wave * 16384), lane);
        for (int m = gw; m < MTOK; m += ngw) x_row_to_bf16(x + (size_t)m * DM, bufA + (size_t)m * DM, ssqA + (size_t)m * 16, lane);
    }
    GRID_BAR();
    for (int L = 0; L < DEPTH; ++L) {
#define PHASE_PTRS unsigned char* ws = WSP; bf16_t* cur = (bf16_t*)(ws + ((L & 1) ? WS_BUFB : WS_BUFA)); bf16_t* oth = (bf16_t*)(ws + ((L & 1) ? WS_BUFA : WS_BUFB)); const unsigned char* wl = ws + WS_W + (size_t)L * W_LAYER; \
        bf16_t* Z = (bf16_t*)(ws + WS_Z); float* PP = (float*)(ws + WS_Z); bf16_t* PB = (bf16_t*)(ws + WS_PB); float* ssqA = (float*)(ws + WS_SSQA); float* ssqB = (float*)(ws + WS_SSQB); float* out = OUTP; \
        (void)cur; (void)oth; (void)wl; (void)Z; (void)PP; (void)PB; (void)ssqA; (void)ssqB; (void)out;
        {
            PHASE_PTRS
            const float* tab16 = (const float*)(ws + WS_TAB16); const float* tabI = (const float*)(ws + WS_TABI);
            const float* src = ARGP(1) + (size_t)L * MTOK * 256; const int tid = opaque_tid();
            for (size_t i = (size_t)bx * 512 + tid; i < (size_t)MTOK * 256 / 8; i += (size_t)G * 512) {
                const f32x4 a = ((const f32x4*)src)[2 * i], b = ((const f32x4*)src)[2 * i + 1];
                u32x4 w; w.x = pk2(a.x, a.y); w.y = pk2(a.z, a.w); w.z = pk2(b.x, b.y); w.w = pk2(b.z, b.w); ((u32x4*)PB)[i] = w; }
            pg8::Gemm g{cur, (const bf16_t*)(wl + W_IN), MTOK, NPAD, K1024}; pg8::StaticOrder S; S.init(MTOK, NPAD, G, bx);
            epi::EpiInProj e; e.Z = Z; e.ssq = ssqA; e.tab16 = tab16; e.tabI = tabI;
            pg8::gemm_phase<epi::EpiInProj, pg8::StaticOrder, true, true>((PG8_LAS unsigned char*)lds, g, S, e);
        }
        GRID_BAR();
        {
            PHASE_PTRS
            MixArgs ma; ma.Z = Z; ma.Y = oth; ma.mu = ARGP(4) + L * 1664; ma.w0 = ARGP(5) + L * 384; ma.w_up = ARGP(6) + (size_t)L * 64 * 384; ma.a0 = ARGP(7) + L * 384; ma.a_up = ARGP(8) + (size_t)L * 64 * 384;
            ma.k_k = ARGP(9) + L * 384; ma.k_a = ARGP(10) + L * 384; ma.r_k = ARGP(11) + L * 384; ma.ln_g = ARGP(12) + L * 384; ma.ln_b = ARGP(13) + L * 384;
            if (bx < 48) rwkv_seq_phase(ma, lds, bx * 2 + (opaque_tid() >> 8));
            __syncthreads();
            for (int r = gw; r < MTOK; r += ngw) dsa_simple_unit(ma, lds, r);
            __syncthreads();
            for (int r = gw; r < MTOK * 2; r += ngw) dil_simple_unit(ma, lds, r);
        }
        GRID_BAR();
        {
            PHASE_PTRS
            const float* x = ARGP(0);
            pg8::Gemm g{oth, (const bf16_t*)(wl + W_OUT), MTOK, DM, K1024}; pg8::StaticOrder S; S.init(MTOK, DM, G, bx);
            epi::EpiOutProj e; e.xin = (L == 0) ? x : out; e.xout = out; e.xb = cur; e.ssq_out = ssqB;
            pg8::gemm_phase<epi::EpiOutProj, pg8::StaticOrder, true, true>((PG8_LAS unsigned char*)lds, g, S, e);
            pg8::Gemm g2{PB, (const bf16_t*)(wl + W_PROJ), MTOK, DM, K256};
            epi::EpiF32 e2; e2.C = PP;
            pg8::gemm_phase<epi::EpiF32, pg8::StaticOrder, true, true>((PG8_LAS unsigned char*)lds, g2, S, e2);
        }
        GRID_BAR();
        {
            PHASE_PTRS
            pg8::Gemm g{cur, (const bf16_t*)(wl + W_GATE), MTOK, DM, K1024}; pg8::StaticOrder S; S.init(MTOK, DM, G, bx);
            epi::EpiGate e; e.xio = out; e.pp = PP; e.xb = oth; e.ssq_in = ssqB; e.ssq_out = ssqA;
            pg8::gemm_phase<epi::EpiGate, pg8::StaticOrder, true, true>((PG8_LAS unsigned char*)lds, g, S, e);
        }
        GRID_BAR();
    }
    {
        const int L = 0; PHASE_PTRS
        const float* fg = ARGP(18); const int lane = opaque_tid() & 63;
        for (int m = gw; m < MTOK; m += ngw) { const float rs = row_rstd(ssqA + (size_t)m * 16); f32x4* xr = (f32x4*)(out + (size_t)m * DM) + lane;
#pragma unroll
            for (int j = 0; j < 4; ++j) { const f32x4 gv = ((const f32x4*)fg)[64 * j + lane]; xr[64 * j] = xr[64 * j] * rs * gv; } }
    }
}

extern "C" void kernel_launch(void* const* d_in, const int* in_sizes, int n_in, void* d_out, int out_size, void* d_ws, size_t ws_size, hipStream_t stream) {
    static int grid = 0;
    if (grid == 0) {
        if (n_in != 19 || out_size != MTOK * DM || ws_size < WS_END) { fprintf(stderr, "kernel_launch: unexpected shapes n_in %d out %d ws %zu\n", n_in, out_size, ws_size); grid = -1; return; }
        int dev = 0, cus = 0, per_cu = 0;
        if (hipGetDevice(&dev) != hipSuccess || hipDeviceGetAttribute(&cus, hipDeviceAttributeMultiprocessorCount, dev) != hipSuccess) { grid = -1; return; }
        if (hipFuncSetAttribute((const void*)mega_fwd, hipFuncAttributeMaxDynamicSharedMemorySize, LDS_BYTES) != hipSuccess) { fprintf(stderr, "kernel_launch: hipFuncSetAttribute failed\n"); grid = -1; return; }
        if (hipOccupancyMaxActiveBlocksPerMultiprocessor(&per_cu, (const void*)mega_fwd, NWAVES * 64, LDS_BYTES) != hipSuccess || per_cu < 1) { fprintf(stderr, "kernel_launch: occupancy query says %d blocks per CU\n", per_cu); (void)hipGetLastError(); grid = -1; return; }
        grid = cus;
    }
    if (grid < 0) return;
    if (hipMemsetAsync((char*)d_ws + WS_CTL, 0, 1 * MiB, stream) != hipSuccess) return;
    Args a; memset(&a, 0, sizeof a);
    for (int i = 0; i < 19; ++i) a.in[i] = (const float*)d_in[i];
    a.out = (float*)d_out; a.ws = (unsigned char*)d_ws;
    hipLaunchKernelGGL(mega_fwd, dim3(grid), dim3(NWAVES * 64), LDS_BYTES, stream, a);
}
```

```cpp
#include <hip/hip_runtime.h>
#include <cstdio>
#include <cstdint>
#include <cmath>
#include <cstring>

constexpr int BATCH = 16, SEQ = 2048, DM = 1024, DEPTH = 4, MTOK = BATCH * SEQ;
constexpr int ZP = 4136;
constexpr int NPAD = 4352;
constexpr int ZA_R = 0, ZA_K = 384, ZA_V = 768, ZA_G = 1152, ZA_WD = 1536, ZA_AD = 1600;
constexpr int ZB_Q = 1664, ZB_K = 1920, ZB_V = 1984, ZB_IQ = 2048, ZB_IK = 2304, ZB_IW = 2336, ZB_G = 2344;
constexpr int ZC_Q = 2600, ZC_K = 2984, ZC_V = 3368, ZC_G = 3752;
constexpr float LOG2E = 1.4426950408889634f;
constexpr float QSCALE = 0.125f * LOG2E;
constexpr float IQSCALE = 0.17677669529663687f;
constexpr float IWSCALE = 0.35355339059327373f;
constexpr float NORM_EPS = 1e-6f, GN_EPS = 64e-5f;
constexpr float DECAY_SCALE = 0.6065306597126334f;

typedef unsigned short bf16_t;
typedef short bf16x8 __attribute__((ext_vector_type(8)));
typedef float f32x4 __attribute__((ext_vector_type(4)));
typedef float f32x16 __attribute__((ext_vector_type(16)));
typedef unsigned u32x4 __attribute__((ext_vector_type(4)));
typedef unsigned u32x2 __attribute__((ext_vector_type(2)));

__device__ __forceinline__ unsigned f2bf(float f) { unsigned u = __builtin_bit_cast(unsigned, f); return (u + 0x7fffu + ((u >> 16) & 1u)) >> 16; }
__device__ __forceinline__ unsigned pk2(float lo, float hi) { return f2bf(lo) | (f2bf(hi) << 16); }
__device__ __forceinline__ float bf2f(unsigned short b) { return __builtin_bit_cast(float, (unsigned)b << 16); }
__device__ __forceinline__ float bflo(unsigned w) { return __builtin_bit_cast(float, w << 16); }
__device__ __forceinline__ float bfhi(unsigned w) { return __builtin_bit_cast(float, w & 0xffff0000u); }
__device__ __forceinline__ float sigmoidf_(float x) { return 1.0f / (1.0f + __expf(-x)); }
__device__ __forceinline__ int opaque_tid() { int t = threadIdx.x; asm volatile("" : "+v"(t)); return t; }
__device__ __forceinline__ float wave_sum(float v) {
#pragma unroll
    for (int o = 1; o < 64; o <<= 1) v += __shfl_xor(v, o);
    return v;
}
__device__ __forceinline__ float wave_max(float v) {
#pragma unroll
    for (int o = 1; o < 64; o <<= 1) v = fmaxf(v, __shfl_xor(v, o));
    return v;
}

constexpr size_t MiB = 1u << 20;
constexpr size_t WS_CTL = 0;
constexpr size_t WS_TAB16 = 1 * MiB;
constexpr size_t WS_TABI = WS_TAB16 + 128 * 1024;
constexpr size_t WS_SSQA = WS_TABI + 64 * 1024;
constexpr size_t WS_SSQB = WS_SSQA + 2 * MiB;
constexpr size_t WS_W = 6 * MiB;
constexpr size_t W_LAYER = 14 * MiB, W_IN = 0, W_OUT = 8912896, W_GATE = W_OUT + 2 * MiB, W_PROJ = W_GATE + 2 * MiB, W_WUPT = W_PROJ + 512 * 1024, W_AUPT = W_WUPT + 48 * 1024;
constexpr size_t WS_BUFA = 62 * MiB;
constexpr size_t WS_BUFB = 126 * MiB;
constexpr size_t WS_PB = 190 * MiB;
constexpr size_t WS_Z = 206 * MiB;
constexpr size_t WS_Z_END = WS_Z + (size_t)MTOK * ZP * 2;
constexpr size_t WS_MISC = 465 * MiB;
constexpr size_t WS_END = 512 * MiB;
constexpr size_t MISC_LQ = 0, MISC_RG = 1 * MiB, MISC_RN = 2 * MiB, MISC_RB = 26 * MiB;
static_assert(W_AUPT + 48 * 1024 <= W_LAYER && WS_W + 4 * W_LAYER <= WS_BUFA && WS_Z_END <= WS_MISC, "ws map");
namespace pg8 {
#define PG8_LAS __attribute__((address_space(3)))
typedef unsigned short bf16_t;
typedef short bf16x8 __attribute__((ext_vector_type(8)));
typedef float f32x4 __attribute__((ext_vector_type(4)));
typedef unsigned u32x4 __attribute__((ext_vector_type(4)));
constexpr int BM = 256, BK = 64, HALF = 128, HTB = HALF * BK * 2  , STAGE_BYTES = 8 * HTB, NXCD = 8, WGM = 8;

__host__ __device__ __forceinline__ int lds_byte(int r, int c) { const int st = (r >> 4) * 2 + (c >> 5), rr = r & 15, cc = c & 31, ob = rr * 64 + cc * 2; return st * 1024 + (ob ^ (((ob >> 9) & 1) << 5)); }
__host__ __device__ __forceinline__ void stage_rc(int b, int& R, int& C) { const int st = b / 1024, sb = b % 1024, swz = sb ^ (((sb >> 9) & 1) << 5); R = (st >> 1) * 16 + swz / 64; C = (st & 1) * 32 + (swz % 64) / 2; }
__host__ __device__ __forceinline__ int perm32(int rho) { const int n = rho >> 4, i = rho & 15; return 8 * (i >> 2) + 4 * n + (i & 3); }

struct Unit { int pm, pn; };
struct Gemm { const bf16_t* A; const bf16_t* Bt; int M, N, K; };

struct StaticOrder {
    int nM, nN, nwg, G, c;
    __host__ __device__ void init(int M, int N, int G_, int c_) { nM = M / BM; nN = N / BM; nwg = nM * nN; G = G_; c = c_; }
    __host__ __device__ bool next(int i, Unit& u) const {
        const long L = (long)i * G + c; if (L >= nwg) return false;
        int wgid = (int)L; { const int q = nwg / NXCD, r = nwg % NXCD, xcd = wgid % NXCD, off = wgid / NXCD; wgid = (xcd < r ? xcd * (q + 1) : r * (q + 1) + (xcd - r) * q) + off; }
        const int nig = WGM * nN, gid = wgid / nig, fm = gid * WGM, gsz = (nM - fm) < WGM ? (nM - fm) : WGM;
        u.pm = fm + ((wgid % nig) % gsz); u.pn = (wgid % nig) / gsz; return true;
    }
    __device__ __forceinline__ void a_ready(const Unit&) const {}
    __device__ __forceinline__ void done(const Unit&) const {}
};

__device__ __forceinline__ unsigned cvt_pk_bf16(float lo, float hi) { unsigned r; asm volatile("v_cvt_pk_bf16_f32 %0, %1, %2" : "=v"(r) : "v"(lo), "v"(hi)); return r; }
template <class Epi, class Sched, bool ALIGN_EPI = false, bool SP2 = false>
__device__ __forceinline__ void gemm_phase(PG8_LAS unsigned char* lds, const Gemm g, const Sched& S, const Epi& E) {
    int tid_ = threadIdx.x; asm volatile("" : "+v"(tid_));
    const int tid = tid_, wid = __builtin_amdgcn_readfirstlane(tid >> 6), lane = tid & 63, wr = wid >> 2, wc = wid & 3, fr = lane & 15, fq = lane >> 4;
    const int K = g.K, nt = K / BK;
    unsigned voffA[2], voffB[2];
#pragma unroll
    for (int i = 0; i < 2; ++i) { int R, C; stage_rc(tid * 16 + i * 8192, R, C); const int Rb = Epi::PERM ? ((R & ~31) + perm32(R & 31)) : R;
        voffA[i] = (unsigned)(R * K + C) * 2u; voffB[i] = (unsigned)(Rb * K + C) * 2u; }
    const size_t kstep = (size_t)(BK * 2);
    const size_t hstep = (size_t)HALF * K * 2;
    const size_t tstep = 2 * hstep;
    const unsigned ldsw = (unsigned)wid * 1024u;
    const int aoff = lds_byte(wr * 64 + fr, fq * 8), boff = lds_byte(wc * 32 + fr, fq * 8);
#define PG8_SA(b, h) (((b) * 2 + (h)) * HTB)
#define PG8_SB(b, h) ((4 + (b) * 2 + (h)) * HTB)
#define PG8_STAGE(bufoff, gbase, voff) do { _Pragma("unroll") for (int _i = 0; _i < 2; ++_i) \
        __builtin_amdgcn_global_load_lds((const unsigned*)((const char*)(gbase) + (voff)[_i]), (PG8_LAS unsigned*)(lds + (bufoff) + ldsw + _i * 8192), 16, 0, 0); } while (0)
#define PG8_LDA(dst, b, h) do { _Pragma("unroll") for (int m = 0; m < 4; ++m) _Pragma("unroll") for (int k = 0; k < 2; ++k) dst[m][k] = *(const PG8_LAS bf16x8*)(lds + PG8_SA(b, h) + aoff + m * 2048 + k * 1024); } while (0)
#define PG8_LDB(dst, b, h) do { _Pragma("unroll") for (int n = 0; n < 2; ++n) _Pragma("unroll") for (int k = 0; k < 2; ++k) dst[n][k] = *(const PG8_LAS bf16x8*)(lds + PG8_SB(b, h) + boff + n * 2048 + k * 1024); } while (0)
#define PG8_MMA(ai, bj, At, Bt) do { __builtin_amdgcn_s_setprio(1); _Pragma("unroll") for (int m = 0; m < 4; ++m) _Pragma("unroll") for (int n = 0; n < 2; ++n) _Pragma("unroll") for (int k = 0; k < 2; ++k) \
        acc[ai][bj][m][n] = __builtin_amdgcn_mfma_f32_16x16x32_bf16(Bt[n][k], At[m][k], acc[ai][bj][m][n], 0, 0, 0); __builtin_amdgcn_s_setprio(0); } while (0)
#define PG8_WAIT_V(n) asm volatile("s_waitcnt vmcnt(" #n ")" ::: "memory")
#define PG8_WAIT_L(n) asm volatile("s_waitcnt lgkmcnt(" #n ")" ::: "memory")
#define PG8_BAR __builtin_amdgcn_s_barrier()
#define PG8_SCHED __builtin_amdgcn_sched_barrier(0)
    Unit cur, nxt; int ui = 0;
    if (!S.next(0, cur)) return;
    f32x4 acc[2][2][4][2];
#pragma unroll
    for (int a = 0; a < 2; ++a)
#pragma unroll
        for (int b = 0; b < 2; ++b)
#pragma unroll
            for (int m = 0; m < 4; ++m)
#pragma unroll
                for (int n = 0; n < 2; ++n) acc[a][b][m][n] = (f32x4){0.f, 0.f, 0.f, 0.f};
    bf16x8 At[4][2], B0[2][2], B1[2][2];
    const char* cA = (const char*)g.A + (size_t)cur.pm * tstep; const char* cB = (const char*)g.Bt + (size_t)cur.pn * tstep;
    S.a_ready(cur);
    if constexpr (SP2) {
        PG8_STAGE(PG8_SB(0, 0), cB, voffB); PG8_STAGE(PG8_SB(0, 1), cB + hstep, voffB); PG8_STAGE(PG8_SA(0, 0), cA, voffA); PG8_STAGE(PG8_SA(0, 1), cA + hstep, voffA);
        if (wr == 1) PG8_BAR;
        PG8_WAIT_V(2); PG8_BAR;
        PG8_STAGE(PG8_SB(1, 0), cB + kstep, voffB); PG8_STAGE(PG8_SA(1, 0), cA + kstep, voffA); PG8_STAGE(PG8_SB(1, 1), cB + hstep + kstep, voffB);
        PG8_WAIT_V(6); PG8_BAR;
    } else {
        PG8_STAGE(PG8_SB(0, 0), cB, voffB); PG8_STAGE(PG8_SA(0, 0), cA, voffA); PG8_STAGE(PG8_SB(0, 1), cB + hstep, voffB); PG8_STAGE(PG8_SA(0, 1), cA + hstep, voffA);
        if (wr == 1) PG8_BAR;
        PG8_WAIT_V(4); PG8_BAR;
        PG8_STAGE(PG8_SB(1, 0), cB + kstep, voffB); PG8_STAGE(PG8_SA(1, 0), cA + kstep, voffA); PG8_STAGE(PG8_SB(1, 1), cB + hstep + kstep, voffB);
        PG8_WAIT_V(6); PG8_BAR;
    }
    for (;;) {
        const bool has_next = S.next(ui + 1, nxt);
        const char* nA = has_next ? (const char*)g.A + (size_t)nxt.pm * tstep : cA; const char* nB = has_next ? (const char*)g.Bt + (size_t)nxt.pn * tstep : cB;
        for (int t = 0; t < nt; t += 2) {
            const bool last = (t == nt - 2);
            const char* a1 = cA + (size_t)(t + 1) * kstep;
            const char* a2 = last ? nA : cA + (size_t)(t + 2) * kstep; const char* b2 = last ? nB : cB + (size_t)(t + 2) * kstep;
            const char* a3 = a2 + kstep; const char* b3 = b2 + kstep;
            if (last && has_next) S.a_ready(nxt);
            if constexpr (SP2) {
            PG8_LDB(B0, 0, 0); PG8_LDB(B1, 0, 1); PG8_SCHED; PG8_LDA(At, 0, 0); PG8_STAGE(PG8_SA(1, 1), a1 + hstep, voffA);
            PG8_WAIT_V(8); PG8_WAIT_L(0); PG8_BAR; PG8_MMA(0, 0, At, B0); PG8_MMA(0, 1, At, B1); PG8_BAR; PG8_SCHED;
            PG8_LDA(At, 0, 1); PG8_STAGE(PG8_SB(0, 0), b2, voffB); PG8_STAGE(PG8_SB(0, 1), b2 + hstep, voffB); PG8_STAGE(PG8_SA(0, 0), a2, voffA);
            PG8_WAIT_V(8); PG8_WAIT_L(0); PG8_BAR; PG8_MMA(1, 0, At, B0); PG8_MMA(1, 1, At, B1); PG8_BAR; PG8_SCHED;
            PG8_LDB(B0, 1, 0); PG8_LDB(B1, 1, 1); PG8_SCHED; PG8_LDA(At, 1, 0); PG8_STAGE(PG8_SA(0, 1), a2 + hstep, voffA);
            PG8_WAIT_V(8); PG8_WAIT_L(0); PG8_BAR; PG8_MMA(0, 0, At, B0); PG8_MMA(0, 1, At, B1); PG8_BAR; PG8_SCHED;
            PG8_LDA(At, 1, 1); PG8_STAGE(PG8_SB(1, 0), b3, voffB); PG8_STAGE(PG8_SB(1, 1), b3 + hstep, voffB); PG8_STAGE(PG8_SA(1, 0), a3, voffA);
            PG8_WAIT_V(8); PG8_WAIT_L(0); PG8_BAR; PG8_MMA(1, 0, At, B0); PG8_MMA(1, 1, At, B1); PG8_BAR; PG8_SCHED;
            } else {
            PG8_LDB(B0, 0, 0); PG8_SCHED; PG8_LDA(At, 0, 0); PG8_STAGE(PG8_SA(1, 1), a1 + hstep, voffA);
            PG8_WAIT_L(8); PG8_BAR; PG8_WAIT_L(0); PG8_MMA(0, 0, At, B0); PG8_BAR; PG8_SCHED;
            PG8_LDB(B1, 0, 1); PG8_STAGE(PG8_SB(0, 0), b2, voffB);
            PG8_BAR; PG8_WAIT_L(0); PG8_MMA(0, 1, At, B1); PG8_BAR;
            PG8_LDA(At, 0, 1); PG8_STAGE(PG8_SA(0, 0), a2, voffA);
            PG8_BAR; PG8_WAIT_L(0); PG8_MMA(1, 0, At, B0); PG8_BAR; PG8_SCHED;
            PG8_STAGE(PG8_SB(0, 1), b2 + hstep, voffB);
            PG8_WAIT_V(6); PG8_BAR; PG8_MMA(1, 1, At, B1); PG8_BAR;
            PG8_LDB(B0, 1, 0); PG8_SCHED; PG8_LDA(At, 1, 0); PG8_STAGE(PG8_SA(0, 1), a2 + hstep, voffA);
            PG8_WAIT_L(8); PG8_BAR; PG8_WAIT_L(0); PG8_MMA(0, 0, At, B0); PG8_BAR; PG8_SCHED;
            PG8_LDB(B1, 1, 1); PG8_STAGE(PG8_SB(1, 0), b3, voffB);
            PG8_BAR; PG8_WAIT_L(0); PG8_MMA(0, 1, At, B1); PG8_BAR;
            PG8_LDA(At, 1, 1); PG8_STAGE(PG8_SA(1, 0), a3, voffA);
            PG8_BAR; PG8_WAIT_L(0); PG8_MMA(1, 0, At, B0); PG8_BAR; PG8_SCHED;
            PG8_STAGE(PG8_SB(1, 1), b3 + hstep, voffB);
            PG8_WAIT_V(6); PG8_BAR; PG8_MMA(1, 1, At, B1); PG8_BAR;
            }
        }
        if constexpr (ALIGN_EPI) { if (wr == 0) PG8_BAR; }
        if constexpr (!Epi::AFTER_DRAIN) { E(acc, cur, wr, wc, fr, fq); S.done(cur); }
        if (!has_next) break;
#pragma unroll
        for (int a = 0; a < 2; ++a)
#pragma unroll
            for (int b = 0; b < 2; ++b)
#pragma unroll
                for (int m = 0; m < 4; ++m)
#pragma unroll
                    for (int n = 0; n < 2; ++n) acc[a][b][m][n] = (f32x4){0.f, 0.f, 0.f, 0.f};
        cur = nxt; cA = nA; cB = nB; ++ui;
        if constexpr (ALIGN_EPI) { if (wr == 1) PG8_BAR; }
    }
    PG8_WAIT_V(0);
    if constexpr (!ALIGN_EPI) { if (wr == 0) PG8_BAR; }
    PG8_BAR;
    if constexpr (Epi::AFTER_DRAIN) { E.fused(acc, cur, wr, wc, fr, fq, lds, wid, lane); S.done(cur); }
#undef PG8_SA
#undef PG8_SB
#undef PG8_STAGE
#undef PG8_LDA
#undef PG8_LDB
#undef PG8_MMA
#undef PG8_WAIT_V
#undef PG8_WAIT_L
#undef PG8_BAR
#undef PG8_SCHED
}
}
#define GAS __attribute__((address_space(1)))
#define LAS __attribute__((address_space(3)))

__device__ __forceinline__ int zcol_src(int n, float& sc) {
    sc = 1.f;
    if (n < ZB_Q) return n;
    if (n < ZB_K) { int o = n - ZB_Q, h = o >> 6, d = o & 63; sc = QSCALE; if (d < 16) d = (d >> 1) + 8 * (d & 1); return ZB_Q + h * 64 + d; }
    if (n < ZB_V) { int d = n - ZB_K; if (d < 16) d = (d >> 1) + 8 * (d & 1); return ZB_K + d; }
    if (n < ZB_IQ) return n;
    if (n < ZB_IK) { int o = n - ZB_IQ, h = o >> 5, d = o & 31; sc = IQSCALE; if (d < 8) d = (d >> 1) + 4 * (d & 1); return ZB_IQ + h * 32 + d; }
    if (n < ZB_IW) { int d = n - ZB_IK; if (d < 8) d = (d >> 1) + 4 * (d & 1); return ZB_IK + d; }
    if (n < ZB_G) { sc = IWSCALE; return n; }
    if (n < ZC_Q) return n;
    if (n < ZC_K) { int o = n - ZC_Q, h = o >> 6, d = o & 63; sc = QSCALE; if (d < 16) d = (d >> 1) + 8 * (d & 1); return ZC_Q + h * 64 + d; }
    if (n < ZC_V) { int o = n - ZC_K, h = o >> 6, d = o & 63; if (d < 16) d = (d >> 1) + 8 * (d & 1); return ZC_K + h * 64 + d; }
    return n;
}

template <bool ZMAP>
__device__ __forceinline__ void transpose_item(const float* __restrict__ W, int K, int NW, bf16_t* WT, const float* __restrict__ kscale, LAS float* scr, int item, int nblk, int lane) {
    const int kb = item / nblk, nb = item % nblk, k0 = 64 * kb, n0 = 32 * nb;
    const int ncol = n0 + (lane & 31);
#pragma unroll 8
    for (int i = 0; i < 32; ++i) { const int kk = 2 * i + (lane >> 5);
        float v = 0.f; if (ncol < NW) { v = W[(size_t)(k0 + kk) * NW + ncol]; if (kscale) v *= kscale[k0 + kk]; }
        scr[kk * 33 + (lane & 31)] = v; }
    asm volatile("s_waitcnt lgkmcnt(0)" ::: "memory");
    const int c = lane & 7;
#pragma unroll
    for (int j = 0; j < 4; ++j) { const int n = (lane >> 3) + 8 * j; int sl = n; float sc = 1.f;
        if (ZMAP) { if (n0 + n < NW) sl = zcol_src(n0 + n, sc) - n0; else { sl = n; sc = 0.f; } }
        const LAS float* s = scr + (8 * c) * 33 + sl;
        u32x4 o; o.x = pk2(s[0 * 33] * sc, s[1 * 33] * sc); o.y = pk2(s[2 * 33] * sc, s[3 * 33] * sc); o.z = pk2(s[4 * 33] * sc, s[5 * 33] * sc); o.w = pk2(s[6 * 33] * sc, s[7 * 33] * sc);
        *(u32x4*)(WT + (size_t)(n0 + n) * K + k0 + 8 * c) = o; }
    asm volatile("s_waitcnt lgkmcnt(0)" ::: "memory");
}

struct PrepArgs { const float* w_in; const float* norm_g; const float* w_out; const float* ple_g; const float* w_gate; const float* w_proj; const float* w_up; const float* a_up; unsigned char* ws; };

__device__ __forceinline__ void prep_weights(const PrepArgs& a, int gw, int ngw, LAS float* scr, int lane) {
    constexpr int I_IN = 16 * (NPAD / 32), I_SQ = 16 * 32, I_PJ = 4 * 32, I_UP = 12, I_LAYER = I_IN + 2 * I_SQ + I_PJ + 2 * I_UP;
    for (int it = gw; it < DEPTH * I_LAYER; it += ngw) {
        const int L = it / I_LAYER; int r = it % I_LAYER;
        unsigned char* wl = a.ws + WS_W + (size_t)L * W_LAYER;
        if (r < I_IN) { transpose_item<true>(a.w_in + (size_t)L * DM * ZP, DM, ZP, (bf16_t*)(wl + W_IN), a.norm_g + L * DM, scr, r, NPAD / 32, lane); continue; } r -= I_IN;
        if (r < I_SQ) { transpose_item<false>(a.w_out + (size_t)L * DM * DM, DM, DM, (bf16_t*)(wl + W_OUT), nullptr, scr, r, 32, lane); continue; } r -= I_SQ;
        if (r < I_SQ) { transpose_item<false>(a.w_gate + (size_t)L * DM * DM, DM, DM, (bf16_t*)(wl + W_GATE), a.ple_g + L * DM, scr, r, 32, lane); continue; } r -= I_SQ;
        if (r < I_PJ) { transpose_item<false>(a.w_proj + (size_t)L * 256 * DM, 256, DM, (bf16_t*)(wl + W_PROJ), nullptr, scr, r, 32, lane); continue; } r -= I_PJ;
        if (r < I_UP) { transpose_item<false>(a.w_up + (size_t)L * 64 * 384, 64, 384, (bf16_t*)(wl + W_WUPT), nullptr, scr, r, 12, lane); continue; } r -= I_UP;
        transpose_item<false>(a.a_up + (size_t)L * 64 * 384, 64, 384, (bf16_t*)(wl + W_AUPT), nullptr, scr, r, 12, lane);
    }
}

__device__ __forceinline__ void sincos_d(float ang, float& c, float& s) {
    const double a = (double)ang; const double n = rint(a * 0.63661977236758134308);
    double r = fma(-n, 1.57079632679489655800e+00, a); r = fma(-n, 6.12323399573676603587e-17, r);
    const double r2 = r * r;
    double sp = r2 * (1.0 / 6227020800.0) - 1.0 / 39916800.0; sp = sp * r2 + 1.0 / 362880.0; sp = sp * r2 - 1.0 / 5040.0; sp = sp * r2 + 1.0 / 120.0; sp = sp * r2 - 1.0 / 6.0; sp = sp * r2 * r + r;
    double cp = r2 * (1.0 / 479001600.0) - 1.0 / 3628800.0; cp = cp * r2 + 1.0 / 40320.0; cp = cp * r2 - 1.0 / 720.0; cp = cp * r2 + 1.0 / 24.0; cp = cp * r2 - 0.5; cp = cp * r2 + 1.0;
    const int q = ((int)n) & 3;
    const double sv = (q == 0) ? sp : (q == 1) ? cp : (q == 2) ? -sp : -cp;
    const double cv = (q == 0) ? cp : (q == 1) ? -sp : (q == 2) ? -cp : sp;
    c = (float)cv; s = (float)sv;
}
__device__ __forceinline__ void prep_tables(unsigned char* ws, int gtid, int nthreads) {
    const float inv8[8] = {1.0f, 0.1939227432012558f, 0.03760603070259094f, 0.007292664609849453f, 0.0014142135623842478f, 0.00027424818836152554f, 5.318296098266728e-05f, 1.0313386155758053e-05f};
    float* t16 = (float*)(ws + WS_TAB16); float* tI = (float*)(ws + WS_TABI);
    for (int e = gtid; e < SEQ * 8; e += nthreads) { const int pos = e >> 3, i = e & 7;
        float iv = inv8[0];
#pragma unroll
        for (int j = 1; j < 8; ++j) iv = (i == j) ? inv8[j] : iv;
        float c, s; sincos_d((float)pos * iv, c, s); t16[pos * 16 + i] = c; t16[pos * 16 + 8 + i] = s;
        if ((i & 1) == 0) { const int i4 = i >> 1; tI[pos * 8 + i4] = c; tI[pos * 8 + 4 + i4] = s; }
    }
}
__device__ __forceinline__ void x_row_to_bf16(const float* xrow, bf16_t* orow, float* ssq, int lane) {
    const f32x4* xr = (const f32x4*)xrow + lane;
    unsigned long long* o8 = (unsigned long long*)orow + lane;
#pragma unroll
    for (int j = 0; j < 4; ++j) { const f32x4 v = xr[64 * j];
        float s = (v.x * v.x + v.y * v.y) + (v.z * v.z + v.w * v.w);
        o8[64 * j] = (unsigned long long)pk2(v.x, v.y) | ((unsigned long long)pk2(v.z, v.w) << 32);
        s += __shfl_xor(s, 1); s += __shfl_xor(s, 2); s += __shfl_xor(s, 4); s += __shfl_xor(s, 8);
        if ((lane & 15) == 0) ssq[4 * j + (lane >> 4)] = s; }
}
__device__ __forceinline__ float row_rstd(const float* ssq_row) {
    const f32x4 a = *(const f32x4*)ssq_row, b = *(const f32x4*)(ssq_row + 4), c = *(const f32x4*)(ssq_row + 8), d = *(const f32x4*)(ssq_row + 12);
    const float s = ((a.x + a.y) + (a.z + a.w)) + ((b.x + b.y) + (b.z + b.w)) + ((c.x + c.y) + (c.z + c.w)) + ((d.x + d.y) + (d.z + d.w));
    return 1.0f / sqrtf(s * (1.0f / DM) + NORM_EPS);
}
namespace epi {
using pg8::Unit; using pg8::BM; using pg8::HALF;
__device__ __forceinline__ u32x4 pack8(const f32x4& a, const f32x4& b) { u32x4 w; w.x = pg8::cvt_pk_bf16(a[0], a[1]); w.y = pg8::cvt_pk_bf16(a[2], a[3]); w.z = pg8::cvt_pk_bf16(b[0], b[1]); w.w = pg8::cvt_pk_bf16(b[2], b[3]); return w; }
__device__ __forceinline__ int rope_class(int c0, int& fb) {
    fb = 0; int o;
    if (c0 >= ZB_Q && c0 < ZB_V) { o = (c0 - ZB_Q) & 63; if (o < 16) { fb = o >> 1; return 1; } return 0; }
    if (c0 >= ZB_IQ && c0 < ZB_IW) { o = (c0 - ZB_IQ) & 31; return o == 0 ? 2 : 0; }
    if (c0 >= ZC_Q && c0 < ZC_V) { o = (c0 - ZC_Q) & 63; if (o < 16) { fb = o >> 1; return 1; } return 0; }
    return 0;
}
struct EpiInProj {
    static constexpr bool PERM = true, AFTER_DRAIN = false;
    bf16_t* Z; const float* ssq; const float* tab16; const float* tabI;
    __device__ __forceinline__ void operator()(const f32x4 (&acc)[2][2][4][2], const Unit& u, int wr, int wc, int fr, int fq) const {
        const int row0 = u.pm * BM + wr * 64 + fr;
        const int c00 = u.pn * BM + wc * 32 + 8 * fq, c01 = c00 + HALF;
        int fb0, fb1; const int rc0 = rope_class(c00, fb0), rc1 = rope_class(c01, fb1);
#pragma unroll
        for (int ai = 0; ai < 2; ++ai)
#pragma unroll
            for (int m = 0; m < 4; ++m) {
                const int row = row0 + ai * HALF + m * 16;
                const float rs = row_rstd(ssq + (size_t)row * 16);
                const int pos = row & (SEQ - 1);
#pragma unroll
                for (int bj = 0; bj < 2; ++bj) {
                    const int c0 = bj ? c01 : c00, rc = bj ? rc1 : rc0, fb = bj ? fb1 : fb0;
                    if (c0 >= ZP) continue;
                    f32x4 v0 = acc[ai][bj][m][0] * rs, v1 = acc[ai][bj][m][1] * rs;
                    if (rc) {
                        const float* tp = (rc == 1) ? tab16 + pos * 16 + fb : tabI + pos * 8;
                        const f32x4 c = *(const f32x4*)tp, s = *(const f32x4*)(tp + (rc == 1 ? 8 : 4));
                        f32x4 a0, a1;
                        a0[0] = v0[0] * c[0] - v0[1] * s[0]; a0[1] = v0[1] * c[0] + v0[0] * s[0];
                        a0[2] = v0[2] * c[1] - v0[3] * s[1]; a0[3] = v0[3] * c[1] + v0[2] * s[1];
                        a1[0] = v1[0] * c[2] - v1[1] * s[2]; a1[1] = v1[1] * c[2] + v1[0] * s[2];
                        a1[2] = v1[2] * c[3] - v1[3] * s[3]; a1[3] = v1[3] * c[3] + v1[2] * s[3];
                        v0 = a0; v1 = a1;
                    }
                    *(u32x4*)(Z + (size_t)row * ZP + c0) = pack8(v0, v1);
                }
                asm volatile("" ::: "memory");
            }
    }
};
struct EpiOutProj {
    static constexpr bool PERM = true, AFTER_DRAIN = false;
    const float* xin; float* xout; bf16_t* xb; float* ssq_out;
    __device__ __forceinline__ void operator()(const f32x4 (&acc)[2][2][4][2], const Unit& u, int wr, int wc, int fr, int fq) const {
        const int row0 = u.pm * BM + wr * 64 + fr;
#pragma unroll
        for (int ai = 0; ai < 2; ++ai)
#pragma unroll
            for (int m = 0; m < 4; ++m) {
                const int row = row0 + ai * HALF + m * 16; float sq = 0.f;
#pragma unroll
                for (int bj = 0; bj < 2; ++bj) {
                    const size_t off = (size_t)row * DM + u.pn * BM + bj * HALF + wc * 32 + 8 * fq;
                    const f32x4 x0 = *(const f32x4*)(xin + off) + acc[ai][bj][m][0], x1 = *(const f32x4*)(xin + off + 4) + acc[ai][bj][m][1];
                    *(f32x4*)(xout + off) = x0; *(f32x4*)(xout + off + 4) = x1;
                    *(u32x4*)(xb + off) = pack8(x0, x1);
                    sq += ((x0[0] * x0[0] + x0[1] * x0[1]) + (x0[2] * x0[2] + x0[3] * x0[3])) + ((x1[0] * x1[0] + x1[1] * x1[1]) + (x1[2] * x1[2] + x1[3] * x1[3]));
                }
                sq += __shfl_xor(sq, 16); sq += __shfl_xor(sq, 32);
                if (fq == 0) ssq_out[(size_t)row * 16 + u.pn * 4 + wc] = sq;
            }
    }
};
struct EpiGate {
    static constexpr bool PERM = true, AFTER_DRAIN = false;
    float* xio; const float* pp; bf16_t* xb; const float* ssq_in; float* ssq_out;
    __device__ __forceinline__ void operator()(const f32x4 (&acc)[2][2][4][2], const Unit& u, int wr, int wc, int fr, int fq) const {
        const int row0 = u.pm * BM + wr * 64 + fr;
#pragma unroll
        for (int ai = 0; ai < 2; ++ai)
#pragma unroll
            for (int m = 0; m < 4; ++m) {
                const int row = row0 + ai * HALF + m * 16; float sq = 0.f;
                const float rs = row_rstd(ssq_in + (size_t)row * 16);
#pragma unroll
                for (int bj = 0; bj < 2; ++bj) {
                    const size_t off = (size_t)row * DM + u.pn * BM + bj * HALF + wc * 32 + 8 * fq;
                    f32x4 g0 = acc[ai][bj][m][0] * rs, g1 = acc[ai][bj][m][1] * rs;
#pragma unroll
                    for (int i = 0; i < 4; ++i) { g0[i] = 1.0f / (1.0f + __expf(-g0[i])); g1[i] = 1.0f / (1.0f + __expf(-g1[i])); }
                    const f32x4 x0 = *(const f32x4*)(xio + off) + g0 * *(const f32x4*)(pp + off), x1 = *(const f32x4*)(xio + off + 4) + g1 * *(const f32x4*)(pp + off + 4);
                    *(f32x4*)(xio + off) = x0; *(f32x4*)(xio + off + 4) = x1;
                    *(u32x4*)(xb + off) = pack8(x0, x1);
                    sq += ((x0[0] * x0[0] + x0[1] * x0[1]) + (x0[2] * x0[2] + x0[3] * x0[3])) + ((x1[0] * x1[0] + x1[1] * x1[1]) + (x1[2] * x1[2] + x1[3] * x1[3]));
                }
                sq += __shfl_xor(sq, 16); sq += __shfl_xor(sq, 32);
                if (fq == 0) ssq_out[(size_t)row * 16 + u.pn * 4 + wc] = sq;
            }
    }
};
struct EpiF32 {
    static constexpr bool PERM = true, AFTER_DRAIN = false;
    float* C;
    __device__ __forceinline__ void operator()(const f32x4 (&acc)[2][2][4][2], const Unit& u, int wr, int wc, int fr, int fq) const {
        const int row0 = u.pm * BM + wr * 64 + fr;
#pragma unroll
        for (int ai = 0; ai < 2; ++ai)
#pragma unroll
            for (int m = 0; m < 4; ++m)
#pragma unroll
                for (int bj = 0; bj < 2; ++bj) {
                    const size_t off = (size_t)(row0 + ai * HALF + m * 16) * DM + u.pn * BM + bj * HALF + wc * 32 + 8 * fq;
                    *(f32x4*)(C + off) = acc[ai][bj][m][0]; *(f32x4*)(C + off + 4) = acc[ai][bj][m][1];
                }
    }
};
}
typedef GAS unsigned gu32;
#define RLX_AGENT __ATOMIC_RELAXED, __HIP_MEMORY_SCOPE_AGENT
#define XB_TMO      128
#define XB_XCNT(j)  (256  + 64 * (j))
#define XB_XSUB(j)  (1280 + 64 * (j))
#define XB_XGEN(j)  (2304 + 64 * (j))
#define XB_TOP      3328
#define XB_TOPGEN   3392
#define XCD_BAR_WORDS 3456
#define XB_SPIN_CAP (1u << 27)

__device__ __forceinline__ unsigned xb_ld(unsigned* p)              { return __hip_atomic_load(p, __ATOMIC_RELAXED, __HIP_MEMORY_SCOPE_AGENT); }
__device__ __forceinline__ unsigned xb_add(unsigned* p, unsigned v) { return __hip_atomic_fetch_add(p, v, __ATOMIC_RELAXED, __HIP_MEMORY_SCOPE_AGENT); }
__device__ __forceinline__ unsigned xb_xcc_id() { return (unsigned)__builtin_amdgcn_s_getreg((3 << 11) | 20) & 0xFu; }
#define XB_SPIN(cond, bar) do { unsigned _sp = 0; while (cond) { __builtin_amdgcn_s_sleep(1); \
    if ((++_sp & 255u) == 0u) { if (xb_ld(&(bar)[XB_TMO])) break; if (_sp > XB_SPIN_CAP) { atomicAdd(&(bar)[XB_TMO], 1u); break; } } } } while (0)

struct XcdBarrier {
    unsigned* bar; unsigned x;
    volatile LAS unsigned* st;
};

__device__ __forceinline__ XcdBarrier xcd_barrier_post(unsigned* bar, volatile LAS unsigned* st) {
    XcdBarrier b; b.bar = bar; b.x = xb_xcc_id(); b.st = st;
    if (threadIdx.x == 0) (void)xb_add(&bar[XB_XCNT(b.x)], 1u);
    return b;
}
__device__ __forceinline__ void xcd_barrier_complete(unsigned* bar, unsigned x, unsigned& nloc, unsigned& nx) {
    const unsigned G = gridDim.x * gridDim.y * gridDim.z;
    unsigned sum, cnt, mine, sp = 0u;
    for (;;) {
        sum = 0u; cnt = 0u; mine = 0u;
#pragma unroll
        for (unsigned j = 0; j < 16; ++j) { const unsigned c = xb_ld(&bar[XB_XCNT(j)]); sum += c; cnt += (c > 0u) ? 1u : 0u; mine = (j == x) ? c : mine; }
        if (sum == G) break;
        __builtin_amdgcn_s_sleep(1);
        if ((++sp & 255u) == 0u) { if (xb_ld(&bar[XB_TMO])) break; if (sp > XB_SPIN_CAP) { atomicAdd(&bar[XB_TMO], 1u); break; } }
    }
    nloc = mine > 0u ? mine : 1u; nx = cnt > 0u ? cnt : 1u;
}

__device__ __forceinline__ void xcd_barrier(const XcdBarrier& b) {
    asm volatile("s_waitcnt vmcnt(0)" ::: "memory");
    __syncthreads();
    if (threadIdx.x == 0) {
        unsigned* bar = b.bar;
        __builtin_amdgcn_s_waitcnt(0);
        unsigned nloc = b.st[0], nx = b.st[1];
        if (nloc == 0u) { xcd_barrier_complete(bar, b.x, nloc, nx); b.st[0] = nloc; b.st[1] = nx; }
        const unsigned old = xb_add(&bar[XB_XSUB(b.x)], 1u);
        const unsigned gen = old / nloc;
        if (old + 1u == (gen + 1u) * nloc) {
            __builtin_amdgcn_fence(__ATOMIC_RELEASE, "agent");
            asm volatile("s_waitcnt vmcnt(0)" ::: "memory");
            const unsigned og = xb_add(&bar[XB_TOP], 1u);
            const unsigned tg = og / nx;
            if (og + 1u == (tg + 1u) * nx) xb_add(&bar[XB_TOPGEN], 1u);
            else XB_SPIN(xb_ld(&bar[XB_TOPGEN]) == tg, bar);
            __builtin_amdgcn_fence(__ATOMIC_ACQUIRE, "agent");
            xb_add(&bar[XB_XGEN(b.x)], 1u);
            asm volatile("s_waitcnt vmcnt(0)" ::: "memory");
        } else {
            XB_SPIN(xb_ld(&bar[XB_XGEN(b.x)]) == gen, bar);
            __builtin_amdgcn_fence(__ATOMIC_ACQUIRE, "agent");
            asm volatile("s_waitcnt vmcnt(0)" ::: "memory");
        }
    }
    __syncthreads();
}
struct MixArgs { const bf16_t* Z; bf16_t* Y; const float* mu; const float* w0; const float* w_up; const float* a0; const float* a_up; const float* k_k; const float* k_a; const float* r_k; const float* ln_g; const float* ln_b; };

__device__ __forceinline__ void rwkv_seq_phase(const MixArgs& a, unsigned char* ldsb, int chain  ) {
    constexpr int TB = 16;
    typedef float (*arr_t)[64];
    const int tid0 = opaque_tid();
    float* base = (float*)(ldsb + (tid0 >> 8) * 40960);
    arr_t sr = (arr_t)(base), sw = (arr_t)(base + 1024), sk = (arr_t)(base + 2048), sv = (arr_t)(base + 3072), skk = (arr_t)(base + 4096), sb = (arr_t)(base + 5120), sg = (arr_t)(base + 6144), swd = (arr_t)(base + 7168), sad = (arr_t)(base + 8192), sy = (arr_t)(base + 9216);
    const int b = chain / 6, h = chain % 6, tid = tid0 & 255, lane = tid & 63, wv = tid >> 6;
    const int vrow = tid >> 2, kq = tid & 3;
    float st[16];
#pragma unroll
    for (int i = 0; i < 16; ++i) st[i] = 0.f;
    for (int t0 = 0; t0 < SEQ; t0 += TB) {
        for (int idx = tid; idx < TB * 64; idx += 256) {
            const int t = idx >> 6, c = idx & 63, tok = t0 + t;
            const bf16_t* zr = a.Z + (size_t)(b * SEQ + tok) * ZP; const bf16_t* zp = zr - ZP; const bool hp = tok > 0;
            auto mix = [&](int col) { const float cur = bf2f(zr[col]), prv = hp ? bf2f(zp[col]) : 0.f; return cur + (prv - cur) * a.mu[col]; };
            sr[t][c] = mix(ZA_R + h * 64 + c); sk[t][c] = mix(ZA_K + h * 64 + c); sv[t][c] = mix(ZA_V + h * 64 + c); sg[t][c] = mix(ZA_G + h * 64 + c);
            swd[t][c] = tanhf(mix(ZA_WD + c)); sad[t][c] = mix(ZA_AD + c);
        }
        __syncthreads();
        for (int idx = tid; idx < TB * 64; idx += 256) {
            const int t = idx >> 6, c = idx & 63, hc = h * 64 + c;
            float pw = a.w0[hc], pa = a.a0[hc];
            for (int j = 0; j < 64; ++j) { pw += swd[t][j] * a.w_up[j * 384 + hc]; pa += sad[t][j] * a.a_up[j * 384 + hc]; }
            const float w = __expf(-DECAY_SCALE * sigmoidf_(pw)), eta = sigmoidf_(pa);
            const float k = sk[t][c];
            sw[t][c] = w; sb[t][c] = eta; skk[t][c] = k * a.k_k[hc]; sk[t][c] = k * (1.f + (eta - 1.f) * a.k_a[hc]);
        }
        __syncthreads();
        for (int t = wv; t < TB; t += 4) {
            const float kr = skk[t][lane]; const float nrm = sqrtf(wave_sum(kr * kr)); const float kk = kr / fmaxf(nrm, 1e-12f);
            skk[t][lane] = kk; sb[t][lane] = kk * sb[t][lane];
        }
        __syncthreads();
        for (int t = 0; t < TB; ++t) {
            float sa = 0.f;
#pragma unroll
            for (int i = 0; i < 16; ++i) sa -= st[i] * skk[t][kq * 16 + i];
            sa += __shfl_xor(sa, 1); sa += __shfl_xor(sa, 2);
            const float vv = sv[t][vrow]; float yy = 0.f;
#pragma unroll
            for (int i = 0; i < 16; ++i) { const int kc = kq * 16 + i; st[i] = st[i] * sw[t][kc] + sa * sb[t][kc] + vv * sk[t][kc]; yy += st[i] * sr[t][kc]; }
            yy += __shfl_xor(yy, 1); yy += __shfl_xor(yy, 2);
            if (kq == 0) sy[t][vrow] = yy;
        }
        __syncthreads();
        for (int t = wv; t < TB; t += 4) {
            const int hc = h * 64 + lane;
            const float y = sy[t][lane]; const float mean = wave_sum(y) * (1.f / 64.f); const float d = y - mean; const float var = wave_sum(d * d) * (1.f / 64.f);
            const float yn = d * (1.0f / sqrtf(var + GN_EPS)) * a.ln_g[hc] + a.ln_b[hc];
            const float bonus = wave_sum(sr[t][lane] * sk[t][lane] * a.r_k[hc]) * sv[t][lane];
            const float g = sg[t][lane];
            a.Y[(size_t)(b * SEQ + t0 + t) * DM + hc] = (bf16_t)f2bf((yn + bonus) * g * sigmoidf_(g));
        }
        __syncthreads();
    }
}

__device__ __forceinline__ void dsa_simple_unit(const MixArgs& a, unsigned char* ldsb, int row) {
    const int tid0 = opaque_tid(); const int wv = tid0 >> 6, lane = tid0 & 63;
    typedef float (*a256_t)[256]; typedef float (*a8_t)[8]; typedef float (*p_t)[4][256]; typedef unsigned (*key_t)[SEQ]; typedef int (*idx_t)[256];
    a256_t s_iq = (a256_t)(ldsb); a256_t s_q = (a256_t)(ldsb + 8192); a8_t s_iw = (a8_t)(ldsb + 16384); idx_t s_idx = (idx_t)(ldsb + 16384 + 256); p_t s_p = (p_t)(ldsb + 16384 + 256 + 8192); key_t s_key = (key_t)(ldsb + 16384 + 256 + 8192 + 32768);
    const int b = row / SEQ, t = row % SEQ;
    __syncthreads();
    const bf16_t* zr = a.Z + (size_t)row * ZP; const bf16_t* zb = a.Z + (size_t)b * SEQ * ZP;
    for (int i = lane; i < 256; i += 64) { s_iq[wv][i] = bf2f(zr[ZB_IQ + i]); s_q[wv][i] = bf2f(zr[ZB_Q + i]); }
    if (lane < 8) s_iw[wv][lane] = bf2f(zr[ZB_IW + lane]);
    __syncthreads();
    const int nj = (t >> 6) + 1;
    for (int j = 0; j < nj; ++j) {
        const int s = lane + 64 * j; unsigned u = 0u;
        if (s <= t) {
            const u32x4* kp = (const u32x4*)(zb + (size_t)s * ZP + ZB_IK); float ik[32];
#pragma unroll
            for (int q4 = 0; q4 < 4; ++q4) { const u32x4 w = kp[q4];
                ik[q4 * 8 + 0] = bflo(w.x); ik[q4 * 8 + 1] = bfhi(w.x); ik[q4 * 8 + 2] = bflo(w.y); ik[q4 * 8 + 3] = bfhi(w.y); ik[q4 * 8 + 4] = bflo(w.z); ik[q4 * 8 + 5] = bfhi(w.z); ik[q4 * 8 + 6] = bflo(w.w); ik[q4 * 8 + 7] = bfhi(w.w); }
            float sc = 0.f;
#pragma unroll
            for (int hh = 0; hh < 8; ++hh) { float d = 0.f;
#pragma unroll
                for (int dd = 0; dd < 32; ++dd) d += s_iq[wv][hh * 32 + dd] * ik[dd];
                sc += s_iw[wv][hh] * fmaxf(d, 0.f); }
            const unsigned bits = __builtin_bit_cast(unsigned, sc);
            u = (bits & 0x80000000u) ? ~bits : (bits | 0x80000000u);
        }
        s_key[wv][s] = u;
    }
    __syncthreads();
    int nsel;
    if (t < 256) { for (int s = lane; s <= t; s += 64) s_idx[wv][s] = s; nsel = t + 1; }
    else {
        unsigned prefix = 0u;
        for (int bit = 31; bit >= 0; --bit) { const unsigned cand = prefix | (1u << bit); int cnt = 0;
            for (int j = 0; j < nj; ++j) cnt += __popcll(__ballot(s_key[wv][lane + 64 * j] >= cand));
            if (cnt >= 256) prefix = cand; }
        int ngt = 0;
        for (int j = 0; j < nj; ++j) ngt += __popcll(__ballot(s_key[wv][lane + 64 * j] > prefix));
        const int need = 256 - ngt; int nt = 0, ns = 0;
        for (int j = 0; j < nj; ++j) { const unsigned u = s_key[wv][lane + 64 * j];
            const unsigned long long mt = __ballot(u == prefix); const int trank = nt + __popcll(mt & ((1ull << lane) - 1ull));
            const bool sel = (u > prefix) || (u == prefix && trank < need);
            const unsigned long long ms = __ballot(sel); const int slot = ns + __popcll(ms & ((1ull << lane) - 1ull));
            if (sel) s_idx[wv][slot] = lane + 64 * j;
            nt += __popcll(mt); ns += __popcll(ms); }
        nsel = ns;
    }
    __syncthreads();
    float lg[4][4];
#pragma unroll
    for (int i = 0; i < 4; ++i) { const int slot = lane + 64 * i;
#pragma unroll
        for (int hh = 0; hh < 4; ++hh) lg[i][hh] = -INFINITY;
        if (slot < nsel) { const int s = s_idx[wv][slot]; const u32x4* kp = (const u32x4*)(zb + (size_t)s * ZP + ZB_K);
            float acc4[4] = {0.f, 0.f, 0.f, 0.f};
#pragma unroll
            for (int q8 = 0; q8 < 8; ++q8) { const u32x4 w = kp[q8]; float kv[8] = {bflo(w.x), bfhi(w.x), bflo(w.y), bfhi(w.y), bflo(w.z), bfhi(w.z), bflo(w.w), bfhi(w.w)};
#pragma unroll
                for (int hh = 0; hh < 4; ++hh)
#pragma unroll
                    for (int e = 0; e < 8; ++e) acc4[hh] += s_q[wv][hh * 64 + q8 * 8 + e] * kv[e]; }
#pragma unroll
            for (int hh = 0; hh < 4; ++hh) lg[i][hh] = acc4[hh]; } }
#pragma unroll
    for (int hh = 0; hh < 4; ++hh) {
        float m = fmaxf(fmaxf(lg[0][hh], lg[1][hh]), fmaxf(lg[2][hh], lg[3][hh])); m = wave_max(m);
        float p[4], l = 0.f;
#pragma unroll
        for (int i = 0; i < 4; ++i) { p[i] = exp2f(lg[i][hh] - m); l += p[i]; }
        l = wave_sum(l); const float rl = 1.f / l;
#pragma unroll
        for (int i = 0; i < 4; ++i) s_p[wv][hh][lane + 64 * i] = p[i] * rl;
    }
    __syncthreads();
    float o[4] = {0.f, 0.f, 0.f, 0.f};
    for (int slot = 0; slot < nsel; ++slot) { const int s = s_idx[wv][slot]; const float vv = bf2f(zb[(size_t)s * ZP + ZB_V + lane]);
#pragma unroll
        for (int hh = 0; hh < 4; ++hh) o[hh] += s_p[wv][hh][slot] * vv; }
#pragma unroll
    for (int hh = 0; hh < 4; ++hh) { const float g = bf2f(zr[ZB_G + hh * 64 + lane]); a.Y[(size_t)row * DM + 384 + hh * 64 + lane] = (bf16_t)f2bf(o[hh] * g * sigmoidf_(g)); }
}

__device__ __forceinline__ void dil_simple_unit(const MixArgs& a, unsigned char* ldsb, int wid) {
    const int tid0 = opaque_tid(); const int wv = tid0 >> 6, lane = tid0 & 63;
    typedef float (*q_t)[64]; typedef float (*pp_t)[192];
    q_t s_q = (q_t)(ldsb); pp_t s_p = (pp_t)(ldsb + 2048);
    const int row = wid >> 1, hg = wid & 1, b = row / SEQ, t = row % SEQ;
    const bf16_t* zr = a.Z + (size_t)row * ZP; const bf16_t* zb = a.Z + (size_t)b * SEQ * ZP;
    float og[3], lse[3];
#pragma unroll
    for (int gi = 0; gi < 3; ++gi) {
        const int head = gi * 2 + hg, rate = (gi == 0) ? 1 : (gi == 1) ? 4 : 16;
        const int ip = t / rate; const int nkeys = (ip < 128 ? ip : 128) + 1;
        __syncthreads();
        s_q[wv][lane] = bf2f(zr[ZC_Q + head * 64 + lane]);
        __syncthreads();
        float lg[3];
#pragma unroll
        for (int i = 0; i < 3; ++i) { const int j = lane + 64 * i; lg[i] = -INFINITY;
            if (j < nkeys) { const u32x4* kp = (const u32x4*)(zb + (size_t)(t - j * rate) * ZP + ZC_K + head * 64); float d = 0.f;
#pragma unroll
                for (int q8 = 0; q8 < 8; ++q8) { const u32x4 w = kp[q8]; const float kv[8] = {bflo(w.x), bfhi(w.x), bflo(w.y), bfhi(w.y), bflo(w.z), bfhi(w.z), bflo(w.w), bfhi(w.w)};
#pragma unroll
                    for (int e = 0; e < 8; ++e) d += s_q[wv][q8 * 8 + e] * kv[e]; }
                lg[i] = d; } }
        const float m = wave_max(fmaxf(fmaxf(lg[0], lg[1]), lg[2]));
        float p[3], l = 0.f;
#pragma unroll
        for (int i = 0; i < 3; ++i) { p[i] = exp2f(lg[i] - m); l += p[i]; }
        l = wave_sum(l); const float rl = 1.f / l;
#pragma unroll
        for (int i = 0; i < 3; ++i) s_p[wv][lane + 64 * i] = p[i] * rl;
        __syncthreads();
        float o = 0.f;
        for (int j = 0; j < nkeys; ++j) o += s_p[wv][j] * bf2f(zb[(size_t)(t - j * rate) * ZP + ZC_V + head * 64 + lane]);
        og[gi] = o; lse[gi] = m + log2f(l);
    }
    const float mx = fmaxf(fmaxf(lse[0], lse[1]), lse[2]);
    const float e0 = exp2f(lse[0] - mx), e1 = exp2f(lse[1] - mx), e2 = exp2f(lse[2] - mx); const float rs = 1.f / (e0 + e1 + e2);
    const float al[3] = {e0 * rs, e1 * rs, e2 * rs};
#pragma unroll
    for (int gi = 0; gi < 3; ++gi) { const int head = gi * 2 + hg; const float g = bf2f(zr[ZC_G + head * 64 + lane]);
        a.Y[(size_t)row * DM + 640 + head * 64 + lane] = (bf16_t)f2bf(og[gi] * al[gi] * g * sigmoidf_(g)); }
}
namespace dsa {
#define MFMA32(a, b, c) __builtin_amdgcn_mfma_f32_32x32x16_bf16((a), (b), (c), 0, 0, 0)
typedef short v4i16_t __attribute__((ext_vector_type(4)));
typedef short s16x4 __attribute__((ext_vector_type(4)));
constexpr int WAVE_LDS = 2048 + 4096;
__device__ __forceinline__ unsigned fkey(float f) { const unsigned b = __builtin_bit_cast(unsigned, f); return (b & 0x80000000u) ? ~b : (b | 0x80000000u); }
__device__ __forceinline__ float keyf(unsigned u) { const unsigned b = (u & 0x80000000u) ? (u & 0x7fffffffu) : ~u; return __builtin_bit_cast(float, b); }
__device__ __forceinline__ s16x4 vtr(const LAS unsigned char* p) { return __builtin_bit_cast(s16x4, __builtin_amdgcn_ds_read_tr16_b64_v4i16((LAS v4i16_t*)p)); }

__device__ __forceinline__ unsigned next_pivot(unsigned ulo, unsigned uhi, int clo, int chi, int n, int it) {
    unsigned p;
    if (it == 0) p = fkey(0.0f);
    else if (chi == 0) { const float f = keyf(ulo); p = fkey(f >= 0.f ? 2.f * f + 0.25f : 0.5f * f + 0.125f); }
    else if (clo == n) { const float f = keyf(uhi); p = fkey(f <= 0.f ? 2.f * f - 0.25f : 0.5f * f - 0.125f); }
    else { float fr = ((float)(clo - 256) + 0.5f) / (float)(clo - chi); fr = fminf(fmaxf(fr, 1.f / 32.f), 31.f / 32.f); p = ulo + (unsigned)((float)(uhi - ulo) * fr); }
    if ((it % 3 == 2 && clo != n && chi != 0) || !(p > ulo && p < uhi)) p = ulo + ((uhi - ulo) >> 1);
    return p;
}

__device__ __forceinline__ void dsa_unit(const MixArgs& a, unsigned char* ldsb, int b, int blk) {
    const int tid = opaque_tid(), lane = tid & 63, wave = __builtin_amdgcn_readfirstlane(tid >> 6), r32 = lane & 31, hi = lane >> 5;
    const GAS bf16_t* zb = (const GAS bf16_t*)a.Z + (size_t)b * SEQ * ZP;
    LAS unsigned char* wl = (LAS unsigned char*)ldsb + wave * WAVE_LDS;
    LAS unsigned* bm = (LAS unsigned*)wl;
    LAS unsigned char* vimg = wl + 2048;
    const int tw = blk * 64 + 8 * wave;
    f32x16 zero16;
#pragma unroll
    for (int i = 0; i < 16; ++i) zero16[i] = 0.f;
#pragma unroll 1
    for (int rnd = 0; rnd < 2; ++rnd) {
        const int tb = tw + 4 * rnd;
        const int qsub = 2 * ((r32 >> 2) & 1) + (r32 >> 4), head = (r32 & 3) + 4 * ((r32 >> 3) & 1);
        const GAS bf16_t* iqp = zb + (size_t)(tb + qsub) * ZP + ZB_IQ + head * 32 + 8 * hi;
        const bf16x8 aiq0 = *(const GAS bf16x8*)iqp, aiq1 = *(const GAS bf16x8*)(iqp + 16);
        const int tqA = tb + 2 * hi, tqB = tqA + 1;
        float wA[8], wB[8];
        { const u32x4 ua = *(const GAS u32x4*)(zb + (size_t)tqA * ZP + ZB_IW), ub = *(const GAS u32x4*)(zb + (size_t)tqB * ZP + ZB_IW);
          wA[0] = bflo(ua.x); wA[1] = bfhi(ua.x); wA[2] = bflo(ua.y); wA[3] = bfhi(ua.y); wA[4] = bflo(ua.z); wA[5] = bfhi(ua.z); wA[6] = bflo(ua.w); wA[7] = bfhi(ua.w);
          wB[0] = bflo(ub.x); wB[1] = bfhi(ub.x); wB[2] = bflo(ub.y); wB[3] = bfhi(ub.y); wB[4] = bflo(ub.z); wB[5] = bfhi(ub.z); wB[6] = bflo(ub.w); wB[7] = bfhi(ub.w); }
        unsigned scA[64], scB[64];
        const int dA = tqA - 32 * ((tb + 3) >> 5);
        const int Tmax = (tb + 3) >> 5;
        int Tm_s = Tmax, Tm_b = Tmax; asm volatile("" : "+s"(Tm_s), "+s"(Tm_b));
        const GAS bf16_t* kp = zb + (size_t)r32 * ZP + ZB_IK + 8 * hi;
        bf16x8 kb0[2], kb1[2];
#pragma unroll
        for (int i = 0; i < 2; ++i) { if (i <= Tm_s) { kb0[i] = *(const GAS bf16x8*)kp; kb1[i] = *(const GAS bf16x8*)(kp + 16); } kp += 32 * ZP; asm volatile("" : "+v"(kp)); }
#pragma unroll
        for (int T = 0; T < 64; ++T) {
            if (T <= Tm_s) {
                f32x16 c = MFMA32(aiq0, kb0[T & 1], zero16); c = MFMA32(aiq1, kb1[T & 1], c);
                if (T + 2 <= Tm_s) { kb0[T & 1] = *(const GAS bf16x8*)kp; kb1[T & 1] = *(const GAS bf16x8*)(kp + 16); }
                kp += 32 * ZP; asm volatile("" : "+v"(kp) :: "memory");
                float sA = 0.f, sB = 0.f;
#pragma unroll
                for (int r = 0; r < 8; ++r) { sA += wA[r] * fmaxf(c[r], 0.f); sB += wB[r] * fmaxf(c[8 + r], 0.f); }
                const bool last = (T == Tm_s);
                scA[T] = (!last || r32 <= dA) ? fkey(sA + 0.f) : 0u; scB[T] = (!last || r32 <= dA + 1) ? fkey(sB + 0.f) : 0u;
            } else { scA[T] = 0u; scB[T] = 0u; }
        }
        const int nA = tqA + 1, nB = tqB + 1;
        unsigned uloA = 1u, uhiA = 0xffffffffu, uloB = 1u, uhiB = 0xffffffffu; int cloA = nA, chiA = 0, cloB = nB, chiB = 0;
        bool doneA = nA <= 256, doneB = nB <= 256;
        unsigned thA = 1u, thB = 1u; int needA = 0, needB = 0;
        for (int it = 0; it < 200; ++it) {
            if (!doneA && uhiA - uloA <= 1u) { thA = uhiA; needA = 256 - chiA; doneA = true; }
            if (!doneB && uhiB - uloB <= 1u) { thB = uhiB; needB = 256 - chiB; doneB = true; }
            if (!__any(!doneA || !doneB)) break;
            const unsigned pA = doneA ? 0xffffffffu : next_pivot(uloA, uhiA, cloA, chiA, nA, it), pB = doneB ? 0xffffffffu : next_pivot(uloB, uhiB, cloB, chiB, nB, it);
            int ca = 0, cb = 0;
#pragma unroll
            for (int T = 0; T < 64; ++T) { ca += (scA[T] >= pA) ? 1 : 0; cb += (scB[T] >= pB) ? 1 : 0; }
            int pk = ca | (cb << 16);
            pk += __shfl_xor(pk, 1); pk += __shfl_xor(pk, 2); pk += __shfl_xor(pk, 4); pk += __shfl_xor(pk, 8); pk += __shfl_xor(pk, 16);
            ca = pk & 0xffff; cb = pk >> 16;
            if (!doneA) { if (ca == 256) { thA = pA; needA = 0; doneA = true; } else if (ca > 256) { uloA = pA; cloA = ca; } else { uhiA = pA; chiA = ca; } }
            if (!doneB) { if (cb == 256) { thB = pB; needB = 0; doneB = true; } else if (cb > 256) { uloB = pB; cloB = cb; } else { uhiB = pB; chiB = cb; } }
        }
        int rem0 = __builtin_amdgcn_readlane(needA, 0), rem1 = __builtin_amdgcn_readlane(needB, 0), rem2 = __builtin_amdgcn_readlane(needA, 32), rem3 = __builtin_amdgcn_readlane(needB, 32);
        const bool anytie = (rem0 | rem1 | rem2 | rem3) != 0;
        LAS unsigned* bmr = bm + 4 * rnd; asm volatile("" : "+v"(bmr));
#pragma unroll
        for (int T = 0; T < 64; ++T) {
            if (T <= Tm_b) {
                const unsigned long long mA = __ballot(scA[T] >= thA), mB = __ballot(scB[T] >= thB);
                unsigned m0 = (unsigned)mA, m2 = (unsigned)(mA >> 32), m1 = (unsigned)mB, m3 = (unsigned)(mB >> 32);
                if (anytie) {
                    const unsigned long long eA = __ballot(scA[T] == thA - 1u), eB = __ballot(scB[T] == thB - 1u);
                    unsigned e0 = (unsigned)eA, e2 = (unsigned)(eA >> 32), e1 = (unsigned)eB, e3 = (unsigned)(eB >> 32);
                    while (rem0 > 0 && e0) { const unsigned bit = e0 & (0u - e0); m0 |= bit; e0 ^= bit; --rem0; }
                    while (rem1 > 0 && e1) { const unsigned bit = e1 & (0u - e1); m1 |= bit; e1 ^= bit; --rem1; }
                    while (rem2 > 0 && e2) { const unsigned bit = e2 & (0u - e2); m2 |= bit; e2 ^= bit; --rem2; }
                    while (rem3 > 0 && e3) { const unsigned bit = e3 & (0u - e3); m3 |= bit; e3 ^= bit; --rem3; }
                }
                if (lane == 0) { u32x4 w; w.x = m0; w.y = m1; w.z = m2; w.w = m3; *(LAS u32x4*)(bmr + T * 8) = w; }
            }
        }
    }
    asm volatile("s_waitcnt lgkmcnt(0)" ::: "memory");
    const int qc = r32 >> 2, hc = r32 & 3;
    const size_t qrow = (size_t)(b * SEQ + tw + qc);
    bf16x8 bq[4];
#pragma unroll
    for (int s = 0; s < 4; ++s) bq[s] = *(const GAS bf16x8*)((const GAS bf16_t*)a.Z + qrow * ZP + ZB_Q + hc * 64 + 16 * s + 8 * hi);
    f32x16 o0 = zero16, o1 = zero16; float lsum = 0.f;
    const int Tend = (tw + 7) >> 5;
    const int g16 = lane >> 4, i16 = lane & 15, q4 = i16 >> 2, p4 = i16 & 3;
    const int vrd = ((g16 >> 1) * 4 + q4) * 64 + (16 * (g16 & 1) + 4 * p4) * 2;
    const int vwr_key = lane >> 3, vwr_ch = lane & 7;
    u32x4 vst[4]; bf16x8 ak[4];
    auto load_tile = [&](int T) {
#pragma unroll
        for (int s = 0; s < 4; ++s) ak[s] = *(const GAS bf16x8*)(zb + (size_t)(32 * T + r32) * ZP + ZB_K + 16 * s + 8 * hi);
#pragma unroll
        for (int i = 0; i < 4; ++i) vst[i] = *(const GAS u32x4*)(zb + (size_t)(32 * T + vwr_key + 8 * i) * ZP + ZB_V + 8 * vwr_ch);
    };
    load_tile(0);
#pragma unroll 1
    for (int T = 0; T <= Tend; ++T) {
#pragma unroll
        for (int i = 0; i < 4; ++i) *(LAS u32x4*)(vimg + (vwr_ch >> 2) * 2048 + (vwr_key + 8 * i) * 64 + (vwr_ch & 3) * 16) = vst[i];
        f32x16 sacc = MFMA32(ak[0], bq[0], zero16); sacc = MFMA32(ak[1], bq[1], sacc); sacc = MFMA32(ak[2], bq[2], sacc); sacc = MFMA32(ak[3], bq[3], sacc);
        const unsigned mw = bm[T * 8 + qc] >> (4 * hi);
        if (T < Tend) load_tile(T + 1);
        asm volatile("s_waitcnt lgkmcnt(0)" ::: "memory");
        s16x4 va[2][2][2];
#pragma unroll
        for (int dt = 0; dt < 2; ++dt)
#pragma unroll
            for (int s = 0; s < 2; ++s) { va[dt][s][0] = vtr(vimg + dt * 2048 + (16 * s) * 64 + vrd); va[dt][s][1] = vtr(vimg + dt * 2048 + (16 * s + 8) * 64 + vrd); }
        unsigned pw[8];
#pragma unroll
        for (int r = 0; r < 16; r += 2) {
            const float e0 = __builtin_amdgcn_exp2f(fminf(sacc[r], 64.f)), e1 = __builtin_amdgcn_exp2f(fminf(sacc[r + 1], 64.f));
            const int c0 = (r & 3) + 8 * (r >> 2), c1 = ((r + 1) & 3) + 8 * ((r + 1) >> 2);
            const float p0 = __builtin_bit_cast(float, __builtin_bit_cast(unsigned, e0) & (unsigned)__builtin_amdgcn_sbfe((int)mw, c0, 1));
            const float p1 = __builtin_bit_cast(float, __builtin_bit_cast(unsigned, e1) & (unsigned)__builtin_amdgcn_sbfe((int)mw, c1, 1));
            lsum += p0 + p1;
            pw[r >> 1] = pk2(p0, p1);
        }
        asm volatile("s_waitcnt lgkmcnt(0)" ::: "memory");
#pragma unroll
        for (int s = 0; s < 2; ++s) {
            u32x4 pv4; pv4.x = pw[4 * s]; pv4.y = pw[4 * s + 1]; pv4.z = pw[4 * s + 2]; pv4.w = pw[4 * s + 3];
            const bf16x8 pb = __builtin_bit_cast(bf16x8, pv4);
            const bf16x8 v0 = __builtin_shufflevector(va[0][s][0], va[0][s][1], 0, 1, 2, 3, 4, 5, 6, 7), v1 = __builtin_shufflevector(va[1][s][0], va[1][s][1], 0, 1, 2, 3, 4, 5, 6, 7);
            o0 = MFMA32(v0, pb, o0); o1 = MFMA32(v1, pb, o1);
        }
    }
    lsum += __shfl_xor(lsum, 32);
    const float rl = 1.0f / lsum;
    const GAS bf16_t* gp = (const GAS bf16_t*)a.Z + qrow * ZP + ZB_G + hc * 64; GAS bf16_t* yp = (GAS bf16_t*)a.Y + qrow * DM + 384 + hc * 64;
#pragma unroll
    for (int dt = 0; dt < 2; ++dt)
#pragma unroll
        for (int i = 0; i < 4; ++i) {
            const int d = 32 * dt + 8 * i + 4 * hi;
            const u32x2 gw = *(const GAS u32x2*)(gp + d);
            const float g0 = bflo(gw.x), g1 = bfhi(gw.x), g2 = bflo(gw.y), g3 = bfhi(gw.y);
            const f32x16& o = dt ? o1 : o0;
            u32x2 w; w.x = pk2(o[4 * i] * rl * g0 * sigmoidf_(g0), o[4 * i + 1] * rl * g1 * sigmoidf_(g1)); w.y = pk2(o[4 * i + 2] * rl * g2 * sigmoidf_(g2), o[4 * i + 3] * rl * g3 * sigmoidf_(g3));
            *(GAS u32x2*)(yp + d) = w;
        }
}
}
namespace dil {
using dsa::vtr; using dsa::s16x4;
__device__ __forceinline__ void dil_unit(const MixArgs& a, float* LQ, unsigned char* ldsb, int b, int gi, int u16) {
    const int tid = opaque_tid(), lane = tid & 63, wave = __builtin_amdgcn_readfirstlane(tid >> 6), r32 = lane & 31, hi = lane >> 5;
    const int rate = (gi == 0) ? 1 : (gi == 1) ? 4 : 16, nblk = 16 / rate, c = u16 / nblk, qb = u16 % nblk;
    const int head = gi * 2 + (wave >> 2), q0 = 128 * qb + 32 * (wave & 3);
    const GAS bf16_t* zb = (const GAS bf16_t*)a.Z + (size_t)b * SEQ * ZP;
    LAS unsigned char* vimg = (LAS unsigned char*)ldsb + wave * 4096;
    f32x16 zero16;
#pragma unroll
    for (int i = 0; i < 16; ++i) zero16[i] = 0.f;
    const size_t qrow = (size_t)b * SEQ + (size_t)(q0 + r32) * rate + c;
    bf16x8 bq[4];
#pragma unroll
    for (int s = 0; s < 4; ++s) bq[s] = *(const GAS bf16x8*)((const GAS bf16_t*)a.Z + qrow * ZP + ZC_Q + head * 64 + 16 * s + 8 * hi);
    f32x16 o0 = zero16, o1 = zero16; float lsum = 0.f;
    const int g16 = lane >> 4, i16 = lane & 15, q4 = i16 >> 2, p4 = i16 & 3;
    const int vrd = ((g16 >> 1) * 4 + q4) * 64 + (16 * (g16 & 1) + 4 * p4) * 2;
    const int vwr_key = lane >> 3, vwr_ch = lane & 7;
#pragma unroll 1
    for (int ti = 0; ti < 5; ++ti) {
        const int j0 = q0 - 128 + 32 * ti;
        if (j0 < 0) continue;
        bf16x8 ak[4]; u32x4 vst[4];
#pragma unroll
        for (int s = 0; s < 4; ++s) ak[s] = *(const GAS bf16x8*)(zb + ((size_t)(j0 + r32) * rate + c) * ZP + ZC_K + head * 64 + 16 * s + 8 * hi);
#pragma unroll
        for (int i = 0; i < 4; ++i) vst[i] = *(const GAS u32x4*)(zb + ((size_t)(j0 + vwr_key + 8 * i) * rate + c) * ZP + ZC_V + head * 64 + 8 * vwr_ch);
#pragma unroll
        for (int i = 0; i < 4; ++i) *(LAS u32x4*)(vimg + (vwr_ch >> 2) * 2048 + (vwr_key + 8 * i) * 64 + (vwr_ch & 3) * 16) = vst[i];
        f32x16 sacc = MFMA32(ak[0], bq[0], zero16); sacc = MFMA32(ak[1], bq[1], sacc); sacc = MFMA32(ak[2], bq[2], sacc); sacc = MFMA32(ak[3], bq[3], sacc);
        asm volatile("s_waitcnt lgkmcnt(0)" ::: "memory");
        s16x4 va[2][2][2];
#pragma unroll
        for (int dt = 0; dt < 2; ++dt)
#pragma unroll
            for (int s = 0; s < 2; ++s) { va[dt][s][0] = vtr(vimg + dt * 2048 + (16 * s) * 64 + vrd); va[dt][s][1] = vtr(vimg + dt * 2048 + (16 * s + 8) * 64 + vrd); }
        const int dbase = q0 + r32 - j0 - 4 * hi;
        unsigned pw[8];
#pragma unroll
        for (int r = 0; r < 16; r += 2) {
            const int d0 = dbase - ((r & 3) + 8 * (r >> 2)), d1 = dbase - (((r + 1) & 3) + 8 * ((r + 1) >> 2));
            float p0 = __builtin_amdgcn_exp2f(fminf(sacc[r], 64.f)), p1 = __builtin_amdgcn_exp2f(fminf(sacc[r + 1], 64.f));
            p0 = ((unsigned)d0 <= 128u) ? p0 : 0.f; p1 = ((unsigned)d1 <= 128u) ? p1 : 0.f;
            lsum += p0 + p1;
            pw[r >> 1] = pk2(p0, p1);
        }
        asm volatile("s_waitcnt lgkmcnt(0)" ::: "memory");
#pragma unroll
        for (int s = 0; s < 2; ++s) {
            u32x4 pv4; pv4.x = pw[4 * s]; pv4.y = pw[4 * s + 1]; pv4.z = pw[4 * s + 2]; pv4.w = pw[4 * s + 3];
            const bf16x8 pb = __builtin_bit_cast(bf16x8, pv4);
            const bf16x8 v0 = __builtin_shufflevector(va[0][s][0], va[0][s][1], 0, 1, 2, 3, 4, 5, 6, 7), v1 = __builtin_shufflevector(va[1][s][0], va[1][s][1], 0, 1, 2, 3, 4, 5, 6, 7);
            o0 = MFMA32(v0, pb, o0); o1 = MFMA32(v1, pb, o1);
        }
    }
    lsum += __shfl_xor(lsum, 32);
    if (hi == 0) LQ[qrow * 8 + head] = lsum;
    GAS bf16_t* yp = (GAS bf16_t*)a.Y + qrow * DM + 640 + head * 64;
#pragma unroll
    for (int dt = 0; dt < 2; ++dt)
#pragma unroll
        for (int i = 0; i < 4; ++i) {
            const int d = 32 * dt + 8 * i + 4 * hi; const f32x16& o = dt ? o1 : o0;
            u32x2 w; w.x = pk2(o[4 * i], o[4 * i + 1]); w.y = pk2(o[4 * i + 2], o[4 * i + 3]);
            *(GAS u32x2*)(yp + d) = w;
        }
}
__device__ __forceinline__ void dil_merge_row(const MixArgs& a, const float* LQ, size_t row, int lane) {
    GAS bf16_t* yp = (GAS bf16_t*)a.Y + row * DM + 640; const GAS bf16_t* gp = (const GAS bf16_t*)a.Z + row * ZP + ZC_G;
    const float* lq = LQ + row * 8;
    const float L0 = lq[0] + lq[2] + lq[4], L1 = lq[1] + lq[3] + lq[5];
#pragma unroll
    for (int j = 0; j < 3; ++j) {
        const int col = 128 * j + 2 * lane, head = col >> 6; const float rl = 1.0f / ((head & 1) ? L1 : L0);
        const unsigned ow = *(const GAS unsigned*)(yp + col), gw = *(const GAS unsigned*)(gp + col);
        const float g0 = bflo(gw), g1 = bfhi(gw);
        *(GAS unsigned*)(yp + col) = pk2(bflo(ow) * rl * g0 * sigmoidf_(g0), bfhi(ow) * rl * g1 * sigmoidf_(g1));
    }
}
}
namespace rwkv {
using dsa::vtr; using dsa::s16x4;
constexpr int IP = 144;
constexpr int IMG = 64 * IP;
constexpr int S_WD = 0 * IMG, S_AD = 1 * IMG, S_V = 2 * IMG, S_AT = 3 * IMG, S_BH = 4 * IMG, S_KH = 5 * IMG, S_RT = 6 * IMG, S_KB = 7 * IMG, S_BB = 8 * IMG, S_ARB = 9 * IMG, S_AH = 10 * IMG, S_UV = 11 * IMG;
constexpr int S_AAK = S_WD, S_ARK = S_AD, S_TT = S_BH, S_W1 = S_KH;
constexpr int F_AAB = 12 * IMG;
constexpr int F_LG = S_ARB;
constexpr int F_TOT = F_AAB + 16384;
static_assert(F_TOT + 512 <= 131072 && F_LG + 16384 <= F_AAB, "rwkv LDS map");

struct RArgs { const float* mu; const float* w0; const float* a0; const float* k_k; const float* k_a; const float* r_k; const float* ln_g; const float* ln_b;
               const bf16_t* wupT; const bf16_t* aupT; bf16_t* RQ; bf16_t* RM; bf16_t* RN; float* RG; float* RB; };

__device__ __forceinline__ bf16x8 rowfrag(const LAS unsigned char* img, int r0, int k0, int r32, int hi) { return *(const LAS bf16x8*)(img + (r0 + r32) * IP + (k0 + 8 * hi) * 2); }
__device__ __forceinline__ bf16x8 colfrag(const LAS unsigned char* img, int c0, int k0, int lane) {
    const int g16 = lane >> 4, i16 = lane & 15;
    const LAS unsigned char* p = img + (k0 + 8 * (g16 >> 1) + (i16 >> 2)) * IP + (c0 + 16 * (g16 & 1) + 4 * (i16 & 3)) * 2;
    const s16x4 lo = vtr(p), hi4 = vtr(p + 4 * IP);
    return __builtin_shufflevector(lo, hi4, 0, 1, 2, 3, 4, 5, 6, 7);
}
__device__ __forceinline__ bf16x8 colfrag_perm(const LAS unsigned char* img, int c0, int k0, int lane) {
    const int g16 = lane >> 4, i16 = lane & 15;
    const LAS unsigned char* p = img + (k0 + 4 * (g16 >> 1) + (i16 >> 2)) * IP + (c0 + 16 * (g16 & 1) + 4 * (i16 & 3)) * 2;
    const s16x4 lo = vtr(p), hi4 = vtr(p + 8 * IP);
    return __builtin_shufflevector(lo, hi4, 0, 1, 2, 3, 4, 5, 6, 7);
}
__device__ __forceinline__ bf16x8 rowfrag_f32(const LAS float* img, int r0, int k0, int r32, int hi) {
    const LAS f32x4* p = (const LAS f32x4*)(img + (r0 + r32) * 64 + k0 + 8 * hi); const f32x4 a = p[0], b = p[1];
    u32x4 w; w.x = pk2(a[0], a[1]); w.y = pk2(a[2], a[3]); w.z = pk2(b[0], b[1]); w.w = pk2(b[2], b[3]); return __builtin_bit_cast(bf16x8, w);
}
__device__ __forceinline__ void store_T(LAS unsigned char* imgT, const f32x16& c, int r0, int c0, int r32, int hi) {
#pragma unroll
    for (int g = 0; g < 4; ++g) { u32x2 w; w.x = pk2(c[4 * g], c[4 * g + 1]); w.y = pk2(c[4 * g + 2], c[4 * g + 3]); *(LAS u32x2*)(imgT + (c0 + r32) * IP + (r0 + 8 * g + 4 * hi) * 2) = w; }
}
__device__ __forceinline__ void store_T_global(GAS bf16_t* gT  , const f32x16& c, int r0, int c0, int r32, int hi) {
#pragma unroll
    for (int g = 0; g < 4; ++g) { u32x2 w; w.x = pk2(c[4 * g], c[4 * g + 1]); w.y = pk2(c[4 * g + 2], c[4 * g + 3]); *(GAS u32x2*)(gT + (c0 + r32) * 64 + r0 + 8 * g + 4 * hi) = w; }
}
__device__ __forceinline__ f32x16 zero16() { f32x16 z;
#pragma unroll
    for (int i = 0; i < 16; ++i) z[i] = 0.f;
    return z; }
#define WSYNC() asm volatile("s_waitcnt lgkmcnt(0)" ::: "memory")
#define BAR() do { asm volatile("s_waitcnt lgkmcnt(0)" ::: "memory"); __syncthreads(); } while (0)

__device__ __forceinline__ void rwkv_chunk_unit(const MixArgs& a, const RArgs& ra, unsigned char* ldsb, int b, int h, int ck) {
    const int tid = opaque_tid(), lane = tid & 63, wave = __builtin_amdgcn_readfirstlane(tid >> 6), r32 = lane & 31, hi = lane >> 5;
    LAS unsigned char* L = (LAS unsigned char*)ldsb;
    LAS float* fETA = (LAS float*)(L + F_AAB); LAS float* fAAB = fETA; LAS float* fLG = (LAS float*)(L + F_LG); LAS float* fTOT = (LAS float*)(L + F_TOT);
    const int t0 = ck * 64;
    const size_t row0 = (size_t)b * SEQ + t0;
    const int unit = (b * 6 + h) * 32 + ck;
    const int et = tid >> 3, ec = (tid & 7) * 8, hc = h * 64 + ec;
    float r8[8], k8[8];
    {
        const GAS bf16_t* zr = (const GAS bf16_t*)a.Z + (row0 + et) * ZP; const bool hp = (t0 + et) > 0;
        auto mix8 = [&](int col, float* out) {
            const u32x4 cw = *(const GAS u32x4*)(zr + col); u32x4 pw; pw.x = pw.y = pw.z = pw.w = 0u; if (hp) pw = *(const GAS u32x4*)(zr - ZP + col);
            const f32x4 m0 = *(const f32x4*)(ra.mu + col), m1 = *(const f32x4*)(ra.mu + col + 4);
            const float cv[8] = {bflo(cw.x), bfhi(cw.x), bflo(cw.y), bfhi(cw.y), bflo(cw.z), bfhi(cw.z), bflo(cw.w), bfhi(cw.w)};
            const float pv[8] = {bflo(pw.x), bfhi(pw.x), bflo(pw.y), bfhi(pw.y), bflo(pw.z), bfhi(pw.z), bflo(pw.w), bfhi(pw.w)};
            const float mv[8] = {m0[0], m0[1], m0[2], m0[3], m1[0], m1[1], m1[2], m1[3]};
#pragma unroll
            for (int i = 0; i < 8; ++i) out[i] = cv[i] + (pv[i] - cv[i]) * mv[i];
        };
        float v8[8], wd8[8], ad8[8];
        mix8(ZA_R + hc, r8); mix8(ZA_K + hc, k8); mix8(ZA_V + hc, v8); mix8(ZA_WD + ec, wd8); mix8(ZA_AD + ec, ad8);
#pragma unroll
        for (int i = 0; i < 8; ++i) wd8[i] = tanhf(wd8[i]);
        u32x4 w;
        w.x = pk2(wd8[0], wd8[1]); w.y = pk2(wd8[2], wd8[3]); w.z = pk2(wd8[4], wd8[5]); w.w = pk2(wd8[6], wd8[7]); *(LAS u32x4*)(L + S_WD + et * IP + ec * 2) = w;
        w.x = pk2(ad8[0], ad8[1]); w.y = pk2(ad8[2], ad8[3]); w.z = pk2(ad8[4], ad8[5]); w.w = pk2(ad8[6], ad8[7]); *(LAS u32x4*)(L + S_AD + et * IP + ec * 2) = w;
        w.x = pk2(v8[0], v8[1]); w.y = pk2(v8[2], v8[3]); w.z = pk2(v8[4], v8[5]); w.w = pk2(v8[6], v8[7]); *(LAS u32x4*)(L + S_V + et * IP + ec * 2) = w;
    }
    BAR();
    const int q = wave & 3, tr = q >> 1, tc = q & 1, grp = wave >> 2;
    {
        const LAS unsigned char* Aimg = L + (grp ? S_AD : S_WD);
        const GAS bf16_t* Bg = (const GAS bf16_t*)(grp ? ra.aupT : ra.wupT) + (size_t)(h * 64 + 32 * tc + r32) * 64 + 8 * hi;
        f32x16 acc = zero16();
#pragma unroll
        for (int s = 0; s < 4; ++s) acc = MFMA32(rowfrag(Aimg, 32 * tr, 16 * s, r32, hi), *(const GAS bf16x8*)(Bg + 16 * s), acc);
        const int c = 32 * tc + r32; const float bias = grp ? ra.a0[h * 64 + c] : ra.w0[h * 64 + c];
        if (grp == 0) {
            float x[16], gs[4];
#pragma unroll
            for (int i = 0; i < 16; ++i) x[i] = -DECAY_SCALE * sigmoidf_(acc[i] + bias);
#pragma unroll
            for (int g = 0; g < 4; ++g) gs[g] = (x[4 * g] + x[4 * g + 1]) + (x[4 * g + 2] + x[4 * g + 3]);
            float run = 0.f;
#pragma unroll
            for (int g = 0; g < 4; ++g) { const float other = __shfl_xor(gs[g], 32); float base = run + (hi ? other : 0.f); run += gs[g] + other;
#pragma unroll
                for (int j = 0; j < 4; ++j) { base += x[4 * g + j]; fLG[(32 * tr + 8 * g + 4 * hi + j) * 64 + c] = base; } }
            if (tr == 0 && hi == 0) fTOT[c] = run;
        } else {
#pragma unroll
            for (int i = 0; i < 16; ++i) fETA[(32 * tr + (i & 3) + 8 * (i >> 2) + 4 * hi) * 64 + c] = sigmoidf_(acc[i] + bias);
        }
    }
    BAR();
    {
        const f32x4 l0 = *(const LAS f32x4*)(fLG + et * 64 + ec), l1 = *(const LAS f32x4*)(fLG + et * 64 + ec + 4);
        f32x4 p0 = {0.f, 0.f, 0.f, 0.f}, p1 = p0; if (et > 0) { p0 = *(const LAS f32x4*)(fLG + (et - 1) * 64 + ec); p1 = *(const LAS f32x4*)(fLG + (et - 1) * 64 + ec + 4); }
        const f32x4 e0 = *(const LAS f32x4*)(fETA + et * 64 + ec), e1 = *(const LAS f32x4*)(fETA + et * 64 + ec + 4);
        const f32x4 z0 = *(const LAS f32x4*)(fLG + 63 * 64 + ec), z1 = *(const LAS f32x4*)(fLG + 63 * 64 + ec + 4);
        const f32x4 u0 = *(const LAS f32x4*)(fTOT + ec), u1 = *(const LAS f32x4*)(fTOT + ec + 4);
        float lg[8] = {l0[0], l0[1], l0[2], l0[3], l1[0], l1[1], l1[2], l1[3]}, lp[8] = {p0[0], p0[1], p0[2], p0[3], p1[0], p1[1], p1[2], p1[3]};
        const float eta[8] = {e0[0], e0[1], e0[2], e0[3], e1[0], e1[1], e1[2], e1[3]}, tot[8] = {u0[0], u0[1], u0[2], u0[3], u1[0], u1[1], u1[2], u1[3]};
        float lC[8] = {z0[0], z0[1], z0[2], z0[3], z1[0], z1[1], z1[2], z1[3]};
        float kk[8], kp[8], ss = 0.f, bsum = 0.f;
#pragma unroll
        for (int i = 0; i < 8; ++i) {
            if (et >= 32) lg[i] += tot[i]; if (et >= 33) lp[i] += tot[i]; lC[i] += tot[i];
            kk[i] = k8[i] * ra.k_k[hc + i]; ss += kk[i] * kk[i];
            kp[i] = k8[i] * (1.f + (eta[i] - 1.f) * ra.k_a[hc + i]); bsum += r8[i] * kp[i] * ra.r_k[hc + i];
        }
        ss += __shfl_xor(ss, 1); ss += __shfl_xor(ss, 2); ss += __shfl_xor(ss, 4);
        bsum += __shfl_xor(bsum, 1); bsum += __shfl_xor(bsum, 2); bsum += __shfl_xor(bsum, 4);
        const float rn = 1.0f / fmaxf(sqrtf(ss), 1e-12f);
        if ((tid & 7) == 0) ra.RB[(row0 + et) * 8 + h] = bsum;
        float at[8], bh[8], kh[8], rt[8], kb[8], bb[8];
#pragma unroll
        for (int i = 0; i < 8; ++i) {
            const float kn = kk[i] * rn, bv = kn * eta[i];
            const float ig = __expf(-lg[i]), gC = __expf(lC[i] - lg[i]);
            at[i] = -kn * __expf(lp[i]); bh[i] = bv * ig; kh[i] = kp[i] * ig; rt[i] = r8[i] * __expf(lg[i]); kb[i] = kp[i] * gC; bb[i] = bv * gC;
        }
        if (et == 63) { f32x4 g0 = {__expf(lC[0]), __expf(lC[1]), __expf(lC[2]), __expf(lC[3])}, g1 = {__expf(lC[4]), __expf(lC[5]), __expf(lC[6]), __expf(lC[7])};
            *(f32x4*)(ra.RG + (size_t)unit * 64 + ec) = g0; *(f32x4*)(ra.RG + (size_t)unit * 64 + ec + 4) = g1; }
        auto put = [&](int slot, const float* v) { u32x4 w; w.x = pk2(v[0], v[1]); w.y = pk2(v[2], v[3]); w.z = pk2(v[4], v[5]); w.w = pk2(v[6], v[7]); *(LAS u32x4*)(L + slot + et * IP + ec * 2) = w; };
        put(S_AT, at); put(S_BH, bh); put(S_KH, kh); put(S_RT, rt); put(S_KB, kb); put(S_BB, bb);
    }
    BAR();
    {
        const LAS unsigned char* Aimg = L + (grp ? S_RT : S_AT);
        f32x16 c1 = zero16(), c2 = zero16();
        if (!(tr == 0 && tc == 1)) {
#pragma unroll
            for (int s = 0; s < 4; ++s) { const bf16x8 af = rowfrag(Aimg, 32 * tr, 16 * s, r32, hi);
                c1 = MFMA32(af, rowfrag(L + S_BH, 32 * tc, 16 * s, r32, hi), c1); c2 = MFMA32(af, rowfrag(L + S_KH, 32 * tc, 16 * s, r32, hi), c2); }
        }
        const int ci = 32 * tc + r32;
#pragma unroll
        for (int i = 0; i < 16; ++i) { const int t = 32 * tr + (i & 3) + 8 * (i >> 2) + 4 * hi; const bool keep = grp ? (ci <= t) : (ci < t); if (!keep) { c1[i] = 0.f; c2[i] = 0.f; } }
        if (grp == 0) {
#pragma unroll
            for (int i = 0; i < 16; ++i) fAAB[(32 * tr + (i & 3) + 8 * (i >> 2) + 4 * hi) * 64 + ci] = c1[i];
            store_T(L + S_AAK, c2, 32 * tr, 32 * tc, r32, hi);
        } else { store_T(L + S_ARB, c1, 32 * tr, 32 * tc, r32, hi); store_T(L + S_ARK, c2, 32 * tr, 32 * tc, r32, hi); }
    }
    BAR();
    f32x16 nacc = zero16(), yacc = zero16();
    if (grp == 0) {
        const int bk = wave;
        float d[16];
        if (lane < 16) {
#pragma unroll
            for (int t = 0; t < 16; ++t) { float s = (t == lane) ? 1.f : 0.f;
#pragma unroll
                for (int i = 0; i < 16; ++i) if (i < t) s += fAAB[(16 * bk + t) * 64 + 16 * bk + i] * d[i];
                d[t] = s; }
        }
        if (lane < 16) {
            LAS unsigned char* rowp = L + S_TT + (16 * bk + lane) * IP;
#pragma unroll
            for (int cb = 0; cb < 4; ++cb) { u32x4 w0, w1;
                if (cb == bk) { w0.x = pk2(d[0], d[1]); w0.y = pk2(d[2], d[3]); w0.z = pk2(d[4], d[5]); w0.w = pk2(d[6], d[7]); w1.x = pk2(d[8], d[9]); w1.y = pk2(d[10], d[11]); w1.z = pk2(d[12], d[13]); w1.w = pk2(d[14], d[15]); }
                else { w0.x = w0.y = w0.z = w0.w = 0u; w1 = w0; }
                *(LAS u32x4*)(rowp + cb * 32) = w0; *(LAS u32x4*)(rowp + cb * 32 + 16) = w1; }
        }
    } else {
        f32x16 c = zero16();
#pragma unroll
        for (int s = 0; s < 4; ++s) c = MFMA32(colfrag(L + S_AAK, 32 * tr, 16 * s, lane), colfrag(L + S_V, 32 * tc, 16 * s, lane), c);
        store_T(L + S_W1, c, 32 * tr, 32 * tc, r32, hi);
    }
    BAR();
    if (grp == 0) {
        if (wave < 2) { const int p = 2 * wave;
            f32x16 x = MFMA32(rowfrag_f32(fAAB, 16 * (p + 1), 16 * p, r32, hi), rowfrag(L + S_TT, 16 * p, 16 * p, r32, hi), zero16());
            u32x4 xw; xw.x = pk2(x[0], x[1]); xw.y = pk2(x[2], x[3]); xw.z = pk2(x[4], x[5]); xw.w = pk2(x[6], x[7]);
            const f32x16 tb = MFMA32(colfrag_perm(L + S_TT, 16 * (p + 1), 16 * (p + 1), lane), __builtin_bit_cast(bf16x8, xw), zero16());
            if (r32 < 16) {
#pragma unroll
                for (int g = 0; g < 2; ++g) { u32x2 w; w.x = pk2(tb[4 * g], tb[4 * g + 1]); w.y = pk2(tb[4 * g + 2], tb[4 * g + 3]); *(LAS u32x2*)(L + S_TT + (16 * p + r32) * IP + (16 * (p + 1) + 8 * g + 4 * hi) * 2) = w; } }
        }
    } else {
#pragma unroll
        for (int s = 0; s < 4; ++s) { const bf16x8 vf = colfrag(L + S_V, 32 * tr, 16 * s, lane);
            nacc = MFMA32(vf, colfrag(L + S_KB, 32 * tc, 16 * s, lane), nacc); yacc = MFMA32(vf, colfrag(L + S_ARK, 32 * tc, 16 * s, lane), yacc); }
    }
    BAR();
    if (wave == 0) {
        f32x16 x = zero16();
#pragma unroll
        for (int s = 0; s < 2; ++s) x = MFMA32(rowfrag_f32(fAAB, 32, 16 * s, r32, hi), rowfrag(L + S_TT, 0, 16 * s, r32, hi), x);
        f32x16 tb = zero16();
#pragma unroll
        for (int s = 0; s < 2; ++s) { u32x4 xw; xw.x = pk2(x[8 * s], x[8 * s + 1]); xw.y = pk2(x[8 * s + 2], x[8 * s + 3]); xw.z = pk2(x[8 * s + 4], x[8 * s + 5]); xw.w = pk2(x[8 * s + 6], x[8 * s + 7]);
            tb = MFMA32(colfrag_perm(L + S_TT, 32, 32 + 16 * s, lane), __builtin_bit_cast(bf16x8, xw), tb); }
        store_T(L + S_TT, tb, 32, 0, r32, hi);
    }
    BAR();
    {
        f32x16 c = zero16();
#pragma unroll
        for (int s = 0; s < 4; ++s) { const bf16x8 tf = colfrag(L + S_TT, 32 * tr, 16 * s, lane);
            c = MFMA32(tf, grp ? rowfrag(L + S_W1, 32 * tc, 16 * s, r32, hi) : colfrag(L + S_AT, 32 * tc, 16 * s, lane), c); }
        store_T(L + (grp ? S_UV : S_AH), c, 32 * tr, 32 * tc, r32, hi);
    }
    BAR();
    {
        const LAS unsigned char* Aimg = L + (grp ? S_UV : S_AH);
        f32x16 c1 = grp ? nacc : zero16(), c2 = grp ? yacc : zero16();
#pragma unroll
        for (int s = 0; s < 4; ++s) { const bf16x8 af = rowfrag(Aimg, 32 * tr, 16 * s, r32, hi);
            c1 = MFMA32(af, colfrag(L + S_BB, 32 * tc, 16 * s, lane), c1); c2 = MFMA32(af, colfrag(L + S_ARB, 32 * tc, 16 * s, lane), c2); }
        GAS bf16_t* gq = (GAS bf16_t*)ra.RQ + (size_t)unit * 4096; GAS bf16_t* gm = (GAS bf16_t*)ra.RM + (size_t)unit * 4096; GAS bf16_t* gn = (GAS bf16_t*)ra.RN + (size_t)unit * 4096;
        if (grp == 0) {
            store_T_global(gm, c1, 32 * tr, 32 * tc, r32, hi);
#pragma unroll
            for (int g = 0; g < 4; ++g) { const u32x2 w = *(const LAS u32x2*)(L + S_RT + (32 * tc + r32) * IP + (32 * tr + 8 * g + 4 * hi) * 2);
                c2[4 * g] += bflo(w.x); c2[4 * g + 1] += bfhi(w.x); c2[4 * g + 2] += bflo(w.y); c2[4 * g + 3] += bfhi(w.y); }
            store_T_global(gq, c2, 32 * tr, 32 * tc, r32, hi);
        } else {
            store_T_global(gn, c1, 32 * tr, 32 * tc, r32, hi);
            GAS bf16_t* yp = (GAS bf16_t*)a.Y + (row0 + 32 * tc + r32) * DM + h * 64 + 32 * tr;
#pragma unroll
            for (int g = 0; g < 4; ++g) { u32x2 w; w.x = pk2(c2[4 * g], c2[4 * g + 1]); w.y = pk2(c2[4 * g + 2], c2[4 * g + 3]); *(GAS u32x2*)(yp + 8 * g + 4 * hi) = w; }
        }
    }
    BAR();
}

__device__ __forceinline__ void rwkv_scan_chain(const MixArgs& a, const RArgs& ra, unsigned char* ldsb, int b, int h) {
    const int tid = opaque_tid(), lane = tid & 63, wave = __builtin_amdgcn_readfirstlane(tid >> 6), r32 = lane & 31, hi = lane >> 5;
    LAS unsigned char* L = (LAS unsigned char*)ldsb;
    const int q = wave & 3, tr = q >> 1, tc = q & 1;
    f32x16 st = zero16();
    for (int i = tid; i < 2 * IMG / 16; i += 512) { u32x4 z; z.x = z.y = z.z = z.w = 0u; *(LAS u32x4*)(L + i * 16) = z; }
    BAR();
    const int ubase = (b * 6 + h) * 32;
    const size_t rowb = (size_t)b * SEQ;
#pragma unroll 1
    for (int ck = 0; ck < 32; ++ck) {
        const LAS unsigned char* Simg = L + (ck & 1) * IMG; LAS unsigned char* Snew = L + ((ck + 1) & 1) * IMG;
        const int unit = ubase + ck;
        if (wave < 4) {
            const GAS bf16_t* gm = (const GAS bf16_t*)ra.RM + (size_t)unit * 4096 + (32 * tc + r32) * 64 + 8 * hi;
            const GAS bf16_t* gn = (const GAS bf16_t*)ra.RN + (size_t)unit * 4096 + (32 * tc + r32) * 64 + 32 * tr + 4 * hi;
            bf16x8 bm[4];
#pragma unroll
            for (int s = 0; s < 4; ++s) bm[s] = *(const GAS bf16x8*)(gm + 16 * s);
            u32x2 nw[4];
#pragma unroll
            for (int g = 0; g < 4; ++g) nw[g] = *(const GAS u32x2*)(gn + 8 * g);
            const float gc = ra.RG[(size_t)unit * 64 + 32 * tc + r32];
            f32x16 acc;
#pragma unroll
            for (int g = 0; g < 4; ++g) { acc[4 * g] = st[4 * g] * gc + bflo(nw[g].x); acc[4 * g + 1] = st[4 * g + 1] * gc + bfhi(nw[g].x); acc[4 * g + 2] = st[4 * g + 2] * gc + bflo(nw[g].y); acc[4 * g + 3] = st[4 * g + 3] * gc + bfhi(nw[g].y); }
#pragma unroll
            for (int s = 0; s < 4; ++s) acc = MFMA32(colfrag(Simg, 32 * tr, 16 * s, lane), bm[s], acc);
            st = acc;
            store_T(Snew, st, 32 * tr, 32 * tc, r32, hi);
        } else if (wave < 6) {
            const int tw = wave - 4; const size_t trow = rowb + ck * 64 + 32 * tw + r32;
            const GAS bf16_t* gq = (const GAS bf16_t*)ra.RQ + (size_t)unit * 4096 + (32 * tw + r32) * 64 + 8 * hi;
            bf16x8 bq[4];
#pragma unroll
            for (int s = 0; s < 4; ++s) bq[s] = *(const GAS bf16x8*)(gq + 16 * s);
            GAS bf16_t* yp = (GAS bf16_t*)a.Y + trow * DM + h * 64;
            f32x16 y0, y1;
#pragma unroll
            for (int g = 0; g < 4; ++g) { const u32x2 w0 = *(const GAS u32x2*)(yp + 8 * g + 4 * hi), w1 = *(const GAS u32x2*)(yp + 32 + 8 * g + 4 * hi);
                y0[4 * g] = bflo(w0.x); y0[4 * g + 1] = bfhi(w0.x); y0[4 * g + 2] = bflo(w0.y); y0[4 * g + 3] = bfhi(w0.y);
                y1[4 * g] = bflo(w1.x); y1[4 * g + 1] = bfhi(w1.x); y1[4 * g + 2] = bflo(w1.y); y1[4 * g + 3] = bfhi(w1.y); }
#pragma unroll
            for (int s = 0; s < 4; ++s) { y0 = MFMA32(colfrag(Simg, 0, 16 * s, lane), bq[s], y0); y1 = MFMA32(colfrag(Simg, 32, 16 * s, lane), bq[s], y1); }
            float sm = 0.f;
#pragma unroll
            for (int i = 0; i < 16; ++i) sm += y0[i] + y1[i];
            sm += __shfl_xor(sm, 32); const float mean = sm * (1.f / 64.f);
            float sq = 0.f;
#pragma unroll
            for (int i = 0; i < 16; ++i) { const float d0 = y0[i] - mean, d1 = y1[i] - mean; sq += d0 * d0 + d1 * d1; }
            sq += __shfl_xor(sq, 32); const float rstd = 1.0f / sqrtf(sq * (1.f / 64.f) + GN_EPS);
            const float beta = ra.RB[trow * 8 + h];
            const GAS bf16_t* zr = (const GAS bf16_t*)a.Z + trow * ZP; const bool hp = (ck * 64 + 32 * tw + r32) > 0;
#pragma unroll
            for (int half = 0; half < 2; ++half)
#pragma unroll
                for (int g = 0; g < 4; ++g) {
                    const int v0 = 32 * half + 8 * g + 4 * hi, hc = h * 64 + v0;
                    const u32x2 vc = *(const GAS u32x2*)(zr + ZA_V + hc), gcw = *(const GAS u32x2*)(zr + ZA_G + hc);
                    u32x2 vp, gp; vp.x = vp.y = gp.x = gp.y = 0u; if (hp) { vp = *(const GAS u32x2*)(zr - ZP + ZA_V + hc); gp = *(const GAS u32x2*)(zr - ZP + ZA_G + hc); }
                    const f32x4 muv = *(const f32x4*)(ra.mu + ZA_V + hc), mug = *(const f32x4*)(ra.mu + ZA_G + hc), lg4 = *(const f32x4*)(ra.ln_g + hc), lb4 = *(const f32x4*)(ra.ln_b + hc);
                    const float vcur[4] = {bflo(vc.x), bfhi(vc.x), bflo(vc.y), bfhi(vc.y)}, vprv[4] = {bflo(vp.x), bfhi(vp.x), bflo(vp.y), bfhi(vp.y)};
                    const float gcur[4] = {bflo(gcw.x), bfhi(gcw.x), bflo(gcw.y), bfhi(gcw.y)}, gprv[4] = {bflo(gp.x), bfhi(gp.x), bflo(gp.y), bfhi(gp.y)};
                    float o[4];
#pragma unroll
                    for (int j = 0; j < 4; ++j) { const float vv = vcur[j] + (vprv[j] - vcur[j]) * muv[j], gg = gcur[j] + (gprv[j] - gcur[j]) * mug[j];
                        const float yv = half ? y1[4 * g + j] : y0[4 * g + j];
                        o[j] = ((yv - mean) * rstd * lg4[j] + lb4[j] + beta * vv) * gg * sigmoidf_(gg); }
                    u32x2 w; w.x = pk2(o[0], o[1]); w.y = pk2(o[2], o[3]); *(GAS u32x2*)(yp + v0) = w;
                }
        }
        BAR();
    }
}
}
constexpr int NWAVES = 8;
constexpr int RING_BYTES = 131072, LDSCTL_OFF = RING_BYTES, LDS_BYTES = 147456;
constexpr int CW_BAR = 4096;
struct Args { const float* in[19]; float* out; unsigned char* ws; };

__global__ void __launch_bounds__(NWAVES * 64, 2) mega_fwd(Args args) {
    extern __shared__ __attribute__((aligned(16))) unsigned char lds[];
    const int tid = threadIdx.x, lane = tid & 63, wave = __builtin_amdgcn_readfirstlane(tid >> 6);
    const int G = gridDim.x, bx = blockIdx.x;
    unsigned char* ws = args.ws;
    volatile LAS unsigned* MISC = (volatile LAS unsigned*)((LAS unsigned char*)lds + LDSCTL_OFF);
    for (int u = tid; u < (LDS_BYTES - LDSCTL_OFF) / 4; u += NWAVES * 64) ((LAS unsigned*)((LAS unsigned char*)lds + LDSCTL_OFF))[u] = 0u;
    __syncthreads();
    (void)xcd_barrier_post((unsigned*)(ws + WS_CTL) + CW_BAR, MISC + 8);
    volatile LAS unsigned long long* PTRS = (volatile LAS unsigned long long*)((LAS unsigned char*)lds + LDSCTL_OFF + 256);
    if (tid < 19) PTRS[tid] = (unsigned long long)(uintptr_t)args.in[tid];
    if (tid == 19) PTRS[19] = (unsigned long long)(uintptr_t)args.out;
    if (tid == 20) PTRS[20] = (unsigned long long)(uintptr_t)args.ws;
    __syncthreads();
#define ARGP(i) ((const float*)(uintptr_t)PTRS[i])
#define OUTP ((float*)(uintptr_t)PTRS[19])
#define WSP ((unsigned char*)(uintptr_t)PTRS[20])
#define GRID_BAR() do { XcdBarrier b_; b_.bar = (unsigned*)(WSP + WS_CTL) + CW_BAR; b_.x = xb_xcc_id(); b_.st = (volatile LAS unsigned*)((LAS unsigned char*)lds + LDSCTL_OFF) + 8; xcd_barrier(b_); } while (0)
    const int gw = bx * NWAVES + wave, ngw = G * NWAVES;
    int K1024 = DM, K256 = 256; asm volatile("" : "+s"(K1024), "+s"(K256));
    {
        const float* x = args.in[0]; bf16_t* bufA = (bf16_t*)(ws + WS_BUFA); float* ssqA = (float*)(ws + WS_SSQA);
        PrepArgs pa; pa.w_in = args.in[3]; pa.norm_g = args.in[2]; pa.w_out = args.in[14]; pa.ple_g = args.in[15]; pa.w_gate = args.in[16]; pa.w_proj = args.in[17]; pa.w_up = args.in[6]; pa.a_up = args.in[8]; pa.ws = ws;
        prep_tables(ws, bx * NWAVES * 64 + tid, G * NWAVES * 64);
        prep_weights(pa, gw, ngw, (LAS float*)((LAS unsigned char*)lds + wave * 16384), lane);
        for (int m = gw; m < MTOK; m += ngw) x_row_to_bf16(x + (size_t)m * DM, bufA + (size_t)m * DM, ssqA + (size_t)m * 16, lane);
    }
    GRID_BAR();
    for (int L = 0; L < DEPTH; ++L) {
#define PHASE_PTRS unsigned char* ws = WSP; bf16_t* cur = (bf16_t*)(ws + ((L & 1) ? WS_BUFB : WS_BUFA)); bf16_t* oth = (bf16_t*)(ws + ((L & 1) ? WS_BUFA : WS_BUFB)); const unsigned char* wl = ws + WS_W + (size_t)L * W_LAYER; \
        bf16_t* Z = (bf16_t*)(ws + WS_Z); float* PP = (float*)(ws + WS_Z); bf16_t* PB = (bf16_t*)(ws + WS_PB); float* ssqA = (float*)(ws + WS_SSQA); float* ssqB = (float*)(ws + WS_SSQB); float* out = OUTP; \
        (void)cur; (void)oth; (void)wl; (void)Z; (void)PP; (void)PB; (void)ssqA; (void)ssqB; (void)out;
        {
            PHASE_PTRS
            const float* tab16 = (const float*)(ws + WS_TAB16); const float* tabI = (const float*)(ws + WS_TABI);
            const float* src = ARGP(1) + (size_t)L * MTOK * 256; const int tid = opaque_tid();
            for (size_t i = (size_t)bx * 512 + tid; i < (size_t)MTOK * 256 / 8; i += (size_t)G * 512) {
                const f32x4 a = ((const f32x4*)src)[2 * i], b = ((const f32x4*)src)[2 * i + 1];
                u32x4 w; w.x = pk2(a.x, a.y); w.y = pk2(a.z, a.w); w.z = pk2(b.x, b.y); w.w = pk2(b.z, b.w); ((u32x4*)PB)[i] = w; }
            pg8::Gemm g{cur, (const bf16_t*)(wl + W_IN), MTOK, NPAD, K1024}; pg8::StaticOrder S; S.init(MTOK, NPAD, G, bx);
            epi::EpiInProj e; e.Z = Z; e.ssq = ssqA; e.tab16 = tab16; e.tabI = tabI;
            pg8::gemm_phase<epi::EpiInProj, pg8::StaticOrder, true, true>((PG8_LAS unsigned char*)lds, g, S, e);
        }
        GRID_BAR();
        {
            PHASE_PTRS
            MixArgs ma; ma.Z = Z; ma.Y = oth; ma.mu = ARGP(4) + L * 1664; ma.w0 = ARGP(5) + L * 384; ma.w_up = ARGP(6) + (size_t)L * 64 * 384; ma.a0 = ARGP(7) + L * 384; ma.a_up = ARGP(8) + (size_t)L * 64 * 384;
            ma.k_k = ARGP(9) + L * 384; ma.k_a = ARGP(10) + L * 384; ma.r_k = ARGP(11) + L * 384; ma.ln_g = ARGP(12) + L * 384; ma.ln_b = ARGP(13) + L * 384;
            rwkv::RArgs ra; ra.mu = ma.mu; ra.w0 = ma.w0; ra.a0 = ma.a0; ra.k_k = ma.k_k; ra.k_a = ma.k_a; ra.r_k = ma.r_k; ra.ln_g = ma.ln_g; ra.ln_b = ma.ln_b;
            ra.wupT = (const bf16_t*)(wl + W_WUPT); ra.aupT = (const bf16_t*)(wl + W_AUPT); ra.RQ = cur; ra.RM = cur + (size_t)3072 * 4096; ra.RN = (bf16_t*)(ws + WS_MISC + MISC_RN); ra.RG = (float*)(ws + WS_MISC + MISC_RG); ra.RB = (float*)(ws + WS_MISC + MISC_RB);
            for (int u = bx; u < 3072; u += G) rwkv::rwkv_chunk_unit(ma, ra, lds, u / 192, (u / 32) % 6, u & 31);
            for (int u = bx; u < 256; u += G) { dsa::dsa_unit(ma, lds, u >> 4, u & 15); dsa::dsa_unit(ma, lds, u >> 4, 31 - (u & 15)); }
            __syncthreads();
            float* LQ = (float*)(ws + WS_MISC);
            for (int u = bx; u < 768; u += G) dil::dil_unit(ma, LQ, lds, u / 48, (u % 48) >> 4, u & 15);
        }
        GRID_BAR();
        {
            PHASE_PTRS
            MixArgs ma; ma.Z = Z; ma.Y = oth; const float* LQ = (const float*)(ws + WS_MISC); const int lane = opaque_tid() & 63;
            rwkv::RArgs ra; ra.mu = ARGP(4) + L * 1664; ra.ln_g = ARGP(12) + L * 384; ra.ln_b = ARGP(13) + L * 384;
            ra.RQ = cur; ra.RM = cur + (size_t)3072 * 4096; ra.RN = (bf16_t*)(ws + WS_MISC + MISC_RN); ra.RG = (float*)(ws + WS_MISC + MISC_RG); ra.RB = (float*)(ws + WS_MISC + MISC_RB);
            for (int u = bx; u < 96; u += G) rwkv::rwkv_scan_chain(ma, ra, lds, u / 6, u % 6);
            for (int m = gw; m < MTOK; m += ngw) dil::dil_merge_row(ma, LQ, (size_t)m, lane);
        }
        GRID_BAR();
        {
            PHASE_PTRS
            const float* x = ARGP(0);
            pg8::Gemm g{oth, (const bf16_t*)(wl + W_OUT), MTOK, DM, K1024}; pg8::StaticOrder S; S.init(MTOK, DM, G, bx);
            epi::EpiOutProj e; e.xin = (L == 0) ? x : out; e.xout = out; e.xb = cur; e.ssq_out = ssqB;
            pg8::gemm_phase<epi::EpiOutProj, pg8::StaticOrder, true, true>((PG8_LAS unsigned char*)lds, g, S, e);
            pg8::Gemm g2{PB, (const bf16_t*)(wl + W_PROJ), MTOK, DM, K256};
            epi::EpiF32 e2; e2.C = PP;
            pg8::gemm_phase<epi::EpiF32, pg8::StaticOrder, true, true>((PG8_LAS unsigned char*)lds, g2, S, e2);
        }
        GRID_BAR();
        {
            PHASE_PTRS
            pg8::Gemm g{cur, (const bf16_t*)(wl + W_GATE), MTOK, DM, K1024}; pg8::StaticOrder S; S.init(MTOK, DM, G, bx);
            epi::EpiGate e; e.xio = out; e.pp = PP; e.xb = oth; e.ssq_in = ssqB; e.ssq_out = ssqA;
            pg8::gemm_phase<epi::EpiGate, pg8::StaticOrder, true, true>((PG8_LAS unsigned char*)lds, g, S, e);
        }
        GRID_BAR();
    }
    {
        const int L = 0; PHASE_PTRS
        const float* fg = ARGP(18); const int lane = opaque_tid() & 63;
        for (int m = gw; m < MTOK; m += ngw) { const float rs = row_rstd(ssqA + (size_t)m * 16); f32x4* xr = (f32x4*)(out + (size_t)m * DM) + lane;
#pragma unroll
            for (int j = 0; j < 4; ++j) { const f32x4 gv = ((const f32x4*)fg)[64 * j + lane]; xr[64 * j] = xr[64 * j] * rs * gv; } }
    }
}

extern "C" void kernel_launch(void* const* d_in, const int* in_sizes, int n_in, void* d_out, int out_size, void* d_ws, size_t ws_size, hipStream_t stream) {
    static int grid = 0;
    if (grid == 0) {
        if (n_in != 19 || out_size != MTOK * DM || ws_size < WS_END) { fprintf(stderr, "kernel_launch: unexpected shapes n_in %d out %d ws %zu\n", n_in, out_size, ws_size); grid = -1; return; }
        int dev = 0, cus = 0, per_cu = 0;
        if (hipGetDevice(&dev) != hipSuccess || hipDeviceGetAttribute(&cus, hipDeviceAttributeMultiprocessorCount, dev) != hipSuccess) { grid = -1; return; }
        if (hipFuncSetAttribute((const void*)mega_fwd, hipFuncAttributeMaxDynamicSharedMemorySize, LDS_BYTES) != hipSuccess) { fprintf(stderr, "kernel_launch: hipFuncSetAttribute failed\n"); grid = -1; return; }
        if (hipOccupancyMaxActiveBlocksPerMultiprocessor(&per_cu, (const void*)mega_fwd, NWAVES * 64, LDS_BYTES) != hipSuccess || per_cu < 1) { fprintf(stderr, "kernel_launch: occupancy query says %d blocks per CU\n", per_cu); (void)hipGetLastError(); grid = -1; return; }
        grid = cus;
    }
    if (grid < 0) return;
    if (hipMemsetAsync((char*)d_ws + WS_CTL, 0, 1 * MiB, stream) != hipSuccess) return;
    Args a; memset(&a, 0, sizeof a);
    for (int i = 0; i < 19; ++i) a.in[i] = (const float*)d_in[i];
    a.out = (float*)d_out; a.ws = (unsigned char*)d_ws;
    hipLaunchKernelGGL(mega_fwd, dim3(grid), dim3(NWAVES * 64), LDS_BYTES, stream, a);
}
```

```cpp
#include <hip/hip_runtime.h>
#include <cstdio>
#include <cstdint>
#include <cmath>
#include <cstring>

constexpr int BATCH = 16, SEQ = 2048, DM = 1024, DEPTH = 4, MTOK = BATCH * SEQ;
constexpr int ZP = 4136;
constexpr int NPAD = 4352;
constexpr int ZA_R = 0, ZA_K = 384, ZA_V = 768, ZA_G = 1152, ZA_WD = 1536, ZA_AD = 1600;
constexpr int ZB_Q = 1664, ZB_K = 1920, ZB_V = 1984, ZB_IQ = 2048, ZB_IK = 2304, ZB_IW = 2336, ZB_G = 2344;
constexpr int ZC_Q = 2600, ZC_K = 2984, ZC_V = 3368, ZC_G = 3752;
constexpr float LOG2E = 1.4426950408889634f;
constexpr float QSCALE = 0.125f * LOG2E;
constexpr float IQSCALE = 0.17677669529663687f;
constexpr float IWSCALE = 0.35355339059327373f;
constexpr float NORM_EPS = 1e-6f, GN_EPS = 64e-5f;
constexpr float DECAY_SCALE = 0.6065306597126334f;

typedef unsigned short bf16_t;
typedef short bf16x8 __attribute__((ext_vector_type(8)));
typedef float f32x4 __attribute__((ext_vector_type(4)));
typedef float f32x16 __attribute__((ext_vector_type(16)));
typedef unsigned u32x4 __attribute__((ext_vector_type(4)));
typedef unsigned u32x2 __attribute__((ext_vector_type(2)));

__device__ __forceinline__ unsigned f2bf(float f) { unsigned u = __builtin_bit_cast(unsigned, f); return (u + 0x7fffu + ((u >> 16) & 1u)) >> 16; }
typedef float f32x2_t __attribute__((ext_vector_type(2))); typedef __bf16 bf16x2_t __attribute__((ext_vector_type(2)));
__device__ __forceinline__ unsigned pk2(float lo, float hi) { const f32x2_t v = {lo, hi}; return __builtin_bit_cast(unsigned, __builtin_convertvector(v, bf16x2_t)); }
__device__ __forceinline__ float bf2f(unsigned short b) { return __builtin_bit_cast(float, (unsigned)b << 16); }
__device__ __forceinline__ float bflo(unsigned w) { return __builtin_bit_cast(float, w << 16); }
__device__ __forceinline__ float bfhi(unsigned w) { return __builtin_bit_cast(float, w & 0xffff0000u); }
__device__ __forceinline__ float sigmoidf_(float x) { return __builtin_amdgcn_rcpf(1.0f + __builtin_amdgcn_exp2f(-1.4426950408889634f * x)); }
__device__ __forceinline__ float fexp_(float x) { return __builtin_amdgcn_exp2f(1.4426950408889634f * x); }
__device__ __forceinline__ float tanhf_(float x) { const float e = __builtin_amdgcn_exp2f(fminf(2.8853900817779268f * x, 60.f)); return 1.0f - 2.0f * __builtin_amdgcn_rcpf(e + 1.0f); }
__device__ __forceinline__ int opaque_tid() { int t = threadIdx.x; asm volatile("" : "+v"(t)); return t; }
__device__ __forceinline__ float wave_sum(float v) {
#pragma unroll
    for (int o = 1; o < 64; o <<= 1) v += __shfl_xor(v, o);
    return v;
}
__device__ __forceinline__ float wave_max(float v) {
#pragma unroll
    for (int o = 1; o < 64; o <<= 1) v = fmaxf(v, __shfl_xor(v, o));
    return v;
}

constexpr size_t MiB = 1u << 20;
constexpr size_t WS_CTL = 0;
constexpr size_t WS_TAB16 = 1 * MiB;
constexpr size_t WS_TABI = WS_TAB16 + 128 * 1024;
constexpr size_t WS_SSQA = WS_TABI + 64 * 1024;
constexpr size_t WS_SSQB = WS_SSQA + 2 * MiB;
constexpr size_t WS_W = 6 * MiB;
constexpr size_t W_LAYER = 14 * MiB, W_IN = 0, W_OUT = 8912896, W_GATE = W_OUT + 2 * MiB, W_PROJ = W_GATE + 2 * MiB, W_WUPT = W_PROJ + 512 * 1024, W_AUPT = W_WUPT + 48 * 1024;
constexpr size_t WS_BUFA = 62 * MiB;
constexpr size_t WS_BUFB = 126 * MiB;
constexpr size_t WS_PB = 190 * MiB;
constexpr size_t WS_Z = 206 * MiB;
constexpr size_t WS_Z_END = WS_Z + (size_t)MTOK * ZP * 2;
constexpr size_t WS_MISC = 465 * MiB;
constexpr size_t WS_END = 512 * MiB;
constexpr size_t MISC_LQ = 0, MISC_RG = 1 * MiB, MISC_RN = 2 * MiB, MISC_RB = 26 * MiB, MISC_KV = 27 * MiB, MISC_IKC = 35 * MiB;
static_assert(W_AUPT + 48 * 1024 <= W_LAYER && WS_W + 4 * W_LAYER <= WS_BUFA && WS_Z_END <= WS_MISC, "ws map");
namespace pg8 {
#define PG8_LAS __attribute__((address_space(3)))
typedef unsigned short bf16_t;
typedef short bf16x8 __attribute__((ext_vector_type(8)));
typedef float f32x4 __attribute__((ext_vector_type(4)));
typedef unsigned u32x4 __attribute__((ext_vector_type(4)));
constexpr int BM = 256, BK = 64, HALF = 128, HTB = HALF * BK * 2  , STAGE_BYTES = 8 * HTB, NXCD = 8, WGM = 8;

__host__ __device__ __forceinline__ int lds_byte(int r, int c) { const int st = (r >> 4) * 2 + (c >> 5), rr = r & 15, cc = c & 31, ob = rr * 64 + cc * 2; return st * 1024 + (ob ^ (((ob >> 9) & 1) << 5)); }
__host__ __device__ __forceinline__ void stage_rc(int b, int& R, int& C) { const int st = b / 1024, sb = b % 1024, swz = sb ^ (((sb >> 9) & 1) << 5); R = (st >> 1) * 16 + swz / 64; C = (st & 1) * 32 + (swz % 64) / 2; }
__host__ __device__ __forceinline__ int perm32(int rho) { const int n = rho >> 4, i = rho & 15; return 8 * (i >> 2) + 4 * n + (i & 3); }

struct Unit { int pm, pn; };
struct Gemm { const bf16_t* A; const bf16_t* Bt; int M, N, K; };

struct StaticOrder {
    int nM, nN, nwg, G, c;
    __host__ __device__ void init(int M, int N, int G_, int c_) { nM = M / BM; nN = N / BM; nwg = nM * nN; G = G_; c = c_; }
    __host__ __device__ bool next(int i, Unit& u) const {
        const long L = (long)i * G + c; if (L >= nwg) return false;
        int wgid = (int)L; { const int q = nwg / NXCD, r = nwg % NXCD, xcd = wgid % NXCD, off = wgid / NXCD; wgid = (xcd < r ? xcd * (q + 1) : r * (q + 1) + (xcd - r) * q) + off; }
        const int nig = WGM * nN, gid = wgid / nig, fm = gid * WGM, gsz = (nM - fm) < WGM ? (nM - fm) : WGM;
        u.pm = fm + ((wgid % nig) % gsz); u.pn = (wgid % nig) / gsz; return true;
    }
    __device__ __forceinline__ void a_ready(const Unit&) const {}
    __device__ __forceinline__ void done(const Unit&) const {}
};

__device__ __forceinline__ unsigned cvt_pk_bf16(float lo, float hi) { unsigned r; asm volatile("v_cvt_pk_bf16_f32 %0, %1, %2" : "=v"(r) : "v"(lo), "v"(hi)); return r; }
template <class Epi, class Sched, bool ALIGN_EPI = false, bool SP2 = false>
__device__ __forceinline__ void gemm_phase(PG8_LAS unsigned char* lds, const Gemm g, const Sched& S, const Epi& E) {
    int tid_ = threadIdx.x; asm volatile("" : "+v"(tid_));
    const int tid = tid_, wid = __builtin_amdgcn_readfirstlane(tid >> 6), lane = tid & 63, wr = wid >> 2, wc = wid & 3, fr = lane & 15, fq = lane >> 4;
    const int K = g.K, nt = K / BK;
    unsigned voffA[2], voffB[2];
#pragma unroll
    for (int i = 0; i < 2; ++i) { int R, C; stage_rc(tid * 16 + i * 8192, R, C); const int Rb = Epi::PERM ? ((R & ~31) + perm32(R & 31)) : R;
        voffA[i] = (unsigned)(R * K + C) * 2u; voffB[i] = (unsigned)(Rb * K + C) * 2u; }
    const size_t kstep = (size_t)(BK * 2);
    const size_t hstep = (size_t)HALF * K * 2;
    const size_t tstep = 2 * hstep;
    const unsigned ldsw = (unsigned)wid * 1024u;
    const int aoff = lds_byte(wr * 64 + fr, fq * 8), boff = lds_byte(wc * 32 + fr, fq * 8);
#define PG8_SA(b, h) (((b) * 2 + (h)) * HTB)
#define PG8_SB(b, h) ((4 + (b) * 2 + (h)) * HTB)
#define PG8_STAGE(bufoff, gbase, voff) do { _Pragma("unroll") for (int _i = 0; _i < 2; ++_i) \
        __builtin_amdgcn_global_load_lds((const unsigned*)((const char*)(gbase) + (voff)[_i]), (PG8_LAS unsigned*)(lds + (bufoff) + ldsw + _i * 8192), 16, 0, 0); } while (0)
#define PG8_LDA(dst, b, h) do { _Pragma("unroll") for (int m = 0; m < 4; ++m) _Pragma("unroll") for (int k = 0; k < 2; ++k) dst[m][k] = *(const PG8_LAS bf16x8*)(lds + PG8_SA(b, h) + aoff + m * 2048 + k * 1024); } while (0)
#define PG8_LDB(dst, b, h) do { _Pragma("unroll") for (int n = 0; n < 2; ++n) _Pragma("unroll") for (int k = 0; k < 2; ++k) dst[n][k] = *(const PG8_LAS bf16x8*)(lds + PG8_SB(b, h) + boff + n * 2048 + k * 1024); } while (0)
#define PG8_MMA(ai, bj, At, Bt) do { __builtin_amdgcn_s_setprio(1); _Pragma("unroll") for (int m = 0; m < 4; ++m) _Pragma("unroll") for (int n = 0; n < 2; ++n) _Pragma("unroll") for (int k = 0; k < 2; ++k) \
        acc[ai][bj][m][n] = __builtin_amdgcn_mfma_f32_16x16x32_bf16(Bt[n][k], At[m][k], acc[ai][bj][m][n], 0, 0, 0); __builtin_amdgcn_s_setprio(0); } while (0)
#define PG8_WAIT_V(n) asm volatile("s_waitcnt vmcnt(" #n ")" ::: "memory")
#define PG8_WAIT_L(n) asm volatile("s_waitcnt lgkmcnt(" #n ")" ::: "memory")
#define PG8_BAR __builtin_amdgcn_s_barrier()
#define PG8_SCHED __builtin_amdgcn_sched_barrier(0)
    Unit cur, nxt; int ui = 0;
    if (!S.next(0, cur)) return;
    f32x4 acc[2][2][4][2];
#pragma unroll
    for (int a = 0; a < 2; ++a)
#pragma unroll
        for (int b = 0; b < 2; ++b)
#pragma unroll
            for (int m = 0; m < 4; ++m)
#pragma unroll
                for (int n = 0; n < 2; ++n) acc[a][b][m][n] = (f32x4){0.f, 0.f, 0.f, 0.f};
    bf16x8 At[4][2], B0[2][2], B1[2][2];
    const char* cA = (const char*)g.A + (size_t)cur.pm * tstep; const char* cB = (const char*)g.Bt + (size_t)cur.pn * tstep;
    S.a_ready(cur);
    if constexpr (SP2) {
        PG8_STAGE(PG8_SB(0, 0), cB, voffB); PG8_STAGE(PG8_SB(0, 1), cB + hstep, voffB); PG8_STAGE(PG8_SA(0, 0), cA, voffA); PG8_STAGE(PG8_SA(0, 1), cA + hstep, voffA);
        if (wr == 1) PG8_BAR;
        PG8_WAIT_V(2); PG8_BAR;
        PG8_STAGE(PG8_SB(1, 0), cB + kstep, voffB); PG8_STAGE(PG8_SA(1, 0), cA + kstep, voffA); PG8_STAGE(PG8_SB(1, 1), cB + hstep + kstep, voffB);
        PG8_WAIT_V(6); PG8_BAR;
    } else {
        PG8_STAGE(PG8_SB(0, 0), cB, voffB); PG8_STAGE(PG8_SA(0, 0), cA, voffA); PG8_STAGE(PG8_SB(0, 1), cB + hstep, voffB); PG8_STAGE(PG8_SA(0, 1), cA + hstep, voffA);
        if (wr == 1) PG8_BAR;
        PG8_WAIT_V(4); PG8_BAR;
        PG8_STAGE(PG8_SB(1, 0), cB + kstep, voffB); PG8_STAGE(PG8_SA(1, 0), cA + kstep, voffA); PG8_STAGE(PG8_SB(1, 1), cB + hstep + kstep, voffB);
        PG8_WAIT_V(6); PG8_BAR;
    }
    for (;;) {
        const bool has_next = S.next(ui + 1, nxt);
        const char* nA = has_next ? (const char*)g.A + (size_t)nxt.pm * tstep : cA; const char* nB = has_next ? (const char*)g.Bt + (size_t)nxt.pn * tstep : cB;
        for (int t = 0; t < nt; t += 2) {
            const bool last = (t == nt - 2);
            const char* a1 = cA + (size_t)(t + 1) * kstep;
            const char* a2 = last ? nA : cA + (size_t)(t + 2) * kstep; const char* b2 = last ? nB : cB + (size_t)(t + 2) * kstep;
            const char* a3 = a2 + kstep; const char* b3 = b2 + kstep;
            if (last && has_next) S.a_ready(nxt);
            if constexpr (SP2) {
            PG8_LDB(B0, 0, 0); PG8_LDB(B1, 0, 1); PG8_SCHED; PG8_LDA(At, 0, 0); PG8_STAGE(PG8_SA(1, 1), a1 + hstep, voffA);
            PG8_WAIT_V(8); PG8_WAIT_L(0); PG8_BAR; PG8_MMA(0, 0, At, B0); PG8_MMA(0, 1, At, B1); PG8_BAR; PG8_SCHED;
            PG8_LDA(At, 0, 1); PG8_STAGE(PG8_SB(0, 0), b2, voffB); PG8_STAGE(PG8_SB(0, 1), b2 + hstep, voffB); PG8_STAGE(PG8_SA(0, 0), a2, voffA);
            PG8_WAIT_V(8); PG8_WAIT_L(0); PG8_BAR; PG8_MMA(1, 0, At, B0); PG8_MMA(1, 1, At, B1); PG8_BAR; PG8_SCHED;
            PG8_LDB(B0, 1, 0); PG8_LDB(B1, 1, 1); PG8_SCHED; PG8_LDA(At, 1, 0); PG8_STAGE(PG8_SA(0, 1), a2 + hstep, voffA);
            PG8_WAIT_V(8); PG8_WAIT_L(0); PG8_BAR; PG8_MMA(0, 0, At, B0); PG8_MMA(0, 1, At, B1); PG8_BAR; PG8_SCHED;
            PG8_LDA(At, 1, 1); PG8_STAGE(PG8_SB(1, 0), b3, voffB); PG8_STAGE(PG8_SB(1, 1), b3 + hstep, voffB); PG8_STAGE(PG8_SA(1, 0), a3, voffA);
            PG8_WAIT_V(8); PG8_WAIT_L(0); PG8_BAR; PG8_MMA(1, 0, At, B0); PG8_MMA(1, 1, At, B1); PG8_BAR; PG8_SCHED;
            } else {
            PG8_LDB(B0, 0, 0); PG8_SCHED; PG8_LDA(At, 0, 0); PG8_STAGE(PG8_SA(1, 1), a1 + hstep, voffA);
            PG8_WAIT_L(8); PG8_BAR; PG8_WAIT_L(0); PG8_MMA(0, 0, At, B0); PG8_BAR; PG8_SCHED;
            PG8_LDB(B1, 0, 1); PG8_STAGE(PG8_SB(0, 0), b2, voffB);
            PG8_BAR; PG8_WAIT_L(0); PG8_MMA(0, 1, At, B1); PG8_BAR;
            PG8_LDA(At, 0, 1); PG8_STAGE(PG8_SA(0, 0), a2, voffA);
            PG8_BAR; PG8_WAIT_L(0); PG8_MMA(1, 0, At, B0); PG8_BAR; PG8_SCHED;
            PG8_STAGE(PG8_SB(0, 1), b2 + hstep, voffB);
            PG8_WAIT_V(6); PG8_BAR; PG8_MMA(1, 1, At, B1); PG8_BAR;
            PG8_LDB(B0, 1, 0); PG8_SCHED; PG8_LDA(At, 1, 0); PG8_STAGE(PG8_SA(0, 1), a2 + hstep, voffA);
            PG8_WAIT_L(8); PG8_BAR; PG8_WAIT_L(0); PG8_MMA(0, 0, At, B0); PG8_BAR; PG8_SCHED;
            PG8_LDB(B1, 1, 1); PG8_STAGE(PG8_SB(1, 0), b3, voffB);
            PG8_BAR; PG8_WAIT_L(0); PG8_MMA(0, 1, At, B1); PG8_BAR;
            PG8_LDA(At, 1, 1); PG8_STAGE(PG8_SA(1, 0), a3, voffA);
            PG8_BAR; PG8_WAIT_L(0); PG8_MMA(1, 0, At, B0); PG8_BAR; PG8_SCHED;
            PG8_STAGE(PG8_SB(1, 1), b3 + hstep, voffB);
            PG8_WAIT_V(6); PG8_BAR; PG8_MMA(1, 1, At, B1); PG8_BAR;
            }
        }
        if constexpr (ALIGN_EPI) { if (wr == 0) PG8_BAR; }
        if constexpr (!Epi::AFTER_DRAIN) { E(acc, cur, wr, wc, fr, fq); S.done(cur); }
        if (!has_next) break;
#pragma unroll
        for (int a = 0; a < 2; ++a)
#pragma unroll
            for (int b = 0; b < 2; ++b)
#pragma unroll
                for (int m = 0; m < 4; ++m)
#pragma unroll
                    for (int n = 0; n < 2; ++n) acc[a][b][m][n] = (f32x4){0.f, 0.f, 0.f, 0.f};
        cur = nxt; cA = nA; cB = nB; ++ui;
        if constexpr (ALIGN_EPI) { if (wr == 1) PG8_BAR; }
    }
    PG8_WAIT_V(0);
    if constexpr (!ALIGN_EPI) { if (wr == 0) PG8_BAR; }
    PG8_BAR;
    if constexpr (Epi::AFTER_DRAIN) { E.fused(acc, cur, wr, wc, fr, fq, lds, wid, lane); S.done(cur); }
#undef PG8_SA
#undef PG8_SB
#undef PG8_STAGE
#undef PG8_LDA
#undef PG8_LDB
#undef PG8_MMA
#undef PG8_WAIT_V
#undef PG8_WAIT_L
#undef PG8_BAR
#undef PG8_SCHED
}
}
#define GAS __attribute__((address_space(1)))
#define LAS __attribute__((address_space(3)))

__device__ __forceinline__ int zcol_src(int n, float& sc) {
    sc = 1.f;
    if (n < ZB_Q) return n;
    if (n < ZB_K) { int o = n - ZB_Q, h = o >> 6, d = o & 63; sc = QSCALE; if (d < 16) d = (d >> 1) + 8 * (d & 1); return ZB_Q + h * 64 + d; }
    if (n < ZB_V) { int d = n - ZB_K; if (d < 16) d = (d >> 1) + 8 * (d & 1); return ZB_K + d; }
    if (n < ZB_IQ) return n;
    if (n < ZB_IK) { int o = n - ZB_IQ, h = o >> 5, d = o & 31; sc = IQSCALE; if (d < 8) d = (d >> 1) + 4 * (d & 1); return ZB_IQ + h * 32 + d; }
    if (n < ZB_IW) { int d = n - ZB_IK; if (d < 8) d = (d >> 1) + 4 * (d & 1); return ZB_IK + d; }
    if (n < ZB_G) { sc = IWSCALE; return n; }
    if (n < ZC_Q) return n;
    if (n < ZC_K) { int o = n - ZC_Q, h = o >> 6, d = o & 63; sc = QSCALE; if (d < 16) d = (d >> 1) + 8 * (d & 1); return ZC_Q + h * 64 + d; }
    if (n < ZC_V) { int o = n - ZC_K, h = o >> 6, d = o & 63; if (d < 16) d = (d >> 1) + 8 * (d & 1); return ZC_K + h * 64 + d; }
    return n;
}

template <bool ZMAP>
__device__ __forceinline__ void transpose_item(const float* __restrict__ W, int K, int NW, bf16_t* WT, const float* __restrict__ kscale, LAS float* scr, int item, int nblk, int lane) {
    const int kb = item / nblk, nb = item % nblk, k0 = 64 * kb, n0 = 32 * nb;
    const int ncol = n0 + (lane & 31);
#pragma unroll 8
    for (int i = 0; i < 32; ++i) { const int kk = 2 * i + (lane >> 5);
        float v = 0.f; if (ncol < NW) { v = W[(size_t)(k0 + kk) * NW + ncol]; if (kscale) v *= kscale[k0 + kk]; }
        scr[kk * 33 + (lane & 31)] = v; }
    asm volatile("s_waitcnt lgkmcnt(0)" ::: "memory");
    const int c = lane & 7;
#pragma unroll
    for (int j = 0; j < 4; ++j) { const int n = (lane >> 3) + 8 * j; int sl = n; float sc = 1.f;
        if (ZMAP) { if (n0 + n < NW) sl = zcol_src(n0 + n, sc) - n0; else { sl = n; sc = 0.f; } }
        const LAS float* s = scr + (8 * c) * 33 + sl;
        u32x4 o; o.x = pk2(s[0 * 33] * sc, s[1 * 33] * sc); o.y = pk2(s[2 * 33] * sc, s[3 * 33] * sc); o.z = pk2(s[4 * 33] * sc, s[5 * 33] * sc); o.w = pk2(s[6 * 33] * sc, s[7 * 33] * sc);
        *(u32x4*)(WT + (size_t)(n0 + n) * K + k0 + 8 * c) = o; }
    asm volatile("s_waitcnt lgkmcnt(0)" ::: "memory");
}

struct PrepArgs { const float* w_in; const float* norm_g; const float* w_out; const float* ple_g; const float* w_gate; const float* w_proj; const float* w_up; const float* a_up; unsigned char* ws; };

__device__ __forceinline__ void prep_weights(const PrepArgs& a, int gw, int ngw, LAS float* scr, int lane) {
    constexpr int I_IN = 16 * (NPAD / 32), I_SQ = 16 * 32, I_PJ = 4 * 32, I_UP = 12, I_LAYER = I_IN + 2 * I_SQ + I_PJ + 2 * I_UP;
    for (int it = gw; it < DEPTH * I_LAYER; it += ngw) {
        const int L = it / I_LAYER; int r = it % I_LAYER;
        unsigned char* wl = a.ws + WS_W + (size_t)L * W_LAYER;
        if (r < I_IN) { transpose_item<true>(a.w_in + (size_t)L * DM * ZP, DM, ZP, (bf16_t*)(wl + W_IN), a.norm_g + L * DM, scr, r, NPAD / 32, lane); continue; } r -= I_IN;
        if (r < I_SQ) { transpose_item<false>(a.w_out + (size_t)L * DM * DM, DM, DM, (bf16_t*)(wl + W_OUT), nullptr, scr, r, 32, lane); continue; } r -= I_SQ;
        if (r < I_SQ) { transpose_item<false>(a.w_gate + (size_t)L * DM * DM, DM, DM, (bf16_t*)(wl + W_GATE), a.ple_g + L * DM, scr, r, 32, lane); continue; } r -= I_SQ;
        if (r < I_PJ) { transpose_item<false>(a.w_proj + (size_t)L * 256 * DM, 256, DM, (bf16_t*)(wl + W_PROJ), nullptr, scr, r, 32, lane); continue; } r -= I_PJ;
        if (r < I_UP) { transpose_item<false>(a.w_up + (size_t)L * 64 * 384, 64, 384, (bf16_t*)(wl + W_WUPT), nullptr, scr, r, 12, lane); continue; } r -= I_UP;
        transpose_item<false>(a.a_up + (size_t)L * 64 * 384, 64, 384, (bf16_t*)(wl + W_AUPT), nullptr, scr, r, 12, lane);
    }
}

__device__ __forceinline__ void sincos_d(float ang, float& c, float& s) {
    const double a = (double)ang; const double n = rint(a * 0.63661977236758134308);
    double r = fma(-n, 1.57079632679489655800e+00, a); r = fma(-n, 6.12323399573676603587e-17, r);
    const double r2 = r * r;
    double sp = r2 * (1.0 / 6227020800.0) - 1.0 / 39916800.0; sp = sp * r2 + 1.0 / 362880.0; sp = sp * r2 - 1.0 / 5040.0; sp = sp * r2 + 1.0 / 120.0; sp = sp * r2 - 1.0 / 6.0; sp = sp * r2 * r + r;
    double cp = r2 * (1.0 / 479001600.0) - 1.0 / 3628800.0; cp = cp * r2 + 1.0 / 40320.0; cp = cp * r2 - 1.0 / 720.0; cp = cp * r2 + 1.0 / 24.0; cp = cp * r2 - 0.5; cp = cp * r2 + 1.0;
    const int q = ((int)n) & 3;
    const double sv = (q == 0) ? sp : (q == 1) ? cp : (q == 2) ? -sp : -cp;
    const double cv = (q == 0) ? cp : (q == 1) ? -sp : (q == 2) ? -cp : sp;
    c = (float)cv; s = (float)sv;
}
__device__ __forceinline__ void prep_tables(unsigned char* ws, int gtid, int nthreads) {
    const float inv8[8] = {1.0f, 0.1939227432012558f, 0.03760603070259094f, 0.007292664609849453f, 0.0014142135623842478f, 0.00027424818836152554f, 5.318296098266728e-05f, 1.0313386155758053e-05f};
    float* t16 = (float*)(ws + WS_TAB16); float* tI = (float*)(ws + WS_TABI);
    for (int e = gtid; e < SEQ * 8; e += nthreads) { const int pos = e >> 3, i = e & 7;
        float iv = inv8[0];
#pragma unroll
        for (int j = 1; j < 8; ++j) iv = (i == j) ? inv8[j] : iv;
        float c, s; sincos_d((float)pos * iv, c, s); t16[pos * 16 + i] = c; t16[pos * 16 + 8 + i] = s;
        if ((i & 1) == 0) { const int i4 = i >> 1; tI[pos * 8 + i4] = c; tI[pos * 8 + 4 + i4] = s; }
    }
}
__device__ __forceinline__ void x_row_to_bf16(const float* xrow, bf16_t* orow, float* ssq, int lane) {
    const f32x4* xr = (const f32x4*)xrow + lane;
    unsigned long long* o8 = (unsigned long long*)orow + lane;
#pragma unroll
    for (int j = 0; j < 4; ++j) { const f32x4 v = xr[64 * j];
        float s = (v.x * v.x + v.y * v.y) + (v.z * v.z + v.w * v.w);
        o8[64 * j] = (unsigned long long)pk2(v.x, v.y) | ((unsigned long long)pk2(v.z, v.w) << 32);
        s += __shfl_xor(s, 1); s += __shfl_xor(s, 2); s += __shfl_xor(s, 4); s += __shfl_xor(s, 8);
        if ((lane & 15) == 0) ssq[4 * j + (lane >> 4)] = s; }
}
__device__ __forceinline__ float row_rstd(const float* ssq_row) {
    const f32x4 a = *(const f32x4*)ssq_row, b = *(const f32x4*)(ssq_row + 4), c = *(const f32x4*)(ssq_row + 8), d = *(const f32x4*)(ssq_row + 12);
    const float s = ((a.x + a.y) + (a.z + a.w)) + ((b.x + b.y) + (b.z + b.w)) + ((c.x + c.y) + (c.z + c.w)) + ((d.x + d.y) + (d.z + d.w));
    return __builtin_amdgcn_rsqf(s * (1.0f / DM) + NORM_EPS);
}
namespace epi {
using pg8::Unit; using pg8::BM; using pg8::HALF;
__device__ __forceinline__ u32x4 pack8(const f32x4& a, const f32x4& b) { u32x4 w; w.x = pg8::cvt_pk_bf16(a[0], a[1]); w.y = pg8::cvt_pk_bf16(a[2], a[3]); w.z = pg8::cvt_pk_bf16(b[0], b[1]); w.w = pg8::cvt_pk_bf16(b[2], b[3]); return w; }
__device__ __forceinline__ int rope_class(int c0, int& fb) {
    fb = 0; int o;
    if (c0 >= ZB_Q && c0 < ZB_V) { o = (c0 - ZB_Q) & 63; if (o < 16) { fb = o >> 1; return 1; } return 0; }
    if (c0 >= ZB_IQ && c0 < ZB_IW) { o = (c0 - ZB_IQ) & 31; return o == 0 ? 2 : 0; }
    if (c0 >= ZC_Q && c0 < ZC_V) { o = (c0 - ZC_Q) & 63; if (o < 16) { fb = o >> 1; return 1; } return 0; }
    return 0;
}
struct EpiInProj {
    static constexpr bool PERM = true, AFTER_DRAIN = false;
    bf16_t* Z; const float* ssq; const float* tab16; const float* tabI; bf16_t* KV; bf16_t* IKC;
    __device__ __forceinline__ void operator()(const f32x4 (&acc)[2][2][4][2], const Unit& u, int wr, int wc, int fr, int fq) const {
        const int row0 = u.pm * BM + wr * 64 + fr;
        const int c00 = u.pn * BM + wc * 32 + 8 * fq, c01 = c00 + HALF;
        int fb0, fb1; const int rc0 = rope_class(c00, fb0), rc1 = rope_class(c01, fb1);
#pragma unroll
        for (int ai = 0; ai < 2; ++ai)
#pragma unroll
            for (int m = 0; m < 4; ++m) {
                const int row = row0 + ai * HALF + m * 16;
                const float rs = row_rstd(ssq + (size_t)row * 16);
                const int pos = row & (SEQ - 1);
#pragma unroll
                for (int bj = 0; bj < 2; ++bj) {
                    const int c0 = bj ? c01 : c00, rc = bj ? rc1 : rc0, fb = bj ? fb1 : fb0;
                    if (c0 >= ZP) continue;
                    f32x4 v0 = acc[ai][bj][m][0] * rs, v1 = acc[ai][bj][m][1] * rs;
                    if (rc) {
                        const float* tp = (rc == 1) ? tab16 + pos * 16 + fb : tabI + pos * 8;
                        const f32x4 c = *(const f32x4*)tp, s = *(const f32x4*)(tp + (rc == 1 ? 8 : 4));
                        f32x4 a0, a1;
                        a0[0] = v0[0] * c[0] - v0[1] * s[0]; a0[1] = v0[1] * c[0] + v0[0] * s[0];
                        a0[2] = v0[2] * c[1] - v0[3] * s[1]; a0[3] = v0[3] * c[1] + v0[2] * s[1];
                        a1[0] = v1[0] * c[2] - v1[1] * s[2]; a1[1] = v1[1] * c[2] + v1[0] * s[2];
                        a1[2] = v1[2] * c[3] - v1[3] * s[3]; a1[3] = v1[3] * c[3] + v1[2] * s[3];
                        v0 = a0; v1 = a1;
                    }
                    const u32x4 pk = pack8(v0, v1);
                    if (c0 >= ZB_K && c0 < ZB_IQ) *(u32x4*)(KV + (size_t)row * 128 + (c0 - ZB_K)) = pk;
                    else if (c0 >= ZB_IK && c0 < ZB_IW) *(u32x4*)(IKC + (size_t)row * 32 + (c0 - ZB_IK)) = pk;
                    else *(u32x4*)(Z + (size_t)row * ZP + c0) = pk;
                }
                asm volatile("" ::: "memory");
            }
    }
};
struct EpiPlainZ {
    static constexpr bool PERM = true, AFTER_DRAIN = false;
    bf16_t* Z;
    __device__ __forceinline__ void operator()(const f32x4 (&acc)[2][2][4][2], const Unit& u, int wr, int wc, int fr, int fq) const {
        const int row0 = u.pm * BM + wr * 64 + fr;
#pragma unroll
        for (int ai = 0; ai < 2; ++ai)
#pragma unroll
            for (int m = 0; m < 4; ++m)
#pragma unroll
                for (int bj = 0; bj < 2; ++bj) { const int c0 = u.pn * BM + bj * HALF + wc * 32 + 8 * fq; if (c0 < ZP) *(u32x4*)(Z + (size_t)(row0 + ai * HALF + m * 16) * ZP + c0) = pack8(acc[ai][bj][m][0], acc[ai][bj][m][1]); }
    }
};
struct EpiOutProj {
    static constexpr bool PERM = true, AFTER_DRAIN = false;
    const float* xin; float* xout; bf16_t* xb; float* ssq_out;
    __device__ __forceinline__ void operator()(const f32x4 (&acc)[2][2][4][2], const Unit& u, int wr, int wc, int fr, int fq) const {
        const int row0 = u.pm * BM + wr * 64 + fr;
#pragma unroll
        for (int ai = 0; ai < 2; ++ai)
#pragma unroll
            for (int m = 0; m < 4; ++m) {
                const int row = row0 + ai * HALF + m * 16; float sq = 0.f;
#pragma unroll
                for (int bj = 0; bj < 2; ++bj) {
                    const size_t off = (size_t)row * DM + u.pn * BM + bj * HALF + wc * 32 + 8 * fq;
                    const f32x4 x0 = *(const f32x4*)(xin + off) + acc[ai][bj][m][0], x1 = *(const f32x4*)(xin + off + 4) + acc[ai][bj][m][1];
                    *(f32x4*)(xout + off) = x0; *(f32x4*)(xout + off + 4) = x1;
                    *(u32x4*)(xb + off) = pack8(x0, x1);
                    sq += ((x0[0] * x0[0] + x0[1] * x0[1]) + (x0[2] * x0[2] + x0[3] * x0[3])) + ((x1[0] * x1[0] + x1[1] * x1[1]) + (x1[2] * x1[2] + x1[3] * x1[3]));
                }
                sq += __shfl_xor(sq, 16); sq += __shfl_xor(sq, 32);
                if (fq == 0) ssq_out[(size_t)row * 16 + u.pn * 4 + wc] = sq;
            }
    }
};
struct EpiGate {
    static constexpr bool PERM = true, AFTER_DRAIN = false;
    float* xio; const float* pp; bf16_t* xb; const float* ssq_in; float* ssq_out;
    __device__ __forceinline__ void operator()(const f32x4 (&acc)[2][2][4][2], const Unit& u, int wr, int wc, int fr, int fq) const {
        const int row0 = u.pm * BM + wr * 64 + fr;
#pragma unroll
        for (int ai = 0; ai < 2; ++ai)
#pragma unroll
            for (int m = 0; m < 4; ++m) {
                const int row = row0 + ai * HALF + m * 16; float sq = 0.f;
                const float rs = row_rstd(ssq_in + (size_t)row * 16);
#pragma unroll
                for (int bj = 0; bj < 2; ++bj) {
                    const size_t off = (size_t)row * DM + u.pn * BM + bj * HALF + wc * 32 + 8 * fq;
                    f32x4 g0 = acc[ai][bj][m][0] * rs, g1 = acc[ai][bj][m][1] * rs;
#pragma unroll
                    for (int i = 0; i < 4; ++i) { g0[i] = sigmoidf_(g0[i]); g1[i] = sigmoidf_(g1[i]); }
                    const f32x4 x0 = *(const f32x4*)(xio + off) + g0 * *(const f32x4*)(pp + off), x1 = *(const f32x4*)(xio + off + 4) + g1 * *(const f32x4*)(pp + off + 4);
                    *(f32x4*)(xio + off) = x0; *(f32x4*)(xio + off + 4) = x1;
                    *(u32x4*)(xb + off) = pack8(x0, x1);
                    sq += ((x0[0] * x0[0] + x0[1] * x0[1]) + (x0[2] * x0[2] + x0[3] * x0[3])) + ((x1[0] * x1[0] + x1[1] * x1[1]) + (x1[2] * x1[2] + x1[3] * x1[3]));
                }
                sq += __shfl_xor(sq, 16); sq += __shfl_xor(sq, 32);
                if (fq == 0) ssq_out[(size_t)row * 16 + u.pn * 4 + wc] = sq;
            }
    }
};
struct EpiF32 {
    static constexpr bool PERM = true, AFTER_DRAIN = false;
    float* C;
    __device__ __forceinline__ void operator()(const f32x4 (&acc)[2][2][4][2], const Unit& u, int wr, int wc, int fr, int fq) const {
        const int row0 = u.pm * BM + wr * 64 + fr;
#pragma unroll
        for (int ai = 0; ai < 2; ++ai)
#pragma unroll
            for (int m = 0; m < 4; ++m)
#pragma unroll
                for (int bj = 0; bj < 2; ++bj) {
                    const size_t off = (size_t)(row0 + ai * HALF + m * 16) * DM + u.pn * BM + bj * HALF + wc * 32 + 8 * fq;
                    *(f32x4*)(C + off) = acc[ai][bj][m][0]; *(f32x4*)(C + off + 4) = acc[ai][bj][m][1];
                }
    }
};
}
typedef GAS unsigned gu32;
#define RLX_AGENT __ATOMIC_RELAXED, __HIP_MEMORY_SCOPE_AGENT
#define XB_TMO      128
#define XB_XCNT(j)  (256  + 64 * (j))
#define XB_XSUB(j)  (1280 + 64 * (j))
#define XB_XGEN(j)  (2304 + 64 * (j))
#define XB_TOP      3328
#define XB_TOPGEN   3392
#define XCD_BAR_WORDS 3456
#define XB_SPIN_CAP (1u << 27)

__device__ __forceinline__ unsigned xb_ld(unsigned* p)              { return __hip_atomic_load(p, __ATOMIC_RELAXED, __HIP_MEMORY_SCOPE_AGENT); }
__device__ __forceinline__ unsigned xb_add(unsigned* p, unsigned v) { return __hip_atomic_fetch_add(p, v, __ATOMIC_RELAXED, __HIP_MEMORY_SCOPE_AGENT); }
__device__ __forceinline__ unsigned xb_xcc_id() { return (unsigned)__builtin_amdgcn_s_getreg((3 << 11) | 20) & 0xFu; }
#define XB_SPIN(cond, bar) do { unsigned _sp = 0; while (cond) { __builtin_amdgcn_s_sleep(1); \
    if ((++_sp & 255u) == 0u) { if (xb_ld(&(bar)[XB_TMO])) break; if (_sp > XB_SPIN_CAP) { atomicAdd(&(bar)[XB_TMO], 1u); break; } } } } while (0)

struct XcdBarrier {
    unsigned* bar; unsigned x;
    volatile LAS unsigned* st;
};

__device__ __forceinline__ XcdBarrier xcd_barrier_post(unsigned* bar, volatile LAS unsigned* st) {
    XcdBarrier b; b.bar = bar; b.x = xb_xcc_id(); b.st = st;
    if (threadIdx.x == 0) (void)xb_add(&bar[XB_XCNT(b.x)], 1u);
    return b;
}
__device__ __forceinline__ void xcd_barrier_complete(unsigned* bar, unsigned x, unsigned& nloc, unsigned& nx) {
    const unsigned G = gridDim.x * gridDim.y * gridDim.z;
    unsigned sum, cnt, mine, sp = 0u;
    for (;;) {
        sum = 0u; cnt = 0u; mine = 0u;
#pragma unroll
        for (unsigned j = 0; j < 16; ++j) { const unsigned c = xb_ld(&bar[XB_XCNT(j)]); sum += c; cnt += (c > 0u) ? 1u : 0u; mine = (j == x) ? c : mine; }
        if (sum == G) break;
        __builtin_amdgcn_s_sleep(1);
        if ((++sp & 255u) == 0u) { if (xb_ld(&bar[XB_TMO])) break; if (sp > XB_SPIN_CAP) { atomicAdd(&bar[XB_TMO], 1u); break; } }
    }
    nloc = mine > 0u ? mine : 1u; nx = cnt > 0u ? cnt : 1u;
}

__device__ __forceinline__ void xcd_barrier(const XcdBarrier& b) {
    asm volatile("s_waitcnt vmcnt(0)" ::: "memory");
    __syncthreads();
    if (threadIdx.x == 0) {
        unsigned* bar = b.bar;
        __builtin_amdgcn_s_waitcnt(0);
        unsigned nloc = b.st[0], nx = b.st[1];
        if (nloc == 0u) { xcd_barrier_complete(bar, b.x, nloc, nx); b.st[0] = nloc; b.st[1] = nx; }
        const unsigned old = xb_add(&bar[XB_XSUB(b.x)], 1u);
        const unsigned gen = old / nloc;
        if (old + 1u == (gen + 1u) * nloc) {
            __builtin_amdgcn_fence(__ATOMIC_RELEASE, "agent");
            asm volatile("s_waitcnt vmcnt(0)" ::: "memory");
            const unsigned og = xb_add(&bar[XB_TOP], 1u);
            const unsigned tg = og / nx;
            if (og + 1u == (tg + 1u) * nx) xb_add(&bar[XB_TOPGEN], 1u);
            else XB_SPIN(xb_ld(&bar[XB_TOPGEN]) == tg, bar);
            __builtin_amdgcn_fence(__ATOMIC_ACQUIRE, "agent");
            xb_add(&bar[XB_XGEN(b.x)], 1u);
            asm volatile("s_waitcnt vmcnt(0)" ::: "memory");
        } else {
            XB_SPIN(xb_ld(&bar[XB_XGEN(b.x)]) == gen, bar);
            __builtin_amdgcn_fence(__ATOMIC_ACQUIRE, "agent");
            asm volatile("s_waitcnt vmcnt(0)" ::: "memory");
        }
    }
    __syncthreads();
}
struct MixArgs { const bf16_t* Z; bf16_t* Y; const bf16_t* KV; const bf16_t* IKC; const float* mu; const float* w0; const float* w_up; const float* a0; const float* a_up; const float* k_k; const float* k_a; const float* r_k; const float* ln_g; const float* ln_b; };

__device__ __forceinline__ void rwkv_seq_phase(const MixArgs& a, unsigned char* ldsb, int chain  ) {
    constexpr int TB = 16;
    typedef float (*arr_t)[64];
    const int tid0 = opaque_tid();
    float* base = (float*)(ldsb + (tid0 >> 8) * 40960);
    arr_t sr = (arr_t)(base), sw = (arr_t)(base + 1024), sk = (arr_t)(base + 2048), sv = (arr_t)(base + 3072), skk = (arr_t)(base + 4096), sb = (arr_t)(base + 5120), sg = (arr_t)(base + 6144), swd = (arr_t)(base + 7168), sad = (arr_t)(base + 8192), sy = (arr_t)(base + 9216);
    const int b = chain / 6, h = chain % 6, tid = tid0 & 255, lane = tid & 63, wv = tid >> 6;
    const int vrow = tid >> 2, kq = tid & 3;
    float st[16];
#pragma unroll
    for (int i = 0; i < 16; ++i) st[i] = 0.f;
    for (int t0 = 0; t0 < SEQ; t0 += TB) {
        for (int idx = tid; idx < TB * 64; idx += 256) {
            const int t = idx >> 6, c = idx & 63, tok = t0 + t;
            const bf16_t* zr = a.Z + (size_t)(b * SEQ + tok) * ZP; const bf16_t* zp = zr - ZP; const bool hp = tok > 0;
            auto mix = [&](int col) { const float cur = bf2f(zr[col]), prv = hp ? bf2f(zp[col]) : 0.f; return cur + (prv - cur) * a.mu[col]; };
            sr[t][c] = mix(ZA_R + h * 64 + c); sk[t][c] = mix(ZA_K + h * 64 + c); sv[t][c] = mix(ZA_V + h * 64 + c); sg[t][c] = mix(ZA_G + h * 64 + c);
            swd[t][c] = tanhf(mix(ZA_WD + c)); sad[t][c] = mix(ZA_AD + c);
        }
        __syncthreads();
        for (int idx = tid; idx < TB * 64; idx += 256) {
            const int t = idx >> 6, c = idx & 63, hc = h * 64 + c;
            float pw = a.w0[hc], pa = a.a0[hc];
            for (int j = 0; j < 64; ++j) { pw += swd[t][j] * a.w_up[j * 384 + hc]; pa += sad[t][j] * a.a_up[j * 384 + hc]; }
            const float w = __expf(-DECAY_SCALE * sigmoidf_(pw)), eta = sigmoidf_(pa);
            const float k = sk[t][c];
            sw[t][c] = w; sb[t][c] = eta; skk[t][c] = k * a.k_k[hc]; sk[t][c] = k * (1.f + (eta - 1.f) * a.k_a[hc]);
        }
        __syncthreads();
        for (int t = wv; t < TB; t += 4) {
            const float kr = skk[t][lane]; const float nrm = sqrtf(wave_sum(kr * kr)); const float kk = kr / fmaxf(nrm, 1e-12f);
            skk[t][lane] = kk; sb[t][lane] = kk * sb[t][lane];
        }
        __syncthreads();
        for (int t = 0; t < TB; ++t) {
            float sa = 0.f;
#pragma unroll
            for (int i = 0; i < 16; ++i) sa -= st[i] * skk[t][kq * 16 + i];
            sa += __shfl_xor(sa, 1); sa += __shfl_xor(sa, 2);
            const float vv = sv[t][vrow]; float yy = 0.f;
#pragma unroll
            for (int i = 0; i < 16; ++i) { const int kc = kq * 16 + i; st[i] = st[i] * sw[t][kc] + sa * sb[t][kc] + vv * sk[t][kc]; yy += st[i] * sr[t][kc]; }
            yy += __shfl_xor(yy, 1); yy += __shfl_xor(yy, 2);
            if (kq == 0) sy[t][vrow] = yy;
        }
        __syncthreads();
        for (int t = wv; t < TB; t += 4) {
            const int hc = h * 64 + lane;
            const float y = sy[t][lane]; const float mean = wave_sum(y) * (1.f / 64.f); const float d = y - mean; const float var = wave_sum(d * d) * (1.f / 64.f);
            const float yn = d * (1.0f / sqrtf(var + GN_EPS)) * a.ln_g[hc] + a.ln_b[hc];
            const float bonus = wave_sum(sr[t][lane] * sk[t][lane] * a.r_k[hc]) * sv[t][lane];
            const float g = sg[t][lane];
            a.Y[(size_t)(b * SEQ + t0 + t) * DM + hc] = (bf16_t)f2bf((yn + bonus) * g * sigmoidf_(g));
        }
        __syncthreads();
    }
}

__device__ __forceinline__ void dsa_simple_unit(const MixArgs& a, unsigned char* ldsb, int row) {
    const int tid0 = opaque_tid(); const int wv = tid0 >> 6, lane = tid0 & 63;
    typedef float (*a256_t)[256]; typedef float (*a8_t)[8]; typedef float (*p_t)[4][256]; typedef unsigned (*key_t)[SEQ]; typedef int (*idx_t)[256];
    a256_t s_iq = (a256_t)(ldsb); a256_t s_q = (a256_t)(ldsb + 8192); a8_t s_iw = (a8_t)(ldsb + 16384); idx_t s_idx = (idx_t)(ldsb + 16384 + 256); p_t s_p = (p_t)(ldsb + 16384 + 256 + 8192); key_t s_key = (key_t)(ldsb + 16384 + 256 + 8192 + 32768);
    const int b = row / SEQ, t = row % SEQ;
    __syncthreads();
    const bf16_t* zr = a.Z + (size_t)row * ZP; const bf16_t* zb = a.Z + (size_t)b * SEQ * ZP;
    for (int i = lane; i < 256; i += 64) { s_iq[wv][i] = bf2f(zr[ZB_IQ + i]); s_q[wv][i] = bf2f(zr[ZB_Q + i]); }
    if (lane < 8) s_iw[wv][lane] = bf2f(zr[ZB_IW + lane]);
    __syncthreads();
    const int nj = (t >> 6) + 1;
    for (int j = 0; j < nj; ++j) {
        const int s = lane + 64 * j; unsigned u = 0u;
        if (s <= t) {
            const u32x4* kp = (const u32x4*)(zb + (size_t)s * ZP + ZB_IK); float ik[32];
#pragma unroll
            for (int q4 = 0; q4 < 4; ++q4) { const u32x4 w = kp[q4];
                ik[q4 * 8 + 0] = bflo(w.x); ik[q4 * 8 + 1] = bfhi(w.x); ik[q4 * 8 + 2] = bflo(w.y); ik[q4 * 8 + 3] = bfhi(w.y); ik[q4 * 8 + 4] = bflo(w.z); ik[q4 * 8 + 5] = bfhi(w.z); ik[q4 * 8 + 6] = bflo(w.w); ik[q4 * 8 + 7] = bfhi(w.w); }
            float sc = 0.f;
#pragma unroll
            for (int hh = 0; hh < 8; ++hh) { float d = 0.f;
#pragma unroll
                for (int dd = 0; dd < 32; ++dd) d += s_iq[wv][hh * 32 + dd] * ik[dd];
                sc += s_iw[wv][hh] * fmaxf(d, 0.f); }
            const unsigned bits = __builtin_bit_cast(unsigned, sc);
            u = (bits & 0x80000000u) ? ~bits : (bits | 0x80000000u);
        }
        s_key[wv][s] = u;
    }
    __syncthreads();
    int nsel;
    if (t < 256) { for (int s = lane; s <= t; s += 64) s_idx[wv][s] = s; nsel = t + 1; }
    else {
        unsigned prefix = 0u;
        for (int bit = 31; bit >= 0; --bit) { const unsigned cand = prefix | (1u << bit); int cnt = 0;
            for (int j = 0; j < nj; ++j) cnt += __popcll(__ballot(s_key[wv][lane + 64 * j] >= cand));
            if (cnt >= 256) prefix = cand; }
        int ngt = 0;
        for (int j = 0; j < nj; ++j) ngt += __popcll(__ballot(s_key[wv][lane + 64 * j] > prefix));
        const int need = 256 - ngt; int nt = 0, ns = 0;
        for (int j = 0; j < nj; ++j) { const unsigned u = s_key[wv][lane + 64 * j];
            const unsigned long long mt = __ballot(u == prefix); const int trank = nt + __popcll(mt & ((1ull << lane) - 1ull));
            const bool sel = (u > prefix) || (u == prefix && trank < need);
            const unsigned long long ms = __ballot(sel); const int slot = ns + __popcll(ms & ((1ull << lane) - 1ull));
            if (sel) s_idx[wv][slot] = lane + 64 * j;
            nt += __popcll(mt); ns += __popcll(ms); }
        nsel = ns;
    }
    __syncthreads();
    float lg[4][4];
#pragma unroll
    for (int i = 0; i < 4; ++i) { const int slot = lane + 64 * i;
#pragma unroll
        for (int hh = 0; hh < 4; ++hh) lg[i][hh] = -INFINITY;
        if (slot < nsel) { const int s = s_idx[wv][slot]; const u32x4* kp = (const u32x4*)(zb + (size_t)s * ZP + ZB_K);
            float acc4[4] = {0.f, 0.f, 0.f, 0.f};
#pragma unroll
            for (int q8 = 0; q8 < 8; ++q8) { const u32x4 w = kp[q8]; float kv[8] = {bflo(w.x), bfhi(w.x), bflo(w.y), bfhi(w.y), bflo(w.z), bfhi(w.z), bflo(w.w), bfhi(w.w)};
#pragma unroll
                for (int hh = 0; hh < 4; ++hh)
#pragma unroll
                    for (int e = 0; e < 8; ++e) acc4[hh] += s_q[wv][hh * 64 + q8 * 8 + e] * kv[e]; }
#pragma unroll
            for (int hh = 0; hh < 4; ++hh) lg[i][hh] = acc4[hh]; } }
#pragma unroll
    for (int hh = 0; hh < 4; ++hh) {
        float m = fmaxf(fmaxf(lg[0][hh], lg[1][hh]), fmaxf(lg[2][hh], lg[3][hh])); m = wave_max(m);
        float p[4], l = 0.f;
#pragma unroll
        for (int i = 0; i < 4; ++i) { p[i] = exp2f(lg[i][hh] - m); l += p[i]; }
        l = wave_sum(l); const float rl = 1.f / l;
#pragma unroll
        for (int i = 0; i < 4; ++i) s_p[wv][hh][lane + 64 * i] = p[i] * rl;
    }
    __syncthreads();
    float o[4] = {0.f, 0.f, 0.f, 0.f};
    for (int slot = 0; slot < nsel; ++slot) { const int s = s_idx[wv][slot]; const float vv = bf2f(zb[(size_t)s * ZP + ZB_V + lane]);
#pragma unroll
        for (int hh = 0; hh < 4; ++hh) o[hh] += s_p[wv][hh][slot] * vv; }
#pragma unroll
    for (int hh = 0; hh < 4; ++hh) { const float g = bf2f(zr[ZB_G + hh * 64 + lane]); a.Y[(size_t)row * DM + 384 + hh * 64 + lane] = (bf16_t)f2bf(o[hh] * g * sigmoidf_(g)); }
}

__device__ __forceinline__ void dil_simple_unit(const MixArgs& a, unsigned char* ldsb, int wid) {
    const int tid0 = opaque_tid(); const int wv = tid0 >> 6, lane = tid0 & 63;
    typedef float (*q_t)[64]; typedef float (*pp_t)[192];
    q_t s_q = (q_t)(ldsb); pp_t s_p = (pp_t)(ldsb + 2048);
    const int row = wid >> 1, hg = wid & 1, b = row / SEQ, t = row % SEQ;
    const bf16_t* zr = a.Z + (size_t)row * ZP; const bf16_t* zb = a.Z + (size_t)b * SEQ * ZP;
    float og[3], lse[3];
#pragma unroll
    for (int gi = 0; gi < 3; ++gi) {
        const int head = gi * 2 + hg, rate = (gi == 0) ? 1 : (gi == 1) ? 4 : 16;
        const int ip = t / rate; const int nkeys = (ip < 128 ? ip : 128) + 1;
        __syncthreads();
        s_q[wv][lane] = bf2f(zr[ZC_Q + head * 64 + lane]);
        __syncthreads();
        float lg[3];
#pragma unroll
        for (int i = 0; i < 3; ++i) { const int j = lane + 64 * i; lg[i] = -INFINITY;
            if (j < nkeys) { const u32x4* kp = (const u32x4*)(zb + (size_t)(t - j * rate) * ZP + ZC_K + head * 64); float d = 0.f;
#pragma unroll
                for (int q8 = 0; q8 < 8; ++q8) { const u32x4 w = kp[q8]; const float kv[8] = {bflo(w.x), bfhi(w.x), bflo(w.y), bfhi(w.y), bflo(w.z), bfhi(w.z), bflo(w.w), bfhi(w.w)};
#pragma unroll
                    for (int e = 0; e < 8; ++e) d += s_q[wv][q8 * 8 + e] * kv[e]; }
                lg[i] = d; } }
        const float m = wave_max(fmaxf(fmaxf(lg[0], lg[1]), lg[2]));
        float p[3], l = 0.f;
#pragma unroll
        for (int i = 0; i < 3; ++i) { p[i] = exp2f(lg[i] - m); l += p[i]; }
        l = wave_sum(l); const float rl = 1.f / l;
#pragma unroll
        for (int i = 0; i < 3; ++i) s_p[wv][lane + 64 * i] = p[i] * rl;
        __syncthreads();
        float o = 0.f;
        for (int j = 0; j < nkeys; ++j) o += s_p[wv][j] * bf2f(zb[(size_t)(t - j * rate) * ZP + ZC_V + head * 64 + lane]);
        og[gi] = o; lse[gi] = m + log2f(l);
    }
    const float mx = fmaxf(fmaxf(lse[0], lse[1]), lse[2]);
    const float e0 = exp2f(lse[0] - mx), e1 = exp2f(lse[1] - mx), e2 = exp2f(lse[2] - mx); const float rs = 1.f / (e0 + e1 + e2);
    const float al[3] = {e0 * rs, e1 * rs, e2 * rs};
#pragma unroll
    for (int gi = 0; gi < 3; ++gi) { const int head = gi * 2 + hg; const float g = bf2f(zr[ZC_G + head * 64 + lane]);
        a.Y[(size_t)row * DM + 640 + head * 64 + lane] = (bf16_t)f2bf(og[gi] * al[gi] * g * sigmoidf_(g)); }
}
namespace dsa {
#define MFMA32(a, b, c) __builtin_amdgcn_mfma_f32_32x32x16_bf16((a), (b), (c), 0, 0, 0)
typedef short v4i16_t __attribute__((ext_vector_type(4)));
typedef short s16x4 __attribute__((ext_vector_type(4)));
constexpr int WAVE_LDS = 2048 + 4096;
constexpr int IKS_OFF = 8 * WAVE_LDS, IKS_BYTES = 65536;
__device__ __forceinline__ unsigned fkey(float f) { const unsigned b = __builtin_bit_cast(unsigned, f); return (b & 0x80000000u) ? ~b : (b | 0x80000000u); }
__device__ __forceinline__ float keyf(unsigned u) { const unsigned b = (u & 0x80000000u) ? (u & 0x7fffffffu) : ~u; return __builtin_bit_cast(float, b); }
__device__ __forceinline__ float relu_(float x) { const int b = __builtin_bit_cast(int, x); return __builtin_bit_cast(float, b > 0 ? b : 0); }
__device__ __forceinline__ s16x4 vtr(const LAS unsigned char* p) { return __builtin_bit_cast(s16x4, __builtin_amdgcn_ds_read_tr16_b64_v4i16((LAS v4i16_t*)p)); }

__device__ __forceinline__ unsigned next_pivot(unsigned ulo, unsigned uhi, int clo, int chi, int it) {
    unsigned p;
    const bool hl = clo >= 0, hh = chi >= 0;
    if (it == 0) p = fkey(0.0f);
    else if (!hh) { const float f = keyf(ulo); p = fkey(f >= 0.f ? 2.f * f + 0.25f : 0.5f * f + 0.125f); }
    else if (!hl) { const float f = keyf(uhi); p = fkey(f <= 0.f ? 2.f * f - 0.25f : 0.5f * f - 0.125f); }
    else { const float fl = keyf(ulo), fh = keyf(uhi);
        float fr = ((float)(clo - 256) + 0.5f) * __builtin_amdgcn_rcpf((float)(clo - chi)); fr = fminf(fmaxf(fr, 1.f / 32.f), 31.f / 32.f);
        if (it % 3 == 2) fr = 0.5f;
        p = fkey(fl + (fh - fl) * fr); }
    if (!(p > ulo && p < uhi)) p = ulo + ((uhi - ulo) >> 1);
    return p;
}

__device__ __forceinline__ void dsa_unit(const MixArgs& a, unsigned char* ldsb, int b, int blk) {
    const int tid = opaque_tid(), lane = tid & 63, wave = __builtin_amdgcn_readfirstlane(tid >> 6), r32 = lane & 31, hi = lane >> 5;
    const GAS bf16_t* zb = (const GAS bf16_t*)a.Z + (size_t)b * SEQ * ZP;
    LAS unsigned char* wl = (LAS unsigned char*)ldsb + wave * WAVE_LDS;
    LAS unsigned* bm = (LAS unsigned*)wl;
    LAS unsigned char* vimg = wl + 2048;
    const int tw = blk * 64 + 8 * wave;
    f32x16 zero16;
#pragma unroll
    for (int i = 0; i < 16; ++i) zero16[i] = 0.f;
#ifdef PROBE_SEL
#define NRND 4
#else
#define NRND 2
#endif
#pragma unroll 1
    for (int rnd_ = 0; rnd_ < NRND; ++rnd_) { const int rnd = rnd_ & 1;
        const int tb = tw + 4 * rnd;
        const int qsub = 2 * ((r32 >> 2) & 1) + (r32 >> 4), head = (r32 & 3) + 4 * ((r32 >> 3) & 1);
        const GAS bf16_t* iqp = zb + (size_t)(tb + qsub) * ZP + ZB_IQ + head * 32 + 8 * hi;
        const bf16x8 aiq0 = *(const GAS bf16x8*)iqp, aiq1 = *(const GAS bf16x8*)(iqp + 16);
        const int tqA = tb + 2 * hi, tqB = tqA + 1;
        float wA[8], wB[8];
        { const u32x4 ua = *(const GAS u32x4*)(zb + (size_t)tqA * ZP + ZB_IW), ub = *(const GAS u32x4*)(zb + (size_t)tqB * ZP + ZB_IW);
          wA[0] = bflo(ua.x); wA[1] = bfhi(ua.x); wA[2] = bflo(ua.y); wA[3] = bfhi(ua.y); wA[4] = bflo(ua.z); wA[5] = bfhi(ua.z); wA[6] = bflo(ua.w); wA[7] = bfhi(ua.w);
          wB[0] = bflo(ub.x); wB[1] = bfhi(ub.x); wB[2] = bflo(ub.y); wB[3] = bfhi(ub.y); wB[4] = bflo(ub.z); wB[5] = bfhi(ub.z); wB[6] = bflo(ub.w); wB[7] = bfhi(ub.w); }
        unsigned scA[64], scB[64];
        const int dA = tqA - 32 * ((tb + 3) >> 5);
        const int Tmax = (tb + 3) >> 5;
        int Tm_s = Tmax, Tm_b = Tmax; asm volatile("" : "+s"(Tm_s), "+s"(Tm_b));
        const int TmaxU = 2 * blk + 1;
        const int fsw = (r32 >> 2) & 3;
        const LAS unsigned char* ikl = (const LAS unsigned char*)ldsb + IKS_OFF + r32 * 64;
        const int off0 = (hi ^ fsw) * 16, off1 = ((2 + hi) ^ fsw) * 16;
#ifdef PROBE_SCORE
        for (int rep_ = 0; rep_ < 2; ++rep_)
#endif
#pragma unroll
        for (int half = 0; half < 2; ++half) {
            if (32 * half <= TmaxU) {
                __syncthreads();
                { const int nkeys = min(32 * (TmaxU + 1) - 1024 * half, 1024);
                  const GAS bf16_t* src = (const GAS bf16_t*)a.IKC + ((size_t)b * SEQ + 1024 * half) * 32;
                  for (int ch = tid; ch < nkeys * 4; ch += 512) { const int key = ch >> 2, c4 = ch & 3;
                      *(LAS u32x4*)((LAS unsigned char*)ldsb + IKS_OFF + key * 64 + ((c4 ^ ((key >> 2) & 3)) * 16)) = *(const GAS u32x4*)(src + key * 32 + c4 * 8); } }
                asm volatile("s_waitcnt vmcnt(0) lgkmcnt(0)" ::: "memory");
                __syncthreads();
                bf16x8 kb0[2], kb1[2];
#pragma unroll
                for (int i = 0; i < 2; ++i) { if (32 * half + i <= Tm_s) { kb0[i] = *(const LAS bf16x8*)(ikl + i * 2048 + off0); kb1[i] = *(const LAS bf16x8*)(ikl + i * 2048 + off1); } }
#pragma unroll
                for (int i = 0; i < 32; ++i) { const int T = 32 * half + i;
                    if (T <= Tm_s) {
                        f32x16 c = MFMA32(aiq0, kb0[i & 1], zero16); c = MFMA32(aiq1, kb1[i & 1], c);
                        if (i + 2 < 32 && T + 2 <= Tm_s) { kb0[i & 1] = *(const LAS bf16x8*)(ikl + (i + 2) * 2048 + off0); kb1[i & 1] = *(const LAS bf16x8*)(ikl + (i + 2) * 2048 + off1); }
                        float sA = 0.f, sB = 0.f;
#pragma unroll
                        for (int r = 0; r < 8; ++r) { sA += wA[r] * relu_(c[r]); sB += wB[r] * relu_(c[8 + r]); }
                        const bool last = (T == Tm_s);
                        scA[T] = (!last || r32 <= dA) ? fkey(sA + 0.f) : 0u; scB[T] = (!last || r32 <= dA + 1) ? fkey(sB + 0.f) : 0u;
                    } else { scA[T] = 0u; scB[T] = 0u; }
                }
            } else {
#pragma unroll
                for (int i = 0; i < 32; ++i) { scA[32 * half + i] = 0u; scB[32 * half + i] = 0u; }
            }
        }
        const int nA = tqA + 1, nB = tqB + 1;
        unsigned uloA = 1u, uhiA = 0xffffffffu, uloB = 1u, uhiB = 0xffffffffu; int cloA = -1, chiA = -1, cloB = -1, chiB = -1;
        bool doneA = nA <= 256, doneB = nB <= 256;
        unsigned thA = 1u, thB = 1u; int needA = 0, needB = 0;
        int itn = 0;
        for (; itn < 200; ++itn) {
            if (!doneA && uhiA - uloA <= 1u) { thA = uhiA; needA = 256 - max(chiA, 0); doneA = true; }
            if (!doneB && uhiB - uloB <= 1u) { thB = uhiB; needB = 256 - max(chiB, 0); doneB = true; }
            const bool actA = !doneA && ((cloA < 0 ? nA : cloA) - max(chiA, 0) > 128), actB = !doneB && ((cloB < 0 ? nB : cloB) - max(chiB, 0) > 128);
            if (!__any(actA || actB)) break;
            const unsigned pA = actA ? next_pivot(uloA, uhiA, cloA, chiA, itn) : 0xffffffffu, pB = actB ? next_pivot(uloB, uhiB, cloB, chiB, itn) : 0xffffffffu;
            int ca = 0, cb = 0;
#pragma unroll
            for (int T = 0; T < 64; ++T)
                asm("v_cmp_ge_u32 vcc, %2, %3\n\tv_addc_co_u32 %0, vcc, 0, %0, vcc\n\tv_cmp_ge_u32 vcc, %4, %5\n\tv_addc_co_u32 %1, vcc, 0, %1, vcc" : "+v"(ca), "+v"(cb) : "v"(scA[T]), "v"(pA), "v"(scB[T]), "v"(pB) : "vcc");
            int pk = ca | (cb << 16);
            pk += __shfl_xor(pk, 1); pk += __shfl_xor(pk, 2); pk += __shfl_xor(pk, 4); pk += __shfl_xor(pk, 8); pk += __shfl_xor(pk, 16);
            ca = pk & 0xffff; cb = pk >> 16;
            if (actA) { if (ca == 256) { thA = pA; needA = 0; doneA = true; } else if (ca > 256) { uloA = pA; cloA = ca; } else { uhiA = pA; chiA = ca; } }
            if (actB) { if (cb == 256) { thB = pB; needB = 0; doneB = true; } else if (cb > 256) { uloB = pB; cloB = cb; } else { uhiB = pB; chiB = cb; } }
        }
        if (__any(!doneA || !doneB)) {
            LAS unsigned* lst = (LAS unsigned*)vimg;
            LAS unsigned* lstA = lst + hi * 128, *lstB = lst + 256 + hi * 128;
            const int trashA = 512 - hi * 128 + lane, trashB = 576 - 256 - hi * 128 + lane;
            const unsigned wA_ = doneA ? 0u : uhiA - uloA, wB_ = doneB ? 0u : uhiB - uloB;
            int posA = 0, posB = 0;
#pragma unroll
            for (int T = 0; T < 64; ++T) {
                const bool fA = (scA[T] - uloA) < wA_, fB = (scB[T] - uloB) < wB_;
                const unsigned long long mA = __ballot(fA), mB = __ballot(fB);
                const int iA = hi ? __builtin_amdgcn_mbcnt_hi((unsigned)(mA >> 32), 0) : __builtin_amdgcn_mbcnt_lo((unsigned)mA, 0);
                const int iB = hi ? __builtin_amdgcn_mbcnt_hi((unsigned)(mB >> 32), 0) : __builtin_amdgcn_mbcnt_lo((unsigned)mB, 0);
                lstA[fA ? posA + iA : trashA] = scA[T];
                lstB[fB ? posB + iB : trashB] = scB[T];
                posA += hi ? __popc((unsigned)(mA >> 32)) : __popc((unsigned)mA); posB += hi ? __popc((unsigned)(mB >> 32)) : __popc((unsigned)mB);
            }
            asm volatile("s_waitcnt lgkmcnt(0)" ::: "memory");
            unsigned ca_[4], cb_[4];
#pragma unroll
            for (int j = 0; j < 4; ++j) { ca_[j] = (r32 + 32 * j < posA) ? lstA[r32 + 32 * j] : 0u; cb_[j] = (r32 + 32 * j < posB) ? lstB[r32 + 32 * j] : 0u; }
            const int baseA = max(chiA, 0), baseB = max(chiB, 0);
            for (; itn < 400; ++itn) {
                unsigned mnA = 0xffffffffu, mxA = 0u, mnB = 0xffffffffu, mxB = 0u;
                const unsigned wa = doneA ? 0u : uhiA - uloA, wb = doneB ? 0u : uhiB - uloB;
#pragma unroll
                for (int j = 0; j < 4; ++j) { if ((ca_[j] - uloA) < wa) { mnA = min(mnA, ca_[j]); mxA = max(mxA, ca_[j]); } if ((cb_[j] - uloB) < wb) { mnB = min(mnB, cb_[j]); mxB = max(mxB, cb_[j]); } }
#pragma unroll
                for (int o = 1; o < 32; o <<= 1) { mnA = min(mnA, (unsigned)__shfl_xor((int)mnA, o)); mxA = max(mxA, (unsigned)__shfl_xor((int)mxA, o)); mnB = min(mnB, (unsigned)__shfl_xor((int)mnB, o)); mxB = max(mxB, (unsigned)__shfl_xor((int)mxB, o)); }
                if (!doneA) { if (mnA >= mxA) { thA = mxA + 1u; needA = 256 - max(chiA, 0); doneA = true; } else { uloA = mnA; uhiA = mxA + 1u; if (cloA < 0) cloA = nA; if (chiA < 0) chiA = 0; } }
                if (!doneB) { if (mnB >= mxB) { thB = mxB + 1u; needB = 256 - max(chiB, 0); doneB = true; } else { uloB = mnB; uhiB = mxB + 1u; if (cloB < 0) cloB = nB; if (chiB < 0) chiB = 0; } }
                if (!__any(!doneA || !doneB)) break;
                const unsigned pA = doneA ? 0xffffffffu : next_pivot(uloA, uhiA, cloA, chiA, itn | 1), pB = doneB ? 0xffffffffu : next_pivot(uloB, uhiB, cloB, chiB, itn | 1);
                int pk = 0;
#pragma unroll
                for (int j = 0; j < 4; ++j) pk += ((ca_[j] >= pA) ? 1 : 0) + ((cb_[j] >= pB) ? 0x10000 : 0);
                pk += __shfl_xor(pk, 1); pk += __shfl_xor(pk, 2); pk += __shfl_xor(pk, 4); pk += __shfl_xor(pk, 8); pk += __shfl_xor(pk, 16);
                const int ca = baseA + (pk & 0xffff), cb = baseB + (pk >> 16);
                if (!doneA) { if (ca == 256) { thA = pA; needA = 0; doneA = true; } else if (ca > 256) { uloA = pA; cloA = ca; } else { uhiA = pA; chiA = ca; } }
                if (!doneB) { if (cb == 256) { thB = pB; needB = 0; doneB = true; } else if (cb > 256) { uloB = pB; cloB = cb; } else { uhiB = pB; chiB = cb; } }
            }
        }
        int rem0 = __builtin_amdgcn_readlane(needA, 0), rem1 = __builtin_amdgcn_readlane(needB, 0), rem2 = __builtin_amdgcn_readlane(needA, 32), rem3 = __builtin_amdgcn_readlane(needB, 32);
        const bool anytie = (rem0 | rem1 | rem2 | rem3) != 0;
        LAS unsigned* bmr = bm + 4 * rnd; asm volatile("" : "+v"(bmr));
#pragma unroll
        for (int T = 0; T < 64; ++T) {
            if (T <= Tm_b) {
                const unsigned long long mA = __ballot(scA[T] >= thA), mB = __ballot(scB[T] >= thB);
                unsigned m0 = (unsigned)mA, m2 = (unsigned)(mA >> 32), m1 = (unsigned)mB, m3 = (unsigned)(mB >> 32);
                if (anytie) {
                    const unsigned long long eA = __ballot(scA[T] == thA - 1u), eB = __ballot(scB[T] == thB - 1u);
                    unsigned e0 = (unsigned)eA, e2 = (unsigned)(eA >> 32), e1 = (unsigned)eB, e3 = (unsigned)(eB >> 32);
                    while (rem0 > 0 && e0) { const unsigned bit = e0 & (0u - e0); m0 |= bit; e0 ^= bit; --rem0; }
                    while (rem1 > 0 && e1) { const unsigned bit = e1 & (0u - e1); m1 |= bit; e1 ^= bit; --rem1; }
                    while (rem2 > 0 && e2) { const unsigned bit = e2 & (0u - e2); m2 |= bit; e2 ^= bit; --rem2; }
                    while (rem3 > 0 && e3) { const unsigned bit = e3 & (0u - e3); m3 |= bit; e3 ^= bit; --rem3; }
                }
                if (lane == 0) { u32x4 w; w.x = m0; w.y = m1; w.z = m2; w.w = m3; *(LAS u32x4*)(bmr + T * 8) = w; }
            }
        }
    }
    asm volatile("s_waitcnt lgkmcnt(0)" ::: "memory");
    const int qc = r32 >> 2, hc = r32 & 3;
    const GAS bf16_t* kvb = (const GAS bf16_t*)a.KV + (size_t)b * SEQ * 128;
    const size_t qrow = (size_t)(b * SEQ + tw + qc);
    bf16x8 bq[4];
#pragma unroll
    for (int s = 0; s < 4; ++s) bq[s] = *(const GAS bf16x8*)((const GAS bf16_t*)a.Z + qrow * ZP + ZB_Q + hc * 64 + 16 * s + 8 * hi);
    f32x16 o0 = zero16, o1 = zero16; float lsum = 0.f;
    const int Tend = (tw + 7) >> 5;
    const int g16 = lane >> 4, i16 = lane & 15, q4 = i16 >> 2, p4 = i16 & 3;
    const int vrd = ((g16 >> 1) * 4 + q4) * 64 + (16 * (g16 & 1) + 4 * p4) * 2;
    const int vwr_key = lane >> 3, vwr_ch = lane & 7;
    u32x4 vst[4]; bf16x8 ak[4];
    auto load_tile = [&](int T) {
#pragma unroll
        for (int s = 0; s < 4; ++s) ak[s] = *(const GAS bf16x8*)(kvb + (size_t)(32 * T + r32) * 128 + 16 * s + 8 * hi);
#pragma unroll
        for (int i = 0; i < 4; ++i) vst[i] = *(const GAS u32x4*)(kvb + (size_t)(32 * T + vwr_key + 8 * i) * 128 + 64 + 8 * vwr_ch);
    };
#ifdef PROBE_ATT
    for (int rep_ = 0; rep_ < 2; ++rep_) { o0 = zero16; o1 = zero16; lsum = 0.f;
#endif
    load_tile(0);
#pragma unroll 1
    for (int T = 0; T <= Tend; ++T) {
#pragma unroll
        for (int i = 0; i < 4; ++i) *(LAS u32x4*)(vimg + (vwr_ch >> 2) * 2048 + (vwr_key + 8 * i) * 64 + (vwr_ch & 3) * 16) = vst[i];
        f32x16 sacc = MFMA32(ak[0], bq[0], zero16); sacc = MFMA32(ak[1], bq[1], sacc); sacc = MFMA32(ak[2], bq[2], sacc); sacc = MFMA32(ak[3], bq[3], sacc);
        const unsigned mw = bm[T * 8 + qc] >> (4 * hi);
        if (T < Tend) load_tile(T + 1);
        asm volatile("s_waitcnt lgkmcnt(0)" ::: "memory");
        s16x4 va[2][2][2];
#pragma unroll
        for (int dt = 0; dt < 2; ++dt)
#pragma unroll
            for (int s = 0; s < 2; ++s) { va[dt][s][0] = vtr(vimg + dt * 2048 + (16 * s) * 64 + vrd); va[dt][s][1] = vtr(vimg + dt * 2048 + (16 * s + 8) * 64 + vrd); }
        unsigned pw[8];
#pragma unroll
        for (int r = 0; r < 16; r += 2) {
            const float e0 = __builtin_amdgcn_exp2f(fminf(sacc[r], 64.f)), e1 = __builtin_amdgcn_exp2f(fminf(sacc[r + 1], 64.f));
            const int c0 = (r & 3) + 8 * (r >> 2), c1 = ((r + 1) & 3) + 8 * ((r + 1) >> 2);
            const float p0 = __builtin_bit_cast(float, __builtin_bit_cast(unsigned, e0) & (unsigned)__builtin_amdgcn_sbfe((int)mw, c0, 1));
            const float p1 = __builtin_bit_cast(float, __builtin_bit_cast(unsigned, e1) & (unsigned)__builtin_amdgcn_sbfe((int)mw, c1, 1));
            lsum += p0 + p1;
            pw[r >> 1] = pk2(p0, p1);
        }
        asm volatile("s_waitcnt lgkmcnt(0)" ::: "memory");
#pragma unroll
        for (int s = 0; s < 2; ++s) {
            u32x4 pv4; pv4.x = pw[4 * s]; pv4.y = pw[4 * s + 1]; pv4.z = pw[4 * s + 2]; pv4.w = pw[4 * s + 3];
            const bf16x8 pb = __builtin_bit_cast(bf16x8, pv4);
            const bf16x8 v0 = __builtin_shufflevector(va[0][s][0], va[0][s][1], 0, 1, 2, 3, 4, 5, 6, 7), v1 = __builtin_shufflevector(va[1][s][0], va[1][s][1], 0, 1, 2, 3, 4, 5, 6, 7);
            o0 = MFMA32(v0, pb, o0); o1 = MFMA32(v1, pb, o1);
        }
    }
#ifdef PROBE_ATT
    }
#endif
    lsum += __shfl_xor(lsum, 32);
    const float rl = 1.0f / lsum;
    const GAS bf16_t* gp = (const GAS bf16_t*)a.Z + qrow * ZP + ZB_G + hc * 64; GAS bf16_t* yp = (GAS bf16_t*)a.Y + qrow * DM + 384 + hc * 64;
#pragma unroll
    for (int dt = 0; dt < 2; ++dt)
#pragma unroll
        for (int i = 0; i < 4; ++i) {
            const int d = 32 * dt + 8 * i + 4 * hi;
            const u32x2 gw = *(const GAS u32x2*)(gp + d);
            const float g0 = bflo(gw.x), g1 = bfhi(gw.x), g2 = bflo(gw.y), g3 = bfhi(gw.y);
            const f32x16& o = dt ? o1 : o0;
            u32x2 w; w.x = pk2(o[4 * i] * rl * g0 * sigmoidf_(g0), o[4 * i + 1] * rl * g1 * sigmoidf_(g1)); w.y = pk2(o[4 * i + 2] * rl * g2 * sigmoidf_(g2), o[4 * i + 3] * rl * g3 * sigmoidf_(g3));
            *(GAS u32x2*)(yp + d) = w;
        }
}
}
namespace dil {
using dsa::vtr; using dsa::s16x4;
__device__ __forceinline__ void dil_unit(const MixArgs& a, float* LQ, unsigned char* ldsb, int b, int gi, int u16) {
    const int tid = opaque_tid(), lane = tid & 63, wave = __builtin_amdgcn_readfirstlane(tid >> 6), r32 = lane & 31, hi = lane >> 5;
    const int rate = (gi == 0) ? 1 : (gi == 1) ? 4 : 16, nblk = 16 / rate, c = u16 / nblk, qb = u16 % nblk;
    const int head = gi * 2 + (wave >> 2), q0 = 128 * qb + 32 * (wave & 3);
    const GAS bf16_t* zb = (const GAS bf16_t*)a.Z + (size_t)b * SEQ * ZP;
    LAS unsigned char* vimg = (LAS unsigned char*)ldsb + wave * 4096;
    f32x16 zero16;
#pragma unroll
    for (int i = 0; i < 16; ++i) zero16[i] = 0.f;
    const size_t qrow = (size_t)b * SEQ + (size_t)(q0 + r32) * rate + c;
    bf16x8 bq[4];
#pragma unroll
    for (int s = 0; s < 4; ++s) bq[s] = *(const GAS bf16x8*)((const GAS bf16_t*)a.Z + qrow * ZP + ZC_Q + head * 64 + 16 * s + 8 * hi);
    f32x16 o0 = zero16, o1 = zero16; float lsum = 0.f;
    const int g16 = lane >> 4, i16 = lane & 15, q4 = i16 >> 2, p4 = i16 & 3;
    const int vrd = ((g16 >> 1) * 4 + q4) * 64 + (16 * (g16 & 1) + 4 * p4) * 2;
    const int vwr_key = lane >> 3, vwr_ch = lane & 7;
#pragma unroll 1
    for (int ti = 0; ti < 5; ++ti) {
        const int j0 = q0 - 128 + 32 * ti;
        if (j0 < 0) continue;
        bf16x8 ak[4]; u32x4 vst[4];
#pragma unroll
        for (int s = 0; s < 4; ++s) ak[s] = *(const GAS bf16x8*)(zb + ((size_t)(j0 + r32) * rate + c) * ZP + ZC_K + head * 64 + 16 * s + 8 * hi);
#pragma unroll
        for (int i = 0; i < 4; ++i) vst[i] = *(const GAS u32x4*)(zb + ((size_t)(j0 + vwr_key + 8 * i) * rate + c) * ZP + ZC_V + head * 64 + 8 * vwr_ch);
#pragma unroll
        for (int i = 0; i < 4; ++i) *(LAS u32x4*)(vimg + (vwr_ch >> 2) * 2048 + (vwr_key + 8 * i) * 64 + (vwr_ch & 3) * 16) = vst[i];
        f32x16 sacc = MFMA32(ak[0], bq[0], zero16); sacc = MFMA32(ak[1], bq[1], sacc); sacc = MFMA32(ak[2], bq[2], sacc); sacc = MFMA32(ak[3], bq[3], sacc);
        asm volatile("s_waitcnt lgkmcnt(0)" ::: "memory");
        s16x4 va[2][2][2];
#pragma unroll
        for (int dt = 0; dt < 2; ++dt)
#pragma unroll
            for (int s = 0; s < 2; ++s) { va[dt][s][0] = vtr(vimg + dt * 2048 + (16 * s) * 64 + vrd); va[dt][s][1] = vtr(vimg + dt * 2048 + (16 * s + 8) * 64 + vrd); }
        const int dbase = q0 + r32 - j0 - 4 * hi;
        unsigned pw[8];
#pragma unroll
        for (int r = 0; r < 16; r += 2) {
            const int d0 = dbase - ((r & 3) + 8 * (r >> 2)), d1 = dbase - (((r + 1) & 3) + 8 * ((r + 1) >> 2));
            float p0 = __builtin_amdgcn_exp2f(fminf(sacc[r], 64.f)), p1 = __builtin_amdgcn_exp2f(fminf(sacc[r + 1], 64.f));
            p0 = ((unsigned)d0 <= 128u) ? p0 : 0.f; p1 = ((unsigned)d1 <= 128u) ? p1 : 0.f;
            lsum += p0 + p1;
            pw[r >> 1] = pk2(p0, p1);
        }
        asm volatile("s_waitcnt lgkmcnt(0)" ::: "memory");
#pragma unroll
        for (int s = 0; s < 2; ++s) {
            u32x4 pv4; pv4.x = pw[4 * s]; pv4.y = pw[4 * s + 1]; pv4.z = pw[4 * s + 2]; pv4.w = pw[4 * s + 3];
            const bf16x8 pb = __builtin_bit_cast(bf16x8, pv4);
            const bf16x8 v0 = __builtin_shufflevector(va[0][s][0], va[0][s][1], 0, 1, 2, 3, 4, 5, 6, 7), v1 = __builtin_shufflevector(va[1][s][0], va[1][s][1], 0, 1, 2, 3, 4, 5, 6, 7);
            o0 = MFMA32(v0, pb, o0); o1 = MFMA32(v1, pb, o1);
        }
    }
    lsum += __shfl_xor(lsum, 32);
    if (hi == 0) LQ[qrow * 8 + head] = lsum;
    GAS bf16_t* yp = (GAS bf16_t*)a.Y + qrow * DM + 640 + head * 64;
#pragma unroll
    for (int dt = 0; dt < 2; ++dt)
#pragma unroll
        for (int i = 0; i < 4; ++i) {
            const int d = 32 * dt + 8 * i + 4 * hi; const f32x16& o = dt ? o1 : o0;
            u32x2 w; w.x = pk2(o[4 * i], o[4 * i + 1]); w.y = pk2(o[4 * i + 2], o[4 * i + 3]);
            *(GAS u32x2*)(yp + d) = w;
        }
}
__device__ __forceinline__ void dil_merge_row(const MixArgs& a, const float* LQ, size_t row, int lane) {
    GAS bf16_t* yp = (GAS bf16_t*)a.Y + row * DM + 640; const GAS bf16_t* gp = (const GAS bf16_t*)a.Z + row * ZP + ZC_G;
    const float* lq = LQ + row * 8;
    const float L0 = lq[0] + lq[2] + lq[4], L1 = lq[1] + lq[3] + lq[5];
#pragma unroll
    for (int j = 0; j < 3; ++j) {
        const int col = 128 * j + 2 * lane, head = col >> 6; const float rl = 1.0f / ((head & 1) ? L1 : L0);
        const unsigned ow = *(const GAS unsigned*)(yp + col), gw = *(const GAS unsigned*)(gp + col);
        const float g0 = bflo(gw), g1 = bfhi(gw);
        *(GAS unsigned*)(yp + col) = pk2(bflo(ow) * rl * g0 * sigmoidf_(g0), bfhi(ow) * rl * g1 * sigmoidf_(g1));
    }
}
}
namespace rwkv {
using dsa::vtr; using dsa::s16x4;
constexpr int IP = 144;
constexpr int IMG = 64 * IP;
constexpr int S_WD = 0 * IMG, S_AD = 1 * IMG, S_V = 2 * IMG, S_AT = 3 * IMG, S_BH = 4 * IMG, S_KH = 5 * IMG, S_RT = 6 * IMG, S_KB = 7 * IMG, S_BB = 8 * IMG, S_ARB = 9 * IMG, S_AH = 10 * IMG, S_UV = 11 * IMG;
constexpr int S_AAK = S_WD, S_ARK = S_AD, S_TT = S_BH, S_W1 = S_KH;
constexpr int F_AAB = 12 * IMG;
constexpr int F_LG = S_ARB;
constexpr int F_TOT = F_AAB + 16384;
static_assert(F_TOT + 512 <= 131072 && F_LG + 16384 <= F_AAB, "rwkv LDS map");

struct RArgs { const float* mu; const float* w0; const float* a0; const float* k_k; const float* k_a; const float* r_k; const float* ln_g; const float* ln_b;
               const bf16_t* wupT; const bf16_t* aupT; bf16_t* RQ; bf16_t* RM; bf16_t* RN; float* RG; float* RB; };

__device__ __forceinline__ bf16x8 rowfrag(const LAS unsigned char* img, int r0, int k0, int r32, int hi) { return *(const LAS bf16x8*)(img + (r0 + r32) * IP + (k0 + 8 * hi) * 2); }
__device__ __forceinline__ bf16x8 colfrag(const LAS unsigned char* img, int c0, int k0, int lane) {
    const int g16 = lane >> 4, i16 = lane & 15;
    const LAS unsigned char* p = img + (k0 + 8 * (g16 >> 1) + (i16 >> 2)) * IP + (c0 + 16 * (g16 & 1) + 4 * (i16 & 3)) * 2;
    const s16x4 lo = vtr(p), hi4 = vtr(p + 4 * IP);
    return __builtin_shufflevector(lo, hi4, 0, 1, 2, 3, 4, 5, 6, 7);
}
__device__ __forceinline__ bf16x8 colfrag_perm(const LAS unsigned char* img, int c0, int k0, int lane) {
    const int g16 = lane >> 4, i16 = lane & 15;
    const LAS unsigned char* p = img + (k0 + 4 * (g16 >> 1) + (i16 >> 2)) * IP + (c0 + 16 * (g16 & 1) + 4 * (i16 & 3)) * 2;
    const s16x4 lo = vtr(p), hi4 = vtr(p + 8 * IP);
    return __builtin_shufflevector(lo, hi4, 0, 1, 2, 3, 4, 5, 6, 7);
}
__device__ __forceinline__ bf16x8 rowfrag_f32(const LAS float* img, int r0, int k0, int r32, int hi) {
    const LAS f32x4* p = (const LAS f32x4*)(img + (r0 + r32) * 64 + k0 + 8 * hi); const f32x4 a = p[0], b = p[1];
    u32x4 w; w.x = pk2(a[0], a[1]); w.y = pk2(a[2], a[3]); w.z = pk2(b[0], b[1]); w.w = pk2(b[2], b[3]); return __builtin_bit_cast(bf16x8, w);
}
__device__ __forceinline__ void store_T(LAS unsigned char* imgT, const f32x16& c, int r0, int c0, int r32, int hi) {
#pragma unroll
    for (int g = 0; g < 4; ++g) { u32x2 w; w.x = pk2(c[4 * g], c[4 * g + 1]); w.y = pk2(c[4 * g + 2], c[4 * g + 3]); *(LAS u32x2*)(imgT + (c0 + r32) * IP + (r0 + 8 * g + 4 * hi) * 2) = w; }
}
__device__ __forceinline__ void store_T_global(GAS bf16_t* gT  , const f32x16& c, int r0, int c0, int r32, int hi) {
#pragma unroll
    for (int g = 0; g < 4; ++g) { u32x2 w; w.x = pk2(c[4 * g], c[4 * g + 1]); w.y = pk2(c[4 * g + 2], c[4 * g + 3]); *(GAS u32x2*)(gT + (c0 + r32) * 64 + r0 + 8 * g + 4 * hi) = w; }
}
__device__ __forceinline__ f32x16 zero16() { f32x16 z;
#pragma unroll
    for (int i = 0; i < 16; ++i) z[i] = 0.f;
    return z; }
#define WSYNC() asm volatile("s_waitcnt lgkmcnt(0)" ::: "memory")
#define BAR() do { asm volatile("s_waitcnt lgkmcnt(0)" ::: "memory"); __syncthreads(); } while (0)

__device__ __forceinline__ void rwkv_chunk_unit(const MixArgs& a, const RArgs& ra, unsigned char* ldsb, int b, int h, int ck) {
    const int tid = opaque_tid(), lane = tid & 63, wave = __builtin_amdgcn_readfirstlane(tid >> 6), r32 = lane & 31, hi = lane >> 5;
    LAS unsigned char* L = (LAS unsigned char*)ldsb;
    LAS float* fETA = (LAS float*)(L + F_AAB); LAS float* fAAB = fETA; LAS float* fLG = (LAS float*)(L + F_LG); LAS float* fTOT = (LAS float*)(L + F_TOT);
    const int t0 = ck * 64;
    const size_t row0 = (size_t)b * SEQ + t0;
    const int unit = (b * 6 + h) * 32 + ck;
    const int et = tid >> 3, ec = (tid & 7) * 8, hc = h * 64 + ec;
    float r8[8], k8[8];
    {
        const GAS bf16_t* zr = (const GAS bf16_t*)a.Z + (row0 + et) * ZP; const bool hp = (t0 + et) > 0;
        auto mix8 = [&](int col, float* out) {
            const u32x4 cw = *(const GAS u32x4*)(zr + col); u32x4 pw; pw.x = pw.y = pw.z = pw.w = 0u; if (hp) pw = *(const GAS u32x4*)(zr - ZP + col);
            const f32x4 m0 = *(const f32x4*)(ra.mu + col), m1 = *(const f32x4*)(ra.mu + col + 4);
            const float cv[8] = {bflo(cw.x), bfhi(cw.x), bflo(cw.y), bfhi(cw.y), bflo(cw.z), bfhi(cw.z), bflo(cw.w), bfhi(cw.w)};
            const float pv[8] = {bflo(pw.x), bfhi(pw.x), bflo(pw.y), bfhi(pw.y), bflo(pw.z), bfhi(pw.z), bflo(pw.w), bfhi(pw.w)};
            const float mv[8] = {m0[0], m0[1], m0[2], m0[3], m1[0], m1[1], m1[2], m1[3]};
#pragma unroll
            for (int i = 0; i < 8; ++i) out[i] = cv[i] + (pv[i] - cv[i]) * mv[i];
        };
        float v8[8], wd8[8], ad8[8];
        mix8(ZA_R + hc, r8); mix8(ZA_K + hc, k8); mix8(ZA_V + hc, v8); mix8(ZA_WD + ec, wd8); mix8(ZA_AD + ec, ad8);
#pragma unroll
        for (int i = 0; i < 8; ++i) wd8[i] = tanhf_(wd8[i]);
        u32x4 w;
        w.x = pk2(wd8[0], wd8[1]); w.y = pk2(wd8[2], wd8[3]); w.z = pk2(wd8[4], wd8[5]); w.w = pk2(wd8[6], wd8[7]); *(LAS u32x4*)(L + S_WD + et * IP + ec * 2) = w;
        w.x = pk2(ad8[0], ad8[1]); w.y = pk2(ad8[2], ad8[3]); w.z = pk2(ad8[4], ad8[5]); w.w = pk2(ad8[6], ad8[7]); *(LAS u32x4*)(L + S_AD + et * IP + ec * 2) = w;
        w.x = pk2(v8[0], v8[1]); w.y = pk2(v8[2], v8[3]); w.z = pk2(v8[4], v8[5]); w.w = pk2(v8[6], v8[7]); *(LAS u32x4*)(L + S_V + et * IP + ec * 2) = w;
    }
    BAR();
    const int q = wave & 3, tr = q >> 1, tc = q & 1, grp = wave >> 2;
    {
        const LAS unsigned char* Aimg = L + (grp ? S_AD : S_WD);
        const GAS bf16_t* Bg = (const GAS bf16_t*)(grp ? ra.aupT : ra.wupT) + (size_t)(h * 64 + 32 * tc + r32) * 64 + 8 * hi;
        f32x16 acc = zero16();
#pragma unroll
        for (int s = 0; s < 4; ++s) acc = MFMA32(rowfrag(Aimg, 32 * tr, 16 * s, r32, hi), *(const GAS bf16x8*)(Bg + 16 * s), acc);
        const int c = 32 * tc + r32; const float bias = grp ? ra.a0[h * 64 + c] : ra.w0[h * 64 + c];
        if (grp == 0) {
            float x[16], gs[4];
#pragma unroll
            for (int i = 0; i < 16; ++i) x[i] = -DECAY_SCALE * sigmoidf_(acc[i] + bias);
#pragma unroll
            for (int g = 0; g < 4; ++g) gs[g] = (x[4 * g] + x[4 * g + 1]) + (x[4 * g + 2] + x[4 * g + 3]);
            float run = 0.f;
#pragma unroll
            for (int g = 0; g < 4; ++g) { const float other = __shfl_xor(gs[g], 32); float base = run + (hi ? other : 0.f); run += gs[g] + other;
#pragma unroll
                for (int j = 0; j < 4; ++j) { base += x[4 * g + j]; fLG[(32 * tr + 8 * g + 4 * hi + j) * 64 + c] = base; } }
            if (tr == 0 && hi == 0) fTOT[c] = run;
        } else {
#pragma unroll
            for (int i = 0; i < 16; ++i) fETA[(32 * tr + (i & 3) + 8 * (i >> 2) + 4 * hi) * 64 + c] = sigmoidf_(acc[i] + bias);
        }
    }
    BAR();
    {
        const f32x4 l0 = *(const LAS f32x4*)(fLG + et * 64 + ec), l1 = *(const LAS f32x4*)(fLG + et * 64 + ec + 4);
        f32x4 p0 = {0.f, 0.f, 0.f, 0.f}, p1 = p0; if (et > 0) { p0 = *(const LAS f32x4*)(fLG + (et - 1) * 64 + ec); p1 = *(const LAS f32x4*)(fLG + (et - 1) * 64 + ec + 4); }
        const f32x4 e0 = *(const LAS f32x4*)(fETA + et * 64 + ec), e1 = *(const LAS f32x4*)(fETA + et * 64 + ec + 4);
        const f32x4 z0 = *(const LAS f32x4*)(fLG + 63 * 64 + ec), z1 = *(const LAS f32x4*)(fLG + 63 * 64 + ec + 4);
        const f32x4 u0 = *(const LAS f32x4*)(fTOT + ec), u1 = *(const LAS f32x4*)(fTOT + ec + 4);
        float lg[8] = {l0[0], l0[1], l0[2], l0[3], l1[0], l1[1], l1[2], l1[3]}, lp[8] = {p0[0], p0[1], p0[2], p0[3], p1[0], p1[1], p1[2], p1[3]};
        const float eta[8] = {e0[0], e0[1], e0[2], e0[3], e1[0], e1[1], e1[2], e1[3]}, tot[8] = {u0[0], u0[1], u0[2], u0[3], u1[0], u1[1], u1[2], u1[3]};
        float lC[8] = {z0[0], z0[1], z0[2], z0[3], z1[0], z1[1], z1[2], z1[3]};
        float kk[8], kp[8], ss = 0.f, bsum = 0.f;
#pragma unroll
        for (int i = 0; i < 8; ++i) {
            if (et >= 32) lg[i] += tot[i]; if (et >= 33) lp[i] += tot[i]; lC[i] += tot[i];
            kk[i] = k8[i] * ra.k_k[hc + i]; ss += kk[i] * kk[i];
            kp[i] = k8[i] * (1.f + (eta[i] - 1.f) * ra.k_a[hc + i]); bsum += r8[i] * kp[i] * ra.r_k[hc + i];
        }
        ss += __shfl_xor(ss, 1); ss += __shfl_xor(ss, 2); ss += __shfl_xor(ss, 4);
        bsum += __shfl_xor(bsum, 1); bsum += __shfl_xor(bsum, 2); bsum += __shfl_xor(bsum, 4);
        const float rn = __builtin_amdgcn_rsqf(fmaxf(ss, 1e-24f));
        if ((tid & 7) == 0) ra.RB[(row0 + et) * 8 + h] = bsum;
        float at[8], bh[8], kh[8], rt[8], kb[8], bb[8];
#pragma unroll
        for (int i = 0; i < 8; ++i) {
            const float kn = kk[i] * rn, bv = kn * eta[i];
            const float ig = fexp_(-lg[i]), gC = fexp_(lC[i] - lg[i]);
            at[i] = -kn * fexp_(lp[i]); bh[i] = bv * ig; kh[i] = kp[i] * ig; rt[i] = r8[i] * fexp_(lg[i]); kb[i] = kp[i] * gC; bb[i] = bv * gC;
        }
        if (et == 63) { f32x4 g0 = {fexp_(lC[0]), fexp_(lC[1]), fexp_(lC[2]), fexp_(lC[3])}, g1 = {fexp_(lC[4]), fexp_(lC[5]), fexp_(lC[6]), fexp_(lC[7])};
            *(f32x4*)(ra.RG + (size_t)unit * 64 + ec) = g0; *(f32x4*)(ra.RG + (size_t)unit * 64 + ec + 4) = g1; }
        auto put = [&](int slot, const float* v) { u32x4 w; w.x = pk2(v[0], v[1]); w.y = pk2(v[2], v[3]); w.z = pk2(v[4], v[5]); w.w = pk2(v[6], v[7]); *(LAS u32x4*)(L + slot + et * IP + ec * 2) = w; };
        put(S_AT, at); put(S_BH, bh); put(S_KH, kh); put(S_RT, rt); put(S_KB, kb); put(S_BB, bb);
    }
    BAR();
    {
        const LAS unsigned char* Aimg = L + (grp ? S_RT : S_AT);
        f32x16 c1 = zero16(), c2 = zero16();
        if (!(tr == 0 && tc == 1)) {
#pragma unroll
            for (int s = 0; s < 4; ++s) { const bf16x8 af = rowfrag(Aimg, 32 * tr, 16 * s, r32, hi);
                c1 = MFMA32(af, rowfrag(L + S_BH, 32 * tc, 16 * s, r32, hi), c1); c2 = MFMA32(af, rowfrag(L + S_KH, 32 * tc, 16 * s, r32, hi), c2); }
        }
        const int ci = 32 * tc + r32;
#pragma unroll
        for (int i = 0; i < 16; ++i) { const int t = 32 * tr + (i & 3) + 8 * (i >> 2) + 4 * hi; const bool keep = grp ? (ci <= t) : (ci < t); if (!keep) { c1[i] = 0.f; c2[i] = 0.f; } }
        if (grp == 0) {
#pragma unroll
            for (int i = 0; i < 16; ++i) fAAB[(32 * tr + (i & 3) + 8 * (i >> 2) + 4 * hi) * 64 + ci] = c1[i];
            store_T(L + S_AAK, c2, 32 * tr, 32 * tc, r32, hi);
        } else { store_T(L + S_ARB, c1, 32 * tr, 32 * tc, r32, hi); store_T(L + S_ARK, c2, 32 * tr, 32 * tc, r32, hi); }
    }
    BAR();
    f32x16 nacc = zero16(), yacc = zero16();
    if (grp == 0) {
        const int bk = wave;
        float d[16];
        if (lane < 16) {
#pragma unroll
            for (int t = 0; t < 16; ++t) { float s = (t == lane) ? 1.f : 0.f;
#pragma unroll
                for (int i = 0; i < 16; ++i) if (i < t) s += fAAB[(16 * bk + t) * 64 + 16 * bk + i] * d[i];
                d[t] = s; }
        }
        if (lane < 16) {
            LAS unsigned char* rowp = L + S_TT + (16 * bk + lane) * IP;
#pragma unroll
            for (int cb = 0; cb < 4; ++cb) { u32x4 w0, w1;
                if (cb == bk) { w0.x = pk2(d[0], d[1]); w0.y = pk2(d[2], d[3]); w0.z = pk2(d[4], d[5]); w0.w = pk2(d[6], d[7]); w1.x = pk2(d[8], d[9]); w1.y = pk2(d[10], d[11]); w1.z = pk2(d[12], d[13]); w1.w = pk2(d[14], d[15]); }
                else { w0.x = w0.y = w0.z = w0.w = 0u; w1 = w0; }
                *(LAS u32x4*)(rowp + cb * 32) = w0; *(LAS u32x4*)(rowp + cb * 32 + 16) = w1; }
        }
    } else {
        f32x16 c = zero16();
#pragma unroll
        for (int s = 0; s < 4; ++s) c = MFMA32(colfrag(L + S_AAK, 32 * tr, 16 * s, lane), colfrag(L + S_V, 32 * tc, 16 * s, lane), c);
        store_T(L + S_W1, c, 32 * tr, 32 * tc, r32, hi);
    }
    BAR();
    if (grp == 0) {
        if (wave < 2) { const int p = 2 * wave;
            f32x16 x = MFMA32(rowfrag_f32(fAAB, 16 * (p + 1), 16 * p, r32, hi), rowfrag(L + S_TT, 16 * p, 16 * p, r32, hi), zero16());
            u32x4 xw; xw.x = pk2(x[0], x[1]); xw.y = pk2(x[2], x[3]); xw.z = pk2(x[4], x[5]); xw.w = pk2(x[6], x[7]);
            const f32x16 tb = MFMA32(colfrag_perm(L + S_TT, 16 * (p + 1), 16 * (p + 1), lane), __builtin_bit_cast(bf16x8, xw), zero16());
            if (r32 < 16) {
#pragma unroll
                for (int g = 0; g < 2; ++g) { u32x2 w; w.x = pk2(tb[4 * g], tb[4 * g + 1]); w.y = pk2(tb[4 * g + 2], tb[4 * g + 3]); *(LAS u32x2*)(L + S_TT + (16 * p + r32) * IP + (16 * (p + 1) + 8 * g + 4 * hi) * 2) = w; } }
        }
    } else {
#pragma unroll
        for (int s = 0; s < 4; ++s) { const bf16x8 vf = colfrag(L + S_V, 32 * tr, 16 * s, lane);
            nacc = MFMA32(colfrag(L + S_KB, 32 * tr, 16 * s, lane), colfrag(L + S_V, 32 * tc, 16 * s, lane), nacc);
            yacc = MFMA32(vf, colfrag(L + S_ARK, 32 * tc, 16 * s, lane), yacc); }
    }
    BAR();
    if (wave == 0) {
        f32x16 x = zero16();
#pragma unroll
        for (int s = 0; s < 2; ++s) x = MFMA32(rowfrag_f32(fAAB, 32, 16 * s, r32, hi), rowfrag(L + S_TT, 0, 16 * s, r32, hi), x);
        f32x16 tb = zero16();
#pragma unroll
        for (int s = 0; s < 2; ++s) { u32x4 xw; xw.x = pk2(x[8 * s], x[8 * s + 1]); xw.y = pk2(x[8 * s + 2], x[8 * s + 3]); xw.z = pk2(x[8 * s + 4], x[8 * s + 5]); xw.w = pk2(x[8 * s + 6], x[8 * s + 7]);
            tb = MFMA32(colfrag_perm(L + S_TT, 32, 32 + 16 * s, lane), __builtin_bit_cast(bf16x8, xw), tb); }
        store_T(L + S_TT, tb, 32, 0, r32, hi);
    }
    BAR();
    {
        f32x16 c = zero16();
#pragma unroll
        for (int s = 0; s < 4; ++s) { const bf16x8 tf = colfrag(L + S_TT, 32 * tr, 16 * s, lane);
            c = MFMA32(tf, grp ? rowfrag(L + S_W1, 32 * tc, 16 * s, r32, hi) : colfrag(L + S_AT, 32 * tc, 16 * s, lane), c); }
        store_T(L + (grp ? S_UV : S_AH), c, 32 * tr, 32 * tc, r32, hi);
    }
    BAR();
    {
        const LAS unsigned char* Aimg = L + (grp ? S_UV : S_AH);
        f32x16 c1 = grp ? nacc : zero16(), c2 = grp ? yacc : zero16();
#pragma unroll
        for (int s = 0; s < 4; ++s) { const bf16x8 af = rowfrag(Aimg, 32 * tr, 16 * s, r32, hi);
            if (grp) c1 = MFMA32(colfrag(L + S_BB, 32 * tr, 16 * s, lane), rowfrag(L + S_UV, 32 * tc, 16 * s, r32, hi), c1);
            else c1 = MFMA32(af, colfrag(L + S_BB, 32 * tc, 16 * s, lane), c1);
            c2 = MFMA32(af, colfrag(L + S_ARB, 32 * tc, 16 * s, lane), c2); }
        GAS bf16_t* gq = (GAS bf16_t*)ra.RQ + (size_t)unit * 4096; GAS bf16_t* gm = (GAS bf16_t*)ra.RM + (size_t)unit * 4096; GAS bf16_t* gn = (GAS bf16_t*)ra.RN + (size_t)unit * 4096;
        if (grp == 0) {
            store_T_global(gm, c1, 32 * tr, 32 * tc, r32, hi);
#pragma unroll
            for (int g = 0; g < 4; ++g) { const u32x2 w = *(const LAS u32x2*)(L + S_RT + (32 * tc + r32) * IP + (32 * tr + 8 * g + 4 * hi) * 2);
                c2[4 * g] += bflo(w.x); c2[4 * g + 1] += bfhi(w.x); c2[4 * g + 2] += bflo(w.y); c2[4 * g + 3] += bfhi(w.y); }
            store_T_global(gq, c2, 32 * tr, 32 * tc, r32, hi);
        } else {
            store_T_global(gn, c1, 32 * tr, 32 * tc, r32, hi);
            GAS bf16_t* yp = (GAS bf16_t*)a.Y + (row0 + 32 * tc + r32) * DM + h * 64 + 32 * tr;
#pragma unroll
            for (int g = 0; g < 4; ++g) { u32x2 w; w.x = pk2(c2[4 * g], c2[4 * g + 1]); w.y = pk2(c2[4 * g + 2], c2[4 * g + 3]); *(GAS u32x2*)(yp + 8 * g + 4 * hi) = w; }
        }
    }
    BAR();
}

template <bool DRY = false> __device__ __forceinline__ void rwkv_scan_chain(const RArgs& ra, unsigned char* ldsb, int b, int h) {
    const int tid = opaque_tid(), lane = tid & 63, wave = __builtin_amdgcn_readfirstlane(tid >> 6), r32 = lane & 31, hi = lane >> 5;
    LAS unsigned char* L = (LAS unsigned char*)ldsb;
    const int q = wave & 3, tr = q >> 1, tc = q & 1;
    f32x16 st = zero16();
    for (int i = tid; i < 2 * IMG / 16; i += 512) { u32x4 z; z.x = z.y = z.z = z.w = 0u; *(LAS u32x4*)(L + i * 16) = z; }
    BAR();
    const int ubase = (b * 6 + h) * 32;
    bf16x8 bm[4]; u32x2 nw[4]; f32x4 gc[4];
    auto fetch = [&](int unit) {
        const GAS bf16_t* gm = (const GAS bf16_t*)ra.RM + (size_t)unit * 4096 + (32 * tr + r32) * 64 + 8 * hi;
        const GAS bf16_t* gn = (const GAS bf16_t*)ra.RN + (size_t)unit * 4096 + (32 * tc + r32) * 64 + 32 * tr + 4 * hi;
#pragma unroll
        for (int s = 0; s < 4; ++s) bm[s] = *(const GAS bf16x8*)(gm + 16 * s);
#pragma unroll
        for (int g = 0; g < 4; ++g) { nw[g] = *(const GAS u32x2*)(gn + 8 * g); gc[g] = *(const GAS f32x4*)(ra.RG + (size_t)unit * 64 + 32 * tr + 8 * g + 4 * hi); }
    };
    if (wave < 4) fetch(ubase);
#pragma unroll 1
    for (int ck = 0; ck < 32; ++ck) {
        const LAS unsigned char* Simg = L + (ck & 1) * IMG; LAS unsigned char* Snew = L + ((ck + 1) & 1) * IMG;
        if (wave < 4) {
            const int unit = ubase + ck;
            f32x16 acc;
#pragma unroll
            for (int g = 0; g < 4; ++g) { acc[4 * g] = st[4 * g] * gc[g][0] + bflo(nw[g].x); acc[4 * g + 1] = st[4 * g + 1] * gc[g][1] + bfhi(nw[g].x); acc[4 * g + 2] = st[4 * g + 2] * gc[g][2] + bflo(nw[g].y); acc[4 * g + 3] = st[4 * g + 3] * gc[g][3] + bfhi(nw[g].y); }
#pragma unroll
            for (int s = 0; s < 4; ++s) acc = MFMA32(bm[s], rowfrag(Simg, 32 * tc, 16 * s, r32, hi), acc);
            asm volatile("s_waitcnt vmcnt(0)" ::: "memory");
            __builtin_amdgcn_s_barrier();
            if (!DRY || st[0] == 1.2345e-30f) store_T_global((GAS bf16_t*)ra.RM + (size_t)unit * 4096, st, 32 * tr, 32 * tc, r32, hi);
            st = acc;
            store_T(Snew, st, 32 * tr, 32 * tc, r32, hi);
            if (ck < 31) fetch(unit + 1);
        } else {
            asm volatile("s_waitcnt vmcnt(0)" ::: "memory");
            __builtin_amdgcn_s_barrier();
        }
        BAR();
    }
}
constexpr int RP = 136, RTILE = 64 * RP, R3_TEAM_LDS = 3 * RTILE;
__device__ __forceinline__ void rwkv_out_unit(const MixArgs& a, const RArgs& ra, unsigned char* ldsb, int b, int h, int ck) {
    const int tid = opaque_tid(), lane = tid & 63, wave = __builtin_amdgcn_readfirstlane(tid >> 6), r32 = lane & 31, hi = lane >> 5;
    const int tw = wave & 1, tt = tid & 127;
    LAS unsigned char* TL = (LAS unsigned char*)ldsb + (wave >> 1) * R3_TEAM_LDS;
    LAS unsigned char* VM = TL, *SG = TL + RTILE, *YC = TL + 2 * RTILE;
    const int unit = (b * 6 + h) * 32 + ck;
    const size_t row0 = (size_t)b * SEQ + ck * 64;
#pragma unroll
    for (int j = 0; j < 4; ++j) {
        const int c = tt + 128 * j, t = c >> 3, c8 = (c & 7) * 8, hc = h * 64 + c8;
        const GAS bf16_t* zr = (const GAS bf16_t*)a.Z + (row0 + t) * ZP; const bool hp = (ck * 64 + t) > 0;
        const u32x4 vc = *(const GAS u32x4*)(zr + ZA_V + hc), gcw = *(const GAS u32x4*)(zr + ZA_G + hc);
        u32x4 vp, gp; vp.x = vp.y = vp.z = vp.w = 0u; gp = vp; if (hp) { vp = *(const GAS u32x4*)(zr - ZP + ZA_V + hc); gp = *(const GAS u32x4*)(zr - ZP + ZA_G + hc); }
        const u32x4 yc = *(const GAS u32x4*)((const GAS bf16_t*)a.Y + (row0 + t) * DM + hc);
        const f32x4 mv0 = *(const f32x4*)(ra.mu + ZA_V + hc), mv1 = *(const f32x4*)(ra.mu + ZA_V + hc + 4), mg0 = *(const f32x4*)(ra.mu + ZA_G + hc), mg1 = *(const f32x4*)(ra.mu + ZA_G + hc + 4);
        const float vcur[8] = {bflo(vc.x), bfhi(vc.x), bflo(vc.y), bfhi(vc.y), bflo(vc.z), bfhi(vc.z), bflo(vc.w), bfhi(vc.w)}, vprv[8] = {bflo(vp.x), bfhi(vp.x), bflo(vp.y), bfhi(vp.y), bflo(vp.z), bfhi(vp.z), bflo(vp.w), bfhi(vp.w)};
        const float gcur[8] = {bflo(gcw.x), bfhi(gcw.x), bflo(gcw.y), bfhi(gcw.y), bflo(gcw.z), bfhi(gcw.z), bflo(gcw.w), bfhi(gcw.w)}, gprv[8] = {bflo(gp.x), bfhi(gp.x), bflo(gp.y), bfhi(gp.y), bflo(gp.z), bfhi(gp.z), bflo(gp.w), bfhi(gp.w)};
        const float muv[8] = {mv0[0], mv0[1], mv0[2], mv0[3], mv1[0], mv1[1], mv1[2], mv1[3]}, mug[8] = {mg0[0], mg0[1], mg0[2], mg0[3], mg1[0], mg1[1], mg1[2], mg1[3]};
        float vm[8], sg[8];
#pragma unroll
        for (int i = 0; i < 8; ++i) { vm[i] = vcur[i] + (vprv[i] - vcur[i]) * muv[i]; const float gg = gcur[i] + (gprv[i] - gcur[i]) * mug[i]; sg[i] = gg * sigmoidf_(gg); }
        u32x4 w; w.x = pk2(vm[0], vm[1]); w.y = pk2(vm[2], vm[3]); w.z = pk2(vm[4], vm[5]); w.w = pk2(vm[6], vm[7]);
        *(LAS u32x2*)(VM + t * RP + c8 * 2) = (u32x2){w.x, w.y}; *(LAS u32x2*)(VM + t * RP + c8 * 2 + 8) = (u32x2){w.z, w.w};
        w.x = pk2(sg[0], sg[1]); w.y = pk2(sg[2], sg[3]); w.z = pk2(sg[4], sg[5]); w.w = pk2(sg[6], sg[7]);
        *(LAS u32x2*)(SG + t * RP + c8 * 2) = (u32x2){w.x, w.y}; *(LAS u32x2*)(SG + t * RP + c8 * 2 + 8) = (u32x2){w.z, w.w};
        *(LAS u32x2*)(YC + t * RP + c8 * 2) = (u32x2){yc.x, yc.y}; *(LAS u32x2*)(YC + t * RP + c8 * 2 + 8) = (u32x2){yc.z, yc.w};
    }
    const GAS bf16_t* gq = (const GAS bf16_t*)ra.RQ + (size_t)unit * 4096 + (32 * tw + r32) * 64 + 8 * hi;
    const GAS bf16_t* gs = (const GAS bf16_t*)ra.RM + (size_t)unit * 4096 + r32 * 64 + 8 * hi;
    bf16x8 bq[4], a0[4], a1[4];
#pragma unroll
    for (int s = 0; s < 4; ++s) { bq[s] = *(const GAS bf16x8*)(gq + 16 * s); a0[s] = *(const GAS bf16x8*)(gs + 16 * s); a1[s] = *(const GAS bf16x8*)(gs + 32 * 64 + 16 * s); }
    const float beta = ra.RB[(row0 + 32 * tw + r32) * 8 + h];
    BAR();
    const int tl = 32 * tw + r32;
    f32x16 y0, y1;
#pragma unroll
    for (int g = 0; g < 4; ++g) { const u32x2 w0 = *(const LAS u32x2*)(YC + tl * RP + (8 * g + 4 * hi) * 2), w1 = *(const LAS u32x2*)(YC + tl * RP + (32 + 8 * g + 4 * hi) * 2);
        y0[4 * g] = bflo(w0.x); y0[4 * g + 1] = bfhi(w0.x); y0[4 * g + 2] = bflo(w0.y); y0[4 * g + 3] = bfhi(w0.y);
        y1[4 * g] = bflo(w1.x); y1[4 * g + 1] = bfhi(w1.x); y1[4 * g + 2] = bflo(w1.y); y1[4 * g + 3] = bfhi(w1.y); }
#pragma unroll
    for (int s = 0; s < 4; ++s) { y0 = MFMA32(a0[s], bq[s], y0); y1 = MFMA32(a1[s], bq[s], y1); }
    float sm = 0.f;
#pragma unroll
    for (int i = 0; i < 16; ++i) sm += y0[i] + y1[i];
    sm += __shfl_xor(sm, 32); const float mean = sm * (1.f / 64.f);
    float sq = 0.f;
#pragma unroll
    for (int i = 0; i < 16; ++i) { const float d0 = y0[i] - mean, d1 = y1[i] - mean; sq += d0 * d0 + d1 * d1; }
    sq += __shfl_xor(sq, 32); const float rstd = __builtin_amdgcn_rsqf(sq * (1.f / 64.f) + GN_EPS);
#pragma unroll
    for (int half = 0; half < 2; ++half)
#pragma unroll
        for (int g = 0; g < 4; ++g) {
            const int v0 = 32 * half + 8 * g + 4 * hi, hc = h * 64 + v0;
            const u32x2 vw = *(const LAS u32x2*)(VM + tl * RP + v0 * 2), sw = *(const LAS u32x2*)(SG + tl * RP + v0 * 2);
            const f32x4 lg4 = *(const f32x4*)(ra.ln_g + hc), lb4 = *(const f32x4*)(ra.ln_b + hc);
            const float vv[4] = {bflo(vw.x), bfhi(vw.x), bflo(vw.y), bfhi(vw.y)}, ss[4] = {bflo(sw.x), bfhi(sw.x), bflo(sw.y), bfhi(sw.y)};
            float o[4];
#pragma unroll
            for (int j = 0; j < 4; ++j) { const float yv = half ? y1[4 * g + j] : y0[4 * g + j]; o[j] = ((yv - mean) * rstd * lg4[j] + lb4[j] + beta * vv[j]) * ss[j]; }
            u32x2 w; w.x = pk2(o[0], o[1]); w.y = pk2(o[2], o[3]); *(LAS u32x2*)(YC + tl * RP + v0 * 2) = w;
        }
    BAR();
#pragma unroll
    for (int j = 0; j < 4; ++j) { const int c = tt + 128 * j, t = c >> 3, c8 = (c & 7) * 8;
        const u32x2 lo = *(const LAS u32x2*)(YC + t * RP + c8 * 2), hi2 = *(const LAS u32x2*)(YC + t * RP + c8 * 2 + 8);
        u32x4 w; w.x = lo.x; w.y = lo.y; w.z = hi2.x; w.w = hi2.y; *(GAS u32x4*)((GAS bf16_t*)a.Y + (row0 + t) * DM + h * 64 + c8) = w; }
    BAR();
}
}
constexpr int NWAVES = 8;
constexpr int RING_BYTES = 131072, LDSCTL_OFF = RING_BYTES, LDS_BYTES = 147456;
constexpr int CW_BAR = 4096;
struct Args { const float* in[19]; float* out; unsigned char* ws; };

__device__ __forceinline__ unsigned long long rd_ptr_u(volatile LAS unsigned long long* p) { const unsigned long long v = *p; const unsigned lo = __builtin_amdgcn_readfirstlane((unsigned)v), hi = __builtin_amdgcn_readfirstlane((unsigned)(v >> 32)); return ((unsigned long long)hi << 32) | lo; }
__global__ void __launch_bounds__(NWAVES * 64, 2) mega_fwd(Args args) {
    extern __shared__ __attribute__((aligned(16))) unsigned char lds[];
    const int tid = threadIdx.x, lane = tid & 63, wave = __builtin_amdgcn_readfirstlane(tid >> 6);
    const int G = gridDim.x, bx = blockIdx.x;
    unsigned char* ws = args.ws;
    volatile LAS unsigned* MISC = (volatile LAS unsigned*)((LAS unsigned char*)lds + LDSCTL_OFF);
    for (int u = tid; u < (LDS_BYTES - LDSCTL_OFF) / 4; u += NWAVES * 64) ((LAS unsigned*)((LAS unsigned char*)lds + LDSCTL_OFF))[u] = 0u;
    __syncthreads();
    (void)xcd_barrier_post((unsigned*)(ws + WS_CTL) + CW_BAR, MISC + 8);
    volatile LAS unsigned long long* PTRS = (volatile LAS unsigned long long*)((LAS unsigned char*)lds + LDSCTL_OFF + 256);
    if (tid < 19) PTRS[tid] = (unsigned long long)(uintptr_t)args.in[tid];
    if (tid == 19) PTRS[19] = (unsigned long long)(uintptr_t)args.out;
    if (tid == 20) PTRS[20] = (unsigned long long)(uintptr_t)args.ws;
    __syncthreads();
#define PTRS_RD(i) rd_ptr_u(({ LAS unsigned long long* p_ = (LAS unsigned long long*)((LAS unsigned char*)lds + LDSCTL_OFF + 256); asm volatile("" : "+v"(p_)); (volatile LAS unsigned long long*)p_ + (i); }))
#define ARGP(i) ((const float*)(uintptr_t)PTRS_RD(i))
#define OUTP ((float*)(uintptr_t)PTRS_RD(19))
#define WSP ((unsigned char*)(uintptr_t)PTRS_RD(20))
#ifdef PROBE_BAR
#define GRID_BAR() do { GRID_BAR1(); GRID_BAR1(); } while (0)
#else
#define GRID_BAR() GRID_BAR1()
#endif
#define GRID_BAR1() do { XcdBarrier b_; b_.bar = (unsigned*)(WSP + WS_CTL) + CW_BAR; b_.x = xb_xcc_id(); b_.st = (volatile LAS unsigned*)((LAS unsigned char*)lds + LDSCTL_OFF) + 8; xcd_barrier(b_); } while (0)
#define PHASE_IDS const int tid = opaque_tid(), lane = tid & 63, wave = __builtin_amdgcn_readfirstlane(tid >> 6), gw = bx * NWAVES + wave, ngw = G * NWAVES; (void)lane; (void)gw; (void)ngw; (void)tid; (void)wave;
    int K1024 = DM, K256 = 256; asm volatile("" : "+s"(K1024), "+s"(K256));
    {
        PHASE_IDS
        const float* x = args.in[0]; bf16_t* bufA = (bf16_t*)(ws + WS_BUFA); float* ssqA = (float*)(ws + WS_SSQA);
        PrepArgs pa; pa.w_in = args.in[3]; pa.norm_g = args.in[2]; pa.w_out = args.in[14]; pa.ple_g = args.in[15]; pa.w_gate = args.in[16]; pa.w_proj = args.in[17]; pa.w_up = args.in[6]; pa.a_up = args.in[8]; pa.ws = ws;
        prep_tables(ws, bx * NWAVES * 64 + tid, G * NWAVES * 64);
        prep_weights(pa, gw, ngw, (LAS float*)((LAS unsigned char*)lds + wave * 16384), lane);
#ifdef PROBE_PRO
        prep_weights(pa, gw, ngw, (LAS float*)((LAS unsigned char*)lds + wave * 16384), lane);
        for (int m = gw; m < MTOK; m += ngw) x_row_to_bf16(x + (size_t)m * DM, bufA + (size_t)m * DM, ssqA + (size_t)m * 16, lane);
#endif
        for (int m = gw; m < MTOK; m += ngw) x_row_to_bf16(x + (size_t)m * DM, bufA + (size_t)m * DM, ssqA + (size_t)m * 16, lane);
    }
    GRID_BAR();
    for (int L = 0; L < DEPTH; ++L) {
#define PHASE_PTRS unsigned char* ws = WSP; bf16_t* cur = (bf16_t*)(ws + ((L & 1) ? WS_BUFB : WS_BUFA)); bf16_t* oth = (bf16_t*)(ws + ((L & 1) ? WS_BUFA : WS_BUFB)); const unsigned char* wl = ws + WS_W + (size_t)L * W_LAYER; \
        bf16_t* Z = (bf16_t*)(ws + WS_Z); float* PP = (float*)(ws + WS_Z); bf16_t* PB = (bf16_t*)(ws + WS_PB); float* ssqA = (float*)(ws + WS_SSQA); float* ssqB = (float*)(ws + WS_SSQB); float* out = OUTP; \
        (void)cur; (void)oth; (void)wl; (void)Z; (void)PP; (void)PB; (void)ssqA; (void)ssqB; (void)out;
        {
            PHASE_PTRS
            const float* tab16 = (const float*)(ws + WS_TAB16); const float* tabI = (const float*)(ws + WS_TABI);
            const float* src = ARGP(1) + (size_t)L * MTOK * 256; PHASE_IDS
            for (size_t i = (size_t)bx * 512 + tid; i < (size_t)MTOK * 256 / 8; i += (size_t)G * 512) {
                const f32x4 a = ((const f32x4*)src)[2 * i], b = ((const f32x4*)src)[2 * i + 1];
                u32x4 w; w.x = pk2(a.x, a.y); w.y = pk2(a.z, a.w); w.z = pk2(b.x, b.y); w.w = pk2(b.z, b.w); ((u32x4*)PB)[i] = w; }
            pg8::Gemm g{cur, (const bf16_t*)(wl + W_IN), MTOK, NPAD, K1024}; pg8::StaticOrder S; S.init(MTOK, NPAD, G, bx);
            epi::EpiInProj e; e.Z = Z; e.ssq = ssqA; e.tab16 = tab16; e.tabI = tabI; e.KV = (bf16_t*)(ws + WS_MISC + MISC_KV); e.IKC = (bf16_t*)(ws + WS_MISC + MISC_IKC);
#ifdef PROBE_G1
            pg8::gemm_phase<epi::EpiInProj, pg8::StaticOrder, true, true>((PG8_LAS unsigned char*)lds, g, S, e);
#endif
#ifdef PROBE_G1P
            { epi::EpiPlainZ ep; ep.Z = Z; pg8::gemm_phase<epi::EpiPlainZ, pg8::StaticOrder, true, true>((PG8_LAS unsigned char*)lds, g, S, ep); }
#endif
            pg8::gemm_phase<epi::EpiInProj, pg8::StaticOrder, true, true>((PG8_LAS unsigned char*)lds, g, S, e);
        }
        GRID_BAR();
        {
            PHASE_PTRS
            MixArgs ma; ma.Z = Z; ma.Y = oth; ma.KV = (const bf16_t*)(ws + WS_MISC + MISC_KV); ma.IKC = (const bf16_t*)(ws + WS_MISC + MISC_IKC); ma.mu = ARGP(4) + L * 1664; ma.w0 = ARGP(5) + L * 384; ma.w_up = ARGP(6) + (size_t)L * 64 * 384; ma.a0 = ARGP(7) + L * 384; ma.a_up = ARGP(8) + (size_t)L * 64 * 384;
            ma.k_k = ARGP(9) + L * 384; ma.k_a = ARGP(10) + L * 384; ma.r_k = ARGP(11) + L * 384; ma.ln_g = ARGP(12) + L * 384; ma.ln_b = ARGP(13) + L * 384;
            rwkv::RArgs ra; ra.mu = ma.mu; ra.w0 = ma.w0; ra.a0 = ma.a0; ra.k_k = ma.k_k; ra.k_a = ma.k_a; ra.r_k = ma.r_k; ra.ln_g = ma.ln_g; ra.ln_b = ma.ln_b;
            ra.wupT = (const bf16_t*)(wl + W_WUPT); ra.aupT = (const bf16_t*)(wl + W_AUPT); ra.RQ = cur; ra.RM = cur + (size_t)3072 * 4096; ra.RN = (bf16_t*)(ws + WS_MISC + MISC_RN); ra.RG = (float*)(ws + WS_MISC + MISC_RG); ra.RB = (float*)(ws + WS_MISC + MISC_RB);
#ifdef PROBE_R1
            for (int rep = 0; rep < 2; ++rep)
#endif
            for (int u = bx; u < 3072; u += G) rwkv::rwkv_chunk_unit(ma, ra, lds, u / 192, (u / 32) % 6, u & 31);
            for (int u = bx; u < 256; u += G) { const int bb = (u & 7) * 2 + ((u >> 3) & 1), jj = u >> 4; dsa::dsa_unit(ma, lds, bb, jj); dsa::dsa_unit(ma, lds, bb, 31 - jj); }
            __syncthreads();
            float* LQ = (float*)(ws + WS_MISC);
#ifdef PROBE_DIL
            for (int rep = 0; rep < 2; ++rep)
#endif
            for (int u = bx; u < 768; u += G) dil::dil_unit(ma, LQ, lds, u / 48, (u % 48) >> 4, u & 15);
        }
        GRID_BAR();
        {
            PHASE_PTRS
            MixArgs ma; ma.Z = Z; ma.Y = oth; const float* LQ = (const float*)(ws + WS_MISC); PHASE_IDS
            rwkv::RArgs ra; ra.mu = ARGP(4) + L * 1664; ra.ln_g = ARGP(12) + L * 384; ra.ln_b = ARGP(13) + L * 384;
            ra.RQ = cur; ra.RM = cur + (size_t)3072 * 4096; ra.RN = (bf16_t*)(ws + WS_MISC + MISC_RN); ra.RG = (float*)(ws + WS_MISC + MISC_RG); ra.RB = (float*)(ws + WS_MISC + MISC_RB);
            if (G > 96) {
#ifdef PROBE_R2
                if (bx < 96) rwkv::rwkv_scan_chain<true>(ra, lds, bx / 6, bx % 6);
#endif
                if (bx < 96) rwkv::rwkv_scan_chain(ra, lds, bx / 6, bx % 6);
                else for (int m = (bx - 96) * NWAVES + wave; m < MTOK; m += (G - 96) * NWAVES) dil::dil_merge_row(ma, LQ, (size_t)m, lane);
            } else {
                for (int u = bx; u < 96; u += G) rwkv::rwkv_scan_chain(ra, lds, u / 6, u % 6);
                for (int m = gw; m < MTOK; m += ngw) dil::dil_merge_row(ma, LQ, (size_t)m, lane);
            }
        }
        GRID_BAR();
        {
            PHASE_PTRS
            MixArgs ma; ma.Z = Z; ma.Y = oth;
            rwkv::RArgs ra; ra.mu = ARGP(4) + L * 1664; ra.ln_g = ARGP(12) + L * 384; ra.ln_b = ARGP(13) + L * 384;
            ra.RQ = cur; ra.RM = cur + (size_t)3072 * 4096; ra.RB = (float*)(ws + WS_MISC + MISC_RB); PHASE_IDS
            for (int u4 = bx; u4 < 768; u4 += G) { const int u = u4 * 4 + (wave >> 1); rwkv::rwkv_out_unit(ma, ra, lds, u / 192, (u / 32) % 6, u & 31); }
        }
        GRID_BAR();
        {
            PHASE_PTRS
            const float* x = ARGP(0);
            pg8::Gemm g{oth, (const bf16_t*)(wl + W_OUT), MTOK, DM, K1024}; pg8::StaticOrder S; S.init(MTOK, DM, G, bx);
            epi::EpiOutProj e; e.xin = (L == 0) ? x : out; e.xout = out; e.xb = cur; e.ssq_out = ssqB;
            pg8::gemm_phase<epi::EpiOutProj, pg8::StaticOrder, true, true>((PG8_LAS unsigned char*)lds, g, S, e);
            pg8::Gemm g2{PB, (const bf16_t*)(wl + W_PROJ), MTOK, DM, K256};
            epi::EpiF32 e2; e2.C = PP;
            pg8::gemm_phase<epi::EpiF32, pg8::StaticOrder, true, true>((PG8_LAS unsigned char*)lds, g2, S, e2);
#ifdef PROBE_PP
            pg8::gemm_phase<epi::EpiF32, pg8::StaticOrder, true, true>((PG8_LAS unsigned char*)lds, g2, S, e2);
#endif
#ifdef PROBE_G2
            { epi::EpiF32 e3; e3.C = (float*)(ws + WS_BUFA)  ; e3.C = PP; pg8::gemm_phase<epi::EpiF32, pg8::StaticOrder, true, true>((PG8_LAS unsigned char*)lds, g, S, e3); pg8::gemm_phase<epi::EpiF32, pg8::StaticOrder, true, true>((PG8_LAS unsigned char*)lds, g2, S, e2); }
#endif
        }
        GRID_BAR();
        {
            PHASE_PTRS
            pg8::Gemm g{cur, (const bf16_t*)(wl + W_GATE), MTOK, DM, K1024}; pg8::StaticOrder S; S.init(MTOK, DM, G, bx);
            epi::EpiGate e; e.xio = out; e.pp = PP; e.xb = oth; e.ssq_in = ssqB; e.ssq_out = ssqA;
            pg8::gemm_phase<epi::EpiGate, pg8::StaticOrder, true, true>((PG8_LAS unsigned char*)lds, g, S, e);
        }
        GRID_BAR();
    }
    {
        const int L = 0; PHASE_PTRS
        const float* fg = ARGP(18); PHASE_IDS
        for (int m = gw; m < MTOK; m += ngw) { const float rs = row_rstd(ssqA + (size_t)m * 16); f32x4* xr = (f32x4*)(out + (size_t)m * DM) + lane;
#pragma unroll
            for (int j = 0; j < 4; ++j) { const f32x4 gv = ((const f32x4*)fg)[64 * j + lane]; xr[64 * j] = xr[64 * j] * rs * gv; } }
    }
}

extern "C" void kernel_launch(void* const* d_in, const int* in_sizes, int n_in, void* d_out, int out_size, void* d_ws, size_t ws_size, hipStream_t stream) {
    static int grid = 0;
    if (grid == 0) {
        if (n_in != 19 || out_size != MTOK * DM || ws_size < WS_END) { fprintf(stderr, "kernel_launch: unexpected shapes n_in %d out %d ws %zu\n", n_in, out_size, ws_size); grid = -1; return; }
        int dev = 0, cus = 0, per_cu = 0;
        if (hipGetDevice(&dev) != hipSuccess || hipDeviceGetAttribute(&cus, hipDeviceAttributeMultiprocessorCount, dev) != hipSuccess) { grid = -1; return; }
        if (hipFuncSetAttribute((const void*)mega_fwd, hipFuncAttributeMaxDynamicSharedMemorySize, LDS_BYTES) != hipSuccess) { fprintf(stderr, "kernel_launch: hipFuncSetAttribute failed\n"); grid = -1; return; }
        if (hipOccupancyMaxActiveBlocksPerMultiprocessor(&per_cu, (const void*)mega_fwd, NWAVES * 64, LDS_BYTES) != hipSuccess || per_cu < 1) { fprintf(stderr, "kernel_launch: occupancy query says %d blocks per CU\n", per_cu); (void)hipGetLastError(); grid = -1; return; }
        grid = cus;
    }
    if (grid < 0) return;
    if (hipMemsetAsync((char*)d_ws + WS_CTL, 0, 1 * MiB, stream) != hipSuccess) return;
    Args a; memset(&a, 0, sizeof a);
    for (int i = 0; i < 19; ++i) a.in[i] = (const float*)d_in[i];
    a.out = (float*)d_out; a.ws = (unsigned char*)d_ws;
    hipLaunchKernelGGL(mega_fwd, dim3(grid), dim3(NWAVES * 64), LDS_BYTES, stream, a);
}
```

```cpp
#include <hip/hip_runtime.h>
#include <cstdio>
#include <cstdint>
#include <cmath>
#include <cstring>

constexpr int BATCH = 16, SEQ = 2048, DM = 1024, DEPTH = 4, MTOK = BATCH * SEQ;
constexpr int ZP = 4136;
constexpr int NPAD = 4352;
constexpr int ZA_R = 0, ZA_K = 384, ZA_V = 768, ZA_G = 1152, ZA_WD = 1536, ZA_AD = 1600;
constexpr int ZB_Q = 1664, ZB_K = 1920, ZB_V = 1984, ZB_IQ = 2048, ZB_IK = 2304, ZB_IW = 2336, ZB_G = 2344;
constexpr int ZC_Q = 2600, ZC_K = 2984, ZC_V = 3368, ZC_G = 3752;
constexpr float LOG2E = 1.4426950408889634f;
constexpr float QSCALE = 0.125f * LOG2E;
constexpr float IQSCALE = 0.17677669529663687f;
constexpr float IWSCALE = 0.35355339059327373f;
constexpr float NORM_EPS = 1e-6f, GN_EPS = 64e-5f;
constexpr float DECAY_SCALE = 0.6065306597126334f;

typedef unsigned short bf16_t;
typedef short bf16x8 __attribute__((ext_vector_type(8)));
typedef float f32x4 __attribute__((ext_vector_type(4)));
typedef float f32x16 __attribute__((ext_vector_type(16)));
typedef unsigned u32x4 __attribute__((ext_vector_type(4)));
typedef unsigned u32x2 __attribute__((ext_vector_type(2)));

__device__ __forceinline__ unsigned f2bf(float f) { unsigned u = __builtin_bit_cast(unsigned, f); return (u + 0x7fffu + ((u >> 16) & 1u)) >> 16; }
typedef float f32x2_t __attribute__((ext_vector_type(2))); typedef __bf16 bf16x2_t __attribute__((ext_vector_type(2)));
__device__ __forceinline__ unsigned pk2(float lo, float hi) { const f32x2_t v = {lo, hi}; return __builtin_bit_cast(unsigned, __builtin_convertvector(v, bf16x2_t)); }
__device__ __forceinline__ float bf2f(unsigned short b) { return __builtin_bit_cast(float, (unsigned)b << 16); }
__device__ __forceinline__ float bflo(unsigned w) { return __builtin_bit_cast(float, w << 16); }
__device__ __forceinline__ float bfhi(unsigned w) { return __builtin_bit_cast(float, w & 0xffff0000u); }
__device__ __forceinline__ float sigmoidf_(float x) { return __builtin_amdgcn_rcpf(1.0f + __builtin_amdgcn_exp2f(-1.4426950408889634f * x)); }
__device__ __forceinline__ float fexp_(float x) { return __builtin_amdgcn_exp2f(1.4426950408889634f * x); }
__device__ __forceinline__ float tanhf_(float x) { const float e = __builtin_amdgcn_exp2f(fminf(2.8853900817779268f * x, 60.f)); return 1.0f - 2.0f * __builtin_amdgcn_rcpf(e + 1.0f); }
__device__ __forceinline__ int opaque_tid() { int t = threadIdx.x; asm volatile("" : "+v"(t)); return t; }
__device__ __forceinline__ u32x4 zero_u32x4() { unsigned z = 0u; asm volatile("" : "+v"(z)); u32x4 r; r.x = z; r.y = z; r.z = z; r.w = z; return r; }
__device__ __forceinline__ float wave_sum(float v) {
#pragma unroll
    for (int o = 1; o < 64; o <<= 1) v += __shfl_xor(v, o);
    return v;
}
__device__ __forceinline__ float wave_max(float v) {
#pragma unroll
    for (int o = 1; o < 64; o <<= 1) v = fmaxf(v, __shfl_xor(v, o));
    return v;
}

constexpr size_t MiB = 1u << 20;
constexpr size_t WS_CTL = 0;
constexpr size_t WS_TAB16 = 1 * MiB;
constexpr size_t WS_TABI = WS_TAB16 + 128 * 1024;
constexpr size_t WS_SSQA = WS_TABI + 64 * 1024;
constexpr size_t WS_SSQB = WS_SSQA + 2 * MiB;
constexpr size_t WS_W = 6 * MiB;
constexpr size_t W_LAYER = 14 * MiB, W_IN = 0, W_OUT = 8912896, W_GATE = W_OUT + 2 * MiB, W_PROJ = W_GATE + 2 * MiB, W_WUPT = W_PROJ + 512 * 1024, W_AUPT = W_WUPT + 48 * 1024;
constexpr size_t WS_BUFA = 62 * MiB;
constexpr size_t WS_BUFB = 126 * MiB;
constexpr size_t WS_PB = 190 * MiB;
constexpr size_t WS_Z = 206 * MiB;
constexpr size_t WS_Z_END = WS_Z + (size_t)MTOK * ZP * 2;
constexpr size_t WS_MISC = 465 * MiB;
constexpr size_t WS_END = 512 * MiB;
constexpr size_t MISC_LQ = 0, MISC_RG = 1 * MiB, MISC_RN = 2 * MiB, MISC_RB = 26 * MiB, MISC_KV = 27 * MiB, MISC_IKC = 35 * MiB;
static_assert(W_AUPT + 48 * 1024 <= W_LAYER && WS_W + 4 * W_LAYER <= WS_BUFA && WS_Z_END <= WS_MISC, "ws map");
namespace pg8 {
#define PG8_LAS __attribute__((address_space(3)))
typedef unsigned short bf16_t;
typedef short bf16x8 __attribute__((ext_vector_type(8)));
typedef float f32x4 __attribute__((ext_vector_type(4)));
typedef unsigned u32x4 __attribute__((ext_vector_type(4)));
constexpr int BM = 256, BK = 64, HALF = 128, HTB = HALF * BK * 2  , STAGE_BYTES = 8 * HTB, NXCD = 8, WGM = 8;

__host__ __device__ __forceinline__ int lds_byte(int r, int c) { const int st = (r >> 4) * 2 + (c >> 5), rr = r & 15, cc = c & 31, ob = rr * 64 + cc * 2; return st * 1024 + (ob ^ (((ob >> 9) & 1) << 5)); }
__host__ __device__ __forceinline__ void stage_rc(int b, int& R, int& C) { const int st = b / 1024, sb = b % 1024, swz = sb ^ (((sb >> 9) & 1) << 5); R = (st >> 1) * 16 + swz / 64; C = (st & 1) * 32 + (swz % 64) / 2; }
__host__ __device__ __forceinline__ int perm32(int rho) { const int n = rho >> 4, i = rho & 15; return 8 * (i >> 2) + 4 * n + (i & 3); }

struct Unit { int pm, pn; };
struct Gemm { const bf16_t* A; const bf16_t* Bt; int M, N, K; };

struct StaticOrder {
    int nM, nN, nwg, G, c;
    __host__ __device__ void init(int M, int N, int G_, int c_) { nM = M / BM; nN = N / BM; nwg = nM * nN; G = G_; c = c_; }
    __host__ __device__ bool next(int i, Unit& u) const {
        const long L = (long)i * G + c; if (L >= nwg) return false;
        int wgid = (int)L; { const int q = nwg / NXCD, r = nwg % NXCD, xcd = wgid % NXCD, off = wgid / NXCD; wgid = (xcd < r ? xcd * (q + 1) : r * (q + 1) + (xcd - r) * q) + off; }
        const int nig = WGM * nN, gid = wgid / nig, fm = gid * WGM, gsz = (nM - fm) < WGM ? (nM - fm) : WGM;
        u.pm = fm + ((wgid % nig) % gsz); u.pn = (wgid % nig) / gsz; return true;
    }
    __device__ __forceinline__ void a_ready(const Unit&) const {}
    __device__ __forceinline__ void done(const Unit&) const {}
};

__device__ __forceinline__ unsigned cvt_pk_bf16(float lo, float hi) { unsigned r; asm volatile("v_cvt_pk_bf16_f32 %0, %1, %2" : "=v"(r) : "v"(lo), "v"(hi)); return r; }
template <class Epi, class Sched, bool ALIGN_EPI = false, bool SP2 = false>
__device__ __forceinline__ void gemm_phase(PG8_LAS unsigned char* lds, const Gemm g, const Sched& S, const Epi& E) {
    int tid_ = threadIdx.x; asm volatile("" : "+v"(tid_));
    const int tid = tid_, wid = __builtin_amdgcn_readfirstlane(tid >> 6), lane = tid & 63, wr = wid >> 2, wc = wid & 3, fr = lane & 15, fq = lane >> 4;
    const int K = g.K, nt = K / BK;
    unsigned voffA[2], voffB[2];
#pragma unroll
    for (int i = 0; i < 2; ++i) { int R, C; stage_rc(tid * 16 + i * 8192, R, C); const int Rb = Epi::PERM ? ((R & ~31) + perm32(R & 31)) : R;
        voffA[i] = (unsigned)(R * K + C) * 2u; voffB[i] = (unsigned)(Rb * K + C) * 2u; }
    const size_t kstep = (size_t)(BK * 2);
    const size_t hstep = (size_t)HALF * K * 2;
    const size_t tstep = 2 * hstep;
    const unsigned ldsw = (unsigned)wid * 1024u;
    const int aoff = lds_byte(wr * 64 + fr, fq * 8), boff = lds_byte(wc * 32 + fr, fq * 8);
#define PG8_SA(b, h) (((b) * 2 + (h)) * HTB)
#define PG8_SB(b, h) ((4 + (b) * 2 + (h)) * HTB)
#define PG8_STAGE(bufoff, gbase, voff) do { _Pragma("unroll") for (int _i = 0; _i < 2; ++_i) \
        __builtin_amdgcn_global_load_lds((const unsigned*)((const char*)(gbase) + (voff)[_i]), (PG8_LAS unsigned*)(lds + (bufoff) + ldsw + _i * 8192), 16, 0, 0); } while (0)
#define PG8_LDA(dst, b, h) do { _Pragma("unroll") for (int m = 0; m < 4; ++m) _Pragma("unroll") for (int k = 0; k < 2; ++k) dst[m][k] = *(const PG8_LAS bf16x8*)(lds + PG8_SA(b, h) + aoff + m * 2048 + k * 1024); } while (0)
#define PG8_LDB(dst, b, h) do { _Pragma("unroll") for (int n = 0; n < 2; ++n) _Pragma("unroll") for (int k = 0; k < 2; ++k) dst[n][k] = *(const PG8_LAS bf16x8*)(lds + PG8_SB(b, h) + boff + n * 2048 + k * 1024); } while (0)
#define PG8_MMA(ai, bj, At, Bt) do { __builtin_amdgcn_s_setprio(1); _Pragma("unroll") for (int m = 0; m < 4; ++m) _Pragma("unroll") for (int n = 0; n < 2; ++n) _Pragma("unroll") for (int k = 0; k < 2; ++k) \
        acc[ai][bj][m][n] = __builtin_amdgcn_mfma_f32_16x16x32_bf16(Bt[n][k], At[m][k], acc[ai][bj][m][n], 0, 0, 0); __builtin_amdgcn_s_setprio(0); } while (0)
#define PG8_WAIT_V(n) asm volatile("s_waitcnt vmcnt(" #n ")" ::: "memory")
#define PG8_WAIT_L(n) asm volatile("s_waitcnt lgkmcnt(" #n ")" ::: "memory")
#define PG8_BAR __builtin_amdgcn_s_barrier()
#define PG8_SCHED __builtin_amdgcn_sched_barrier(0)
    Unit cur, nxt; int ui = 0;
    if (!S.next(0, cur)) return;
    f32x4 acc[2][2][4][2];
#pragma unroll
    for (int a = 0; a < 2; ++a)
#pragma unroll
        for (int b = 0; b < 2; ++b)
#pragma unroll
            for (int m = 0; m < 4; ++m)
#pragma unroll
                for (int n = 0; n < 2; ++n) acc[a][b][m][n] = (f32x4){0.f, 0.f, 0.f, 0.f};
    bf16x8 At[4][2], B0[2][2], B1[2][2];
    const char* cA = (const char*)g.A + (size_t)cur.pm * tstep; const char* cB = (const char*)g.Bt + (size_t)cur.pn * tstep;
    S.a_ready(cur);
    if constexpr (SP2) {
        PG8_STAGE(PG8_SB(0, 0), cB, voffB); PG8_STAGE(PG8_SB(0, 1), cB + hstep, voffB); PG8_STAGE(PG8_SA(0, 0), cA, voffA); PG8_STAGE(PG8_SA(0, 1), cA + hstep, voffA);
        if (wr == 1) PG8_BAR;
        PG8_WAIT_V(2); PG8_BAR;
        PG8_STAGE(PG8_SB(1, 0), cB + kstep, voffB); PG8_STAGE(PG8_SA(1, 0), cA + kstep, voffA); PG8_STAGE(PG8_SB(1, 1), cB + hstep + kstep, voffB);
        PG8_WAIT_V(6); PG8_BAR;
    } else {
        PG8_STAGE(PG8_SB(0, 0), cB, voffB); PG8_STAGE(PG8_SA(0, 0), cA, voffA); PG8_STAGE(PG8_SB(0, 1), cB + hstep, voffB); PG8_STAGE(PG8_SA(0, 1), cA + hstep, voffA);
        if (wr == 1) PG8_BAR;
        PG8_WAIT_V(4); PG8_BAR;
        PG8_STAGE(PG8_SB(1, 0), cB + kstep, voffB); PG8_STAGE(PG8_SA(1, 0), cA + kstep, voffA); PG8_STAGE(PG8_SB(1, 1), cB + hstep + kstep, voffB);
        PG8_WAIT_V(6); PG8_BAR;
    }
    for (;;) {
        const bool has_next = S.next(ui + 1, nxt);
        const char* nA = has_next ? (const char*)g.A + (size_t)nxt.pm * tstep : cA; const char* nB = has_next ? (const char*)g.Bt + (size_t)nxt.pn * tstep : cB;
        for (int t = 0; t < nt; t += 2) {
            const bool last = (t == nt - 2);
            const char* a1 = cA + (size_t)(t + 1) * kstep;
            const char* a2 = last ? nA : cA + (size_t)(t + 2) * kstep; const char* b2 = last ? nB : cB + (size_t)(t + 2) * kstep;
            const char* a3 = a2 + kstep; const char* b3 = b2 + kstep;
            if (last && has_next) S.a_ready(nxt);
            if constexpr (SP2) {
            PG8_LDB(B0, 0, 0); PG8_LDB(B1, 0, 1); PG8_SCHED; PG8_LDA(At, 0, 0); PG8_STAGE(PG8_SA(1, 1), a1 + hstep, voffA);
            PG8_WAIT_V(8); PG8_WAIT_L(0); PG8_BAR; PG8_MMA(0, 0, At, B0); PG8_MMA(0, 1, At, B1); PG8_BAR; PG8_SCHED;
            PG8_LDA(At, 0, 1); PG8_STAGE(PG8_SB(0, 0), b2, voffB); PG8_STAGE(PG8_SB(0, 1), b2 + hstep, voffB); PG8_STAGE(PG8_SA(0, 0), a2, voffA);
            PG8_WAIT_V(8); PG8_WAIT_L(0); PG8_BAR; PG8_MMA(1, 0, At, B0); PG8_MMA(1, 1, At, B1); PG8_BAR; PG8_SCHED;
            PG8_LDB(B0, 1, 0); PG8_LDB(B1, 1, 1); PG8_SCHED; PG8_LDA(At, 1, 0); PG8_STAGE(PG8_SA(0, 1), a2 + hstep, voffA);
            PG8_WAIT_V(8); PG8_WAIT_L(0); PG8_BAR; PG8_MMA(0, 0, At, B0); PG8_MMA(0, 1, At, B1); PG8_BAR; PG8_SCHED;
            PG8_LDA(At, 1, 1); PG8_STAGE(PG8_SB(1, 0), b3, voffB); PG8_STAGE(PG8_SB(1, 1), b3 + hstep, voffB); PG8_STAGE(PG8_SA(1, 0), a3, voffA);
            PG8_WAIT_V(8); PG8_WAIT_L(0); PG8_BAR; PG8_MMA(1, 0, At, B0); PG8_MMA(1, 1, At, B1); PG8_BAR; PG8_SCHED;
            } else {
            PG8_LDB(B0, 0, 0); PG8_SCHED; PG8_LDA(At, 0, 0); PG8_STAGE(PG8_SA(1, 1), a1 + hstep, voffA);
            PG8_WAIT_L(8); PG8_BAR; PG8_WAIT_L(0); PG8_MMA(0, 0, At, B0); PG8_BAR; PG8_SCHED;
            PG8_LDB(B1, 0, 1); PG8_STAGE(PG8_SB(0, 0), b2, voffB);
            PG8_BAR; PG8_WAIT_L(0); PG8_MMA(0, 1, At, B1); PG8_BAR;
            PG8_LDA(At, 0, 1); PG8_STAGE(PG8_SA(0, 0), a2, voffA);
            PG8_BAR; PG8_WAIT_L(0); PG8_MMA(1, 0, At, B0); PG8_BAR; PG8_SCHED;
            PG8_STAGE(PG8_SB(0, 1), b2 + hstep, voffB);
            PG8_WAIT_V(6); PG8_BAR; PG8_MMA(1, 1, At, B1); PG8_BAR;
            PG8_LDB(B0, 1, 0); PG8_SCHED; PG8_LDA(At, 1, 0); PG8_STAGE(PG8_SA(0, 1), a2 + hstep, voffA);
            PG8_WAIT_L(8); PG8_BAR; PG8_WAIT_L(0); PG8_MMA(0, 0, At, B0); PG8_BAR; PG8_SCHED;
            PG8_LDB(B1, 1, 1); PG8_STAGE(PG8_SB(1, 0), b3, voffB);
            PG8_BAR; PG8_WAIT_L(0); PG8_MMA(0, 1, At, B1); PG8_BAR;
            PG8_LDA(At, 1, 1); PG8_STAGE(PG8_SA(1, 0), a3, voffA);
            PG8_BAR; PG8_WAIT_L(0); PG8_MMA(1, 0, At, B0); PG8_BAR; PG8_SCHED;
            PG8_STAGE(PG8_SB(1, 1), b3 + hstep, voffB);
            PG8_WAIT_V(6); PG8_BAR; PG8_MMA(1, 1, At, B1); PG8_BAR;
            }
        }
        if constexpr (ALIGN_EPI) { if (wr == 0) PG8_BAR; }
        if constexpr (!Epi::AFTER_DRAIN) { E(acc, cur, wr, wc, fr, fq); S.done(cur); }
        if (!has_next) break;
#pragma unroll
        for (int a = 0; a < 2; ++a)
#pragma unroll
            for (int b = 0; b < 2; ++b)
#pragma unroll
                for (int m = 0; m < 4; ++m)
#pragma unroll
                    for (int n = 0; n < 2; ++n) acc[a][b][m][n] = (f32x4){0.f, 0.f, 0.f, 0.f};
        cur = nxt; cA = nA; cB = nB; ++ui;
        if constexpr (ALIGN_EPI) { if (wr == 1) PG8_BAR; }
    }
    PG8_WAIT_V(0);
    if constexpr (!ALIGN_EPI) { if (wr == 0) PG8_BAR; }
    PG8_BAR;
    if constexpr (Epi::AFTER_DRAIN) { E.fused(acc, cur, wr, wc, fr, fq, lds, wid, lane); S.done(cur); }
#undef PG8_SA
#undef PG8_SB
#undef PG8_STAGE
#undef PG8_LDA
#undef PG8_LDB
#undef PG8_MMA
#undef PG8_WAIT_V
#undef PG8_WAIT_L
#undef PG8_BAR
#undef PG8_SCHED
}
}
#define GAS __attribute__((address_space(1)))
#define LAS __attribute__((address_space(3)))

__device__ __forceinline__ int zcol_src(int n, float& sc) {
    sc = 1.f;
    if (n < ZB_Q) return n;
    if (n < ZB_K) { int o = n - ZB_Q, h = o >> 6, d = o & 63; sc = QSCALE; if (d < 16) d = (d >> 1) + 8 * (d & 1); return ZB_Q + h * 64 + d; }
    if (n < ZB_V) { int d = n - ZB_K; if (d < 16) d = (d >> 1) + 8 * (d & 1); return ZB_K + d; }
    if (n < ZB_IQ) return n;
    if (n < ZB_IK) { int o = n - ZB_IQ, h = o >> 5, d = o & 31; sc = IQSCALE; if (d < 8) d = (d >> 1) + 4 * (d & 1); return ZB_IQ + h * 32 + d; }
    if (n < ZB_IW) { int d = n - ZB_IK; if (d < 8) d = (d >> 1) + 4 * (d & 1); return ZB_IK + d; }
    if (n < ZB_G) { sc = IWSCALE; return n; }
    if (n < ZC_Q) return n;
    if (n < ZC_K) { int o = n - ZC_Q, h = o >> 6, d = o & 63; sc = QSCALE; if (d < 16) d = (d >> 1) + 8 * (d & 1); return ZC_Q + h * 64 + d; }
    if (n < ZC_V) { int o = n - ZC_K, h = o >> 6, d = o & 63; if (d < 16) d = (d >> 1) + 8 * (d & 1); return ZC_K + h * 64 + d; }
    return n;
}

template <bool ZMAP>
__device__ __forceinline__ void transpose_item(const float* __restrict__ W, int K, int NW, bf16_t* WT, const float* __restrict__ kscale, LAS float* scr, int item, int nblk, int lane) {
    const int kb = item / nblk, nb = item % nblk, k0 = 64 * kb, n0 = 32 * nb;
    const int c4 = 4 * (lane & 7), ncol = n0 + c4;
    f32x4 v[8];
#pragma unroll
    for (int i = 0; i < 8; ++i) { const int kk = (lane >> 3) + 8 * i; v[i] = (f32x4){0.f, 0.f, 0.f, 0.f}; if (ncol < NW) v[i] = *(const f32x4*)(W + (size_t)(k0 + kk) * NW + ncol); }
#pragma unroll
    for (int i = 0; i < 8; ++i) { const int kk = (lane >> 3) + 8 * i; f32x4 x = v[i]; if (kscale) x = x * kscale[k0 + kk];
        scr[kk * 33 + c4] = x[0]; scr[kk * 33 + c4 + 1] = x[1]; scr[kk * 33 + c4 + 2] = x[2]; scr[kk * 33 + c4 + 3] = x[3]; }
    asm volatile("s_waitcnt lgkmcnt(0)" ::: "memory");
    const int c = lane & 7;
#pragma unroll
    for (int j = 0; j < 4; ++j) { const int n = (lane >> 3) + 8 * j; int sl = n; float sc = 1.f;
        if (ZMAP) { if (n0 + n < NW) sl = zcol_src(n0 + n, sc) - n0; else { sl = n; sc = 0.f; } }
        const LAS float* s = scr + (8 * c) * 33 + sl;
        u32x4 o; o.x = pk2(s[0 * 33] * sc, s[1 * 33] * sc); o.y = pk2(s[2 * 33] * sc, s[3 * 33] * sc); o.z = pk2(s[4 * 33] * sc, s[5 * 33] * sc); o.w = pk2(s[6 * 33] * sc, s[7 * 33] * sc);
        *(u32x4*)(WT + (size_t)(n0 + n) * K + k0 + 8 * c) = o; }
    asm volatile("s_waitcnt lgkmcnt(0)" ::: "memory");
}

struct PrepArgs { const float* w_in; const float* norm_g; const float* w_out; const float* ple_g; const float* w_gate; const float* w_proj; const float* w_up; const float* a_up; unsigned char* ws; };

__device__ __forceinline__ void prep_weights(const PrepArgs& a, int gw, int ngw, LAS float* scr, int lane) {
    constexpr int I_IN = 16 * (NPAD / 32), I_SQ = 16 * 32, I_PJ = 4 * 32, I_UP = 12, I_LAYER = I_IN + 2 * I_SQ + I_PJ + 2 * I_UP;
    for (int it = gw; it < DEPTH * I_LAYER; it += ngw) {
        const int L = it / I_LAYER; int r = it % I_LAYER;
        unsigned char* wl = a.ws + WS_W + (size_t)L * W_LAYER;
        if (r < I_IN) { transpose_item<true>(a.w_in + (size_t)L * DM * ZP, DM, ZP, (bf16_t*)(wl + W_IN), a.norm_g + L * DM, scr, r, NPAD / 32, lane); continue; } r -= I_IN;
        if (r < I_SQ) { transpose_item<false>(a.w_out + (size_t)L * DM * DM, DM, DM, (bf16_t*)(wl + W_OUT), nullptr, scr, r, 32, lane); continue; } r -= I_SQ;
        if (r < I_SQ) { transpose_item<false>(a.w_gate + (size_t)L * DM * DM, DM, DM, (bf16_t*)(wl + W_GATE), a.ple_g + L * DM, scr, r, 32, lane); continue; } r -= I_SQ;
        if (r < I_PJ) { transpose_item<false>(a.w_proj + (size_t)L * 256 * DM, 256, DM, (bf16_t*)(wl + W_PROJ), nullptr, scr, r, 32, lane); continue; } r -= I_PJ;
        if (r < I_UP) { transpose_item<false>(a.w_up + (size_t)L * 64 * 384, 64, 384, (bf16_t*)(wl + W_WUPT), nullptr, scr, r, 12, lane); continue; } r -= I_UP;
        transpose_item<false>(a.a_up + (size_t)L * 64 * 384, 64, 384, (bf16_t*)(wl + W_AUPT), nullptr, scr, r, 12, lane);
    }
}

__device__ __forceinline__ void sincos_d(float ang, float& c, float& s) {
    const double a = (double)ang; const double n = rint(a * 0.63661977236758134308);
    double r = fma(-n, 1.57079632679489655800e+00, a); r = fma(-n, 6.12323399573676603587e-17, r);
    const double r2 = r * r;
    double sp = r2 * (1.0 / 6227020800.0) - 1.0 / 39916800.0; sp = sp * r2 + 1.0 / 362880.0; sp = sp * r2 - 1.0 / 5040.0; sp = sp * r2 + 1.0 / 120.0; sp = sp * r2 - 1.0 / 6.0; sp = sp * r2 * r + r;
    double cp = r2 * (1.0 / 479001600.0) - 1.0 / 3628800.0; cp = cp * r2 + 1.0 / 40320.0; cp = cp * r2 - 1.0 / 720.0; cp = cp * r2 + 1.0 / 24.0; cp = cp * r2 - 0.5; cp = cp * r2 + 1.0;
    const int q = ((int)n) & 3;
    const double sv = (q == 0) ? sp : (q == 1) ? cp : (q == 2) ? -sp : -cp;
    const double cv = (q == 0) ? cp : (q == 1) ? -sp : (q == 2) ? -cp : sp;
    c = (float)cv; s = (float)sv;
}
__device__ __forceinline__ void prep_tables(unsigned char* ws, int gtid, int nthreads) {
    const float inv8[8] = {1.0f, 0.1939227432012558f, 0.03760603070259094f, 0.007292664609849453f, 0.0014142135623842478f, 0.00027424818836152554f, 5.318296098266728e-05f, 1.0313386155758053e-05f};
    float* t16 = (float*)(ws + WS_TAB16); float* tI = (float*)(ws + WS_TABI);
    for (int e = gtid; e < SEQ * 8; e += nthreads) { const int pos = e >> 3, i = e & 7;
        float iv = inv8[0];
#pragma unroll
        for (int j = 1; j < 8; ++j) iv = (i == j) ? inv8[j] : iv;
        float c, s; sincos_d((float)pos * iv, c, s); t16[pos * 16 + i] = c; t16[pos * 16 + 8 + i] = s;
        if ((i & 1) == 0) { const int i4 = i >> 1; tI[pos * 8 + i4] = c; tI[pos * 8 + 4 + i4] = s; }
    }
}
__device__ __forceinline__ void x_row_to_bf16(const float* xrow, bf16_t* orow, float* ssq, int lane) {
    const f32x4* xr = (const f32x4*)xrow + lane;
    unsigned long long* o8 = (unsigned long long*)orow + lane;
#pragma unroll
    for (int j = 0; j < 4; ++j) { const f32x4 v = xr[64 * j];
        float s = (v.x * v.x + v.y * v.y) + (v.z * v.z + v.w * v.w);
        o8[64 * j] = (unsigned long long)pk2(v.x, v.y) | ((unsigned long long)pk2(v.z, v.w) << 32);
        s += __shfl_xor(s, 1); s += __shfl_xor(s, 2); s += __shfl_xor(s, 4); s += __shfl_xor(s, 8);
        if ((lane & 15) == 0) ssq[4 * j + (lane >> 4)] = s; }
}
__device__ __forceinline__ float row_rstd(const float* ssq_row) {
    const f32x4 a = *(const f32x4*)ssq_row, b = *(const f32x4*)(ssq_row + 4), c = *(const f32x4*)(ssq_row + 8), d = *(const f32x4*)(ssq_row + 12);
    const float s = ((a.x + a.y) + (a.z + a.w)) + ((b.x + b.y) + (b.z + b.w)) + ((c.x + c.y) + (c.z + c.w)) + ((d.x + d.y) + (d.z + d.w));
    return __builtin_amdgcn_rsqf(s * (1.0f / DM) + NORM_EPS);
}
namespace epi {
using pg8::Unit; using pg8::BM; using pg8::HALF;
__device__ __forceinline__ u32x4 pack8(const f32x4& a, const f32x4& b) { u32x4 w; w.x = pg8::cvt_pk_bf16(a[0], a[1]); w.y = pg8::cvt_pk_bf16(a[2], a[3]); w.z = pg8::cvt_pk_bf16(b[0], b[1]); w.w = pg8::cvt_pk_bf16(b[2], b[3]); return w; }
__device__ __forceinline__ int rope_class(int c0, int& fb) {
    fb = 0; int o;
    if (c0 >= ZB_Q && c0 < ZB_V) { o = (c0 - ZB_Q) & 63; if (o < 16) { fb = o >> 1; return 1; } return 0; }
    if (c0 >= ZB_IQ && c0 < ZB_IW) { o = (c0 - ZB_IQ) & 31; return o == 0 ? 2 : 0; }
    if (c0 >= ZC_Q && c0 < ZC_V) { o = (c0 - ZC_Q) & 63; if (o < 16) { fb = o >> 1; return 1; } return 0; }
    return 0;
}
struct EpiInProj {
    static constexpr bool PERM = true, AFTER_DRAIN = false;
    bf16_t* Z; const float* ssq; const float* tab16; const float* tabI; bf16_t* KV; bf16_t* IKC;
    __device__ __forceinline__ void operator()(const f32x4 (&acc)[2][2][4][2], const Unit& u, int wr, int wc, int fr, int fq) const {
        const int row0 = u.pm * BM + wr * 64 + fr;
        const int c00 = u.pn * BM + wc * 32 + 8 * fq, c01 = c00 + HALF;
        int fb0, fb1; const int rc0 = rope_class(c00, fb0), rc1 = rope_class(c01, fb1);
#pragma unroll
        for (int ai = 0; ai < 2; ++ai)
#pragma unroll
            for (int m = 0; m < 4; ++m) {
                const int row = row0 + ai * HALF + m * 16;
                const float rs = row_rstd(ssq + (size_t)row * 16);
                const int pos = row & (SEQ - 1);
#pragma unroll
                for (int bj = 0; bj < 2; ++bj) {
                    const int c0 = bj ? c01 : c00, rc = bj ? rc1 : rc0, fb = bj ? fb1 : fb0;
                    if (c0 >= ZP) continue;
                    f32x4 v0 = acc[ai][bj][m][0] * rs, v1 = acc[ai][bj][m][1] * rs;
                    if (rc) {
                        const float* tp = (rc == 1) ? tab16 + pos * 16 + fb : tabI + pos * 8;
                        const f32x4 c = *(const f32x4*)tp, s = *(const f32x4*)(tp + (rc == 1 ? 8 : 4));
                        f32x4 a0, a1;
                        a0[0] = v0[0] * c[0] - v0[1] * s[0]; a0[1] = v0[1] * c[0] + v0[0] * s[0];
                        a0[2] = v0[2] * c[1] - v0[3] * s[1]; a0[3] = v0[3] * c[1] + v0[2] * s[1];
                        a1[0] = v1[0] * c[2] - v1[1] * s[2]; a1[1] = v1[1] * c[2] + v1[0] * s[2];
                        a1[2] = v1[2] * c[3] - v1[3] * s[3]; a1[3] = v1[3] * c[3] + v1[2] * s[3];
                        v0 = a0; v1 = a1;
                    }
                    const u32x4 pk = pack8(v0, v1);
                    if (c0 >= ZB_K && c0 < ZB_IQ) *(u32x4*)(KV + (size_t)row * 128 + (c0 - ZB_K)) = pk;
                    else if (c0 >= ZB_IK && c0 < ZB_IW) *(u32x4*)(IKC + (size_t)row * 32 + (c0 - ZB_IK)) = pk;
                    else *(u32x4*)(Z + (size_t)row * ZP + c0) = pk;
                }
                asm volatile("" ::: "memory");
            }
    }
};
struct EpiPlainZ {
    static constexpr bool PERM = true, AFTER_DRAIN = false;
    bf16_t* Z;
    __device__ __forceinline__ void operator()(const f32x4 (&acc)[2][2][4][2], const Unit& u, int wr, int wc, int fr, int fq) const {
        const int row0 = u.pm * BM + wr * 64 + fr;
#pragma unroll
        for (int ai = 0; ai < 2; ++ai)
#pragma unroll
            for (int m = 0; m < 4; ++m)
#pragma unroll
                for (int bj = 0; bj < 2; ++bj) { const int c0 = u.pn * BM + bj * HALF + wc * 32 + 8 * fq; if (c0 < ZP) *(u32x4*)(Z + (size_t)(row0 + ai * HALF + m * 16) * ZP + c0) = pack8(acc[ai][bj][m][0], acc[ai][bj][m][1]); }
    }
};
struct EpiOutProj {
    static constexpr bool PERM = true, AFTER_DRAIN = false;
    const float* xin; bf16_t* xb; float* ssq_out;
    __device__ __forceinline__ void operator()(const f32x4 (&acc)[2][2][4][2], const Unit& u, int wr, int wc, int fr, int fq) const {
        const int row0 = u.pm * BM + wr * 64 + fr;
#pragma unroll
        for (int ai = 0; ai < 2; ++ai)
#pragma unroll
            for (int m = 0; m < 4; ++m) {
                const int row = row0 + ai * HALF + m * 16; float sq = 0.f;
#pragma unroll
                for (int bj = 0; bj < 2; ++bj) {
                    const size_t off = (size_t)row * DM + u.pn * BM + bj * HALF + wc * 32 + 8 * fq;
                    const f32x4 x0 = *(const f32x4*)(xin + off) + acc[ai][bj][m][0], x1 = *(const f32x4*)(xin + off + 4) + acc[ai][bj][m][1];
                    *(u32x4*)(xb + off) = pack8(x0, x1);
                    sq += ((x0[0] * x0[0] + x0[1] * x0[1]) + (x0[2] * x0[2] + x0[3] * x0[3])) + ((x1[0] * x1[0] + x1[1] * x1[1]) + (x1[2] * x1[2] + x1[3] * x1[3]));
                }
                sq += __shfl_xor(sq, 16); sq += __shfl_xor(sq, 32);
                if (fq == 0) ssq_out[(size_t)row * 16 + u.pn * 4 + wc] = sq;
            }
    }
};
struct EpiGate {
    static constexpr bool PERM = true, AFTER_DRAIN = false;
    float* xout; const bf16_t* x1b; const bf16_t* pp; bf16_t* xb; const float* ssq_in; float* ssq_out;
    __device__ __forceinline__ void operator()(const f32x4 (&acc)[2][2][4][2], const Unit& u, int wr, int wc, int fr, int fq) const {
        const int row0 = u.pm * BM + wr * 64 + fr;
#pragma unroll
        for (int ai = 0; ai < 2; ++ai)
#pragma unroll
            for (int m = 0; m < 4; ++m) {
                const int row = row0 + ai * HALF + m * 16; float sq = 0.f;
                const float rs = row_rstd(ssq_in + (size_t)row * 16);
#pragma unroll
                for (int bj = 0; bj < 2; ++bj) {
                    const size_t off = (size_t)row * DM + u.pn * BM + bj * HALF + wc * 32 + 8 * fq;
                    f32x4 g0 = acc[ai][bj][m][0] * rs, g1 = acc[ai][bj][m][1] * rs;
#pragma unroll
                    for (int i = 0; i < 4; ++i) { g0[i] = sigmoidf_(g0[i]); g1[i] = sigmoidf_(g1[i]); }
                    const u32x4 pw = *(const u32x4*)(pp + off); const f32x4 pp0 = {bflo(pw.x), bfhi(pw.x), bflo(pw.y), bfhi(pw.y)}, pp1 = {bflo(pw.z), bfhi(pw.z), bflo(pw.w), bfhi(pw.w)};
                    const u32x4 xw = *(const u32x4*)(x1b + off); const f32x4 xa = {bflo(xw.x), bfhi(xw.x), bflo(xw.y), bfhi(xw.y)}, xc = {bflo(xw.z), bfhi(xw.z), bflo(xw.w), bfhi(xw.w)};
                    const f32x4 x0 = xa + g0 * pp0, x1 = xc + g1 * pp1;
                    *(f32x4*)(xout + off) = x0; *(f32x4*)(xout + off + 4) = x1;
                    *(u32x4*)(xb + off) = pack8(x0, x1);
                    sq += ((x0[0] * x0[0] + x0[1] * x0[1]) + (x0[2] * x0[2] + x0[3] * x0[3])) + ((x1[0] * x1[0] + x1[1] * x1[1]) + (x1[2] * x1[2] + x1[3] * x1[3]));
                }
                sq += __shfl_xor(sq, 16); sq += __shfl_xor(sq, 32);
                if (fq == 0) ssq_out[(size_t)row * 16 + u.pn * 4 + wc] = sq;
            }
    }
};
struct EpiBf16Plain {
    static constexpr bool PERM = true, AFTER_DRAIN = false;
    bf16_t* C;
    __device__ __forceinline__ void operator()(const f32x4 (&acc)[2][2][4][2], const Unit& u, int wr, int wc, int fr, int fq) const {
        const int row0 = u.pm * BM + wr * 64 + fr;
#pragma unroll
        for (int ai = 0; ai < 2; ++ai)
#pragma unroll
            for (int m = 0; m < 4; ++m)
#pragma unroll
                for (int bj = 0; bj < 2; ++bj) {
                    const size_t off = (size_t)(row0 + ai * HALF + m * 16) * DM + u.pn * BM + bj * HALF + wc * 32 + 8 * fq;
                    *(u32x4*)(C + off) = pack8(acc[ai][bj][m][0], acc[ai][bj][m][1]);
                }
    }
};
struct EpiF32 {
    static constexpr bool PERM = true, AFTER_DRAIN = false;
    float* C;
    __device__ __forceinline__ void operator()(const f32x4 (&acc)[2][2][4][2], const Unit& u, int wr, int wc, int fr, int fq) const {
        const int row0 = u.pm * BM + wr * 64 + fr;
#pragma unroll
        for (int ai = 0; ai < 2; ++ai)
#pragma unroll
            for (int m = 0; m < 4; ++m)
#pragma unroll
                for (int bj = 0; bj < 2; ++bj) {
                    const size_t off = (size_t)(row0 + ai * HALF + m * 16) * DM + u.pn * BM + bj * HALF + wc * 32 + 8 * fq;
                    *(f32x4*)(C + off) = acc[ai][bj][m][0]; *(f32x4*)(C + off + 4) = acc[ai][bj][m][1];
                }
    }
};
}
typedef GAS unsigned gu32;
#define RLX_AGENT __ATOMIC_RELAXED, __HIP_MEMORY_SCOPE_AGENT
#define XB_TMO      128
#define XB_XCNT(j)  (256  + 64 * (j))
#define XB_XSUB(j)  (1280 + 64 * (j))
#define XB_XGEN(j)  (2304 + 64 * (j))
#define XB_TOP      3328
#define XB_TOPGEN   3392
#define XCD_BAR_WORDS 3456
#define XB_SPIN_CAP (1u << 27)

__device__ __forceinline__ unsigned xb_ld(unsigned* p)              { return __hip_atomic_load(p, __ATOMIC_RELAXED, __HIP_MEMORY_SCOPE_AGENT); }
__device__ __forceinline__ unsigned xb_add(unsigned* p, unsigned v) { return __hip_atomic_fetch_add(p, v, __ATOMIC_RELAXED, __HIP_MEMORY_SCOPE_AGENT); }
__device__ __forceinline__ unsigned xb_xcc_id() { return (unsigned)__builtin_amdgcn_s_getreg((3 << 11) | 20) & 0xFu; }
#define XB_SPIN(cond, bar) do { unsigned _sp = 0; while (cond) { __builtin_amdgcn_s_sleep(1); \
    if ((++_sp & 255u) == 0u) { if (xb_ld(&(bar)[XB_TMO])) break; if (_sp > XB_SPIN_CAP) { atomicAdd(&(bar)[XB_TMO], 1u); break; } } } } while (0)

struct XcdBarrier {
    unsigned* bar; unsigned x;
    volatile LAS unsigned* st;
};

__device__ __forceinline__ XcdBarrier xcd_barrier_post(unsigned* bar, volatile LAS unsigned* st) {
    XcdBarrier b; b.bar = bar; b.x = xb_xcc_id(); b.st = st;
    if (threadIdx.x == 0) (void)xb_add(&bar[XB_XCNT(b.x)], 1u);
    return b;
}
__device__ __forceinline__ void xcd_barrier_complete(unsigned* bar, unsigned x, unsigned& nloc, unsigned& nx) {
    const unsigned G = gridDim.x * gridDim.y * gridDim.z;
    unsigned sum, cnt, mine, sp = 0u;
    for (;;) {
        sum = 0u; cnt = 0u; mine = 0u;
#pragma unroll
        for (unsigned j = 0; j < 16; ++j) { const unsigned c = xb_ld(&bar[XB_XCNT(j)]); sum += c; cnt += (c > 0u) ? 1u : 0u; mine = (j == x) ? c : mine; }
        if (sum == G) break;
        __builtin_amdgcn_s_sleep(1);
        if ((++sp & 255u) == 0u) { if (xb_ld(&bar[XB_TMO])) break; if (sp > XB_SPIN_CAP) { atomicAdd(&bar[XB_TMO], 1u); break; } }
    }
    nloc = mine > 0u ? mine : 1u; nx = cnt > 0u ? cnt : 1u;
}

__device__ __forceinline__ void xcd_barrier(const XcdBarrier& b) {
    asm volatile("s_waitcnt vmcnt(0)" ::: "memory");
    __syncthreads();
    if (threadIdx.x == 0) {
        unsigned* bar = b.bar;
        __builtin_amdgcn_s_waitcnt(0);
        unsigned nloc = b.st[0], nx = b.st[1];
        if (nloc == 0u) { xcd_barrier_complete(bar, b.x, nloc, nx); b.st[0] = nloc; b.st[1] = nx; }
        const unsigned old = xb_add(&bar[XB_XSUB(b.x)], 1u);
        const unsigned gen = old / nloc;
        if (old + 1u == (gen + 1u) * nloc) {
            __builtin_amdgcn_fence(__ATOMIC_RELEASE, "agent");
            asm volatile("s_waitcnt vmcnt(0)" ::: "memory");
            const unsigned og = xb_add(&bar[XB_TOP], 1u);
            const unsigned tg = og / nx;
            if (og + 1u == (tg + 1u) * nx) xb_add(&bar[XB_TOPGEN], 1u);
            else XB_SPIN(xb_ld(&bar[XB_TOPGEN]) == tg, bar);
            __builtin_amdgcn_fence(__ATOMIC_ACQUIRE, "agent");
            xb_add(&bar[XB_XGEN(b.x)], 1u);
            asm volatile("s_waitcnt vmcnt(0)" ::: "memory");
        } else {
            XB_SPIN(xb_ld(&bar[XB_XGEN(b.x)]) == gen, bar);
            __builtin_amdgcn_fence(__ATOMIC_ACQUIRE, "agent");
            asm volatile("s_waitcnt vmcnt(0)" ::: "memory");
        }
    }
    __syncthreads();
}
struct MixArgs { const bf16_t* Z; bf16_t* Y; const bf16_t* KV; const bf16_t* IKC; const float* mu; const float* w0; const float* w_up; const float* a0; const float* a_up; const float* k_k; const float* k_a; const float* r_k; const float* ln_g; const float* ln_b; };

__device__ __forceinline__ void rwkv_seq_phase(const MixArgs& a, unsigned char* ldsb, int chain  ) {
    constexpr int TB = 16;
    typedef float (*arr_t)[64];
    const int tid0 = opaque_tid();
    float* base = (float*)(ldsb + (tid0 >> 8) * 40960);
    arr_t sr = (arr_t)(base), sw = (arr_t)(base + 1024), sk = (arr_t)(base + 2048), sv = (arr_t)(base + 3072), skk = (arr_t)(base + 4096), sb = (arr_t)(base + 5120), sg = (arr_t)(base + 6144), swd = (arr_t)(base + 7168), sad = (arr_t)(base + 8192), sy = (arr_t)(base + 9216);
    const int b = chain / 6, h = chain % 6, tid = tid0 & 255, lane = tid & 63, wv = tid >> 6;
    const int vrow = tid >> 2, kq = tid & 3;
    float st[16];
#pragma unroll
    for (int i = 0; i < 16; ++i) st[i] = 0.f;
    for (int t0 = 0; t0 < SEQ; t0 += TB) {
        for (int idx = tid; idx < TB * 64; idx += 256) {
            const int t = idx >> 6, c = idx & 63, tok = t0 + t;
            const bf16_t* zr = a.Z + (size_t)(b * SEQ + tok) * ZP; const bf16_t* zp = zr - ZP; const bool hp = tok > 0;
            auto mix = [&](int col) { const float cur = bf2f(zr[col]), prv = hp ? bf2f(zp[col]) : 0.f; return cur + (prv - cur) * a.mu[col]; };
            sr[t][c] = mix(ZA_R + h * 64 + c); sk[t][c] = mix(ZA_K + h * 64 + c); sv[t][c] = mix(ZA_V + h * 64 + c); sg[t][c] = mix(ZA_G + h * 64 + c);
            swd[t][c] = tanhf(mix(ZA_WD + c)); sad[t][c] = mix(ZA_AD + c);
        }
        __syncthreads();
        for (int idx = tid; idx < TB * 64; idx += 256) {
            const int t = idx >> 6, c = idx & 63, hc = h * 64 + c;
            float pw = a.w0[hc], pa = a.a0[hc];
            for (int j = 0; j < 64; ++j) { pw += swd[t][j] * a.w_up[j * 384 + hc]; pa += sad[t][j] * a.a_up[j * 384 + hc]; }
            const float w = __expf(-DECAY_SCALE * sigmoidf_(pw)), eta = sigmoidf_(pa);
            const float k = sk[t][c];
            sw[t][c] = w; sb[t][c] = eta; skk[t][c] = k * a.k_k[hc]; sk[t][c] = k * (1.f + (eta - 1.f) * a.k_a[hc]);
        }
        __syncthreads();
        for (int t = wv; t < TB; t += 4) {
            const float kr = skk[t][lane]; const float nrm = sqrtf(wave_sum(kr * kr)); const float kk = kr / fmaxf(nrm, 1e-12f);
            skk[t][lane] = kk; sb[t][lane] = kk * sb[t][lane];
        }
        __syncthreads();
        for (int t = 0; t < TB; ++t) {
            float sa = 0.f;
#pragma unroll
            for (int i = 0; i < 16; ++i) sa -= st[i] * skk[t][kq * 16 + i];
            sa += __shfl_xor(sa, 1); sa += __shfl_xor(sa, 2);
            const float vv = sv[t][vrow]; float yy = 0.f;
#pragma unroll
            for (int i = 0; i < 16; ++i) { const int kc = kq * 16 + i; st[i] = st[i] * sw[t][kc] + sa * sb[t][kc] + vv * sk[t][kc]; yy += st[i] * sr[t][kc]; }
            yy += __shfl_xor(yy, 1); yy += __shfl_xor(yy, 2);
            if (kq == 0) sy[t][vrow] = yy;
        }
        __syncthreads();
        for (int t = wv; t < TB; t += 4) {
            const int hc = h * 64 + lane;
            const float y = sy[t][lane]; const float mean = wave_sum(y) * (1.f / 64.f); const float d = y - mean; const float var = wave_sum(d * d) * (1.f / 64.f);
            const float yn = d * (1.0f / sqrtf(var + GN_EPS)) * a.ln_g[hc] + a.ln_b[hc];
            const float bonus = wave_sum(sr[t][lane] * sk[t][lane] * a.r_k[hc]) * sv[t][lane];
            const float g = sg[t][lane];
            a.Y[(size_t)(b * SEQ + t0 + t) * DM + hc] = (bf16_t)f2bf((yn + bonus) * g * sigmoidf_(g));
        }
        __syncthreads();
    }
}

__device__ __forceinline__ void dsa_simple_unit(const MixArgs& a, unsigned char* ldsb, int row) {
    const int tid0 = opaque_tid(); const int wv = tid0 >> 6, lane = tid0 & 63;
    typedef float (*a256_t)[256]; typedef float (*a8_t)[8]; typedef float (*p_t)[4][256]; typedef unsigned (*key_t)[SEQ]; typedef int (*idx_t)[256];
    a256_t s_iq = (a256_t)(ldsb); a256_t s_q = (a256_t)(ldsb + 8192); a8_t s_iw = (a8_t)(ldsb + 16384); idx_t s_idx = (idx_t)(ldsb + 16384 + 256); p_t s_p = (p_t)(ldsb + 16384 + 256 + 8192); key_t s_key = (key_t)(ldsb + 16384 + 256 + 8192 + 32768);
    const int b = row / SEQ, t = row % SEQ;
    __syncthreads();
    const bf16_t* zr = a.Z + (size_t)row * ZP; const bf16_t* zb = a.Z + (size_t)b * SEQ * ZP;
    for (int i = lane; i < 256; i += 64) { s_iq[wv][i] = bf2f(zr[ZB_IQ + i]); s_q[wv][i] = bf2f(zr[ZB_Q + i]); }
    if (lane < 8) s_iw[wv][lane] = bf2f(zr[ZB_IW + lane]);
    __syncthreads();
    const int nj = (t >> 6) + 1;
    for (int j = 0; j < nj; ++j) {
        const int s = lane + 64 * j; unsigned u = 0u;
        if (s <= t) {
            const u32x4* kp = (const u32x4*)(zb + (size_t)s * ZP + ZB_IK); float ik[32];
#pragma unroll
            for (int q4 = 0; q4 < 4; ++q4) { const u32x4 w = kp[q4];
                ik[q4 * 8 + 0] = bflo(w.x); ik[q4 * 8 + 1] = bfhi(w.x); ik[q4 * 8 + 2] = bflo(w.y); ik[q4 * 8 + 3] = bfhi(w.y); ik[q4 * 8 + 4] = bflo(w.z); ik[q4 * 8 + 5] = bfhi(w.z); ik[q4 * 8 + 6] = bflo(w.w); ik[q4 * 8 + 7] = bfhi(w.w); }
            float sc = 0.f;
#pragma unroll
            for (int hh = 0; hh < 8; ++hh) { float d = 0.f;
#pragma unroll
                for (int dd = 0; dd < 32; ++dd) d += s_iq[wv][hh * 32 + dd] * ik[dd];
                sc += s_iw[wv][hh] * fmaxf(d, 0.f); }
            const unsigned bits = __builtin_bit_cast(unsigned, sc);
            u = (bits & 0x80000000u) ? ~bits : (bits | 0x80000000u);
        }
        s_key[wv][s] = u;
    }
    __syncthreads();
    int nsel;
    if (t < 256) { for (int s = lane; s <= t; s += 64) s_idx[wv][s] = s; nsel = t + 1; }
    else {
        unsigned prefix = 0u;
        for (int bit = 31; bit >= 0; --bit) { const unsigned cand = prefix | (1u << bit); int cnt = 0;
            for (int j = 0; j < nj; ++j) cnt += __popcll(__ballot(s_key[wv][lane + 64 * j] >= cand));
            if (cnt >= 256) prefix = cand; }
        int ngt = 0;
        for (int j = 0; j < nj; ++j) ngt += __popcll(__ballot(s_key[wv][lane + 64 * j] > prefix));
        const int need = 256 - ngt; int nt = 0, ns = 0;
        for (int j = 0; j < nj; ++j) { const unsigned u = s_key[wv][lane + 64 * j];
            const unsigned long long mt = __ballot(u == prefix); const int trank = nt + __popcll(mt & ((1ull << lane) - 1ull));
            const bool sel = (u > prefix) || (u == prefix && trank < need);
            const unsigned long long ms = __ballot(sel); const int slot = ns + __popcll(ms & ((1ull << lane) - 1ull));
            if (sel) s_idx[wv][slot] = lane + 64 * j;
            nt += __popcll(mt); ns += __popcll(ms); }
        nsel = ns;
    }
    __syncthreads();
    float lg[4][4];
#pragma unroll
    for (int i = 0; i < 4; ++i) { const int slot = lane + 64 * i;
#pragma unroll
        for (int hh = 0; hh < 4; ++hh) lg[i][hh] = -INFINITY;
        if (slot < nsel) { const int s = s_idx[wv][slot]; const u32x4* kp = (const u32x4*)(zb + (size_t)s * ZP + ZB_K);
            float acc4[4] = {0.f, 0.f, 0.f, 0.f};
#pragma unroll
            for (int q8 = 0; q8 < 8; ++q8) { const u32x4 w = kp[q8]; float kv[8] = {bflo(w.x), bfhi(w.x), bflo(w.y), bfhi(w.y), bflo(w.z), bfhi(w.z), bflo(w.w), bfhi(w.w)};
#pragma unroll
                for (int hh = 0; hh < 4; ++hh)
#pragma unroll
                    for (int e = 0; e < 8; ++e) acc4[hh] += s_q[wv][hh * 64 + q8 * 8 + e] * kv[e]; }
#pragma unroll
            for (int hh = 0; hh < 4; ++hh) lg[i][hh] = acc4[hh]; } }
#pragma unroll
    for (int hh = 0; hh < 4; ++hh) {
        float m = fmaxf(fmaxf(lg[0][hh], lg[1][hh]), fmaxf(lg[2][hh], lg[3][hh])); m = wave_max(m);
        float p[4], l = 0.f;
#pragma unroll
        for (int i = 0; i < 4; ++i) { p[i] = exp2f(lg[i][hh] - m); l += p[i]; }
        l = wave_sum(l); const float rl = 1.f / l;
#pragma unroll
        for (int i = 0; i < 4; ++i) s_p[wv][hh][lane + 64 * i] = p[i] * rl;
    }
    __syncthreads();
    float o[4] = {0.f, 0.f, 0.f, 0.f};
    for (int slot = 0; slot < nsel; ++slot) { const int s = s_idx[wv][slot]; const float vv = bf2f(zb[(size_t)s * ZP + ZB_V + lane]);
#pragma unroll
        for (int hh = 0; hh < 4; ++hh) o[hh] += s_p[wv][hh][slot] * vv; }
#pragma unroll
    for (int hh = 0; hh < 4; ++hh) { const float g = bf2f(zr[ZB_G + hh * 64 + lane]); a.Y[(size_t)row * DM + 384 + hh * 64 + lane] = (bf16_t)f2bf(o[hh] * g * sigmoidf_(g)); }
}

__device__ __forceinline__ void dil_simple_unit(const MixArgs& a, unsigned char* ldsb, int wid) {
    const int tid0 = opaque_tid(); const int wv = tid0 >> 6, lane = tid0 & 63;
    typedef float (*q_t)[64]; typedef float (*pp_t)[192];
    q_t s_q = (q_t)(ldsb); pp_t s_p = (pp_t)(ldsb + 2048);
    const int row = wid >> 1, hg = wid & 1, b = row / SEQ, t = row % SEQ;
    const bf16_t* zr = a.Z + (size_t)row * ZP; const bf16_t* zb = a.Z + (size_t)b * SEQ * ZP;
    float og[3], lse[3];
#pragma unroll
    for (int gi = 0; gi < 3; ++gi) {
        const int head = gi * 2 + hg, rate = (gi == 0) ? 1 : (gi == 1) ? 4 : 16;
        const int ip = t / rate; const int nkeys = (ip < 128 ? ip : 128) + 1;
        __syncthreads();
        s_q[wv][lane] = bf2f(zr[ZC_Q + head * 64 + lane]);
        __syncthreads();
        float lg[3];
#pragma unroll
        for (int i = 0; i < 3; ++i) { const int j = lane + 64 * i; lg[i] = -INFINITY;
            if (j < nkeys) { const u32x4* kp = (const u32x4*)(zb + (size_t)(t - j * rate) * ZP + ZC_K + head * 64); float d = 0.f;
#pragma unroll
                for (int q8 = 0; q8 < 8; ++q8) { const u32x4 w = kp[q8]; const float kv[8] = {bflo(w.x), bfhi(w.x), bflo(w.y), bfhi(w.y), bflo(w.z), bfhi(w.z), bflo(w.w), bfhi(w.w)};
#pragma unroll
                    for (int e = 0; e < 8; ++e) d += s_q[wv][q8 * 8 + e] * kv[e]; }
                lg[i] = d; } }
        const float m = wave_max(fmaxf(fmaxf(lg[0], lg[1]), lg[2]));
        float p[3], l = 0.f;
#pragma unroll
        for (int i = 0; i < 3; ++i) { p[i] = exp2f(lg[i] - m); l += p[i]; }
        l = wave_sum(l); const float rl = 1.f / l;
#pragma unroll
        for (int i = 0; i < 3; ++i) s_p[wv][lane + 64 * i] = p[i] * rl;
        __syncthreads();
        float o = 0.f;
        for (int j = 0; j < nkeys; ++j) o += s_p[wv][j] * bf2f(zb[(size_t)(t - j * rate) * ZP + ZC_V + head * 64 + lane]);
        og[gi] = o; lse[gi] = m + log2f(l);
    }
    const float mx = fmaxf(fmaxf(lse[0], lse[1]), lse[2]);
    const float e0 = exp2f(lse[0] - mx), e1 = exp2f(lse[1] - mx), e2 = exp2f(lse[2] - mx); const float rs = 1.f / (e0 + e1 + e2);
    const float al[3] = {e0 * rs, e1 * rs, e2 * rs};
#pragma unroll
    for (int gi = 0; gi < 3; ++gi) { const int head = gi * 2 + hg; const float g = bf2f(zr[ZC_G + head * 64 + lane]);
        a.Y[(size_t)row * DM + 640 + head * 64 + lane] = (bf16_t)f2bf(og[gi] * al[gi] * g * sigmoidf_(g)); }
}
namespace dsa {
#ifdef PROBE_T
#define DTS ((volatile LAS unsigned long long*)((LAS unsigned char*)ldsb + 131072 + 1024))
#define DSTAMP_B(id) do { if ((id) == PROBE_T && blockIdx.x == 0 && threadIdx.x == 0) DTS[0] = __builtin_amdgcn_s_memrealtime(); } while (0)
#define DSTAMP_E(id) do { if ((id) == PROBE_T && blockIdx.x == 0 && threadIdx.x == 0) DTS[1] += __builtin_amdgcn_s_memrealtime() - DTS[0]; } while (0)
#else
#define DSTAMP_B(id) do {} while (0)
#define DSTAMP_E(id) do {} while (0)
#endif
#define MFMA32(a, b, c) __builtin_amdgcn_mfma_f32_32x32x16_bf16((a), (b), (c), 0, 0, 0)
typedef short v4i16_t __attribute__((ext_vector_type(4)));
typedef short s16x4 __attribute__((ext_vector_type(4)));
constexpr int WAVE_LDS = 2048 + 4096;
constexpr int IKS_OFF = 8 * WAVE_LDS, IKS_BYTES = 65536;
__device__ __forceinline__ unsigned fkey(float f) { const unsigned b = __builtin_bit_cast(unsigned, f); return (b & 0x80000000u) ? ~b : (b | 0x80000000u); }
__device__ __forceinline__ float keyf(unsigned u) { const unsigned b = (u & 0x80000000u) ? (u & 0x7fffffffu) : ~u; return __builtin_bit_cast(float, b); }
__device__ __forceinline__ float relu_(float x) { const int b = __builtin_bit_cast(int, x); return __builtin_bit_cast(float, b > 0 ? b : 0); }
__device__ __forceinline__ s16x4 vtr(const LAS unsigned char* p) { return __builtin_bit_cast(s16x4, __builtin_amdgcn_ds_read_tr16_b64_v4i16((LAS v4i16_t*)p)); }

__device__ __forceinline__ unsigned next_pivot(unsigned ulo, unsigned uhi, int clo, int chi, int it) {
    unsigned p;
    const bool hl = clo >= 0, hh = chi >= 0;
    if (it == 0) p = fkey(0.0f);
    else if (!hh) { const float f = keyf(ulo); p = fkey(f >= 0.f ? 2.f * f + 0.25f : 0.5f * f + 0.125f); }
    else if (!hl) { const float f = keyf(uhi); p = fkey(f <= 0.f ? 2.f * f - 0.25f : 0.5f * f - 0.125f); }
    else { const float fl = keyf(ulo), fh = keyf(uhi);
        float fr = ((float)(clo - 256) + 0.5f) * __builtin_amdgcn_rcpf((float)(clo - chi)); fr = fminf(fmaxf(fr, 1.f / 32.f), 31.f / 32.f);
        if (it % 3 == 2) fr = 0.5f;
        p = fkey(fl + (fh - fl) * fr); }
    if (!(p > ulo && p < uhi)) p = ulo + ((uhi - ulo) >> 1);
    return p;
}

__device__ __forceinline__ void dsa_unit(const MixArgs& a, unsigned char* ldsb, int b, int blk) {
    const int tid = opaque_tid(), lane = tid & 63, wave = __builtin_amdgcn_readfirstlane(tid >> 6), r32 = lane & 31, hi = lane >> 5;
    const GAS bf16_t* zb = (const GAS bf16_t*)a.Z + (size_t)b * SEQ * ZP;
    LAS unsigned char* wl = (LAS unsigned char*)ldsb + wave * WAVE_LDS;
    LAS unsigned* bm = (LAS unsigned*)wl;
    LAS unsigned char* vimg = wl + 2048;
    const int tw = blk * 64 + 8 * wave;
    f32x16 zero16;
#pragma unroll
    for (int i = 0; i < 16; ++i) zero16[i] = 0.f;
#ifdef PROBE_SEL
#define NRND 4
#else
#define NRND 2
#endif
#pragma unroll 1
    for (int rnd_ = 0; rnd_ < NRND; ++rnd_) { const int rnd = rnd_ & 1;
        const int tb = tw + 4 * rnd;
        const int qsub = 2 * ((r32 >> 2) & 1) + (r32 >> 4), head = (r32 & 3) + 4 * ((r32 >> 3) & 1);
        const GAS bf16_t* iqp = zb + (size_t)(tb + qsub) * ZP + ZB_IQ + head * 32 + 8 * hi;
        const bf16x8 aiq0 = *(const GAS bf16x8*)iqp, aiq1 = *(const GAS bf16x8*)(iqp + 16);
        const int tqA = tb + 2 * hi, tqB = tqA + 1;
        float wA[8], wB[8];
        { const u32x4 ua = *(const GAS u32x4*)(zb + (size_t)tqA * ZP + ZB_IW), ub = *(const GAS u32x4*)(zb + (size_t)tqB * ZP + ZB_IW);
          wA[0] = bflo(ua.x); wA[1] = bfhi(ua.x); wA[2] = bflo(ua.y); wA[3] = bfhi(ua.y); wA[4] = bflo(ua.z); wA[5] = bfhi(ua.z); wA[6] = bflo(ua.w); wA[7] = bfhi(ua.w);
          wB[0] = bflo(ub.x); wB[1] = bfhi(ub.x); wB[2] = bflo(ub.y); wB[3] = bfhi(ub.y); wB[4] = bflo(ub.z); wB[5] = bfhi(ub.z); wB[6] = bflo(ub.w); wB[7] = bfhi(ub.w); }
        unsigned scA[64], scB[64];
        const int dA = tqA - 32 * ((tb + 3) >> 5);
        const int Tmax = (tb + 3) >> 5;
        int Tm_s = Tmax, Tm_b = Tmax; asm volatile("" : "+s"(Tm_s), "+s"(Tm_b));
        DSTAMP_B(30);
        const int TmaxU = 2 * blk + 1;
        const int fsw = (r32 >> 2) & 3;
        const LAS unsigned char* ikl = (const LAS unsigned char*)ldsb + IKS_OFF + r32 * 64;
        const int off0 = (hi ^ fsw) * 16, off1 = ((2 + hi) ^ fsw) * 16;
#ifdef PROBE_SCORE
        for (int rep_ = 0; rep_ < 2; ++rep_)
#endif
#pragma unroll
        for (int half = 0; half < 2; ++half) {
            if (32 * half <= TmaxU) {
                __syncthreads();
                { const int nkeys = min(32 * (TmaxU + 1) - 1024 * half, 1024);
                  const GAS bf16_t* src = (const GAS bf16_t*)a.IKC + ((size_t)b * SEQ + 1024 * half) * 32;
                  for (int ch = tid; ch < nkeys * 4; ch += 512) { const int key = ch >> 2, c4 = ch & 3;
                      *(LAS u32x4*)((LAS unsigned char*)ldsb + IKS_OFF + key * 64 + ((c4 ^ ((key >> 2) & 3)) * 16)) = *(const GAS u32x4*)(src + key * 32 + c4 * 8); } }
                asm volatile("s_waitcnt vmcnt(0) lgkmcnt(0)" ::: "memory");
                __syncthreads();
                bf16x8 kb0[2], kb1[2];
#pragma unroll
                for (int i = 0; i < 2; ++i) { if (32 * half + i <= Tm_s) { kb0[i] = *(const LAS bf16x8*)(ikl + i * 2048 + off0); kb1[i] = *(const LAS bf16x8*)(ikl + i * 2048 + off1); } }
#pragma unroll
                for (int i = 0; i < 32; ++i) { const int T = 32 * half + i;
                    if (T <= Tm_s) {
                        f32x16 c = MFMA32(aiq0, kb0[i & 1], zero16); c = MFMA32(aiq1, kb1[i & 1], c);
                        if (i + 2 < 32 && T + 2 <= Tm_s) { kb0[i & 1] = *(const LAS bf16x8*)(ikl + (i + 2) * 2048 + off0); kb1[i & 1] = *(const LAS bf16x8*)(ikl + (i + 2) * 2048 + off1); }
                        float sA = 0.f, sB = 0.f;
#pragma unroll
                        for (int r = 0; r < 8; ++r) { sA += wA[r] * relu_(c[r]); sB += wB[r] * relu_(c[8 + r]); }
                        const bool last = (T == Tm_s);
                        scA[T] = (!last || r32 <= dA) ? fkey(sA + 0.f) : 0u; scB[T] = (!last || r32 <= dA + 1) ? fkey(sB + 0.f) : 0u;
                    } else { scA[T] = 0u; scB[T] = 0u; }
                }
            } else {
#pragma unroll
                for (int i = 0; i < 32; ++i) { scA[32 * half + i] = 0u; scB[32 * half + i] = 0u; }
            }
        }
        DSTAMP_E(30); DSTAMP_B(31);
        const int nA = tqA + 1, nB = tqB + 1;
        unsigned uloA = 1u, uhiA = 0xffffffffu, uloB = 1u, uhiB = 0xffffffffu; int cloA = -1, chiA = -1, cloB = -1, chiB = -1;
        bool doneA = nA <= 256, doneB = nB <= 256;
        unsigned thA = 1u, thB = 1u; int needA = 0, needB = 0;
        int itn = 0;
        for (; itn < 200; ++itn) {
            if (!doneA && uhiA - uloA <= 1u) { thA = uhiA; needA = 256 - max(chiA, 0); doneA = true; }
            if (!doneB && uhiB - uloB <= 1u) { thB = uhiB; needB = 256 - max(chiB, 0); doneB = true; }
            const bool actA = !doneA && ((cloA < 0 ? nA : cloA) - max(chiA, 0) > 128), actB = !doneB && ((cloB < 0 ? nB : cloB) - max(chiB, 0) > 128);
            if (!__any(actA || actB)) break;
            const unsigned pA = actA ? next_pivot(uloA, uhiA, cloA, chiA, itn) : 0xffffffffu, pB = actB ? next_pivot(uloB, uhiB, cloB, chiB, itn) : 0xffffffffu;
            int ca = 0, cb = 0;
#pragma unroll
            for (int T = 0; T < 64; ++T)
                asm("v_cmp_ge_u32 vcc, %2, %3\n\tv_addc_co_u32 %0, vcc, 0, %0, vcc\n\tv_cmp_ge_u32 vcc, %4, %5\n\tv_addc_co_u32 %1, vcc, 0, %1, vcc" : "+v"(ca), "+v"(cb) : "v"(scA[T]), "v"(pA), "v"(scB[T]), "v"(pB) : "vcc");
            int pk = ca | (cb << 16);
            pk += __shfl_xor(pk, 1); pk += __shfl_xor(pk, 2); pk += __shfl_xor(pk, 4); pk += __shfl_xor(pk, 8); pk += __shfl_xor(pk, 16);
            ca = pk & 0xffff; cb = pk >> 16;
            if (actA) { if (ca == 256) { thA = pA; needA = 0; doneA = true; } else if (ca > 256) { uloA = pA; cloA = ca; } else { uhiA = pA; chiA = ca; } }
            if (actB) { if (cb == 256) { thB = pB; needB = 0; doneB = true; } else if (cb > 256) { uloB = pB; cloB = cb; } else { uhiB = pB; chiB = cb; } }
        }
        if (__any(!doneA || !doneB)) {
            LAS unsigned* lst = (LAS unsigned*)vimg;
            LAS unsigned* lstA = lst + hi * 128, *lstB = lst + 256 + hi * 128;
            const int trashA = 512 - hi * 128 + lane, trashB = 576 - 256 - hi * 128 + lane;
            const unsigned wA_ = doneA ? 0u : uhiA - uloA, wB_ = doneB ? 0u : uhiB - uloB;
            int posA = 0, posB = 0;
#pragma unroll
            for (int T = 0; T < 64; ++T) {
                const bool fA = (scA[T] - uloA) < wA_, fB = (scB[T] - uloB) < wB_;
                const unsigned long long mA = __ballot(fA), mB = __ballot(fB);
                const int iA = hi ? __builtin_amdgcn_mbcnt_hi((unsigned)(mA >> 32), 0) : __builtin_amdgcn_mbcnt_lo((unsigned)mA, 0);
                const int iB = hi ? __builtin_amdgcn_mbcnt_hi((unsigned)(mB >> 32), 0) : __builtin_amdgcn_mbcnt_lo((unsigned)mB, 0);
                lstA[fA ? posA + iA : trashA] = scA[T];
                lstB[fB ? posB + iB : trashB] = scB[T];
                posA += hi ? __popc((unsigned)(mA >> 32)) : __popc((unsigned)mA); posB += hi ? __popc((unsigned)(mB >> 32)) : __popc((unsigned)mB);
            }
            asm volatile("s_waitcnt lgkmcnt(0)" ::: "memory");
            unsigned ca_[4], cb_[4];
#pragma unroll
            for (int j = 0; j < 4; ++j) { ca_[j] = (r32 + 32 * j < posA) ? lstA[r32 + 32 * j] : 0u; cb_[j] = (r32 + 32 * j < posB) ? lstB[r32 + 32 * j] : 0u; }
            const int baseA = max(chiA, 0), baseB = max(chiB, 0);
            for (; itn < 400; ++itn) {
                unsigned mnA = 0xffffffffu, mxA = 0u, mnB = 0xffffffffu, mxB = 0u;
                const unsigned wa = doneA ? 0u : uhiA - uloA, wb = doneB ? 0u : uhiB - uloB;
#pragma unroll
                for (int j = 0; j < 4; ++j) { if ((ca_[j] - uloA) < wa) { mnA = min(mnA, ca_[j]); mxA = max(mxA, ca_[j]); } if ((cb_[j] - uloB) < wb) { mnB = min(mnB, cb_[j]); mxB = max(mxB, cb_[j]); } }
#pragma unroll
                for (int o = 1; o < 32; o <<= 1) { mnA = min(mnA, (unsigned)__shfl_xor((int)mnA, o)); mxA = max(mxA, (unsigned)__shfl_xor((int)mxA, o)); mnB = min(mnB, (unsigned)__shfl_xor((int)mnB, o)); mxB = max(mxB, (unsigned)__shfl_xor((int)mxB, o)); }
                if (!doneA) { if (mnA >= mxA) { thA = mxA + 1u; needA = 256 - max(chiA, 0); doneA = true; } else { uloA = mnA; uhiA = mxA + 1u; if (cloA < 0) cloA = nA; if (chiA < 0) chiA = 0; } }
                if (!doneB) { if (mnB >= mxB) { thB = mxB + 1u; needB = 256 - max(chiB, 0); doneB = true; } else { uloB = mnB; uhiB = mxB + 1u; if (cloB < 0) cloB = nB; if (chiB < 0) chiB = 0; } }
                if (!__any(!doneA || !doneB)) break;
                const unsigned pA = doneA ? 0xffffffffu : next_pivot(uloA, uhiA, cloA, chiA, itn | 1), pB = doneB ? 0xffffffffu : next_pivot(uloB, uhiB, cloB, chiB, itn | 1);
                int pk = 0;
#pragma unroll
                for (int j = 0; j < 4; ++j) pk += ((ca_[j] >= pA) ? 1 : 0) + ((cb_[j] >= pB) ? 0x10000 : 0);
                pk += __shfl_xor(pk, 1); pk += __shfl_xor(pk, 2); pk += __shfl_xor(pk, 4); pk += __shfl_xor(pk, 8); pk += __shfl_xor(pk, 16);
                const int ca = baseA + (pk & 0xffff), cb = baseB + (pk >> 16);
                if (!doneA) { if (ca == 256) { thA = pA; needA = 0; doneA = true; } else if (ca > 256) { uloA = pA; cloA = ca; } else { uhiA = pA; chiA = ca; } }
                if (!doneB) { if (cb == 256) { thB = pB; needB = 0; doneB = true; } else if (cb > 256) { uloB = pB; cloB = cb; } else { uhiB = pB; chiB = cb; } }
            }
        }
        DSTAMP_E(31); DSTAMP_B(32);
        int rem0 = __builtin_amdgcn_readlane(needA, 0), rem1 = __builtin_amdgcn_readlane(needB, 0), rem2 = __builtin_amdgcn_readlane(needA, 32), rem3 = __builtin_amdgcn_readlane(needB, 32);
        const bool anytie = (rem0 | rem1 | rem2 | rem3) != 0;
        LAS unsigned* bmr = bm + 4 * rnd; asm volatile("" : "+v"(bmr));
#pragma unroll
        for (int T = 0; T < 64; ++T) {
            if (T <= Tm_b) {
                const unsigned long long mA = __ballot(scA[T] >= thA), mB = __ballot(scB[T] >= thB);
                unsigned m0 = (unsigned)mA, m2 = (unsigned)(mA >> 32), m1 = (unsigned)mB, m3 = (unsigned)(mB >> 32);
                if (anytie) {
                    const unsigned long long eA = __ballot(scA[T] == thA - 1u), eB = __ballot(scB[T] == thB - 1u);
                    unsigned e0 = (unsigned)eA, e2 = (unsigned)(eA >> 32), e1 = (unsigned)eB, e3 = (unsigned)(eB >> 32);
                    while (rem0 > 0 && e0) { const unsigned bit = e0 & (0u - e0); m0 |= bit; e0 ^= bit; --rem0; }
                    while (rem1 > 0 && e1) { const unsigned bit = e1 & (0u - e1); m1 |= bit; e1 ^= bit; --rem1; }
                    while (rem2 > 0 && e2) { const unsigned bit = e2 & (0u - e2); m2 |= bit; e2 ^= bit; --rem2; }
                    while (rem3 > 0 && e3) { const unsigned bit = e3 & (0u - e3); m3 |= bit; e3 ^= bit; --rem3; }
                }
                if (lane == 0) { u32x4 w; w.x = m0; w.y = m1; w.z = m2; w.w = m3; *(LAS u32x4*)(bmr + T * 8) = w; }
            }
        }
        DSTAMP_E(32);
    }
    DSTAMP_B(33);
    asm volatile("s_waitcnt lgkmcnt(0)" ::: "memory");
    const int qc = r32 >> 2, hc = r32 & 3;
    const GAS bf16_t* kvb = (const GAS bf16_t*)a.KV + (size_t)b * SEQ * 128;
    const size_t qrow = (size_t)(b * SEQ + tw + qc);
    bf16x8 bq[4];
#pragma unroll
    for (int s = 0; s < 4; ++s) bq[s] = *(const GAS bf16x8*)((const GAS bf16_t*)a.Z + qrow * ZP + ZB_Q + hc * 64 + 16 * s + 8 * hi);
    f32x16 o0 = zero16, o1 = zero16; float lsum = 0.f;
    const int Tend = (tw + 7) >> 5;
    const int g16 = lane >> 4, i16 = lane & 15, q4 = i16 >> 2, p4 = i16 & 3;
    const int vrd = ((g16 >> 1) * 4 + q4) * 64 + (16 * (g16 & 1) + 4 * p4) * 2;
    const int vwr_key = lane >> 3, vwr_ch = lane & 7;
    u32x4 vst[4]; bf16x8 ak[4];
    auto load_tile = [&](int T) {
#pragma unroll
        for (int s = 0; s < 4; ++s) ak[s] = *(const GAS bf16x8*)(kvb + (size_t)(32 * T + r32) * 128 + 16 * s + 8 * hi);
#pragma unroll
        for (int i = 0; i < 4; ++i) vst[i] = *(const GAS u32x4*)(kvb + (size_t)(32 * T + vwr_key + 8 * i) * 128 + 64 + 8 * vwr_ch);
    };
#ifdef PROBE_ATT
    for (int rep_ = 0; rep_ < 2; ++rep_) { o0 = zero16; o1 = zero16; lsum = 0.f;
#endif
    load_tile(0);
#pragma unroll 1
    for (int T = 0; T <= Tend; ++T) {
#pragma unroll
        for (int i = 0; i < 4; ++i) *(LAS u32x4*)(vimg + (vwr_ch >> 2) * 2048 + (vwr_key + 8 * i) * 64 + (vwr_ch & 3) * 16) = vst[i];
        f32x16 sacc = MFMA32(ak[0], bq[0], zero16); sacc = MFMA32(ak[1], bq[1], sacc); sacc = MFMA32(ak[2], bq[2], sacc); sacc = MFMA32(ak[3], bq[3], sacc);
        const unsigned mw = bm[T * 8 + qc] >> (4 * hi);
        if (T < Tend) load_tile(T + 1);
        asm volatile("s_waitcnt lgkmcnt(0)" ::: "memory");
        s16x4 va[2][2][2];
#pragma unroll
        for (int dt = 0; dt < 2; ++dt)
#pragma unroll
            for (int s = 0; s < 2; ++s) { va[dt][s][0] = vtr(vimg + dt * 2048 + (16 * s) * 64 + vrd); va[dt][s][1] = vtr(vimg + dt * 2048 + (16 * s + 8) * 64 + vrd); }
        unsigned pw[8];
#pragma unroll
        for (int r = 0; r < 16; r += 2) {
            const float e0 = __builtin_amdgcn_exp2f(fminf(sacc[r], 64.f)), e1 = __builtin_amdgcn_exp2f(fminf(sacc[r + 1], 64.f));
            const int c0 = (r & 3) + 8 * (r >> 2), c1 = ((r + 1) & 3) + 8 * ((r + 1) >> 2);
            const float p0 = __builtin_bit_cast(float, __builtin_bit_cast(unsigned, e0) & (unsigned)__builtin_amdgcn_sbfe((int)mw, c0, 1));
            const float p1 = __builtin_bit_cast(float, __builtin_bit_cast(unsigned, e1) & (unsigned)__builtin_amdgcn_sbfe((int)mw, c1, 1));
            lsum += p0 + p1;
            pw[r >> 1] = pk2(p0, p1);
        }
        asm volatile("s_waitcnt lgkmcnt(0)" ::: "memory");
#pragma unroll
        for (int s = 0; s < 2; ++s) {
            u32x4 pv4; pv4.x = pw[4 * s]; pv4.y = pw[4 * s + 1]; pv4.z = pw[4 * s + 2]; pv4.w = pw[4 * s + 3];
            const bf16x8 pb = __builtin_bit_cast(bf16x8, pv4);
            const bf16x8 v0 = __builtin_shufflevector(va[0][s][0], va[0][s][1], 0, 1, 2, 3, 4, 5, 6, 7), v1 = __builtin_shufflevector(va[1][s][0], va[1][s][1], 0, 1, 2, 3, 4, 5, 6, 7);
            o0 = MFMA32(v0, pb, o0); o1 = MFMA32(v1, pb, o1);
        }
    }
#ifdef PROBE_ATT
    }
#endif
    DSTAMP_E(33);
    lsum += __shfl_xor(lsum, 32);
    const float rl = 1.0f / lsum;
    const GAS bf16_t* gp = (const GAS bf16_t*)a.Z + qrow * ZP + ZB_G + hc * 64; GAS bf16_t* yp = (GAS bf16_t*)a.Y + qrow * DM + 384 + hc * 64;
#pragma unroll
    for (int dt = 0; dt < 2; ++dt)
#pragma unroll
        for (int i = 0; i < 4; ++i) {
            const int d = 32 * dt + 8 * i + 4 * hi;
            const u32x2 gw = *(const GAS u32x2*)(gp + d);
            const float g0 = bflo(gw.x), g1 = bfhi(gw.x), g2 = bflo(gw.y), g3 = bfhi(gw.y);
            const f32x16& o = dt ? o1 : o0;
            u32x2 w; w.x = pk2(o[4 * i] * rl * g0 * sigmoidf_(g0), o[4 * i + 1] * rl * g1 * sigmoidf_(g1)); w.y = pk2(o[4 * i + 2] * rl * g2 * sigmoidf_(g2), o[4 * i + 3] * rl * g3 * sigmoidf_(g3));
            *(GAS u32x2*)(yp + d) = w;
        }
}
}
namespace dil {
using dsa::vtr; using dsa::s16x4;
__device__ __forceinline__ void dil_unit(const MixArgs& a, float* LQ, unsigned char* ldsb, int b, int gi, int u16) {
    const int tid = opaque_tid(), lane = tid & 63, wave = __builtin_amdgcn_readfirstlane(tid >> 6), r32 = lane & 31, hi = lane >> 5;
    const int rate = (gi == 0) ? 1 : (gi == 1) ? 4 : 16, nblk = 16 / rate, c = u16 / nblk, qb = u16 % nblk;
    const int head = gi * 2 + (wave >> 2), q0 = 128 * qb + 32 * (wave & 3);
    const GAS bf16_t* zb = (const GAS bf16_t*)a.Z + (size_t)b * SEQ * ZP;
    LAS unsigned char* vimg = (LAS unsigned char*)ldsb + wave * 4096;
    f32x16 zero16;
#pragma unroll
    for (int i = 0; i < 16; ++i) zero16[i] = 0.f;
    const size_t qrow = (size_t)b * SEQ + (size_t)(q0 + r32) * rate + c;
    bf16x8 bq[4];
#pragma unroll
    for (int s = 0; s < 4; ++s) bq[s] = *(const GAS bf16x8*)((const GAS bf16_t*)a.Z + qrow * ZP + ZC_Q + head * 64 + 16 * s + 8 * hi);
    f32x16 o0 = zero16, o1 = zero16; float lsum = 0.f;
    const int g16 = lane >> 4, i16 = lane & 15, q4 = i16 >> 2, p4 = i16 & 3;
    const int vrd = ((g16 >> 1) * 4 + q4) * 64 + (16 * (g16 & 1) + 4 * p4) * 2;
    const int vwr_key = lane >> 3, vwr_ch = lane & 7;
#pragma unroll 1
    for (int ti = 0; ti < 5; ++ti) {
        const int j0 = q0 - 128 + 32 * ti;
        if (j0 < 0) continue;
        bf16x8 ak[4]; u32x4 vst[4];
#pragma unroll
        for (int s = 0; s < 4; ++s) ak[s] = *(const GAS bf16x8*)(zb + ((size_t)(j0 + r32) * rate + c) * ZP + ZC_K + head * 64 + 16 * s + 8 * hi);
#pragma unroll
        for (int i = 0; i < 4; ++i) vst[i] = *(const GAS u32x4*)(zb + ((size_t)(j0 + vwr_key + 8 * i) * rate + c) * ZP + ZC_V + head * 64 + 8 * vwr_ch);
#pragma unroll
        for (int i = 0; i < 4; ++i) *(LAS u32x4*)(vimg + (vwr_ch >> 2) * 2048 + (vwr_key + 8 * i) * 64 + (vwr_ch & 3) * 16) = vst[i];
        f32x16 sacc = MFMA32(ak[0], bq[0], zero16); sacc = MFMA32(ak[1], bq[1], sacc); sacc = MFMA32(ak[2], bq[2], sacc); sacc = MFMA32(ak[3], bq[3], sacc);
        asm volatile("s_waitcnt lgkmcnt(0)" ::: "memory");
        s16x4 va[2][2][2];
#pragma unroll
        for (int dt = 0; dt < 2; ++dt)
#pragma unroll
            for (int s = 0; s < 2; ++s) { va[dt][s][0] = vtr(vimg + dt * 2048 + (16 * s) * 64 + vrd); va[dt][s][1] = vtr(vimg + dt * 2048 + (16 * s + 8) * 64 + vrd); }
        const int dbase = q0 + r32 - j0 - 4 * hi;
        unsigned pw[8];
#pragma unroll
        for (int r = 0; r < 16; r += 2) {
            const int d0 = dbase - ((r & 3) + 8 * (r >> 2)), d1 = dbase - (((r + 1) & 3) + 8 * ((r + 1) >> 2));
            float p0 = __builtin_amdgcn_exp2f(fminf(sacc[r], 64.f)), p1 = __builtin_amdgcn_exp2f(fminf(sacc[r + 1], 64.f));
            p0 = ((unsigned)d0 <= 128u) ? p0 : 0.f; p1 = ((unsigned)d1 <= 128u) ? p1 : 0.f;
            lsum += p0 + p1;
            pw[r >> 1] = pk2(p0, p1);
        }
        asm volatile("s_waitcnt lgkmcnt(0)" ::: "memory");
#pragma unroll
        for (int s = 0; s < 2; ++s) {
            u32x4 pv4; pv4.x = pw[4 * s]; pv4.y = pw[4 * s + 1]; pv4.z = pw[4 * s + 2]; pv4.w = pw[4 * s + 3];
            const bf16x8 pb = __builtin_bit_cast(bf16x8, pv4);
            const bf16x8 v0 = __builtin_shufflevector(va[0][s][0], va[0][s][1], 0, 1, 2, 3, 4, 5, 6, 7), v1 = __builtin_shufflevector(va[1][s][0], va[1][s][1], 0, 1, 2, 3, 4, 5, 6, 7);
            o0 = MFMA32(v0, pb, o0); o1 = MFMA32(v1, pb, o1);
        }
    }
    lsum += __shfl_xor(lsum, 32);
    if (hi == 0) LQ[qrow * 8 + head] = lsum;
    GAS bf16_t* yp = (GAS bf16_t*)a.Y + qrow * DM + 640 + head * 64;
#pragma unroll
    for (int dt = 0; dt < 2; ++dt)
#pragma unroll
        for (int i = 0; i < 4; ++i) {
            const int d = 32 * dt + 8 * i + 4 * hi; const f32x16& o = dt ? o1 : o0;
            u32x2 w; w.x = pk2(o[4 * i], o[4 * i + 1]); w.y = pk2(o[4 * i + 2], o[4 * i + 3]);
            *(GAS u32x2*)(yp + d) = w;
        }
}
__device__ __forceinline__ void dil_merge(const MixArgs& a, const float* LQ, int first, int nthreads) {
    constexpr int NCH = MTOK * 48;
    for (int id0 = first; id0 < NCH; id0 += 4 * nthreads) {
        u32x4 ow[4], gw[4]; float rl[4];
#pragma unroll
        for (int j = 0; j < 4; ++j) { const int id = id0 + j * nthreads; if (id < NCH) { const int row = id / 48, ch = id % 48;
            ow[j] = *(const GAS u32x4*)((const GAS bf16_t*)a.Y + (size_t)row * DM + 640 + ch * 8); gw[j] = *(const GAS u32x4*)((const GAS bf16_t*)a.Z + (size_t)row * ZP + ZC_G + ch * 8);
            const float* lq = LQ + (size_t)row * 8 + ((ch >> 3) & 1); rl[j] = lq[0] + lq[2] + lq[4]; } }
#pragma unroll
        for (int j = 0; j < 4; ++j) { const int id = id0 + j * nthreads; if (id < NCH) { const int row = id / 48, ch = id % 48; const float r = __builtin_amdgcn_rcpf(rl[j]);
            const unsigned o4[4] = {ow[j].x, ow[j].y, ow[j].z, ow[j].w}, g4[4] = {gw[j].x, gw[j].y, gw[j].z, gw[j].w}; unsigned w4[4];
#pragma unroll
            for (int k = 0; k < 4; ++k) { const float g0 = bflo(g4[k]), g1 = bfhi(g4[k]); w4[k] = pk2(bflo(o4[k]) * r * g0 * sigmoidf_(g0), bfhi(o4[k]) * r * g1 * sigmoidf_(g1)); }
            u32x4 w; w.x = w4[0]; w.y = w4[1]; w.z = w4[2]; w.w = w4[3]; *(GAS u32x4*)((GAS bf16_t*)a.Y + (size_t)row * DM + 640 + ch * 8) = w; } }
    }
}
}
namespace rwkv {
#ifdef PROBE_T
#define RTS ((volatile LAS unsigned long long*)((LAS unsigned char*)ldsb + 131072 + 1024))
#define RST(id_end, id_begin) do { if (blockIdx.x == 0 && threadIdx.x == 0) { const unsigned long long now_ = __builtin_amdgcn_s_memrealtime(); if ((id_end) == PROBE_T) RTS[1] += now_ - RTS[0]; if ((id_begin) == PROBE_T) RTS[0] = now_; } } while (0)
#else
#define RST(a, b) do {} while (0)
#endif
using dsa::vtr; using dsa::s16x4;
constexpr int IP = 144;
constexpr int IMG = 64 * IP;
constexpr int S_WD = 0 * IMG, S_AD = 1 * IMG, S_V = 2 * IMG, S_AT = 3 * IMG, S_BH = 4 * IMG, S_KH = 5 * IMG, S_RT = 6 * IMG, S_KB = 7 * IMG, S_BB = 8 * IMG, S_ARB = 9 * IMG, S_AH = 10 * IMG, S_UV = 11 * IMG;
constexpr int S_AAK = S_WD, S_ARK = S_AD, S_TT = S_BH, S_W1 = S_KH;
constexpr int F_AAB = 12 * IMG;
constexpr int F_LG = S_ARB;
constexpr int F_TOT = F_AAB + 16384;
static_assert(F_TOT + 512 <= 131072 && F_LG + 16384 <= F_AAB, "rwkv LDS map");

struct RArgs { const float* mu; const float* w0; const float* a0; const float* k_k; const float* k_a; const float* r_k; const float* ln_g; const float* ln_b;
               const bf16_t* wupT; const bf16_t* aupT; bf16_t* RQ; bf16_t* RM; bf16_t* RN; float* RG; float* RB; };

__device__ __forceinline__ bf16x8 rowfrag(const LAS unsigned char* img, int r0, int k0, int r32, int hi) { return *(const LAS bf16x8*)(img + (r0 + r32) * IP + (k0 + 8 * hi) * 2); }
__device__ __forceinline__ bf16x8 colfrag(const LAS unsigned char* img, int c0, int k0, int lane) {
    const int g16 = lane >> 4, i16 = lane & 15;
    const LAS unsigned char* p = img + (k0 + 8 * (g16 >> 1) + (i16 >> 2)) * IP + (c0 + 16 * (g16 & 1) + 4 * (i16 & 3)) * 2;
    const s16x4 lo = vtr(p), hi4 = vtr(p + 4 * IP);
    return __builtin_shufflevector(lo, hi4, 0, 1, 2, 3, 4, 5, 6, 7);
}
__device__ __forceinline__ bf16x8 colfrag_perm(const LAS unsigned char* img, int c0, int k0, int lane) {
    const int g16 = lane >> 4, i16 = lane & 15;
    const LAS unsigned char* p = img + (k0 + 4 * (g16 >> 1) + (i16 >> 2)) * IP + (c0 + 16 * (g16 & 1) + 4 * (i16 & 3)) * 2;
    const s16x4 lo = vtr(p), hi4 = vtr(p + 8 * IP);
    return __builtin_shufflevector(lo, hi4, 0, 1, 2, 3, 4, 5, 6, 7);
}
__device__ __forceinline__ bf16x8 rowfrag_f32(const LAS float* img, int r0, int k0, int r32, int hi) {
    const LAS f32x4* p = (const LAS f32x4*)(img + (r0 + r32) * 64 + k0 + 8 * hi); const f32x4 a = p[0], b = p[1];
    u32x4 w; w.x = pk2(a[0], a[1]); w.y = pk2(a[2], a[3]); w.z = pk2(b[0], b[1]); w.w = pk2(b[2], b[3]); return __builtin_bit_cast(bf16x8, w);
}
__device__ __forceinline__ void store_T(LAS unsigned char* imgT, const f32x16& c, int r0, int c0, int r32, int hi) {
#pragma unroll
    for (int g = 0; g < 4; ++g) { u32x2 w; w.x = pk2(c[4 * g], c[4 * g + 1]); w.y = pk2(c[4 * g + 2], c[4 * g + 3]); *(LAS u32x2*)(imgT + (c0 + r32) * IP + (r0 + 8 * g + 4 * hi) * 2) = w; }
}
__device__ __forceinline__ void store_T_global(GAS bf16_t* gT  , const f32x16& c, int r0, int c0, int r32, int hi) {
#pragma unroll
    for (int g = 0; g < 4; ++g) { u32x2 w; w.x = pk2(c[4 * g], c[4 * g + 1]); w.y = pk2(c[4 * g + 2], c[4 * g + 3]); *(GAS u32x2*)(gT + (c0 + r32) * 64 + r0 + 8 * g + 4 * hi) = w; }
}
__device__ __forceinline__ f32x16 zero16() { f32x16 z;
#pragma unroll
    for (int i = 0; i < 16; ++i) z[i] = 0.f;
    return z; }
#define WSYNC() asm volatile("s_waitcnt lgkmcnt(0)" ::: "memory")
#define BAR() do { asm volatile("s_waitcnt lgkmcnt(0)" ::: "memory"); __builtin_amdgcn_s_barrier(); asm volatile("" ::: "memory"); } while (0)

constexpr int R1_STG = S_AT;
constexpr int R1_SAVE = 131072 + 2048, R1_PAR = R1_SAVE + 1024, R1_WUP = R1_PAR + 2560, R1_AUP = R1_WUP + IMG;
struct R1Raw { u32x4 c[5]; };
__device__ __forceinline__ void r1_load(const MixArgs& a, R1Raw& raw, int tid, int b, int h, int ck) {
    const int et = tid >> 3, ec = (tid & 7) * 8, hc = h * 64 + ec;
    const GAS bf16_t* zr = (const GAS bf16_t*)a.Z + ((size_t)b * SEQ + ck * 64 + et) * ZP;
    const int cols[5] = {ZA_R + hc, ZA_K + hc, ZA_V + hc, ZA_WD + ec, ZA_AD + ec};
#pragma unroll
    for (int i = 0; i < 5; ++i) raw.c[i] = *(const GAS u32x4*)(zr + cols[i]);
}
__device__ __forceinline__ void r1_load_params(const RArgs& ra, unsigned char* ldsb, int tid, int h) {
    LAS float* par = (LAS float*)((LAS unsigned char*)ldsb + R1_PAR);
    for (int i = tid; i < 640; i += 512) { const int g = i >> 6, c = i & 63; float v;
        if (g == 0) v = ra.mu[ZA_R + h * 64 + c]; else if (g == 1) v = ra.mu[ZA_K + h * 64 + c]; else if (g == 2) v = ra.mu[ZA_V + h * 64 + c]; else if (g == 3) v = ra.mu[ZA_WD + c]; else if (g == 4) v = ra.mu[ZA_AD + c];
        else if (g == 5) v = ra.w0[h * 64 + c]; else if (g == 6) v = ra.a0[h * 64 + c]; else if (g == 7) v = ra.k_k[h * 64 + c]; else if (g == 8) v = ra.k_a[h * 64 + c]; else v = ra.r_k[h * 64 + c];
        par[i] = v; }
    for (int ch = tid; ch < 1024; ch += 512) { const int m = ch >> 9, row = (ch >> 3) & 63, c8 = ch & 7;
        *(LAS u32x4*)((LAS unsigned char*)ldsb + (m ? R1_AUP : R1_WUP) + row * IP + c8 * 16) = *(const GAS u32x4*)((const GAS bf16_t*)(m ? ra.aupT : ra.wupT) + (size_t)(h * 64 + row) * 64 + c8 * 8); }
}
static_assert(65 * 640 <= 5 * IMG, "staging fits");
__device__ __forceinline__ void rwkv_chunk_unit(const MixArgs& a, const RArgs& ra, unsigned char* ldsb, int b, int h, int ck, R1Raw& raw, int prev_mode, bool has_next, int nb, int nh, int nck) {
    const int tid = opaque_tid(), lane = tid & 63, wave = __builtin_amdgcn_readfirstlane(tid >> 6), r32 = lane & 31, hi = lane >> 5;
    LAS unsigned char* L = (LAS unsigned char*)ldsb;
    LAS float* fETA = (LAS float*)(L + F_AAB); LAS float* fAAB = fETA; LAS float* fLG = (LAS float*)(L + F_LG); LAS float* fTOT = (LAS float*)(L + F_TOT);
    const int t0 = ck * 64;
    const size_t row0 = (size_t)b * SEQ + t0;
    const int unit = (b * 6 + h) * 32 + ck;
    RST(-1, 50);
    const int et = tid >> 3, ec = (tid & 7) * 8, hc = h * 64 + ec;
    const LAS float* par = (const LAS float*)(L + R1_PAR);
    float r8[8], k8[8];
    {
        {
            LAS unsigned char* stg = L + R1_STG;
#pragma unroll
            for (int i = 0; i < 5; ++i) *(LAS u32x4*)(stg + (et + 1) * 640 + i * 128 + (tid & 7) * 16) = raw.c[i];
            if (et == 0) {
                const int hc0 = h * 64 + ec; const int cols[5] = {ZA_R + hc0, ZA_K + hc0, ZA_V + hc0, ZA_WD + ec, ZA_AD + ec};
#pragma unroll
                for (int i = 0; i < 5; ++i) { u32x4 pv = zero_u32x4();
                    if (prev_mode == 1) pv = *(const LAS u32x4*)(L + R1_SAVE + i * 128 + (tid & 7) * 16);
                    else if (prev_mode == 2) pv = *(const GAS u32x4*)((const GAS bf16_t*)a.Z + (row0 - 1) * ZP + cols[i]);
                    *(LAS u32x4*)(stg + i * 128 + (tid & 7) * 16) = pv; }
            }
        }
        BAR();
        if (et == 63) {
#pragma unroll
            for (int i = 0; i < 5; ++i) *(LAS u32x4*)(L + R1_SAVE + i * 128 + (tid & 7) * 16) = raw.c[i];
        }
        auto mix8 = [&](int i, int col, float* out) {
            const u32x4 cw = raw.c[i], pw = *(const LAS u32x4*)(L + R1_STG + et * 640 + i * 128 + (tid & 7) * 16);
            const f32x4 m0 = *(const LAS f32x4*)(par + i * 64 + ec), m1 = *(const LAS f32x4*)(par + i * 64 + ec + 4); (void)col;
            const float cv[8] = {bflo(cw.x), bfhi(cw.x), bflo(cw.y), bfhi(cw.y), bflo(cw.z), bfhi(cw.z), bflo(cw.w), bfhi(cw.w)};
            const float pv[8] = {bflo(pw.x), bfhi(pw.x), bflo(pw.y), bfhi(pw.y), bflo(pw.z), bfhi(pw.z), bflo(pw.w), bfhi(pw.w)};
            const float mv[8] = {m0[0], m0[1], m0[2], m0[3], m1[0], m1[1], m1[2], m1[3]};
#pragma unroll
            for (int j = 0; j < 8; ++j) out[j] = cv[j] + (pv[j] - cv[j]) * mv[j];
        };
        float v8[8], wd8[8], ad8[8];
        mix8(0, ZA_R + hc, r8); mix8(1, ZA_K + hc, k8); mix8(2, ZA_V + hc, v8); mix8(3, ZA_WD + ec, wd8); mix8(4, ZA_AD + ec, ad8);
#pragma unroll
        for (int i = 0; i < 8; ++i) wd8[i] = tanhf_(wd8[i]);
        u32x4 w;
        w.x = pk2(wd8[0], wd8[1]); w.y = pk2(wd8[2], wd8[3]); w.z = pk2(wd8[4], wd8[5]); w.w = pk2(wd8[6], wd8[7]); *(LAS u32x4*)(L + S_WD + et * IP + ec * 2) = w;
        w.x = pk2(ad8[0], ad8[1]); w.y = pk2(ad8[2], ad8[3]); w.z = pk2(ad8[4], ad8[5]); w.w = pk2(ad8[6], ad8[7]); *(LAS u32x4*)(L + S_AD + et * IP + ec * 2) = w;
        w.x = pk2(v8[0], v8[1]); w.y = pk2(v8[2], v8[3]); w.z = pk2(v8[4], v8[5]); w.w = pk2(v8[6], v8[7]); *(LAS u32x4*)(L + S_V + et * IP + ec * 2) = w;
    }
    BAR();
    RST(50, 51);
    const int q = wave & 3, tr = q >> 1, tc = q & 1, grp = wave >> 2;
    {
        const LAS unsigned char* Aimg = L + (grp ? S_AD : S_WD);
        f32x16 acc = zero16();
#pragma unroll
        for (int s = 0; s < 4; ++s) acc = MFMA32(rowfrag(Aimg, 32 * tr, 16 * s, r32, hi), rowfrag(L + (grp ? R1_AUP : R1_WUP), 32 * tc, 16 * s, r32, hi), acc);
        const int c = 32 * tc + r32; const float bias = par[(grp ? 6 : 5) * 64 + c];
        if (grp == 0) {
            float x[16], gs[4];
#pragma unroll
            for (int i = 0; i < 16; ++i) x[i] = -DECAY_SCALE * sigmoidf_(acc[i] + bias);
#pragma unroll
            for (int g = 0; g < 4; ++g) gs[g] = (x[4 * g] + x[4 * g + 1]) + (x[4 * g + 2] + x[4 * g + 3]);
            float run = 0.f;
#pragma unroll
            for (int g = 0; g < 4; ++g) { const float other = __shfl_xor(gs[g], 32); float base = run + (hi ? other : 0.f); run += gs[g] + other;
#pragma unroll
                for (int j = 0; j < 4; ++j) { base += x[4 * g + j]; fLG[(32 * tr + 8 * g + 4 * hi + j) * 64 + c] = base; } }
            if (tr == 0 && hi == 0) fTOT[c] = run;
        } else {
#pragma unroll
            for (int i = 0; i < 16; ++i) fETA[(32 * tr + (i & 3) + 8 * (i >> 2) + 4 * hi) * 64 + c] = sigmoidf_(acc[i] + bias);
        }
    }
    BAR();
    RST(51, 52);
    {
        const f32x4 l0 = *(const LAS f32x4*)(fLG + et * 64 + ec), l1 = *(const LAS f32x4*)(fLG + et * 64 + ec + 4);
        f32x4 p0 = {0.f, 0.f, 0.f, 0.f}, p1 = p0; if (et > 0) { p0 = *(const LAS f32x4*)(fLG + (et - 1) * 64 + ec); p1 = *(const LAS f32x4*)(fLG + (et - 1) * 64 + ec + 4); }
        const f32x4 e0 = *(const LAS f32x4*)(fETA + et * 64 + ec), e1 = *(const LAS f32x4*)(fETA + et * 64 + ec + 4);
        const f32x4 z0 = *(const LAS f32x4*)(fLG + 63 * 64 + ec), z1 = *(const LAS f32x4*)(fLG + 63 * 64 + ec + 4);
        const f32x4 u0 = *(const LAS f32x4*)(fTOT + ec), u1 = *(const LAS f32x4*)(fTOT + ec + 4);
        float lg[8] = {l0[0], l0[1], l0[2], l0[3], l1[0], l1[1], l1[2], l1[3]}, lp[8] = {p0[0], p0[1], p0[2], p0[3], p1[0], p1[1], p1[2], p1[3]};
        const float eta[8] = {e0[0], e0[1], e0[2], e0[3], e1[0], e1[1], e1[2], e1[3]}, tot[8] = {u0[0], u0[1], u0[2], u0[3], u1[0], u1[1], u1[2], u1[3]};
        float lC[8] = {z0[0], z0[1], z0[2], z0[3], z1[0], z1[1], z1[2], z1[3]};
        float kk[8], kp[8], ss = 0.f, bsum = 0.f;
#pragma unroll
        for (int i = 0; i < 8; ++i) {
            if (et >= 32) lg[i] += tot[i]; if (et >= 33) lp[i] += tot[i]; lC[i] += tot[i];
            kk[i] = k8[i] * par[7 * 64 + ec + i]; ss += kk[i] * kk[i];
            kp[i] = k8[i] * (1.f + (eta[i] - 1.f) * par[8 * 64 + ec + i]); bsum += r8[i] * kp[i] * par[9 * 64 + ec + i];
        }
        ss += __shfl_xor(ss, 1); ss += __shfl_xor(ss, 2); ss += __shfl_xor(ss, 4);
        bsum += __shfl_xor(bsum, 1); bsum += __shfl_xor(bsum, 2); bsum += __shfl_xor(bsum, 4);
        const float rn = __builtin_amdgcn_rsqf(fmaxf(ss, 1e-24f));
        if ((tid & 7) == 0) ra.RB[(row0 + et) * 8 + h] = bsum;
        float at[8], bh[8], kh[8], rt[8], kb[8], bb[8];
#pragma unroll
        for (int i = 0; i < 8; ++i) {
            const float kn = kk[i] * rn, bv = kn * eta[i];
            const float ig = fexp_(-lg[i]), gC = fexp_(lC[i] - lg[i]);
            at[i] = -kn * fexp_(lp[i]); bh[i] = bv * ig; kh[i] = kp[i] * ig; rt[i] = r8[i] * fexp_(lg[i]); kb[i] = kp[i] * gC; bb[i] = bv * gC;
        }
        if (et == 63) { f32x4 g0 = {fexp_(lC[0]), fexp_(lC[1]), fexp_(lC[2]), fexp_(lC[3])}, g1 = {fexp_(lC[4]), fexp_(lC[5]), fexp_(lC[6]), fexp_(lC[7])};
            *(f32x4*)(ra.RG + (size_t)unit * 64 + ec) = g0; *(f32x4*)(ra.RG + (size_t)unit * 64 + ec + 4) = g1; }
        auto put = [&](int slot, const float* v) { u32x4 w; w.x = pk2(v[0], v[1]); w.y = pk2(v[2], v[3]); w.z = pk2(v[4], v[5]); w.w = pk2(v[6], v[7]); *(LAS u32x4*)(L + slot + et * IP + ec * 2) = w; };
        put(S_AT, at); put(S_BH, bh); put(S_KH, kh); put(S_RT, rt); put(S_KB, kb); put(S_BB, bb);
    }
    BAR();
    RST(52, 53);
    if (has_next) r1_load(a, raw, tid, nb, nh, nck);
    {
        const LAS unsigned char* Aimg = L + (grp ? S_RT : S_AT);
        f32x16 c1 = zero16(), c2 = zero16();
        if (!(tr == 0 && tc == 1)) {
#pragma unroll
            for (int s = 0; s < 4; ++s) { const bf16x8 af = rowfrag(Aimg, 32 * tr, 16 * s, r32, hi);
                c1 = MFMA32(af, rowfrag(L + S_BH, 32 * tc, 16 * s, r32, hi), c1); c2 = MFMA32(af, rowfrag(L + S_KH, 32 * tc, 16 * s, r32, hi), c2); }
        }
        const int ci = 32 * tc + r32;
#pragma unroll
        for (int i = 0; i < 16; ++i) { const int t = 32 * tr + (i & 3) + 8 * (i >> 2) + 4 * hi; const bool keep = grp ? (ci <= t) : (ci < t); if (!keep) { c1[i] = 0.f; c2[i] = 0.f; } }
        if (grp == 0) {
#pragma unroll
            for (int i = 0; i < 16; ++i) fAAB[(32 * tr + (i & 3) + 8 * (i >> 2) + 4 * hi) * 64 + ci] = c1[i];
            store_T(L + S_AAK, c2, 32 * tr, 32 * tc, r32, hi);
        } else { store_T(L + S_ARB, c1, 32 * tr, 32 * tc, r32, hi); store_T(L + S_ARK, c2, 32 * tr, 32 * tc, r32, hi); }
    }
    BAR();
    RST(53, 54);
    f32x16 nacc = zero16(), yacc = zero16();
    if (grp == 0) {
        const int bk = wave;
        float d[16];
        if (lane < 16) {
#pragma unroll
            for (int t = 0; t < 16; ++t) { float s = (t == lane) ? 1.f : 0.f;
#pragma unroll
                for (int i = 0; i < 16; ++i) if (i < t) s += fAAB[(16 * bk + t) * 64 + 16 * bk + i] * d[i];
                d[t] = s; }
        }
        if (lane < 16) {
            LAS unsigned char* rowp = L + S_TT + (16 * bk + lane) * IP;
#pragma unroll
            for (int cb = 0; cb < 4; ++cb) { u32x4 w0, w1;
                if (cb == bk) { w0.x = pk2(d[0], d[1]); w0.y = pk2(d[2], d[3]); w0.z = pk2(d[4], d[5]); w0.w = pk2(d[6], d[7]); w1.x = pk2(d[8], d[9]); w1.y = pk2(d[10], d[11]); w1.z = pk2(d[12], d[13]); w1.w = pk2(d[14], d[15]); }
                else { w0 = zero_u32x4(); w1 = w0; }
                *(LAS u32x4*)(rowp + cb * 32) = w0; *(LAS u32x4*)(rowp + cb * 32 + 16) = w1; }
        }
    } else {
        f32x16 c = zero16();
#pragma unroll
        for (int s = 0; s < 4; ++s) c = MFMA32(colfrag(L + S_AAK, 32 * tr, 16 * s, lane), colfrag(L + S_V, 32 * tc, 16 * s, lane), c);
        store_T(L + S_W1, c, 32 * tr, 32 * tc, r32, hi);
    }
    BAR();
    if (grp == 0) {
        if (wave < 2) { const int p = 2 * wave;
            f32x16 x = MFMA32(rowfrag_f32(fAAB, 16 * (p + 1), 16 * p, r32, hi), rowfrag(L + S_TT, 16 * p, 16 * p, r32, hi), zero16());
            u32x4 xw; xw.x = pk2(x[0], x[1]); xw.y = pk2(x[2], x[3]); xw.z = pk2(x[4], x[5]); xw.w = pk2(x[6], x[7]);
            const f32x16 tb = MFMA32(colfrag_perm(L + S_TT, 16 * (p + 1), 16 * (p + 1), lane), __builtin_bit_cast(bf16x8, xw), zero16());
            if (r32 < 16) {
#pragma unroll
                for (int g = 0; g < 2; ++g) { u32x2 w; w.x = pk2(tb[4 * g], tb[4 * g + 1]); w.y = pk2(tb[4 * g + 2], tb[4 * g + 3]); *(LAS u32x2*)(L + S_TT + (16 * p + r32) * IP + (16 * (p + 1) + 8 * g + 4 * hi) * 2) = w; } }
        }
    } else {
#pragma unroll
        for (int s = 0; s < 4; ++s) { const bf16x8 vf = colfrag(L + S_V, 32 * tr, 16 * s, lane);
            nacc = MFMA32(colfrag(L + S_KB, 32 * tr, 16 * s, lane), colfrag(L + S_V, 32 * tc, 16 * s, lane), nacc);
            yacc = MFMA32(vf, colfrag(L + S_ARK, 32 * tc, 16 * s, lane), yacc); }
    }
    BAR();
    if (wave == 0) {
        f32x16 x = zero16();
#pragma unroll
        for (int s = 0; s < 2; ++s) x = MFMA32(rowfrag_f32(fAAB, 32, 16 * s, r32, hi), rowfrag(L + S_TT, 0, 16 * s, r32, hi), x);
        f32x16 tb = zero16();
#pragma unroll
        for (int s = 0; s < 2; ++s) { u32x4 xw; xw.x = pk2(x[8 * s], x[8 * s + 1]); xw.y = pk2(x[8 * s + 2], x[8 * s + 3]); xw.z = pk2(x[8 * s + 4], x[8 * s + 5]); xw.w = pk2(x[8 * s + 6], x[8 * s + 7]);
            tb = MFMA32(colfrag_perm(L + S_TT, 32, 32 + 16 * s, lane), __builtin_bit_cast(bf16x8, xw), tb); }
        store_T(L + S_TT, tb, 32, 0, r32, hi);
    }
    BAR();
    RST(54, 55);
    {
        f32x16 c = zero16();
#pragma unroll
        for (int s = 0; s < 4; ++s) { const bf16x8 tf = colfrag(L + S_TT, 32 * tr, 16 * s, lane);
            c = MFMA32(tf, grp ? rowfrag(L + S_W1, 32 * tc, 16 * s, r32, hi) : colfrag(L + S_AT, 32 * tc, 16 * s, lane), c); }
        store_T(L + (grp ? S_UV : S_AH), c, 32 * tr, 32 * tc, r32, hi);
    }
    BAR();
    RST(55, 56);
    {
        const LAS unsigned char* Aimg = L + (grp ? S_UV : S_AH);
        f32x16 c1 = grp ? nacc : zero16(), c2 = grp ? yacc : zero16();
#pragma unroll
        for (int s = 0; s < 4; ++s) { const bf16x8 af = rowfrag(Aimg, 32 * tr, 16 * s, r32, hi);
            if (grp) c1 = MFMA32(colfrag(L + S_BB, 32 * tr, 16 * s, lane), rowfrag(L + S_UV, 32 * tc, 16 * s, r32, hi), c1);
            else c1 = MFMA32(af, colfrag(L + S_BB, 32 * tc, 16 * s, lane), c1);
            c2 = MFMA32(af, colfrag(L + S_ARB, 32 * tc, 16 * s, lane), c2); }
        GAS bf16_t* gq = (GAS bf16_t*)ra.RQ + (size_t)unit * 4096; GAS bf16_t* gm = (GAS bf16_t*)ra.RM + (size_t)unit * 4096; GAS bf16_t* gn = (GAS bf16_t*)ra.RN + (size_t)unit * 4096;
        if (grp == 0) {
            store_T_global(gm, c1, 32 * tr, 32 * tc, r32, hi);
#pragma unroll
            for (int g = 0; g < 4; ++g) { const u32x2 w = *(const LAS u32x2*)(L + S_RT + (32 * tc + r32) * IP + (32 * tr + 8 * g + 4 * hi) * 2);
                c2[4 * g] += bflo(w.x); c2[4 * g + 1] += bfhi(w.x); c2[4 * g + 2] += bflo(w.y); c2[4 * g + 3] += bfhi(w.y); }
            store_T_global(gq, c2, 32 * tr, 32 * tc, r32, hi);
        } else {
            store_T_global(gn, c1, 32 * tr, 32 * tc, r32, hi);
            GAS bf16_t* yp = (GAS bf16_t*)a.Y + (row0 + 32 * tc + r32) * DM + h * 64 + 32 * tr;
#pragma unroll
            for (int g = 0; g < 4; ++g) { u32x2 w; w.x = pk2(c2[4 * g], c2[4 * g + 1]); w.y = pk2(c2[4 * g + 2], c2[4 * g + 3]); *(GAS u32x2*)(yp + 8 * g + 4 * hi) = w; }
        }
    }
    BAR();
    RST(56, -1);
}

constexpr int R2_D = 6, R2_SLOT = 16640, R2_RING = 2 * IMG;
__device__ __forceinline__ void rwkv_scan_chain(const RArgs& ra, unsigned char* ldsb, int b, int h) {
    const int tid = opaque_tid(), lane = tid & 63, wave = __builtin_amdgcn_readfirstlane(tid >> 6), r32 = lane & 31, hi = lane >> 5;
    LAS unsigned char* L = (LAS unsigned char*)ldsb;
    const int q = wave & 3, tr = q >> 1, tc = q & 1;
    f32x16 st = zero16();
    for (int i = tid; i < 2 * IMG / 16; i += 512) { *(LAS u32x4*)(L + i * 16) = zero_u32x4(); }
    const int ubase = (b * 6 + h) * 32;
    auto issue = [&](int step) {
        const int unit = ubase + step; LAS unsigned char* slot = L + R2_RING + (step % R2_D) * R2_SLOT; const int lw = wave - 4;
        const GAS unsigned char* gm = (const GAS unsigned char*)ra.RM + (size_t)unit * 8192 + lane * 16; const GAS unsigned char* gn = (const GAS unsigned char*)ra.RN + (size_t)unit * 8192 + lane * 16;
#pragma unroll
        for (int p = 0; p < 2; ++p) {
            __builtin_amdgcn_global_load_lds((const GAS unsigned*)(gm + (2 * lw + p) * 1024), (LAS unsigned*)(slot + (2 * lw + p) * 1024), 16, 0, 0);
            __builtin_amdgcn_global_load_lds((const GAS unsigned*)(gn + (2 * lw + p) * 1024), (LAS unsigned*)(slot + 8192 + (2 * lw + p) * 1024), 16, 0, 0);
        }
        if (lw == 0) __builtin_amdgcn_global_load_lds((const GAS unsigned*)((const GAS unsigned char*)ra.RG + (size_t)unit * 256 + lane * 4), (LAS unsigned*)(slot + 16384), 4, 0, 0);
    };
    if (wave >= 4) {
#pragma unroll 1
        for (int s0 = 0; s0 < R2_D - 1; ++s0) issue(s0);
        asm volatile("s_waitcnt vmcnt(0)" ::: "memory");
    }
    asm volatile("s_waitcnt lgkmcnt(0)" ::: "memory"); __builtin_amdgcn_s_barrier();
#pragma unroll 1
    for (int ck = 0; ck < 32; ++ck) {
        const LAS unsigned char* Simg = L + (ck & 1) * IMG; LAS unsigned char* Snew = L + ((ck + 1) & 1) * IMG;
        if (wave < 4) {
            const int unit = ubase + ck; const LAS unsigned char* slot = L + R2_RING + (ck % R2_D) * R2_SLOT;
            f32x16 acc;
#pragma unroll
            for (int g = 0; g < 4; ++g) { const u32x2 nw = *(const LAS u32x2*)(slot + 8192 + (32 * tc + r32) * 128 + (32 * tr + 8 * g + 4 * hi) * 2); const f32x4 gc = *(const LAS f32x4*)(slot + 16384 + (32 * tr + 8 * g + 4 * hi) * 4);
                acc[4 * g] = st[4 * g] * gc[0] + bflo(nw.x); acc[4 * g + 1] = st[4 * g + 1] * gc[1] + bfhi(nw.x); acc[4 * g + 2] = st[4 * g + 2] * gc[2] + bflo(nw.y); acc[4 * g + 3] = st[4 * g + 3] * gc[3] + bfhi(nw.y); }
#pragma unroll
            for (int s = 0; s < 4; ++s) acc = MFMA32(*(const LAS bf16x8*)(slot + (32 * tr + r32) * 128 + (16 * s + 8 * hi) * 2), rowfrag(Simg, 32 * tc, 16 * s, r32, hi), acc);
            store_T_global((GAS bf16_t*)ra.RM + (size_t)unit * 4096, st, 32 * tr, 32 * tc, r32, hi);
            st = acc;
            store_T(Snew, st, 32 * tr, 32 * tc, r32, hi);
            asm volatile("s_waitcnt lgkmcnt(0)" ::: "memory");
        } else {
            if (ck + R2_D - 1 < 32) { issue(ck + R2_D - 1);
                if (wave == 4) asm volatile("s_waitcnt vmcnt(20)" ::: "memory"); else asm volatile("s_waitcnt vmcnt(16)" ::: "memory"); }
            else asm volatile("s_waitcnt vmcnt(0)" ::: "memory");
        }
        __builtin_amdgcn_s_barrier();
    }
    asm volatile("s_waitcnt vmcnt(0) lgkmcnt(0)" ::: "memory"); __syncthreads();
}
constexpr int RP = 136, RTILE = 64 * RP, R3_TEAM_LDS = 3 * RTILE;
__device__ __forceinline__ void rwkv_out_unit(const MixArgs& a, const RArgs& ra, unsigned char* ldsb, int b, int h, int ck) {
    const int tid = opaque_tid(), lane = tid & 63, wave = __builtin_amdgcn_readfirstlane(tid >> 6), r32 = lane & 31, hi = lane >> 5;
    const int tw = wave & 1, tt = tid & 127;
    LAS unsigned char* TL = (LAS unsigned char*)ldsb + (wave >> 1) * R3_TEAM_LDS;
    LAS unsigned char* VM = TL, *SG = TL + RTILE, *YC = TL + 2 * RTILE;
    const int unit = (b * 6 + h) * 32 + ck;
    const size_t row0 = (size_t)b * SEQ + ck * 64;
#pragma unroll
    for (int j = 0; j < 4; ++j) {
        const int c = tt + 128 * j, t = c >> 3, c8 = (c & 7) * 8, hc = h * 64 + c8;
        const GAS bf16_t* zr = (const GAS bf16_t*)a.Z + (row0 + t) * ZP; const bool hp = (ck * 64 + t) > 0;
        const u32x4 vc = *(const GAS u32x4*)(zr + ZA_V + hc), gcw = *(const GAS u32x4*)(zr + ZA_G + hc);
        u32x4 vp = zero_u32x4(), gp = vp; if (hp) { vp = *(const GAS u32x4*)(zr - ZP + ZA_V + hc); gp = *(const GAS u32x4*)(zr - ZP + ZA_G + hc); }
        const u32x4 yc = *(const GAS u32x4*)((const GAS bf16_t*)a.Y + (row0 + t) * DM + hc);
        const f32x4 mv0 = *(const f32x4*)(ra.mu + ZA_V + hc), mv1 = *(const f32x4*)(ra.mu + ZA_V + hc + 4), mg0 = *(const f32x4*)(ra.mu + ZA_G + hc), mg1 = *(const f32x4*)(ra.mu + ZA_G + hc + 4);
        const float vcur[8] = {bflo(vc.x), bfhi(vc.x), bflo(vc.y), bfhi(vc.y), bflo(vc.z), bfhi(vc.z), bflo(vc.w), bfhi(vc.w)}, vprv[8] = {bflo(vp.x), bfhi(vp.x), bflo(vp.y), bfhi(vp.y), bflo(vp.z), bfhi(vp.z), bflo(vp.w), bfhi(vp.w)};
        const float gcur[8] = {bflo(gcw.x), bfhi(gcw.x), bflo(gcw.y), bfhi(gcw.y), bflo(gcw.z), bfhi(gcw.z), bflo(gcw.w), bfhi(gcw.w)}, gprv[8] = {bflo(gp.x), bfhi(gp.x), bflo(gp.y), bfhi(gp.y), bflo(gp.z), bfhi(gp.z), bflo(gp.w), bfhi(gp.w)};
        const float muv[8] = {mv0[0], mv0[1], mv0[2], mv0[3], mv1[0], mv1[1], mv1[2], mv1[3]}, mug[8] = {mg0[0], mg0[1], mg0[2], mg0[3], mg1[0], mg1[1], mg1[2], mg1[3]};
        float vm[8], sg[8];
#pragma unroll
        for (int i = 0; i < 8; ++i) { vm[i] = vcur[i] + (vprv[i] - vcur[i]) * muv[i]; const float gg = gcur[i] + (gprv[i] - gcur[i]) * mug[i]; sg[i] = gg * sigmoidf_(gg); }
        u32x4 w; w.x = pk2(vm[0], vm[1]); w.y = pk2(vm[2], vm[3]); w.z = pk2(vm[4], vm[5]); w.w = pk2(vm[6], vm[7]);
        *(LAS u32x2*)(VM + t * RP + c8 * 2) = (u32x2){w.x, w.y}; *(LAS u32x2*)(VM + t * RP + c8 * 2 + 8) = (u32x2){w.z, w.w};
        w.x = pk2(sg[0], sg[1]); w.y = pk2(sg[2], sg[3]); w.z = pk2(sg[4], sg[5]); w.w = pk2(sg[6], sg[7]);
        *(LAS u32x2*)(SG + t * RP + c8 * 2) = (u32x2){w.x, w.y}; *(LAS u32x2*)(SG + t * RP + c8 * 2 + 8) = (u32x2){w.z, w.w};
        *(LAS u32x2*)(YC + t * RP + c8 * 2) = (u32x2){yc.x, yc.y}; *(LAS u32x2*)(YC + t * RP + c8 * 2 + 8) = (u32x2){yc.z, yc.w};
    }
    const GAS bf16_t* gq = (const GAS bf16_t*)ra.RQ + (size_t)unit * 4096 + (32 * tw + r32) * 64 + 8 * hi;
    const GAS bf16_t* gs = (const GAS bf16_t*)ra.RM + (size_t)unit * 4096 + r32 * 64 + 8 * hi;
    bf16x8 bq[4], a0[4], a1[4];
#pragma unroll
    for (int s = 0; s < 4; ++s) { bq[s] = *(const GAS bf16x8*)(gq + 16 * s); a0[s] = *(const GAS bf16x8*)(gs + 16 * s); a1[s] = *(const GAS bf16x8*)(gs + 32 * 64 + 16 * s); }
    const float beta = ra.RB[(row0 + 32 * tw + r32) * 8 + h];
    BAR();
    const int tl = 32 * tw + r32;
    f32x16 y0, y1;
#pragma unroll
    for (int g = 0; g < 4; ++g) { const u32x2 w0 = *(const LAS u32x2*)(YC + tl * RP + (8 * g + 4 * hi) * 2), w1 = *(const LAS u32x2*)(YC + tl * RP + (32 + 8 * g + 4 * hi) * 2);
        y0[4 * g] = bflo(w0.x); y0[4 * g + 1] = bfhi(w0.x); y0[4 * g + 2] = bflo(w0.y); y0[4 * g + 3] = bfhi(w0.y);
        y1[4 * g] = bflo(w1.x); y1[4 * g + 1] = bfhi(w1.x); y1[4 * g + 2] = bflo(w1.y); y1[4 * g + 3] = bfhi(w1.y); }
#pragma unroll
    for (int s = 0; s < 4; ++s) { y0 = MFMA32(a0[s], bq[s], y0); y1 = MFMA32(a1[s], bq[s], y1); }
    float sm = 0.f;
#pragma unroll
    for (int i = 0; i < 16; ++i) sm += y0[i] + y1[i];
    sm += __shfl_xor(sm, 32); const float mean = sm * (1.f / 64.f);
    float sq = 0.f;
#pragma unroll
    for (int i = 0; i < 16; ++i) { const float d0 = y0[i] - mean, d1 = y1[i] - mean; sq += d0 * d0 + d1 * d1; }
    sq += __shfl_xor(sq, 32); const float rstd = __builtin_amdgcn_rsqf(sq * (1.f / 64.f) + GN_EPS);
#pragma unroll
    for (int half = 0; half < 2; ++half)
#pragma unroll
        for (int g = 0; g < 4; ++g) {
            const int v0 = 32 * half + 8 * g + 4 * hi, hc = h * 64 + v0;
            const u32x2 vw = *(const LAS u32x2*)(VM + tl * RP + v0 * 2), sw = *(const LAS u32x2*)(SG + tl * RP + v0 * 2);
            const f32x4 lg4 = *(const f32x4*)(ra.ln_g + hc), lb4 = *(const f32x4*)(ra.ln_b + hc);
            const float vv[4] = {bflo(vw.x), bfhi(vw.x), bflo(vw.y), bfhi(vw.y)}, ss[4] = {bflo(sw.x), bfhi(sw.x), bflo(sw.y), bfhi(sw.y)};
            float o[4];
#pragma unroll
            for (int j = 0; j < 4; ++j) { const float yv = half ? y1[4 * g + j] : y0[4 * g + j]; o[j] = ((yv - mean) * rstd * lg4[j] + lb4[j] + beta * vv[j]) * ss[j]; }
            u32x2 w; w.x = pk2(o[0], o[1]); w.y = pk2(o[2], o[3]); *(LAS u32x2*)(YC + tl * RP + v0 * 2) = w;
        }
    BAR();
#pragma unroll
    for (int j = 0; j < 4; ++j) { const int c = tt + 128 * j, t = c >> 3, c8 = (c & 7) * 8;
        const u32x2 lo = *(const LAS u32x2*)(YC + t * RP + c8 * 2), hi2 = *(const LAS u32x2*)(YC + t * RP + c8 * 2 + 8);
        u32x4 w; w.x = lo.x; w.y = lo.y; w.z = hi2.x; w.w = hi2.y; *(GAS u32x4*)((GAS bf16_t*)a.Y + (row0 + t) * DM + h * 64 + c8) = w; }
    BAR();
}
}
constexpr int NWAVES = 8;
constexpr int RING_BYTES = 131072, LDSCTL_OFF = RING_BYTES, LDS_BYTES = 163840;
constexpr int CW_BAR = 4096, CW_Q = 2048;
struct Args { const float* in[19]; float* out; unsigned char* ws; };

__device__ __forceinline__ unsigned long long rd_ptr_u(volatile LAS unsigned long long* p) { const unsigned long long v = *p; const unsigned lo = __builtin_amdgcn_readfirstlane((unsigned)v), hi = __builtin_amdgcn_readfirstlane((unsigned)(v >> 32)); return ((unsigned long long)hi << 32) | lo; }
__global__ void __launch_bounds__(NWAVES * 64, 2) mega_fwd(Args args) {
    extern __shared__ __attribute__((aligned(16))) unsigned char lds[];
    const int tid = threadIdx.x, lane = tid & 63, wave = __builtin_amdgcn_readfirstlane(tid >> 6);
    const int G = gridDim.x, bx = blockIdx.x;
    unsigned char* ws = args.ws;
    volatile LAS unsigned* MISC = (volatile LAS unsigned*)((LAS unsigned char*)lds + LDSCTL_OFF);
    for (int u = tid; u < (LDS_BYTES - LDSCTL_OFF) / 4; u += NWAVES * 64) ((LAS unsigned*)((LAS unsigned char*)lds + LDSCTL_OFF))[u] = 0u;
    __syncthreads();
    (void)xcd_barrier_post((unsigned*)(ws + WS_CTL) + CW_BAR, MISC + 8);
    volatile LAS unsigned long long* PTRS = (volatile LAS unsigned long long*)((LAS unsigned char*)lds + LDSCTL_OFF + 256);
    if (tid < 19) PTRS[tid] = (unsigned long long)(uintptr_t)args.in[tid];
    if (tid == 19) PTRS[19] = (unsigned long long)(uintptr_t)args.out;
    if (tid == 20) PTRS[20] = (unsigned long long)(uintptr_t)args.ws;
    __syncthreads();
#define PTRS_RD(i) rd_ptr_u(({ LAS unsigned long long* p_ = (LAS unsigned long long*)((LAS unsigned char*)lds + LDSCTL_OFF + 256); asm volatile("" : "+v"(p_)); (volatile LAS unsigned long long*)p_ + (i); }))
#define ARGP(i) ((const float*)(uintptr_t)PTRS_RD(i))
#define OUTP ((float*)(uintptr_t)PTRS_RD(19))
#define WSP ((unsigned char*)(uintptr_t)PTRS_RD(20))
#ifdef PROBE_BAR
#define GRID_BAR() do { GRID_BAR1(); GRID_BAR1(); } while (0)
#else
#define GRID_BAR() GRID_BAR1()
#endif
#define GRID_BAR1() do { XcdBarrier b_; b_.bar = (unsigned*)(WSP + WS_CTL) + CW_BAR; b_.x = xb_xcc_id(); b_.st = (volatile LAS unsigned*)((LAS unsigned char*)lds + LDSCTL_OFF) + 8; xcd_barrier(b_); } while (0)
#ifdef PROBE_T
#define TS_LDS ((volatile LAS unsigned long long*)((LAS unsigned char*)lds + LDSCTL_OFF + 1024))
#define STAMP_BEGIN(id) do { if ((id) == PROBE_T && blockIdx.x == 0 && threadIdx.x == 0) TS_LDS[0] = __builtin_amdgcn_s_memrealtime(); } while (0)
#define STAMP_END(id) do { if ((id) == PROBE_T && blockIdx.x == 0 && threadIdx.x == 0) TS_LDS[1] += __builtin_amdgcn_s_memrealtime() - TS_LDS[0]; } while (0)
#else
#define STAMP_BEGIN(id) do {} while (0)
#define STAMP_END(id) do {} while (0)
#endif
#ifdef PROBE_TBUSY
#define STAMP_END_BUSY(id) STAMP_END(id)
#define STAMP_END_WALL(id) do {} while (0)
#else
#define STAMP_END_BUSY(id) do {} while (0)
#define STAMP_END_WALL(id) STAMP_END(id)
#endif
#define PHASE_IDS const int tid = opaque_tid(), lane = tid & 63, wave = __builtin_amdgcn_readfirstlane(tid >> 6), gw = bx * NWAVES + wave, ngw = G * NWAVES; (void)lane; (void)gw; (void)ngw; (void)tid; (void)wave;
    int K1024 = DM, K256 = 256; asm volatile("" : "+s"(K1024), "+s"(K256));
    STAMP_BEGIN(0);
    {
        PHASE_IDS
        const float* x = args.in[0]; bf16_t* bufA = (bf16_t*)(ws + WS_BUFA); float* ssqA = (float*)(ws + WS_SSQA);
        PrepArgs pa; pa.w_in = args.in[3]; pa.norm_g = args.in[2]; pa.w_out = args.in[14]; pa.ple_g = args.in[15]; pa.w_gate = args.in[16]; pa.w_proj = args.in[17]; pa.w_up = args.in[6]; pa.a_up = args.in[8]; pa.ws = ws;
        prep_tables(ws, bx * NWAVES * 64 + tid, G * NWAVES * 64);
        prep_weights(pa, gw, ngw, (LAS float*)((LAS unsigned char*)lds + wave * 16384), lane);
#ifdef PROBE_PRO
        prep_weights(pa, gw, ngw, (LAS float*)((LAS unsigned char*)lds + wave * 16384), lane);
        for (int m = gw; m < MTOK; m += ngw) x_row_to_bf16(x + (size_t)m * DM, bufA + (size_t)m * DM, ssqA + (size_t)m * 16, lane);
#endif
        for (int m = gw; m < MTOK; m += ngw) x_row_to_bf16(x + (size_t)m * DM, bufA + (size_t)m * DM, ssqA + (size_t)m * 16, lane);
    }
    STAMP_END_BUSY(0);
    GRID_BAR();
    STAMP_END_WALL(0);
    STAMP_BEGIN(1);
    for (int L = 0; L < DEPTH; ++L) {
#define PHASE_PTRS unsigned char* ws = WSP; bf16_t* cur = (bf16_t*)(ws + ((L & 1) ? WS_BUFB : WS_BUFA)); bf16_t* oth = (bf16_t*)(ws + ((L & 1) ? WS_BUFA : WS_BUFB)); const unsigned char* wl = ws + WS_W + (size_t)L * W_LAYER; \
        bf16_t* Z = (bf16_t*)(ws + WS_Z); float* PP = (float*)(ws + WS_Z); bf16_t* PB = (bf16_t*)(ws + WS_PB); float* ssqA = (float*)(ws + WS_SSQA); float* ssqB = (float*)(ws + WS_SSQB); float* out = OUTP; \
        (void)cur; (void)oth; (void)wl; (void)Z; (void)PP; (void)PB; (void)ssqA; (void)ssqB; (void)out;
        {
            PHASE_PTRS
            const float* tab16 = (const float*)(ws + WS_TAB16); const float* tabI = (const float*)(ws + WS_TABI);
            pg8::Gemm g{cur, (const bf16_t*)(wl + W_IN), MTOK, NPAD, K1024}; pg8::StaticOrder S; S.init(MTOK, NPAD, G, bx);
            epi::EpiInProj e; e.Z = Z; e.ssq = ssqA; e.tab16 = tab16; e.tabI = tabI; e.KV = (bf16_t*)(ws + WS_MISC + MISC_KV); e.IKC = (bf16_t*)(ws + WS_MISC + MISC_IKC);
#ifdef PROBE_G1
            pg8::gemm_phase<epi::EpiInProj, pg8::StaticOrder, true, true>((PG8_LAS unsigned char*)lds, g, S, e);
#endif
#ifdef PROBE_G1P
            { epi::EpiPlainZ ep; ep.Z = Z; pg8::gemm_phase<epi::EpiPlainZ, pg8::StaticOrder, true, true>((PG8_LAS unsigned char*)lds, g, S, ep); }
#endif
            pg8::gemm_phase<epi::EpiInProj, pg8::StaticOrder, true, true>((PG8_LAS unsigned char*)lds, g, S, e);
        }
        STAMP_END_BUSY(1);
        GRID_BAR();
        STAMP_END_WALL(1);
        STAMP_BEGIN(2);
        {
            PHASE_PTRS
            MixArgs ma; ma.Z = Z; ma.Y = oth; ma.KV = (const bf16_t*)(ws + WS_MISC + MISC_KV); ma.IKC = (const bf16_t*)(ws + WS_MISC + MISC_IKC); ma.mu = ARGP(4) + L * 1664; ma.w0 = ARGP(5) + L * 384; ma.w_up = ARGP(6) + (size_t)L * 64 * 384; ma.a0 = ARGP(7) + L * 384; ma.a_up = ARGP(8) + (size_t)L * 64 * 384;
            ma.k_k = ARGP(9) + L * 384; ma.k_a = ARGP(10) + L * 384; ma.r_k = ARGP(11) + L * 384; ma.ln_g = ARGP(12) + L * 384; ma.ln_b = ARGP(13) + L * 384;
            rwkv::RArgs ra; ra.mu = ma.mu; ra.w0 = ma.w0; ra.a0 = ma.a0; ra.k_k = ma.k_k; ra.k_a = ma.k_a; ra.r_k = ma.r_k; ra.ln_g = ma.ln_g; ra.ln_b = ma.ln_b;
            ra.wupT = (const bf16_t*)(wl + W_WUPT); ra.aupT = (const bf16_t*)(wl + W_AUPT); ra.RQ = cur; ra.RM = cur + (size_t)3072 * 4096; ra.RN = (bf16_t*)(ws + WS_MISC + MISC_RN); ra.RG = (float*)(ws + WS_MISC + MISC_RG); ra.RB = (float*)(ws + WS_MISC + MISC_RB);
#ifdef PROBE_R1
            for (int rep = 0; rep < 2; ++rep)
#endif
            STAMP_BEGIN(20);
            {
              rwkv::R1Raw raw; const int tid1 = opaque_tid(); const int per = (3072 + G - 1) / G, u0 = bx * per, u1 = min(u0 + per, 3072);
              if (u0 < u1) rwkv::r1_load(ma, raw, tid1, u0 / 192, (u0 / 32) % 6, u0 & 31);
              int hprev = -1;
              for (int u = u0; u < u1; ++u) { const int un = u + 1; const int ck = u & 31, hh = (u / 32) % 6;
                  if (hh != hprev) { __syncthreads(); rwkv::r1_load_params(ra, lds, tid1, hh); __syncthreads(); hprev = hh; }
                  rwkv::rwkv_chunk_unit(ma, ra, lds, u / 192, hh, ck, raw, ck == 0 ? 0 : (u == u0 ? 2 : 1), un < u1, un / 192, (un / 32) % 6, un & 31); } }
            STAMP_END(20); STAMP_BEGIN(21);
            { volatile LAS unsigned* qw = (volatile LAS unsigned*)((LAS unsigned char*)lds + LDSCTL_OFF + 1536);
              unsigned* qctr = (unsigned*)(ws + WS_CTL) + CW_Q + L * 8 + (bx & 7);
              for (;;) {
                  if (opaque_tid() == 0) qw[0] = __hip_atomic_fetch_add(qctr, 1u, __ATOMIC_RELAXED, __HIP_MEMORY_SCOPE_AGENT);
                  __syncthreads();
                  const unsigned qi = qw[0];
                  __syncthreads();
                  if (qi >= 64u) break;
                  dsa::dsa_unit(ma, lds, (bx & 7) * 2 + (int)(qi & 1u), 31 - (int)(qi >> 1));
              } }
            __syncthreads();
            STAMP_END(21); STAMP_BEGIN(22);
            float* LQ = (float*)(ws + WS_MISC);
#ifdef PROBE_DIL
            for (int rep = 0; rep < 2; ++rep)
#endif
            for (int u = bx; u < 768; u += G) dil::dil_unit(ma, LQ, lds, u / 48, (u % 48) >> 4, u & 15);
            STAMP_END(22); STAMP_BEGIN(23);
        }
        STAMP_END_BUSY(2);
        GRID_BAR();
        STAMP_END_WALL(2); STAMP_END(23);
        STAMP_BEGIN(3);
        {
            PHASE_PTRS
            MixArgs ma; ma.Z = Z; ma.Y = oth; const float* LQ = (const float*)(ws + WS_MISC); PHASE_IDS
            rwkv::RArgs ra; ra.mu = ARGP(4) + L * 1664; ra.ln_g = ARGP(12) + L * 384; ra.ln_b = ARGP(13) + L * 384;
            ra.RQ = cur; ra.RM = cur + (size_t)3072 * 4096; ra.RN = (bf16_t*)(ws + WS_MISC + MISC_RN); ra.RG = (float*)(ws + WS_MISC + MISC_RG); ra.RB = (float*)(ws + WS_MISC + MISC_RB);
            if (G > 96) {
#ifdef PROBE_R2
                if (bx < 96) rwkv::rwkv_scan_chain<true>(ra, lds, bx / 6, bx % 6);
#endif
                if (bx < 96) { STAMP_BEGIN(40); rwkv::rwkv_scan_chain(ra, lds, bx / 6, bx % 6); STAMP_END(40); }
                else { dil::dil_merge(ma, LQ, (bx - 96) * 512 + tid, (G - 96) * 512);
                    const float* src = ARGP(1) + (size_t)L * MTOK * 256;
                    for (size_t i = (size_t)(bx - 96) * 512 + tid; i < (size_t)MTOK * 256 / 8; i += (size_t)(G - 96) * 512) {
                        const f32x4 a = ((const f32x4*)src)[2 * i], b = ((const f32x4*)src)[2 * i + 1];
                        u32x4 w; w.x = pk2(a.x, a.y); w.y = pk2(a.z, a.w); w.z = pk2(b.x, b.y); w.w = pk2(b.z, b.w); ((u32x4*)PB)[i] = w; } }
            } else {
                for (int u = bx; u < 96; u += G) rwkv::rwkv_scan_chain(ra, lds, u / 6, u % 6);
                dil::dil_merge(ma, LQ, bx * 512 + tid, G * 512);
                { const float* src = ARGP(1) + (size_t)L * MTOK * 256;
                  for (size_t i = (size_t)bx * 512 + tid; i < (size_t)MTOK * 256 / 8; i += (size_t)G * 512) {
                      const f32x4 a = ((const f32x4*)src)[2 * i], b = ((const f32x4*)src)[2 * i + 1];
                      u32x4 w; w.x = pk2(a.x, a.y); w.y = pk2(a.z, a.w); w.z = pk2(b.x, b.y); w.w = pk2(b.z, b.w); ((u32x4*)PB)[i] = w; } }
            }
        }
        STAMP_END_BUSY(3);
        GRID_BAR();
        STAMP_END_WALL(3);
        STAMP_BEGIN(4);
        {
            PHASE_PTRS
            MixArgs ma; ma.Z = Z; ma.Y = oth;
            rwkv::RArgs ra; ra.mu = ARGP(4) + L * 1664; ra.ln_g = ARGP(12) + L * 384; ra.ln_b = ARGP(13) + L * 384;
            ra.RQ = cur; ra.RM = cur + (size_t)3072 * 4096; ra.RB = (float*)(ws + WS_MISC + MISC_RB); PHASE_IDS
            for (int u4 = bx; u4 < 768; u4 += G) { const int u = u4 * 4 + (wave >> 1); rwkv::rwkv_out_unit(ma, ra, lds, u / 192, (u / 32) % 6, u & 31); }
        }
        STAMP_END_BUSY(4);
        GRID_BAR();
        STAMP_END_WALL(4);
        STAMP_BEGIN(5);
        {
            PHASE_PTRS
            const float* x = ARGP(0);
            pg8::Gemm g{oth, (const bf16_t*)(wl + W_OUT), MTOK, DM, K1024}; pg8::StaticOrder S; S.init(MTOK, DM, G, bx);
            epi::EpiOutProj e; e.xin = (L == 0) ? x : out; e.xb = cur; e.ssq_out = ssqB;
            pg8::Gemm g2{PB, (const bf16_t*)(wl + W_PROJ), MTOK, DM, K256};
            epi::EpiBf16Plain e2; e2.C = (bf16_t*)PP;
            if ((bx >> 3) & 1) {
                pg8::gemm_phase<epi::EpiBf16Plain, pg8::StaticOrder, true, true>((PG8_LAS unsigned char*)lds, g2, S, e2);
                pg8::gemm_phase<epi::EpiOutProj, pg8::StaticOrder, true, true>((PG8_LAS unsigned char*)lds, g, S, e);
            } else {
                pg8::gemm_phase<epi::EpiOutProj, pg8::StaticOrder, true, true>((PG8_LAS unsigned char*)lds, g, S, e);
                pg8::gemm_phase<epi::EpiBf16Plain, pg8::StaticOrder, true, true>((PG8_LAS unsigned char*)lds, g2, S, e2);
            }
        }
        STAMP_END_BUSY(5);
        GRID_BAR();
        STAMP_END_WALL(5);
        STAMP_BEGIN(6);
        {
            PHASE_PTRS
            pg8::Gemm g{cur, (const bf16_t*)(wl + W_GATE), MTOK, DM, K1024}; pg8::StaticOrder S; S.init(MTOK, DM, G, bx);
            epi::EpiGate e; e.xout = out; e.x1b = cur; e.pp = (const bf16_t*)PP; e.xb = oth; e.ssq_in = ssqB; e.ssq_out = ssqA;
            pg8::gemm_phase<epi::EpiGate, pg8::StaticOrder, true, true>((PG8_LAS unsigned char*)lds, g, S, e);
        }
        STAMP_END_BUSY(6);
        GRID_BAR();
        STAMP_END_WALL(6);
        STAMP_BEGIN(1); STAMP_BEGIN(7);
    }
    {
        const int L = 0; PHASE_PTRS
        const float* fg = ARGP(18); PHASE_IDS
        for (int m = gw; m < MTOK; m += ngw) { const float rs = row_rstd(ssqA + (size_t)m * 16); f32x4* xr = (f32x4*)(out + (size_t)m * DM) + lane;
#pragma unroll
            for (int j = 0; j < 4; ++j) { const f32x4 gv = ((const f32x4*)fg)[64 * j + lane]; xr[64 * j] = xr[64 * j] * rs * gv; } }
    }
#ifdef PROBE_T
    if (PROBE_T == 7) { __syncthreads(); STAMP_END(7); }
    if (blockIdx.x == 0 && threadIdx.x == 0) { const unsigned long long t0 = __builtin_amdgcn_s_memrealtime(), w = 4ull * TS_LDS[1]; while (__builtin_amdgcn_s_memrealtime() - t0 < w) __builtin_amdgcn_s_sleep(8); }
#endif
}

extern "C" void kernel_launch(void* const* d_in, const int* in_sizes, int n_in, void* d_out, int out_size, void* d_ws, size_t ws_size, hipStream_t stream) {
    static int grid = 0;
    if (grid == 0) {
        if (n_in != 19 || out_size != MTOK * DM || ws_size < WS_END) { fprintf(stderr, "kernel_launch: unexpected shapes n_in %d out %d ws %zu\n", n_in, out_size, ws_size); grid = -1; return; }
        int dev = 0, cus = 0, per_cu = 0;
        if (hipGetDevice(&dev) != hipSuccess || hipDeviceGetAttribute(&cus, hipDeviceAttributeMultiprocessorCount, dev) != hipSuccess) { grid = -1; return; }
        if (hipFuncSetAttribute((const void*)mega_fwd, hipFuncAttributeMaxDynamicSharedMemorySize, LDS_BYTES) != hipSuccess) { fprintf(stderr, "kernel_launch: hipFuncSetAttribute failed\n"); grid = -1; return; }
        if (hipOccupancyMaxActiveBlocksPerMultiprocessor(&per_cu, (const void*)mega_fwd, NWAVES * 64, LDS_BYTES) != hipSuccess || per_cu < 1) { fprintf(stderr, "kernel_launch: occupancy query says %d blocks per CU\n", per_cu); (void)hipGetLastError(); grid = -1; return; }
        grid = cus;
    }
    if (grid < 0) return;
    if (hipMemsetAsync((char*)d_ws + WS_CTL, 0, 1 * MiB, stream) != hipSuccess) return;
    Args a; memset(&a, 0, sizeof a);
    for (int i = 0; i < 19; ++i) a.in[i] = (const float*)d_in[i];
    a.out = (float*)d_out; a.ws = (unsigned char*)d_ws;
    hipLaunchKernelGGL(mega_fwd, dim3(grid), dim3(NWAVES * 64), LDS_BYTES, stream, a);
}
```

```cpp
#include <hip/hip_runtime.h>
#include <cstdio>
#include <cstdint>
#include <cmath>
#include <cstring>

constexpr int BATCH = 16, SEQ = 2048, DM = 1024, DEPTH = 4, MTOK = BATCH * SEQ;
constexpr int ZP = 4136;
constexpr int NPAD = 4352;
constexpr int ZA_R = 0, ZA_K = 384, ZA_V = 768, ZA_G = 1152, ZA_WD = 1536, ZA_AD = 1600;
constexpr int ZB_Q = 1664, ZB_K = 1920, ZB_V = 1984, ZB_IQ = 2048, ZB_IK = 2304, ZB_IW = 2336, ZB_G = 2344;
constexpr int ZC_Q = 2600, ZC_K = 2984, ZC_V = 3368, ZC_G = 3752;
constexpr float LOG2E = 1.4426950408889634f;
constexpr float QSCALE = 0.125f * LOG2E;
constexpr float IQSCALE = 0.17677669529663687f;
constexpr float IWSCALE = 0.35355339059327373f;
constexpr float NORM_EPS = 1e-6f, GN_EPS = 64e-5f;
constexpr float DECAY_SCALE = 0.6065306597126334f;

typedef unsigned short bf16_t;
typedef short bf16x8 __attribute__((ext_vector_type(8)));
typedef float f32x4 __attribute__((ext_vector_type(4)));
typedef float f32x16 __attribute__((ext_vector_type(16)));
typedef unsigned u32x4 __attribute__((ext_vector_type(4)));
typedef unsigned u32x2 __attribute__((ext_vector_type(2)));

__device__ __forceinline__ unsigned f2bf(float f) { unsigned u = __builtin_bit_cast(unsigned, f); return (u + 0x7fffu + ((u >> 16) & 1u)) >> 16; }
typedef float f32x2_t __attribute__((ext_vector_type(2))); typedef __bf16 bf16x2_t __attribute__((ext_vector_type(2)));
__device__ __forceinline__ unsigned pk2(float lo, float hi) { const f32x2_t v = {lo, hi}; return __builtin_bit_cast(unsigned, __builtin_convertvector(v, bf16x2_t)); }
__device__ __forceinline__ float bf2f(unsigned short b) { return __builtin_bit_cast(float, (unsigned)b << 16); }
__device__ __forceinline__ float bflo(unsigned w) { return __builtin_bit_cast(float, w << 16); }
__device__ __forceinline__ float bfhi(unsigned w) { return __builtin_bit_cast(float, w & 0xffff0000u); }
__device__ __forceinline__ float sigmoidf_(float x) { return __builtin_amdgcn_rcpf(1.0f + __builtin_amdgcn_exp2f(-1.4426950408889634f * x)); }
__device__ __forceinline__ float fexp_(float x) { return __builtin_amdgcn_exp2f(1.4426950408889634f * x); }
__device__ __forceinline__ float tanhf_(float x) { const float e = __builtin_amdgcn_exp2f(fminf(2.8853900817779268f * x, 60.f)); return 1.0f - 2.0f * __builtin_amdgcn_rcpf(e + 1.0f); }
__device__ __forceinline__ int opaque_tid() { int t = threadIdx.x; asm volatile("" : "+v"(t)); return t; }
__device__ __forceinline__ u32x4 zero_u32x4() { unsigned z = 0u; asm volatile("" : "+v"(z)); u32x4 r; r.x = z; r.y = z; r.z = z; r.w = z; return r; }
__device__ __forceinline__ float wave_sum(float v) {
#pragma unroll
    for (int o = 1; o < 64; o <<= 1) v += __shfl_xor(v, o);
    return v;
}
__device__ __forceinline__ float wave_max(float v) {
#pragma unroll
    for (int o = 1; o < 64; o <<= 1) v = fmaxf(v, __shfl_xor(v, o));
    return v;
}

constexpr size_t MiB = 1u << 20;
constexpr size_t WS_CTL = 0;
constexpr size_t WS_TAB16 = 1 * MiB;
constexpr size_t WS_TABI = WS_TAB16 + 128 * 1024;
constexpr size_t WS_SSQA = WS_TABI + 64 * 1024;
constexpr size_t WS_SSQB = WS_SSQA + 2 * MiB;
constexpr size_t WS_W = 6 * MiB;
constexpr size_t W_LAYER = 14 * MiB, W_IN = 0, W_OUT = 8912896, W_GATE = W_OUT + 2 * MiB, W_PROJ = W_GATE + 2 * MiB, W_WUPT = W_PROJ + 512 * 1024, W_AUPT = W_WUPT + 48 * 1024;
constexpr size_t WS_BUFA = 62 * MiB;
constexpr size_t WS_BUFB = 126 * MiB;
constexpr size_t WS_PB = 190 * MiB;
constexpr size_t WS_Z = 206 * MiB;
constexpr size_t WS_Z_END = WS_Z + (size_t)MTOK * ZP * 2;
constexpr size_t WS_MISC = 465 * MiB;
constexpr size_t WS_END = 512 * MiB;
constexpr size_t MISC_LQ = 0, MISC_RG = 1 * MiB, MISC_RN = 2 * MiB, MISC_RB = 26 * MiB, MISC_KV = 27 * MiB, MISC_IKC = 35 * MiB;
static_assert(W_AUPT + 48 * 1024 <= W_LAYER && WS_W + 4 * W_LAYER <= WS_BUFA && WS_Z_END <= WS_MISC, "ws map");
namespace pg8 {
#define PG8_LAS __attribute__((address_space(3)))
typedef unsigned short bf16_t;
typedef short bf16x8 __attribute__((ext_vector_type(8)));
typedef float f32x4 __attribute__((ext_vector_type(4)));
typedef unsigned u32x4 __attribute__((ext_vector_type(4)));
constexpr int BM = 256, BK = 64, HALF = 128, HTB = HALF * BK * 2  , STAGE_BYTES = 8 * HTB, NXCD = 8, WGM = 8;

__host__ __device__ __forceinline__ int lds_byte(int r, int c) { const int st = (r >> 4) * 2 + (c >> 5), rr = r & 15, cc = c & 31, ob = rr * 64 + cc * 2; return st * 1024 + (ob ^ (((ob >> 9) & 1) << 5)); }
__host__ __device__ __forceinline__ void stage_rc(int b, int& R, int& C) { const int st = b / 1024, sb = b % 1024, swz = sb ^ (((sb >> 9) & 1) << 5); R = (st >> 1) * 16 + swz / 64; C = (st & 1) * 32 + (swz % 64) / 2; }
__host__ __device__ __forceinline__ int perm32(int rho) { const int n = rho >> 4, i = rho & 15; return 8 * (i >> 2) + 4 * n + (i & 3); }

struct Unit { int pm, pn; };
struct Gemm { const bf16_t* A; const bf16_t* Bt; int M, N, K; };

struct StaticOrder {
    int nM, nN, nwg, G, c;
    __host__ __device__ void init(int M, int N, int G_, int c_) { nM = M / BM; nN = N / BM; nwg = nM * nN; G = G_; c = c_; }
    __host__ __device__ bool next(int i, Unit& u) const {
        const long L = (long)i * G + c; if (L >= nwg) return false;
        int wgid = (int)L; { const int q = nwg / NXCD, r = nwg % NXCD, xcd = wgid % NXCD, off = wgid / NXCD; wgid = (xcd < r ? xcd * (q + 1) : r * (q + 1) + (xcd - r) * q) + off; }
        const int nig = WGM * nN, gid = wgid / nig, fm = gid * WGM, gsz = (nM - fm) < WGM ? (nM - fm) : WGM;
        u.pm = fm + ((wgid % nig) % gsz); u.pn = (wgid % nig) / gsz; return true;
    }
    __device__ __forceinline__ void a_ready(const Unit&) const {}
    __device__ __forceinline__ void done(const Unit&) const {}
};

__device__ __forceinline__ unsigned cvt_pk_bf16(float lo, float hi) { unsigned r; asm volatile("v_cvt_pk_bf16_f32 %0, %1, %2" : "=v"(r) : "v"(lo), "v"(hi)); return r; }
template <class Epi, class Sched, bool ALIGN_EPI = false, bool SP2 = false>
__device__ __forceinline__ void gemm_phase(PG8_LAS unsigned char* lds, const Gemm g, const Sched& S, const Epi& E) {
    int tid_ = threadIdx.x; asm volatile("" : "+v"(tid_));
    const int tid = tid_, wid = __builtin_amdgcn_readfirstlane(tid >> 6), lane = tid & 63, wr = wid >> 2, wc = wid & 3, fr = lane & 15, fq = lane >> 4;
    const int K = g.K, nt = K / BK;
    unsigned voffA[2], voffB[2];
#pragma unroll
    for (int i = 0; i < 2; ++i) { int R, C; stage_rc(tid * 16 + i * 8192, R, C); const int Rb = Epi::PERM ? ((R & ~31) + perm32(R & 31)) : R;
        voffA[i] = (unsigned)(R * K + C) * 2u; voffB[i] = (unsigned)(Rb * K + C) * 2u; }
    const size_t kstep = (size_t)(BK * 2);
    const size_t hstep = (size_t)HALF * K * 2;
    const size_t tstep = 2 * hstep;
    const unsigned ldsw = (unsigned)wid * 1024u;
    const int aoff = lds_byte(wr * 64 + fr, fq * 8), boff = lds_byte(wc * 32 + fr, fq * 8);
#define PG8_SA(b, h) (((b) * 2 + (h)) * HTB)
#define PG8_SB(b, h) ((4 + (b) * 2 + (h)) * HTB)
#define PG8_STAGE(bufoff, gbase, voff) do { _Pragma("unroll") for (int _i = 0; _i < 2; ++_i) \
        __builtin_amdgcn_global_load_lds((const unsigned*)((const char*)(gbase) + (voff)[_i]), (PG8_LAS unsigned*)(lds + (bufoff) + ldsw + _i * 8192), 16, 0, 0); } while (0)
#define PG8_LDA(dst, b, h) do { _Pragma("unroll") for (int m = 0; m < 4; ++m) _Pragma("unroll") for (int k = 0; k < 2; ++k) dst[m][k] = *(const PG8_LAS bf16x8*)(lds + PG8_SA(b, h) + aoff + m * 2048 + k * 1024); } while (0)
#define PG8_LDB(dst, b, h) do { _Pragma("unroll") for (int n = 0; n < 2; ++n) _Pragma("unroll") for (int k = 0; k < 2; ++k) dst[n][k] = *(const PG8_LAS bf16x8*)(lds + PG8_SB(b, h) + boff + n * 2048 + k * 1024); } while (0)
#define PG8_MMA(ai, bj, At, Bt) do { __builtin_amdgcn_s_setprio(1); _Pragma("unroll") for (int m = 0; m < 4; ++m) _Pragma("unroll") for (int n = 0; n < 2; ++n) _Pragma("unroll") for (int k = 0; k < 2; ++k) \
        acc[ai][bj][m][n] = __builtin_amdgcn_mfma_f32_16x16x32_bf16(Bt[n][k], At[m][k], acc[ai][bj][m][n], 0, 0, 0); __builtin_amdgcn_s_setprio(0); } while (0)
#define PG8_WAIT_V(n) asm volatile("s_waitcnt vmcnt(" #n ")" ::: "memory")
#define PG8_WAIT_L(n) asm volatile("s_waitcnt lgkmcnt(" #n ")" ::: "memory")
#define PG8_BAR __builtin_amdgcn_s_barrier()
#define PG8_SCHED __builtin_amdgcn_sched_barrier(0)
    Unit cur, nxt; int ui = 0;
    if (!S.next(0, cur)) return;
    f32x4 acc[2][2][4][2];
#pragma unroll
    for (int a = 0; a < 2; ++a)
#pragma unroll
        for (int b = 0; b < 2; ++b)
#pragma unroll
            for (int m = 0; m < 4; ++m)
#pragma unroll
                for (int n = 0; n < 2; ++n) acc[a][b][m][n] = (f32x4){0.f, 0.f, 0.f, 0.f};
    bf16x8 At[4][2], B0[2][2], B1[2][2];
    const char* cA = (const char*)g.A + (size_t)cur.pm * tstep; const char* cB = (const char*)g.Bt + (size_t)cur.pn * tstep;
    S.a_ready(cur);
    if constexpr (SP2) {
        PG8_STAGE(PG8_SB(0, 0), cB, voffB); PG8_STAGE(PG8_SB(0, 1), cB + hstep, voffB); PG8_STAGE(PG8_SA(0, 0), cA, voffA); PG8_STAGE(PG8_SA(0, 1), cA + hstep, voffA);
        if (wr == 1) PG8_BAR;
        PG8_WAIT_V(2); PG8_BAR;
        PG8_STAGE(PG8_SB(1, 0), cB + kstep, voffB); PG8_STAGE(PG8_SA(1, 0), cA + kstep, voffA); PG8_STAGE(PG8_SB(1, 1), cB + hstep + kstep, voffB);
        PG8_WAIT_V(6); PG8_BAR;
    } else {
        PG8_STAGE(PG8_SB(0, 0), cB, voffB); PG8_STAGE(PG8_SA(0, 0), cA, voffA); PG8_STAGE(PG8_SB(0, 1), cB + hstep, voffB); PG8_STAGE(PG8_SA(0, 1), cA + hstep, voffA);
        if (wr == 1) PG8_BAR;
        PG8_WAIT_V(4); PG8_BAR;
        PG8_STAGE(PG8_SB(1, 0), cB + kstep, voffB); PG8_STAGE(PG8_SA(1, 0), cA + kstep, voffA); PG8_STAGE(PG8_SB(1, 1), cB + hstep + kstep, voffB);
        PG8_WAIT_V(6); PG8_BAR;
    }
    for (;;) {
        const bool has_next = S.next(ui + 1, nxt);
        const char* nA = has_next ? (const char*)g.A + (size_t)nxt.pm * tstep : cA; const char* nB = has_next ? (const char*)g.Bt + (size_t)nxt.pn * tstep : cB;
        for (int t = 0; t < nt; t += 2) {
            const bool last = (t == nt - 2);
            const char* a1 = cA + (size_t)(t + 1) * kstep;
            const char* a2 = last ? nA : cA + (size_t)(t + 2) * kstep; const char* b2 = last ? nB : cB + (size_t)(t + 2) * kstep;
            const char* a3 = a2 + kstep; const char* b3 = b2 + kstep;
            if (last && has_next) S.a_ready(nxt);
            if constexpr (SP2) {
            PG8_LDB(B0, 0, 0); PG8_LDB(B1, 0, 1); PG8_SCHED; PG8_LDA(At, 0, 0); PG8_STAGE(PG8_SA(1, 1), a1 + hstep, voffA);
            PG8_WAIT_V(8); PG8_WAIT_L(0); PG8_BAR; PG8_MMA(0, 0, At, B0); PG8_MMA(0, 1, At, B1); PG8_BAR; PG8_SCHED;
            PG8_LDA(At, 0, 1); PG8_STAGE(PG8_SB(0, 0), b2, voffB); PG8_STAGE(PG8_SB(0, 1), b2 + hstep, voffB); PG8_STAGE(PG8_SA(0, 0), a2, voffA);
            PG8_WAIT_V(8); PG8_WAIT_L(0); PG8_BAR; PG8_MMA(1, 0, At, B0); PG8_MMA(1, 1, At, B1); PG8_BAR; PG8_SCHED;
            PG8_LDB(B0, 1, 0); PG8_LDB(B1, 1, 1); PG8_SCHED; PG8_LDA(At, 1, 0); PG8_STAGE(PG8_SA(0, 1), a2 + hstep, voffA);
            PG8_WAIT_V(8); PG8_WAIT_L(0); PG8_BAR; PG8_MMA(0, 0, At, B0); PG8_MMA(0, 1, At, B1); PG8_BAR; PG8_SCHED;
            PG8_LDA(At, 1, 1); PG8_STAGE(PG8_SB(1, 0), b3, voffB); PG8_STAGE(PG8_SB(1, 1), b3 + hstep, voffB); PG8_STAGE(PG8_SA(1, 0), a3, voffA);
            PG8_WAIT_V(8); PG8_WAIT_L(0); PG8_BAR; PG8_MMA(1, 0, At, B0); PG8_MMA(1, 1, At, B1); PG8_BAR; PG8_SCHED;
            } else {
            PG8_LDB(B0, 0, 0); PG8_SCHED; PG8_LDA(At, 0, 0); PG8_STAGE(PG8_SA(1, 1), a1 + hstep, voffA);
            PG8_WAIT_L(8); PG8_BAR; PG8_WAIT_L(0); PG8_MMA(0, 0, At, B0); PG8_BAR; PG8_SCHED;
            PG8_LDB(B1, 0, 1); PG8_STAGE(PG8_SB(0, 0), b2, voffB);
            PG8_BAR; PG8_WAIT_L(0); PG8_MMA(0, 1, At, B1); PG8_BAR;
            PG8_LDA(At, 0, 1); PG8_STAGE(PG8_SA(0, 0), a2, voffA);
            PG8_BAR; PG8_WAIT_L(0); PG8_MMA(1, 0, At, B0); PG8_BAR; PG8_SCHED;
            PG8_STAGE(PG8_SB(0, 1), b2 + hstep, voffB);
            PG8_WAIT_V(6); PG8_BAR; PG8_MMA(1, 1, At, B1); PG8_BAR;
            PG8_LDB(B0, 1, 0); PG8_SCHED; PG8_LDA(At, 1, 0); PG8_STAGE(PG8_SA(0, 1), a2 + hstep, voffA);
            PG8_WAIT_L(8); PG8_BAR; PG8_WAIT_L(0); PG8_MMA(0, 0, At, B0); PG8_BAR; PG8_SCHED;
            PG8_LDB(B1, 1, 1); PG8_STAGE(PG8_SB(1, 0), b3, voffB);
            PG8_BAR; PG8_WAIT_L(0); PG8_MMA(0, 1, At, B1); PG8_BAR;
            PG8_LDA(At, 1, 1); PG8_STAGE(PG8_SA(1, 0), a3, voffA);
            PG8_BAR; PG8_WAIT_L(0); PG8_MMA(1, 0, At, B0); PG8_BAR; PG8_SCHED;
            PG8_STAGE(PG8_SB(1, 1), b3 + hstep, voffB);
            PG8_WAIT_V(6); PG8_BAR; PG8_MMA(1, 1, At, B1); PG8_BAR;
            }
        }
        if constexpr (ALIGN_EPI) { if (wr == 0) PG8_BAR; }
        if constexpr (!Epi::AFTER_DRAIN) { E(acc, cur, wr, wc, fr, fq); S.done(cur); }
        if (!has_next) break;
#pragma unroll
        for (int a = 0; a < 2; ++a)
#pragma unroll
            for (int b = 0; b < 2; ++b)
#pragma unroll
                for (int m = 0; m < 4; ++m)
#pragma unroll
                    for (int n = 0; n < 2; ++n) acc[a][b][m][n] = (f32x4){0.f, 0.f, 0.f, 0.f};
        cur = nxt; cA = nA; cB = nB; ++ui;
        if constexpr (ALIGN_EPI) { if (wr == 1) PG8_BAR; }
    }
    PG8_WAIT_V(0);
    if constexpr (!ALIGN_EPI) { if (wr == 0) PG8_BAR; }
    PG8_BAR;
    if constexpr (Epi::AFTER_DRAIN) { E.fused(acc, cur, wr, wc, fr, fq, lds, wid, lane); S.done(cur); }
#undef PG8_SA
#undef PG8_SB
#undef PG8_STAGE
#undef PG8_LDA
#undef PG8_LDB
#undef PG8_MMA
#undef PG8_WAIT_V
#undef PG8_WAIT_L
#undef PG8_BAR
#undef PG8_SCHED
}
}
#define GAS __attribute__((address_space(1)))
#define LAS __attribute__((address_space(3)))

__device__ __forceinline__ int zcol_src(int n, float& sc) {
    sc = 1.f;
    if (n < ZB_Q) return n;
    if (n < ZB_K) { int o = n - ZB_Q, h = o >> 6, d = o & 63; sc = QSCALE; if (d < 16) d = (d >> 1) + 8 * (d & 1); return ZB_Q + h * 64 + d; }
    if (n < ZB_V) { int d = n - ZB_K; if (d < 16) d = (d >> 1) + 8 * (d & 1); return ZB_K + d; }
    if (n < ZB_IQ) return n;
    if (n < ZB_IK) { int o = n - ZB_IQ, h = o >> 5, d = o & 31; sc = IQSCALE; if (d < 8) d = (d >> 1) + 4 * (d & 1); return ZB_IQ + h * 32 + d; }
    if (n < ZB_IW) { int d = n - ZB_IK; if (d < 8) d = (d >> 1) + 4 * (d & 1); return ZB_IK + d; }
    if (n < ZB_G) { sc = IWSCALE; return n; }
    if (n < ZC_Q) return n;
    if (n < ZC_K) { int o = n - ZC_Q, h = o >> 6, d = o & 63; sc = QSCALE; if (d < 16) d = (d >> 1) + 8 * (d & 1); return ZC_Q + h * 64 + d; }
    if (n < ZC_V) { int o = n - ZC_K, h = o >> 6, d = o & 63; if (d < 16) d = (d >> 1) + 8 * (d & 1); return ZC_K + h * 64 + d; }
    return n;
}

template <bool ZMAP>
__device__ __forceinline__ void transpose_item(const float* __restrict__ W, int K, int NW, bf16_t* WT, const float* __restrict__ kscale, LAS float* scr, int item, int nblk, int lane) {
    const int kb = item / nblk, nb = item % nblk, k0 = 64 * kb, n0 = 32 * nb;
    const int c4 = 4 * (lane & 7), ncol = n0 + c4;
    f32x4 v[8];
#pragma unroll
    for (int i = 0; i < 8; ++i) { const int kk = (lane >> 3) + 8 * i; v[i] = (f32x4){0.f, 0.f, 0.f, 0.f}; if (ncol < NW) v[i] = *(const f32x4*)(W + (size_t)(k0 + kk) * NW + ncol); }
#pragma unroll
    for (int i = 0; i < 8; ++i) { const int kk = (lane >> 3) + 8 * i; f32x4 x = v[i]; if (kscale) x = x * kscale[k0 + kk];
        scr[kk * 33 + c4] = x[0]; scr[kk * 33 + c4 + 1] = x[1]; scr[kk * 33 + c4 + 2] = x[2]; scr[kk * 33 + c4 + 3] = x[3]; }
    asm volatile("s_waitcnt lgkmcnt(0)" ::: "memory");
    const int c = lane & 7;
#pragma unroll
    for (int j = 0; j < 4; ++j) { const int n = (lane >> 3) + 8 * j; int sl = n; float sc = 1.f;
        if (ZMAP) { if (n0 + n < NW) sl = zcol_src(n0 + n, sc) - n0; else { sl = n; sc = 0.f; } }
        const LAS float* s = scr + (8 * c) * 33 + sl;
        u32x4 o; o.x = pk2(s[0 * 33] * sc, s[1 * 33] * sc); o.y = pk2(s[2 * 33] * sc, s[3 * 33] * sc); o.z = pk2(s[4 * 33] * sc, s[5 * 33] * sc); o.w = pk2(s[6 * 33] * sc, s[7 * 33] * sc);
        *(u32x4*)(WT + (size_t)(n0 + n) * K + k0 + 8 * c) = o; }
    asm volatile("s_waitcnt lgkmcnt(0)" ::: "memory");
}

struct PrepArgs { const float* w_in; const float* norm_g; const float* w_out; const float* ple_g; const float* w_gate; const float* w_proj; const float* w_up; const float* a_up; unsigned char* ws; };

__device__ __forceinline__ void prep_weights(const PrepArgs& a, int gw, int ngw, LAS float* scr, int lane, int L0, int L1) {
    constexpr int I_IN = 16 * (NPAD / 32), I_SQ = 16 * 32, I_PJ = 4 * 32, I_UP = 12, I_LAYER = I_IN + 2 * I_SQ + I_PJ + 2 * I_UP;
    for (int it = gw; it < (L1 - L0) * I_LAYER; it += ngw) {
        const int L = L0 + it / I_LAYER; int r = it % I_LAYER;
        unsigned char* wl = a.ws + WS_W + (size_t)L * W_LAYER;
        if (r < I_IN) { transpose_item<true>(a.w_in + (size_t)L * DM * ZP, DM, ZP, (bf16_t*)(wl + W_IN), a.norm_g + L * DM, scr, r, NPAD / 32, lane); continue; } r -= I_IN;
        if (r < I_SQ) { transpose_item<false>(a.w_out + (size_t)L * DM * DM, DM, DM, (bf16_t*)(wl + W_OUT), nullptr, scr, r, 32, lane); continue; } r -= I_SQ;
        if (r < I_SQ) { transpose_item<false>(a.w_gate + (size_t)L * DM * DM, DM, DM, (bf16_t*)(wl + W_GATE), a.ple_g + L * DM, scr, r, 32, lane); continue; } r -= I_SQ;
        if (r < I_PJ) { transpose_item<false>(a.w_proj + (size_t)L * 256 * DM, 256, DM, (bf16_t*)(wl + W_PROJ), nullptr, scr, r, 32, lane); continue; } r -= I_PJ;
        if (r < I_UP) { transpose_item<false>(a.w_up + (size_t)L * 64 * 384, 64, 384, (bf16_t*)(wl + W_WUPT), nullptr, scr, r, 12, lane); continue; } r -= I_UP;
        transpose_item<false>(a.a_up + (size_t)L * 64 * 384, 64, 384, (bf16_t*)(wl + W_AUPT), nullptr, scr, r, 12, lane);
    }
}

__device__ __forceinline__ void sincos_d(float ang, float& c, float& s) {
    const double a = (double)ang; const double n = rint(a * 0.63661977236758134308);
    double r = fma(-n, 1.57079632679489655800e+00, a); r = fma(-n, 6.12323399573676603587e-17, r);
    const double r2 = r * r;
    double sp = r2 * (1.0 / 6227020800.0) - 1.0 / 39916800.0; sp = sp * r2 + 1.0 / 362880.0; sp = sp * r2 - 1.0 / 5040.0; sp = sp * r2 + 1.0 / 120.0; sp = sp * r2 - 1.0 / 6.0; sp = sp * r2 * r + r;
    double cp = r2 * (1.0 / 479001600.0) - 1.0 / 3628800.0; cp = cp * r2 + 1.0 / 40320.0; cp = cp * r2 - 1.0 / 720.0; cp = cp * r2 + 1.0 / 24.0; cp = cp * r2 - 0.5; cp = cp * r2 + 1.0;
    const int q = ((int)n) & 3;
    const double sv = (q == 0) ? sp : (q == 1) ? cp : (q == 2) ? -sp : -cp;
    const double cv = (q == 0) ? cp : (q == 1) ? -sp : (q == 2) ? -cp : sp;
    c = (float)cv; s = (float)sv;
}
__device__ __forceinline__ void prep_tables(unsigned char* ws, int gtid, int nthreads) {
    const float inv8[8] = {1.0f, 0.1939227432012558f, 0.03760603070259094f, 0.007292664609849453f, 0.0014142135623842478f, 0.00027424818836152554f, 5.318296098266728e-05f, 1.0313386155758053e-05f};
    float* t16 = (float*)(ws + WS_TAB16); float* tI = (float*)(ws + WS_TABI);
    for (int e = gtid; e < SEQ * 8; e += nthreads) { const int pos = e >> 3, i = e & 7;
        float iv = inv8[0];
#pragma unroll
        for (int j = 1; j < 8; ++j) iv = (i == j) ? inv8[j] : iv;
        float c, s; sincos_d((float)pos * iv, c, s); t16[pos * 16 + i] = c; t16[pos * 16 + 8 + i] = s;
        if ((i & 1) == 0) { const int i4 = i >> 1; tI[pos * 8 + i4] = c; tI[pos * 8 + 4 + i4] = s; }
    }
}
__device__ __forceinline__ void x_row_to_bf16(const float* xrow, bf16_t* orow, float* ssq, int lane) {
    const f32x4* xr = (const f32x4*)xrow + lane;
    unsigned long long* o8 = (unsigned long long*)orow + lane;
#pragma unroll
    for (int j = 0; j < 4; ++j) { const f32x4 v = xr[64 * j];
        float s = (v.x * v.x + v.y * v.y) + (v.z * v.z + v.w * v.w);
        o8[64 * j] = (unsigned long long)pk2(v.x, v.y) | ((unsigned long long)pk2(v.z, v.w) << 32);
        s += __shfl_xor(s, 1); s += __shfl_xor(s, 2); s += __shfl_xor(s, 4); s += __shfl_xor(s, 8);
        if ((lane & 15) == 0) ssq[4 * j + (lane >> 4)] = s; }
}
__device__ __forceinline__ float row_rstd(const float* ssq_row) {
    const f32x4 a = *(const f32x4*)ssq_row, b = *(const f32x4*)(ssq_row + 4), c = *(const f32x4*)(ssq_row + 8), d = *(const f32x4*)(ssq_row + 12);
    const float s = ((a.x + a.y) + (a.z + a.w)) + ((b.x + b.y) + (b.z + b.w)) + ((c.x + c.y) + (c.z + c.w)) + ((d.x + d.y) + (d.z + d.w));
    return __builtin_amdgcn_rsqf(s * (1.0f / DM) + NORM_EPS);
}
namespace epi {
using pg8::Unit; using pg8::BM; using pg8::HALF;
__device__ __forceinline__ u32x4 pack8(const f32x4& a, const f32x4& b) { u32x4 w; w.x = pg8::cvt_pk_bf16(a[0], a[1]); w.y = pg8::cvt_pk_bf16(a[2], a[3]); w.z = pg8::cvt_pk_bf16(b[0], b[1]); w.w = pg8::cvt_pk_bf16(b[2], b[3]); return w; }
__device__ __forceinline__ int rope_class(int c0, int& fb) {
    fb = 0; int o;
    if (c0 >= ZB_Q && c0 < ZB_V) { o = (c0 - ZB_Q) & 63; if (o < 16) { fb = o >> 1; return 1; } return 0; }
    if (c0 >= ZB_IQ && c0 < ZB_IW) { o = (c0 - ZB_IQ) & 31; return o == 0 ? 2 : 0; }
    if (c0 >= ZC_Q && c0 < ZC_V) { o = (c0 - ZC_Q) & 63; if (o < 16) { fb = o >> 1; return 1; } return 0; }
    return 0;
}
struct EpiInProj {
    static constexpr bool PERM = true, AFTER_DRAIN = false;
    bf16_t* Z; const float* ssq; const float* tab16; const float* tabI; bf16_t* KV; bf16_t* IKC;
    __device__ __forceinline__ void operator()(const f32x4 (&acc)[2][2][4][2], const Unit& u, int wr, int wc, int fr, int fq) const {
        const int row0 = u.pm * BM + wr * 64 + fr;
        const int c00 = u.pn * BM + wc * 32 + 8 * fq, c01 = c00 + HALF;
        int fb0, fb1; const int rc0 = rope_class(c00, fb0), rc1 = rope_class(c01, fb1);
#pragma unroll
        for (int ai = 0; ai < 2; ++ai)
#pragma unroll
            for (int m = 0; m < 4; ++m) {
                const int row = row0 + ai * HALF + m * 16;
                const float rs = row_rstd(ssq + (size_t)row * 16);
                const int pos = row & (SEQ - 1);
#pragma unroll
                for (int bj = 0; bj < 2; ++bj) {
                    const int c0 = bj ? c01 : c00, rc = bj ? rc1 : rc0, fb = bj ? fb1 : fb0;
                    if (c0 >= ZP) continue;
                    f32x4 v0 = acc[ai][bj][m][0] * rs, v1 = acc[ai][bj][m][1] * rs;
                    if (rc) {
                        const float* tp = (rc == 1) ? tab16 + pos * 16 + fb : tabI + pos * 8;
                        const f32x4 c = *(const f32x4*)tp, s = *(const f32x4*)(tp + (rc == 1 ? 8 : 4));
                        f32x4 a0, a1;
                        a0[0] = v0[0] * c[0] - v0[1] * s[0]; a0[1] = v0[1] * c[0] + v0[0] * s[0];
                        a0[2] = v0[2] * c[1] - v0[3] * s[1]; a0[3] = v0[3] * c[1] + v0[2] * s[1];
                        a1[0] = v1[0] * c[2] - v1[1] * s[2]; a1[1] = v1[1] * c[2] + v1[0] * s[2];
                        a1[2] = v1[2] * c[3] - v1[3] * s[3]; a1[3] = v1[3] * c[3] + v1[2] * s[3];
                        v0 = a0; v1 = a1;
                    }
                    const u32x4 pk = pack8(v0, v1);
                    if (c0 >= ZB_K && c0 < ZB_IQ) *(u32x4*)(KV + (size_t)row * 128 + (c0 - ZB_K)) = pk;
                    else if (c0 >= ZB_IK && c0 < ZB_IW) *(u32x4*)(IKC + (size_t)row * 32 + (c0 - ZB_IK)) = pk;
                    else *(u32x4*)(Z + (size_t)row * ZP + c0) = pk;
                }
                asm volatile("" ::: "memory");
            }
    }
};
struct EpiPlainZ {
    static constexpr bool PERM = true, AFTER_DRAIN = false;
    bf16_t* Z;
    __device__ __forceinline__ void operator()(const f32x4 (&acc)[2][2][4][2], const Unit& u, int wr, int wc, int fr, int fq) const {
        const int row0 = u.pm * BM + wr * 64 + fr;
#pragma unroll
        for (int ai = 0; ai < 2; ++ai)
#pragma unroll
            for (int m = 0; m < 4; ++m)
#pragma unroll
                for (int bj = 0; bj < 2; ++bj) { const int c0 = u.pn * BM + bj * HALF + wc * 32 + 8 * fq; if (c0 < ZP) *(u32x4*)(Z + (size_t)(row0 + ai * HALF + m * 16) * ZP + c0) = pack8(acc[ai][bj][m][0], acc[ai][bj][m][1]); }
    }
};
struct EpiOutProj {
    static constexpr bool PERM = true, AFTER_DRAIN = false;
    const float* xin; bf16_t* xb; float* ssq_out;
    __device__ __forceinline__ void operator()(const f32x4 (&acc)[2][2][4][2], const Unit& u, int wr, int wc, int fr, int fq) const {
        const int row0 = u.pm * BM + wr * 64 + fr;
#pragma unroll
        for (int ai = 0; ai < 2; ++ai)
#pragma unroll
            for (int m = 0; m < 4; ++m) {
                const int row = row0 + ai * HALF + m * 16; float sq = 0.f;
#pragma unroll
                for (int bj = 0; bj < 2; ++bj) {
                    const size_t off = (size_t)row * DM + u.pn * BM + bj * HALF + wc * 32 + 8 * fq;
                    const f32x4 x0 = *(const f32x4*)(xin + off) + acc[ai][bj][m][0], x1 = *(const f32x4*)(xin + off + 4) + acc[ai][bj][m][1];
                    *(u32x4*)(xb + off) = pack8(x0, x1);
                    sq += ((x0[0] * x0[0] + x0[1] * x0[1]) + (x0[2] * x0[2] + x0[3] * x0[3])) + ((x1[0] * x1[0] + x1[1] * x1[1]) + (x1[2] * x1[2] + x1[3] * x1[3]));
                }
                sq += __shfl_xor(sq, 16); sq += __shfl_xor(sq, 32);
                if (fq == 0) ssq_out[(size_t)row * 16 + u.pn * 4 + wc] = sq;
            }
    }
};
struct EpiGate {
    static constexpr bool PERM = true, AFTER_DRAIN = false;
    float* xout; const bf16_t* x1b; const bf16_t* pp; bf16_t* xb; const float* ssq_in; float* ssq_out;
    __device__ __forceinline__ void operator()(const f32x4 (&acc)[2][2][4][2], const Unit& u, int wr, int wc, int fr, int fq) const {
        const int row0 = u.pm * BM + wr * 64 + fr;
#pragma unroll
        for (int ai = 0; ai < 2; ++ai)
#pragma unroll
            for (int m = 0; m < 4; ++m) {
                const int row = row0 + ai * HALF + m * 16; float sq = 0.f;
                const float rs = row_rstd(ssq_in + (size_t)row * 16);
#pragma unroll
                for (int bj = 0; bj < 2; ++bj) {
                    const size_t off = (size_t)row * DM + u.pn * BM + bj * HALF + wc * 32 + 8 * fq;
                    f32x4 g0 = acc[ai][bj][m][0] * rs, g1 = acc[ai][bj][m][1] * rs;
#pragma unroll
                    for (int i = 0; i < 4; ++i) { g0[i] = sigmoidf_(g0[i]); g1[i] = sigmoidf_(g1[i]); }
                    const u32x4 pw = *(const u32x4*)(pp + off); const f32x4 pp0 = {bflo(pw.x), bfhi(pw.x), bflo(pw.y), bfhi(pw.y)}, pp1 = {bflo(pw.z), bfhi(pw.z), bflo(pw.w), bfhi(pw.w)};
                    const u32x4 xw = *(const u32x4*)(x1b + off); const f32x4 xa = {bflo(xw.x), bfhi(xw.x), bflo(xw.y), bfhi(xw.y)}, xc = {bflo(xw.z), bfhi(xw.z), bflo(xw.w), bfhi(xw.w)};
                    const f32x4 x0 = xa + g0 * pp0, x1 = xc + g1 * pp1;
                    *(f32x4*)(xout + off) = x0; *(f32x4*)(xout + off + 4) = x1;
                    *(u32x4*)(xb + off) = pack8(x0, x1);
                    sq += ((x0[0] * x0[0] + x0[1] * x0[1]) + (x0[2] * x0[2] + x0[3] * x0[3])) + ((x1[0] * x1[0] + x1[1] * x1[1]) + (x1[2] * x1[2] + x1[3] * x1[3]));
                }
                sq += __shfl_xor(sq, 16); sq += __shfl_xor(sq, 32);
                if (fq == 0) ssq_out[(size_t)row * 16 + u.pn * 4 + wc] = sq;
            }
    }
};
struct EpiBf16Plain {
    static constexpr bool PERM = true, AFTER_DRAIN = false;
    bf16_t* C;
    __device__ __forceinline__ void operator()(const f32x4 (&acc)[2][2][4][2], const Unit& u, int wr, int wc, int fr, int fq) const {
        const int row0 = u.pm * BM + wr * 64 + fr;
#pragma unroll
        for (int ai = 0; ai < 2; ++ai)
#pragma unroll
            for (int m = 0; m < 4; ++m)
#pragma unroll
                for (int bj = 0; bj < 2; ++bj) {
                    const size_t off = (size_t)(row0 + ai * HALF + m * 16) * DM + u.pn * BM + bj * HALF + wc * 32 + 8 * fq;
                    *(u32x4*)(C + off) = pack8(acc[ai][bj][m][0], acc[ai][bj][m][1]);
                }
    }
};
struct EpiF32 {
    static constexpr bool PERM = true, AFTER_DRAIN = false;
    float* C;
    __device__ __forceinline__ void operator()(const f32x4 (&acc)[2][2][4][2], const Unit& u, int wr, int wc, int fr, int fq) const {
        const int row0 = u.pm * BM + wr * 64 + fr;
#pragma unroll
        for (int ai = 0; ai < 2; ++ai)
#pragma unroll
            for (int m = 0; m < 4; ++m)
#pragma unroll
                for (int bj = 0; bj < 2; ++bj) {
                    const size_t off = (size_t)(row0 + ai * HALF + m * 16) * DM + u.pn * BM + bj * HALF + wc * 32 + 8 * fq;
                    *(f32x4*)(C + off) = acc[ai][bj][m][0]; *(f32x4*)(C + off + 4) = acc[ai][bj][m][1];
                }
    }
};
}
typedef GAS unsigned gu32;
#define RLX_AGENT __ATOMIC_RELAXED, __HIP_MEMORY_SCOPE_AGENT
#define XB_TMO      128
#define XB_XCNT(j)  (256  + 64 * (j))
#define XB_XSUB(j)  (1280 + 64 * (j))
#define XB_XGEN(j)  (2304 + 64 * (j))
#define XB_TOP      3328
#define XB_TOPGEN   3392
#define XCD_BAR_WORDS 3456
#define XB_SPIN_CAP (1u << 27)

__device__ __forceinline__ unsigned xb_ld(unsigned* p)              { return __hip_atomic_load(p, __ATOMIC_RELAXED, __HIP_MEMORY_SCOPE_AGENT); }
__device__ __forceinline__ unsigned xb_add(unsigned* p, unsigned v) { return __hip_atomic_fetch_add(p, v, __ATOMIC_RELAXED, __HIP_MEMORY_SCOPE_AGENT); }
__device__ __forceinline__ unsigned xb_xcc_id() { return (unsigned)__builtin_amdgcn_s_getreg((3 << 11) | 20) & 0xFu; }
#define XB_SPIN(cond, bar) do { unsigned _sp = 0; while (cond) { __builtin_amdgcn_s_sleep(1); \
    if ((++_sp & 255u) == 0u) { if (xb_ld(&(bar)[XB_TMO])) break; if (_sp > XB_SPIN_CAP) { atomicAdd(&(bar)[XB_TMO], 1u); break; } } } } while (0)

struct XcdBarrier {
    unsigned* bar; unsigned x;
    volatile LAS unsigned* st;
};

__device__ __forceinline__ XcdBarrier xcd_barrier_post(unsigned* bar, volatile LAS unsigned* st) {
    XcdBarrier b; b.bar = bar; b.x = xb_xcc_id(); b.st = st;
    if (threadIdx.x == 0) (void)xb_add(&bar[XB_XCNT(b.x)], 1u);
    return b;
}
__device__ __forceinline__ void xcd_barrier_complete(unsigned* bar, unsigned x, unsigned& nloc, unsigned& nx) {
    const unsigned G = gridDim.x * gridDim.y * gridDim.z;
    unsigned sum, cnt, mine, sp = 0u;
    for (;;) {
        sum = 0u; cnt = 0u; mine = 0u;
#pragma unroll
        for (unsigned j = 0; j < 16; ++j) { const unsigned c = xb_ld(&bar[XB_XCNT(j)]); sum += c; cnt += (c > 0u) ? 1u : 0u; mine = (j == x) ? c : mine; }
        if (sum == G) break;
        __builtin_amdgcn_s_sleep(1);
        if ((++sp & 255u) == 0u) { if (xb_ld(&bar[XB_TMO])) break; if (sp > XB_SPIN_CAP) { atomicAdd(&bar[XB_TMO], 1u); break; } }
    }
    nloc = mine > 0u ? mine : 1u; nx = cnt > 0u ? cnt : 1u;
}

__device__ __forceinline__ void xcd_barrier(const XcdBarrier& b) {
    asm volatile("s_waitcnt vmcnt(0)" ::: "memory");
    __syncthreads();
    if (threadIdx.x == 0) {
        unsigned* bar = b.bar;
        __builtin_amdgcn_s_waitcnt(0);
        unsigned nloc = b.st[0], nx = b.st[1];
        if (nloc == 0u) { xcd_barrier_complete(bar, b.x, nloc, nx); b.st[0] = nloc; b.st[1] = nx; }
        const unsigned old = xb_add(&bar[XB_XSUB(b.x)], 1u);
        const unsigned gen = old / nloc;
        if (old + 1u == (gen + 1u) * nloc) {
            __builtin_amdgcn_fence(__ATOMIC_RELEASE, "agent");
            asm volatile("s_waitcnt vmcnt(0)" ::: "memory");
            const unsigned og = xb_add(&bar[XB_TOP], 1u);
            const unsigned tg = og / nx;
            if (og + 1u == (tg + 1u) * nx) xb_add(&bar[XB_TOPGEN], 1u);
            else XB_SPIN(xb_ld(&bar[XB_TOPGEN]) == tg, bar);
            __builtin_amdgcn_fence(__ATOMIC_ACQUIRE, "agent");
            xb_add(&bar[XB_XGEN(b.x)], 1u);
            asm volatile("s_waitcnt vmcnt(0)" ::: "memory");
        } else {
            XB_SPIN(xb_ld(&bar[XB_XGEN(b.x)]) == gen, bar);
            __builtin_amdgcn_fence(__ATOMIC_ACQUIRE, "agent");
            asm volatile("s_waitcnt vmcnt(0)" ::: "memory");
        }
    }
    __syncthreads();
}
struct MixArgs { const bf16_t* Z; bf16_t* Y; const bf16_t* KV; const bf16_t* IKC; const float* mu; const float* w0; const float* w_up; const float* a0; const float* a_up; const float* k_k; const float* k_a; const float* r_k; const float* ln_g; const float* ln_b; };
namespace dsa {
#ifdef PROBE_T
#define DTS ((volatile LAS unsigned long long*)((LAS unsigned char*)ldsb + 131072 + 1024))
#define DSTAMP_B(id) do { if ((id) == PROBE_T && blockIdx.x == 0 && threadIdx.x == 0) DTS[0] = __builtin_amdgcn_s_memrealtime(); } while (0)
#define DSTAMP_E(id) do { if ((id) == PROBE_T && blockIdx.x == 0 && threadIdx.x == 0) DTS[1] += __builtin_amdgcn_s_memrealtime() - DTS[0]; } while (0)
#else
#define DSTAMP_B(id) do {} while (0)
#define DSTAMP_E(id) do {} while (0)
#endif
#define MFMA32(a, b, c) __builtin_amdgcn_mfma_f32_32x32x16_bf16((a), (b), (c), 0, 0, 0)
typedef short v4i16_t __attribute__((ext_vector_type(4)));
typedef short s16x4 __attribute__((ext_vector_type(4)));
constexpr int WAVE_LDS = 2048 + 4096;
constexpr int IKS_OFF = 8 * WAVE_LDS, IKS_BYTES = 65536;
__device__ __forceinline__ unsigned fkey(float f) { const unsigned b = __builtin_bit_cast(unsigned, f); return (b & 0x80000000u) ? ~b : (b | 0x80000000u); }
__device__ __forceinline__ float keyf(unsigned u) { const unsigned b = (u & 0x80000000u) ? (u & 0x7fffffffu) : ~u; return __builtin_bit_cast(float, b); }
__device__ __forceinline__ float relu_(float x) { const int b = __builtin_bit_cast(int, x); return __builtin_bit_cast(float, b > 0 ? b : 0); }
__device__ __forceinline__ s16x4 vtr(const LAS unsigned char* p) { return __builtin_bit_cast(s16x4, __builtin_amdgcn_ds_read_tr16_b64_v4i16((LAS v4i16_t*)p)); }

#define DPP_(v, ctrl) ((unsigned)__builtin_amdgcn_update_dpp((int)(v), (int)(v), (ctrl), 0xf, 0xf, false))
__device__ __forceinline__ unsigned half_min(unsigned v) { v = min(v, DPP_(v, 0xB1)); v = min(v, DPP_(v, 0x4E)); v = min(v, DPP_(v, 0x141)); v = min(v, DPP_(v, 0x140)); return min(v, (unsigned)__builtin_amdgcn_ds_swizzle((int)v, 0x401F)); }
__device__ __forceinline__ unsigned half_max(unsigned v) { v = max(v, DPP_(v, 0xB1)); v = max(v, DPP_(v, 0x4E)); v = max(v, DPP_(v, 0x141)); v = max(v, DPP_(v, 0x140)); return max(v, (unsigned)__builtin_amdgcn_ds_swizzle((int)v, 0x401F)); }
__device__ __forceinline__ int half_sum(int v) { v += (int)DPP_(v, 0xB1); v += (int)DPP_(v, 0x4E); v += (int)DPP_(v, 0x141); v += (int)DPP_(v, 0x140); return v + __builtin_amdgcn_ds_swizzle(v, 0x401F); }
__device__ __forceinline__ unsigned next_pivot(unsigned ulo, unsigned uhi, int clo, int chi, int it) {
    unsigned p;
    const bool hl = clo >= 0, hh = chi >= 0;
    if (it == 0) p = fkey(0.0f);
    else if (!hh) { const float f = keyf(ulo); p = fkey(f >= 0.f ? 2.f * f + 0.25f : 0.5f * f + 0.125f); }
    else if (!hl) { const float f = keyf(uhi); p = fkey(f <= 0.f ? 2.f * f - 0.25f : 0.5f * f - 0.125f); }
    else { const float fl = keyf(ulo), fh = keyf(uhi);
        float fr = ((float)(clo - 256) + 0.5f) * __builtin_amdgcn_rcpf((float)(clo - chi)); fr = fminf(fmaxf(fr, 1.f / 32.f), 31.f / 32.f);
        if (it % 3 == 2) fr = 0.5f;
        p = fkey(fl + (fh - fl) * fr); }
    if (!(p > ulo && p < uhi)) p = ulo + ((uhi - ulo) >> 1);
    return p;
}

__device__ __forceinline__ void dsa_unit(const MixArgs& a, unsigned char* ldsb, int b, int blk) {
    const int tid = opaque_tid(), lane = tid & 63, wave = __builtin_amdgcn_readfirstlane(tid >> 6), r32 = lane & 31, hi = lane >> 5;
    const GAS bf16_t* zb = (const GAS bf16_t*)a.Z + (size_t)b * SEQ * ZP;
    LAS unsigned char* wl = (LAS unsigned char*)ldsb + wave * WAVE_LDS;
    LAS unsigned* bm = (LAS unsigned*)wl;
    LAS unsigned char* vimg = wl + 2048;
    const int tw = blk * 64 + 8 * wave;
    f32x16 zero16;
#pragma unroll
    for (int i = 0; i < 16; ++i) zero16[i] = 0.f;
#ifdef PROBE_SEL
#define NRND 4
#else
#define NRND 2
#endif
#pragma unroll 1
    for (int rnd_ = 0; rnd_ < NRND; ++rnd_) { const int rnd = rnd_ & 1;
        const int tb = tw + 4 * rnd;
        const int qsub = 2 * ((r32 >> 2) & 1) + (r32 >> 4), head = (r32 & 3) + 4 * ((r32 >> 3) & 1);
        const GAS bf16_t* iqp = zb + (size_t)(tb + qsub) * ZP + ZB_IQ + head * 32 + 8 * hi;
        const bf16x8 aiq0 = *(const GAS bf16x8*)iqp, aiq1 = *(const GAS bf16x8*)(iqp + 16);
        const int tqA = tb + 2 * hi, tqB = tqA + 1;
        float wA[8], wB[8];
        { const u32x4 ua = *(const GAS u32x4*)(zb + (size_t)tqA * ZP + ZB_IW), ub = *(const GAS u32x4*)(zb + (size_t)tqB * ZP + ZB_IW);
          wA[0] = bflo(ua.x); wA[1] = bfhi(ua.x); wA[2] = bflo(ua.y); wA[3] = bfhi(ua.y); wA[4] = bflo(ua.z); wA[5] = bfhi(ua.z); wA[6] = bflo(ua.w); wA[7] = bfhi(ua.w);
          wB[0] = bflo(ub.x); wB[1] = bfhi(ub.x); wB[2] = bflo(ub.y); wB[3] = bfhi(ub.y); wB[4] = bflo(ub.z); wB[5] = bfhi(ub.z); wB[6] = bflo(ub.w); wB[7] = bfhi(ub.w); }
        unsigned scA[64], scB[64];
        const int dA = tqA - 32 * ((tb + 3) >> 5);
        const int Tmax = (tb + 3) >> 5;
        int Tm_s = Tmax, Tm_b = Tmax; asm volatile("" : "+s"(Tm_s), "+s"(Tm_b));
        DSTAMP_B(30);
        const int TmaxU = 2 * blk + 1;
        const int fsw = (r32 >> 2) & 3;
        const LAS unsigned char* ikl = (const LAS unsigned char*)ldsb + IKS_OFF + r32 * 64;
        const int off0 = (hi ^ fsw) * 16, off1 = ((2 + hi) ^ fsw) * 16;
#ifdef PROBE_SCORE
        for (int rep_ = 0; rep_ < 2; ++rep_)
#endif
#pragma unroll
        for (int half = 0; half < 2; ++half) {
            if (32 * half <= TmaxU) {
                __syncthreads();
                { const int nkeys = min(32 * (TmaxU + 1) - 1024 * half, 1024);
                  const GAS bf16_t* src = (const GAS bf16_t*)a.IKC + ((size_t)b * SEQ + 1024 * half) * 32;
                  for (int ch = tid; ch < nkeys * 4; ch += 512) { const int key = ch >> 2, c4 = ch & 3;
                      *(LAS u32x4*)((LAS unsigned char*)ldsb + IKS_OFF + key * 64 + ((c4 ^ ((key >> 2) & 3)) * 16)) = *(const GAS u32x4*)(src + key * 32 + c4 * 8); } }
                asm volatile("s_waitcnt vmcnt(0) lgkmcnt(0)" ::: "memory");
                __syncthreads();
                bf16x8 kb0[2], kb1[2];
#pragma unroll
                for (int i = 0; i < 2; ++i) { if (32 * half + i <= Tm_s) { kb0[i] = *(const LAS bf16x8*)(ikl + i * 2048 + off0); kb1[i] = *(const LAS bf16x8*)(ikl + i * 2048 + off1); } }
#pragma unroll
                for (int i = 0; i < 32; ++i) { const int T = 32 * half + i;
                    if (T <= Tm_s) {
                        f32x16 c = MFMA32(aiq0, kb0[i & 1], zero16); c = MFMA32(aiq1, kb1[i & 1], c);
                        if (i + 2 < 32 && T + 2 <= Tm_s) { kb0[i & 1] = *(const LAS bf16x8*)(ikl + (i + 2) * 2048 + off0); kb1[i & 1] = *(const LAS bf16x8*)(ikl + (i + 2) * 2048 + off1); }
                        float sA = 0.f, sB = 0.f;
#pragma unroll
                        for (int r = 0; r < 8; ++r) { sA += wA[r] * relu_(c[r]); sB += wB[r] * relu_(c[8 + r]); }
                        const bool last = (T == Tm_s);
                        scA[T] = (!last || r32 <= dA) ? fkey(sA + 0.f) : 0u; scB[T] = (!last || r32 <= dA + 1) ? fkey(sB + 0.f) : 0u;
                    } else { scA[T] = 0u; scB[T] = 0u; }
                }
            } else {
#pragma unroll
                for (int i = 0; i < 32; ++i) { scA[32 * half + i] = 0u; scB[32 * half + i] = 0u; }
            }
        }
        DSTAMP_E(30); DSTAMP_B(31);
        const int nA = tqA + 1, nB = tqB + 1;
        unsigned uloA = 1u, uhiA = 0xffffffffu, uloB = 1u, uhiB = 0xffffffffu; int cloA = -1, chiA = -1, cloB = -1, chiB = -1;
        bool doneA = nA <= 256, doneB = nB <= 256;
        unsigned thA = 1u, thB = 1u; int needA = 0, needB = 0;
        int itn = 0, lim = 128;
        constexpr int CAP = 12;
        LAS unsigned* lstA = (LAS unsigned*)((LAS unsigned char*)ldsb + IKS_OFF + wave * 8192) + lane * (CAP + 1), *lstB = lstA + 64 * (CAP + 1);
        unsigned ca_[CAP], cb_[CAP];
        for (;;) {
            DSTAMP_B(34);
            for (; itn < 200; ++itn) {
                if (!doneA && uhiA - uloA <= 1u) { thA = uhiA; needA = 256 - max(chiA, 0); doneA = true; }
                if (!doneB && uhiB - uloB <= 1u) { thB = uhiB; needB = 256 - max(chiB, 0); doneB = true; }
                const bool actA = !doneA && ((cloA < 0 ? nA : cloA) - max(chiA, 0) > lim), actB = !doneB && ((cloB < 0 ? nB : cloB) - max(chiB, 0) > lim);
                if (!__any(actA || actB)) break;
                const unsigned pA = actA ? next_pivot(uloA, uhiA, cloA, chiA, itn) : 0xffffffffu, pB = actB ? next_pivot(uloB, uhiB, cloB, chiB, itn) : 0xffffffffu;
                int ca = 0, cb = 0;
#pragma unroll
                for (int T = 0; T < 64; ++T)
                    asm("v_cmp_ge_u32 vcc, %2, %3\n\tv_addc_co_u32 %0, vcc, 0, %0, vcc\n\tv_cmp_ge_u32 vcc, %4, %5\n\tv_addc_co_u32 %1, vcc, 0, %1, vcc" : "+v"(ca), "+v"(cb) : "v"(scA[T]), "v"(pA), "v"(scB[T]), "v"(pB) : "vcc");
                const int pk = half_sum(ca | (cb << 16));
                ca = pk & 0xffff; cb = pk >> 16;
                if (actA) { if (ca == 256) { thA = pA; needA = 0; doneA = true; } else if (ca > 256) { uloA = pA; cloA = ca; } else { uhiA = pA; chiA = ca; } }
                if (actB) { if (cb == 256) { thB = pB; needB = 0; doneB = true; } else if (cb > 256) { uloB = pB; cloB = cb; } else { uhiB = pB; chiB = cb; } }
            }
            DSTAMP_E(34);
            if (!__any(!doneA || !doneB)) break;
            DSTAMP_B(35);
            const unsigned wA_ = doneA ? 0u : uhiA - uloA, wB_ = doneB ? 0u : uhiB - uloB;
            int nA_ = 0, nB_ = 0;
#pragma unroll
            for (int T = 0; T < 64; ++T) {
                lstA[min(nA_, CAP)] = scA[T]; lstB[min(nB_, CAP)] = scB[T];
                nA_ += ((scA[T] - uloA) < wA_) ? 1 : 0; nB_ += ((scB[T] - uloB) < wB_) ? 1 : 0;
            }
            asm volatile("s_waitcnt lgkmcnt(0)" ::: "memory");
            if (__any(nA_ > CAP || nB_ > CAP)) { lim >>= 1; continue; }
#pragma unroll
            for (int j = 0; j < CAP; ++j) { ca_[j] = (j < nA_) ? lstA[j] : 0u; cb_[j] = (j < nB_) ? lstB[j] : 0u; }
            DSTAMP_E(35);
            break;
        }
        if (__any(!doneA || !doneB)) {
            DSTAMP_B(36);
            const int baseA = max(chiA, 0), baseB = max(chiB, 0);
            for (; itn < 400; ++itn) {
                unsigned mnA = 0xffffffffu, mxA = 0u, mnB = 0xffffffffu, mxB = 0u;
                const unsigned wa = doneA ? 0u : uhiA - uloA, wb = doneB ? 0u : uhiB - uloB;
#pragma unroll
                for (int j = 0; j < CAP; ++j) { if ((ca_[j] - uloA) < wa) { mnA = min(mnA, ca_[j]); mxA = max(mxA, ca_[j]); } if ((cb_[j] - uloB) < wb) { mnB = min(mnB, cb_[j]); mxB = max(mxB, cb_[j]); } }
                mnA = half_min(mnA); mxA = half_max(mxA); mnB = half_min(mnB); mxB = half_max(mxB);
                if (!doneA) { if (mnA >= mxA) { thA = mxA + 1u; needA = 256 - max(chiA, 0); doneA = true; } else { uloA = mnA; uhiA = mxA + 1u; if (cloA < 0) cloA = nA; if (chiA < 0) chiA = 0; } }
                if (!doneB) { if (mnB >= mxB) { thB = mxB + 1u; needB = 256 - max(chiB, 0); doneB = true; } else { uloB = mnB; uhiB = mxB + 1u; if (cloB < 0) cloB = nB; if (chiB < 0) chiB = 0; } }
                if (!__any(!doneA || !doneB)) break;
                const unsigned pA = doneA ? 0xffffffffu : next_pivot(uloA, uhiA, cloA, chiA, itn | 1), pB = doneB ? 0xffffffffu : next_pivot(uloB, uhiB, cloB, chiB, itn | 1);
                int pk = 0;
#pragma unroll
                for (int j = 0; j < CAP; ++j) pk += ((ca_[j] >= pA) ? 1 : 0) + ((cb_[j] >= pB) ? 0x10000 : 0);
                pk = half_sum(pk);
                const int ca = baseA + (pk & 0xffff), cb = baseB + (pk >> 16);
                if (!doneA) { if (ca == 256) { thA = pA; needA = 0; doneA = true; } else if (ca > 256) { uloA = pA; cloA = ca; } else { uhiA = pA; chiA = ca; } }
                if (!doneB) { if (cb == 256) { thB = pB; needB = 0; doneB = true; } else if (cb > 256) { uloB = pB; cloB = cb; } else { uhiB = pB; chiB = cb; } }
            }
            DSTAMP_E(36);
        }
        DSTAMP_E(31); DSTAMP_B(32);
        int rem0 = __builtin_amdgcn_readlane(needA, 0), rem1 = __builtin_amdgcn_readlane(needB, 0), rem2 = __builtin_amdgcn_readlane(needA, 32), rem3 = __builtin_amdgcn_readlane(needB, 32);
        const bool anytie = (rem0 | rem1 | rem2 | rem3) != 0;
        LAS unsigned* bmr = bm + 4 * rnd; asm volatile("" : "+v"(bmr));
#pragma unroll
        for (int T = 0; T < 64; ++T) {
            if (T <= Tm_b) {
                const unsigned long long mA = __ballot(scA[T] >= thA), mB = __ballot(scB[T] >= thB);
                unsigned m0 = (unsigned)mA, m2 = (unsigned)(mA >> 32), m1 = (unsigned)mB, m3 = (unsigned)(mB >> 32);
                if (anytie) {
                    const unsigned long long eA = __ballot(scA[T] == thA - 1u), eB = __ballot(scB[T] == thB - 1u);
                    unsigned e0 = (unsigned)eA, e2 = (unsigned)(eA >> 32), e1 = (unsigned)eB, e3 = (unsigned)(eB >> 32);
                    while (rem0 > 0 && e0) { const unsigned bit = e0 & (0u - e0); m0 |= bit; e0 ^= bit; --rem0; }
                    while (rem1 > 0 && e1) { const unsigned bit = e1 & (0u - e1); m1 |= bit; e1 ^= bit; --rem1; }
                    while (rem2 > 0 && e2) { const unsigned bit = e2 & (0u - e2); m2 |= bit; e2 ^= bit; --rem2; }
                    while (rem3 > 0 && e3) { const unsigned bit = e3 & (0u - e3); m3 |= bit; e3 ^= bit; --rem3; }
                }
                if (lane == 0) { u32x4 w; w.x = m0; w.y = m1; w.z = m2; w.w = m3; *(LAS u32x4*)(bmr + T * 8) = w; }
            }
        }
        DSTAMP_E(32);
    }
    DSTAMP_B(33);
    asm volatile("s_waitcnt lgkmcnt(0)" ::: "memory");
    const int qc = r32 >> 2, hc = r32 & 3;
    const GAS bf16_t* kvb = (const GAS bf16_t*)a.KV + (size_t)b * SEQ * 128;
    const size_t qrow = (size_t)(b * SEQ + tw + qc);
    bf16x8 bq[4];
#pragma unroll
    for (int s = 0; s < 4; ++s) bq[s] = *(const GAS bf16x8*)((const GAS bf16_t*)a.Z + qrow * ZP + ZB_Q + hc * 64 + 16 * s + 8 * hi);
    f32x16 o0 = zero16, o1 = zero16, lacc = zero16; float lsum = 0.f;
    const bf16x8 ones8 = {(short)0x3f80, (short)0x3f80, (short)0x3f80, (short)0x3f80, (short)0x3f80, (short)0x3f80, (short)0x3f80, (short)0x3f80};
    const int Tend = (tw + 7) >> 5;
    const int g16 = lane >> 4, i16 = lane & 15, q4 = i16 >> 2, p4 = i16 & 3;
    const int vrd = ((g16 >> 1) * 4 + q4) * 64 + (16 * (g16 & 1) + 4 * p4) * 2;
    const int vwr_key = lane >> 3, vwr_ch = lane & 7;
    u32x4 vst[4]; bf16x8 ak[4];
    auto load_tile = [&](int T) {
#pragma unroll
        for (int s = 0; s < 4; ++s) ak[s] = *(const GAS bf16x8*)(kvb + (size_t)(32 * T + r32) * 128 + 16 * s + 8 * hi);
#pragma unroll
        for (int i = 0; i < 4; ++i) vst[i] = *(const GAS u32x4*)(kvb + (size_t)(32 * T + vwr_key + 8 * i) * 128 + 64 + 8 * vwr_ch);
    };
#ifdef PROBE_ATT
    for (int rep_ = 0; rep_ < 2; ++rep_) { o0 = zero16; o1 = zero16; lacc = zero16; lsum = 0.f;
#endif
    load_tile(0);
#pragma unroll 1
    for (int T = 0; T <= Tend; ++T) {
#pragma unroll
        for (int i = 0; i < 4; ++i) *(LAS u32x4*)(vimg + (vwr_ch >> 2) * 2048 + (vwr_key + 8 * i) * 64 + (vwr_ch & 3) * 16) = vst[i];
        f32x16 sacc = MFMA32(ak[0], bq[0], zero16); sacc = MFMA32(ak[1], bq[1], sacc); sacc = MFMA32(ak[2], bq[2], sacc); sacc = MFMA32(ak[3], bq[3], sacc);
        const unsigned mw = bm[T * 8 + qc] >> (4 * hi);
        if (T < Tend) load_tile(T + 1);
        asm volatile("s_waitcnt lgkmcnt(0)" ::: "memory");
        s16x4 va[2][2][2];
#pragma unroll
        for (int dt = 0; dt < 2; ++dt)
#pragma unroll
            for (int s = 0; s < 2; ++s) { va[dt][s][0] = vtr(vimg + dt * 2048 + (16 * s) * 64 + vrd); va[dt][s][1] = vtr(vimg + dt * 2048 + (16 * s + 8) * 64 + vrd); }
        unsigned pw[8];
#pragma unroll
        for (int r = 0; r < 16; r += 2) {
            float m0, m1; asm("v_min_f32 %0, 0x42800000, %1" : "=v"(m0) : "v"(sacc[r])); asm("v_min_f32 %0, 0x42800000, %1" : "=v"(m1) : "v"(sacc[r + 1]));
            const unsigned pkw = pk2(__builtin_amdgcn_exp2f(m0), __builtin_amdgcn_exp2f(m1));
            const int c0 = (r & 3) + 8 * (r >> 2), c1 = ((r + 1) & 3) + 8 * ((r + 1) >> 2);
            const unsigned a_ = (unsigned)__builtin_amdgcn_sbfe((int)mw, c0, 1), b_ = (unsigned)__builtin_amdgcn_sbfe((int)mw, c1, 1);
            pw[r >> 1] = pkw & ((a_ & 0xffffu) | (b_ & 0xffff0000u));
        }
        asm volatile("s_waitcnt lgkmcnt(0)" ::: "memory");
#pragma unroll
        for (int s = 0; s < 2; ++s) {
            u32x4 pv4; pv4.x = pw[4 * s]; pv4.y = pw[4 * s + 1]; pv4.z = pw[4 * s + 2]; pv4.w = pw[4 * s + 3];
            const bf16x8 pb = __builtin_bit_cast(bf16x8, pv4);
            const bf16x8 v0 = __builtin_shufflevector(va[0][s][0], va[0][s][1], 0, 1, 2, 3, 4, 5, 6, 7), v1 = __builtin_shufflevector(va[1][s][0], va[1][s][1], 0, 1, 2, 3, 4, 5, 6, 7);
            o0 = MFMA32(v0, pb, o0); o1 = MFMA32(v1, pb, o1); lacc = MFMA32(ones8, pb, lacc);
        }
    }
#ifdef PROBE_ATT
    }
#endif
    DSTAMP_E(33);
    lsum = lacc[0];
    const float rl = 1.0f / lsum;
    const GAS bf16_t* gp = (const GAS bf16_t*)a.Z + qrow * ZP + ZB_G + hc * 64; GAS bf16_t* yp = (GAS bf16_t*)a.Y + qrow * DM + 384 + hc * 64;
#pragma unroll
    for (int dt = 0; dt < 2; ++dt)
#pragma unroll
        for (int i = 0; i < 4; ++i) {
            const int d = 32 * dt + 8 * i + 4 * hi;
            const u32x2 gw = *(const GAS u32x2*)(gp + d);
            const float g0 = bflo(gw.x), g1 = bfhi(gw.x), g2 = bflo(gw.y), g3 = bfhi(gw.y);
            const f32x16& o = dt ? o1 : o0;
            u32x2 w; w.x = pk2(o[4 * i] * rl * g0 * sigmoidf_(g0), o[4 * i + 1] * rl * g1 * sigmoidf_(g1)); w.y = pk2(o[4 * i + 2] * rl * g2 * sigmoidf_(g2), o[4 * i + 3] * rl * g3 * sigmoidf_(g3));
            *(GAS u32x2*)(yp + d) = w;
        }
}
}
namespace dil {
using dsa::vtr; using dsa::s16x4;
__device__ __forceinline__ void dil_unit(const MixArgs& a, float* LQ, unsigned char* ldsb, int b, int gi, int u16) {
    const int tid = opaque_tid(), lane = tid & 63, wave = __builtin_amdgcn_readfirstlane(tid >> 6), r32 = lane & 31, hi = lane >> 5;
    const int rate = (gi == 0) ? 1 : (gi == 1) ? 4 : 16, nblk = 16 / rate, c = u16 / nblk, qb = u16 % nblk;
    const int head = gi * 2 + (wave >> 2), q0 = 128 * qb + 32 * (wave & 3);
    const GAS bf16_t* zb = (const GAS bf16_t*)a.Z + (size_t)b * SEQ * ZP;
    LAS unsigned char* vimg = (LAS unsigned char*)ldsb + wave * 4096;
    f32x16 zero16;
#pragma unroll
    for (int i = 0; i < 16; ++i) zero16[i] = 0.f;
    const size_t qrow = (size_t)b * SEQ + (size_t)(q0 + r32) * rate + c;
    bf16x8 bq[4];
#pragma unroll
    for (int s = 0; s < 4; ++s) bq[s] = *(const GAS bf16x8*)((const GAS bf16_t*)a.Z + qrow * ZP + ZC_Q + head * 64 + 16 * s + 8 * hi);
    f32x16 o0 = zero16, o1 = zero16; float lsum = 0.f;
    const int g16 = lane >> 4, i16 = lane & 15, q4 = i16 >> 2, p4 = i16 & 3;
    const int vrd = ((g16 >> 1) * 4 + q4) * 64 + (16 * (g16 & 1) + 4 * p4) * 2;
    const int vwr_key = lane >> 3, vwr_ch = lane & 7;
#pragma unroll 1
    for (int ti = 0; ti < 5; ++ti) {
        const int j0 = q0 - 128 + 32 * ti;
        if (j0 < 0) continue;
        bf16x8 ak[4]; u32x4 vst[4];
#pragma unroll
        for (int s = 0; s < 4; ++s) ak[s] = *(const GAS bf16x8*)(zb + ((size_t)(j0 + r32) * rate + c) * ZP + ZC_K + head * 64 + 16 * s + 8 * hi);
#pragma unroll
        for (int i = 0; i < 4; ++i) vst[i] = *(const GAS u32x4*)(zb + ((size_t)(j0 + vwr_key + 8 * i) * rate + c) * ZP + ZC_V + head * 64 + 8 * vwr_ch);
#pragma unroll
        for (int i = 0; i < 4; ++i) *(LAS u32x4*)(vimg + (vwr_ch >> 2) * 2048 + (vwr_key + 8 * i) * 64 + (vwr_ch & 3) * 16) = vst[i];
        f32x16 sacc = MFMA32(ak[0], bq[0], zero16); sacc = MFMA32(ak[1], bq[1], sacc); sacc = MFMA32(ak[2], bq[2], sacc); sacc = MFMA32(ak[3], bq[3], sacc);
        asm volatile("s_waitcnt lgkmcnt(0)" ::: "memory");
        s16x4 va[2][2][2];
#pragma unroll
        for (int dt = 0; dt < 2; ++dt)
#pragma unroll
            for (int s = 0; s < 2; ++s) { va[dt][s][0] = vtr(vimg + dt * 2048 + (16 * s) * 64 + vrd); va[dt][s][1] = vtr(vimg + dt * 2048 + (16 * s + 8) * 64 + vrd); }
        const int dbase = q0 + r32 - j0 - 4 * hi;
        unsigned pw[8];
#pragma unroll
        for (int r = 0; r < 16; r += 2) {
            const int d0 = dbase - ((r & 3) + 8 * (r >> 2)), d1 = dbase - (((r + 1) & 3) + 8 * ((r + 1) >> 2));
            float p0 = __builtin_amdgcn_exp2f(fminf(sacc[r], 64.f)), p1 = __builtin_amdgcn_exp2f(fminf(sacc[r + 1], 64.f));
            p0 = ((unsigned)d0 <= 128u) ? p0 : 0.f; p1 = ((unsigned)d1 <= 128u) ? p1 : 0.f;
            lsum += p0 + p1;
            pw[r >> 1] = pk2(p0, p1);
        }
        asm volatile("s_waitcnt lgkmcnt(0)" ::: "memory");
#pragma unroll
        for (int s = 0; s < 2; ++s) {
            u32x4 pv4; pv4.x = pw[4 * s]; pv4.y = pw[4 * s + 1]; pv4.z = pw[4 * s + 2]; pv4.w = pw[4 * s + 3];
            const bf16x8 pb = __builtin_bit_cast(bf16x8, pv4);
            const bf16x8 v0 = __builtin_shufflevector(va[0][s][0], va[0][s][1], 0, 1, 2, 3, 4, 5, 6, 7), v1 = __builtin_shufflevector(va[1][s][0], va[1][s][1], 0, 1, 2, 3, 4, 5, 6, 7);
            o0 = MFMA32(v0, pb, o0); o1 = MFMA32(v1, pb, o1);
        }
    }
    lsum += __shfl_xor(lsum, 32);
    if (hi == 0) LQ[qrow * 8 + head] = lsum;
    GAS bf16_t* yp = (GAS bf16_t*)a.Y + qrow * DM + 640 + head * 64;
#pragma unroll
    for (int dt = 0; dt < 2; ++dt)
#pragma unroll
        for (int i = 0; i < 4; ++i) {
            const int d = 32 * dt + 8 * i + 4 * hi; const f32x16& o = dt ? o1 : o0;
            u32x2 w; w.x = pk2(o[4 * i], o[4 * i + 1]); w.y = pk2(o[4 * i + 2], o[4 * i + 3]);
            *(GAS u32x2*)(yp + d) = w;
        }
}
__device__ __forceinline__ void dil_merge(const MixArgs& a, const float* LQ, int first, int nthreads) {
    constexpr int NCH = MTOK * 48;
    for (int id0 = first; id0 < NCH; id0 += 4 * nthreads) {
        u32x4 ow[4], gw[4]; float rl[4];
#pragma unroll
        for (int j = 0; j < 4; ++j) { const int id = id0 + j * nthreads; if (id < NCH) { const int row = id / 48, ch = id % 48;
            ow[j] = *(const GAS u32x4*)((const GAS bf16_t*)a.Y + (size_t)row * DM + 640 + ch * 8); gw[j] = *(const GAS u32x4*)((const GAS bf16_t*)a.Z + (size_t)row * ZP + ZC_G + ch * 8);
            const float* lq = LQ + (size_t)row * 8 + ((ch >> 3) & 1); rl[j] = lq[0] + lq[2] + lq[4]; } }
#pragma unroll
        for (int j = 0; j < 4; ++j) { const int id = id0 + j * nthreads; if (id < NCH) { const int row = id / 48, ch = id % 48; const float r = __builtin_amdgcn_rcpf(rl[j]);
            const unsigned o4[4] = {ow[j].x, ow[j].y, ow[j].z, ow[j].w}, g4[4] = {gw[j].x, gw[j].y, gw[j].z, gw[j].w}; unsigned w4[4];
#pragma unroll
            for (int k = 0; k < 4; ++k) { const float g0 = bflo(g4[k]), g1 = bfhi(g4[k]); w4[k] = pk2(bflo(o4[k]) * r * g0 * sigmoidf_(g0), bfhi(o4[k]) * r * g1 * sigmoidf_(g1)); }
            u32x4 w; w.x = w4[0]; w.y = w4[1]; w.z = w4[2]; w.w = w4[3]; *(GAS u32x4*)((GAS bf16_t*)a.Y + (size_t)row * DM + 640 + ch * 8) = w; } }
    }
}
}
namespace rwkv {
#ifdef PROBE_T
#define RTS ((volatile LAS unsigned long long*)((LAS unsigned char*)ldsb + 131072 + 1024))
#define RST(id_end, id_begin) do { if (blockIdx.x == 0 && threadIdx.x == 0) { const unsigned long long now_ = __builtin_amdgcn_s_memrealtime(); if ((id_end) == PROBE_T) RTS[1] += now_ - RTS[0]; if ((id_begin) == PROBE_T) RTS[0] = now_; } } while (0)
#else
#define RST(a, b) do {} while (0)
#endif
using dsa::vtr; using dsa::s16x4;
constexpr int IP = 144;
constexpr int IMG = 64 * IP;
constexpr int S_WD = 0 * IMG, S_AD = 1 * IMG, S_V = 2 * IMG, S_AT = 3 * IMG, S_BH = 4 * IMG, S_KH = 5 * IMG, S_RT = 6 * IMG, S_KB = 7 * IMG, S_BB = 8 * IMG, S_ARB = 9 * IMG, S_AH = 10 * IMG, S_UV = 11 * IMG;
constexpr int S_AAK = S_WD, S_ARK = S_AD, S_TT = S_BH, S_W1 = S_KH;
constexpr int F_AAB = 12 * IMG;
constexpr int F_LG = S_ARB;
constexpr int F_TOT = F_AAB + 16384;
static_assert(F_TOT + 512 <= 131072 && F_LG + 16384 <= F_AAB, "rwkv LDS map");

struct RArgs { const float* mu; const float* w0; const float* a0; const float* k_k; const float* k_a; const float* r_k; const float* ln_g; const float* ln_b;
               const bf16_t* wupT; const bf16_t* aupT; bf16_t* RQ; bf16_t* RM; bf16_t* RN; float* RG; float* RB; };

__device__ __forceinline__ bf16x8 rowfrag(const LAS unsigned char* img, int r0, int k0, int r32, int hi) { return *(const LAS bf16x8*)(img + (r0 + r32) * IP + (k0 + 8 * hi) * 2); }
__device__ __forceinline__ bf16x8 colfrag(const LAS unsigned char* img, int c0, int k0, int lane) {
    const int g16 = lane >> 4, i16 = lane & 15;
    const LAS unsigned char* p = img + (k0 + 8 * (g16 >> 1) + (i16 >> 2)) * IP + (c0 + 16 * (g16 & 1) + 4 * (i16 & 3)) * 2;
    const s16x4 lo = vtr(p), hi4 = vtr(p + 4 * IP);
    return __builtin_shufflevector(lo, hi4, 0, 1, 2, 3, 4, 5, 6, 7);
}
__device__ __forceinline__ bf16x8 colfrag_perm(const LAS unsigned char* img, int c0, int k0, int lane) {
    const int g16 = lane >> 4, i16 = lane & 15;
    const LAS unsigned char* p = img + (k0 + 4 * (g16 >> 1) + (i16 >> 2)) * IP + (c0 + 16 * (g16 & 1) + 4 * (i16 & 3)) * 2;
    const s16x4 lo = vtr(p), hi4 = vtr(p + 8 * IP);
    return __builtin_shufflevector(lo, hi4, 0, 1, 2, 3, 4, 5, 6, 7);
}
__device__ __forceinline__ bf16x8 rowfrag_f32(const LAS float* img, int r0, int k0, int r32, int hi) {
    const LAS f32x4* p = (const LAS f32x4*)(img + (r0 + r32) * 64 + k0 + 8 * hi); const f32x4 a = p[0], b = p[1];
    u32x4 w; w.x = pk2(a[0], a[1]); w.y = pk2(a[2], a[3]); w.z = pk2(b[0], b[1]); w.w = pk2(b[2], b[3]); return __builtin_bit_cast(bf16x8, w);
}
__device__ __forceinline__ void store_T(LAS unsigned char* imgT, const f32x16& c, int r0, int c0, int r32, int hi) {
#pragma unroll
    for (int g = 0; g < 4; ++g) { u32x2 w; w.x = pk2(c[4 * g], c[4 * g + 1]); w.y = pk2(c[4 * g + 2], c[4 * g + 3]); *(LAS u32x2*)(imgT + (c0 + r32) * IP + (r0 + 8 * g + 4 * hi) * 2) = w; }
}
__device__ __forceinline__ void store_T_global(GAS bf16_t* gT  , const f32x16& c, int r0, int c0, int r32, int hi) {
#pragma unroll
    for (int g = 0; g < 4; ++g) { u32x2 w; w.x = pk2(c[4 * g], c[4 * g + 1]); w.y = pk2(c[4 * g + 2], c[4 * g + 3]); *(GAS u32x2*)(gT + (c0 + r32) * 64 + r0 + 8 * g + 4 * hi) = w; }
}
__device__ __forceinline__ void store_T_global_wt(GAS bf16_t* gT, const f32x16& c, int r0, int c0, int r32, int hi) {
#pragma unroll
    for (int g = 0; g < 4; ++g) { const unsigned long long w = (unsigned long long)pk2(c[4 * g], c[4 * g + 1]) | ((unsigned long long)pk2(c[4 * g + 2], c[4 * g + 3]) << 32);
        __hip_atomic_store((GAS unsigned long long*)(gT + (c0 + r32) * 64 + r0 + 8 * g + 4 * hi), w, __ATOMIC_RELAXED, __HIP_MEMORY_SCOPE_AGENT); }
}
__device__ __forceinline__ f32x16 zero16() { f32x16 z;
#pragma unroll
    for (int i = 0; i < 16; ++i) z[i] = 0.f;
    return z; }
#define WSYNC() asm volatile("s_waitcnt lgkmcnt(0)" ::: "memory")
#define BAR() do { asm volatile("s_waitcnt lgkmcnt(0)" ::: "memory"); __builtin_amdgcn_s_barrier(); asm volatile("" ::: "memory"); } while (0)

constexpr int R1_STG = S_AT;
constexpr int R1_SAVE = 131072 + 2048, R1_PAR = R1_SAVE + 1024, R1_WUP = R1_PAR + 2560, R1_AUP = R1_WUP + IMG;
struct R1Raw { u32x4 c[5]; };
__device__ __forceinline__ void r1_load(const MixArgs& a, R1Raw& raw, int tid, int b, int h, int ck) {
    const int et = tid >> 3, ec = (tid & 7) * 8, hc = h * 64 + ec;
    const GAS bf16_t* zr = (const GAS bf16_t*)a.Z + ((size_t)b * SEQ + ck * 64 + et) * ZP;
    const int cols[5] = {ZA_R + hc, ZA_K + hc, ZA_V + hc, ZA_WD + ec, ZA_AD + ec};
#pragma unroll
    for (int i = 0; i < 5; ++i) raw.c[i] = *(const GAS u32x4*)(zr + cols[i]);
}
__device__ __forceinline__ void r1_load_params(const RArgs& ra, unsigned char* ldsb, int tid, int h) {
    LAS float* par = (LAS float*)((LAS unsigned char*)ldsb + R1_PAR);
    for (int i = tid; i < 640; i += 512) { const int g = i >> 6, c = i & 63; float v;
        if (g == 0) v = ra.mu[ZA_R + h * 64 + c]; else if (g == 1) v = ra.mu[ZA_K + h * 64 + c]; else if (g == 2) v = ra.mu[ZA_V + h * 64 + c]; else if (g == 3) v = ra.mu[ZA_WD + c]; else if (g == 4) v = ra.mu[ZA_AD + c];
        else if (g == 5) v = ra.w0[h * 64 + c]; else if (g == 6) v = ra.a0[h * 64 + c]; else if (g == 7) v = ra.k_k[h * 64 + c]; else if (g == 8) v = ra.k_a[h * 64 + c]; else v = ra.r_k[h * 64 + c];
        par[i] = v; }
    for (int ch = tid; ch < 1024; ch += 512) { const int m = ch >> 9, row = (ch >> 3) & 63, c8 = ch & 7;
        *(LAS u32x4*)((LAS unsigned char*)ldsb + (m ? R1_AUP : R1_WUP) + row * IP + c8 * 16) = *(const GAS u32x4*)((const GAS bf16_t*)(m ? ra.aupT : ra.wupT) + (size_t)(h * 64 + row) * 64 + c8 * 8); }
}
static_assert(65 * 640 <= 5 * IMG, "staging fits");
__device__ __forceinline__ void rwkv_chunk_unit(const MixArgs& a, const RArgs& ra, unsigned char* ldsb, int b, int h, int ck, R1Raw& raw, int prev_mode, bool has_next, int nb, int nh, int nck) {
    const int tid = opaque_tid(), lane = tid & 63, wave = __builtin_amdgcn_readfirstlane(tid >> 6), r32 = lane & 31, hi = lane >> 5;
    LAS unsigned char* L = (LAS unsigned char*)ldsb;
    LAS float* fETA = (LAS float*)(L + F_AAB); LAS float* fAAB = fETA; LAS float* fLG = (LAS float*)(L + F_LG); LAS float* fTOT = (LAS float*)(L + F_TOT);
    const int t0 = ck * 64;
    const size_t row0 = (size_t)b * SEQ + t0;
    const int unit = (b * 6 + h) * 32 + ck;
    RST(-1, 50);
    const int et = tid >> 3, ec = (tid & 7) * 8, hc = h * 64 + ec;
    const LAS float* par = (const LAS float*)(L + R1_PAR);
    float r8[8], k8[8];
    {
        {
            LAS unsigned char* stg = L + R1_STG;
#pragma unroll
            for (int i = 0; i < 5; ++i) *(LAS u32x4*)(stg + (et + 1) * 640 + i * 128 + (tid & 7) * 16) = raw.c[i];
            if (et == 0) {
                const int hc0 = h * 64 + ec; const int cols[5] = {ZA_R + hc0, ZA_K + hc0, ZA_V + hc0, ZA_WD + ec, ZA_AD + ec};
#pragma unroll
                for (int i = 0; i < 5; ++i) { u32x4 pv = zero_u32x4();
                    if (prev_mode == 1) pv = *(const LAS u32x4*)(L + R1_SAVE + i * 128 + (tid & 7) * 16);
                    else if (prev_mode == 2) pv = *(const GAS u32x4*)((const GAS bf16_t*)a.Z + (row0 - 1) * ZP + cols[i]);
                    *(LAS u32x4*)(stg + i * 128 + (tid & 7) * 16) = pv; }
            }
        }
        BAR();
        if (et == 63) {
#pragma unroll
            for (int i = 0; i < 5; ++i) *(LAS u32x4*)(L + R1_SAVE + i * 128 + (tid & 7) * 16) = raw.c[i];
        }
        auto mix8 = [&](int i, int col, float* out) {
            const u32x4 cw = raw.c[i], pw = *(const LAS u32x4*)(L + R1_STG + et * 640 + i * 128 + (tid & 7) * 16);
            const f32x4 m0 = *(const LAS f32x4*)(par + i * 64 + ec), m1 = *(const LAS f32x4*)(par + i * 64 + ec + 4); (void)col;
            const float cv[8] = {bflo(cw.x), bfhi(cw.x), bflo(cw.y), bfhi(cw.y), bflo(cw.z), bfhi(cw.z), bflo(cw.w), bfhi(cw.w)};
            const float pv[8] = {bflo(pw.x), bfhi(pw.x), bflo(pw.y), bfhi(pw.y), bflo(pw.z), bfhi(pw.z), bflo(pw.w), bfhi(pw.w)};
            const float mv[8] = {m0[0], m0[1], m0[2], m0[3], m1[0], m1[1], m1[2], m1[3]};
#pragma unroll
            for (int j = 0; j < 8; ++j) out[j] = cv[j] + (pv[j] - cv[j]) * mv[j];
        };
        float v8[8], wd8[8], ad8[8];
        mix8(0, ZA_R + hc, r8); mix8(1, ZA_K + hc, k8); mix8(2, ZA_V + hc, v8); mix8(3, ZA_WD + ec, wd8); mix8(4, ZA_AD + ec, ad8);
#pragma unroll
        for (int i = 0; i < 8; ++i) wd8[i] = tanhf_(wd8[i]);
        u32x4 w;
        w.x = pk2(wd8[0], wd8[1]); w.y = pk2(wd8[2], wd8[3]); w.z = pk2(wd8[4], wd8[5]); w.w = pk2(wd8[6], wd8[7]); *(LAS u32x4*)(L + S_WD + et * IP + ec * 2) = w;
        w.x = pk2(ad8[0], ad8[1]); w.y = pk2(ad8[2], ad8[3]); w.z = pk2(ad8[4], ad8[5]); w.w = pk2(ad8[6], ad8[7]); *(LAS u32x4*)(L + S_AD + et * IP + ec * 2) = w;
        w.x = pk2(v8[0], v8[1]); w.y = pk2(v8[2], v8[3]); w.z = pk2(v8[4], v8[5]); w.w = pk2(v8[6], v8[7]); *(LAS u32x4*)(L + S_V + et * IP + ec * 2) = w;
    }
    BAR();
    RST(50, 51);
    const int q = wave & 3, tr = q >> 1, tc = q & 1, grp = wave >> 2;
    {
        const LAS unsigned char* Aimg = L + (grp ? S_AD : S_WD);
        f32x16 acc = zero16();
#pragma unroll
        for (int s = 0; s < 4; ++s) acc = MFMA32(rowfrag(Aimg, 32 * tr, 16 * s, r32, hi), rowfrag(L + (grp ? R1_AUP : R1_WUP), 32 * tc, 16 * s, r32, hi), acc);
        const int c = 32 * tc + r32; const float bias = par[(grp ? 6 : 5) * 64 + c];
        if (grp == 0) {
            float x[16], gs[4];
#pragma unroll
            for (int i = 0; i < 16; ++i) x[i] = -DECAY_SCALE * sigmoidf_(acc[i] + bias);
#pragma unroll
            for (int g = 0; g < 4; ++g) gs[g] = (x[4 * g] + x[4 * g + 1]) + (x[4 * g + 2] + x[4 * g + 3]);
            float run = 0.f;
#pragma unroll
            for (int g = 0; g < 4; ++g) { const float other = __shfl_xor(gs[g], 32); float base = run + (hi ? other : 0.f); run += gs[g] + other;
#pragma unroll
                for (int j = 0; j < 4; ++j) { base += x[4 * g + j]; fLG[(32 * tr + 8 * g + 4 * hi + j) * 64 + c] = base; } }
            if (tr == 0 && hi == 0) fTOT[c] = run;
        } else {
#pragma unroll
            for (int i = 0; i < 16; ++i) fETA[(32 * tr + (i & 3) + 8 * (i >> 2) + 4 * hi) * 64 + c] = sigmoidf_(acc[i] + bias);
        }
    }
    BAR();
    RST(51, 52);
    {
        const f32x4 l0 = *(const LAS f32x4*)(fLG + et * 64 + ec), l1 = *(const LAS f32x4*)(fLG + et * 64 + ec + 4);
        f32x4 p0 = {0.f, 0.f, 0.f, 0.f}, p1 = p0; if (et > 0) { p0 = *(const LAS f32x4*)(fLG + (et - 1) * 64 + ec); p1 = *(const LAS f32x4*)(fLG + (et - 1) * 64 + ec + 4); }
        const f32x4 e0 = *(const LAS f32x4*)(fETA + et * 64 + ec), e1 = *(const LAS f32x4*)(fETA + et * 64 + ec + 4);
        const f32x4 z0 = *(const LAS f32x4*)(fLG + 63 * 64 + ec), z1 = *(const LAS f32x4*)(fLG + 63 * 64 + ec + 4);
        const f32x4 u0 = *(const LAS f32x4*)(fTOT + ec), u1 = *(const LAS f32x4*)(fTOT + ec + 4);
        float lg[8] = {l0[0], l0[1], l0[2], l0[3], l1[0], l1[1], l1[2], l1[3]}, lp[8] = {p0[0], p0[1], p0[2], p0[3], p1[0], p1[1], p1[2], p1[3]};
        const float eta[8] = {e0[0], e0[1], e0[2], e0[3], e1[0], e1[1], e1[2], e1[3]}, tot[8] = {u0[0], u0[1], u0[2], u0[3], u1[0], u1[1], u1[2], u1[3]};
        float lC[8] = {z0[0], z0[1], z0[2], z0[3], z1[0], z1[1], z1[2], z1[3]};
        float kk[8], kp[8], ss = 0.f, bsum = 0.f;
#pragma unroll
        for (int i = 0; i < 8; ++i) {
            if (et >= 32) lg[i] += tot[i]; if (et >= 33) lp[i] += tot[i]; lC[i] += tot[i];
            kk[i] = k8[i] * par[7 * 64 + ec + i]; ss += kk[i] * kk[i];
            kp[i] = k8[i] * (1.f + (eta[i] - 1.f) * par[8 * 64 + ec + i]); bsum += r8[i] * kp[i] * par[9 * 64 + ec + i];
        }
        ss += __shfl_xor(ss, 1); ss += __shfl_xor(ss, 2); ss += __shfl_xor(ss, 4);
        bsum += __shfl_xor(bsum, 1); bsum += __shfl_xor(bsum, 2); bsum += __shfl_xor(bsum, 4);
        const float rn = __builtin_amdgcn_rsqf(fmaxf(ss, 1e-24f));
        if ((tid & 7) == 0) ra.RB[(row0 + et) * 8 + h] = bsum;
        if (et == 63) { f32x4 g0 = {fexp_(lC[0]), fexp_(lC[1]), fexp_(lC[2]), fexp_(lC[3])}, g1 = {fexp_(lC[4]), fexp_(lC[5]), fexp_(lC[6]), fexp_(lC[7])};
            *(f32x4*)(ra.RG + (size_t)unit * 64 + ec) = g0; *(f32x4*)(ra.RG + (size_t)unit * 64 + ec + 4) = g1; }
#pragma unroll
        for (int i = 0; i < 8; i += 2) {
            float vat[2], vbh[2], vkh[2], vrt[2], vkb[2], vbb[2];
#pragma unroll
            for (int j = 0; j < 2; ++j) { const int c = i + j;
                const float kn = kk[c] * rn, bv = kn * eta[c];
                const float ig = fexp_(-lg[c]), gC = fexp_(lC[c] - lg[c]);
                vat[j] = -kn * fexp_(lp[c]); vbh[j] = bv * ig; vkh[j] = kp[c] * ig; vrt[j] = r8[c] * fexp_(lg[c]); vkb[j] = kp[c] * gC; vbb[j] = bv * gC; }
            const int off = et * IP + (ec + i) * 2;
            *(LAS unsigned*)(L + S_AT + off) = pk2(vat[0], vat[1]); *(LAS unsigned*)(L + S_BH + off) = pk2(vbh[0], vbh[1]); *(LAS unsigned*)(L + S_KH + off) = pk2(vkh[0], vkh[1]);
            *(LAS unsigned*)(L + S_RT + off) = pk2(vrt[0], vrt[1]); *(LAS unsigned*)(L + S_KB + off) = pk2(vkb[0], vkb[1]); *(LAS unsigned*)(L + S_BB + off) = pk2(vbb[0], vbb[1]);
        }
    }
    BAR();
    RST(52, 53);
    if (has_next) r1_load(a, raw, tid, nb, nh, nck);
    {
        const LAS unsigned char* Aimg = L + (grp ? S_RT : S_AT);
        f32x16 c1 = zero16(), c2 = zero16();
        if (!(tr == 0 && tc == 1)) {
#pragma unroll
            for (int s = 0; s < 4; ++s) { const bf16x8 af = rowfrag(Aimg, 32 * tr, 16 * s, r32, hi);
                c1 = MFMA32(af, rowfrag(L + S_BH, 32 * tc, 16 * s, r32, hi), c1); c2 = MFMA32(af, rowfrag(L + S_KH, 32 * tc, 16 * s, r32, hi), c2); }
        }
        const int ci = 32 * tc + r32;
#pragma unroll
        for (int i = 0; i < 16; ++i) { const int t = 32 * tr + (i & 3) + 8 * (i >> 2) + 4 * hi; const bool keep = grp ? (ci <= t) : (ci < t); if (!keep) { c1[i] = 0.f; c2[i] = 0.f; } }
        if (grp == 0) {
#pragma unroll
            for (int i = 0; i < 16; ++i) fAAB[(32 * tr + (i & 3) + 8 * (i >> 2) + 4 * hi) * 64 + ci] = c1[i];
            store_T(L + S_AAK, c2, 32 * tr, 32 * tc, r32, hi);
        } else { store_T(L + S_ARB, c1, 32 * tr, 32 * tc, r32, hi); store_T(L + S_ARK, c2, 32 * tr, 32 * tc, r32, hi); }
    }
    BAR();
    RST(53, 54);
    f32x16 nacc = zero16(), yacc = zero16();
    if (grp == 0) {
        const int bk = wave;
        float d[16];
        if (lane < 16) {
#pragma unroll
            for (int t = 0; t < 16; ++t) { float s = (t == lane) ? 1.f : 0.f;
#pragma unroll
                for (int i = 0; i < 16; ++i) if (i < t) s += fAAB[(16 * bk + t) * 64 + 16 * bk + i] * d[i];
                d[t] = s; }
        }
        if (lane < 16) {
            LAS unsigned char* rowp = L + S_TT + (16 * bk + lane) * IP;
#pragma unroll
            for (int cb = 0; cb < 4; ++cb) { u32x4 w0, w1;
                if (cb == bk) { w0.x = pk2(d[0], d[1]); w0.y = pk2(d[2], d[3]); w0.z = pk2(d[4], d[5]); w0.w = pk2(d[6], d[7]); w1.x = pk2(d[8], d[9]); w1.y = pk2(d[10], d[11]); w1.z = pk2(d[12], d[13]); w1.w = pk2(d[14], d[15]); }
                else { w0 = zero_u32x4(); w1 = w0; }
                *(LAS u32x4*)(rowp + cb * 32) = w0; *(LAS u32x4*)(rowp + cb * 32 + 16) = w1; }
        }
    } else {
        f32x16 c = zero16();
#pragma unroll
        for (int s = 0; s < 4; ++s) c = MFMA32(colfrag(L + S_AAK, 32 * tr, 16 * s, lane), colfrag(L + S_V, 32 * tc, 16 * s, lane), c);
        store_T(L + S_W1, c, 32 * tr, 32 * tc, r32, hi);
    }
    BAR();
    if (grp == 0) {
        if (wave < 2) { const int p = 2 * wave;
            f32x16 x = MFMA32(rowfrag_f32(fAAB, 16 * (p + 1), 16 * p, r32, hi), rowfrag(L + S_TT, 16 * p, 16 * p, r32, hi), zero16());
            u32x4 xw; xw.x = pk2(x[0], x[1]); xw.y = pk2(x[2], x[3]); xw.z = pk2(x[4], x[5]); xw.w = pk2(x[6], x[7]);
            const f32x16 tb = MFMA32(colfrag_perm(L + S_TT, 16 * (p + 1), 16 * (p + 1), lane), __builtin_bit_cast(bf16x8, xw), zero16());
            if (r32 < 16) {
#pragma unroll
                for (int g = 0; g < 2; ++g) { u32x2 w; w.x = pk2(tb[4 * g], tb[4 * g + 1]); w.y = pk2(tb[4 * g + 2], tb[4 * g + 3]); *(LAS u32x2*)(L + S_TT + (16 * p + r32) * IP + (16 * (p + 1) + 8 * g + 4 * hi) * 2) = w; } }
        }
    } else {
#pragma unroll
        for (int s = 0; s < 4; ++s) { const bf16x8 vf = colfrag(L + S_V, 32 * tr, 16 * s, lane);
            nacc = MFMA32(colfrag(L + S_KB, 32 * tr, 16 * s, lane), colfrag(L + S_V, 32 * tc, 16 * s, lane), nacc);
            yacc = MFMA32(vf, colfrag(L + S_ARK, 32 * tc, 16 * s, lane), yacc); }
    }
    BAR();
    if (wave == 0) {
        f32x16 x = zero16();
#pragma unroll
        for (int s = 0; s < 2; ++s) x = MFMA32(rowfrag_f32(fAAB, 32, 16 * s, r32, hi), rowfrag(L + S_TT, 0, 16 * s, r32, hi), x);
        f32x16 tb = zero16();
#pragma unroll
        for (int s = 0; s < 2; ++s) { u32x4 xw; xw.x = pk2(x[8 * s], x[8 * s + 1]); xw.y = pk2(x[8 * s + 2], x[8 * s + 3]); xw.z = pk2(x[8 * s + 4], x[8 * s + 5]); xw.w = pk2(x[8 * s + 6], x[8 * s + 7]);
            tb = MFMA32(colfrag_perm(L + S_TT, 32, 32 + 16 * s, lane), __builtin_bit_cast(bf16x8, xw), tb); }
        store_T(L + S_TT, tb, 32, 0, r32, hi);
    }
    BAR();
    RST(54, 55);
    {
        f32x16 c = zero16();
#pragma unroll
        for (int s = 0; s < 4; ++s) { const bf16x8 tf = colfrag(L + S_TT, 32 * tr, 16 * s, lane);
            c = MFMA32(tf, grp ? rowfrag(L + S_W1, 32 * tc, 16 * s, r32, hi) : colfrag(L + S_AT, 32 * tc, 16 * s, lane), c); }
        store_T(L + (grp ? S_UV : S_AH), c, 32 * tr, 32 * tc, r32, hi);
    }
    BAR();
    RST(55, 56);
    {
        const LAS unsigned char* Aimg = L + (grp ? S_UV : S_AH);
        f32x16 c1 = grp ? nacc : zero16(), c2 = grp ? yacc : zero16();
#pragma unroll
        for (int s = 0; s < 4; ++s) { const bf16x8 af = rowfrag(Aimg, 32 * tr, 16 * s, r32, hi);
            if (grp) c1 = MFMA32(colfrag(L + S_BB, 32 * tr, 16 * s, lane), rowfrag(L + S_UV, 32 * tc, 16 * s, r32, hi), c1);
            else c1 = MFMA32(af, colfrag(L + S_BB, 32 * tc, 16 * s, lane), c1);
            c2 = MFMA32(af, colfrag(L + S_ARB, 32 * tc, 16 * s, lane), c2); }
        GAS bf16_t* gq = (GAS bf16_t*)ra.RQ + (size_t)unit * 4096; GAS bf16_t* gm = (GAS bf16_t*)ra.RM + (size_t)unit * 4096; GAS bf16_t* gn = (GAS bf16_t*)ra.RN + (size_t)unit * 4096;
        if (grp == 0) {
            store_T_global(gm, c1, 32 * tr, 32 * tc, r32, hi);
#pragma unroll
            for (int g = 0; g < 4; ++g) { const u32x2 w = *(const LAS u32x2*)(L + S_RT + (32 * tc + r32) * IP + (32 * tr + 8 * g + 4 * hi) * 2);
                c2[4 * g] += bflo(w.x); c2[4 * g + 1] += bfhi(w.x); c2[4 * g + 2] += bflo(w.y); c2[4 * g + 3] += bfhi(w.y); }
            store_T_global(gq, c2, 32 * tr, 32 * tc, r32, hi);
        } else {
            store_T_global(gn, c1, 32 * tr, 32 * tc, r32, hi);
            GAS bf16_t* yp = (GAS bf16_t*)a.Y + (row0 + 32 * tc + r32) * DM + h * 64 + 32 * tr;
#pragma unroll
            for (int g = 0; g < 4; ++g) { u32x2 w; w.x = pk2(c2[4 * g], c2[4 * g + 1]); w.y = pk2(c2[4 * g + 2], c2[4 * g + 3]); *(GAS u32x2*)(yp + 8 * g + 4 * hi) = w; }
        }
    }
    BAR();
    RST(56, -1);
}

constexpr int R2_D = 6, R2_SLOT = 16640, R2_RING = 2 * IMG;
__device__ __forceinline__ void rwkv_scan_chain(const RArgs& ra, unsigned char* ldsb, int b, int h, unsigned* flag  ) {
    const int tid = opaque_tid(), lane = tid & 63, wave = __builtin_amdgcn_readfirstlane(tid >> 6), r32 = lane & 31, hi = lane >> 5;
    LAS unsigned char* L = (LAS unsigned char*)ldsb;
    const int q = wave & 3, tr = q >> 1, tc = q & 1;
    f32x16 st = zero16();
    for (int i = tid; i < 2 * IMG / 16; i += 512) { *(LAS u32x4*)(L + i * 16) = zero_u32x4(); }
    const int ubase = (b * 6 + h) * 32;
    auto issue = [&](int step) {
        const int unit = ubase + step; LAS unsigned char* slot = L + R2_RING + (step % R2_D) * R2_SLOT; const int lw = wave - 4;
        const GAS unsigned char* gm = (const GAS unsigned char*)ra.RM + (size_t)unit * 8192 + lane * 16; const GAS unsigned char* gn = (const GAS unsigned char*)ra.RN + (size_t)unit * 8192 + lane * 16;
#pragma unroll
        for (int p = 0; p < 2; ++p) {
            __builtin_amdgcn_global_load_lds((const GAS unsigned*)(gm + (2 * lw + p) * 1024), (LAS unsigned*)(slot + (2 * lw + p) * 1024), 16, 0, 0);
            __builtin_amdgcn_global_load_lds((const GAS unsigned*)(gn + (2 * lw + p) * 1024), (LAS unsigned*)(slot + 8192 + (2 * lw + p) * 1024), 16, 0, 0);
        }
        if (lw == 0) __builtin_amdgcn_global_load_lds((const GAS unsigned*)((const GAS unsigned char*)ra.RG + (size_t)unit * 256 + lane * 4), (LAS unsigned*)(slot + 16384), 4, 0, 0);
    };
    if (wave >= 4) {
#pragma unroll 1
        for (int s0 = 0; s0 < R2_D - 1; ++s0) issue(s0);
        asm volatile("s_waitcnt vmcnt(0)" ::: "memory");
    }
    asm volatile("s_waitcnt lgkmcnt(0)" ::: "memory"); __builtin_amdgcn_s_barrier();
#pragma unroll 1
    for (int ck = 0; ck < 32; ++ck) {
        const LAS unsigned char* Simg = L + (ck & 1) * IMG; LAS unsigned char* Snew = L + ((ck + 1) & 1) * IMG;
        if (wave < 4) {
            const int unit = ubase + ck; const LAS unsigned char* slot = L + R2_RING + (ck % R2_D) * R2_SLOT;
            f32x16 acc;
#pragma unroll
            for (int g = 0; g < 4; ++g) { const u32x2 nw = *(const LAS u32x2*)(slot + 8192 + (32 * tc + r32) * 128 + (32 * tr + 8 * g + 4 * hi) * 2); const f32x4 gc = *(const LAS f32x4*)(slot + 16384 + (32 * tr + 8 * g + 4 * hi) * 4);
                acc[4 * g] = st[4 * g] * gc[0] + bflo(nw.x); acc[4 * g + 1] = st[4 * g + 1] * gc[1] + bfhi(nw.x); acc[4 * g + 2] = st[4 * g + 2] * gc[2] + bflo(nw.y); acc[4 * g + 3] = st[4 * g + 3] * gc[3] + bfhi(nw.y); }
#pragma unroll
            for (int s = 0; s < 4; ++s) acc = MFMA32(*(const LAS bf16x8*)(slot + (32 * tr + r32) * 128 + (16 * s + 8 * hi) * 2), rowfrag(Simg, 32 * tc, 16 * s, r32, hi), acc);
            store_T_global((GAS bf16_t*)ra.RM + (size_t)unit * 4096, st, 32 * tr, 32 * tc, r32, hi);
            st = acc;
            store_T(Snew, st, 32 * tr, 32 * tc, r32, hi);
            asm volatile("s_waitcnt lgkmcnt(0)" ::: "memory");
        } else {
            if (ck + R2_D - 1 < 32) { issue(ck + R2_D - 1);
                if (wave == 4) asm volatile("s_waitcnt vmcnt(20)" ::: "memory"); else asm volatile("s_waitcnt vmcnt(16)" ::: "memory"); }
            else asm volatile("s_waitcnt vmcnt(0)" ::: "memory");
        }
        __builtin_amdgcn_s_barrier();
    }
    asm volatile("s_waitcnt vmcnt(0) lgkmcnt(0)" ::: "memory"); __syncthreads();
    (void)flag;
}
__device__ __forceinline__ void r3_wait(const unsigned* flags, int chain0, int ck, int tid) {
    if (tid < 64) {
        const unsigned* f = flags + (size_t)(chain0 + (tid & 3)) * 64;
        for (unsigned spins = 0; spins < (1u << 22); ++spins) {
            const bool ok = __hip_atomic_load((const GAS unsigned*)f, __ATOMIC_RELAXED, __HIP_MEMORY_SCOPE_AGENT) > (unsigned)ck;
            if (__all(ok)) break;
            __builtin_amdgcn_s_sleep(4);
        }
        __builtin_amdgcn_fence(__ATOMIC_ACQUIRE, "agent");
        asm volatile("s_waitcnt vmcnt(0)" ::: "memory");
    }
}
constexpr int RP = 136, RTILE = 64 * RP, R3_TEAM_LDS = 3 * RTILE;
__device__ __forceinline__ void rwkv_out_unit(const MixArgs& a, const RArgs& ra, unsigned char* ldsb, int b, int h, int ck) {
    const int tid = opaque_tid(), lane = tid & 63, wave = __builtin_amdgcn_readfirstlane(tid >> 6), r32 = lane & 31, hi = lane >> 5;
    const int tw = wave & 1, tt = tid & 127;
    LAS unsigned char* TL = (LAS unsigned char*)ldsb + (wave >> 1) * R3_TEAM_LDS;
    LAS unsigned char* VM = TL, *SG = TL + RTILE, *YC = TL + 2 * RTILE;
    const int unit = (b * 6 + h) * 32 + ck;
    const size_t row0 = (size_t)b * SEQ + ck * 64;
#pragma unroll
    for (int j = 0; j < 4; ++j) {
        const int c = tt + 128 * j, t = c >> 3, c8 = (c & 7) * 8, hc = h * 64 + c8;
        const GAS bf16_t* zr = (const GAS bf16_t*)a.Z + (row0 + t) * ZP; const bool hp = (ck * 64 + t) > 0;
        const u32x4 vc = *(const GAS u32x4*)(zr + ZA_V + hc), gcw = *(const GAS u32x4*)(zr + ZA_G + hc);
        u32x4 vp = zero_u32x4(), gp = vp; if (hp) { vp = *(const GAS u32x4*)(zr - ZP + ZA_V + hc); gp = *(const GAS u32x4*)(zr - ZP + ZA_G + hc); }
        const u32x4 yc = *(const GAS u32x4*)((const GAS bf16_t*)a.Y + (row0 + t) * DM + hc);
        const f32x4 mv0 = *(const f32x4*)(ra.mu + ZA_V + hc), mv1 = *(const f32x4*)(ra.mu + ZA_V + hc + 4), mg0 = *(const f32x4*)(ra.mu + ZA_G + hc), mg1 = *(const f32x4*)(ra.mu + ZA_G + hc + 4);
        const float vcur[8] = {bflo(vc.x), bfhi(vc.x), bflo(vc.y), bfhi(vc.y), bflo(vc.z), bfhi(vc.z), bflo(vc.w), bfhi(vc.w)}, vprv[8] = {bflo(vp.x), bfhi(vp.x), bflo(vp.y), bfhi(vp.y), bflo(vp.z), bfhi(vp.z), bflo(vp.w), bfhi(vp.w)};
        const float gcur[8] = {bflo(gcw.x), bfhi(gcw.x), bflo(gcw.y), bfhi(gcw.y), bflo(gcw.z), bfhi(gcw.z), bflo(gcw.w), bfhi(gcw.w)}, gprv[8] = {bflo(gp.x), bfhi(gp.x), bflo(gp.y), bfhi(gp.y), bflo(gp.z), bfhi(gp.z), bflo(gp.w), bfhi(gp.w)};
        const float muv[8] = {mv0[0], mv0[1], mv0[2], mv0[3], mv1[0], mv1[1], mv1[2], mv1[3]}, mug[8] = {mg0[0], mg0[1], mg0[2], mg0[3], mg1[0], mg1[1], mg1[2], mg1[3]};
        float vm[8], sg[8];
#pragma unroll
        for (int i = 0; i < 8; ++i) { vm[i] = vcur[i] + (vprv[i] - vcur[i]) * muv[i]; const float gg = gcur[i] + (gprv[i] - gcur[i]) * mug[i]; sg[i] = gg * sigmoidf_(gg); }
        u32x4 w; w.x = pk2(vm[0], vm[1]); w.y = pk2(vm[2], vm[3]); w.z = pk2(vm[4], vm[5]); w.w = pk2(vm[6], vm[7]);
        *(LAS u32x2*)(VM + t * RP + c8 * 2) = (u32x2){w.x, w.y}; *(LAS u32x2*)(VM + t * RP + c8 * 2 + 8) = (u32x2){w.z, w.w};
        w.x = pk2(sg[0], sg[1]); w.y = pk2(sg[2], sg[3]); w.z = pk2(sg[4], sg[5]); w.w = pk2(sg[6], sg[7]);
        *(LAS u32x2*)(SG + t * RP + c8 * 2) = (u32x2){w.x, w.y}; *(LAS u32x2*)(SG + t * RP + c8 * 2 + 8) = (u32x2){w.z, w.w};
        *(LAS u32x2*)(YC + t * RP + c8 * 2) = (u32x2){yc.x, yc.y}; *(LAS u32x2*)(YC + t * RP + c8 * 2 + 8) = (u32x2){yc.z, yc.w};
    }
    const GAS bf16_t* gq = (const GAS bf16_t*)ra.RQ + (size_t)unit * 4096 + (32 * tw + r32) * 64 + 8 * hi;
    const GAS bf16_t* gs = (const GAS bf16_t*)ra.RM + (size_t)unit * 4096 + r32 * 64 + 8 * hi;
    bf16x8 bq[4], a0[4], a1[4];
#pragma unroll
    for (int s = 0; s < 4; ++s) { bq[s] = *(const GAS bf16x8*)(gq + 16 * s); a0[s] = *(const GAS bf16x8*)(gs + 16 * s); a1[s] = *(const GAS bf16x8*)(gs + 32 * 64 + 16 * s); }
    const float beta = ra.RB[(row0 + 32 * tw + r32) * 8 + h];
    BAR();
    const int tl = 32 * tw + r32;
    f32x16 y0, y1;
#pragma unroll
    for (int g = 0; g < 4; ++g) { const u32x2 w0 = *(const LAS u32x2*)(YC + tl * RP + (8 * g + 4 * hi) * 2), w1 = *(const LAS u32x2*)(YC + tl * RP + (32 + 8 * g + 4 * hi) * 2);
        y0[4 * g] = bflo(w0.x); y0[4 * g + 1] = bfhi(w0.x); y0[4 * g + 2] = bflo(w0.y); y0[4 * g + 3] = bfhi(w0.y);
        y1[4 * g] = bflo(w1.x); y1[4 * g + 1] = bfhi(w1.x); y1[4 * g + 2] = bflo(w1.y); y1[4 * g + 3] = bfhi(w1.y); }
#pragma unroll
    for (int s = 0; s < 4; ++s) { y0 = MFMA32(a0[s], bq[s], y0); y1 = MFMA32(a1[s], bq[s], y1); }
    float sm = 0.f;
#pragma unroll
    for (int i = 0; i < 16; ++i) sm += y0[i] + y1[i];
    sm += __shfl_xor(sm, 32); const float mean = sm * (1.f / 64.f);
    float sq = 0.f;
#pragma unroll
    for (int i = 0; i < 16; ++i) { const float d0 = y0[i] - mean, d1 = y1[i] - mean; sq += d0 * d0 + d1 * d1; }
    sq += __shfl_xor(sq, 32); const float rstd = __builtin_amdgcn_rsqf(sq * (1.f / 64.f) + GN_EPS);
#pragma unroll
    for (int half = 0; half < 2; ++half)
#pragma unroll
        for (int g = 0; g < 4; ++g) {
            const int v0 = 32 * half + 8 * g + 4 * hi, hc = h * 64 + v0;
            const u32x2 vw = *(const LAS u32x2*)(VM + tl * RP + v0 * 2), sw = *(const LAS u32x2*)(SG + tl * RP + v0 * 2);
            const f32x4 lg4 = *(const f32x4*)(ra.ln_g + hc), lb4 = *(const f32x4*)(ra.ln_b + hc);
            const float vv[4] = {bflo(vw.x), bfhi(vw.x), bflo(vw.y), bfhi(vw.y)}, ss[4] = {bflo(sw.x), bfhi(sw.x), bflo(sw.y), bfhi(sw.y)};
            float o[4];
#pragma unroll
            for (int j = 0; j < 4; ++j) { const float yv = half ? y1[4 * g + j] : y0[4 * g + j]; o[j] = ((yv - mean) * rstd * lg4[j] + lb4[j] + beta * vv[j]) * ss[j]; }
            u32x2 w; w.x = pk2(o[0], o[1]); w.y = pk2(o[2], o[3]); *(LAS u32x2*)(YC + tl * RP + v0 * 2) = w;
        }
    BAR();
#pragma unroll
    for (int j = 0; j < 4; ++j) { const int c = tt + 128 * j, t = c >> 3, c8 = (c & 7) * 8;
        const u32x2 lo = *(const LAS u32x2*)(YC + t * RP + c8 * 2), hi2 = *(const LAS u32x2*)(YC + t * RP + c8 * 2 + 8);
        u32x4 w; w.x = lo.x; w.y = lo.y; w.z = hi2.x; w.w = hi2.y; *(GAS u32x4*)((GAS bf16_t*)a.Y + (row0 + t) * DM + h * 64 + c8) = w; }
    BAR();
}
}
constexpr int NWAVES = 8;
constexpr int RING_BYTES = 131072, LDSCTL_OFF = RING_BYTES, LDS_BYTES = 163840;
constexpr int CW_BAR = 4096, CW_Q = 2048, CW_FLAG = 65536;
struct Args { const float* in[19]; float* out; unsigned char* ws; };

__device__ __forceinline__ unsigned lds_base_u32() { extern __shared__ __attribute__((aligned(16))) unsigned char lds_[]; return (unsigned)(uintptr_t)(LAS unsigned char*)lds_; }
__device__ __forceinline__ unsigned long long rd_ptr_u(volatile LAS unsigned long long* p) { const unsigned long long v = *p; const unsigned lo = __builtin_amdgcn_readfirstlane((unsigned)v), hi = __builtin_amdgcn_readfirstlane((unsigned)(v >> 32)); return ((unsigned long long)hi << 32) | lo; }
__global__ void __launch_bounds__(NWAVES * 64, 2) mega_fwd(Args args) {
    extern __shared__ __attribute__((aligned(16))) unsigned char lds[];
    const int tid = threadIdx.x, lane = tid & 63, wave = __builtin_amdgcn_readfirstlane(tid >> 6);
    const int G = gridDim.x, bx = blockIdx.x;
    unsigned char* ws = args.ws;
    volatile LAS unsigned* MISC = (volatile LAS unsigned*)((LAS unsigned char*)lds + LDSCTL_OFF);
    for (int u = tid; u < (LDS_BYTES - LDSCTL_OFF) / 4; u += NWAVES * 64) ((LAS unsigned*)((LAS unsigned char*)lds + LDSCTL_OFF))[u] = 0u;
    __syncthreads();
    (void)xcd_barrier_post((unsigned*)(ws + WS_CTL) + CW_BAR, MISC + 8);
    volatile LAS unsigned long long* PTRS = (volatile LAS unsigned long long*)((LAS unsigned char*)lds + LDSCTL_OFF + 256);
    if (tid < 19) PTRS[tid] = (unsigned long long)(uintptr_t)args.in[tid];
    if (tid == 19) PTRS[19] = (unsigned long long)(uintptr_t)args.out;
    if (tid == 20) PTRS[20] = (unsigned long long)(uintptr_t)args.ws;
    __syncthreads();
#define PTRS_RD(i) rd_ptr_u(({ unsigned a_; asm volatile("s_mov_b32 %0, %1" : "=s"(a_) : "i"(LDSCTL_OFF + 256 + 8 * (i))); (volatile LAS unsigned long long*)(LAS unsigned char*)(lds_base_u32() + a_); }))
#define ARGP(i) ((const float*)(uintptr_t)PTRS_RD(i))
#define OUTP ((float*)(uintptr_t)PTRS_RD(19))
#define WSP ((unsigned char*)(uintptr_t)PTRS_RD(20))
#ifdef PROBE_BAR
#define GRID_BAR() do { GRID_BAR1(); GRID_BAR1(); } while (0)
#else
#define GRID_BAR() GRID_BAR1()
#endif
#define GRID_BAR1() do { XcdBarrier b_; b_.bar = (unsigned*)(WSP + WS_CTL) + CW_BAR; b_.x = xb_xcc_id(); b_.st = (volatile LAS unsigned*)((LAS unsigned char*)lds + LDSCTL_OFF) + 8; xcd_barrier(b_); } while (0)
#ifdef PROBE_T
#define TS_LDS ((volatile LAS unsigned long long*)((LAS unsigned char*)lds + LDSCTL_OFF + 1024))
#define STAMP_BEGIN(id) do { if ((id) == PROBE_T && blockIdx.x == 0 && threadIdx.x == 0) TS_LDS[0] = __builtin_amdgcn_s_memrealtime(); } while (0)
#define STAMP_END(id) do { if ((id) == PROBE_T && blockIdx.x == 0 && threadIdx.x == 0) TS_LDS[1] += __builtin_amdgcn_s_memrealtime() - TS_LDS[0]; } while (0)
#else
#define STAMP_BEGIN(id) do {} while (0)
#define STAMP_END(id) do {} while (0)
#endif
#ifdef PROBE_TBUSY
#define STAMP_END_BUSY(id) STAMP_END(id)
#define STAMP_END_WALL(id) do {} while (0)
#else
#define STAMP_END_BUSY(id) do {} while (0)
#define STAMP_END_WALL(id) STAMP_END(id)
#endif
#define PHASE_IDS const int tid = opaque_tid(), lane = tid & 63, wave = __builtin_amdgcn_readfirstlane(tid >> 6), gw = bx * NWAVES + wave, ngw = G * NWAVES; (void)lane; (void)gw; (void)ngw; (void)tid; (void)wave;
    int K1024 = DM, K256 = 256; asm volatile("" : "+s"(K1024), "+s"(K256));
    STAMP_BEGIN(0);
    {
        PHASE_IDS
        const float* x = args.in[0]; bf16_t* bufA = (bf16_t*)(ws + WS_BUFA); float* ssqA = (float*)(ws + WS_SSQA);
        PrepArgs pa; pa.w_in = args.in[3]; pa.norm_g = args.in[2]; pa.w_out = args.in[14]; pa.ple_g = args.in[15]; pa.w_gate = args.in[16]; pa.w_proj = args.in[17]; pa.w_up = args.in[6]; pa.a_up = args.in[8]; pa.ws = ws;
        prep_tables(ws, bx * NWAVES * 64 + tid, G * NWAVES * 64);
        prep_weights(pa, gw, ngw, (LAS float*)((LAS unsigned char*)lds + wave * 16384), lane, 0, DEPTH);
#ifdef PROBE_PRO
        prep_weights(pa, gw, ngw, (LAS float*)((LAS unsigned char*)lds + wave * 16384), lane, 0, DEPTH);
        for (int m = gw; m < MTOK; m += ngw) x_row_to_bf16(x + (size_t)m * DM, bufA + (size_t)m * DM, ssqA + (size_t)m * 16, lane);
#endif
        for (int m = gw; m < MTOK; m += ngw) x_row_to_bf16(x + (size_t)m * DM, bufA + (size_t)m * DM, ssqA + (size_t)m * 16, lane);
    }
    STAMP_END_BUSY(0);
    GRID_BAR();
    STAMP_END_WALL(0);
    STAMP_BEGIN(1);
#pragma clang loop unroll(full)
    for (int L = 0; L < DEPTH; ++L) {
#define PHASE_PTRS unsigned char* ws = WSP; bf16_t* cur = (bf16_t*)(ws + ((L & 1) ? WS_BUFB : WS_BUFA)); bf16_t* oth = (bf16_t*)(ws + ((L & 1) ? WS_BUFA : WS_BUFB)); const unsigned char* wl = ws + WS_W + (size_t)L * W_LAYER; \
        bf16_t* Z = (bf16_t*)(ws + WS_Z); float* PP = (float*)(ws + WS_Z); bf16_t* PB = (bf16_t*)(ws + WS_PB); float* ssqA = (float*)(ws + WS_SSQA); float* ssqB = (float*)(ws + WS_SSQB); float* out = OUTP; \
        (void)cur; (void)oth; (void)wl; (void)Z; (void)PP; (void)PB; (void)ssqA; (void)ssqB; (void)out;
        {
            PHASE_PTRS
            const float* tab16 = (const float*)(ws + WS_TAB16); const float* tabI = (const float*)(ws + WS_TABI);
            pg8::Gemm g{cur, (const bf16_t*)(wl + W_IN), MTOK, NPAD, K1024}; pg8::StaticOrder S; S.init(MTOK, NPAD, G, bx);
            epi::EpiInProj e; e.Z = Z; e.ssq = ssqA; e.tab16 = tab16; e.tabI = tabI; e.KV = (bf16_t*)(ws + WS_MISC + MISC_KV); e.IKC = (bf16_t*)(ws + WS_MISC + MISC_IKC);
#ifdef PROBE_G1
            pg8::gemm_phase<epi::EpiInProj, pg8::StaticOrder, true, true>((PG8_LAS unsigned char*)lds, g, S, e);
#endif
#ifdef PROBE_G1P
            { epi::EpiPlainZ ep; ep.Z = Z; pg8::gemm_phase<epi::EpiPlainZ, pg8::StaticOrder, true, true>((PG8_LAS unsigned char*)lds, g, S, ep); }
#endif
            pg8::gemm_phase<epi::EpiInProj, pg8::StaticOrder, true, true>((PG8_LAS unsigned char*)lds, g, S, e);
        }
        STAMP_END_BUSY(1);
        GRID_BAR();
        STAMP_END_WALL(1);
        STAMP_BEGIN(2);
        {
            PHASE_PTRS
            MixArgs ma; ma.Z = Z; ma.Y = oth; ma.KV = (const bf16_t*)(ws + WS_MISC + MISC_KV); ma.IKC = (const bf16_t*)(ws + WS_MISC + MISC_IKC); ma.mu = ARGP(4) + L * 1664; ma.w0 = ARGP(5) + L * 384; ma.w_up = ARGP(6) + (size_t)L * 64 * 384; ma.a0 = ARGP(7) + L * 384; ma.a_up = ARGP(8) + (size_t)L * 64 * 384;
            ma.k_k = ARGP(9) + L * 384; ma.k_a = ARGP(10) + L * 384; ma.r_k = ARGP(11) + L * 384; ma.ln_g = ARGP(12) + L * 384; ma.ln_b = ARGP(13) + L * 384;
            rwkv::RArgs ra; ra.mu = ma.mu; ra.w0 = ma.w0; ra.a0 = ma.a0; ra.k_k = ma.k_k; ra.k_a = ma.k_a; ra.r_k = ma.r_k; ra.ln_g = ma.ln_g; ra.ln_b = ma.ln_b;
            ra.wupT = (const bf16_t*)(wl + W_WUPT); ra.aupT = (const bf16_t*)(wl + W_AUPT); ra.RQ = cur; ra.RM = cur + (size_t)3072 * 4096; ra.RN = (bf16_t*)(ws + WS_MISC + MISC_RN); ra.RG = (float*)(ws + WS_MISC + MISC_RG); ra.RB = (float*)(ws + WS_MISC + MISC_RB);
#ifdef PROBE_R1
            for (int rep = 0; rep < 2; ++rep)
#endif
            STAMP_BEGIN(20);
            {
              rwkv::R1Raw raw; const int tid1 = opaque_tid(); const int per = (3072 + G - 1) / G, u0 = bx * per, u1 = min(u0 + per, 3072);
              if (u0 < u1) rwkv::r1_load(ma, raw, tid1, u0 / 192, (u0 / 32) % 6, u0 & 31);
              int hprev = -1;
              for (int u = u0; u < u1; ++u) { const int un = u + 1; const int ck = u & 31, hh = (u / 32) % 6;
                  if (hh != hprev) { __syncthreads(); rwkv::r1_load_params(ra, lds, tid1, hh); __syncthreads(); hprev = hh; }
                  rwkv::rwkv_chunk_unit(ma, ra, lds, u / 192, hh, ck, raw, ck == 0 ? 0 : (u == u0 ? 2 : 1), un < u1, un / 192, (un / 32) % 6, un & 31); } }
            STAMP_END(20); STAMP_BEGIN(21);
            { volatile LAS unsigned* qw = (volatile LAS unsigned*)((LAS unsigned char*)lds + LDSCTL_OFF + 1536);
              unsigned* qctr = (unsigned*)(ws + WS_CTL) + CW_Q + L * 8 + (bx & 7);
              for (;;) {
                  if (opaque_tid() == 0) qw[0] = __hip_atomic_fetch_add(qctr, 1u, __ATOMIC_RELAXED, __HIP_MEMORY_SCOPE_AGENT);
                  __syncthreads();
                  const unsigned qi = qw[0];
                  __syncthreads();
                  if (qi >= 64u) break;
                  dsa::dsa_unit(ma, lds, (bx & 7) * 2 + (int)(qi & 1u), 31 - (int)(qi >> 1));
              } }
            __syncthreads();
            STAMP_END(21); STAMP_BEGIN(22);
            float* LQ = (float*)(ws + WS_MISC);
#ifdef PROBE_DIL
            for (int rep = 0; rep < 2; ++rep)
#endif
            for (int u = bx; u < 768; u += G) dil::dil_unit(ma, LQ, lds, u / 48, (u % 48) >> 4, u & 15);
            STAMP_END(22); STAMP_BEGIN(23);
        }
        STAMP_END_BUSY(2);
        GRID_BAR();
        STAMP_END_WALL(2); STAMP_END(23);
        STAMP_BEGIN(3);
        {
            PHASE_PTRS
            MixArgs ma; ma.Z = Z; ma.Y = oth; const float* LQ = (const float*)(ws + WS_MISC); PHASE_IDS
            rwkv::RArgs ra; ra.mu = ARGP(4) + L * 1664; ra.ln_g = ARGP(12) + L * 384; ra.ln_b = ARGP(13) + L * 384;
            ra.RQ = cur; ra.RM = cur + (size_t)3072 * 4096; ra.RN = (bf16_t*)(ws + WS_MISC + MISC_RN); ra.RG = (float*)(ws + WS_MISC + MISC_RG); ra.RB = (float*)(ws + WS_MISC + MISC_RB);
            if (G > 96) {
#ifdef PROBE_R2
                if (bx < 96) rwkv::rwkv_scan_chain<true>(ra, lds, bx / 6, bx % 6);
#endif
                if (bx < 96) { STAMP_BEGIN(40); rwkv::rwkv_scan_chain(ra, lds, bx / 6, bx % 6, (unsigned*)(ws + WS_CTL) + CW_FLAG + (L * 96 + bx) * 64); STAMP_END(40); }
                else { dil::dil_merge(ma, LQ, (bx - 96) * 512 + tid, (G - 96) * 512);
                    const float* src = ARGP(1) + (size_t)L * MTOK * 256;
                    for (size_t i = (size_t)(bx - 96) * 512 + tid; i < (size_t)MTOK * 256 / 8; i += (size_t)(G - 96) * 512) {
                        const f32x4 a = ((const f32x4*)src)[2 * i], b = ((const f32x4*)src)[2 * i + 1];
                        u32x4 w; w.x = pk2(a.x, a.y); w.y = pk2(a.z, a.w); w.z = pk2(b.x, b.y); w.w = pk2(b.z, b.w); ((u32x4*)PB)[i] = w; }
                }
            } else {
                for (int u = bx; u < 96; u += G) rwkv::rwkv_scan_chain(ra, lds, u / 6, u % 6, (unsigned*)(ws + WS_CTL) + CW_FLAG + (L * 96 + u) * 64);
                dil::dil_merge(ma, LQ, bx * 512 + tid, G * 512);
                { const float* src = ARGP(1) + (size_t)L * MTOK * 256;
                  for (size_t i = (size_t)bx * 512 + tid; i < (size_t)MTOK * 256 / 8; i += (size_t)G * 512) {
                      const f32x4 a = ((const f32x4*)src)[2 * i], b = ((const f32x4*)src)[2 * i + 1];
                      u32x4 w; w.x = pk2(a.x, a.y); w.y = pk2(a.z, a.w); w.z = pk2(b.x, b.y); w.w = pk2(b.z, b.w); ((u32x4*)PB)[i] = w; } }
            }
        }
        STAMP_END_BUSY(3);
        GRID_BAR();
        STAMP_END_WALL(3);
        STAMP_BEGIN(4);
        {
            PHASE_PTRS
            MixArgs ma; ma.Z = Z; ma.Y = oth;
            rwkv::RArgs ra; ra.mu = ARGP(4) + L * 1664; ra.ln_g = ARGP(12) + L * 384; ra.ln_b = ARGP(13) + L * 384;
            ra.RQ = cur; ra.RM = cur + (size_t)3072 * 4096; ra.RB = (float*)(ws + WS_MISC + MISC_RB); PHASE_IDS
            for (int u4 = bx; u4 < 768; u4 += G) { const int u = u4 * 4 + (wave >> 1); rwkv::rwkv_out_unit(ma, ra, lds, u / 192, (u / 32) % 6, u & 31); }
        }
        STAMP_END_BUSY(4);
        GRID_BAR();
        STAMP_END_WALL(4);
        STAMP_BEGIN(5);
        {
            PHASE_PTRS
            const float* x = ARGP(0);
            pg8::Gemm g{oth, (const bf16_t*)(wl + W_OUT), MTOK, DM, K1024}; pg8::StaticOrder S; S.init(MTOK, DM, G, bx);
            epi::EpiOutProj e; e.xin = (L == 0) ? x : out; e.xb = cur; e.ssq_out = ssqB;
            pg8::Gemm g2{PB, (const bf16_t*)(wl + W_PROJ), MTOK, DM, K256};
            epi::EpiBf16Plain e2; e2.C = (bf16_t*)PP;
            if ((bx >> 3) & 1) {
                pg8::gemm_phase<epi::EpiBf16Plain, pg8::StaticOrder, true, true>((PG8_LAS unsigned char*)lds, g2, S, e2);
                pg8::gemm_phase<epi::EpiOutProj, pg8::StaticOrder, true, true>((PG8_LAS unsigned char*)lds, g, S, e);
            } else {
                pg8::gemm_phase<epi::EpiOutProj, pg8::StaticOrder, true, true>((PG8_LAS unsigned char*)lds, g, S, e);
                pg8::gemm_phase<epi::EpiBf16Plain, pg8::StaticOrder, true, true>((PG8_LAS unsigned char*)lds, g2, S, e2);
            }
        }
        STAMP_END_BUSY(5);
        GRID_BAR();
        STAMP_END_WALL(5);
        STAMP_BEGIN(6);
        {
            PHASE_PTRS
            pg8::Gemm g{cur, (const bf16_t*)(wl + W_GATE), MTOK, DM, K1024}; pg8::StaticOrder S; S.init(MTOK, DM, G, bx);
            epi::EpiGate e; e.xout = out; e.x1b = cur; e.pp = (const bf16_t*)PP; e.xb = oth; e.ssq_in = ssqB; e.ssq_out = ssqA;
            pg8::gemm_phase<epi::EpiGate, pg8::StaticOrder, true, true>((PG8_LAS unsigned char*)lds, g, S, e);
        }
        STAMP_END_BUSY(6);
        GRID_BAR();
        STAMP_END_WALL(6);
        STAMP_BEGIN(1); STAMP_BEGIN(7);
    }
    {
        const int L = 0; PHASE_PTRS
        const float* fg = ARGP(18); PHASE_IDS
        for (int m = gw; m < MTOK; m += ngw) { const float rs = row_rstd(ssqA + (size_t)m * 16); f32x4* xr = (f32x4*)(out + (size_t)m * DM) + lane;
#pragma unroll
            for (int j = 0; j < 4; ++j) { const f32x4 gv = ((const f32x4*)fg)[64 * j + lane]; xr[64 * j] = xr[64 * j] * rs * gv; } }
    }
#ifdef PROBE_T
    if (PROBE_T == 7) { __syncthreads(); STAMP_END(7); }
    if (blockIdx.x == 0 && threadIdx.x == 0) { const unsigned long long t0 = __builtin_amdgcn_s_memrealtime(), w = 4ull * TS_LDS[1]; while (__builtin_amdgcn_s_memrealtime() - t0 < w) __builtin_amdgcn_s_sleep(8); }
#endif
}

extern "C" void kernel_launch(void* const* d_in, const int* in_sizes, int n_in, void* d_out, int out_size, void* d_ws, size_t ws_size, hipStream_t stream) {
    static int grid = 0;
    if (grid == 0) {
        if (n_in != 19 || out_size != MTOK * DM || ws_size < WS_END) { fprintf(stderr, "kernel_launch: unexpected shapes n_in %d out %d ws %zu\n", n_in, out_size, ws_size); grid = -1; return; }
        int dev = 0, cus = 0, per_cu = 0;
        if (hipGetDevice(&dev) != hipSuccess || hipDeviceGetAttribute(&cus, hipDeviceAttributeMultiprocessorCount, dev) != hipSuccess) { grid = -1; return; }
        if (hipFuncSetAttribute((const void*)mega_fwd, hipFuncAttributeMaxDynamicSharedMemorySize, LDS_BYTES) != hipSuccess) { fprintf(stderr, "kernel_launch: hipFuncSetAttribute failed\n"); grid = -1; return; }
        if (hipOccupancyMaxActiveBlocksPerMultiprocessor(&per_cu, (const void*)mega_fwd, NWAVES * 64, LDS_BYTES) != hipSuccess || per_cu < 1) { fprintf(stderr, "kernel_launch: occupancy query says %d blocks per CU\n", per_cu); (void)hipGetLastError(); grid = -1; return; }
        grid = cus;
    }
    if (grid < 0) return;
    if (hipMemsetAsync((char*)d_ws + WS_CTL, 0, 1 * MiB, stream) != hipSuccess) return;
    Args a; memset(&a, 0, sizeof a);
    for (int i = 0; i < 19; ++i) a.in[i] = (const float*)d_in[i];
    a.out = (float*)d_out; a.ws = (unsigned char*)d_ws;
    hipLaunchKernelGGL(mega_fwd, dim3(grid), dim3(NWAVES * 64), LDS_BYTES, stream, a);
}
```

```cpp
#include <hip/hip_runtime.h>
#include <cstdio>
#include <cstdint>
#include <cmath>
#include <cstring>

constexpr int BATCH = 16, SEQ = 2048, DM = 1024, DEPTH = 4, MTOK = BATCH * SEQ;
constexpr int ZP = 4136;
constexpr int NPAD = 4352;
constexpr int ZA_R = 0, ZA_K = 384, ZA_V = 768, ZA_G = 1152, ZA_WD = 1536, ZA_AD = 1600;
constexpr int ZB_Q = 1664, ZB_K = 1920, ZB_V = 1984, ZB_IQ = 2048, ZB_IK = 2304, ZB_IW = 2336, ZB_G = 2344;
constexpr int ZC_Q = 2600, ZC_K = 2984, ZC_V = 3368, ZC_G = 3752;
constexpr float LOG2E = 1.4426950408889634f;
constexpr float QSCALE = 0.125f * LOG2E;
constexpr float IQSCALE = 0.17677669529663687f;
constexpr float IWSCALE = 0.35355339059327373f;
constexpr float NORM_EPS = 1e-6f, GN_EPS = 64e-5f;
constexpr float DECAY_SCALE = 0.6065306597126334f;

typedef unsigned short bf16_t;
typedef short bf16x8 __attribute__((ext_vector_type(8)));
typedef float f32x4 __attribute__((ext_vector_type(4)));
typedef float f32x16 __attribute__((ext_vector_type(16)));
typedef unsigned u32x4 __attribute__((ext_vector_type(4)));
typedef unsigned u32x2 __attribute__((ext_vector_type(2)));

__device__ __forceinline__ unsigned f2bf(float f) { unsigned u = __builtin_bit_cast(unsigned, f); return (u + 0x7fffu + ((u >> 16) & 1u)) >> 16; }
typedef float f32x2_t __attribute__((ext_vector_type(2))); typedef __bf16 bf16x2_t __attribute__((ext_vector_type(2)));
__device__ __forceinline__ unsigned pk2(float lo, float hi) { const f32x2_t v = {lo, hi}; return __builtin_bit_cast(unsigned, __builtin_convertvector(v, bf16x2_t)); }
__device__ __forceinline__ float bf2f(unsigned short b) { return __builtin_bit_cast(float, (unsigned)b << 16); }
__device__ __forceinline__ float bflo(unsigned w) { return __builtin_bit_cast(float, w << 16); }
__device__ __forceinline__ float bfhi(unsigned w) { return __builtin_bit_cast(float, w & 0xffff0000u); }
__device__ __forceinline__ float sigmoidf_(float x) { return __builtin_amdgcn_rcpf(1.0f + __builtin_amdgcn_exp2f(-1.4426950408889634f * x)); }
__device__ __forceinline__ float fexp_(float x) { return __builtin_amdgcn_exp2f(1.4426950408889634f * x); }
__device__ __forceinline__ float tanhf_(float x) { const float e = __builtin_amdgcn_exp2f(fminf(2.8853900817779268f * x, 60.f)); return 1.0f - 2.0f * __builtin_amdgcn_rcpf(e + 1.0f); }
__device__ __forceinline__ int opaque_tid() { int t = threadIdx.x; asm volatile("" : "+v"(t)); return t; }
__device__ __forceinline__ u32x4 zero_u32x4() { unsigned z = 0u; asm volatile("" : "+v"(z)); u32x4 r; r.x = z; r.y = z; r.z = z; r.w = z; return r; }
__device__ __forceinline__ float wave_sum(float v) {
#pragma unroll
    for (int o = 1; o < 64; o <<= 1) v += __shfl_xor(v, o);
    return v;
}
__device__ __forceinline__ float wave_max(float v) {
#pragma unroll
    for (int o = 1; o < 64; o <<= 1) v = fmaxf(v, __shfl_xor(v, o));
    return v;
}

constexpr size_t MiB = 1u << 20;
constexpr size_t WS_CTL = 0;
constexpr size_t WS_TAB16 = 1 * MiB;
constexpr size_t WS_TABI = WS_TAB16 + 128 * 1024;
constexpr size_t WS_SSQA = WS_TABI + 64 * 1024;
constexpr size_t WS_SSQB = WS_SSQA + 2 * MiB;
constexpr size_t WS_W = 6 * MiB;
constexpr size_t W_LAYER = 14 * MiB, W_IN = 0, W_OUT = 8912896, W_GATE = W_OUT + 2 * MiB, W_PROJ = W_GATE + 2 * MiB, W_WUPT = W_PROJ + 512 * 1024, W_AUPT = W_WUPT + 48 * 1024;
constexpr size_t WS_BUFA = 62 * MiB;
constexpr size_t WS_BUFB = 126 * MiB;
constexpr size_t WS_PB = 190 * MiB;
constexpr size_t WS_Z = 206 * MiB;
constexpr size_t WS_Z_END = WS_Z + (size_t)MTOK * ZP * 2;
constexpr size_t WS_MISC = 465 * MiB;
constexpr size_t WS_END = 512 * MiB;
constexpr size_t MISC_LQ = 0, MISC_RG = 1 * MiB, MISC_RN = 2 * MiB, MISC_RB = 26 * MiB, MISC_KV = 27 * MiB, MISC_IKC = 35 * MiB;
static_assert(W_AUPT + 48 * 1024 <= W_LAYER && WS_W + 4 * W_LAYER <= WS_BUFA && WS_Z_END <= WS_MISC, "ws map");
namespace pg8 {
#define PG8_LAS __attribute__((address_space(3)))
typedef unsigned short bf16_t;
typedef short bf16x8 __attribute__((ext_vector_type(8)));
typedef float f32x4 __attribute__((ext_vector_type(4)));
typedef unsigned u32x4 __attribute__((ext_vector_type(4)));
constexpr int BM = 256, BK = 64, HALF = 128, HTB = HALF * BK * 2  , STAGE_BYTES = 8 * HTB, NXCD = 8, WGM = 8;

__host__ __device__ __forceinline__ int lds_byte(int r, int c) { const int st = (r >> 4) * 2 + (c >> 5), rr = r & 15, cc = c & 31, ob = rr * 64 + cc * 2; return st * 1024 + (ob ^ (((ob >> 9) & 1) << 5)); }
__host__ __device__ __forceinline__ void stage_rc(int b, int& R, int& C) { const int st = b / 1024, sb = b % 1024, swz = sb ^ (((sb >> 9) & 1) << 5); R = (st >> 1) * 16 + swz / 64; C = (st & 1) * 32 + (swz % 64) / 2; }
__host__ __device__ __forceinline__ int perm32(int rho) { const int n = rho >> 4, i = rho & 15; return 8 * (i >> 2) + 4 * n + (i & 3); }

struct Unit { int pm, pn; };
struct Gemm { const bf16_t* A; const bf16_t* Bt; int M, N, K; };

struct StaticOrder {
    int nM, nN, nwg, G, c;
    __host__ __device__ void init(int M, int N, int G_, int c_) { nM = M / BM; nN = N / BM; nwg = nM * nN; G = G_; c = c_; }
    __host__ __device__ bool next(int i, Unit& u) const {
        const long L = (long)i * G + c; if (L >= nwg) return false;
        int wgid = (int)L; { const int q = nwg / NXCD, r = nwg % NXCD, xcd = wgid % NXCD, off = wgid / NXCD; wgid = (xcd < r ? xcd * (q + 1) : r * (q + 1) + (xcd - r) * q) + off; }
        const int nig = WGM * nN, gid = wgid / nig, fm = gid * WGM, gsz = (nM - fm) < WGM ? (nM - fm) : WGM;
        u.pm = fm + ((wgid % nig) % gsz); u.pn = (wgid % nig) / gsz; return true;
    }
    __device__ __forceinline__ void a_ready(const Unit&) const {}
    __device__ __forceinline__ void done(const Unit&) const {}
};

__device__ __forceinline__ unsigned cvt_pk_bf16(float lo, float hi) { unsigned r; asm volatile("v_cvt_pk_bf16_f32 %0, %1, %2" : "=v"(r) : "v"(lo), "v"(hi)); return r; }
template <class Epi, class Sched, bool ALIGN_EPI = false, bool SP2 = false>
__device__ __forceinline__ void gemm_phase(PG8_LAS unsigned char* lds, const Gemm g, const Sched& S, const Epi& E) {
    int tid_ = threadIdx.x; asm volatile("" : "+v"(tid_));
    const int tid = tid_, wid = __builtin_amdgcn_readfirstlane(tid >> 6), lane = tid & 63, wr = wid >> 2, wc = wid & 3, fr = lane & 15, fq = lane >> 4;
    const int K = g.K, nt = K / BK;
    unsigned voffA[2], voffB[2];
#pragma unroll
    for (int i = 0; i < 2; ++i) { int R, C; stage_rc(tid * 16 + i * 8192, R, C); const int Rb = Epi::PERM ? ((R & ~31) + perm32(R & 31)) : R;
        voffA[i] = (unsigned)(R * K + C) * 2u; voffB[i] = (unsigned)(Rb * K + C) * 2u; }
    const size_t kstep = (size_t)(BK * 2);
    const size_t hstep = (size_t)HALF * K * 2;
    const size_t tstep = 2 * hstep;
    const unsigned ldsw = (unsigned)wid * 1024u;
    const int aoff = lds_byte(wr * 64 + fr, fq * 8), boff = lds_byte(wc * 32 + fr, fq * 8);
#define PG8_SA(b, h) (((b) * 2 + (h)) * HTB)
#define PG8_SB(b, h) ((4 + (b) * 2 + (h)) * HTB)
#define PG8_STAGE(bufoff, gbase, voff) do { _Pragma("unroll") for (int _i = 0; _i < 2; ++_i) \
        __builtin_amdgcn_global_load_lds((const unsigned*)((const char*)(gbase) + (voff)[_i]), (PG8_LAS unsigned*)(lds + (bufoff) + ldsw + _i * 8192), 16, 0, 0); } while (0)
#define PG8_LDA(dst, b, h) do { _Pragma("unroll") for (int m = 0; m < 4; ++m) _Pragma("unroll") for (int k = 0; k < 2; ++k) dst[m][k] = *(const PG8_LAS bf16x8*)(lds + PG8_SA(b, h) + aoff + m * 2048 + k * 1024); } while (0)
#define PG8_LDB(dst, b, h) do { _Pragma("unroll") for (int n = 0; n < 2; ++n) _Pragma("unroll") for (int k = 0; k < 2; ++k) dst[n][k] = *(const PG8_LAS bf16x8*)(lds + PG8_SB(b, h) + boff + n * 2048 + k * 1024); } while (0)
#define PG8_MMA(ai, bj, At, Bt) do { __builtin_amdgcn_s_setprio(1); _Pragma("unroll") for (int m = 0; m < 4; ++m) _Pragma("unroll") for (int n = 0; n < 2; ++n) _Pragma("unroll") for (int k = 0; k < 2; ++k) \
        acc[ai][bj][m][n] = __builtin_amdgcn_mfma_f32_16x16x32_bf16(Bt[n][k], At[m][k], acc[ai][bj][m][n], 0, 0, 0); __builtin_amdgcn_s_setprio(0); } while (0)
#define PG8_WAIT_V(n) asm volatile("s_waitcnt vmcnt(" #n ")" ::: "memory")
#define PG8_WAIT_L(n) asm volatile("s_waitcnt lgkmcnt(" #n ")" ::: "memory")
#define PG8_BAR __builtin_amdgcn_s_barrier()
#define PG8_SCHED __builtin_amdgcn_sched_barrier(0)
    Unit cur, nxt; int ui = 0;
    if (!S.next(0, cur)) return;
    f32x4 acc[2][2][4][2];
#pragma unroll
    for (int a = 0; a < 2; ++a)
#pragma unroll
        for (int b = 0; b < 2; ++b)
#pragma unroll
            for (int m = 0; m < 4; ++m)
#pragma unroll
                for (int n = 0; n < 2; ++n) acc[a][b][m][n] = (f32x4){0.f, 0.f, 0.f, 0.f};
    bf16x8 At[4][2], B0[2][2], B1[2][2];
    const char* cA = (const char*)g.A + (size_t)cur.pm * tstep; const char* cB = (const char*)g.Bt + (size_t)cur.pn * tstep;
    S.a_ready(cur);
    if constexpr (SP2) {
        PG8_STAGE(PG8_SB(0, 0), cB, voffB); PG8_STAGE(PG8_SB(0, 1), cB + hstep, voffB); PG8_STAGE(PG8_SA(0, 0), cA, voffA); PG8_STAGE(PG8_SA(0, 1), cA + hstep, voffA);
        if (wr == 1) PG8_BAR;
        PG8_WAIT_V(2); PG8_BAR;
        PG8_STAGE(PG8_SB(1, 0), cB + kstep, voffB); PG8_STAGE(PG8_SA(1, 0), cA + kstep, voffA); PG8_STAGE(PG8_SB(1, 1), cB + hstep + kstep, voffB);
        PG8_WAIT_V(6); PG8_BAR;
    } else {
        PG8_STAGE(PG8_SB(0, 0), cB, voffB); PG8_STAGE(PG8_SA(0, 0), cA, voffA); PG8_STAGE(PG8_SB(0, 1), cB + hstep, voffB); PG8_STAGE(PG8_SA(0, 1), cA + hstep, voffA);
        if (wr == 1) PG8_BAR;
        PG8_WAIT_V(4); PG8_BAR;
        PG8_STAGE(PG8_SB(1, 0), cB + kstep, voffB); PG8_STAGE(PG8_SA(1, 0), cA + kstep, voffA); PG8_STAGE(PG8_SB(1, 1), cB + hstep + kstep, voffB);
        PG8_WAIT_V(6); PG8_BAR;
    }
    for (;;) {
        const bool has_next = S.next(ui + 1, nxt);
        const char* nA = has_next ? (const char*)g.A + (size_t)nxt.pm * tstep : cA; const char* nB = has_next ? (const char*)g.Bt + (size_t)nxt.pn * tstep : cB;
        for (int t = 0; t < nt; t += 2) {
            const bool last = (t == nt - 2);
            const char* a1 = cA + (size_t)(t + 1) * kstep;
            const char* a2 = last ? nA : cA + (size_t)(t + 2) * kstep; const char* b2 = last ? nB : cB + (size_t)(t + 2) * kstep;
            const char* a3 = a2 + kstep; const char* b3 = b2 + kstep;
            if (last && has_next) S.a_ready(nxt);
            if constexpr (SP2) {
            PG8_LDB(B0, 0, 0); PG8_LDB(B1, 0, 1); PG8_SCHED; PG8_LDA(At, 0, 0); PG8_STAGE(PG8_SA(1, 1), a1 + hstep, voffA);
            PG8_WAIT_V(8); PG8_WAIT_L(0); PG8_BAR; PG8_MMA(0, 0, At, B0); PG8_MMA(0, 1, At, B1); PG8_BAR; PG8_SCHED;
            PG8_LDA(At, 0, 1); PG8_STAGE(PG8_SB(0, 0), b2, voffB); PG8_STAGE(PG8_SB(0, 1), b2 + hstep, voffB); PG8_STAGE(PG8_SA(0, 0), a2, voffA);
            PG8_WAIT_V(8); PG8_WAIT_L(0); PG8_BAR; PG8_MMA(1, 0, At, B0); PG8_MMA(1, 1, At, B1); PG8_BAR; PG8_SCHED;
            PG8_LDB(B0, 1, 0); PG8_LDB(B1, 1, 1); PG8_SCHED; PG8_LDA(At, 1, 0); PG8_STAGE(PG8_SA(0, 1), a2 + hstep, voffA);
            PG8_WAIT_V(8); PG8_WAIT_L(0); PG8_BAR; PG8_MMA(0, 0, At, B0); PG8_MMA(0, 1, At, B1); PG8_BAR; PG8_SCHED;
            PG8_LDA(At, 1, 1); PG8_STAGE(PG8_SB(1, 0), b3, voffB); PG8_STAGE(PG8_SB(1, 1), b3 + hstep, voffB); PG8_STAGE(PG8_SA(1, 0), a3, voffA);
            PG8_WAIT_V(8); PG8_WAIT_L(0); PG8_BAR; PG8_MMA(1, 0, At, B0); PG8_MMA(1, 1, At, B1); PG8_BAR; PG8_SCHED;
            } else {
            PG8_LDB(B0, 0, 0); PG8_SCHED; PG8_LDA(At, 0, 0); PG8_STAGE(PG8_SA(1, 1), a1 + hstep, voffA);
            PG8_WAIT_L(8); PG8_BAR; PG8_WAIT_L(0); PG8_MMA(0, 0, At, B0); PG8_BAR; PG8_SCHED;
            PG8_LDB(B1, 0, 1); PG8_STAGE(PG8_SB(0, 0), b2, voffB);
            PG8_BAR; PG8_WAIT_L(0); PG8_MMA(0, 1, At, B1); PG8_BAR;
            PG8_LDA(At, 0, 1); PG8_STAGE(PG8_SA(0, 0), a2, voffA);
            PG8_BAR; PG8_WAIT_L(0); PG8_MMA(1, 0, At, B0); PG8_BAR; PG8_SCHED;
            PG8_STAGE(PG8_SB(0, 1), b2 + hstep, voffB);
            PG8_WAIT_V(6); PG8_BAR; PG8_MMA(1, 1, At, B1); PG8_BAR;
            PG8_LDB(B0, 1, 0); PG8_SCHED; PG8_LDA(At, 1, 0); PG8_STAGE(PG8_SA(0, 1), a2 + hstep, voffA);
            PG8_WAIT_L(8); PG8_BAR; PG8_WAIT_L(0); PG8_MMA(0, 0, At, B0); PG8_BAR; PG8_SCHED;
            PG8_LDB(B1, 1, 1); PG8_STAGE(PG8_SB(1, 0), b3, voffB);
            PG8_BAR; PG8_WAIT_L(0); PG8_MMA(0, 1, At, B1); PG8_BAR;
            PG8_LDA(At, 1, 1); PG8_STAGE(PG8_SA(1, 0), a3, voffA);
            PG8_BAR; PG8_WAIT_L(0); PG8_MMA(1, 0, At, B0); PG8_BAR; PG8_SCHED;
            PG8_STAGE(PG8_SB(1, 1), b3 + hstep, voffB);
            PG8_WAIT_V(6); PG8_BAR; PG8_MMA(1, 1, At, B1); PG8_BAR;
            }
        }
        if constexpr (ALIGN_EPI) { if (wr == 0) PG8_BAR; }
        if constexpr (!Epi::AFTER_DRAIN) { E(acc, cur, wr, wc, fr, fq); S.done(cur); }
        if (!has_next) break;
#pragma unroll
        for (int a = 0; a < 2; ++a)
#pragma unroll
            for (int b = 0; b < 2; ++b)
#pragma unroll
                for (int m = 0; m < 4; ++m)
#pragma unroll
                    for (int n = 0; n < 2; ++n) acc[a][b][m][n] = (f32x4){0.f, 0.f, 0.f, 0.f};
        cur = nxt; cA = nA; cB = nB; ++ui;
        if constexpr (ALIGN_EPI) { if (wr == 1) PG8_BAR; }
    }
    PG8_WAIT_V(0);
    if constexpr (!ALIGN_EPI) { if (wr == 0) PG8_BAR; }
    PG8_BAR;
    if constexpr (Epi::AFTER_DRAIN) { E.fused(acc, cur, wr, wc, fr, fq, lds, wid, lane); S.done(cur); }
#undef PG8_SA
#undef PG8_SB
#undef PG8_STAGE
#undef PG8_LDA
#undef PG8_LDB
#undef PG8_MMA
#undef PG8_WAIT_V
#undef PG8_WAIT_L
#undef PG8_BAR
#undef PG8_SCHED
}
}
#define GAS __attribute__((address_space(1)))
#define LAS __attribute__((address_space(3)))

__device__ __forceinline__ int zcol_src(int n, float& sc) {
    sc = 1.f;
    if (n < ZB_Q) return n;
    if (n < ZB_K) { int o = n - ZB_Q, h = o >> 6, d = o & 63; sc = QSCALE; if (d < 16) d = (d >> 1) + 8 * (d & 1); return ZB_Q + h * 64 + d; }
    if (n < ZB_V) { int d = n - ZB_K; if (d < 16) d = (d >> 1) + 8 * (d & 1); return ZB_K + d; }
    if (n < ZB_IQ) return n;
    if (n < ZB_IK) { int o = n - ZB_IQ, h = o >> 5, d = o & 31; sc = IQSCALE; if (d < 8) d = (d >> 1) + 4 * (d & 1); return ZB_IQ + h * 32 + d; }
    if (n < ZB_IW) { int d = n - ZB_IK; if (d < 8) d = (d >> 1) + 4 * (d & 1); return ZB_IK + d; }
    if (n < ZB_G) { sc = IWSCALE; return n; }
    if (n < ZC_Q) return n;
    if (n < ZC_K) { int o = n - ZC_Q, h = o >> 6, d = o & 63; sc = QSCALE; if (d < 16) d = (d >> 1) + 8 * (d & 1); return ZC_Q + h * 64 + d; }
    if (n < ZC_V) { int o = n - ZC_K, h = o >> 6, d = o & 63; if (d < 16) d = (d >> 1) + 8 * (d & 1); return ZC_K + h * 64 + d; }
    return n;
}

template <bool ZMAP>
__device__ __forceinline__ void transpose_item(const float* __restrict__ W, int K, int NW, bf16_t* WT, const float* __restrict__ kscale, LAS float* scr, int item, int nblk, int lane) {
    const int kb = item / nblk, nb = item % nblk, k0 = 64 * kb, n0 = 32 * nb;
    const int c4 = 4 * (lane & 7), ncol = n0 + c4;
    f32x4 v[8];
#pragma unroll
    for (int i = 0; i < 8; ++i) { const int kk = (lane >> 3) + 8 * i; v[i] = (f32x4){0.f, 0.f, 0.f, 0.f}; if (ncol < NW) v[i] = *(const f32x4*)(W + (size_t)(k0 + kk) * NW + ncol); }
#pragma unroll
    for (int i = 0; i < 8; ++i) { const int kk = (lane >> 3) + 8 * i; f32x4 x = v[i]; if (kscale) x = x * kscale[k0 + kk];
        scr[kk * 33 + c4] = x[0]; scr[kk * 33 + c4 + 1] = x[1]; scr[kk * 33 + c4 + 2] = x[2]; scr[kk * 33 + c4 + 3] = x[3]; }
    asm volatile("s_waitcnt lgkmcnt(0)" ::: "memory");
    const int c = lane & 7;
#pragma unroll
    for (int j = 0; j < 4; ++j) { const int n = (lane >> 3) + 8 * j; int sl = n; float sc = 1.f;
        if (ZMAP) { if (n0 + n < NW) sl = zcol_src(n0 + n, sc) - n0; else { sl = n; sc = 0.f; } }
        const LAS float* s = scr + (8 * c) * 33 + sl;
        u32x4 o; o.x = pk2(s[0 * 33] * sc, s[1 * 33] * sc); o.y = pk2(s[2 * 33] * sc, s[3 * 33] * sc); o.z = pk2(s[4 * 33] * sc, s[5 * 33] * sc); o.w = pk2(s[6 * 33] * sc, s[7 * 33] * sc);
        *(u32x4*)(WT + (size_t)(n0 + n) * K + k0 + 8 * c) = o; }
    asm volatile("s_waitcnt lgkmcnt(0)" ::: "memory");
}

struct PrepArgs { const float* w_in; const float* norm_g; const float* w_out; const float* ple_g; const float* w_gate; const float* w_proj; const float* w_up; const float* a_up; unsigned char* ws; };

__device__ __forceinline__ void prep_weights(const PrepArgs& a, int gw, int ngw, LAS float* scr, int lane, int L0, int L1) {
    constexpr int I_IN = 16 * (NPAD / 32), I_SQ = 16 * 32, I_PJ = 4 * 32, I_UP = 12, I_LAYER = I_IN + 2 * I_SQ + I_PJ + 2 * I_UP;
    for (int it = gw; it < (L1 - L0) * I_LAYER; it += ngw) {
        const int L = L0 + it / I_LAYER; int r = it % I_LAYER;
        unsigned char* wl = a.ws + WS_W + (size_t)L * W_LAYER;
        if (r < I_IN) { transpose_item<true>(a.w_in + (size_t)L * DM * ZP, DM, ZP, (bf16_t*)(wl + W_IN), a.norm_g + L * DM, scr, r, NPAD / 32, lane); continue; } r -= I_IN;
        if (r < I_SQ) { transpose_item<false>(a.w_out + (size_t)L * DM * DM, DM, DM, (bf16_t*)(wl + W_OUT), nullptr, scr, r, 32, lane); continue; } r -= I_SQ;
        if (r < I_SQ) { transpose_item<false>(a.w_gate + (size_t)L * DM * DM, DM, DM, (bf16_t*)(wl + W_GATE), a.ple_g + L * DM, scr, r, 32, lane); continue; } r -= I_SQ;
        if (r < I_PJ) { transpose_item<false>(a.w_proj + (size_t)L * 256 * DM, 256, DM, (bf16_t*)(wl + W_PROJ), nullptr, scr, r, 32, lane); continue; } r -= I_PJ;
        if (r < I_UP) { transpose_item<false>(a.w_up + (size_t)L * 64 * 384, 64, 384, (bf16_t*)(wl + W_WUPT), nullptr, scr, r, 12, lane); continue; } r -= I_UP;
        transpose_item<false>(a.a_up + (size_t)L * 64 * 384, 64, 384, (bf16_t*)(wl + W_AUPT), nullptr, scr, r, 12, lane);
    }
}

__device__ __forceinline__ void sincos_d(float ang, float& c, float& s) {
    const double a = (double)ang; const double n = rint(a * 0.63661977236758134308);
    double r = fma(-n, 1.57079632679489655800e+00, a); r = fma(-n, 6.12323399573676603587e-17, r);
    const double r2 = r * r;
    double sp = r2 * (1.0 / 6227020800.0) - 1.0 / 39916800.0; sp = sp * r2 + 1.0 / 362880.0; sp = sp * r2 - 1.0 / 5040.0; sp = sp * r2 + 1.0 / 120.0; sp = sp * r2 - 1.0 / 6.0; sp = sp * r2 * r + r;
    double cp = r2 * (1.0 / 479001600.0) - 1.0 / 3628800.0; cp = cp * r2 + 1.0 / 40320.0; cp = cp * r2 - 1.0 / 720.0; cp = cp * r2 + 1.0 / 24.0; cp = cp * r2 - 0.5; cp = cp * r2 + 1.0;
    const int q = ((int)n) & 3;
    const double sv = (q == 0) ? sp : (q == 1) ? cp : (q == 2) ? -sp : -cp;
    const double cv = (q == 0) ? cp : (q == 1) ? -sp : (q == 2) ? -cp : sp;
    c = (float)cv; s = (float)sv;
}
__device__ __forceinline__ void prep_tables(unsigned char* ws, int gtid, int nthreads) {
    const float inv8[8] = {1.0f, 0.1939227432012558f, 0.03760603070259094f, 0.007292664609849453f, 0.0014142135623842478f, 0.00027424818836152554f, 5.318296098266728e-05f, 1.0313386155758053e-05f};
    float* t16 = (float*)(ws + WS_TAB16); float* tI = (float*)(ws + WS_TABI);
    for (int e = gtid; e < SEQ * 8; e += nthreads) { const int pos = e >> 3, i = e & 7;
        float iv = inv8[0];
#pragma unroll
        for (int j = 1; j < 8; ++j) iv = (i == j) ? inv8[j] : iv;
        float c, s; sincos_d((float)pos * iv, c, s); t16[pos * 16 + i] = c; t16[pos * 16 + 8 + i] = s;
        if ((i & 1) == 0) { const int i4 = i >> 1; tI[pos * 8 + i4] = c; tI[pos * 8 + 4 + i4] = s; }
    }
}
__device__ __forceinline__ void x_row_to_bf16(const float* xrow, bf16_t* orow, float* ssq, int lane) {
    const f32x4* xr = (const f32x4*)xrow + lane;
    unsigned long long* o8 = (unsigned long long*)orow + lane;
#pragma unroll
    for (int j = 0; j < 4; ++j) { const f32x4 v = xr[64 * j];
        float s = (v.x * v.x + v.y * v.y) + (v.z * v.z + v.w * v.w);
        o8[64 * j] = (unsigned long long)pk2(v.x, v.y) | ((unsigned long long)pk2(v.z, v.w) << 32);
        s += __shfl_xor(s, 1); s += __shfl_xor(s, 2); s += __shfl_xor(s, 4); s += __shfl_xor(s, 8);
        if ((lane & 15) == 0) ssq[4 * j + (lane >> 4)] = s; }
}
__device__ __forceinline__ float row_rstd(const float* ssq_row) {
    const f32x4 a = *(const f32x4*)ssq_row, b = *(const f32x4*)(ssq_row + 4), c = *(const f32x4*)(ssq_row + 8), d = *(const f32x4*)(ssq_row + 12);
    const float s = ((a.x + a.y) + (a.z + a.w)) + ((b.x + b.y) + (b.z + b.w)) + ((c.x + c.y) + (c.z + c.w)) + ((d.x + d.y) + (d.z + d.w));
    return __builtin_amdgcn_rsqf(s * (1.0f / DM) + NORM_EPS);
}
namespace epi {
using pg8::Unit; using pg8::BM; using pg8::HALF;
__device__ __forceinline__ u32x4 pack8(const f32x4& a, const f32x4& b) { u32x4 w; w.x = pg8::cvt_pk_bf16(a[0], a[1]); w.y = pg8::cvt_pk_bf16(a[2], a[3]); w.z = pg8::cvt_pk_bf16(b[0], b[1]); w.w = pg8::cvt_pk_bf16(b[2], b[3]); return w; }
__device__ __forceinline__ int rope_class(int c0, int& fb) {
    fb = 0; int o;
    if (c0 >= ZB_Q && c0 < ZB_V) { o = (c0 - ZB_Q) & 63; if (o < 16) { fb = o >> 1; return 1; } return 0; }
    if (c0 >= ZB_IQ && c0 < ZB_IW) { o = (c0 - ZB_IQ) & 31; return o == 0 ? 2 : 0; }
    if (c0 >= ZC_Q && c0 < ZC_V) { o = (c0 - ZC_Q) & 63; if (o < 16) { fb = o >> 1; return 1; } return 0; }
    return 0;
}
struct EpiInProj {
    static constexpr bool PERM = true, AFTER_DRAIN = false;
    bf16_t* Z; const float* ssq; const float* tab16; const float* tabI; bf16_t* KV; bf16_t* IKC;
    __device__ __forceinline__ void operator()(const f32x4 (&acc)[2][2][4][2], const Unit& u, int wr, int wc, int fr, int fq) const {
        const int row0 = u.pm * BM + wr * 64 + fr;
        const int c00 = u.pn * BM + wc * 32 + 8 * fq, c01 = c00 + HALF;
        int fb0, fb1; const int rc0 = rope_class(c00, fb0), rc1 = rope_class(c01, fb1);
#pragma unroll
        for (int ai = 0; ai < 2; ++ai)
#pragma unroll
            for (int m = 0; m < 4; ++m) {
                const int row = row0 + ai * HALF + m * 16;
                const float rs = row_rstd(ssq + (size_t)row * 16);
                const int pos = row & (SEQ - 1);
#pragma unroll
                for (int bj = 0; bj < 2; ++bj) {
                    const int c0 = bj ? c01 : c00, rc = bj ? rc1 : rc0, fb = bj ? fb1 : fb0;
                    if (c0 >= ZP) continue;
                    f32x4 v0 = acc[ai][bj][m][0] * rs, v1 = acc[ai][bj][m][1] * rs;
                    if (rc) {
                        const float* tp = (rc == 1) ? tab16 + pos * 16 + fb : tabI + pos * 8;
                        const f32x4 c = *(const f32x4*)tp, s = *(const f32x4*)(tp + (rc == 1 ? 8 : 4));
                        f32x4 a0, a1;
                        a0[0] = v0[0] * c[0] - v0[1] * s[0]; a0[1] = v0[1] * c[0] + v0[0] * s[0];
                        a0[2] = v0[2] * c[1] - v0[3] * s[1]; a0[3] = v0[3] * c[1] + v0[2] * s[1];
                        a1[0] = v1[0] * c[2] - v1[1] * s[2]; a1[1] = v1[1] * c[2] + v1[0] * s[2];
                        a1[2] = v1[2] * c[3] - v1[3] * s[3]; a1[3] = v1[3] * c[3] + v1[2] * s[3];
                        v0 = a0; v1 = a1;
                    }
                    const u32x4 pk = pack8(v0, v1);
                    if (c0 >= ZB_K && c0 < ZB_IQ) *(u32x4*)(KV + (size_t)row * 128 + (c0 - ZB_K)) = pk;
                    else if (c0 >= ZB_IK && c0 < ZB_IW) *(u32x4*)(IKC + (size_t)row * 32 + (c0 - ZB_IK)) = pk;
                    else *(u32x4*)(Z + (size_t)row * ZP + c0) = pk;
                }
                asm volatile("" ::: "memory");
            }
    }
};
struct EpiPlainZ {
    static constexpr bool PERM = true, AFTER_DRAIN = false;
    bf16_t* Z;
    __device__ __forceinline__ void operator()(const f32x4 (&acc)[2][2][4][2], const Unit& u, int wr, int wc, int fr, int fq) const {
        const int row0 = u.pm * BM + wr * 64 + fr;
#pragma unroll
        for (int ai = 0; ai < 2; ++ai)
#pragma unroll
            for (int m = 0; m < 4; ++m)
#pragma unroll
                for (int bj = 0; bj < 2; ++bj) { const int c0 = u.pn * BM + bj * HALF + wc * 32 + 8 * fq; if (c0 < ZP) *(u32x4*)(Z + (size_t)(row0 + ai * HALF + m * 16) * ZP + c0) = pack8(acc[ai][bj][m][0], acc[ai][bj][m][1]); }
    }
};
struct EpiOutProj {
    static constexpr bool PERM = true, AFTER_DRAIN = false;
    const float* xin; bf16_t* xb; float* ssq_out;
    __device__ __forceinline__ void operator()(const f32x4 (&acc)[2][2][4][2], const Unit& u, int wr, int wc, int fr, int fq) const {
        const int row0 = u.pm * BM + wr * 64 + fr;
#pragma unroll
        for (int ai = 0; ai < 2; ++ai)
#pragma unroll
            for (int m = 0; m < 4; ++m) {
                const int row = row0 + ai * HALF + m * 16; float sq = 0.f;
#pragma unroll
                for (int bj = 0; bj < 2; ++bj) {
                    const size_t off = (size_t)row * DM + u.pn * BM + bj * HALF + wc * 32 + 8 * fq;
                    const f32x4 x0 = *(const f32x4*)(xin + off) + acc[ai][bj][m][0], x1 = *(const f32x4*)(xin + off + 4) + acc[ai][bj][m][1];
                    *(u32x4*)(xb + off) = pack8(x0, x1);
                    sq += ((x0[0] * x0[0] + x0[1] * x0[1]) + (x0[2] * x0[2] + x0[3] * x0[3])) + ((x1[0] * x1[0] + x1[1] * x1[1]) + (x1[2] * x1[2] + x1[3] * x1[3]));
                }
                sq += __shfl_xor(sq, 16); sq += __shfl_xor(sq, 32);
                if (fq == 0) ssq_out[(size_t)row * 16 + u.pn * 4 + wc] = sq;
            }
    }
};
struct EpiGate {
    static constexpr bool PERM = true, AFTER_DRAIN = false;
    float* xout; const bf16_t* x1b; const bf16_t* pp; bf16_t* xb; const float* ssq_in; float* ssq_out;
    __device__ __forceinline__ void operator()(const f32x4 (&acc)[2][2][4][2], const Unit& u, int wr, int wc, int fr, int fq) const {
        const int row0 = u.pm * BM + wr * 64 + fr;
#pragma unroll
        for (int ai = 0; ai < 2; ++ai)
#pragma unroll
            for (int m = 0; m < 4; ++m) {
                const int row = row0 + ai * HALF + m * 16; float sq = 0.f;
                const float rs = row_rstd(ssq_in + (size_t)row * 16);
#pragma unroll
                for (int bj = 0; bj < 2; ++bj) {
                    const size_t off = (size_t)row * DM + u.pn * BM + bj * HALF + wc * 32 + 8 * fq;
                    f32x4 g0 = acc[ai][bj][m][0] * rs, g1 = acc[ai][bj][m][1] * rs;
#pragma unroll
                    for (int i = 0; i < 4; ++i) { g0[i] = sigmoidf_(g0[i]); g1[i] = sigmoidf_(g1[i]); }
                    const u32x4 pw = *(const u32x4*)(pp + off); const f32x4 pp0 = {bflo(pw.x), bfhi(pw.x), bflo(pw.y), bfhi(pw.y)}, pp1 = {bflo(pw.z), bfhi(pw.z), bflo(pw.w), bfhi(pw.w)};
                    const u32x4 xw = *(const u32x4*)(x1b + off); const f32x4 xa = {bflo(xw.x), bfhi(xw.x), bflo(xw.y), bfhi(xw.y)}, xc = {bflo(xw.z), bfhi(xw.z), bflo(xw.w), bfhi(xw.w)};
                    const f32x4 x0 = xa + g0 * pp0, x1 = xc + g1 * pp1;
                    *(f32x4*)(xout + off) = x0; *(f32x4*)(xout + off + 4) = x1;
                    *(u32x4*)(xb + off) = pack8(x0, x1);
                    sq += ((x0[0] * x0[0] + x0[1] * x0[1]) + (x0[2] * x0[2] + x0[3] * x0[3])) + ((x1[0] * x1[0] + x1[1] * x1[1]) + (x1[2] * x1[2] + x1[3] * x1[3]));
                }
                sq += __shfl_xor(sq, 16); sq += __shfl_xor(sq, 32);
                if (fq == 0) ssq_out[(size_t)row * 16 + u.pn * 4 + wc] = sq;
            }
    }
};
struct EpiBf16Plain {
    static constexpr bool PERM = true, AFTER_DRAIN = false;
    bf16_t* C;
    __device__ __forceinline__ void operator()(const f32x4 (&acc)[2][2][4][2], const Unit& u, int wr, int wc, int fr, int fq) const {
        const int row0 = u.pm * BM + wr * 64 + fr;
#pragma unroll
        for (int ai = 0; ai < 2; ++ai)
#pragma unroll
            for (int m = 0; m < 4; ++m)
#pragma unroll
                for (int bj = 0; bj < 2; ++bj) {
                    const size_t off = (size_t)(row0 + ai * HALF + m * 16) * DM + u.pn * BM + bj * HALF + wc * 32 + 8 * fq;
                    *(u32x4*)(C + off) = pack8(acc[ai][bj][m][0], acc[ai][bj][m][1]);
                }
    }
};
struct EpiF32 {
    static constexpr bool PERM = true, AFTER_DRAIN = false;
    float* C;
    __device__ __forceinline__ void operator()(const f32x4 (&acc)[2][2][4][2], const Unit& u, int wr, int wc, int fr, int fq) const {
        const int row0 = u.pm * BM + wr * 64 + fr;
#pragma unroll
        for (int ai = 0; ai < 2; ++ai)
#pragma unroll
            for (int m = 0; m < 4; ++m)
#pragma unroll
                for (int bj = 0; bj < 2; ++bj) {
                    const size_t off = (size_t)(row0 + ai * HALF + m * 16) * DM + u.pn * BM + bj * HALF + wc * 32 + 8 * fq;
                    *(f32x4*)(C + off) = acc[ai][bj][m][0]; *(f32x4*)(C + off + 4) = acc[ai][bj][m][1];
                }
    }
};
}
typedef GAS unsigned gu32;
#define RLX_AGENT __ATOMIC_RELAXED, __HIP_MEMORY_SCOPE_AGENT
#define XB_TMO      128
#define XB_XCNT(j)  (256  + 64 * (j))
#define XB_XSUB(j)  (1280 + 64 * (j))
#define XB_XGEN(j)  (2304 + 64 * (j))
#define XB_TOP      3328
#define XB_TOPGEN   3392
#define XCD_BAR_WORDS 3456
#define XB_SPIN_CAP (1u << 27)

__device__ __forceinline__ unsigned xb_ld(unsigned* p)              { return __hip_atomic_load(p, __ATOMIC_RELAXED, __HIP_MEMORY_SCOPE_AGENT); }
__device__ __forceinline__ unsigned xb_add(unsigned* p, unsigned v) { return __hip_atomic_fetch_add(p, v, __ATOMIC_RELAXED, __HIP_MEMORY_SCOPE_AGENT); }
__device__ __forceinline__ unsigned xb_xcc_id() { return (unsigned)__builtin_amdgcn_s_getreg((3 << 11) | 20) & 0xFu; }
#define XB_SPIN(cond, bar) do { unsigned _sp = 0; while (cond) { __builtin_amdgcn_s_sleep(1); \
    if ((++_sp & 255u) == 0u) { if (xb_ld(&(bar)[XB_TMO])) break; if (_sp > XB_SPIN_CAP) { atomicAdd(&(bar)[XB_TMO], 1u); break; } } } } while (0)

struct XcdBarrier {
    unsigned* bar; unsigned x;
    volatile LAS unsigned* st;
};

__device__ __forceinline__ XcdBarrier xcd_barrier_post(unsigned* bar, volatile LAS unsigned* st) {
    XcdBarrier b; b.bar = bar; b.x = xb_xcc_id(); b.st = st;
    if (threadIdx.x == 0) (void)xb_add(&bar[XB_XCNT(b.x)], 1u);
    return b;
}
__device__ __forceinline__ void xcd_barrier_complete(unsigned* bar, unsigned x, unsigned& nloc, unsigned& nx) {
    const unsigned G = gridDim.x * gridDim.y * gridDim.z;
    unsigned sum, cnt, mine, sp = 0u;
    for (;;) {
        sum = 0u; cnt = 0u; mine = 0u;
#pragma unroll
        for (unsigned j = 0; j < 16; ++j) { const unsigned c = xb_ld(&bar[XB_XCNT(j)]); sum += c; cnt += (c > 0u) ? 1u : 0u; mine = (j == x) ? c : mine; }
        if (sum == G) break;
        __builtin_amdgcn_s_sleep(1);
        if ((++sp & 255u) == 0u) { if (xb_ld(&bar[XB_TMO])) break; if (sp > XB_SPIN_CAP) { atomicAdd(&bar[XB_TMO], 1u); break; } }
    }
    nloc = mine > 0u ? mine : 1u; nx = cnt > 0u ? cnt : 1u;
}

__device__ __forceinline__ void xcd_barrier(const XcdBarrier& b) {
    asm volatile("s_waitcnt vmcnt(0)" ::: "memory");
    __syncthreads();
    if (threadIdx.x == 0) {
        unsigned* bar = b.bar;
        __builtin_amdgcn_s_waitcnt(0);
        unsigned nloc = b.st[0], nx = b.st[1];
        if (nloc == 0u) { xcd_barrier_complete(bar, b.x, nloc, nx); b.st[0] = nloc; b.st[1] = nx; }
        const unsigned old = xb_add(&bar[XB_XSUB(b.x)], 1u);
        const unsigned gen = old / nloc;
        if (old + 1u == (gen + 1u) * nloc) {
            __builtin_amdgcn_fence(__ATOMIC_RELEASE, "agent");
            asm volatile("s_waitcnt vmcnt(0)" ::: "memory");
            const unsigned og = xb_add(&bar[XB_TOP], 1u);
            const unsigned tg = og / nx;
            if (og + 1u == (tg + 1u) * nx) xb_add(&bar[XB_TOPGEN], 1u);
            else XB_SPIN(xb_ld(&bar[XB_TOPGEN]) == tg, bar);
            __builtin_amdgcn_fence(__ATOMIC_ACQUIRE, "agent");
            xb_add(&bar[XB_XGEN(b.x)], 1u);
            asm volatile("s_waitcnt vmcnt(0)" ::: "memory");
        } else {
            XB_SPIN(xb_ld(&bar[XB_XGEN(b.x)]) == gen, bar);
            __builtin_amdgcn_fence(__ATOMIC_ACQUIRE, "agent");
            asm volatile("s_waitcnt vmcnt(0)" ::: "memory");
        }
    }
    __syncthreads();
}
struct MixArgs { const bf16_t* Z; bf16_t* Y; const bf16_t* KV; const bf16_t* IKC; const float* mu; const float* w0; const float* w_up; const float* a0; const float* a_up; const float* k_k; const float* k_a; const float* r_k; const float* ln_g; const float* ln_b; };
namespace dsa {
#ifdef PROBE_T
#define DTS ((volatile LAS unsigned long long*)((LAS unsigned char*)ldsb + 131072 + 1024))
#define DSTAMP_B(id) do { if ((id) == PROBE_T && blockIdx.x == 0 && threadIdx.x == 0) DTS[0] = __builtin_amdgcn_s_memrealtime(); } while (0)
#define DSTAMP_E(id) do { if ((id) == PROBE_T && blockIdx.x == 0 && threadIdx.x == 0) DTS[1] += __builtin_amdgcn_s_memrealtime() - DTS[0]; } while (0)
#else
#define DSTAMP_B(id) do {} while (0)
#define DSTAMP_E(id) do {} while (0)
#endif
#define MFMA32(a, b, c) __builtin_amdgcn_mfma_f32_32x32x16_bf16((a), (b), (c), 0, 0, 0)
typedef short v4i16_t __attribute__((ext_vector_type(4)));
typedef short s16x4 __attribute__((ext_vector_type(4)));
constexpr int WAVE_LDS = 2048 + 4096;
constexpr int IKS_OFF = 8 * WAVE_LDS, IKS_BYTES = 65536;
__device__ __forceinline__ unsigned fkey(float f) { const unsigned b = __builtin_bit_cast(unsigned, f); return (b & 0x80000000u) ? ~b : (b | 0x80000000u); }
__device__ __forceinline__ float keyf(unsigned u) { const unsigned b = (u & 0x80000000u) ? (u & 0x7fffffffu) : ~u; return __builtin_bit_cast(float, b); }
__device__ __forceinline__ float relu_(float x) { const int b = __builtin_bit_cast(int, x); return __builtin_bit_cast(float, b > 0 ? b : 0); }
__device__ __forceinline__ s16x4 vtr(const LAS unsigned char* p) { return __builtin_bit_cast(s16x4, __builtin_amdgcn_ds_read_tr16_b64_v4i16((LAS v4i16_t*)p)); }

#define DPP_(v, ctrl) ((unsigned)__builtin_amdgcn_update_dpp((int)(v), (int)(v), (ctrl), 0xf, 0xf, false))
__device__ __forceinline__ unsigned half_min(unsigned v) { v = min(v, DPP_(v, 0xB1)); v = min(v, DPP_(v, 0x4E)); v = min(v, DPP_(v, 0x141)); v = min(v, DPP_(v, 0x140)); return min(v, (unsigned)__builtin_amdgcn_ds_swizzle((int)v, 0x401F)); }
__device__ __forceinline__ unsigned half_max(unsigned v) { v = max(v, DPP_(v, 0xB1)); v = max(v, DPP_(v, 0x4E)); v = max(v, DPP_(v, 0x141)); v = max(v, DPP_(v, 0x140)); return max(v, (unsigned)__builtin_amdgcn_ds_swizzle((int)v, 0x401F)); }
__device__ __forceinline__ int half_sum(int v) { v += (int)DPP_(v, 0xB1); v += (int)DPP_(v, 0x4E); v += (int)DPP_(v, 0x141); v += (int)DPP_(v, 0x140); return v + __builtin_amdgcn_ds_swizzle(v, 0x401F); }
__device__ __forceinline__ unsigned next_pivot(unsigned ulo, unsigned uhi, int clo, int chi, int it) {
    unsigned p;
    const bool hl = clo >= 0, hh = chi >= 0;
    if (it == 0) p = fkey(0.0f);
    else if (!hh) { const float f = keyf(ulo); p = fkey(f >= 0.f ? 2.f * f + 0.25f : 0.5f * f + 0.125f); }
    else if (!hl) { const float f = keyf(uhi); p = fkey(f <= 0.f ? 2.f * f - 0.25f : 0.5f * f - 0.125f); }
    else { const float fl = keyf(ulo), fh = keyf(uhi);
        float fr = ((float)(clo - 256) + 0.5f) * __builtin_amdgcn_rcpf((float)(clo - chi)); fr = fminf(fmaxf(fr, 1.f / 32.f), 31.f / 32.f);
        if (it % 3 == 2) fr = 0.5f;
        p = fkey(fl + (fh - fl) * fr); }
    if (!(p > ulo && p < uhi)) p = ulo + ((uhi - ulo) >> 1);
    return p;
}

__device__ __forceinline__ void dsa_unit(const MixArgs& a, unsigned char* ldsb, int b, int blk) {
    const int tid = opaque_tid(), lane = tid & 63, wave = __builtin_amdgcn_readfirstlane(tid >> 6), r32 = lane & 31, hi = lane >> 5;
    const GAS bf16_t* zb = (const GAS bf16_t*)a.Z + (size_t)b * SEQ * ZP;
    LAS unsigned char* wl = (LAS unsigned char*)ldsb + wave * WAVE_LDS;
    LAS unsigned* bm = (LAS unsigned*)wl;
    LAS unsigned char* vimg = wl + 2048;
    const int tw = blk * 64 + 8 * wave;
    f32x16 zero16;
#pragma unroll
    for (int i = 0; i < 16; ++i) zero16[i] = 0.f;
#ifdef PROBE_SEL
#define NRND 4
#else
#define NRND 2
#endif
#pragma unroll 1
    for (int rnd_ = 0; rnd_ < NRND; ++rnd_) { const int rnd = rnd_ & 1;
        const int tb = tw + 4 * rnd;
        const int qsub = 2 * ((r32 >> 2) & 1) + (r32 >> 4), head = (r32 & 3) + 4 * ((r32 >> 3) & 1);
        const GAS bf16_t* iqp = zb + (size_t)(tb + qsub) * ZP + ZB_IQ + head * 32 + 8 * hi;
        bf16x8 aiq0, aiq1;
        { const u32x4 r0 = *(const GAS u32x4*)iqp, r1 = *(const GAS u32x4*)(iqp + 16); const float wr = bf2f(zb[(size_t)(tb + qsub) * ZP + ZB_IW + head]);
          u32x4 s0, s1;
          s0.x = pk2(bflo(r0.x) * wr, bfhi(r0.x) * wr); s0.y = pk2(bflo(r0.y) * wr, bfhi(r0.y) * wr); s0.z = pk2(bflo(r0.z) * wr, bfhi(r0.z) * wr); s0.w = pk2(bflo(r0.w) * wr, bfhi(r0.w) * wr);
          s1.x = pk2(bflo(r1.x) * wr, bfhi(r1.x) * wr); s1.y = pk2(bflo(r1.y) * wr, bfhi(r1.y) * wr); s1.z = pk2(bflo(r1.z) * wr, bfhi(r1.z) * wr); s1.w = pk2(bflo(r1.w) * wr, bfhi(r1.w) * wr);
          aiq0 = __builtin_bit_cast(bf16x8, s0); aiq1 = __builtin_bit_cast(bf16x8, s1); }
        const int tqA = tb + 2 * hi, tqB = tqA + 1;
        float wA[8], wB[8];
        { const u32x4 ua = *(const GAS u32x4*)(zb + (size_t)tqA * ZP + ZB_IW), ub = *(const GAS u32x4*)(zb + (size_t)tqB * ZP + ZB_IW);
          wA[0] = bflo(ua.x); wA[1] = bfhi(ua.x); wA[2] = bflo(ua.y); wA[3] = bfhi(ua.y); wA[4] = bflo(ua.z); wA[5] = bfhi(ua.z); wA[6] = bflo(ua.w); wA[7] = bfhi(ua.w);
          wB[0] = bflo(ub.x); wB[1] = bfhi(ub.x); wB[2] = bflo(ub.y); wB[3] = bfhi(ub.y); wB[4] = bflo(ub.z); wB[5] = bfhi(ub.z); wB[6] = bflo(ub.w); wB[7] = bfhi(ub.w); }
#pragma unroll
        for (int r = 0; r < 8; ++r) { wA[r] = (wA[r] > 0.f) ? INFINITY : -INFINITY; wB[r] = (wB[r] > 0.f) ? INFINITY : -INFINITY; }
        unsigned scA[64], scB[64];
        const int dA = tqA - 32 * ((tb + 3) >> 5);
        const int Tmax = (tb + 3) >> 5;
        int Tm_s = Tmax, Tm_b = Tmax; asm volatile("" : "+s"(Tm_s), "+s"(Tm_b));
        DSTAMP_B(30);
        const int TmaxU = 2 * blk + 1;
        const int fsw = (r32 >> 2) & 3;
        const LAS unsigned char* ikl = (const LAS unsigned char*)ldsb + IKS_OFF + r32 * 64;
        const int off0 = (hi ^ fsw) * 16, off1 = ((2 + hi) ^ fsw) * 16;
#ifdef PROBE_SCORE
        for (int rep_ = 0; rep_ < 2; ++rep_)
#endif
#pragma unroll
        for (int half = 0; half < 2; ++half) {
            if (32 * half <= TmaxU) {
                __syncthreads();
                { const int nkeys = min(32 * (TmaxU + 1) - 1024 * half, 1024);
                  const GAS bf16_t* src = (const GAS bf16_t*)a.IKC + ((size_t)b * SEQ + 1024 * half) * 32;
                  for (int ch = tid; ch < nkeys * 4; ch += 512) { const int key = ch >> 2, c4 = ch & 3;
                      *(LAS u32x4*)((LAS unsigned char*)ldsb + IKS_OFF + key * 64 + ((c4 ^ ((key >> 2) & 3)) * 16)) = *(const GAS u32x4*)(src + key * 32 + c4 * 8); } }
                asm volatile("s_waitcnt vmcnt(0) lgkmcnt(0)" ::: "memory");
                __syncthreads();
                bf16x8 kb0[2], kb1[2];
#pragma unroll
                for (int i = 0; i < 2; ++i) { if (32 * half + i <= Tm_s) { kb0[i] = *(const LAS bf16x8*)(ikl + i * 2048 + off0); kb1[i] = *(const LAS bf16x8*)(ikl + i * 2048 + off1); } }
#pragma unroll
                for (int i = 0; i < 32; ++i) { const int T = 32 * half + i;
                    if (T <= Tm_s) {
                        f32x16 c = MFMA32(aiq0, kb0[i & 1], zero16); c = MFMA32(aiq1, kb1[i & 1], c);
                        if (i + 2 < 32 && T + 2 <= Tm_s) { kb0[i & 1] = *(const LAS bf16x8*)(ikl + (i + 2) * 2048 + off0); kb1[i & 1] = *(const LAS bf16x8*)(ikl + (i + 2) * 2048 + off1); }
                        float sA = 0.f, sB = 0.f;
#pragma unroll
                        for (int r = 0; r < 8; ++r) { sA += __builtin_amdgcn_fmed3f(c[r], 0.f, wA[r]); sB += __builtin_amdgcn_fmed3f(c[8 + r], 0.f, wB[r]); }
                        const bool last = (T == Tm_s);
                        scA[T] = (!last || r32 <= dA) ? fkey(sA + 0.f) : 0u; scB[T] = (!last || r32 <= dA + 1) ? fkey(sB + 0.f) : 0u;
                    } else { scA[T] = 0u; scB[T] = 0u; }
                }
            } else {
#pragma unroll
                for (int i = 0; i < 32; ++i) { scA[32 * half + i] = 0u; scB[32 * half + i] = 0u; }
            }
        }
        DSTAMP_E(30); DSTAMP_B(31);
        const int nA = tqA + 1, nB = tqB + 1;
        unsigned uloA = 1u, uhiA = 0xffffffffu, uloB = 1u, uhiB = 0xffffffffu; int cloA = -1, chiA = -1, cloB = -1, chiB = -1;
        bool doneA = nA <= 256, doneB = nB <= 256;
        unsigned thA = 1u, thB = 1u; int needA = 0, needB = 0;
        int itn = 0, lim = 128;
        constexpr int CAP = 12;
        LAS unsigned* lstA = (LAS unsigned*)((LAS unsigned char*)ldsb + IKS_OFF + wave * 8192) + lane * (CAP + 1), *lstB = lstA + 64 * (CAP + 1);
        unsigned ca_[CAP], cb_[CAP];
        for (;;) {
            DSTAMP_B(34);
            for (; itn < 200; ++itn) {
                if (!doneA && uhiA - uloA <= 1u) { thA = uhiA; needA = 256 - max(chiA, 0); doneA = true; }
                if (!doneB && uhiB - uloB <= 1u) { thB = uhiB; needB = 256 - max(chiB, 0); doneB = true; }
                const bool actA = !doneA && ((cloA < 0 ? nA : cloA) - max(chiA, 0) > lim), actB = !doneB && ((cloB < 0 ? nB : cloB) - max(chiB, 0) > lim);
                if (!__any(actA || actB)) break;
                const unsigned pA = actA ? next_pivot(uloA, uhiA, cloA, chiA, itn) : 0xffffffffu, pB = actB ? next_pivot(uloB, uhiB, cloB, chiB, itn) : 0xffffffffu;
                int ca = 0, cb = 0;
#pragma unroll
                for (int T = 0; T < 64; ++T)
                    asm("v_cmp_ge_u32 vcc, %2, %3\n\tv_addc_co_u32 %0, vcc, 0, %0, vcc\n\tv_cmp_ge_u32 vcc, %4, %5\n\tv_addc_co_u32 %1, vcc, 0, %1, vcc" : "+v"(ca), "+v"(cb) : "v"(scA[T]), "v"(pA), "v"(scB[T]), "v"(pB) : "vcc");
                const int pk = half_sum(ca | (cb << 16));
                ca = pk & 0xffff; cb = pk >> 16;
                if (actA) { if (ca == 256) { thA = pA; needA = 0; doneA = true; } else if (ca > 256) { uloA = pA; cloA = ca; } else { uhiA = pA; chiA = ca; } }
                if (actB) { if (cb == 256) { thB = pB; needB = 0; doneB = true; } else if (cb > 256) { uloB = pB; cloB = cb; } else { uhiB = pB; chiB = cb; } }
            }
            DSTAMP_E(34);
            if (!__any(!doneA || !doneB)) break;
            DSTAMP_B(35);
            const unsigned wA_ = doneA ? 0u : uhiA - uloA, wB_ = doneB ? 0u : uhiB - uloB;
            int nA_ = 0, nB_ = 0;
#pragma unroll
            for (int T = 0; T < 64; ++T) {
                lstA[min(nA_, CAP)] = scA[T]; lstB[min(nB_, CAP)] = scB[T];
                nA_ += ((scA[T] - uloA) < wA_) ? 1 : 0; nB_ += ((scB[T] - uloB) < wB_) ? 1 : 0;
            }
            asm volatile("s_waitcnt lgkmcnt(0)" ::: "memory");
            if (__any(nA_ > CAP || nB_ > CAP) && itn < 200) { lim >>= 1; continue; }
#pragma unroll
            for (int j = 0; j < CAP; ++j) { ca_[j] = (j < nA_) ? lstA[j] : 0u; cb_[j] = (j < nB_) ? lstB[j] : 0u; }
            DSTAMP_E(35);
            break;
        }
        if (__any(!doneA || !doneB)) {
            DSTAMP_B(36);
            const int baseA = max(chiA, 0), baseB = max(chiB, 0);
            for (; itn < 400; ++itn) {
                unsigned mnA = 0xffffffffu, mxA = 0u, mnB = 0xffffffffu, mxB = 0u;
                const unsigned wa = doneA ? 0u : uhiA - uloA, wb = doneB ? 0u : uhiB - uloB;
#pragma unroll
                for (int j = 0; j < CAP; ++j) { if ((ca_[j] - uloA) < wa) { mnA = min(mnA, ca_[j]); mxA = max(mxA, ca_[j]); } if ((cb_[j] - uloB) < wb) { mnB = min(mnB, cb_[j]); mxB = max(mxB, cb_[j]); } }
                mnA = half_min(mnA); mxA = half_max(mxA); mnB = half_min(mnB); mxB = half_max(mxB);
                if (!doneA) { if (mnA >= mxA) { thA = mxA + 1u; needA = 256 - max(chiA, 0); doneA = true; } else { uloA = mnA; uhiA = mxA + 1u; if (cloA < 0) cloA = nA; if (chiA < 0) chiA = 0; } }
                if (!doneB) { if (mnB >= mxB) { thB = mxB + 1u; needB = 256 - max(chiB, 0); doneB = true; } else { uloB = mnB; uhiB = mxB + 1u; if (cloB < 0) cloB = nB; if (chiB < 0) chiB = 0; } }
                if (!__any(!doneA || !doneB)) break;
                const unsigned pA = doneA ? 0xffffffffu : next_pivot(uloA, uhiA, cloA, chiA, itn | 1), pB = doneB ? 0xffffffffu : next_pivot(uloB, uhiB, cloB, chiB, itn | 1);
                int pk = 0;
#pragma unroll
                for (int j = 0; j < CAP; ++j) pk += ((ca_[j] >= pA) ? 1 : 0) + ((cb_[j] >= pB) ? 0x10000 : 0);
                pk = half_sum(pk);
                const int ca = baseA + (pk & 0xffff), cb = baseB + (pk >> 16);
                if (!doneA) { if (ca == 256) { thA = pA; needA = 0; doneA = true; } else if (ca > 256) { uloA = pA; cloA = ca; } else { uhiA = pA; chiA = ca; } }
                if (!doneB) { if (cb == 256) { thB = pB; needB = 0; doneB = true; } else if (cb > 256) { uloB = pB; cloB = cb; } else { uhiB = pB; chiB = cb; } }
            }
            DSTAMP_E(36);
        }
        DSTAMP_E(31); DSTAMP_B(32);
        int rem0 = __builtin_amdgcn_readlane(needA, 0), rem1 = __builtin_amdgcn_readlane(needB, 0), rem2 = __builtin_amdgcn_readlane(needA, 32), rem3 = __builtin_amdgcn_readlane(needB, 32);
        const bool anytie = (rem0 | rem1 | rem2 | rem3) != 0;
        LAS unsigned* bmr = bm + 4 * rnd; asm volatile("" : "+v"(bmr));
#pragma unroll
        for (int T = 0; T < 64; ++T) {
            if (T <= Tm_b) {
                const unsigned long long mA = __ballot(scA[T] >= thA), mB = __ballot(scB[T] >= thB);
                unsigned m0 = (unsigned)mA, m2 = (unsigned)(mA >> 32), m1 = (unsigned)mB, m3 = (unsigned)(mB >> 32);
                if (anytie) {
                    const unsigned long long eA = __ballot(scA[T] == thA - 1u), eB = __ballot(scB[T] == thB - 1u);
                    unsigned e0 = (unsigned)eA, e2 = (unsigned)(eA >> 32), e1 = (unsigned)eB, e3 = (unsigned)(eB >> 32);
                    while (rem0 > 0 && e0) { const unsigned bit = e0 & (0u - e0); m0 |= bit; e0 ^= bit; --rem0; }
                    while (rem1 > 0 && e1) { const unsigned bit = e1 & (0u - e1); m1 |= bit; e1 ^= bit; --rem1; }
                    while (rem2 > 0 && e2) { const unsigned bit = e2 & (0u - e2); m2 |= bit; e2 ^= bit; --rem2; }
                    while (rem3 > 0 && e3) { const unsigned bit = e3 & (0u - e3); m3 |= bit; e3 ^= bit; --rem3; }
                }
                if (lane == 0) { u32x4 w; w.x = m0; w.y = m1; w.z = m2; w.w = m3; *(LAS u32x4*)(bmr + T * 8) = w; }
            }
        }
        DSTAMP_E(32);
    }
    DSTAMP_B(33);
    asm volatile("s_waitcnt lgkmcnt(0)" ::: "memory");
    const int qc = r32 >> 2, hc = r32 & 3;
    const GAS bf16_t* kvb = (const GAS bf16_t*)a.KV + (size_t)b * SEQ * 128;
    const size_t qrow = (size_t)(b * SEQ + tw + qc);
    bf16x8 bq[4];
#pragma unroll
    for (int s = 0; s < 4; ++s) bq[s] = *(const GAS bf16x8*)((const GAS bf16_t*)a.Z + qrow * ZP + ZB_Q + hc * 64 + 16 * s + 8 * hi);
    f32x16 o0 = zero16, o1 = zero16, lacc = zero16; float lsum = 0.f;
    const bf16x8 ones8 = {(short)0x3f80, (short)0x3f80, (short)0x3f80, (short)0x3f80, (short)0x3f80, (short)0x3f80, (short)0x3f80, (short)0x3f80};
    const int Tend = (tw + 7) >> 5;
    const int g16 = lane >> 4, i16 = lane & 15, q4 = i16 >> 2, p4 = i16 & 3;
    const int vrd = ((g16 >> 1) * 4 + q4) * 64 + (16 * (g16 & 1) + 4 * p4) * 2;
    const int vwr_key = lane >> 3, vwr_ch = lane & 7;
    u32x4 vst[4]; bf16x8 ak[4];
    auto load_tile = [&](int T) {
#pragma unroll
        for (int s = 0; s < 4; ++s) ak[s] = *(const GAS bf16x8*)(kvb + (size_t)(32 * T + r32) * 128 + 16 * s + 8 * hi);
#pragma unroll
        for (int i = 0; i < 4; ++i) vst[i] = *(const GAS u32x4*)(kvb + (size_t)(32 * T + vwr_key + 8 * i) * 128 + 64 + 8 * vwr_ch);
    };
#ifdef PROBE_ATT
    for (int rep_ = 0; rep_ < 2; ++rep_) { o0 = zero16; o1 = zero16; lacc = zero16; lsum = 0.f;
#endif
    load_tile(0);
#pragma unroll 1
    for (int T = 0; T <= Tend; ++T) {
#pragma unroll
        for (int i = 0; i < 4; ++i) *(LAS u32x4*)(vimg + (vwr_ch >> 2) * 2048 + (vwr_key + 8 * i) * 64 + (vwr_ch & 3) * 16) = vst[i];
        f32x16 sacc = MFMA32(ak[0], bq[0], zero16); sacc = MFMA32(ak[1], bq[1], sacc); sacc = MFMA32(ak[2], bq[2], sacc); sacc = MFMA32(ak[3], bq[3], sacc);
        const unsigned mw = bm[T * 8 + qc] >> (4 * hi);
        if (T < Tend) load_tile(T + 1);
        asm volatile("s_waitcnt lgkmcnt(0)" ::: "memory");
        s16x4 va[2][2][2];
#pragma unroll
        for (int dt = 0; dt < 2; ++dt)
#pragma unroll
            for (int s = 0; s < 2; ++s) { va[dt][s][0] = vtr(vimg + dt * 2048 + (16 * s) * 64 + vrd); va[dt][s][1] = vtr(vimg + dt * 2048 + (16 * s + 8) * 64 + vrd); }
        unsigned pw[8];
#pragma unroll
        for (int r = 0; r < 16; r += 2) {
            float m0, m1; asm("v_min_f32 %0, 0x42800000, %1" : "=v"(m0) : "v"(sacc[r])); asm("v_min_f32 %0, 0x42800000, %1" : "=v"(m1) : "v"(sacc[r + 1]));
            const unsigned pkw = pk2(__builtin_amdgcn_exp2f(m0), __builtin_amdgcn_exp2f(m1));
            const int c0 = (r & 3) + 8 * (r >> 2), c1 = ((r + 1) & 3) + 8 * ((r + 1) >> 2);
            const unsigned a_ = (unsigned)__builtin_amdgcn_sbfe((int)mw, c0, 1), b_ = (unsigned)__builtin_amdgcn_sbfe((int)mw, c1, 1);
            pw[r >> 1] = pkw & ((a_ & 0xffffu) | (b_ & 0xffff0000u));
        }
        asm volatile("s_waitcnt lgkmcnt(0)" ::: "memory");
#pragma unroll
        for (int s = 0; s < 2; ++s) {
            u32x4 pv4; pv4.x = pw[4 * s]; pv4.y = pw[4 * s + 1]; pv4.z = pw[4 * s + 2]; pv4.w = pw[4 * s + 3];
            const bf16x8 pb = __builtin_bit_cast(bf16x8, pv4);
            const bf16x8 v0 = __builtin_shufflevector(va[0][s][0], va[0][s][1], 0, 1, 2, 3, 4, 5, 6, 7), v1 = __builtin_shufflevector(va[1][s][0], va[1][s][1], 0, 1, 2, 3, 4, 5, 6, 7);
            o0 = MFMA32(v0, pb, o0); o1 = MFMA32(v1, pb, o1); lacc = MFMA32(ones8, pb, lacc);
        }
    }
#ifdef PROBE_ATT
    }
#endif
    DSTAMP_E(33);
    lsum = lacc[0];
    const float rl = 1.0f / lsum;
    const GAS bf16_t* gp = (const GAS bf16_t*)a.Z + qrow * ZP + ZB_G + hc * 64; GAS bf16_t* yp = (GAS bf16_t*)a.Y + qrow * DM + 384 + hc * 64;
#pragma unroll
    for (int dt = 0; dt < 2; ++dt)
#pragma unroll
        for (int i = 0; i < 4; ++i) {
            const int d = 32 * dt + 8 * i + 4 * hi;
            const u32x2 gw = *(const GAS u32x2*)(gp + d);
            const float g0 = bflo(gw.x), g1 = bfhi(gw.x), g2 = bflo(gw.y), g3 = bfhi(gw.y);
            const f32x16& o = dt ? o1 : o0;
            u32x2 w; w.x = pk2(o[4 * i] * rl * g0 * sigmoidf_(g0), o[4 * i + 1] * rl * g1 * sigmoidf_(g1)); w.y = pk2(o[4 * i + 2] * rl * g2 * sigmoidf_(g2), o[4 * i + 3] * rl * g3 * sigmoidf_(g3));
            *(GAS u32x2*)(yp + d) = w;
        }
}
}
namespace dil {
using dsa::vtr; using dsa::s16x4;
__device__ __forceinline__ void dil_unit(const MixArgs& a, float* LQ, unsigned char* ldsb, int b, int gi, int u16) {
    const int tid = opaque_tid(), lane = tid & 63, wave = __builtin_amdgcn_readfirstlane(tid >> 6), r32 = lane & 31, hi = lane >> 5;
    const int rate = (gi == 0) ? 1 : (gi == 1) ? 4 : 16, nblk = 16 / rate, c = u16 / nblk, qb = u16 % nblk;
    const int head = gi * 2 + (wave >> 2), q0 = 128 * qb + 32 * (wave & 3);
    const GAS bf16_t* zb = (const GAS bf16_t*)a.Z + (size_t)b * SEQ * ZP;
    LAS unsigned char* vimg = (LAS unsigned char*)ldsb + wave * 4096;
    f32x16 zero16;
#pragma unroll
    for (int i = 0; i < 16; ++i) zero16[i] = 0.f;
    const size_t qrow = (size_t)b * SEQ + (size_t)(q0 + r32) * rate + c;
    bf16x8 bq[4];
#pragma unroll
    for (int s = 0; s < 4; ++s) bq[s] = *(const GAS bf16x8*)((const GAS bf16_t*)a.Z + qrow * ZP + ZC_Q + head * 64 + 16 * s + 8 * hi);
    f32x16 o0 = zero16, o1 = zero16; float lsum = 0.f;
    const int g16 = lane >> 4, i16 = lane & 15, q4 = i16 >> 2, p4 = i16 & 3;
    const int vrd = ((g16 >> 1) * 4 + q4) * 64 + (16 * (g16 & 1) + 4 * p4) * 2;
    const int vwr_key = lane >> 3, vwr_ch = lane & 7;
#pragma unroll 1
    for (int ti = 0; ti < 5; ++ti) {
        const int j0 = q0 - 128 + 32 * ti;
        if (j0 < 0) continue;
        bf16x8 ak[4]; u32x4 vst[4];
#pragma unroll
        for (int s = 0; s < 4; ++s) ak[s] = *(const GAS bf16x8*)(zb + ((size_t)(j0 + r32) * rate + c) * ZP + ZC_K + head * 64 + 16 * s + 8 * hi);
#pragma unroll
        for (int i = 0; i < 4; ++i) vst[i] = *(const GAS u32x4*)(zb + ((size_t)(j0 + vwr_key + 8 * i) * rate + c) * ZP + ZC_V + head * 64 + 8 * vwr_ch);
#pragma unroll
        for (int i = 0; i < 4; ++i) *(LAS u32x4*)(vimg + (vwr_ch >> 2) * 2048 + (vwr_key + 8 * i) * 64 + (vwr_ch & 3) * 16) = vst[i];
        f32x16 sacc = MFMA32(ak[0], bq[0], zero16); sacc = MFMA32(ak[1], bq[1], sacc); sacc = MFMA32(ak[2], bq[2], sacc); sacc = MFMA32(ak[3], bq[3], sacc);
        asm volatile("s_waitcnt lgkmcnt(0)" ::: "memory");
        s16x4 va[2][2][2];
#pragma unroll
        for (int dt = 0; dt < 2; ++dt)
#pragma unroll
            for (int s = 0; s < 2; ++s) { va[dt][s][0] = vtr(vimg + dt * 2048 + (16 * s) * 64 + vrd); va[dt][s][1] = vtr(vimg + dt * 2048 + (16 * s + 8) * 64 + vrd); }
        const int dbase = q0 + r32 - j0 - 4 * hi;
        unsigned pw[8];
#pragma unroll
        for (int r = 0; r < 16; r += 2) {
            const int d0 = dbase - ((r & 3) + 8 * (r >> 2)), d1 = dbase - (((r + 1) & 3) + 8 * ((r + 1) >> 2));
            float p0 = __builtin_amdgcn_exp2f(fminf(sacc[r], 64.f)), p1 = __builtin_amdgcn_exp2f(fminf(sacc[r + 1], 64.f));
            p0 = ((unsigned)d0 <= 128u) ? p0 : 0.f; p1 = ((unsigned)d1 <= 128u) ? p1 : 0.f;
            lsum += p0 + p1;
            pw[r >> 1] = pk2(p0, p1);
        }
        asm volatile("s_waitcnt lgkmcnt(0)" ::: "memory");
#pragma unroll
        for (int s = 0; s < 2; ++s) {
            u32x4 pv4; pv4.x = pw[4 * s]; pv4.y = pw[4 * s + 1]; pv4.z = pw[4 * s + 2]; pv4.w = pw[4 * s + 3];
            const bf16x8 pb = __builtin_bit_cast(bf16x8, pv4);
            const bf16x8 v0 = __builtin_shufflevector(va[0][s][0], va[0][s][1], 0, 1, 2, 3, 4, 5, 6, 7), v1 = __builtin_shufflevector(va[1][s][0], va[1][s][1], 0, 1, 2, 3, 4, 5, 6, 7);
            o0 = MFMA32(v0, pb, o0); o1 = MFMA32(v1, pb, o1);
        }
    }
    lsum += __shfl_xor(lsum, 32);
    if (hi == 0) LQ[qrow * 8 + head] = lsum;
    GAS bf16_t* yp = (GAS bf16_t*)a.Y + qrow * DM + 640 + head * 64;
#pragma unroll
    for (int dt = 0; dt < 2; ++dt)
#pragma unroll
        for (int i = 0; i < 4; ++i) {
            const int d = 32 * dt + 8 * i + 4 * hi; const f32x16& o = dt ? o1 : o0;
            u32x2 w; w.x = pk2(o[4 * i], o[4 * i + 1]); w.y = pk2(o[4 * i + 2], o[4 * i + 3]);
            *(GAS u32x2*)(yp + d) = w;
        }
}
__device__ __forceinline__ void dil_merge(const MixArgs& a, const float* LQ, int first, int nthreads) {
    constexpr int NCH = MTOK * 48;
    for (int id0 = first; id0 < NCH; id0 += 4 * nthreads) {
        u32x4 ow[4], gw[4]; float rl[4];
#pragma unroll
        for (int j = 0; j < 4; ++j) { const int id = id0 + j * nthreads; if (id < NCH) { const int row = id / 48, ch = id % 48;
            ow[j] = *(const GAS u32x4*)((const GAS bf16_t*)a.Y + (size_t)row * DM + 640 + ch * 8); gw[j] = *(const GAS u32x4*)((const GAS bf16_t*)a.Z + (size_t)row * ZP + ZC_G + ch * 8);
            const float* lq = LQ + (size_t)row * 8 + ((ch >> 3) & 1); rl[j] = lq[0] + lq[2] + lq[4]; } }
#pragma unroll
        for (int j = 0; j < 4; ++j) { const int id = id0 + j * nthreads; if (id < NCH) { const int row = id / 48, ch = id % 48; const float r = __builtin_amdgcn_rcpf(rl[j]);
            const unsigned o4[4] = {ow[j].x, ow[j].y, ow[j].z, ow[j].w}, g4[4] = {gw[j].x, gw[j].y, gw[j].z, gw[j].w}; unsigned w4[4];
#pragma unroll
            for (int k = 0; k < 4; ++k) { const float g0 = bflo(g4[k]), g1 = bfhi(g4[k]); w4[k] = pk2(bflo(o4[k]) * r * g0 * sigmoidf_(g0), bfhi(o4[k]) * r * g1 * sigmoidf_(g1)); }
            u32x4 w; w.x = w4[0]; w.y = w4[1]; w.z = w4[2]; w.w = w4[3]; *(GAS u32x4*)((GAS bf16_t*)a.Y + (size_t)row * DM + 640 + ch * 8) = w; } }
    }
}
}
namespace rwkv {
#ifdef PROBE_T
#define RTS ((volatile LAS unsigned long long*)((LAS unsigned char*)ldsb + 131072 + 1024))
#define RST(id_end, id_begin) do { if (blockIdx.x == 0 && threadIdx.x == 0) { const unsigned long long now_ = __builtin_amdgcn_s_memrealtime(); if ((id_end) == PROBE_T) RTS[1] += now_ - RTS[0]; if ((id_begin) == PROBE_T) RTS[0] = now_; } } while (0)
#else
#define RST(a, b) do {} while (0)
#endif
using dsa::vtr; using dsa::s16x4;
constexpr int IP = 144;
constexpr int IMG = 64 * IP;
constexpr int S_WD = 0 * IMG, S_AD = 1 * IMG, S_V = 2 * IMG, S_AT = 3 * IMG, S_BH = 4 * IMG, S_KH = 5 * IMG, S_RT = 6 * IMG, S_KB = 7 * IMG, S_BB = 8 * IMG, S_ARB = 9 * IMG, S_AH = 10 * IMG, S_UV = 11 * IMG;
constexpr int S_AAK = S_WD, S_ARK = S_AD, S_TT = S_BH, S_W1 = S_KH;
constexpr int F_AAB = 12 * IMG;
constexpr int F_LG = S_ARB;
constexpr int F_TOT = F_AAB + 16384;
static_assert(F_TOT + 512 <= 131072 && F_LG + 16384 <= F_AAB, "rwkv LDS map");

struct RArgs { const float* mu; const float* w0; const float* a0; const float* k_k; const float* k_a; const float* r_k; const float* ln_g; const float* ln_b;
               const bf16_t* wupT; const bf16_t* aupT; bf16_t* RQ; bf16_t* RM; bf16_t* RN; float* RG; float* RB; };

__device__ __forceinline__ bf16x8 rowfrag(const LAS unsigned char* img, int r0, int k0, int r32, int hi) { return *(const LAS bf16x8*)(img + (r0 + r32) * IP + (k0 + 8 * hi) * 2); }
__device__ __forceinline__ bf16x8 colfrag(const LAS unsigned char* img, int c0, int k0, int lane) {
    const int g16 = lane >> 4, i16 = lane & 15;
    const LAS unsigned char* p = img + (k0 + 8 * (g16 >> 1) + (i16 >> 2)) * IP + (c0 + 16 * (g16 & 1) + 4 * (i16 & 3)) * 2;
    const s16x4 lo = vtr(p), hi4 = vtr(p + 4 * IP);
    return __builtin_shufflevector(lo, hi4, 0, 1, 2, 3, 4, 5, 6, 7);
}
__device__ __forceinline__ bf16x8 colfrag_perm(const LAS unsigned char* img, int c0, int k0, int lane) {
    const int g16 = lane >> 4, i16 = lane & 15;
    const LAS unsigned char* p = img + (k0 + 4 * (g16 >> 1) + (i16 >> 2)) * IP + (c0 + 16 * (g16 & 1) + 4 * (i16 & 3)) * 2;
    const s16x4 lo = vtr(p), hi4 = vtr(p + 8 * IP);
    return __builtin_shufflevector(lo, hi4, 0, 1, 2, 3, 4, 5, 6, 7);
}
__device__ __forceinline__ bf16x8 rowfrag_f32(const LAS float* img, int r0, int k0, int r32, int hi) {
    const LAS f32x4* p = (const LAS f32x4*)(img + (r0 + r32) * 64 + k0 + 8 * hi); const f32x4 a = p[0], b = p[1];
    u32x4 w; w.x = pk2(a[0], a[1]); w.y = pk2(a[2], a[3]); w.z = pk2(b[0], b[1]); w.w = pk2(b[2], b[3]); return __builtin_bit_cast(bf16x8, w);
}
__device__ __forceinline__ void store_T(LAS unsigned char* imgT, const f32x16& c, int r0, int c0, int r32, int hi) {
#pragma unroll
    for (int g = 0; g < 4; ++g) { u32x2 w; w.x = pk2(c[4 * g], c[4 * g + 1]); w.y = pk2(c[4 * g + 2], c[4 * g + 3]); *(LAS u32x2*)(imgT + (c0 + r32) * IP + (r0 + 8 * g + 4 * hi) * 2) = w; }
}
__device__ __forceinline__ void store_T_global(GAS bf16_t* gT  , const f32x16& c, int r0, int c0, int r32, int hi) {
#pragma unroll
    for (int g = 0; g < 4; ++g) { u32x2 w; w.x = pk2(c[4 * g], c[4 * g + 1]); w.y = pk2(c[4 * g + 2], c[4 * g + 3]); *(GAS u32x2*)(gT + (c0 + r32) * 64 + r0 + 8 * g + 4 * hi) = w; }
}
__device__ __forceinline__ void store_T_global_wt(GAS bf16_t* gT, const f32x16& c, int r0, int c0, int r32, int hi) {
#pragma unroll
    for (int g = 0; g < 4; ++g) { const unsigned long long w = (unsigned long long)pk2(c[4 * g], c[4 * g + 1]) | ((unsigned long long)pk2(c[4 * g + 2], c[4 * g + 3]) << 32);
        __hip_atomic_store((GAS unsigned long long*)(gT + (c0 + r32) * 64 + r0 + 8 * g + 4 * hi), w, __ATOMIC_RELAXED, __HIP_MEMORY_SCOPE_AGENT); }
}
__device__ __forceinline__ f32x16 zero16() { f32x16 z;
#pragma unroll
    for (int i = 0; i < 16; ++i) z[i] = 0.f;
    return z; }
#define WSYNC() asm volatile("s_waitcnt lgkmcnt(0)" ::: "memory")
#define BAR() do { asm volatile("s_waitcnt lgkmcnt(0)" ::: "memory"); __builtin_amdgcn_s_barrier(); asm volatile("" ::: "memory"); } while (0)

constexpr int R1_STG = S_AT;
constexpr int R1_SAVE = 131072 + 2048, R1_PAR = R1_SAVE + 1024, R1_WUP = R1_PAR + 2560, R1_AUP = R1_WUP + IMG;
struct R1Raw { u32x4 c[5]; };
__device__ __forceinline__ void r1_load(const MixArgs& a, R1Raw& raw, int tid, int b, int h, int ck) {
    const int et = tid >> 3, ec = (tid & 7) * 8, hc = h * 64 + ec;
    const GAS bf16_t* zr = (const GAS bf16_t*)a.Z + ((size_t)b * SEQ + ck * 64 + et) * ZP;
    const int cols[5] = {ZA_R + hc, ZA_K + hc, ZA_V + hc, ZA_WD + ec, ZA_AD + ec};
#pragma unroll
    for (int i = 0; i < 5; ++i) raw.c[i] = *(const GAS u32x4*)(zr + cols[i]);
}
__device__ __forceinline__ void r1_load_params(const RArgs& ra, unsigned char* ldsb, int tid, int h) {
    LAS float* par = (LAS float*)((LAS unsigned char*)ldsb + R1_PAR);
    for (int i = tid; i < 640; i += 512) { const int g = i >> 6, c = i & 63; float v;
        if (g == 0) v = ra.mu[ZA_R + h * 64 + c]; else if (g == 1) v = ra.mu[ZA_K + h * 64 + c]; else if (g == 2) v = ra.mu[ZA_V + h * 64 + c]; else if (g == 3) v = ra.mu[ZA_WD + c]; else if (g == 4) v = ra.mu[ZA_AD + c];
        else if (g == 5) v = ra.w0[h * 64 + c]; else if (g == 6) v = ra.a0[h * 64 + c]; else if (g == 7) v = ra.k_k[h * 64 + c]; else if (g == 8) v = ra.k_a[h * 64 + c]; else v = ra.r_k[h * 64 + c];
        par[i] = v; }
    for (int ch = tid; ch < 1024; ch += 512) { const int m = ch >> 9, row = (ch >> 3) & 63, c8 = ch & 7;
        *(LAS u32x4*)((LAS unsigned char*)ldsb + (m ? R1_AUP : R1_WUP) + row * IP + c8 * 16) = *(const GAS u32x4*)((const GAS bf16_t*)(m ? ra.aupT : ra.wupT) + (size_t)(h * 64 + row) * 64 + c8 * 8); }
}
static_assert(65 * 640 <= 5 * IMG, "staging fits");
__device__ __forceinline__ void rwkv_chunk_unit(const MixArgs& a, const RArgs& ra, unsigned char* ldsb, int b, int h, int ck, R1Raw& raw, int prev_mode, bool has_next, int nb, int nh, int nck) {
    const int tid = opaque_tid(), lane = tid & 63, wave = __builtin_amdgcn_readfirstlane(tid >> 6), r32 = lane & 31, hi = lane >> 5;
    LAS unsigned char* L = (LAS unsigned char*)ldsb;
    LAS float* fETA = (LAS float*)(L + F_AAB); LAS float* fAAB = fETA; LAS float* fLG = (LAS float*)(L + F_LG); LAS float* fTOT = (LAS float*)(L + F_TOT);
    const int t0 = ck * 64;
    const size_t row0 = (size_t)b * SEQ + t0;
    const int unit = (b * 6 + h) * 32 + ck;
    RST(-1, 50);
    const int et = tid >> 3, ec = (tid & 7) * 8, hc = h * 64 + ec;
    const LAS float* par = (const LAS float*)(L + R1_PAR);
    float r8[8], k8[8];
    {
        {
            LAS unsigned char* stg = L + R1_STG;
#pragma unroll
            for (int i = 0; i < 5; ++i) *(LAS u32x4*)(stg + (et + 1) * 640 + i * 128 + (tid & 7) * 16) = raw.c[i];
            if (et == 0) {
                const int hc0 = h * 64 + ec; const int cols[5] = {ZA_R + hc0, ZA_K + hc0, ZA_V + hc0, ZA_WD + ec, ZA_AD + ec};
#pragma unroll
                for (int i = 0; i < 5; ++i) { u32x4 pv = zero_u32x4();
                    if (prev_mode == 1) pv = *(const LAS u32x4*)(L + R1_SAVE + i * 128 + (tid & 7) * 16);
                    else if (prev_mode == 2) pv = *(const GAS u32x4*)((const GAS bf16_t*)a.Z + (row0 - 1) * ZP + cols[i]);
                    *(LAS u32x4*)(stg + i * 128 + (tid & 7) * 16) = pv; }
            }
        }
        BAR();
        if (et == 63) {
#pragma unroll
            for (int i = 0; i < 5; ++i) *(LAS u32x4*)(L + R1_SAVE + i * 128 + (tid & 7) * 16) = raw.c[i];
        }
        auto mix8 = [&](int i, int col, float* out) {
            const u32x4 cw = raw.c[i], pw = *(const LAS u32x4*)(L + R1_STG + et * 640 + i * 128 + (tid & 7) * 16);
            const f32x4 m0 = *(const LAS f32x4*)(par + i * 64 + ec), m1 = *(const LAS f32x4*)(par + i * 64 + ec + 4); (void)col;
            const float cv[8] = {bflo(cw.x), bfhi(cw.x), bflo(cw.y), bfhi(cw.y), bflo(cw.z), bfhi(cw.z), bflo(cw.w), bfhi(cw.w)};
            const float pv[8] = {bflo(pw.x), bfhi(pw.x), bflo(pw.y), bfhi(pw.y), bflo(pw.z), bfhi(pw.z), bflo(pw.w), bfhi(pw.w)};
            const float mv[8] = {m0[0], m0[1], m0[2], m0[3], m1[0], m1[1], m1[2], m1[3]};
#pragma unroll
            for (int j = 0; j < 8; ++j) out[j] = cv[j] + (pv[j] - cv[j]) * mv[j];
        };
        float v8[8], wd8[8], ad8[8];
        mix8(0, ZA_R + hc, r8); mix8(1, ZA_K + hc, k8); mix8(2, ZA_V + hc, v8); mix8(3, ZA_WD + ec, wd8); mix8(4, ZA_AD + ec, ad8);
#pragma unroll
        for (int i = 0; i < 8; ++i) wd8[i] = tanhf_(wd8[i]);
        u32x4 w;
        w.x = pk2(wd8[0], wd8[1]); w.y = pk2(wd8[2], wd8[3]); w.z = pk2(wd8[4], wd8[5]); w.w = pk2(wd8[6], wd8[7]); *(LAS u32x4*)(L + S_WD + et * IP + ec * 2) = w;
        w.x = pk2(ad8[0], ad8[1]); w.y = pk2(ad8[2], ad8[3]); w.z = pk2(ad8[4], ad8[5]); w.w = pk2(ad8[6], ad8[7]); *(LAS u32x4*)(L + S_AD + et * IP + ec * 2) = w;
        w.x = pk2(v8[0], v8[1]); w.y = pk2(v8[2], v8[3]); w.z = pk2(v8[4], v8[5]); w.w = pk2(v8[6], v8[7]); *(LAS u32x4*)(L + S_V + et * IP + ec * 2) = w;
    }
    BAR();
    RST(50, 51);
    const int q = wave & 3, tr = q >> 1, tc = q & 1, grp = wave >> 2;
    {
        const LAS unsigned char* Aimg = L + (grp ? S_AD : S_WD);
        f32x16 acc = zero16();
#pragma unroll
        for (int s = 0; s < 4; ++s) acc = MFMA32(rowfrag(Aimg, 32 * tr, 16 * s, r32, hi), rowfrag(L + (grp ? R1_AUP : R1_WUP), 32 * tc, 16 * s, r32, hi), acc);
        const int c = 32 * tc + r32; const float bias = par[(grp ? 6 : 5) * 64 + c];
        if (grp == 0) {
            float x[16], gs[4];
#pragma unroll
            for (int i = 0; i < 16; ++i) x[i] = -DECAY_SCALE * sigmoidf_(acc[i] + bias);
#pragma unroll
            for (int g = 0; g < 4; ++g) gs[g] = (x[4 * g] + x[4 * g + 1]) + (x[4 * g + 2] + x[4 * g + 3]);
            float run = 0.f;
#pragma unroll
            for (int g = 0; g < 4; ++g) { const float other = __shfl_xor(gs[g], 32); float base = run + (hi ? other : 0.f); run += gs[g] + other;
#pragma unroll
                for (int j = 0; j < 4; ++j) { base += x[4 * g + j]; fLG[(32 * tr + 8 * g + 4 * hi + j) * 64 + c] = base; } }
            if (tr == 0 && hi == 0) fTOT[c] = run;
        } else {
#pragma unroll
            for (int i = 0; i < 16; ++i) fETA[(32 * tr + (i & 3) + 8 * (i >> 2) + 4 * hi) * 64 + c] = sigmoidf_(acc[i] + bias);
        }
    }
    BAR();
    RST(51, 52);
    {
        const f32x4 l0 = *(const LAS f32x4*)(fLG + et * 64 + ec), l1 = *(const LAS f32x4*)(fLG + et * 64 + ec + 4);
        f32x4 p0 = {0.f, 0.f, 0.f, 0.f}, p1 = p0; if (et > 0) { p0 = *(const LAS f32x4*)(fLG + (et - 1) * 64 + ec); p1 = *(const LAS f32x4*)(fLG + (et - 1) * 64 + ec + 4); }
        const f32x4 e0 = *(const LAS f32x4*)(fETA + et * 64 + ec), e1 = *(const LAS f32x4*)(fETA + et * 64 + ec + 4);
        const f32x4 z0 = *(const LAS f32x4*)(fLG + 63 * 64 + ec), z1 = *(const LAS f32x4*)(fLG + 63 * 64 + ec + 4);
        const f32x4 u0 = *(const LAS f32x4*)(fTOT + ec), u1 = *(const LAS f32x4*)(fTOT + ec + 4);
        float lg[8] = {l0[0], l0[1], l0[2], l0[3], l1[0], l1[1], l1[2], l1[3]}, lp[8] = {p0[0], p0[1], p0[2], p0[3], p1[0], p1[1], p1[2], p1[3]};
        const float eta[8] = {e0[0], e0[1], e0[2], e0[3], e1[0], e1[1], e1[2], e1[3]}, tot[8] = {u0[0], u0[1], u0[2], u0[3], u1[0], u1[1], u1[2], u1[3]};
        float lC[8] = {z0[0], z0[1], z0[2], z0[3], z1[0], z1[1], z1[2], z1[3]};
        float kk[8], kp[8], ss = 0.f, bsum = 0.f;
#pragma unroll
        for (int i = 0; i < 8; ++i) {
            if (et >= 32) lg[i] += tot[i]; if (et >= 33) lp[i] += tot[i]; lC[i] += tot[i];
            kk[i] = k8[i] * par[7 * 64 + ec + i]; ss += kk[i] * kk[i];
            kp[i] = k8[i] * (1.f + (eta[i] - 1.f) * par[8 * 64 + ec + i]); bsum += r8[i] * kp[i] * par[9 * 64 + ec + i];
        }
        ss += __shfl_xor(ss, 1); ss += __shfl_xor(ss, 2); ss += __shfl_xor(ss, 4);
        bsum += __shfl_xor(bsum, 1); bsum += __shfl_xor(bsum, 2); bsum += __shfl_xor(bsum, 4);
        const float rn = __builtin_amdgcn_rsqf(fmaxf(ss, 1e-24f));
        if ((tid & 7) == 0) ra.RB[(row0 + et) * 8 + h] = bsum;
        if (et == 63) { f32x4 g0 = {fexp_(lC[0]), fexp_(lC[1]), fexp_(lC[2]), fexp_(lC[3])}, g1 = {fexp_(lC[4]), fexp_(lC[5]), fexp_(lC[6]), fexp_(lC[7])};
            *(f32x4*)(ra.RG + (size_t)unit * 64 + ec) = g0; *(f32x4*)(ra.RG + (size_t)unit * 64 + ec + 4) = g1; }
#pragma unroll
        for (int i = 0; i < 8; i += 2) {
            float vat[2], vbh[2], vkh[2], vrt[2], vkb[2], vbb[2];
#pragma unroll
            for (int j = 0; j < 2; ++j) { const int c = i + j;
                const float kn = kk[c] * rn, bv = kn * eta[c];
                const float ig = fexp_(-lg[c]), gC = fexp_(lC[c] - lg[c]);
                vat[j] = -kn * fexp_(lp[c]); vbh[j] = bv * ig; vkh[j] = kp[c] * ig; vrt[j] = r8[c] * fexp_(lg[c]); vkb[j] = kp[c] * gC; vbb[j] = bv * gC; }
            const int off = et * IP + (ec + i) * 2;
            *(LAS unsigned*)(L + S_AT + off) = pk2(vat[0], vat[1]); *(LAS unsigned*)(L + S_BH + off) = pk2(vbh[0], vbh[1]); *(LAS unsigned*)(L + S_KH + off) = pk2(vkh[0], vkh[1]);
            *(LAS unsigned*)(L + S_RT + off) = pk2(vrt[0], vrt[1]); *(LAS unsigned*)(L + S_KB + off) = pk2(vkb[0], vkb[1]); *(LAS unsigned*)(L + S_BB + off) = pk2(vbb[0], vbb[1]);
        }
    }
    BAR();
    RST(52, 53);
    if (has_next) r1_load(a, raw, tid, nb, nh, nck);
    {
        const LAS unsigned char* Aimg = L + (grp ? S_RT : S_AT);
        f32x16 c1 = zero16(), c2 = zero16();
        if (!(tr == 0 && tc == 1)) {
#pragma unroll
            for (int s = 0; s < 4; ++s) { const bf16x8 af = rowfrag(Aimg, 32 * tr, 16 * s, r32, hi);
                c1 = MFMA32(af, rowfrag(L + S_BH, 32 * tc, 16 * s, r32, hi), c1); c2 = MFMA32(af, rowfrag(L + S_KH, 32 * tc, 16 * s, r32, hi), c2); }
        }
        const int ci = 32 * tc + r32;
#pragma unroll
        for (int i = 0; i < 16; ++i) { const int t = 32 * tr + (i & 3) + 8 * (i >> 2) + 4 * hi; const bool keep = grp ? (ci <= t) : (ci < t); if (!keep) { c1[i] = 0.f; c2[i] = 0.f; } }
        if (grp == 0) {
#pragma unroll
            for (int i = 0; i < 16; ++i) fAAB[(32 * tr + (i & 3) + 8 * (i >> 2) + 4 * hi) * 64 + ci] = c1[i];
            store_T(L + S_AAK, c2, 32 * tr, 32 * tc, r32, hi);
        } else { store_T(L + S_ARB, c1, 32 * tr, 32 * tc, r32, hi); store_T(L + S_ARK, c2, 32 * tr, 32 * tc, r32, hi); }
    }
    BAR();
    RST(53, 54);
    f32x16 nacc = zero16(), yacc = zero16();
    if (grp == 0) {
        const int bk = wave;
        float d[16];
        if (lane < 16) {
#pragma unroll
            for (int t = 0; t < 16; ++t) { float s = (t == lane) ? 1.f : 0.f;
#pragma unroll
                for (int i = 0; i < 16; ++i) if (i < t) s += fAAB[(16 * bk + t) * 64 + 16 * bk + i] * d[i];
                d[t] = s; }
        }
        if (lane < 16) {
            LAS unsigned char* rowp = L + S_TT + (16 * bk + lane) * IP;
#pragma unroll
            for (int cb = 0; cb < 4; ++cb) { u32x4 w0, w1;
                if (cb == bk) { w0.x = pk2(d[0], d[1]); w0.y = pk2(d[2], d[3]); w0.z = pk2(d[4], d[5]); w0.w = pk2(d[6], d[7]); w1.x = pk2(d[8], d[9]); w1.y = pk2(d[10], d[11]); w1.z = pk2(d[12], d[13]); w1.w = pk2(d[14], d[15]); }
                else { w0 = zero_u32x4(); w1 = w0; }
                *(LAS u32x4*)(rowp + cb * 32) = w0; *(LAS u32x4*)(rowp + cb * 32 + 16) = w1; }
        }
    } else {
        f32x16 c = zero16();
#pragma unroll
        for (int s = 0; s < 4; ++s) c = MFMA32(colfrag(L + S_AAK, 32 * tr, 16 * s, lane), colfrag(L + S_V, 32 * tc, 16 * s, lane), c);
        store_T(L + S_W1, c, 32 * tr, 32 * tc, r32, hi);
    }
    BAR();
    if (grp == 0) {
        if (wave < 2) { const int p = 2 * wave;
            f32x16 x = MFMA32(rowfrag_f32(fAAB, 16 * (p + 1), 16 * p, r32, hi), rowfrag(L + S_TT, 16 * p, 16 * p, r32, hi), zero16());
            u32x4 xw; xw.x = pk2(x[0], x[1]); xw.y = pk2(x[2], x[3]); xw.z = pk2(x[4], x[5]); xw.w = pk2(x[6], x[7]);
            const f32x16 tb = MFMA32(colfrag_perm(L + S_TT, 16 * (p + 1), 16 * (p + 1), lane), __builtin_bit_cast(bf16x8, xw), zero16());
            if (r32 < 16) {
#pragma unroll
                for (int g = 0; g < 2; ++g) { u32x2 w; w.x = pk2(tb[4 * g], tb[4 * g + 1]); w.y = pk2(tb[4 * g + 2], tb[4 * g + 3]); *(LAS u32x2*)(L + S_TT + (16 * p + r32) * IP + (16 * (p + 1) + 8 * g + 4 * hi) * 2) = w; } }
        }
    } else {
#pragma unroll
        for (int s = 0; s < 4; ++s) { const bf16x8 vf = colfrag(L + S_V, 32 * tr, 16 * s, lane);
            nacc = MFMA32(colfrag(L + S_KB, 32 * tr, 16 * s, lane), colfrag(L + S_V, 32 * tc, 16 * s, lane), nacc);
            yacc = MFMA32(vf, colfrag(L + S_ARK, 32 * tc, 16 * s, lane), yacc); }
    }
    BAR();
    if (wave == 0) {
        f32x16 x = zero16();
#pragma unroll
        for (int s = 0; s < 2; ++s) x = MFMA32(rowfrag_f32(fAAB, 32, 16 * s, r32, hi), rowfrag(L + S_TT, 0, 16 * s, r32, hi), x);
        f32x16 tb = zero16();
#pragma unroll
        for (int s = 0; s < 2; ++s) { u32x4 xw; xw.x = pk2(x[8 * s], x[8 * s + 1]); xw.y = pk2(x[8 * s + 2], x[8 * s + 3]); xw.z = pk2(x[8 * s + 4], x[8 * s + 5]); xw.w = pk2(x[8 * s + 6], x[8 * s + 7]);
            tb = MFMA32(colfrag_perm(L + S_TT, 32, 32 + 16 * s, lane), __builtin_bit_cast(bf16x8, xw), tb); }
        store_T(L + S_TT, tb, 32, 0, r32, hi);
    }
    BAR();
    RST(54, 55);
    {
        f32x16 c = zero16();
#pragma unroll
        for (int s = 0; s < 4; ++s) { const bf16x8 tf = colfrag(L + S_TT, 32 * tr, 16 * s, lane);
            c = MFMA32(tf, grp ? rowfrag(L + S_W1, 32 * tc, 16 * s, r32, hi) : colfrag(L + S_AT, 32 * tc, 16 * s, lane), c); }
        store_T(L + (grp ? S_UV : S_AH), c, 32 * tr, 32 * tc, r32, hi);
    }
    BAR();
    RST(55, 56);
    {
        const LAS unsigned char* Aimg = L + (grp ? S_UV : S_AH);
        f32x16 c1 = grp ? nacc : zero16(), c2 = grp ? yacc : zero16();
#pragma unroll
        for (int s = 0; s < 4; ++s) { const bf16x8 af = rowfrag(Aimg, 32 * tr, 16 * s, r32, hi);
            if (grp) c1 = MFMA32(colfrag(L + S_BB, 32 * tr, 16 * s, lane), rowfrag(L + S_UV, 32 * tc, 16 * s, r32, hi), c1);
            else c1 = MFMA32(af, colfrag(L + S_BB, 32 * tc, 16 * s, lane), c1);
            c2 = MFMA32(af, colfrag(L + S_ARB, 32 * tc, 16 * s, lane), c2); }
        GAS bf16_t* gq = (GAS bf16_t*)ra.RQ + (size_t)unit * 4096; GAS bf16_t* gm = (GAS bf16_t*)ra.RM + (size_t)unit * 4096; GAS bf16_t* gn = (GAS bf16_t*)ra.RN + (size_t)unit * 4096;
        if (grp == 0) {
            store_T_global(gm, c1, 32 * tr, 32 * tc, r32, hi);
#pragma unroll
            for (int g = 0; g < 4; ++g) { const u32x2 w = *(const LAS u32x2*)(L + S_RT + (32 * tc + r32) * IP + (32 * tr + 8 * g + 4 * hi) * 2);
                c2[4 * g] += bflo(w.x); c2[4 * g + 1] += bfhi(w.x); c2[4 * g + 2] += bflo(w.y); c2[4 * g + 3] += bfhi(w.y); }
            store_T_global(gq, c2, 32 * tr, 32 * tc, r32, hi);
        } else {
            store_T_global(gn, c1, 32 * tr, 32 * tc, r32, hi);
            GAS bf16_t* yp = (GAS bf16_t*)a.Y + (row0 + 32 * tc + r32) * DM + h * 64 + 32 * tr;
#pragma unroll
            for (int g = 0; g < 4; ++g) { u32x2 w; w.x = pk2(c2[4 * g], c2[4 * g + 1]); w.y = pk2(c2[4 * g + 2], c2[4 * g + 3]); *(GAS u32x2*)(yp + 8 * g + 4 * hi) = w; }
        }
    }
    BAR();
    RST(56, -1);
}

constexpr int R2_D = 6, R2_SLOT = 16640, R2_RING = 2 * IMG;
__device__ __forceinline__ void rwkv_scan_chain(const RArgs& ra, unsigned char* ldsb, int b, int h, unsigned* flag  ) {
    const int tid = opaque_tid(), lane = tid & 63, wave = __builtin_amdgcn_readfirstlane(tid >> 6), r32 = lane & 31, hi = lane >> 5;
    LAS unsigned char* L = (LAS unsigned char*)ldsb;
    const int q = wave & 3, tr = q >> 1, tc = q & 1;
    f32x16 st = zero16();
    for (int i = tid; i < 2 * IMG / 16; i += 512) { *(LAS u32x4*)(L + i * 16) = zero_u32x4(); }
    const int ubase = (b * 6 + h) * 32;
    auto issue = [&](int step) {
        const int unit = ubase + step; LAS unsigned char* slot = L + R2_RING + (step % R2_D) * R2_SLOT; const int lw = wave - 4;
        const GAS unsigned char* gm = (const GAS unsigned char*)ra.RM + (size_t)unit * 8192 + lane * 16; const GAS unsigned char* gn = (const GAS unsigned char*)ra.RN + (size_t)unit * 8192 + lane * 16;
#pragma unroll
        for (int p = 0; p < 2; ++p) {
            __builtin_amdgcn_global_load_lds((const GAS unsigned*)(gm + (2 * lw + p) * 1024), (LAS unsigned*)(slot + (2 * lw + p) * 1024), 16, 0, 0);
            __builtin_amdgcn_global_load_lds((const GAS unsigned*)(gn + (2 * lw + p) * 1024), (LAS unsigned*)(slot + 8192 + (2 * lw + p) * 1024), 16, 0, 0);
        }
        if (lw == 0) __builtin_amdgcn_global_load_lds((const GAS unsigned*)((const GAS unsigned char*)ra.RG + (size_t)unit * 256 + lane * 4), (LAS unsigned*)(slot + 16384), 4, 0, 0);
    };
    if (wave >= 4) {
#pragma unroll 1
        for (int s0 = 0; s0 < R2_D - 1; ++s0) issue(s0);
        asm volatile("s_waitcnt vmcnt(0)" ::: "memory");
    }
    asm volatile("s_waitcnt lgkmcnt(0)" ::: "memory"); __builtin_amdgcn_s_barrier();
#pragma unroll 1
    for (int ck = 0; ck < 32; ++ck) {
        const LAS unsigned char* Simg = L + (ck & 1) * IMG; LAS unsigned char* Snew = L + ((ck + 1) & 1) * IMG;
        if (wave < 4) {
            const int unit = ubase + ck; const LAS unsigned char* slot = L + R2_RING + (ck % R2_D) * R2_SLOT;
            f32x16 acc;
#pragma unroll
            for (int g = 0; g < 4; ++g) { const u32x2 nw = *(const LAS u32x2*)(slot + 8192 + (32 * tc + r32) * 128 + (32 * tr + 8 * g + 4 * hi) * 2); const f32x4 gc = *(const LAS f32x4*)(slot + 16384 + (32 * tr + 8 * g + 4 * hi) * 4);
                acc[4 * g] = st[4 * g] * gc[0] + bflo(nw.x); acc[4 * g + 1] = st[4 * g + 1] * gc[1] + bfhi(nw.x); acc[4 * g + 2] = st[4 * g + 2] * gc[2] + bflo(nw.y); acc[4 * g + 3] = st[4 * g + 3] * gc[3] + bfhi(nw.y); }
#pragma unroll
            for (int s = 0; s < 4; ++s) acc = MFMA32(*(const LAS bf16x8*)(slot + (32 * tr + r32) * 128 + (16 * s + 8 * hi) * 2), rowfrag(Simg, 32 * tc, 16 * s, r32, hi), acc);
            store_T_global((GAS bf16_t*)ra.RM + (size_t)unit * 4096, st, 32 * tr, 32 * tc, r32, hi);
            st = acc;
            store_T(Snew, st, 32 * tr, 32 * tc, r32, hi);
            asm volatile("s_waitcnt lgkmcnt(0)" ::: "memory");
        } else {
            if (ck + R2_D - 1 < 32) { issue(ck + R2_D - 1);
                if (wave == 4) asm volatile("s_waitcnt vmcnt(20)" ::: "memory"); else asm volatile("s_waitcnt vmcnt(16)" ::: "memory"); }
            else asm volatile("s_waitcnt vmcnt(0)" ::: "memory");
        }
        __builtin_amdgcn_s_barrier();
    }
    asm volatile("s_waitcnt vmcnt(0) lgkmcnt(0)" ::: "memory"); __syncthreads();
    (void)flag;
}
__device__ __forceinline__ void r3_wait(const unsigned* flags, int chain0, int ck, int tid) {
    if (tid < 64) {
        const unsigned* f = flags + (size_t)(chain0 + (tid & 3)) * 64;
        for (unsigned spins = 0; spins < (1u << 22); ++spins) {
            const bool ok = __hip_atomic_load((const GAS unsigned*)f, __ATOMIC_RELAXED, __HIP_MEMORY_SCOPE_AGENT) > (unsigned)ck;
            if (__all(ok)) break;
            __builtin_amdgcn_s_sleep(4);
        }
        __builtin_amdgcn_fence(__ATOMIC_ACQUIRE, "agent");
        asm volatile("s_waitcnt vmcnt(0)" ::: "memory");
    }
}
constexpr int RP = 136, RTILE = 64 * RP, R3_TEAM_LDS = 3 * RTILE;
__device__ __forceinline__ void rwkv_out_unit(const MixArgs& a, const RArgs& ra, unsigned char* ldsb, int b, int h, int ck) {
    const int tid = opaque_tid(), lane = tid & 63, wave = __builtin_amdgcn_readfirstlane(tid >> 6), r32 = lane & 31, hi = lane >> 5;
    const int tw = wave & 1, tt = tid & 127;
    LAS unsigned char* TL = (LAS unsigned char*)ldsb + (wave >> 1) * R3_TEAM_LDS;
    LAS unsigned char* VM = TL, *SG = TL + RTILE, *YC = TL + 2 * RTILE;
    const int unit = (b * 6 + h) * 32 + ck;
    const size_t row0 = (size_t)b * SEQ + ck * 64;
#pragma unroll
    for (int j = 0; j < 4; ++j) {
        const int c = tt + 128 * j, t = c >> 3, c8 = (c & 7) * 8, hc = h * 64 + c8;
        const GAS bf16_t* zr = (const GAS bf16_t*)a.Z + (row0 + t) * ZP; const bool hp = (ck * 64 + t) > 0;
        const u32x4 vc = *(const GAS u32x4*)(zr + ZA_V + hc), gcw = *(const GAS u32x4*)(zr + ZA_G + hc);
        u32x4 vp = zero_u32x4(), gp = vp; if (hp) { vp = *(const GAS u32x4*)(zr - ZP + ZA_V + hc); gp = *(const GAS u32x4*)(zr - ZP + ZA_G + hc); }
        const u32x4 yc = *(const GAS u32x4*)((const GAS bf16_t*)a.Y + (row0 + t) * DM + hc);
        const f32x4 mv0 = *(const f32x4*)(ra.mu + ZA_V + hc), mv1 = *(const f32x4*)(ra.mu + ZA_V + hc + 4), mg0 = *(const f32x4*)(ra.mu + ZA_G + hc), mg1 = *(const f32x4*)(ra.mu + ZA_G + hc + 4);
        const float vcur[8] = {bflo(vc.x), bfhi(vc.x), bflo(vc.y), bfhi(vc.y), bflo(vc.z), bfhi(vc.z), bflo(vc.w), bfhi(vc.w)}, vprv[8] = {bflo(vp.x), bfhi(vp.x), bflo(vp.y), bfhi(vp.y), bflo(vp.z), bfhi(vp.z), bflo(vp.w), bfhi(vp.w)};
        const float gcur[8] = {bflo(gcw.x), bfhi(gcw.x), bflo(gcw.y), bfhi(gcw.y), bflo(gcw.z), bfhi(gcw.z), bflo(gcw.w), bfhi(gcw.w)}, gprv[8] = {bflo(gp.x), bfhi(gp.x), bflo(gp.y), bfhi(gp.y), bflo(gp.z), bfhi(gp.z), bflo(gp.w), bfhi(gp.w)};
        const float muv[8] = {mv0[0], mv0[1], mv0[2], mv0[3], mv1[0], mv1[1], mv1[2], mv1[3]}, mug[8] = {mg0[0], mg0[1], mg0[2], mg0[3], mg1[0], mg1[1], mg1[2], mg1[3]};
        float vm[8], sg[8];
#pragma unroll
        for (int i = 0; i < 8; ++i) { vm[i] = vcur[i] + (vprv[i] - vcur[i]) * muv[i]; const float gg = gcur[i] + (gprv[i] - gcur[i]) * mug[i]; sg[i] = gg * sigmoidf_(gg); }
        u32x4 w; w.x = pk2(vm[0], vm[1]); w.y = pk2(vm[2], vm[3]); w.z = pk2(vm[4], vm[5]); w.w = pk2(vm[6], vm[7]);
        *(LAS u32x2*)(VM + t * RP + c8 * 2) = (u32x2){w.x, w.y}; *(LAS u32x2*)(VM + t * RP + c8 * 2 + 8) = (u32x2){w.z, w.w};
        w.x = pk2(sg[0], sg[1]); w.y = pk2(sg[2], sg[3]); w.z = pk2(sg[4], sg[5]); w.w = pk2(sg[6], sg[7]);
        *(LAS u32x2*)(SG + t * RP + c8 * 2) = (u32x2){w.x, w.y}; *(LAS u32x2*)(SG + t * RP + c8 * 2 + 8) = (u32x2){w.z, w.w};
        *(LAS u32x2*)(YC + t * RP + c8 * 2) = (u32x2){yc.x, yc.y}; *(LAS u32x2*)(YC + t * RP + c8 * 2 + 8) = (u32x2){yc.z, yc.w};
    }
    const GAS bf16_t* gq = (const GAS bf16_t*)ra.RQ + (size_t)unit * 4096 + (32 * tw + r32) * 64 + 8 * hi;
    const GAS bf16_t* gs = (const GAS bf16_t*)ra.RM + (size_t)unit * 4096 + r32 * 64 + 8 * hi;
    bf16x8 bq[4], a0[4], a1[4];
#pragma unroll
    for (int s = 0; s < 4; ++s) { bq[s] = *(const GAS bf16x8*)(gq + 16 * s); a0[s] = *(const GAS bf16x8*)(gs + 16 * s); a1[s] = *(const GAS bf16x8*)(gs + 32 * 64 + 16 * s); }
    const float beta = ra.RB[(row0 + 32 * tw + r32) * 8 + h];
    BAR();
    const int tl = 32 * tw + r32;
    f32x16 y0, y1;
#pragma unroll
    for (int g = 0; g < 4; ++g) { const u32x2 w0 = *(const LAS u32x2*)(YC + tl * RP + (8 * g + 4 * hi) * 2), w1 = *(const LAS u32x2*)(YC + tl * RP + (32 + 8 * g + 4 * hi) * 2);
        y0[4 * g] = bflo(w0.x); y0[4 * g + 1] = bfhi(w0.x); y0[4 * g + 2] = bflo(w0.y); y0[4 * g + 3] = bfhi(w0.y);
        y1[4 * g] = bflo(w1.x); y1[4 * g + 1] = bfhi(w1.x); y1[4 * g + 2] = bflo(w1.y); y1[4 * g + 3] = bfhi(w1.y); }
#pragma unroll
    for (int s = 0; s < 4; ++s) { y0 = MFMA32(a0[s], bq[s], y0); y1 = MFMA32(a1[s], bq[s], y1); }
    float sm = 0.f;
#pragma unroll
    for (int i = 0; i < 16; ++i) sm += y0[i] + y1[i];
    sm += __shfl_xor(sm, 32); const float mean = sm * (1.f / 64.f);
    float sq = 0.f;
#pragma unroll
    for (int i = 0; i < 16; ++i) { const float d0 = y0[i] - mean, d1 = y1[i] - mean; sq += d0 * d0 + d1 * d1; }
    sq += __shfl_xor(sq, 32); const float rstd = __builtin_amdgcn_rsqf(sq * (1.f / 64.f) + GN_EPS);
#pragma unroll
    for (int half = 0; half < 2; ++half)
#pragma unroll
        for (int g = 0; g < 4; ++g) {
            const int v0 = 32 * half + 8 * g + 4 * hi, hc = h * 64 + v0;
            const u32x2 vw = *(const LAS u32x2*)(VM + tl * RP + v0 * 2), sw = *(const LAS u32x2*)(SG + tl * RP + v0 * 2);
            const f32x4 lg4 = *(const f32x4*)(ra.ln_g + hc), lb4 = *(const f32x4*)(ra.ln_b + hc);
            const float vv[4] = {bflo(vw.x), bfhi(vw.x), bflo(vw.y), bfhi(vw.y)}, ss[4] = {bflo(sw.x), bfhi(sw.x), bflo(sw.y), bfhi(sw.y)};
            float o[4];
#pragma unroll
            for (int j = 0; j < 4; ++j) { const float yv = half ? y1[4 * g + j] : y0[4 * g + j]; o[j] = ((yv - mean) * rstd * lg4[j] + lb4[j] + beta * vv[j]) * ss[j]; }
            u32x2 w; w.x = pk2(o[0], o[1]); w.y = pk2(o[2], o[3]); *(LAS u32x2*)(YC + tl * RP + v0 * 2) = w;
        }
    BAR();
#pragma unroll
    for (int j = 0; j < 4; ++j) { const int c = tt + 128 * j, t = c >> 3, c8 = (c & 7) * 8;
        const u32x2 lo = *(const LAS u32x2*)(YC + t * RP + c8 * 2), hi2 = *(const LAS u32x2*)(YC + t * RP + c8 * 2 + 8);
        u32x4 w; w.x = lo.x; w.y = lo.y; w.z = hi2.x; w.w = hi2.y; *(GAS u32x4*)((GAS bf16_t*)a.Y + (row0 + t) * DM + h * 64 + c8) = w; }
    BAR();
}
}
constexpr int NWAVES = 8;
constexpr int RING_BYTES = 131072, LDSCTL_OFF = RING_BYTES, LDS_BYTES = 163840;
constexpr int CW_BAR = 4096, CW_Q = 2048, CW_FLAG = 65536;
struct Args { const float* in[19]; float* out; unsigned char* ws; };

__device__ __forceinline__ unsigned lds_base_u32() { extern __shared__ __attribute__((aligned(16))) unsigned char lds_[]; return (unsigned)(uintptr_t)(LAS unsigned char*)lds_; }
__device__ __forceinline__ unsigned long long rd_ptr_u(volatile LAS unsigned long long* p) { const unsigned long long v = *p; const unsigned lo = __builtin_amdgcn_readfirstlane((unsigned)v), hi = __builtin_amdgcn_readfirstlane((unsigned)(v >> 32)); return ((unsigned long long)hi << 32) | lo; }
__global__ void __launch_bounds__(NWAVES * 64, 2) mega_fwd(Args args) {
    extern __shared__ __attribute__((aligned(16))) unsigned char lds[];
    const int tid = threadIdx.x, lane = tid & 63, wave = __builtin_amdgcn_readfirstlane(tid >> 6);
    const int G = gridDim.x, bx = blockIdx.x;
    unsigned char* ws = args.ws;
    volatile LAS unsigned* MISC = (volatile LAS unsigned*)((LAS unsigned char*)lds + LDSCTL_OFF);
    for (int u = tid; u < (LDS_BYTES - LDSCTL_OFF) / 4; u += NWAVES * 64) ((LAS unsigned*)((LAS unsigned char*)lds + LDSCTL_OFF))[u] = 0u;
    __syncthreads();
    (void)xcd_barrier_post((unsigned*)(ws + WS_CTL) + CW_BAR, MISC + 8);
    volatile LAS unsigned long long* PTRS = (volatile LAS unsigned long long*)((LAS unsigned char*)lds + LDSCTL_OFF + 256);
    if (tid < 19) PTRS[tid] = (unsigned long long)(uintptr_t)args.in[tid];
    if (tid == 19) PTRS[19] = (unsigned long long)(uintptr_t)args.out;
    if (tid == 20) PTRS[20] = (unsigned long long)(uintptr_t)args.ws;
    __syncthreads();
#define PTRS_RD(i) rd_ptr_u(({ unsigned a_; asm volatile("s_mov_b32 %0, %1" : "=s"(a_) : "i"(LDSCTL_OFF + 256 + 8 * (i))); (volatile LAS unsigned long long*)(LAS unsigned char*)(lds_base_u32() + a_); }))
#define ARGP(i) ((const float*)(uintptr_t)PTRS_RD(i))
#define OUTP ((float*)(uintptr_t)PTRS_RD(19))
#define WSP ((unsigned char*)(uintptr_t)PTRS_RD(20))
#ifdef PROBE_BAR
#define GRID_BAR() do { GRID_BAR1(); GRID_BAR1(); } while (0)
#else
#define GRID_BAR() GRID_BAR1()
#endif
#define GRID_BAR1() do { XcdBarrier b_; b_.bar = (unsigned*)(WSP + WS_CTL) + CW_BAR; b_.x = xb_xcc_id(); b_.st = (volatile LAS unsigned*)((LAS unsigned char*)lds + LDSCTL_OFF) + 8; xcd_barrier(b_); } while (0)
#ifdef PROBE_T
#define TS_LDS ((volatile LAS unsigned long long*)((LAS unsigned char*)lds + LDSCTL_OFF + 1024))
#define STAMP_BEGIN(id) do { if ((id) == PROBE_T && blockIdx.x == 0 && threadIdx.x == 0) TS_LDS[0] = __builtin_amdgcn_s_memrealtime(); } while (0)
#define STAMP_END(id) do { if ((id) == PROBE_T && blockIdx.x == 0 && threadIdx.x == 0) TS_LDS[1] += __builtin_amdgcn_s_memrealtime() - TS_LDS[0]; } while (0)
#else
#define STAMP_BEGIN(id) do {} while (0)
#define STAMP_END(id) do {} while (0)
#endif
#ifdef PROBE_TBUSY
#define STAMP_END_BUSY(id) STAMP_END(id)
#define STAMP_END_WALL(id) do {} while (0)
#else
#define STAMP_END_BUSY(id) do {} while (0)
#define STAMP_END_WALL(id) STAMP_END(id)
#endif
#define PHASE_IDS const int tid = opaque_tid(), lane = tid & 63, wave = __builtin_amdgcn_readfirstlane(tid >> 6), gw = bx * NWAVES + wave, ngw = G * NWAVES; (void)lane; (void)gw; (void)ngw; (void)tid; (void)wave;
    int K1024 = DM, K256 = 256; asm volatile("" : "+s"(K1024), "+s"(K256));
    STAMP_BEGIN(0);
    {
        PHASE_IDS
        const float* x = args.in[0]; bf16_t* bufA = (bf16_t*)(ws + WS_BUFA); float* ssqA = (float*)(ws + WS_SSQA);
        PrepArgs pa; pa.w_in = args.in[3]; pa.norm_g = args.in[2]; pa.w_out = args.in[14]; pa.ple_g = args.in[15]; pa.w_gate = args.in[16]; pa.w_proj = args.in[17]; pa.w_up = args.in[6]; pa.a_up = args.in[8]; pa.ws = ws;
        prep_tables(ws, bx * NWAVES * 64 + tid, G * NWAVES * 64);
        prep_weights(pa, gw, ngw, (LAS float*)((LAS unsigned char*)lds + wave * 16384), lane, 0, DEPTH);
#ifdef PROBE_PRO
        prep_weights(pa, gw, ngw, (LAS float*)((LAS unsigned char*)lds + wave * 16384), lane, 0, DEPTH);
        for (int m = gw; m < MTOK; m += ngw) x_row_to_bf16(x + (size_t)m * DM, bufA + (size_t)m * DM, ssqA + (size_t)m * 16, lane);
#endif
        for (int m = gw; m < MTOK; m += ngw) x_row_to_bf16(x + (size_t)m * DM, bufA + (size_t)m * DM, ssqA + (size_t)m * 16, lane);
    }
    STAMP_END_BUSY(0);
    GRID_BAR();
    STAMP_END_WALL(0);
    STAMP_BEGIN(1);
#pragma clang loop unroll(full)
    for (int L = 0; L < DEPTH; ++L) {
#define PHASE_PTRS unsigned char* ws = WSP; bf16_t* cur = (bf16_t*)(ws + ((L & 1) ? WS_BUFB : WS_BUFA)); bf16_t* oth = (bf16_t*)(ws + ((L & 1) ? WS_BUFA : WS_BUFB)); const unsigned char* wl = ws + WS_W + (size_t)L * W_LAYER; \
        bf16_t* Z = (bf16_t*)(ws + WS_Z); float* PP = (float*)(ws + WS_Z); bf16_t* PB = (bf16_t*)(ws + WS_PB); float* ssqA = (float*)(ws + WS_SSQA); float* ssqB = (float*)(ws + WS_SSQB); float* out = OUTP; \
        (void)cur; (void)oth; (void)wl; (void)Z; (void)PP; (void)PB; (void)ssqA; (void)ssqB; (void)out;
        {
            PHASE_PTRS
            const float* tab16 = (const float*)(ws + WS_TAB16); const float* tabI = (const float*)(ws + WS_TABI);
            pg8::Gemm g{cur, (const bf16_t*)(wl + W_IN), MTOK, NPAD, K1024}; pg8::StaticOrder S; S.init(MTOK, NPAD, G, bx);
            epi::EpiInProj e; e.Z = Z; e.ssq = ssqA; e.tab16 = tab16; e.tabI = tabI; e.KV = (bf16_t*)(ws + WS_MISC + MISC_KV); e.IKC = (bf16_t*)(ws + WS_MISC + MISC_IKC);
#ifdef PROBE_G1
            pg8::gemm_phase<epi::EpiInProj, pg8::StaticOrder, true, true>((PG8_LAS unsigned char*)lds, g, S, e);
#endif
#ifdef PROBE_G1P
            { epi::EpiPlainZ ep; ep.Z = Z; pg8::gemm_phase<epi::EpiPlainZ, pg8::StaticOrder, true, true>((PG8_LAS unsigned char*)lds, g, S, ep); }
#endif
            pg8::gemm_phase<epi::EpiInProj, pg8::StaticOrder, true, true>((PG8_LAS unsigned char*)lds, g, S, e);
        }
        STAMP_END_BUSY(1);
        GRID_BAR();
        STAMP_END_WALL(1);
        STAMP_BEGIN(2);
        {
            PHASE_PTRS
            MixArgs ma; ma.Z = Z; ma.Y = oth; ma.KV = (const bf16_t*)(ws + WS_MISC + MISC_KV); ma.IKC = (const bf16_t*)(ws + WS_MISC + MISC_IKC); ma.mu = ARGP(4) + L * 1664; ma.w0 = ARGP(5) + L * 384; ma.w_up = ARGP(6) + (size_t)L * 64 * 384; ma.a0 = ARGP(7) + L * 384; ma.a_up = ARGP(8) + (size_t)L * 64 * 384;
            ma.k_k = ARGP(9) + L * 384; ma.k_a = ARGP(10) + L * 384; ma.r_k = ARGP(11) + L * 384; ma.ln_g = ARGP(12) + L * 384; ma.ln_b = ARGP(13) + L * 384;
            rwkv::RArgs ra; ra.mu = ma.mu; ra.w0 = ma.w0; ra.a0 = ma.a0; ra.k_k = ma.k_k; ra.k_a = ma.k_a; ra.r_k = ma.r_k; ra.ln_g = ma.ln_g; ra.ln_b = ma.ln_b;
            ra.wupT = (const bf16_t*)(wl + W_WUPT); ra.aupT = (const bf16_t*)(wl + W_AUPT); ra.RQ = cur; ra.RM = cur + (size_t)3072 * 4096; ra.RN = (bf16_t*)(ws + WS_MISC + MISC_RN); ra.RG = (float*)(ws + WS_MISC + MISC_RG); ra.RB = (float*)(ws + WS_MISC + MISC_RB);
#ifdef PROBE_R1
            for (int rep = 0; rep < 2; ++rep)
#endif
            STAMP_BEGIN(20);
            {
              rwkv::R1Raw raw; const int tid1 = opaque_tid(); const int per = (3072 + G - 1) / G, u0 = bx * per, u1 = min(u0 + per, 3072);
              if (u0 < u1) rwkv::r1_load(ma, raw, tid1, u0 / 192, (u0 / 32) % 6, u0 & 31);
              int hprev = -1;
              for (int u = u0; u < u1; ++u) { const int un = u + 1; const int ck = u & 31, hh = (u / 32) % 6;
                  if (hh != hprev) { __syncthreads(); rwkv::r1_load_params(ra, lds, tid1, hh); __syncthreads(); hprev = hh; }
                  rwkv::rwkv_chunk_unit(ma, ra, lds, u / 192, hh, ck, raw, ck == 0 ? 0 : (u == u0 ? 2 : 1), un < u1, un / 192, (un / 32) % 6, un & 31); } }
            STAMP_END(20); STAMP_BEGIN(21);
            { unsigned* qctr = (unsigned*)(ws + WS_CTL) + CW_Q + L * 8 + (bx & 7);
#define QW_PTR() ({ unsigned a_; asm volatile("s_mov_b32 %0, %1" : "=s"(a_) : "i"(LDSCTL_OFF + 1536)); (volatile LAS unsigned*)(LAS unsigned char*)(lds_base_u32() + a_); })
              for (;;) {
                  if (opaque_tid() == 0) { const unsigned v_ = __hip_atomic_fetch_add(qctr, 1u, __ATOMIC_RELAXED, __HIP_MEMORY_SCOPE_AGENT); QW_PTR()[0] = v_; }
                  __syncthreads();
                  const unsigned qi = QW_PTR()[0];
                  __syncthreads();
                  if (qi >= 64u) break;
                  dsa::dsa_unit(ma, lds, (bx & 7) * 2 + (int)(qi & 1u), 31 - (int)(qi >> 1));
              } }
            __syncthreads();
            STAMP_END(21); STAMP_BEGIN(22);
            float* LQ = (float*)(ws + WS_MISC);
#ifdef PROBE_DIL
            for (int rep = 0; rep < 2; ++rep)
#endif
            for (int u = bx; u < 768; u += G) dil::dil_unit(ma, LQ, lds, u / 48, (u % 48) >> 4, u & 15);
            STAMP_END(22); STAMP_BEGIN(23);
        }
        STAMP_END_BUSY(2);
        GRID_BAR();
        STAMP_END_WALL(2); STAMP_END(23);
        STAMP_BEGIN(3);
        {
            PHASE_PTRS
            MixArgs ma; ma.Z = Z; ma.Y = oth; const float* LQ = (const float*)(ws + WS_MISC); PHASE_IDS
            rwkv::RArgs ra; ra.mu = ARGP(4) + L * 1664; ra.ln_g = ARGP(12) + L * 384; ra.ln_b = ARGP(13) + L * 384;
            ra.RQ = cur; ra.RM = cur + (size_t)3072 * 4096; ra.RN = (bf16_t*)(ws + WS_MISC + MISC_RN); ra.RG = (float*)(ws + WS_MISC + MISC_RG); ra.RB = (float*)(ws + WS_MISC + MISC_RB);
            if (G > 96) {
#ifdef PROBE_R2
                if (bx < 96) rwkv::rwkv_scan_chain<true>(ra, lds, bx / 6, bx % 6);
#endif
                if (bx < 96) { STAMP_BEGIN(40); rwkv::rwkv_scan_chain(ra, lds, bx / 6, bx % 6, (unsigned*)(ws + WS_CTL) + CW_FLAG + (L * 96 + bx) * 64); STAMP_END(40); }
                else { dil::dil_merge(ma, LQ, (bx - 96) * 512 + tid, (G - 96) * 512);
                    const float* src = ARGP(1) + (size_t)L * MTOK * 256;
                    for (size_t i = (size_t)(bx - 96) * 512 + tid; i < (size_t)MTOK * 256 / 8; i += (size_t)(G - 96) * 512) {
                        const f32x4 a = ((const f32x4*)src)[2 * i], b = ((const f32x4*)src)[2 * i + 1];
                        u32x4 w; w.x = pk2(a.x, a.y); w.y = pk2(a.z, a.w); w.z = pk2(b.x, b.y); w.w = pk2(b.z, b.w); ((u32x4*)PB)[i] = w; }
                }
            } else {
                for (int u = bx; u < 96; u += G) rwkv::rwkv_scan_chain(ra, lds, u / 6, u % 6, (unsigned*)(ws + WS_CTL) + CW_FLAG + (L * 96 + u) * 64);
                dil::dil_merge(ma, LQ, bx * 512 + tid, G * 512);
                { const float* src = ARGP(1) + (size_t)L * MTOK * 256;
                  for (size_t i = (size_t)bx * 512 + tid; i < (size_t)MTOK * 256 / 8; i += (size_t)G * 512) {
                      const f32x4 a = ((const f32x4*)src)[2 * i], b = ((const f32x4*)src)[2 * i + 1];
                      u32x4 w; w.x = pk2(a.x, a.y); w.y = pk2(a.z, a.w); w.z = pk2(b.x, b.y); w.w = pk2(b.z, b.w); ((u32x4*)PB)[i] = w; } }
            }
        }
        STAMP_END_BUSY(3);
        GRID_BAR();
        STAMP_END_WALL(3);
        STAMP_BEGIN(4);
        {
            PHASE_PTRS
            MixArgs ma; ma.Z = Z; ma.Y = oth;
            rwkv::RArgs ra; ra.mu = ARGP(4) + L * 1664; ra.ln_g = ARGP(12) + L * 384; ra.ln_b = ARGP(13) + L * 384;
            ra.RQ = cur; ra.RM = cur + (size_t)3072 * 4096; ra.RB = (float*)(ws + WS_MISC + MISC_RB); PHASE_IDS
            for (int u4 = bx; u4 < 768; u4 += G) { const int u = u4 * 4 + (wave >> 1); rwkv::rwkv_out_unit(ma, ra, lds, u / 192, (u / 32) % 6, u & 31); }
        }
        STAMP_END_BUSY(4);
        GRID_BAR();
        STAMP_END_WALL(4);
        STAMP_BEGIN(5);
        {
            PHASE_PTRS
            const float* x = ARGP(0);
            pg8::Gemm g{oth, (const bf16_t*)(wl + W_OUT), MTOK, DM, K1024}; pg8::StaticOrder S; S.init(MTOK, DM, G, bx);
            epi::EpiOutProj e; e.xin = (L == 0) ? x : out; e.xb = cur; e.ssq_out = ssqB;
            pg8::Gemm g2{PB, (const bf16_t*)(wl + W_PROJ), MTOK, DM, K256};
            epi::EpiBf16Plain e2; e2.C = (bf16_t*)PP;
            if ((bx >> 3) & 1) {
                pg8::gemm_phase<epi::EpiBf16Plain, pg8::StaticOrder, true, true>((PG8_LAS unsigned char*)lds, g2, S, e2);
                pg8::gemm_phase<epi::EpiOutProj, pg8::StaticOrder, true, true>((PG8_LAS unsigned char*)lds, g, S, e);
            } else {
                pg8::gemm_phase<epi::EpiOutProj, pg8::StaticOrder, true, true>((PG8_LAS unsigned char*)lds, g, S, e);
                pg8::gemm_phase<epi::EpiBf16Plain, pg8::StaticOrder, true, true>((PG8_LAS unsigned char*)lds, g2, S, e2);
            }
        }
        STAMP_END_BUSY(5);
        GRID_BAR();
        STAMP_END_WALL(5);
        STAMP_BEGIN(6);
        {
            PHASE_PTRS
            pg8::Gemm g{cur, (const bf16_t*)(wl + W_GATE), MTOK, DM, K1024}; pg8::StaticOrder S; S.init(MTOK, DM, G, bx);
            epi::EpiGate e; e.xout = out; e.x1b = cur; e.pp = (const bf16_t*)PP; e.xb = oth; e.ssq_in = ssqB; e.ssq_out = ssqA;
            pg8::gemm_phase<epi::EpiGate, pg8::StaticOrder, true, true>((PG8_LAS unsigned char*)lds, g, S, e);
        }
        STAMP_END_BUSY(6);
        GRID_BAR();
        STAMP_END_WALL(6);
        STAMP_BEGIN(1); STAMP_BEGIN(7);
    }
    {
        const int L = 0; PHASE_PTRS
        const float* fg = ARGP(18); PHASE_IDS
        for (int m = gw; m < MTOK; m += ngw) { const float rs = row_rstd(ssqA + (size_t)m * 16); f32x4* xr = (f32x4*)(out + (size_t)m * DM) + lane;
#pragma unroll
            for (int j = 0; j < 4; ++j) { const f32x4 gv = ((const f32x4*)fg)[64 * j + lane]; xr[64 * j] = xr[64 * j] * rs * gv; } }
    }
#ifdef PROBE_T
    if (PROBE_T == 7) { __syncthreads(); STAMP_END(7); }
    if (blockIdx.x == 0 && threadIdx.x == 0) { const unsigned long long t0 = __builtin_amdgcn_s_memrealtime(), w = 4ull * TS_LDS[1]; while (__builtin_amdgcn_s_memrealtime() - t0 < w) __builtin_amdgcn_s_sleep(8); }
#endif
}

extern "C" void kernel_launch(void* const* d_in, const int* in_sizes, int n_in, void* d_out, int out_size, void* d_ws, size_t ws_size, hipStream_t stream) {
    static int grid = 0;
    if (grid == 0) {
        if (n_in != 19 || out_size != MTOK * DM || ws_size < WS_END) { fprintf(stderr, "kernel_launch: unexpected shapes n_in %d out %d ws %zu\n", n_in, out_size, ws_size); grid = -1; return; }
        int dev = 0, cus = 0, per_cu = 0;
        if (hipGetDevice(&dev) != hipSuccess || hipDeviceGetAttribute(&cus, hipDeviceAttributeMultiprocessorCount, dev) != hipSuccess) { grid = -1; return; }
        if (hipFuncSetAttribute((const void*)mega_fwd, hipFuncAttributeMaxDynamicSharedMemorySize, LDS_BYTES) != hipSuccess) { fprintf(stderr, "kernel_launch: hipFuncSetAttribute failed\n"); grid = -1; return; }
        if (hipOccupancyMaxActiveBlocksPerMultiprocessor(&per_cu, (const void*)mega_fwd, NWAVES * 64, LDS_BYTES) != hipSuccess || per_cu < 1) { fprintf(stderr, "kernel_launch: occupancy query says %d blocks per CU\n", per_cu); (void)hipGetLastError(); grid = -1; return; }
        grid = cus;
    }
    if (grid < 0) return;
    if (hipMemsetAsync((char*)d_ws + WS_CTL, 0, 1 * MiB, stream) != hipSuccess) return;
    Args a; memset(&a, 0, sizeof a);
    for (int i = 0; i < 19; ++i) a.in[i] = (const float*)d_in[i];
    a.out = (float*)d_out; a.ws = (unsigned char*)d_ws;
    hipLaunchKernelGGL(mega_fwd, dim3(grid), dim3(NWAVES * 64), LDS_BYTES, stream, a);
}
```

```cpp
#include <hip/hip_runtime.h>
#include <cstdio>
#include <cstdint>
#include <cmath>
#include <cstring>

constexpr int BATCH = 16, SEQ = 2048, DM = 1024, DEPTH = 4, MTOK = BATCH * SEQ;
constexpr int ZP = 4136;
constexpr int NPAD = 4352;
constexpr int ZA_R = 0, ZA_K = 384, ZA_V = 768, ZA_G = 1152, ZA_WD = 1536, ZA_AD = 1600;
constexpr int ZB_Q = 1664, ZB_K = 1920, ZB_V = 1984, ZB_IQ = 2048, ZB_IK = 2304, ZB_IW = 2336, ZB_G = 2344;
constexpr int ZC_Q = 2600, ZC_K = 2984, ZC_V = 3368, ZC_G = 3752;
constexpr float LOG2E = 1.4426950408889634f;
constexpr float QSCALE = 0.125f * LOG2E;
constexpr float IQSCALE = 0.17677669529663687f;
constexpr float IWSCALE = 0.35355339059327373f;
constexpr float NORM_EPS = 1e-6f, GN_EPS = 64e-5f;
constexpr float DECAY_SCALE = 0.6065306597126334f;

typedef unsigned short bf16_t;
typedef short bf16x8 __attribute__((ext_vector_type(8)));
typedef float f32x4 __attribute__((ext_vector_type(4)));
typedef float f32x16 __attribute__((ext_vector_type(16)));
typedef unsigned u32x4 __attribute__((ext_vector_type(4)));
typedef unsigned u32x2 __attribute__((ext_vector_type(2)));

__device__ __forceinline__ unsigned f2bf(float f) { unsigned u = __builtin_bit_cast(unsigned, f); return (u + 0x7fffu + ((u >> 16) & 1u)) >> 16; }
typedef float f32x2_t __attribute__((ext_vector_type(2))); typedef __bf16 bf16x2_t __attribute__((ext_vector_type(2)));
__device__ __forceinline__ unsigned pk2(float lo, float hi) { const f32x2_t v = {lo, hi}; return __builtin_bit_cast(unsigned, __builtin_convertvector(v, bf16x2_t)); }
__device__ __forceinline__ float bf2f(unsigned short b) { return __builtin_bit_cast(float, (unsigned)b << 16); }
__device__ __forceinline__ float bflo(unsigned w) { return __builtin_bit_cast(float, w << 16); }
__device__ __forceinline__ float bfhi(unsigned w) { return __builtin_bit_cast(float, w & 0xffff0000u); }
__device__ __forceinline__ float sigmoidf_(float x) { return __builtin_amdgcn_rcpf(1.0f + __builtin_amdgcn_exp2f(-1.4426950408889634f * x)); }
__device__ __forceinline__ float fexp_(float x) { return __builtin_amdgcn_exp2f(1.4426950408889634f * x); }
__device__ __forceinline__ float tanhf_(float x) { const float e = __builtin_amdgcn_exp2f(fminf(2.8853900817779268f * x, 60.f)); return 1.0f - 2.0f * __builtin_amdgcn_rcpf(e + 1.0f); }
__device__ __forceinline__ int opaque_tid() { int t = threadIdx.x; asm volatile("" : "+v"(t)); return t; }
__device__ __forceinline__ u32x4 zero_u32x4() { unsigned z = 0u; asm volatile("" : "+v"(z)); u32x4 r; r.x = z; r.y = z; r.z = z; r.w = z; return r; }
__device__ __forceinline__ float wave_sum(float v) {
#pragma unroll
    for (int o = 1; o < 64; o <<= 1) v += __shfl_xor(v, o);
    return v;
}
__device__ __forceinline__ float wave_max(float v) {
#pragma unroll
    for (int o = 1; o < 64; o <<= 1) v = fmaxf(v, __shfl_xor(v, o));
    return v;
}

constexpr size_t MiB = 1u << 20;
constexpr size_t WS_CTL = 0;
constexpr size_t WS_TAB16 = 1 * MiB;
constexpr size_t WS_TABI = WS_TAB16 + 128 * 1024;
constexpr size_t WS_SSQA = WS_TABI + 64 * 1024;
constexpr size_t WS_SSQB = WS_SSQA + 2 * MiB;
constexpr size_t WS_W = 6 * MiB;
constexpr size_t W_LAYER = 14 * MiB, W_IN = 0, W_OUT = 8912896, W_GATE = W_OUT + 2 * MiB, W_PROJ = W_GATE + 2 * MiB, W_WUPT = W_PROJ + 512 * 1024, W_AUPT = W_WUPT + 48 * 1024;
constexpr size_t WS_BUFA = 62 * MiB;
constexpr size_t WS_BUFB = 126 * MiB;
constexpr size_t WS_PB = 190 * MiB;
constexpr size_t WS_Z = 206 * MiB;
constexpr size_t WS_Z_END = WS_Z + (size_t)MTOK * ZP * 2;
constexpr size_t WS_MISC = 465 * MiB;
constexpr size_t WS_END = 512 * MiB;
constexpr size_t MISC_LQ = 0, MISC_RG = 1 * MiB, MISC_RN = 2 * MiB, MISC_RB = 26 * MiB, MISC_KV = 27 * MiB, MISC_IKC = 35 * MiB;
static_assert(W_AUPT + 48 * 1024 <= W_LAYER && WS_W + 4 * W_LAYER <= WS_BUFA && WS_Z_END <= WS_MISC, "ws map");
namespace pg8 {
#define PG8_LAS __attribute__((address_space(3)))
typedef unsigned short bf16_t;
typedef short bf16x8 __attribute__((ext_vector_type(8)));
typedef float f32x4 __attribute__((ext_vector_type(4)));
typedef unsigned u32x4 __attribute__((ext_vector_type(4)));
constexpr int BM = 256, BK = 64, HALF = 128, HTB = HALF * BK * 2  , STAGE_BYTES = 8 * HTB, NXCD = 8, WGM = 8;

__host__ __device__ __forceinline__ int lds_byte(int r, int c) { const int st = (r >> 4) * 2 + (c >> 5), rr = r & 15, cc = c & 31, ob = rr * 64 + cc * 2; return st * 1024 + (ob ^ (((ob >> 9) & 1) << 5)); }
__host__ __device__ __forceinline__ void stage_rc(int b, int& R, int& C) { const int st = b / 1024, sb = b % 1024, swz = sb ^ (((sb >> 9) & 1) << 5); R = (st >> 1) * 16 + swz / 64; C = (st & 1) * 32 + (swz % 64) / 2; }
__host__ __device__ __forceinline__ int perm32(int rho) { const int n = rho >> 4, i = rho & 15; return 8 * (i >> 2) + 4 * n + (i & 3); }

struct Unit { int pm, pn; };
struct Gemm { const bf16_t* A; const bf16_t* Bt; int M, N, K; };

struct StaticOrder {
    int nM, nN, nwg, G, c;
    __host__ __device__ void init(int M, int N, int G_, int c_) { nM = M / BM; nN = N / BM; nwg = nM * nN; G = G_; c = c_; }
    __host__ __device__ bool next(int i, Unit& u) const {
        const long L = (long)i * G + c; if (L >= nwg) return false;
        int wgid = (int)L; { const int q = nwg / NXCD, r = nwg % NXCD, xcd = wgid % NXCD, off = wgid / NXCD; wgid = (xcd < r ? xcd * (q + 1) : r * (q + 1) + (xcd - r) * q) + off; }
        const int nig = WGM * nN, gid = wgid / nig, fm = gid * WGM, gsz = (nM - fm) < WGM ? (nM - fm) : WGM;
        u.pm = fm + ((wgid % nig) % gsz); u.pn = (wgid % nig) / gsz; return true;
    }
    __device__ __forceinline__ void a_ready(const Unit&) const {}
    __device__ __forceinline__ void done(const Unit&) const {}
};

__device__ __forceinline__ unsigned cvt_pk_bf16(float lo, float hi) { unsigned r; asm volatile("v_cvt_pk_bf16_f32 %0, %1, %2" : "=v"(r) : "v"(lo), "v"(hi)); return r; }
template <class Epi, class Sched, bool ALIGN_EPI = false, bool SP2 = false>
__device__ __forceinline__ void gemm_phase(PG8_LAS unsigned char* lds, const Gemm g, const Sched& S, const Epi& E) {
    int tid_ = threadIdx.x; asm volatile("" : "+v"(tid_));
    const int tid = tid_, wid = __builtin_amdgcn_readfirstlane(tid >> 6), lane = tid & 63, wr = wid >> 2, wc = wid & 3, fr = lane & 15, fq = lane >> 4;
    const int K = g.K, nt = K / BK;
    unsigned voffA[2], voffB[2];
#pragma unroll
    for (int i = 0; i < 2; ++i) { int R, C; stage_rc(tid * 16 + i * 8192, R, C); const int Rb = Epi::PERM ? ((R & ~31) + perm32(R & 31)) : R;
        voffA[i] = (unsigned)(R * K + C) * 2u; voffB[i] = (unsigned)(Rb * K + C) * 2u; }
    const size_t kstep = (size_t)(BK * 2);
    const size_t hstep = (size_t)HALF * K * 2;
    const size_t tstep = 2 * hstep;
    const unsigned ldsw = (unsigned)wid * 1024u;
    const int aoff = lds_byte(wr * 64 + fr, fq * 8), boff = lds_byte(wc * 32 + fr, fq * 8);
#define PG8_SA(b, h) (((b) * 2 + (h)) * HTB)
#define PG8_SB(b, h) ((4 + (b) * 2 + (h)) * HTB)
#define PG8_STAGE(bufoff, gbase, voff) do { _Pragma("unroll") for (int _i = 0; _i < 2; ++_i) \
        __builtin_amdgcn_global_load_lds((const unsigned*)((const char*)(gbase) + (voff)[_i]), (PG8_LAS unsigned*)(lds + (bufoff) + ldsw + _i * 8192), 16, 0, 0); } while (0)
#define PG8_LDA(dst, b, h) do { _Pragma("unroll") for (int m = 0; m < 4; ++m) _Pragma("unroll") for (int k = 0; k < 2; ++k) dst[m][k] = *(const PG8_LAS bf16x8*)(lds + PG8_SA(b, h) + aoff + m * 2048 + k * 1024); } while (0)
#define PG8_LDB(dst, b, h) do { _Pragma("unroll") for (int n = 0; n < 2; ++n) _Pragma("unroll") for (int k = 0; k < 2; ++k) dst[n][k] = *(const PG8_LAS bf16x8*)(lds + PG8_SB(b, h) + boff + n * 2048 + k * 1024); } while (0)
#define PG8_MMA(ai, bj, At, Bt) do { __builtin_amdgcn_s_setprio(1); _Pragma("unroll") for (int m = 0; m < 4; ++m) _Pragma("unroll") for (int n = 0; n < 2; ++n) _Pragma("unroll") for (int k = 0; k < 2; ++k) \
        acc[ai][bj][m][n] = __builtin_amdgcn_mfma_f32_16x16x32_bf16(Bt[n][k], At[m][k], acc[ai][bj][m][n], 0, 0, 0); __builtin_amdgcn_s_setprio(0); } while (0)
#define PG8_WAIT_V(n) asm volatile("s_waitcnt vmcnt(" #n ")" ::: "memory")
#define PG8_WAIT_L(n) asm volatile("s_waitcnt lgkmcnt(" #n ")" ::: "memory")
#define PG8_BAR __builtin_amdgcn_s_barrier()
#define PG8_SCHED __builtin_amdgcn_sched_barrier(0)
    Unit cur, nxt; int ui = 0;
    if (!S.next(0, cur)) return;
    f32x4 acc[2][2][4][2];
#pragma unroll
    for (int a = 0; a < 2; ++a)
#pragma unroll
        for (int b = 0; b < 2; ++b)
#pragma unroll
            for (int m = 0; m < 4; ++m)
#pragma unroll
                for (int n = 0; n < 2; ++n) acc[a][b][m][n] = (f32x4){0.f, 0.f, 0.f, 0.f};
    bf16x8 At[4][2], B0[2][2], B1[2][2];
    const char* cA = (const char*)g.A + (size_t)cur.pm * tstep; const char* cB = (const char*)g.Bt + (size_t)cur.pn * tstep;
    S.a_ready(cur);
    if constexpr (SP2) {
        PG8_STAGE(PG8_SB(0, 0), cB, voffB); PG8_STAGE(PG8_SB(0, 1), cB + hstep, voffB); PG8_STAGE(PG8_SA(0, 0), cA, voffA); PG8_STAGE(PG8_SA(0, 1), cA + hstep, voffA);
        if (wr == 1) PG8_BAR;
        PG8_WAIT_V(2); PG8_BAR;
        PG8_STAGE(PG8_SB(1, 0), cB + kstep, voffB); PG8_STAGE(PG8_SA(1, 0), cA + kstep, voffA); PG8_STAGE(PG8_SB(1, 1), cB + hstep + kstep, voffB);
        PG8_WAIT_V(6); PG8_BAR;
    } else {
        PG8_STAGE(PG8_SB(0, 0), cB, voffB); PG8_STAGE(PG8_SA(0, 0), cA, voffA); PG8_STAGE(PG8_SB(0, 1), cB + hstep, voffB); PG8_STAGE(PG8_SA(0, 1), cA + hstep, voffA);
        if (wr == 1) PG8_BAR;
        PG8_WAIT_V(4); PG8_BAR;
        PG8_STAGE(PG8_SB(1, 0), cB + kstep, voffB); PG8_STAGE(PG8_SA(1, 0), cA + kstep, voffA); PG8_STAGE(PG8_SB(1, 1), cB + hstep + kstep, voffB);
        PG8_WAIT_V(6); PG8_BAR;
    }
    for (;;) {
        const bool has_next = S.next(ui + 1, nxt);
        const char* nA = has_next ? (const char*)g.A + (size_t)nxt.pm * tstep : cA; const char* nB = has_next ? (const char*)g.Bt + (size_t)nxt.pn * tstep : cB;
        for (int t = 0; t < nt; t += 2) {
            const bool last = (t == nt - 2);
            const char* a1 = cA + (size_t)(t + 1) * kstep;
            const char* a2 = last ? nA : cA + (size_t)(t + 2) * kstep; const char* b2 = last ? nB : cB + (size_t)(t + 2) * kstep;
            const char* a3 = a2 + kstep; const char* b3 = b2 + kstep;
            if (last && has_next) S.a_ready(nxt);
            if constexpr (SP2) {
            PG8_LDB(B0, 0, 0); PG8_LDB(B1, 0, 1); PG8_SCHED; PG8_LDA(At, 0, 0); PG8_STAGE(PG8_SA(1, 1), a1 + hstep, voffA);
            PG8_WAIT_V(8); PG8_WAIT_L(0); PG8_BAR; PG8_MMA(0, 0, At, B0); PG8_MMA(0, 1, At, B1); PG8_BAR; PG8_SCHED;
            PG8_LDA(At, 0, 1); PG8_STAGE(PG8_SB(0, 0), b2, voffB); PG8_STAGE(PG8_SB(0, 1), b2 + hstep, voffB); PG8_STAGE(PG8_SA(0, 0), a2, voffA);
            PG8_WAIT_V(8); PG8_WAIT_L(0); PG8_BAR; PG8_MMA(1, 0, At, B0); PG8_MMA(1, 1, At, B1); PG8_BAR; PG8_SCHED;
            PG8_LDB(B0, 1, 0); PG8_LDB(B1, 1, 1); PG8_SCHED; PG8_LDA(At, 1, 0); PG8_STAGE(PG8_SA(0, 1), a2 + hstep, voffA);
            PG8_WAIT_V(8); PG8_WAIT_L(0); PG8_BAR; PG8_MMA(0, 0, At, B0); PG8_MMA(0, 1, At, B1); PG8_BAR; PG8_SCHED;
            PG8_LDA(At, 1, 1); PG8_STAGE(PG8_SB(1, 0), b3, voffB); PG8_STAGE(PG8_SB(1, 1), b3 + hstep, voffB); PG8_STAGE(PG8_SA(1, 0), a3, voffA);
            PG8_WAIT_V(8); PG8_WAIT_L(0); PG8_BAR; PG8_MMA(1, 0, At, B0); PG8_MMA(1, 1, At, B1); PG8_BAR; PG8_SCHED;
            } else {
            PG8_LDB(B0, 0, 0); PG8_SCHED; PG8_LDA(At, 0, 0); PG8_STAGE(PG8_SA(1, 1), a1 + hstep, voffA);
            PG8_WAIT_L(8); PG8_BAR; PG8_WAIT_L(0); PG8_MMA(0, 0, At, B0); PG8_BAR; PG8_SCHED;
            PG8_LDB(B1, 0, 1); PG8_STAGE(PG8_SB(0, 0), b2, voffB);
            PG8_BAR; PG8_WAIT_L(0); PG8_MMA(0, 1, At, B1); PG8_BAR;
            PG8_LDA(At, 0, 1); PG8_STAGE(PG8_SA(0, 0), a2, voffA);
            PG8_BAR; PG8_WAIT_L(0); PG8_MMA(1, 0, At, B0); PG8_BAR; PG8_SCHED;
            PG8_STAGE(PG8_SB(0, 1), b2 + hstep, voffB);
            PG8_WAIT_V(6); PG8_BAR; PG8_MMA(1, 1, At, B1); PG8_BAR;
            PG8_LDB(B0, 1, 0); PG8_SCHED; PG8_LDA(At, 1, 0); PG8_STAGE(PG8_SA(0, 1), a2 + hstep, voffA);
            PG8_WAIT_L(8); PG8_BAR; PG8_WAIT_L(0); PG8_MMA(0, 0, At, B0); PG8_BAR; PG8_SCHED;
            PG8_LDB(B1, 1, 1); PG8_STAGE(PG8_SB(1, 0), b3, voffB);
            PG8_BAR; PG8_WAIT_L(0); PG8_MMA(0, 1, At, B1); PG8_BAR;
            PG8_LDA(At, 1, 1); PG8_STAGE(PG8_SA(1, 0), a3, voffA);
            PG8_BAR; PG8_WAIT_L(0); PG8_MMA(1, 0, At, B0); PG8_BAR; PG8_SCHED;
            PG8_STAGE(PG8_SB(1, 1), b3 + hstep, voffB);
            PG8_WAIT_V(6); PG8_BAR; PG8_MMA(1, 1, At, B1); PG8_BAR;
            }
        }
        if constexpr (ALIGN_EPI) { if (wr == 0) PG8_BAR; }
        if constexpr (!Epi::AFTER_DRAIN) { E(acc, cur, wr, wc, fr, fq); S.done(cur); }
        if (!has_next) break;
#pragma unroll
        for (int a = 0; a < 2; ++a)
#pragma unroll
            for (int b = 0; b < 2; ++b)
#pragma unroll
                for (int m = 0; m < 4; ++m)
#pragma unroll
                    for (int n = 0; n < 2; ++n) acc[a][b][m][n] = (f32x4){0.f, 0.f, 0.f, 0.f};
        cur = nxt; cA = nA; cB = nB; ++ui;
        if constexpr (ALIGN_EPI) { if (wr == 1) PG8_BAR; }
    }
    PG8_WAIT_V(0);
    if constexpr (!ALIGN_EPI) { if (wr == 0) PG8_BAR; }
    PG8_BAR;
    if constexpr (Epi::AFTER_DRAIN) { E.fused(acc, cur, wr, wc, fr, fq, lds, wid, lane); S.done(cur); }
#undef PG8_SA
#undef PG8_SB
#undef PG8_STAGE
#undef PG8_LDA
#undef PG8_LDB
#undef PG8_MMA
#undef PG8_WAIT_V
#undef PG8_WAIT_L
#undef PG8_BAR
#undef PG8_SCHED
}
}
#define GAS __attribute__((address_space(1)))
#define LAS __attribute__((address_space(3)))

__device__ __forceinline__ int zcol_src(int n, float& sc) {
    sc = 1.f;
    if (n < ZB_Q) return n;
    if (n < ZB_K) { int o = n - ZB_Q, h = o >> 6, d = o & 63; sc = QSCALE; if (d < 16) d = (d >> 1) + 8 * (d & 1); return ZB_Q + h * 64 + d; }
    if (n < ZB_V) { int d = n - ZB_K; if (d < 16) d = (d >> 1) + 8 * (d & 1); return ZB_K + d; }
    if (n < ZB_IQ) return n;
    if (n < ZB_IK) { int o = n - ZB_IQ, h = o >> 5, d = o & 31; sc = IQSCALE; if (d < 8) d = (d >> 1) + 4 * (d & 1); return ZB_IQ + h * 32 + d; }
    if (n < ZB_IW) { int d = n - ZB_IK; if (d < 8) d = (d >> 1) + 4 * (d & 1); return ZB_IK + d; }
    if (n < ZB_G) { sc = IWSCALE; return n; }
    if (n < ZC_Q) return n;
    if (n < ZC_K) { int o = n - ZC_Q, h = o >> 6, d = o & 63; sc = QSCALE; if (d < 16) d = (d >> 1) + 8 * (d & 1); return ZC_Q + h * 64 + d; }
    if (n < ZC_V) { int o = n - ZC_K, h = o >> 6, d = o & 63; if (d < 16) d = (d >> 1) + 8 * (d & 1); return ZC_K + h * 64 + d; }
    return n;
}

template <bool ZMAP>
__device__ __forceinline__ void transpose_item(const float* __restrict__ W, int K, int NW, bf16_t* WT, const float* __restrict__ kscale, LAS float* scr, int item, int nblk, int lane) {
    const int kb = item / nblk, nb = item % nblk, k0 = 64 * kb, n0 = 32 * nb;
    const int c4 = 4 * (lane & 7), ncol = n0 + c4;
    f32x4 v[8];
#pragma unroll
    for (int i = 0; i < 8; ++i) { const int kk = (lane >> 3) + 8 * i; v[i] = (f32x4){0.f, 0.f, 0.f, 0.f}; if (ncol < NW) v[i] = *(const f32x4*)(W + (size_t)(k0 + kk) * NW + ncol); }
#pragma unroll
    for (int i = 0; i < 8; ++i) { const int kk = (lane >> 3) + 8 * i; f32x4 x = v[i]; if (kscale) x = x * kscale[k0 + kk];
        scr[kk * 33 + c4] = x[0]; scr[kk * 33 + c4 + 1] = x[1]; scr[kk * 33 + c4 + 2] = x[2]; scr[kk * 33 + c4 + 3] = x[3]; }
    asm volatile("s_waitcnt lgkmcnt(0)" ::: "memory");
    const int c = lane & 7;
#pragma unroll
    for (int j = 0; j < 4; ++j) { const int n = (lane >> 3) + 8 * j; int sl = n; float sc = 1.f;
        if (ZMAP) { if (n0 + n < NW) sl = zcol_src(n0 + n, sc) - n0; else { sl = n; sc = 0.f; } }
        const LAS float* s = scr + (8 * c) * 33 + sl;
        u32x4 o; o.x = pk2(s[0 * 33] * sc, s[1 * 33] * sc); o.y = pk2(s[2 * 33] * sc, s[3 * 33] * sc); o.z = pk2(s[4 * 33] * sc, s[5 * 33] * sc); o.w = pk2(s[6 * 33] * sc, s[7 * 33] * sc);
        *(u32x4*)(WT + (size_t)(n0 + n) * K + k0 + 8 * c) = o; }
    asm volatile("s_waitcnt lgkmcnt(0)" ::: "memory");
}

struct PrepArgs { const float* w_in; const float* norm_g; const float* w_out; const float* ple_g; const float* w_gate; const float* w_proj; const float* w_up; const float* a_up; unsigned char* ws; };

__device__ __forceinline__ void prep_weights(const PrepArgs& a, int gw, int ngw, LAS float* scr, int lane, int L0, int L1) {
    constexpr int I_IN = 16 * (NPAD / 32), I_SQ = 16 * 32, I_PJ = 4 * 32, I_UP = 12, I_LAYER = I_IN + 2 * I_SQ + I_PJ + 2 * I_UP;
    for (int it = gw; it < (L1 - L0) * I_LAYER; it += ngw) {
        const int L = L0 + it / I_LAYER; int r = it % I_LAYER;
        unsigned char* wl = a.ws + WS_W + (size_t)L * W_LAYER;
        if (r < I_IN) { transpose_item<true>(a.w_in + (size_t)L * DM * ZP, DM, ZP, (bf16_t*)(wl + W_IN), a.norm_g + L * DM, scr, r, NPAD / 32, lane); continue; } r -= I_IN;
        if (r < I_SQ) { transpose_item<false>(a.w_out + (size_t)L * DM * DM, DM, DM, (bf16_t*)(wl + W_OUT), nullptr, scr, r, 32, lane); continue; } r -= I_SQ;
        if (r < I_SQ) { transpose_item<false>(a.w_gate + (size_t)L * DM * DM, DM, DM, (bf16_t*)(wl + W_GATE), a.ple_g + L * DM, scr, r, 32, lane); continue; } r -= I_SQ;
        if (r < I_PJ) { transpose_item<false>(a.w_proj + (size_t)L * 256 * DM, 256, DM, (bf16_t*)(wl + W_PROJ), nullptr, scr, r, 32, lane); continue; } r -= I_PJ;
        if (r < I_UP) { transpose_item<false>(a.w_up + (size_t)L * 64 * 384, 64, 384, (bf16_t*)(wl + W_WUPT), nullptr, scr, r, 12, lane); continue; } r -= I_UP;
        transpose_item<false>(a.a_up + (size_t)L * 64 * 384, 64, 384, (bf16_t*)(wl + W_AUPT), nullptr, scr, r, 12, lane);
    }
}

__device__ __forceinline__ void sincos_d(float ang, float& c, float& s) {
    const double a = (double)ang; const double n = rint(a * 0.63661977236758134308);
    double r = fma(-n, 1.57079632679489655800e+00, a); r = fma(-n, 6.12323399573676603587e-17, r);
    const double r2 = r * r;
    double sp = r2 * (1.0 / 6227020800.0) - 1.0 / 39916800.0; sp = sp * r2 + 1.0 / 362880.0; sp = sp * r2 - 1.0 / 5040.0; sp = sp * r2 + 1.0 / 120.0; sp = sp * r2 - 1.0 / 6.0; sp = sp * r2 * r + r;
    double cp = r2 * (1.0 / 479001600.0) - 1.0 / 3628800.0; cp = cp * r2 + 1.0 / 40320.0; cp = cp * r2 - 1.0 / 720.0; cp = cp * r2 + 1.0 / 24.0; cp = cp * r2 - 0.5; cp = cp * r2 + 1.0;
    const int q = ((int)n) & 3;
    const double sv = (q == 0) ? sp : (q == 1) ? cp : (q == 2) ? -sp : -cp;
    const double cv = (q == 0) ? cp : (q == 1) ? -sp : (q == 2) ? -cp : sp;
    c = (float)cv; s = (float)sv;
}
__device__ __forceinline__ void prep_tables(unsigned char* ws, int gtid, int nthreads) {
    const float inv8[8] = {1.0f, 0.1939227432012558f, 0.03760603070259094f, 0.007292664609849453f, 0.0014142135623842478f, 0.00027424818836152554f, 5.318296098266728e-05f, 1.0313386155758053e-05f};
    float* t16 = (float*)(ws + WS_TAB16); float* tI = (float*)(ws + WS_TABI);
    for (int e = gtid; e < SEQ * 8; e += nthreads) { const int pos = e >> 3, i = e & 7;
        float iv = inv8[0];
#pragma unroll
        for (int j = 1; j < 8; ++j) iv = (i == j) ? inv8[j] : iv;
        float c, s; sincos_d((float)pos * iv, c, s); t16[pos * 16 + i] = c; t16[pos * 16 + 8 + i] = s;
        if ((i & 1) == 0) { const int i4 = i >> 1; tI[pos * 8 + i4] = c; tI[pos * 8 + 4 + i4] = s; }
    }
}
__device__ __forceinline__ void x_row_to_bf16(const float* xrow, bf16_t* orow, float* ssq, int lane) {
    const f32x4* xr = (const f32x4*)xrow + lane;
    unsigned long long* o8 = (unsigned long long*)orow + lane;
#pragma unroll
    for (int j = 0; j < 4; ++j) { const f32x4 v = xr[64 * j];
        float s = (v.x * v.x + v.y * v.y) + (v.z * v.z + v.w * v.w);
        o8[64 * j] = (unsigned long long)pk2(v.x, v.y) | ((unsigned long long)pk2(v.z, v.w) << 32);
        s += __shfl_xor(s, 1); s += __shfl_xor(s, 2); s += __shfl_xor(s, 4); s += __shfl_xor(s, 8);
        if ((lane & 15) == 0) ssq[4 * j + (lane >> 4)] = s; }
}
__device__ __forceinline__ float row_rstd(const float* ssq_row) {
    const f32x4 a = *(const f32x4*)ssq_row, b = *(const f32x4*)(ssq_row + 4), c = *(const f32x4*)(ssq_row + 8), d = *(const f32x4*)(ssq_row + 12);
    const float s = ((a.x + a.y) + (a.z + a.w)) + ((b.x + b.y) + (b.z + b.w)) + ((c.x + c.y) + (c.z + c.w)) + ((d.x + d.y) + (d.z + d.w));
    return __builtin_amdgcn_rsqf(s * (1.0f / DM) + NORM_EPS);
}
namespace epi {
using pg8::Unit; using pg8::BM; using pg8::HALF;
__device__ __forceinline__ u32x4 pack8(const f32x4& a, const f32x4& b) { u32x4 w; w.x = pg8::cvt_pk_bf16(a[0], a[1]); w.y = pg8::cvt_pk_bf16(a[2], a[3]); w.z = pg8::cvt_pk_bf16(b[0], b[1]); w.w = pg8::cvt_pk_bf16(b[2], b[3]); return w; }
__device__ __forceinline__ int rope_class(int c0, int& fb) {
    fb = 0; int o;
    if (c0 >= ZB_Q && c0 < ZB_V) { o = (c0 - ZB_Q) & 63; if (o < 16) { fb = o >> 1; return 1; } return 0; }
    if (c0 >= ZB_IQ && c0 < ZB_IW) { o = (c0 - ZB_IQ) & 31; return o == 0 ? 2 : 0; }
    if (c0 >= ZC_Q && c0 < ZC_V) { o = (c0 - ZC_Q) & 63; if (o < 16) { fb = o >> 1; return 1; } return 0; }
    return 0;
}
struct EpiInProj {
    static constexpr bool PERM = true, AFTER_DRAIN = false;
    bf16_t* Z; const float* ssq; const float* tab16; const float* tabI; bf16_t* KV; bf16_t* IKC;
    __device__ __forceinline__ void operator()(const f32x4 (&acc)[2][2][4][2], const Unit& u, int wr, int wc, int fr, int fq) const {
        const int row0 = u.pm * BM + wr * 64 + fr;
        const int c00 = u.pn * BM + wc * 32 + 8 * fq, c01 = c00 + HALF;
        int fb0, fb1; const int rc0 = rope_class(c00, fb0), rc1 = rope_class(c01, fb1);
#pragma unroll
        for (int ai = 0; ai < 2; ++ai)
#pragma unroll
            for (int m = 0; m < 4; ++m) {
                const int row = row0 + ai * HALF + m * 16;
                const float rs = row_rstd(ssq + (size_t)row * 16);
                const int pos = row & (SEQ - 1);
#pragma unroll
                for (int bj = 0; bj < 2; ++bj) {
                    const int c0 = bj ? c01 : c00, rc = bj ? rc1 : rc0, fb = bj ? fb1 : fb0;
                    if (c0 >= ZP) continue;
                    f32x4 v0 = acc[ai][bj][m][0] * rs, v1 = acc[ai][bj][m][1] * rs;
                    if (rc) {
                        const float* tp = (rc == 1) ? tab16 + pos * 16 + fb : tabI + pos * 8;
                        const f32x4 c = *(const f32x4*)tp, s = *(const f32x4*)(tp + (rc == 1 ? 8 : 4));
                        f32x4 a0, a1;
                        a0[0] = v0[0] * c[0] - v0[1] * s[0]; a0[1] = v0[1] * c[0] + v0[0] * s[0];
                        a0[2] = v0[2] * c[1] - v0[3] * s[1]; a0[3] = v0[3] * c[1] + v0[2] * s[1];
                        a1[0] = v1[0] * c[2] - v1[1] * s[2]; a1[1] = v1[1] * c[2] + v1[0] * s[2];
                        a1[2] = v1[2] * c[3] - v1[3] * s[3]; a1[3] = v1[3] * c[3] + v1[2] * s[3];
                        v0 = a0; v1 = a1;
                    }
                    const u32x4 pk = pack8(v0, v1);
                    if (c0 >= ZB_K && c0 < ZB_IQ) *(u32x4*)(KV + (size_t)row * 128 + (c0 - ZB_K)) = pk;
                    else if (c0 >= ZB_IK && c0 < ZB_IW) *(u32x4*)(IKC + (size_t)row * 32 + (c0 - ZB_IK)) = pk;
                    else *(u32x4*)(Z + (size_t)row * ZP + c0) = pk;
                }
                asm volatile("" ::: "memory");
            }
    }
};
struct EpiPlainZ {
    static constexpr bool PERM = true, AFTER_DRAIN = false;
    bf16_t* Z;
    __device__ __forceinline__ void operator()(const f32x4 (&acc)[2][2][4][2], const Unit& u, int wr, int wc, int fr, int fq) const {
        const int row0 = u.pm * BM + wr * 64 + fr;
#pragma unroll
        for (int ai = 0; ai < 2; ++ai)
#pragma unroll
            for (int m = 0; m < 4; ++m)
#pragma unroll
                for (int bj = 0; bj < 2; ++bj) { const int c0 = u.pn * BM + bj * HALF + wc * 32 + 8 * fq; if (c0 < ZP) *(u32x4*)(Z + (size_t)(row0 + ai * HALF + m * 16) * ZP + c0) = pack8(acc[ai][bj][m][0], acc[ai][bj][m][1]); }
    }
};
struct EpiOutProj {
    static constexpr bool PERM = true, AFTER_DRAIN = false;
    bf16_t* xb; float* ssq_out;
    __device__ __forceinline__ void operator()(const f32x4 (&acc)[2][2][4][2], const Unit& u, int wr, int wc, int fr, int fq) const {
        const int row0 = u.pm * BM + wr * 64 + fr;
#pragma unroll
        for (int ai = 0; ai < 2; ++ai)
#pragma unroll
            for (int m = 0; m < 4; ++m) {
                const int row = row0 + ai * HALF + m * 16; float sq = 0.f;
#pragma unroll
                for (int bj = 0; bj < 2; ++bj) {
                    const size_t off = (size_t)row * DM + u.pn * BM + bj * HALF + wc * 32 + 8 * fq;
                    const u32x4 iw = *(const u32x4*)(xb + off); const f32x4 ia = {bflo(iw.x), bfhi(iw.x), bflo(iw.y), bfhi(iw.y)}, ib = {bflo(iw.z), bfhi(iw.z), bflo(iw.w), bfhi(iw.w)};
                    const f32x4 x0 = ia + acc[ai][bj][m][0], x1 = ib + acc[ai][bj][m][1];
                    *(u32x4*)(xb + off) = pack8(x0, x1);
                    sq += ((x0[0] * x0[0] + x0[1] * x0[1]) + (x0[2] * x0[2] + x0[3] * x0[3])) + ((x1[0] * x1[0] + x1[1] * x1[1]) + (x1[2] * x1[2] + x1[3] * x1[3]));
                }
                sq += __shfl_xor(sq, 16); sq += __shfl_xor(sq, 32);
                if (fq == 0) ssq_out[(size_t)row * 16 + u.pn * 4 + wc] = sq;
            }
    }
};
struct EpiGate {
    static constexpr bool PERM = true, AFTER_DRAIN = false;
    const bf16_t* x1b; const bf16_t* pp; bf16_t* xb; const float* ssq_in; float* ssq_out;
    __device__ __forceinline__ void operator()(const f32x4 (&acc)[2][2][4][2], const Unit& u, int wr, int wc, int fr, int fq) const {
        const int row0 = u.pm * BM + wr * 64 + fr;
#pragma unroll
        for (int ai = 0; ai < 2; ++ai)
#pragma unroll
            for (int m = 0; m < 4; ++m) {
                const int row = row0 + ai * HALF + m * 16; float sq = 0.f;
                const float rs = row_rstd(ssq_in + (size_t)row * 16);
#pragma unroll
                for (int bj = 0; bj < 2; ++bj) {
                    const size_t off = (size_t)row * DM + u.pn * BM + bj * HALF + wc * 32 + 8 * fq;
                    f32x4 g0 = acc[ai][bj][m][0] * rs, g1 = acc[ai][bj][m][1] * rs;
#pragma unroll
                    for (int i = 0; i < 4; ++i) { g0[i] = sigmoidf_(g0[i]); g1[i] = sigmoidf_(g1[i]); }
                    const u32x4 pw = *(const u32x4*)(pp + off); const f32x4 pp0 = {bflo(pw.x), bfhi(pw.x), bflo(pw.y), bfhi(pw.y)}, pp1 = {bflo(pw.z), bfhi(pw.z), bflo(pw.w), bfhi(pw.w)};
                    const u32x4 xw = *(const u32x4*)(x1b + off); const f32x4 xa = {bflo(xw.x), bfhi(xw.x), bflo(xw.y), bfhi(xw.y)}, xc = {bflo(xw.z), bfhi(xw.z), bflo(xw.w), bfhi(xw.w)};
                    const f32x4 x0 = xa + g0 * pp0, x1 = xc + g1 * pp1;
                    *(u32x4*)(xb + off) = pack8(x0, x1);
                    sq += ((x0[0] * x0[0] + x0[1] * x0[1]) + (x0[2] * x0[2] + x0[3] * x0[3])) + ((x1[0] * x1[0] + x1[1] * x1[1]) + (x1[2] * x1[2] + x1[3] * x1[3]));
                }
                sq += __shfl_xor(sq, 16); sq += __shfl_xor(sq, 32);
                if (fq == 0) ssq_out[(size_t)row * 16 + u.pn * 4 + wc] = sq;
            }
    }
};
struct EpiBf16Plain {
    static constexpr bool PERM = true, AFTER_DRAIN = false;
    bf16_t* C;
    __device__ __forceinline__ void operator()(const f32x4 (&acc)[2][2][4][2], const Unit& u, int wr, int wc, int fr, int fq) const {
        const int row0 = u.pm * BM + wr * 64 + fr;
#pragma unroll
        for (int ai = 0; ai < 2; ++ai)
#pragma unroll
            for (int m = 0; m < 4; ++m)
#pragma unroll
                for (int bj = 0; bj < 2; ++bj) {
                    const size_t off = (size_t)(row0 + ai * HALF + m * 16) * DM + u.pn * BM + bj * HALF + wc * 32 + 8 * fq;
                    *(u32x4*)(C + off) = pack8(acc[ai][bj][m][0], acc[ai][bj][m][1]);
                }
    }
};
struct EpiF32 {
    static constexpr bool PERM = true, AFTER_DRAIN = false;
    float* C;
    __device__ __forceinline__ void operator()(const f32x4 (&acc)[2][2][4][2], const Unit& u, int wr, int wc, int fr, int fq) const {
        const int row0 = u.pm * BM + wr * 64 + fr;
#pragma unroll
        for (int ai = 0; ai < 2; ++ai)
#pragma unroll
            for (int m = 0; m < 4; ++m)
#pragma unroll
                for (int bj = 0; bj < 2; ++bj) {
                    const size_t off = (size_t)(row0 + ai * HALF + m * 16) * DM + u.pn * BM + bj * HALF + wc * 32 + 8 * fq;
                    *(f32x4*)(C + off) = acc[ai][bj][m][0]; *(f32x4*)(C + off + 4) = acc[ai][bj][m][1];
                }
    }
};
}
typedef GAS unsigned gu32;
#define RLX_AGENT __ATOMIC_RELAXED, __HIP_MEMORY_SCOPE_AGENT
#define XB_TMO      128
#define XB_XCNT(j)  (256  + 64 * (j))
#define XB_XSUB(j)  (1280 + 64 * (j))
#define XB_XGEN(j)  (2304 + 64 * (j))
#define XB_TOP      3328
#define XB_TOPGEN   3392
#define XCD_BAR_WORDS 3456
#define XB_SPIN_CAP (1u << 27)

__device__ __forceinline__ unsigned xb_ld(unsigned* p)              { return __hip_atomic_load(p, __ATOMIC_RELAXED, __HIP_MEMORY_SCOPE_AGENT); }
__device__ __forceinline__ unsigned xb_add(unsigned* p, unsigned v) { return __hip_atomic_fetch_add(p, v, __ATOMIC_RELAXED, __HIP_MEMORY_SCOPE_AGENT); }
__device__ __forceinline__ unsigned xb_xcc_id() { return (unsigned)__builtin_amdgcn_s_getreg((3 << 11) | 20) & 0xFu; }
#define XB_SPIN(cond, bar) do { unsigned _sp = 0; while (cond) { __builtin_amdgcn_s_sleep(1); \
    if ((++_sp & 255u) == 0u) { if (xb_ld(&(bar)[XB_TMO])) break; if (_sp > XB_SPIN_CAP) { atomicAdd(&(bar)[XB_TMO], 1u); break; } } } } while (0)

struct XcdBarrier {
    unsigned* bar; unsigned x;
    volatile LAS unsigned* st;
};

__device__ __forceinline__ XcdBarrier xcd_barrier_post(unsigned* bar, volatile LAS unsigned* st) {
    XcdBarrier b; b.bar = bar; b.x = xb_xcc_id(); b.st = st;
    if (threadIdx.x == 0) (void)xb_add(&bar[XB_XCNT(b.x)], 1u);
    return b;
}
__device__ __forceinline__ void xcd_barrier_complete(unsigned* bar, unsigned x, unsigned& nloc, unsigned& nx) {
    const unsigned G = gridDim.x * gridDim.y * gridDim.z;
    unsigned sum, cnt, mine, sp = 0u;
    for (;;) {
        sum = 0u; cnt = 0u; mine = 0u;
#pragma unroll
        for (unsigned j = 0; j < 16; ++j) { const unsigned c = xb_ld(&bar[XB_XCNT(j)]); sum += c; cnt += (c > 0u) ? 1u : 0u; mine = (j == x) ? c : mine; }
        if (sum == G) break;
        __builtin_amdgcn_s_sleep(1);
        if ((++sp & 255u) == 0u) { if (xb_ld(&bar[XB_TMO])) break; if (sp > XB_SPIN_CAP) { atomicAdd(&bar[XB_TMO], 1u); break; } }
    }
    nloc = mine > 0u ? mine : 1u; nx = cnt > 0u ? cnt : 1u;
}

__device__ __forceinline__ void xcd_barrier(const XcdBarrier& b) {
    asm volatile("s_waitcnt vmcnt(0)" ::: "memory");
    __syncthreads();
    if (threadIdx.x == 0) {
        unsigned* bar = b.bar;
        __builtin_amdgcn_s_waitcnt(0);
        unsigned nloc = b.st[0], nx = b.st[1];
        if (nloc == 0u) { xcd_barrier_complete(bar, b.x, nloc, nx); b.st[0] = nloc; b.st[1] = nx; }
        const unsigned old = xb_add(&bar[XB_XSUB(b.x)], 1u);
        const unsigned gen = old / nloc;
        if (old + 1u == (gen + 1u) * nloc) {
            __builtin_amdgcn_fence(__ATOMIC_RELEASE, "agent");
            asm volatile("s_waitcnt vmcnt(0)" ::: "memory");
            const unsigned og = xb_add(&bar[XB_TOP], 1u);
            const unsigned tg = og / nx;
            if (og + 1u == (tg + 1u) * nx) xb_add(&bar[XB_TOPGEN], 1u);
            else XB_SPIN(xb_ld(&bar[XB_TOPGEN]) == tg, bar);
            __builtin_amdgcn_fence(__ATOMIC_ACQUIRE, "agent");
            xb_add(&bar[XB_XGEN(b.x)], 1u);
            asm volatile("s_waitcnt vmcnt(0)" ::: "memory");
        } else {
            XB_SPIN(xb_ld(&bar[XB_XGEN(b.x)]) == gen, bar);
            __builtin_amdgcn_fence(__ATOMIC_ACQUIRE, "agent");
            asm volatile("s_waitcnt vmcnt(0)" ::: "memory");
        }
    }
    __syncthreads();
}
struct MixArgs { const bf16_t* Z; bf16_t* Y; const bf16_t* KV; const bf16_t* IKC; const float* mu; const float* w0; const float* w_up; const float* a0; const float* a_up; const float* k_k; const float* k_a; const float* r_k; const float* ln_g; const float* ln_b; };
namespace dsa {
#ifdef PROBE_T
#define DTS ((volatile LAS unsigned long long*)((LAS unsigned char*)ldsb + 131072 + 1024))
#define DSTAMP_B(id) do { if ((id) == PROBE_T && blockIdx.x == 0 && threadIdx.x == 0) DTS[0] = __builtin_amdgcn_s_memrealtime(); } while (0)
#define DSTAMP_E(id) do { if ((id) == PROBE_T && blockIdx.x == 0 && threadIdx.x == 0) DTS[1] += __builtin_amdgcn_s_memrealtime() - DTS[0]; } while (0)
#else
#define DSTAMP_B(id) do {} while (0)
#define DSTAMP_E(id) do {} while (0)
#endif
#define MFMA32(a, b, c) __builtin_amdgcn_mfma_f32_32x32x16_bf16((a), (b), (c), 0, 0, 0)
typedef short v4i16_t __attribute__((ext_vector_type(4)));
typedef short s16x4 __attribute__((ext_vector_type(4)));
constexpr int WAVE_LDS = 2048 + 4096;
constexpr int IKS_OFF = 8 * WAVE_LDS, IKS_BYTES = 65536;
__device__ __forceinline__ unsigned fkey(float f) { const unsigned b = __builtin_bit_cast(unsigned, f); return (b & 0x80000000u) ? ~b : (b | 0x80000000u); }
__device__ __forceinline__ float keyf(unsigned u) { const unsigned b = (u & 0x80000000u) ? (u & 0x7fffffffu) : ~u; return __builtin_bit_cast(float, b); }
__device__ __forceinline__ float relu_(float x) { const int b = __builtin_bit_cast(int, x); return __builtin_bit_cast(float, b > 0 ? b : 0); }
__device__ __forceinline__ s16x4 vtr(const LAS unsigned char* p) { return __builtin_bit_cast(s16x4, __builtin_amdgcn_ds_read_tr16_b64_v4i16((LAS v4i16_t*)p)); }

#define DPP_(v, ctrl) ((unsigned)__builtin_amdgcn_update_dpp((int)(v), (int)(v), (ctrl), 0xf, 0xf, false))
__device__ __forceinline__ unsigned half_min(unsigned v) { v = min(v, DPP_(v, 0xB1)); v = min(v, DPP_(v, 0x4E)); v = min(v, DPP_(v, 0x141)); v = min(v, DPP_(v, 0x140)); return min(v, (unsigned)__builtin_amdgcn_ds_swizzle((int)v, 0x401F)); }
__device__ __forceinline__ unsigned half_max(unsigned v) { v = max(v, DPP_(v, 0xB1)); v = max(v, DPP_(v, 0x4E)); v = max(v, DPP_(v, 0x141)); v = max(v, DPP_(v, 0x140)); return max(v, (unsigned)__builtin_amdgcn_ds_swizzle((int)v, 0x401F)); }
__device__ __forceinline__ int half_sum(int v) { v += (int)DPP_(v, 0xB1); v += (int)DPP_(v, 0x4E); v += (int)DPP_(v, 0x141); v += (int)DPP_(v, 0x140); return v + __builtin_amdgcn_ds_swizzle(v, 0x401F); }
__device__ __forceinline__ unsigned next_pivot(unsigned ulo, unsigned uhi, int clo, int chi, int it) {
    unsigned p;
    const bool hl = clo >= 0, hh = chi >= 0;
    if (it == 0) p = fkey(0.0f);
    else if (!hh) { const float f = keyf(ulo); p = fkey(f >= 0.f ? 2.f * f + 0.25f : 0.5f * f + 0.125f); }
    else if (!hl) { const float f = keyf(uhi); p = fkey(f <= 0.f ? 2.f * f - 0.25f : 0.5f * f - 0.125f); }
    else { const float fl = keyf(ulo), fh = keyf(uhi);
        float fr = ((float)(clo - 256) + 0.5f) * __builtin_amdgcn_rcpf((float)(clo - chi)); fr = fminf(fmaxf(fr, 1.f / 32.f), 31.f / 32.f);
        if (it % 3 == 2) fr = 0.5f;
        p = fkey(fl + (fh - fl) * fr); }
    if (!(p > ulo && p < uhi)) p = ulo + ((uhi - ulo) >> 1);
    return p;
}

__device__ __forceinline__ void dsa_unit(const MixArgs& a, unsigned char* ldsb, int b, int blk) {
    const int tid = opaque_tid(), lane = tid & 63, wave = __builtin_amdgcn_readfirstlane(tid >> 6), r32 = lane & 31, hi = lane >> 5;
    const GAS bf16_t* zb = (const GAS bf16_t*)a.Z + (size_t)b * SEQ * ZP;
    LAS unsigned char* wl = (LAS unsigned char*)ldsb + wave * WAVE_LDS;
    LAS unsigned* bm = (LAS unsigned*)wl;
    LAS unsigned char* vimg = wl + 2048;
    const int tw = blk * 64 + 8 * wave;
    f32x16 zero16;
#pragma unroll
    for (int i = 0; i < 16; ++i) zero16[i] = 0.f;
#ifdef PROBE_SEL
#define NRND 4
#else
#define NRND 2
#endif
#pragma unroll 1
    for (int rnd_ = 0; rnd_ < NRND; ++rnd_) { const int rnd = rnd_ & 1;
        const int tb = tw + 4 * rnd;
        const int qsub = 2 * ((r32 >> 2) & 1) + (r32 >> 4), head = (r32 & 3) + 4 * ((r32 >> 3) & 1);
        const GAS bf16_t* iqp = zb + (size_t)(tb + qsub) * ZP + ZB_IQ + head * 32 + 8 * hi;
        bf16x8 aiq0, aiq1;
        { const u32x4 r0 = *(const GAS u32x4*)iqp, r1 = *(const GAS u32x4*)(iqp + 16); const float wr = bf2f(zb[(size_t)(tb + qsub) * ZP + ZB_IW + head]);
          u32x4 s0, s1;
          s0.x = pk2(bflo(r0.x) * wr, bfhi(r0.x) * wr); s0.y = pk2(bflo(r0.y) * wr, bfhi(r0.y) * wr); s0.z = pk2(bflo(r0.z) * wr, bfhi(r0.z) * wr); s0.w = pk2(bflo(r0.w) * wr, bfhi(r0.w) * wr);
          s1.x = pk2(bflo(r1.x) * wr, bfhi(r1.x) * wr); s1.y = pk2(bflo(r1.y) * wr, bfhi(r1.y) * wr); s1.z = pk2(bflo(r1.z) * wr, bfhi(r1.z) * wr); s1.w = pk2(bflo(r1.w) * wr, bfhi(r1.w) * wr);
          aiq0 = __builtin_bit_cast(bf16x8, s0); aiq1 = __builtin_bit_cast(bf16x8, s1); }
        const int tqA = tb + 2 * hi, tqB = tqA + 1;
        float wA[8], wB[8];
        { const u32x4 ua = *(const GAS u32x4*)(zb + (size_t)tqA * ZP + ZB_IW), ub = *(const GAS u32x4*)(zb + (size_t)tqB * ZP + ZB_IW);
          wA[0] = bflo(ua.x); wA[1] = bfhi(ua.x); wA[2] = bflo(ua.y); wA[3] = bfhi(ua.y); wA[4] = bflo(ua.z); wA[5] = bfhi(ua.z); wA[6] = bflo(ua.w); wA[7] = bfhi(ua.w);
          wB[0] = bflo(ub.x); wB[1] = bfhi(ub.x); wB[2] = bflo(ub.y); wB[3] = bfhi(ub.y); wB[4] = bflo(ub.z); wB[5] = bfhi(ub.z); wB[6] = bflo(ub.w); wB[7] = bfhi(ub.w); }
#pragma unroll
        for (int r = 0; r < 8; ++r) { wA[r] = (wA[r] > 0.f) ? INFINITY : -INFINITY; wB[r] = (wB[r] > 0.f) ? INFINITY : -INFINITY; }
        unsigned scA[64], scB[64];
        const int dA = tqA - 32 * ((tb + 3) >> 5);
        const int Tmax = (tb + 3) >> 5;
        int Tm_s = Tmax, Tm_b = Tmax; asm volatile("" : "+s"(Tm_s), "+s"(Tm_b));
        DSTAMP_B(30);
        const int TmaxU = 2 * blk + 1;
        const int fsw = (r32 >> 2) & 3;
        const LAS unsigned char* ikl = (const LAS unsigned char*)ldsb + IKS_OFF + r32 * 64;
        const int off0 = (hi ^ fsw) * 16, off1 = ((2 + hi) ^ fsw) * 16;
#ifdef PROBE_SCORE
        for (int rep_ = 0; rep_ < 2; ++rep_)
#endif
#pragma unroll
        for (int half = 0; half < 2; ++half) {
            if (32 * half <= TmaxU) {
                __syncthreads();
                { const int nkeys = min(32 * (TmaxU + 1) - 1024 * half, 1024);
                  const GAS bf16_t* src = (const GAS bf16_t*)a.IKC + ((size_t)b * SEQ + 1024 * half) * 32;
                  for (int ch = tid; ch < nkeys * 4; ch += 512) { const int key = ch >> 2, c4 = ch & 3;
                      *(LAS u32x4*)((LAS unsigned char*)ldsb + IKS_OFF + key * 64 + ((c4 ^ ((key >> 2) & 3)) * 16)) = *(const GAS u32x4*)(src + key * 32 + c4 * 8); } }
                asm volatile("s_waitcnt vmcnt(0) lgkmcnt(0)" ::: "memory");
                __syncthreads();
                bf16x8 kb0[2], kb1[2];
#pragma unroll
                for (int i = 0; i < 2; ++i) { if (32 * half + i <= Tm_s) { kb0[i] = *(const LAS bf16x8*)(ikl + i * 2048 + off0); kb1[i] = *(const LAS bf16x8*)(ikl + i * 2048 + off1); } }
#pragma unroll
                for (int i = 0; i < 32; ++i) { const int T = 32 * half + i;
                    if (T <= Tm_s) {
                        f32x16 c = MFMA32(aiq0, kb0[i & 1], zero16); c = MFMA32(aiq1, kb1[i & 1], c);
                        if (i + 2 < 32 && T + 2 <= Tm_s) { kb0[i & 1] = *(const LAS bf16x8*)(ikl + (i + 2) * 2048 + off0); kb1[i & 1] = *(const LAS bf16x8*)(ikl + (i + 2) * 2048 + off1); }
                        float sA = 0.f, sB = 0.f;
#pragma unroll
                        for (int r = 0; r < 8; ++r) { sA += __builtin_amdgcn_fmed3f(c[r], 0.f, wA[r]); sB += __builtin_amdgcn_fmed3f(c[8 + r], 0.f, wB[r]); }
                        const bool last = (T == Tm_s);
                        scA[T] = (!last || r32 <= dA) ? fkey(sA + 0.f) : 0u; scB[T] = (!last || r32 <= dA + 1) ? fkey(sB + 0.f) : 0u;
                    } else { scA[T] = 0u; scB[T] = 0u; }
                }
            } else {
#pragma unroll
                for (int i = 0; i < 32; ++i) { scA[32 * half + i] = 0u; scB[32 * half + i] = 0u; }
            }
        }
        DSTAMP_E(30); DSTAMP_B(31);
        const int nA = tqA + 1, nB = tqB + 1;
        unsigned uloA = 1u, uhiA = 0xffffffffu, uloB = 1u, uhiB = 0xffffffffu; int cloA = -1, chiA = -1, cloB = -1, chiB = -1;
        bool doneA = nA <= 256, doneB = nB <= 256;
        unsigned thA = 1u, thB = 1u; int needA = 0, needB = 0;
        int itn = 0, lim = 128;
        constexpr int CAP = 12;
        LAS unsigned* lstA = (LAS unsigned*)((LAS unsigned char*)ldsb + IKS_OFF + wave * 8192) + lane * (CAP + 1), *lstB = lstA + 64 * (CAP + 1);
        unsigned ca_[CAP], cb_[CAP];
        for (;;) {
            DSTAMP_B(34);
            for (; itn < 200; ++itn) {
                if (!doneA && uhiA - uloA <= 1u) { thA = uhiA; needA = 256 - max(chiA, 0); doneA = true; }
                if (!doneB && uhiB - uloB <= 1u) { thB = uhiB; needB = 256 - max(chiB, 0); doneB = true; }
                const bool actA = !doneA && ((cloA < 0 ? nA : cloA) - max(chiA, 0) > lim), actB = !doneB && ((cloB < 0 ? nB : cloB) - max(chiB, 0) > lim);
                if (!__any(actA || actB)) break;
                const unsigned pA = actA ? next_pivot(uloA, uhiA, cloA, chiA, itn) : 0xffffffffu, pB = actB ? next_pivot(uloB, uhiB, cloB, chiB, itn) : 0xffffffffu;
                int ca = 0, cb = 0;
#pragma unroll
                for (int T = 0; T < 64; ++T)
                    asm("v_cmp_ge_u32 vcc, %2, %3\n\tv_addc_co_u32 %0, vcc, 0, %0, vcc\n\tv_cmp_ge_u32 vcc, %4, %5\n\tv_addc_co_u32 %1, vcc, 0, %1, vcc" : "+v"(ca), "+v"(cb) : "v"(scA[T]), "v"(pA), "v"(scB[T]), "v"(pB) : "vcc");
                const int pk = half_sum(ca | (cb << 16));
                ca = pk & 0xffff; cb = pk >> 16;
                if (actA) { if (ca == 256) { thA = pA; needA = 0; doneA = true; } else if (ca > 256) { uloA = pA; cloA = ca; } else { uhiA = pA; chiA = ca; } }
                if (actB) { if (cb == 256) { thB = pB; needB = 0; doneB = true; } else if (cb > 256) { uloB = pB; cloB = cb; } else { uhiB = pB; chiB = cb; } }
            }
            DSTAMP_E(34);
            if (!__any(!doneA || !doneB)) break;
            DSTAMP_B(35);
            const unsigned wA_ = doneA ? 0u : uhiA - uloA, wB_ = doneB ? 0u : uhiB - uloB;
            int nA_ = 0, nB_ = 0;
#pragma unroll
            for (int T = 0; T < 64; ++T) {
                lstA[min(nA_, CAP)] = scA[T]; lstB[min(nB_, CAP)] = scB[T];
                nA_ += ((scA[T] - uloA) < wA_) ? 1 : 0; nB_ += ((scB[T] - uloB) < wB_) ? 1 : 0;
            }
            asm volatile("s_waitcnt lgkmcnt(0)" ::: "memory");
            if (__any(nA_ > CAP || nB_ > CAP) && itn < 200) { lim >>= 1; continue; }
#pragma unroll
            for (int j = 0; j < CAP; ++j) { ca_[j] = (j < nA_) ? lstA[j] : 0u; cb_[j] = (j < nB_) ? lstB[j] : 0u; }
            DSTAMP_E(35);
            break;
        }
        if (__any(!doneA || !doneB)) {
            DSTAMP_B(36);
            const int baseA = max(chiA, 0), baseB = max(chiB, 0);
            for (; itn < 400; ++itn) {
                unsigned mnA = 0xffffffffu, mxA = 0u, mnB = 0xffffffffu, mxB = 0u;
                const unsigned wa = doneA ? 0u : uhiA - uloA, wb = doneB ? 0u : uhiB - uloB;
#pragma unroll
                for (int j = 0; j < CAP; ++j) { if ((ca_[j] - uloA) < wa) { mnA = min(mnA, ca_[j]); mxA = max(mxA, ca_[j]); } if ((cb_[j] - uloB) < wb) { mnB = min(mnB, cb_[j]); mxB = max(mxB, cb_[j]); } }
                mnA = half_min(mnA); mxA = half_max(mxA); mnB = half_min(mnB); mxB = half_max(mxB);
                if (!doneA) { if (mnA >= mxA) { thA = mxA + 1u; needA = 256 - max(chiA, 0); doneA = true; } else { uloA = mnA; uhiA = mxA + 1u; if (cloA < 0) cloA = nA; if (chiA < 0) chiA = 0; } }
                if (!doneB) { if (mnB >= mxB) { thB = mxB + 1u; needB = 256 - max(chiB, 0); doneB = true; } else { uloB = mnB; uhiB = mxB + 1u; if (cloB < 0) cloB = nB; if (chiB < 0) chiB = 0; } }
                if (!__any(!doneA || !doneB)) break;
                const unsigned pA = doneA ? 0xffffffffu : next_pivot(uloA, uhiA, cloA, chiA, itn | 1), pB = doneB ? 0xffffffffu : next_pivot(uloB, uhiB, cloB, chiB, itn | 1);
                int pk = 0;
#pragma unroll
                for (int j = 0; j < CAP; ++j) pk += ((ca_[j] >= pA) ? 1 : 0) + ((cb_[j] >= pB) ? 0x10000 : 0);
                pk = half_sum(pk);
                const int ca = baseA + (pk & 0xffff), cb = baseB + (pk >> 16);
                if (!doneA) { if (ca == 256) { thA = pA; needA = 0; doneA = true; } else if (ca > 256) { uloA = pA; cloA = ca; } else { uhiA = pA; chiA = ca; } }
                if (!doneB) { if (cb == 256) { thB = pB; needB = 0; doneB = true; } else if (cb > 256) { uloB = pB; cloB = cb; } else { uhiB = pB; chiB = cb; } }
            }
            DSTAMP_E(36);
        }
        DSTAMP_E(31); DSTAMP_B(32);
        int rem0 = __builtin_amdgcn_readlane(needA, 0), rem1 = __builtin_amdgcn_readlane(needB, 0), rem2 = __builtin_amdgcn_readlane(needA, 32), rem3 = __builtin_amdgcn_readlane(needB, 32);
        const bool anytie = (rem0 | rem1 | rem2 | rem3) != 0;
        LAS unsigned* bmr = bm + 4 * rnd; asm volatile("" : "+v"(bmr));
#pragma unroll
        for (int T = 0; T < 64; ++T) {
            if (T <= Tm_b) {
                const unsigned long long mA = __ballot(scA[T] >= thA), mB = __ballot(scB[T] >= thB);
                unsigned m0 = (unsigned)mA, m2 = (unsigned)(mA >> 32), m1 = (unsigned)mB, m3 = (unsigned)(mB >> 32);
                if (anytie) {
                    const unsigned long long eA = __ballot(scA[T] == thA - 1u), eB = __ballot(scB[T] == thB - 1u);
                    unsigned e0 = (unsigned)eA, e2 = (unsigned)(eA >> 32), e1 = (unsigned)eB, e3 = (unsigned)(eB >> 32);
                    while (rem0 > 0 && e0) { const unsigned bit = e0 & (0u - e0); m0 |= bit; e0 ^= bit; --rem0; }
                    while (rem1 > 0 && e1) { const unsigned bit = e1 & (0u - e1); m1 |= bit; e1 ^= bit; --rem1; }
                    while (rem2 > 0 && e2) { const unsigned bit = e2 & (0u - e2); m2 |= bit; e2 ^= bit; --rem2; }
                    while (rem3 > 0 && e3) { const unsigned bit = e3 & (0u - e3); m3 |= bit; e3 ^= bit; --rem3; }
                }
                if (lane == 0) { u32x4 w; w.x = m0; w.y = m1; w.z = m2; w.w = m3; *(LAS u32x4*)(bmr + T * 8) = w; }
            }
        }
        DSTAMP_E(32);
    }
    DSTAMP_B(33);
    asm volatile("s_waitcnt lgkmcnt(0)" ::: "memory");
    const int qc = r32 >> 2, hc = r32 & 3;
    const GAS bf16_t* kvb = (const GAS bf16_t*)a.KV + (size_t)b * SEQ * 128;
    const size_t qrow = (size_t)(b * SEQ + tw + qc);
    bf16x8 bq[4];
#pragma unroll
    for (int s = 0; s < 4; ++s) bq[s] = *(const GAS bf16x8*)((const GAS bf16_t*)a.Z + qrow * ZP + ZB_Q + hc * 64 + 16 * s + 8 * hi);
    f32x16 o0 = zero16, o1 = zero16, lacc = zero16; float lsum = 0.f;
    const bf16x8 ones8 = {(short)0x3f80, (short)0x3f80, (short)0x3f80, (short)0x3f80, (short)0x3f80, (short)0x3f80, (short)0x3f80, (short)0x3f80};
    const int Tend = (tw + 7) >> 5;
    const int g16 = lane >> 4, i16 = lane & 15, q4 = i16 >> 2, p4 = i16 & 3;
    const int vrd = ((g16 >> 1) * 4 + q4) * 64 + (16 * (g16 & 1) + 4 * p4) * 2;
    const int vwr_key = lane >> 3, vwr_ch = lane & 7;
    u32x4 vst[4]; bf16x8 ak[4];
    auto load_tile = [&](int T) {
#pragma unroll
        for (int s = 0; s < 4; ++s) ak[s] = *(const GAS bf16x8*)(kvb + (size_t)(32 * T + r32) * 128 + 16 * s + 8 * hi);
#pragma unroll
        for (int i = 0; i < 4; ++i) vst[i] = *(const GAS u32x4*)(kvb + (size_t)(32 * T + vwr_key + 8 * i) * 128 + 64 + 8 * vwr_ch);
    };
#ifdef PROBE_ATT
    for (int rep_ = 0; rep_ < 2; ++rep_) { o0 = zero16; o1 = zero16; lacc = zero16; lsum = 0.f;
#endif
    load_tile(0);
#pragma unroll 1
    for (int T = 0; T <= Tend; ++T) {
#pragma unroll
        for (int i = 0; i < 4; ++i) *(LAS u32x4*)(vimg + (vwr_ch >> 2) * 2048 + (vwr_key + 8 * i) * 64 + (vwr_ch & 3) * 16) = vst[i];
        f32x16 sacc = MFMA32(ak[0], bq[0], zero16); sacc = MFMA32(ak[1], bq[1], sacc); sacc = MFMA32(ak[2], bq[2], sacc); sacc = MFMA32(ak[3], bq[3], sacc);
        const unsigned mw = bm[T * 8 + qc] >> (4 * hi);
        if (T < Tend) load_tile(T + 1);
        asm volatile("s_waitcnt lgkmcnt(0)" ::: "memory");
        s16x4 va[2][2][2];
#pragma unroll
        for (int dt = 0; dt < 2; ++dt)
#pragma unroll
            for (int s = 0; s < 2; ++s) { va[dt][s][0] = vtr(vimg + dt * 2048 + (16 * s) * 64 + vrd); va[dt][s][1] = vtr(vimg + dt * 2048 + (16 * s + 8) * 64 + vrd); }
        unsigned pw[8];
#pragma unroll
        for (int r = 0; r < 16; r += 2) {
            float m0, m1; asm("v_min_f32 %0, 0x42800000, %1" : "=v"(m0) : "v"(sacc[r])); asm("v_min_f32 %0, 0x42800000, %1" : "=v"(m1) : "v"(sacc[r + 1]));
            const unsigned pkw = pk2(__builtin_amdgcn_exp2f(m0), __builtin_amdgcn_exp2f(m1));
            const int c0 = (r & 3) + 8 * (r >> 2), c1 = ((r + 1) & 3) + 8 * ((r + 1) >> 2);
            const unsigned a_ = (unsigned)__builtin_amdgcn_sbfe((int)mw, c0, 1), b_ = (unsigned)__builtin_amdgcn_sbfe((int)mw, c1, 1);
            pw[r >> 1] = pkw & ((a_ & 0xffffu) | (b_ & 0xffff0000u));
        }
        asm volatile("s_waitcnt lgkmcnt(0)" ::: "memory");
#pragma unroll
        for (int s = 0; s < 2; ++s) {
            u32x4 pv4; pv4.x = pw[4 * s]; pv4.y = pw[4 * s + 1]; pv4.z = pw[4 * s + 2]; pv4.w = pw[4 * s + 3];
            const bf16x8 pb = __builtin_bit_cast(bf16x8, pv4);
            const bf16x8 v0 = __builtin_shufflevector(va[0][s][0], va[0][s][1], 0, 1, 2, 3, 4, 5, 6, 7), v1 = __builtin_shufflevector(va[1][s][0], va[1][s][1], 0, 1, 2, 3, 4, 5, 6, 7);
            o0 = MFMA32(v0, pb, o0); o1 = MFMA32(v1, pb, o1); lacc = MFMA32(ones8, pb, lacc);
        }
    }
#ifdef PROBE_ATT
    }
#endif
    DSTAMP_E(33);
    lsum = lacc[0];
    const float rl = 1.0f / lsum;
    const GAS bf16_t* gp = (const GAS bf16_t*)a.Z + qrow * ZP + ZB_G + hc * 64; GAS bf16_t* yp = (GAS bf16_t*)a.Y + qrow * DM + 384 + hc * 64;
#pragma unroll
    for (int dt = 0; dt < 2; ++dt)
#pragma unroll
        for (int i = 0; i < 4; ++i) {
            const int d = 32 * dt + 8 * i + 4 * hi;
            const u32x2 gw = *(const GAS u32x2*)(gp + d);
            const float g0 = bflo(gw.x), g1 = bfhi(gw.x), g2 = bflo(gw.y), g3 = bfhi(gw.y);
            const f32x16& o = dt ? o1 : o0;
            u32x2 w; w.x = pk2(o[4 * i] * rl * g0 * sigmoidf_(g0), o[4 * i + 1] * rl * g1 * sigmoidf_(g1)); w.y = pk2(o[4 * i + 2] * rl * g2 * sigmoidf_(g2), o[4 * i + 3] * rl * g3 * sigmoidf_(g3));
            *(GAS u32x2*)(yp + d) = w;
        }
}
}
namespace dil {
using dsa::vtr; using dsa::s16x4;
__device__ __forceinline__ void dil_unit(const MixArgs& a, float* LQ, unsigned char* ldsb, int b, int gi, int u16) {
    const int tid = opaque_tid(), lane = tid & 63, wave = __builtin_amdgcn_readfirstlane(tid >> 6), r32 = lane & 31, hi = lane >> 5;
    const int rate = (gi == 0) ? 1 : (gi == 1) ? 4 : 16, nblk = 16 / rate, c = u16 / nblk, qb = u16 % nblk;
    const int head = gi * 2 + (wave >> 2), q0 = 128 * qb + 32 * (wave & 3);
    const GAS bf16_t* zb = (const GAS bf16_t*)a.Z + (size_t)b * SEQ * ZP;
    LAS unsigned char* vimg = (LAS unsigned char*)ldsb + wave * 4096;
    f32x16 zero16;
#pragma unroll
    for (int i = 0; i < 16; ++i) zero16[i] = 0.f;
    const size_t qrow = (size_t)b * SEQ + (size_t)(q0 + r32) * rate + c;
    bf16x8 bq[4];
#pragma unroll
    for (int s = 0; s < 4; ++s) bq[s] = *(const GAS bf16x8*)((const GAS bf16_t*)a.Z + qrow * ZP + ZC_Q + head * 64 + 16 * s + 8 * hi);
    f32x16 o0 = zero16, o1 = zero16; float lsum = 0.f;
    const int g16 = lane >> 4, i16 = lane & 15, q4 = i16 >> 2, p4 = i16 & 3;
    const int vrd = ((g16 >> 1) * 4 + q4) * 64 + (16 * (g16 & 1) + 4 * p4) * 2;
    const int vwr_key = lane >> 3, vwr_ch = lane & 7;
#pragma unroll 1
    for (int ti = 0; ti < 5; ++ti) {
        const int j0 = q0 - 128 + 32 * ti;
        if (j0 < 0) continue;
        bf16x8 ak[4]; u32x4 vst[4];
#pragma unroll
        for (int s = 0; s < 4; ++s) ak[s] = *(const GAS bf16x8*)(zb + ((size_t)(j0 + r32) * rate + c) * ZP + ZC_K + head * 64 + 16 * s + 8 * hi);
#pragma unroll
        for (int i = 0; i < 4; ++i) vst[i] = *(const GAS u32x4*)(zb + ((size_t)(j0 + vwr_key + 8 * i) * rate + c) * ZP + ZC_V + head * 64 + 8 * vwr_ch);
#pragma unroll
        for (int i = 0; i < 4; ++i) *(LAS u32x4*)(vimg + (vwr_ch >> 2) * 2048 + (vwr_key + 8 * i) * 64 + (vwr_ch & 3) * 16) = vst[i];
        f32x16 sacc = MFMA32(ak[0], bq[0], zero16); sacc = MFMA32(ak[1], bq[1], sacc); sacc = MFMA32(ak[2], bq[2], sacc); sacc = MFMA32(ak[3], bq[3], sacc);
        asm volatile("s_waitcnt lgkmcnt(0)" ::: "memory");
        s16x4 va[2][2][2];
#pragma unroll
        for (int dt = 0; dt < 2; ++dt)
#pragma unroll
            for (int s = 0; s < 2; ++s) { va[dt][s][0] = vtr(vimg + dt * 2048 + (16 * s) * 64 + vrd); va[dt][s][1] = vtr(vimg + dt * 2048 + (16 * s + 8) * 64 + vrd); }
        const int dbase = q0 + r32 - j0 - 4 * hi;
        unsigned pw[8];
#pragma unroll
        for (int r = 0; r < 16; r += 2) {
            const int d0 = dbase - ((r & 3) + 8 * (r >> 2)), d1 = dbase - (((r + 1) & 3) + 8 * ((r + 1) >> 2));
            float p0 = __builtin_amdgcn_exp2f(fminf(sacc[r], 64.f)), p1 = __builtin_amdgcn_exp2f(fminf(sacc[r + 1], 64.f));
            p0 = ((unsigned)d0 <= 128u) ? p0 : 0.f; p1 = ((unsigned)d1 <= 128u) ? p1 : 0.f;
            lsum += p0 + p1;
            pw[r >> 1] = pk2(p0, p1);
        }
        asm volatile("s_waitcnt lgkmcnt(0)" ::: "memory");
#pragma unroll
        for (int s = 0; s < 2; ++s) {
            u32x4 pv4; pv4.x = pw[4 * s]; pv4.y = pw[4 * s + 1]; pv4.z = pw[4 * s + 2]; pv4.w = pw[4 * s + 3];
            const bf16x8 pb = __builtin_bit_cast(bf16x8, pv4);
            const bf16x8 v0 = __builtin_shufflevector(va[0][s][0], va[0][s][1], 0, 1, 2, 3, 4, 5, 6, 7), v1 = __builtin_shufflevector(va[1][s][0], va[1][s][1], 0, 1, 2, 3, 4, 5, 6, 7);
            o0 = MFMA32(v0, pb, o0); o1 = MFMA32(v1, pb, o1);
        }
    }
    lsum += __shfl_xor(lsum, 32);
    if (hi == 0) LQ[qrow * 8 + head] = lsum;
    GAS bf16_t* yp = (GAS bf16_t*)a.Y + qrow * DM + 640 + head * 64;
#pragma unroll
    for (int dt = 0; dt < 2; ++dt)
#pragma unroll
        for (int i = 0; i < 4; ++i) {
            const int d = 32 * dt + 8 * i + 4 * hi; const f32x16& o = dt ? o1 : o0;
            u32x2 w; w.x = pk2(o[4 * i], o[4 * i + 1]); w.y = pk2(o[4 * i + 2], o[4 * i + 3]);
            *(GAS u32x2*)(yp + d) = w;
        }
}
__device__ __forceinline__ void dil_merge(const MixArgs& a, const float* LQ, int first, int nthreads) {
    constexpr int NCH = MTOK * 48;
    for (int id0 = first; id0 < NCH; id0 += 4 * nthreads) {
        u32x4 ow[4], gw[4]; float rl[4];
#pragma unroll
        for (int j = 0; j < 4; ++j) { const int id = id0 + j * nthreads; if (id < NCH) { const int row = id / 48, ch = id % 48;
            ow[j] = *(const GAS u32x4*)((const GAS bf16_t*)a.Y + (size_t)row * DM + 640 + ch * 8); gw[j] = *(const GAS u32x4*)((const GAS bf16_t*)a.Z + (size_t)row * ZP + ZC_G + ch * 8);
            const float* lq = LQ + (size_t)row * 8 + ((ch >> 3) & 1); rl[j] = lq[0] + lq[2] + lq[4]; } }
#pragma unroll
        for (int j = 0; j < 4; ++j) { const int id = id0 + j * nthreads; if (id < NCH) { const int row = id / 48, ch = id % 48; const float r = __builtin_amdgcn_rcpf(rl[j]);
            const unsigned o4[4] = {ow[j].x, ow[j].y, ow[j].z, ow[j].w}, g4[4] = {gw[j].x, gw[j].y, gw[j].z, gw[j].w}; unsigned w4[4];
#pragma unroll
            for (int k = 0; k < 4; ++k) { const float g0 = bflo(g4[k]), g1 = bfhi(g4[k]); w4[k] = pk2(bflo(o4[k]) * r * g0 * sigmoidf_(g0), bfhi(o4[k]) * r * g1 * sigmoidf_(g1)); }
            u32x4 w; w.x = w4[0]; w.y = w4[1]; w.z = w4[2]; w.w = w4[3]; *(GAS u32x4*)((GAS bf16_t*)a.Y + (size_t)row * DM + 640 + ch * 8) = w; } }
    }
}
}
namespace rwkv {
#ifdef PROBE_T
#define RTS ((volatile LAS unsigned long long*)((LAS unsigned char*)ldsb + 131072 + 1024))
#define RST(id_end, id_begin) do { if (blockIdx.x == 0 && threadIdx.x == 0) { const unsigned long long now_ = __builtin_amdgcn_s_memrealtime(); if ((id_end) == PROBE_T) RTS[1] += now_ - RTS[0]; if ((id_begin) == PROBE_T) RTS[0] = now_; } } while (0)
#else
#define RST(a, b) do {} while (0)
#endif
using dsa::vtr; using dsa::s16x4;
constexpr int IP = 144;
constexpr int IMG = 64 * IP;
constexpr int S_WD = 0 * IMG, S_AD = 1 * IMG, S_V = 2 * IMG, S_AT = 3 * IMG, S_BH = 4 * IMG, S_KH = 5 * IMG, S_RT = 6 * IMG, S_KB = 7 * IMG, S_BB = 8 * IMG, S_ARB = 9 * IMG, S_AH = 10 * IMG, S_UV = 11 * IMG;
constexpr int S_AAK = S_WD, S_ARK = S_AD, S_TT = S_BH, S_W1 = S_KH;
constexpr int F_AAB = 12 * IMG;
constexpr int F_LG = S_ARB;
constexpr int F_TOT = F_AAB + 16384;
static_assert(F_TOT + 512 <= 131072 && F_LG + 16384 <= F_AAB, "rwkv LDS map");

struct RArgs { const float* mu; const float* w0; const float* a0; const float* k_k; const float* k_a; const float* r_k; const float* ln_g; const float* ln_b;
               const bf16_t* wupT; const bf16_t* aupT; bf16_t* RQ; bf16_t* RM; bf16_t* RN; float* RG; float* RB; };

__device__ __forceinline__ bf16x8 rowfrag(const LAS unsigned char* img, int r0, int k0, int r32, int hi) { return *(const LAS bf16x8*)(img + (r0 + r32) * IP + (k0 + 8 * hi) * 2); }
__device__ __forceinline__ bf16x8 colfrag(const LAS unsigned char* img, int c0, int k0, int lane) {
    const int g16 = lane >> 4, i16 = lane & 15;
    const LAS unsigned char* p = img + (k0 + 8 * (g16 >> 1) + (i16 >> 2)) * IP + (c0 + 16 * (g16 & 1) + 4 * (i16 & 3)) * 2;
    const s16x4 lo = vtr(p), hi4 = vtr(p + 4 * IP);
    return __builtin_shufflevector(lo, hi4, 0, 1, 2, 3, 4, 5, 6, 7);
}
__device__ __forceinline__ bf16x8 colfrag_perm(const LAS unsigned char* img, int c0, int k0, int lane) {
    const int g16 = lane >> 4, i16 = lane & 15;
    const LAS unsigned char* p = img + (k0 + 4 * (g16 >> 1) + (i16 >> 2)) * IP + (c0 + 16 * (g16 & 1) + 4 * (i16 & 3)) * 2;
    const s16x4 lo = vtr(p), hi4 = vtr(p + 8 * IP);
    return __builtin_shufflevector(lo, hi4, 0, 1, 2, 3, 4, 5, 6, 7);
}
__device__ __forceinline__ bf16x8 rowfrag_f32(const LAS float* img, int r0, int k0, int r32, int hi) {
    const LAS f32x4* p = (const LAS f32x4*)(img + (r0 + r32) * 64 + k0 + 8 * hi); const f32x4 a = p[0], b = p[1];
    u32x4 w; w.x = pk2(a[0], a[1]); w.y = pk2(a[2], a[3]); w.z = pk2(b[0], b[1]); w.w = pk2(b[2], b[3]); return __builtin_bit_cast(bf16x8, w);
}
__device__ __forceinline__ void store_T(LAS unsigned char* imgT, const f32x16& c, int r0, int c0, int r32, int hi) {
#pragma unroll
    for (int g = 0; g < 4; ++g) { u32x2 w; w.x = pk2(c[4 * g], c[4 * g + 1]); w.y = pk2(c[4 * g + 2], c[4 * g + 3]); *(LAS u32x2*)(imgT + (c0 + r32) * IP + (r0 + 8 * g + 4 * hi) * 2) = w; }
}
__device__ __forceinline__ void store_T_global(GAS bf16_t* gT  , const f32x16& c, int r0, int c0, int r32, int hi) {
#pragma unroll
    for (int g = 0; g < 4; ++g) { u32x2 w; w.x = pk2(c[4 * g], c[4 * g + 1]); w.y = pk2(c[4 * g + 2], c[4 * g + 3]); *(GAS u32x2*)(gT + (c0 + r32) * 64 + r0 + 8 * g + 4 * hi) = w; }
}
__device__ __forceinline__ void store_T_global_wt(GAS bf16_t* gT, const f32x16& c, int r0, int c0, int r32, int hi) {
#pragma unroll
    for (int g = 0; g < 4; ++g) { const unsigned long long w = (unsigned long long)pk2(c[4 * g], c[4 * g + 1]) | ((unsigned long long)pk2(c[4 * g + 2], c[4 * g + 3]) << 32);
        __hip_atomic_store((GAS unsigned long long*)(gT + (c0 + r32) * 64 + r0 + 8 * g + 4 * hi), w, __ATOMIC_RELAXED, __HIP_MEMORY_SCOPE_AGENT); }
}
__device__ __forceinline__ f32x16 zero16() { f32x16 z;
#pragma unroll
    for (int i = 0; i < 16; ++i) z[i] = 0.f;
    return z; }
#define WSYNC() asm volatile("s_waitcnt lgkmcnt(0)" ::: "memory")
#define BAR() do { asm volatile("s_waitcnt lgkmcnt(0)" ::: "memory"); __builtin_amdgcn_s_barrier(); asm volatile("" ::: "memory"); } while (0)

constexpr int R1_STG = S_AT;
constexpr int R1_SAVE = 131072 + 2048, R1_PAR = R1_SAVE + 1024, R1_WUP = R1_PAR + 2560, R1_AUP = R1_WUP + IMG;
struct R1Raw { u32x4 c[5]; };
__device__ __forceinline__ void r1_load(const MixArgs& a, R1Raw& raw, int tid, int b, int h, int ck) {
    const int et = tid >> 3, ec = (tid & 7) * 8, hc = h * 64 + ec;
    const GAS bf16_t* zr = (const GAS bf16_t*)a.Z + ((size_t)b * SEQ + ck * 64 + et) * ZP;
    const int cols[5] = {ZA_R + hc, ZA_K + hc, ZA_V + hc, ZA_WD + ec, ZA_AD + ec};
#pragma unroll
    for (int i = 0; i < 5; ++i) raw.c[i] = *(const GAS u32x4*)(zr + cols[i]);
}
__device__ __forceinline__ void r1_load_params(const RArgs& ra, unsigned char* ldsb, int tid, int h) {
    LAS float* par = (LAS float*)((LAS unsigned char*)ldsb + R1_PAR);
    for (int i = tid; i < 640; i += 512) { const int g = i >> 6, c = i & 63; float v;
        if (g == 0) v = ra.mu[ZA_R + h * 64 + c]; else if (g == 1) v = ra.mu[ZA_K + h * 64 + c]; else if (g == 2) v = ra.mu[ZA_V + h * 64 + c]; else if (g == 3) v = ra.mu[ZA_WD + c]; else if (g == 4) v = ra.mu[ZA_AD + c];
        else if (g == 5) v = ra.w0[h * 64 + c]; else if (g == 6) v = ra.a0[h * 64 + c]; else if (g == 7) v = ra.k_k[h * 64 + c]; else if (g == 8) v = ra.k_a[h * 64 + c]; else v = ra.r_k[h * 64 + c];
        par[i] = v; }
    for (int ch = tid; ch < 1024; ch += 512) { const int m = ch >> 9, row = (ch >> 3) & 63, c8 = ch & 7;
        *(LAS u32x4*)((LAS unsigned char*)ldsb + (m ? R1_AUP : R1_WUP) + row * IP + c8 * 16) = *(const GAS u32x4*)((const GAS bf16_t*)(m ? ra.aupT : ra.wupT) + (size_t)(h * 64 + row) * 64 + c8 * 8); }
}
static_assert(65 * 640 <= 5 * IMG, "staging fits");
__device__ __forceinline__ void rwkv_chunk_unit(const MixArgs& a, const RArgs& ra, unsigned char* ldsb, int b, int h, int ck, R1Raw& raw, int prev_mode, bool has_next, int nb, int nh, int nck) {
    const int tid = opaque_tid(), lane = tid & 63, wave = __builtin_amdgcn_readfirstlane(tid >> 6), r32 = lane & 31, hi = lane >> 5;
    LAS unsigned char* L = (LAS unsigned char*)ldsb;
    LAS float* fETA = (LAS float*)(L + F_AAB); LAS float* fAAB = fETA; LAS float* fLG = (LAS float*)(L + F_LG); LAS float* fTOT = (LAS float*)(L + F_TOT);
    const int t0 = ck * 64;
    const size_t row0 = (size_t)b * SEQ + t0;
    const int unit = (b * 6 + h) * 32 + ck;
    RST(-1, 50);
    const int et = tid >> 3, ec = (tid & 7) * 8, hc = h * 64 + ec;
    const LAS float* par = (const LAS float*)(L + R1_PAR);
    float r8[8], k8[8];
    {
        {
            LAS unsigned char* stg = L + R1_STG;
#pragma unroll
            for (int i = 0; i < 5; ++i) *(LAS u32x4*)(stg + (et + 1) * 640 + i * 128 + (tid & 7) * 16) = raw.c[i];
            if (et == 0) {
                const int hc0 = h * 64 + ec; const int cols[5] = {ZA_R + hc0, ZA_K + hc0, ZA_V + hc0, ZA_WD + ec, ZA_AD + ec};
#pragma unroll
                for (int i = 0; i < 5; ++i) { u32x4 pv = zero_u32x4();
                    if (prev_mode == 1) pv = *(const LAS u32x4*)(L + R1_SAVE + i * 128 + (tid & 7) * 16);
                    else if (prev_mode == 2) pv = *(const GAS u32x4*)((const GAS bf16_t*)a.Z + (row0 - 1) * ZP + cols[i]);
                    *(LAS u32x4*)(stg + i * 128 + (tid & 7) * 16) = pv; }
            }
        }
        BAR();
        if (et == 63) {
#pragma unroll
            for (int i = 0; i < 5; ++i) *(LAS u32x4*)(L + R1_SAVE + i * 128 + (tid & 7) * 16) = raw.c[i];
        }
        auto mix8 = [&](int i, int col, float* out) {
            const u32x4 cw = raw.c[i], pw = *(const LAS u32x4*)(L + R1_STG + et * 640 + i * 128 + (tid & 7) * 16);
            const f32x4 m0 = *(const LAS f32x4*)(par + i * 64 + ec), m1 = *(const LAS f32x4*)(par + i * 64 + ec + 4); (void)col;
            const float cv[8] = {bflo(cw.x), bfhi(cw.x), bflo(cw.y), bfhi(cw.y), bflo(cw.z), bfhi(cw.z), bflo(cw.w), bfhi(cw.w)};
            const float pv[8] = {bflo(pw.x), bfhi(pw.x), bflo(pw.y), bfhi(pw.y), bflo(pw.z), bfhi(pw.z), bflo(pw.w), bfhi(pw.w)};
            const float mv[8] = {m0[0], m0[1], m0[2], m0[3], m1[0], m1[1], m1[2], m1[3]};
#pragma unroll
            for (int j = 0; j < 8; ++j) out[j] = cv[j] + (pv[j] - cv[j]) * mv[j];
        };
        float v8[8], wd8[8], ad8[8];
        mix8(0, ZA_R + hc, r8); mix8(1, ZA_K + hc, k8); mix8(2, ZA_V + hc, v8); mix8(3, ZA_WD + ec, wd8); mix8(4, ZA_AD + ec, ad8);
#pragma unroll
        for (int i = 0; i < 8; ++i) wd8[i] = tanhf_(wd8[i]);
        u32x4 w;
        w.x = pk2(wd8[0], wd8[1]); w.y = pk2(wd8[2], wd8[3]); w.z = pk2(wd8[4], wd8[5]); w.w = pk2(wd8[6], wd8[7]); *(LAS u32x4*)(L + S_WD + et * IP + ec * 2) = w;
        w.x = pk2(ad8[0], ad8[1]); w.y = pk2(ad8[2], ad8[3]); w.z = pk2(ad8[4], ad8[5]); w.w = pk2(ad8[6], ad8[7]); *(LAS u32x4*)(L + S_AD + et * IP + ec * 2) = w;
        w.x = pk2(v8[0], v8[1]); w.y = pk2(v8[2], v8[3]); w.z = pk2(v8[4], v8[5]); w.w = pk2(v8[6], v8[7]); *(LAS u32x4*)(L + S_V + et * IP + ec * 2) = w;
    }
    BAR();
    RST(50, 51);
    const int q = wave & 3, tr = q >> 1, tc = q & 1, grp = wave >> 2;
    {
        const LAS unsigned char* Aimg = L + (grp ? S_AD : S_WD);
        f32x16 acc = zero16();
#pragma unroll
        for (int s = 0; s < 4; ++s) acc = MFMA32(rowfrag(Aimg, 32 * tr, 16 * s, r32, hi), rowfrag(L + (grp ? R1_AUP : R1_WUP), 32 * tc, 16 * s, r32, hi), acc);
        const int c = 32 * tc + r32; const float bias = par[(grp ? 6 : 5) * 64 + c];
        if (grp == 0) {
            float x[16], gs[4];
#pragma unroll
            for (int i = 0; i < 16; ++i) x[i] = -DECAY_SCALE * sigmoidf_(acc[i] + bias);
#pragma unroll
            for (int g = 0; g < 4; ++g) gs[g] = (x[4 * g] + x[4 * g + 1]) + (x[4 * g + 2] + x[4 * g + 3]);
            float run = 0.f;
#pragma unroll
            for (int g = 0; g < 4; ++g) { const float other = __shfl_xor(gs[g], 32); float base = run + (hi ? other : 0.f); run += gs[g] + other;
#pragma unroll
                for (int j = 0; j < 4; ++j) { base += x[4 * g + j]; fLG[(32 * tr + 8 * g + 4 * hi + j) * 64 + c] = base; } }
            if (tr == 0 && hi == 0) fTOT[c] = run;
        } else {
#pragma unroll
            for (int i = 0; i < 16; ++i) fETA[(32 * tr + (i & 3) + 8 * (i >> 2) + 4 * hi) * 64 + c] = sigmoidf_(acc[i] + bias);
        }
    }
    BAR();
    RST(51, 52);
    {
        const f32x4 l0 = *(const LAS f32x4*)(fLG + et * 64 + ec), l1 = *(const LAS f32x4*)(fLG + et * 64 + ec + 4);
        f32x4 p0 = {0.f, 0.f, 0.f, 0.f}, p1 = p0; if (et > 0) { p0 = *(const LAS f32x4*)(fLG + (et - 1) * 64 + ec); p1 = *(const LAS f32x4*)(fLG + (et - 1) * 64 + ec + 4); }
        const f32x4 e0 = *(const LAS f32x4*)(fETA + et * 64 + ec), e1 = *(const LAS f32x4*)(fETA + et * 64 + ec + 4);
        const f32x4 z0 = *(const LAS f32x4*)(fLG + 63 * 64 + ec), z1 = *(const LAS f32x4*)(fLG + 63 * 64 + ec + 4);
        const f32x4 u0 = *(const LAS f32x4*)(fTOT + ec), u1 = *(const LAS f32x4*)(fTOT + ec + 4);
        float lg[8] = {l0[0], l0[1], l0[2], l0[3], l1[0], l1[1], l1[2], l1[3]}, lp[8] = {p0[0], p0[1], p0[2], p0[3], p1[0], p1[1], p1[2], p1[3]};
        const float eta[8] = {e0[0], e0[1], e0[2], e0[3], e1[0], e1[1], e1[2], e1[3]}, tot[8] = {u0[0], u0[1], u0[2], u0[3], u1[0], u1[1], u1[2], u1[3]};
        float lC[8] = {z0[0], z0[1], z0[2], z0[3], z1[0], z1[1], z1[2], z1[3]};
        float kk[8], kp[8], ss = 0.f, bsum = 0.f;
#pragma unroll
        for (int i = 0; i < 8; ++i) {
            if (et >= 32) lg[i] += tot[i]; if (et >= 33) lp[i] += tot[i]; lC[i] += tot[i];
            kk[i] = k8[i] * par[7 * 64 + ec + i]; ss += kk[i] * kk[i];
            kp[i] = k8[i] * (1.f + (eta[i] - 1.f) * par[8 * 64 + ec + i]); bsum += r8[i] * kp[i] * par[9 * 64 + ec + i];
        }
        ss += __shfl_xor(ss, 1); ss += __shfl_xor(ss, 2); ss += __shfl_xor(ss, 4);
        bsum += __shfl_xor(bsum, 1); bsum += __shfl_xor(bsum, 2); bsum += __shfl_xor(bsum, 4);
        const float rn = __builtin_amdgcn_rsqf(fmaxf(ss, 1e-24f));
        if ((tid & 7) == 0) ra.RB[(row0 + et) * 8 + h] = bsum;
        if (et == 63) { f32x4 g0 = {fexp_(lC[0]), fexp_(lC[1]), fexp_(lC[2]), fexp_(lC[3])}, g1 = {fexp_(lC[4]), fexp_(lC[5]), fexp_(lC[6]), fexp_(lC[7])};
            *(f32x4*)(ra.RG + (size_t)unit * 64 + ec) = g0; *(f32x4*)(ra.RG + (size_t)unit * 64 + ec + 4) = g1; }
#pragma unroll
        for (int i = 0; i < 8; i += 2) {
            float vat[2], vbh[2], vkh[2], vrt[2], vkb[2], vbb[2];
#pragma unroll
            for (int j = 0; j < 2; ++j) { const int c = i + j;
                const float kn = kk[c] * rn, bv = kn * eta[c];
                const float ig = fexp_(-lg[c]), gC = fexp_(lC[c] - lg[c]);
                vat[j] = -kn * fexp_(lp[c]); vbh[j] = bv * ig; vkh[j] = kp[c] * ig; vrt[j] = r8[c] * fexp_(lg[c]); vkb[j] = kp[c] * gC; vbb[j] = bv * gC; }
            const int off = et * IP + (ec + i) * 2;
            *(LAS unsigned*)(L + S_AT + off) = pk2(vat[0], vat[1]); *(LAS unsigned*)(L + S_BH + off) = pk2(vbh[0], vbh[1]); *(LAS unsigned*)(L + S_KH + off) = pk2(vkh[0], vkh[1]);
            *(LAS unsigned*)(L + S_RT + off) = pk2(vrt[0], vrt[1]); *(LAS unsigned*)(L + S_KB + off) = pk2(vkb[0], vkb[1]); *(LAS unsigned*)(L + S_BB + off) = pk2(vbb[0], vbb[1]);
        }
    }
    BAR();
    RST(52, 53);
    if (has_next) r1_load(a, raw, tid, nb, nh, nck);
    {
        const LAS unsigned char* Aimg = L + (grp ? S_RT : S_AT);
        f32x16 c1 = zero16(), c2 = zero16();
        if (!(tr == 0 && tc == 1)) {
#pragma unroll
            for (int s = 0; s < 4; ++s) { const bf16x8 af = rowfrag(Aimg, 32 * tr, 16 * s, r32, hi);
                c1 = MFMA32(af, rowfrag(L + S_BH, 32 * tc, 16 * s, r32, hi), c1); c2 = MFMA32(af, rowfrag(L + S_KH, 32 * tc, 16 * s, r32, hi), c2); }
        }
        const int ci = 32 * tc + r32;
#pragma unroll
        for (int i = 0; i < 16; ++i) { const int t = 32 * tr + (i & 3) + 8 * (i >> 2) + 4 * hi; const bool keep = grp ? (ci <= t) : (ci < t); if (!keep) { c1[i] = 0.f; c2[i] = 0.f; } }
        if (grp == 0) {
#pragma unroll
            for (int i = 0; i < 16; ++i) fAAB[(32 * tr + (i & 3) + 8 * (i >> 2) + 4 * hi) * 64 + ci] = c1[i];
            store_T(L + S_AAK, c2, 32 * tr, 32 * tc, r32, hi);
        } else { store_T(L + S_ARB, c1, 32 * tr, 32 * tc, r32, hi); store_T(L + S_ARK, c2, 32 * tr, 32 * tc, r32, hi); }
    }
    BAR();
    RST(53, 54);
    f32x16 nacc = zero16(), yacc = zero16();
    if (grp == 0) {
        const int bk = wave;
        float d[16];
        if (lane < 16) {
#pragma unroll
            for (int t = 0; t < 16; ++t) { float s = (t == lane) ? 1.f : 0.f;
#pragma unroll
                for (int i = 0; i < 16; ++i) if (i < t) s += fAAB[(16 * bk + t) * 64 + 16 * bk + i] * d[i];
                d[t] = s; }
        }
        if (lane < 16) {
            LAS unsigned char* rowp = L + S_TT + (16 * bk + lane) * IP;
#pragma unroll
            for (int cb = 0; cb < 4; ++cb) { u32x4 w0, w1;
                if (cb == bk) { w0.x = pk2(d[0], d[1]); w0.y = pk2(d[2], d[3]); w0.z = pk2(d[4], d[5]); w0.w = pk2(d[6], d[7]); w1.x = pk2(d[8], d[9]); w1.y = pk2(d[10], d[11]); w1.z = pk2(d[12], d[13]); w1.w = pk2(d[14], d[15]); }
                else { w0 = zero_u32x4(); w1 = w0; }
                *(LAS u32x4*)(rowp + cb * 32) = w0; *(LAS u32x4*)(rowp + cb * 32 + 16) = w1; }
        }
    } else {
        f32x16 c = zero16();
#pragma unroll
        for (int s = 0; s < 4; ++s) c = MFMA32(colfrag(L + S_AAK, 32 * tr, 16 * s, lane), colfrag(L + S_V, 32 * tc, 16 * s, lane), c);
        store_T(L + S_W1, c, 32 * tr, 32 * tc, r32, hi);
    }
    BAR();
    if (grp == 0) {
        if (wave < 2) { const int p = 2 * wave;
            f32x16 x = MFMA32(rowfrag_f32(fAAB, 16 * (p + 1), 16 * p, r32, hi), rowfrag(L + S_TT, 16 * p, 16 * p, r32, hi), zero16());
            u32x4 xw; xw.x = pk2(x[0], x[1]); xw.y = pk2(x[2], x[3]); xw.z = pk2(x[4], x[5]); xw.w = pk2(x[6], x[7]);
            const f32x16 tb = MFMA32(colfrag_perm(L + S_TT, 16 * (p + 1), 16 * (p + 1), lane), __builtin_bit_cast(bf16x8, xw), zero16());
            if (r32 < 16) {
#pragma unroll
                for (int g = 0; g < 2; ++g) { u32x2 w; w.x = pk2(tb[4 * g], tb[4 * g + 1]); w.y = pk2(tb[4 * g + 2], tb[4 * g + 3]); *(LAS u32x2*)(L + S_TT + (16 * p + r32) * IP + (16 * (p + 1) + 8 * g + 4 * hi) * 2) = w; } }
        }
    } else {
#pragma unroll
        for (int s = 0; s < 4; ++s) { const bf16x8 vf = colfrag(L + S_V, 32 * tr, 16 * s, lane);
            nacc = MFMA32(colfrag(L + S_KB, 32 * tr, 16 * s, lane), colfrag(L + S_V, 32 * tc, 16 * s, lane), nacc);
            yacc = MFMA32(vf, colfrag(L + S_ARK, 32 * tc, 16 * s, lane), yacc); }
    }
    BAR();
    if (wave == 0) {
        f32x16 x = zero16();
#pragma unroll
        for (int s = 0; s < 2; ++s) x = MFMA32(rowfrag_f32(fAAB, 32, 16 * s, r32, hi), rowfrag(L + S_TT, 0, 16 * s, r32, hi), x);
        f32x16 tb = zero16();
#pragma unroll
        for (int s = 0; s < 2; ++s) { u32x4 xw; xw.x = pk2(x[8 * s], x[8 * s + 1]); xw.y = pk2(x[8 * s + 2], x[8 * s + 3]); xw.z = pk2(x[8 * s + 4], x[8 * s + 5]); xw.w = pk2(x[8 * s + 6], x[8 * s + 7]);
            tb = MFMA32(colfrag_perm(L + S_TT, 32, 32 + 16 * s, lane), __builtin_bit_cast(bf16x8, xw), tb); }
        store_T(L + S_TT, tb, 32, 0, r32, hi);
    }
    BAR();
    RST(54, 55);
    {
        f32x16 c = zero16();
#pragma unroll
        for (int s = 0; s < 4; ++s) { const bf16x8 tf = colfrag(L + S_TT, 32 * tr, 16 * s, lane);
            c = MFMA32(tf, grp ? rowfrag(L + S_W1, 32 * tc, 16 * s, r32, hi) : colfrag(L + S_AT, 32 * tc, 16 * s, lane), c); }
        store_T(L + (grp ? S_UV : S_AH), c, 32 * tr, 32 * tc, r32, hi);
    }
    BAR();
    RST(55, 56);
    {
        const LAS unsigned char* Aimg = L + (grp ? S_UV : S_AH);
        f32x16 c1 = grp ? nacc : zero16(), c2 = grp ? yacc : zero16();
#pragma unroll
        for (int s = 0; s < 4; ++s) { const bf16x8 af = rowfrag(Aimg, 32 * tr, 16 * s, r32, hi);
            if (grp) c1 = MFMA32(colfrag(L + S_BB, 32 * tr, 16 * s, lane), rowfrag(L + S_UV, 32 * tc, 16 * s, r32, hi), c1);
            else c1 = MFMA32(af, colfrag(L + S_BB, 32 * tc, 16 * s, lane), c1);
            c2 = MFMA32(af, colfrag(L + S_ARB, 32 * tc, 16 * s, lane), c2); }
        GAS bf16_t* gq = (GAS bf16_t*)ra.RQ + (size_t)unit * 4096; GAS bf16_t* gm = (GAS bf16_t*)ra.RM + (size_t)unit * 4096; GAS bf16_t* gn = (GAS bf16_t*)ra.RN + (size_t)unit * 4096;
        if (grp == 0) {
            store_T_global(gm, c1, 32 * tr, 32 * tc, r32, hi);
#pragma unroll
            for (int g = 0; g < 4; ++g) { const u32x2 w = *(const LAS u32x2*)(L + S_RT + (32 * tc + r32) * IP + (32 * tr + 8 * g + 4 * hi) * 2);
                c2[4 * g] += bflo(w.x); c2[4 * g + 1] += bfhi(w.x); c2[4 * g + 2] += bflo(w.y); c2[4 * g + 3] += bfhi(w.y); }
            store_T_global(gq, c2, 32 * tr, 32 * tc, r32, hi);
        } else {
            store_T_global(gn, c1, 32 * tr, 32 * tc, r32, hi);
            GAS bf16_t* yp = (GAS bf16_t*)a.Y + (row0 + 32 * tc + r32) * DM + h * 64 + 32 * tr;
#pragma unroll
            for (int g = 0; g < 4; ++g) { u32x2 w; w.x = pk2(c2[4 * g], c2[4 * g + 1]); w.y = pk2(c2[4 * g + 2], c2[4 * g + 3]); *(GAS u32x2*)(yp + 8 * g + 4 * hi) = w; }
        }
    }
    BAR();
    RST(56, -1);
}

constexpr int R2_D = 6, R2_SLOT = 16640, R2_RING = 2 * IMG;
__device__ __forceinline__ void rwkv_scan_chain(const RArgs& ra, unsigned char* ldsb, int b, int h, unsigned* flag  ) {
    const int tid = opaque_tid(), lane = tid & 63, wave = __builtin_amdgcn_readfirstlane(tid >> 6), r32 = lane & 31, hi = lane >> 5;
    LAS unsigned char* L = (LAS unsigned char*)ldsb;
    const int q = wave & 3, tr = q >> 1, tc = q & 1;
    f32x16 st = zero16();
    for (int i = tid; i < 2 * IMG / 16; i += 512) { *(LAS u32x4*)(L + i * 16) = zero_u32x4(); }
    const int ubase = (b * 6 + h) * 32;
    auto issue = [&](int step) {
        const int unit = ubase + step; LAS unsigned char* slot = L + R2_RING + (step % R2_D) * R2_SLOT; const int lw = wave - 4;
        const GAS unsigned char* gm = (const GAS unsigned char*)ra.RM + (size_t)unit * 8192 + lane * 16; const GAS unsigned char* gn = (const GAS unsigned char*)ra.RN + (size_t)unit * 8192 + lane * 16;
#pragma unroll
        for (int p = 0; p < 2; ++p) {
            __builtin_amdgcn_global_load_lds((const GAS unsigned*)(gm + (2 * lw + p) * 1024), (LAS unsigned*)(slot + (2 * lw + p) * 1024), 16, 0, 0);
            __builtin_amdgcn_global_load_lds((const GAS unsigned*)(gn + (2 * lw + p) * 1024), (LAS unsigned*)(slot + 8192 + (2 * lw + p) * 1024), 16, 0, 0);
        }
        if (lw == 0) __builtin_amdgcn_global_load_lds((const GAS unsigned*)((const GAS unsigned char*)ra.RG + (size_t)unit * 256 + lane * 4), (LAS unsigned*)(slot + 16384), 4, 0, 0);
    };
    if (wave >= 4) {
#pragma unroll 1
        for (int s0 = 0; s0 < R2_D - 1; ++s0) issue(s0);
        asm volatile("s_waitcnt vmcnt(0)" ::: "memory");
    }
    asm volatile("s_waitcnt lgkmcnt(0)" ::: "memory"); __builtin_amdgcn_s_barrier();
#pragma unroll 1
    for (int ck = 0; ck < 32; ++ck) {
        const LAS unsigned char* Simg = L + (ck & 1) * IMG; LAS unsigned char* Snew = L + ((ck + 1) & 1) * IMG;
        if (wave < 4) {
            const int unit = ubase + ck; const LAS unsigned char* slot = L + R2_RING + (ck % R2_D) * R2_SLOT;
            f32x16 acc;
#pragma unroll
            for (int g = 0; g < 4; ++g) { const u32x2 nw = *(const LAS u32x2*)(slot + 8192 + (32 * tc + r32) * 128 + (32 * tr + 8 * g + 4 * hi) * 2); const f32x4 gc = *(const LAS f32x4*)(slot + 16384 + (32 * tr + 8 * g + 4 * hi) * 4);
                acc[4 * g] = st[4 * g] * gc[0] + bflo(nw.x); acc[4 * g + 1] = st[4 * g + 1] * gc[1] + bfhi(nw.x); acc[4 * g + 2] = st[4 * g + 2] * gc[2] + bflo(nw.y); acc[4 * g + 3] = st[4 * g + 3] * gc[3] + bfhi(nw.y); }
#pragma unroll
            for (int s = 0; s < 4; ++s) acc = MFMA32(*(const LAS bf16x8*)(slot + (32 * tr + r32) * 128 + (16 * s + 8 * hi) * 2), rowfrag(Simg, 32 * tc, 16 * s, r32, hi), acc);
            store_T_global((GAS bf16_t*)ra.RM + (size_t)unit * 4096, st, 32 * tr, 32 * tc, r32, hi);
            st = acc;
            store_T(Snew, st, 32 * tr, 32 * tc, r32, hi);
            asm volatile("s_waitcnt lgkmcnt(0)" ::: "memory");
        } else {
            if (ck + R2_D - 1 < 32) { issue(ck + R2_D - 1);
                if (wave == 4) asm volatile("s_waitcnt vmcnt(20)" ::: "memory"); else asm volatile("s_waitcnt vmcnt(16)" ::: "memory"); }
            else asm volatile("s_waitcnt vmcnt(0)" ::: "memory");
        }
        __builtin_amdgcn_s_barrier();
    }
    asm volatile("s_waitcnt vmcnt(0) lgkmcnt(0)" ::: "memory"); __syncthreads();
    (void)flag;
}
__device__ __forceinline__ void r3_wait(const unsigned* flags, int chain0, int ck, int tid) {
    if (tid < 64) {
        const unsigned* f = flags + (size_t)(chain0 + (tid & 3)) * 64;
        for (unsigned spins = 0; spins < (1u << 22); ++spins) {
            const bool ok = __hip_atomic_load((const GAS unsigned*)f, __ATOMIC_RELAXED, __HIP_MEMORY_SCOPE_AGENT) > (unsigned)ck;
            if (__all(ok)) break;
            __builtin_amdgcn_s_sleep(4);
        }
        __builtin_amdgcn_fence(__ATOMIC_ACQUIRE, "agent");
        asm volatile("s_waitcnt vmcnt(0)" ::: "memory");
    }
}
constexpr int RP = 136, RTILE = 64 * RP, R3_TEAM_LDS = 3 * RTILE;
__device__ __forceinline__ void rwkv_out_unit(const MixArgs& a, const RArgs& ra, unsigned char* ldsb, int b, int h, int ck) {
    const int tid = opaque_tid(), lane = tid & 63, wave = __builtin_amdgcn_readfirstlane(tid >> 6), r32 = lane & 31, hi = lane >> 5;
    const int tw = wave & 1, tt = tid & 127;
    LAS unsigned char* TL = (LAS unsigned char*)ldsb + (wave >> 1) * R3_TEAM_LDS;
    LAS unsigned char* VM = TL, *SG = TL + RTILE, *YC = TL + 2 * RTILE;
    const int unit = (b * 6 + h) * 32 + ck;
    const size_t row0 = (size_t)b * SEQ + ck * 64;
#pragma unroll
    for (int j = 0; j < 4; ++j) {
        const int c = tt + 128 * j, t = c >> 3, c8 = (c & 7) * 8, hc = h * 64 + c8;
        const GAS bf16_t* zr = (const GAS bf16_t*)a.Z + (row0 + t) * ZP; const bool hp = (ck * 64 + t) > 0;
        const u32x4 vc = *(const GAS u32x4*)(zr + ZA_V + hc), gcw = *(const GAS u32x4*)(zr + ZA_G + hc);
        u32x4 vp = zero_u32x4(), gp = vp; if (hp) { vp = *(const GAS u32x4*)(zr - ZP + ZA_V + hc); gp = *(const GAS u32x4*)(zr - ZP + ZA_G + hc); }
        const u32x4 yc = *(const GAS u32x4*)((const GAS bf16_t*)a.Y + (row0 + t) * DM + hc);
        const f32x4 mv0 = *(const f32x4*)(ra.mu + ZA_V + hc), mv1 = *(const f32x4*)(ra.mu + ZA_V + hc + 4), mg0 = *(const f32x4*)(ra.mu + ZA_G + hc), mg1 = *(const f32x4*)(ra.mu + ZA_G + hc + 4);
        const float vcur[8] = {bflo(vc.x), bfhi(vc.x), bflo(vc.y), bfhi(vc.y), bflo(vc.z), bfhi(vc.z), bflo(vc.w), bfhi(vc.w)}, vprv[8] = {bflo(vp.x), bfhi(vp.x), bflo(vp.y), bfhi(vp.y), bflo(vp.z), bfhi(vp.z), bflo(vp.w), bfhi(vp.w)};
        const float gcur[8] = {bflo(gcw.x), bfhi(gcw.x), bflo(gcw.y), bfhi(gcw.y), bflo(gcw.z), bfhi(gcw.z), bflo(gcw.w), bfhi(gcw.w)}, gprv[8] = {bflo(gp.x), bfhi(gp.x), bflo(gp.y), bfhi(gp.y), bflo(gp.z), bfhi(gp.z), bflo(gp.w), bfhi(gp.w)};
        const float muv[8] = {mv0[0], mv0[1], mv0[2], mv0[3], mv1[0], mv1[1], mv1[2], mv1[3]}, mug[8] = {mg0[0], mg0[1], mg0[2], mg0[3], mg1[0], mg1[1], mg1[2], mg1[3]};
        float vm[8], sg[8];
#pragma unroll
        for (int i = 0; i < 8; ++i) { vm[i] = vcur[i] + (vprv[i] - vcur[i]) * muv[i]; const float gg = gcur[i] + (gprv[i] - gcur[i]) * mug[i]; sg[i] = gg * sigmoidf_(gg); }
        u32x4 w; w.x = pk2(vm[0], vm[1]); w.y = pk2(vm[2], vm[3]); w.z = pk2(vm[4], vm[5]); w.w = pk2(vm[6], vm[7]);
        *(LAS u32x2*)(VM + t * RP + c8 * 2) = (u32x2){w.x, w.y}; *(LAS u32x2*)(VM + t * RP + c8 * 2 + 8) = (u32x2){w.z, w.w};
        w.x = pk2(sg[0], sg[1]); w.y = pk2(sg[2], sg[3]); w.z = pk2(sg[4], sg[5]); w.w = pk2(sg[6], sg[7]);
        *(LAS u32x2*)(SG + t * RP + c8 * 2) = (u32x2){w.x, w.y}; *(LAS u32x2*)(SG + t * RP + c8 * 2 + 8) = (u32x2){w.z, w.w};
        *(LAS u32x2*)(YC + t * RP + c8 * 2) = (u32x2){yc.x, yc.y}; *(LAS u32x2*)(YC + t * RP + c8 * 2 + 8) = (u32x2){yc.z, yc.w};
    }
    const GAS bf16_t* gq = (const GAS bf16_t*)ra.RQ + (size_t)unit * 4096 + (32 * tw + r32) * 64 + 8 * hi;
    const GAS bf16_t* gs = (const GAS bf16_t*)ra.RM + (size_t)unit * 4096 + r32 * 64 + 8 * hi;
    bf16x8 bq[4], a0[4], a1[4];
#pragma unroll
    for (int s = 0; s < 4; ++s) { bq[s] = *(const GAS bf16x8*)(gq + 16 * s); a0[s] = *(const GAS bf16x8*)(gs + 16 * s); a1[s] = *(const GAS bf16x8*)(gs + 32 * 64 + 16 * s); }
    const float beta = ra.RB[(row0 + 32 * tw + r32) * 8 + h];
    BAR();
    const int tl = 32 * tw + r32;
    f32x16 y0, y1;
#pragma unroll
    for (int g = 0; g < 4; ++g) { const u32x2 w0 = *(const LAS u32x2*)(YC + tl * RP + (8 * g + 4 * hi) * 2), w1 = *(const LAS u32x2*)(YC + tl * RP + (32 + 8 * g + 4 * hi) * 2);
        y0[4 * g] = bflo(w0.x); y0[4 * g + 1] = bfhi(w0.x); y0[4 * g + 2] = bflo(w0.y); y0[4 * g + 3] = bfhi(w0.y);
        y1[4 * g] = bflo(w1.x); y1[4 * g + 1] = bfhi(w1.x); y1[4 * g + 2] = bflo(w1.y); y1[4 * g + 3] = bfhi(w1.y); }
#pragma unroll
    for (int s = 0; s < 4; ++s) { y0 = MFMA32(a0[s], bq[s], y0); y1 = MFMA32(a1[s], bq[s], y1); }
    float sm = 0.f;
#pragma unroll
    for (int i = 0; i < 16; ++i) sm += y0[i] + y1[i];
    sm += __shfl_xor(sm, 32); const float mean = sm * (1.f / 64.f);
    float sq = 0.f;
#pragma unroll
    for (int i = 0; i < 16; ++i) { const float d0 = y0[i] - mean, d1 = y1[i] - mean; sq += d0 * d0 + d1 * d1; }
    sq += __shfl_xor(sq, 32); const float rstd = __builtin_amdgcn_rsqf(sq * (1.f / 64.f) + GN_EPS);
#pragma unroll
    for (int half = 0; half < 2; ++half)
#pragma unroll
        for (int g = 0; g < 4; ++g) {
            const int v0 = 32 * half + 8 * g + 4 * hi, hc = h * 64 + v0;
            const u32x2 vw = *(const LAS u32x2*)(VM + tl * RP + v0 * 2), sw = *(const LAS u32x2*)(SG + tl * RP + v0 * 2);
            const f32x4 lg4 = *(const f32x4*)(ra.ln_g + hc), lb4 = *(const f32x4*)(ra.ln_b + hc);
            const float vv[4] = {bflo(vw.x), bfhi(vw.x), bflo(vw.y), bfhi(vw.y)}, ss[4] = {bflo(sw.x), bfhi(sw.x), bflo(sw.y), bfhi(sw.y)};
            float o[4];
#pragma unroll
            for (int j = 0; j < 4; ++j) { const float yv = half ? y1[4 * g + j] : y0[4 * g + j]; o[j] = ((yv - mean) * rstd * lg4[j] + lb4[j] + beta * vv[j]) * ss[j]; }
            u32x2 w; w.x = pk2(o[0], o[1]); w.y = pk2(o[2], o[3]); *(LAS u32x2*)(YC + tl * RP + v0 * 2) = w;
        }
    BAR();
#pragma unroll
    for (int j = 0; j < 4; ++j) { const int c = tt + 128 * j, t = c >> 3, c8 = (c & 7) * 8;
        const u32x2 lo = *(const LAS u32x2*)(YC + t * RP + c8 * 2), hi2 = *(const LAS u32x2*)(YC + t * RP + c8 * 2 + 8);
        u32x4 w; w.x = lo.x; w.y = lo.y; w.z = hi2.x; w.w = hi2.y; *(GAS u32x4*)((GAS bf16_t*)a.Y + (row0 + t) * DM + h * 64 + c8) = w; }
    BAR();
}
}
constexpr int NWAVES = 8;
constexpr int RING_BYTES = 131072, LDSCTL_OFF = RING_BYTES, LDS_BYTES = 163840;
constexpr int CW_BAR = 4096, CW_Q = 2048, CW_FLAG = 65536;
struct Args { const float* in[19]; float* out; unsigned char* ws; };

__device__ __forceinline__ unsigned lds_base_u32() { extern __shared__ __attribute__((aligned(16))) unsigned char lds_[]; return (unsigned)(uintptr_t)(LAS unsigned char*)lds_; }
__device__ __forceinline__ unsigned long long rd_ptr_u(volatile LAS unsigned long long* p) { const unsigned long long v = *p; const unsigned lo = __builtin_amdgcn_readfirstlane((unsigned)v), hi = __builtin_amdgcn_readfirstlane((unsigned)(v >> 32)); return ((unsigned long long)hi << 32) | lo; }
__global__ void __launch_bounds__(NWAVES * 64, 2) mega_fwd(Args args) {
    extern __shared__ __attribute__((aligned(16))) unsigned char lds[];
    const int tid = threadIdx.x, lane = tid & 63, wave = __builtin_amdgcn_readfirstlane(tid >> 6);
    const int G = gridDim.x, bx = blockIdx.x;
    unsigned char* ws = args.ws;
    volatile LAS unsigned* MISC = (volatile LAS unsigned*)((LAS unsigned char*)lds + LDSCTL_OFF);
    for (int u = tid; u < (LDS_BYTES - LDSCTL_OFF) / 4; u += NWAVES * 64) ((LAS unsigned*)((LAS unsigned char*)lds + LDSCTL_OFF))[u] = 0u;
    __syncthreads();
    (void)xcd_barrier_post((unsigned*)(ws + WS_CTL) + CW_BAR, MISC + 8);
    volatile LAS unsigned long long* PTRS = (volatile LAS unsigned long long*)((LAS unsigned char*)lds + LDSCTL_OFF + 256);
    if (tid < 19) PTRS[tid] = (unsigned long long)(uintptr_t)args.in[tid];
    if (tid == 19) PTRS[19] = (unsigned long long)(uintptr_t)args.out;
    if (tid == 20) PTRS[20] = (unsigned long long)(uintptr_t)args.ws;
    __syncthreads();
#define PTRS_RD(i) rd_ptr_u(({ unsigned a_; asm volatile("s_mov_b32 %0, %1" : "=s"(a_) : "i"(LDSCTL_OFF + 256 + 8 * (i))); (volatile LAS unsigned long long*)(LAS unsigned char*)(lds_base_u32() + a_); }))
#define ARGP(i) ((const float*)(uintptr_t)PTRS_RD(i))
#define OUTP ((float*)(uintptr_t)PTRS_RD(19))
#define WSP ((unsigned char*)(uintptr_t)PTRS_RD(20))
#ifdef PROBE_BAR
#define GRID_BAR() do { GRID_BAR1(); GRID_BAR1(); } while (0)
#else
#define GRID_BAR() GRID_BAR1()
#endif
#define GRID_BAR1() do { XcdBarrier b_; b_.bar = (unsigned*)(WSP + WS_CTL) + CW_BAR; b_.x = xb_xcc_id(); b_.st = (volatile LAS unsigned*)((LAS unsigned char*)lds + LDSCTL_OFF) + 8; xcd_barrier(b_); } while (0)
#ifdef PROBE_T
#define TS_LDS ((volatile LAS unsigned long long*)((LAS unsigned char*)lds + LDSCTL_OFF + 1024))
#define STAMP_BEGIN(id) do { if ((id) == PROBE_T && blockIdx.x == 0 && threadIdx.x == 0) TS_LDS[0] = __builtin_amdgcn_s_memrealtime(); } while (0)
#define STAMP_END(id) do { if ((id) == PROBE_T && blockIdx.x == 0 && threadIdx.x == 0) TS_LDS[1] += __builtin_amdgcn_s_memrealtime() - TS_LDS[0]; } while (0)
#else
#define STAMP_BEGIN(id) do {} while (0)
#define STAMP_END(id) do {} while (0)
#endif
#ifdef PROBE_TBUSY
#define STAMP_END_BUSY(id) STAMP_END(id)
#define STAMP_END_WALL(id) do {} while (0)
#else
#define STAMP_END_BUSY(id) do {} while (0)
#define STAMP_END_WALL(id) STAMP_END(id)
#endif
#define PHASE_IDS const int tid = opaque_tid(), lane = tid & 63, wave = __builtin_amdgcn_readfirstlane(tid >> 6), gw = bx * NWAVES + wave, ngw = G * NWAVES; (void)lane; (void)gw; (void)ngw; (void)tid; (void)wave;
    int K1024 = DM, K256 = 256; asm volatile("" : "+s"(K1024), "+s"(K256));
    STAMP_BEGIN(0);
    {
        PHASE_IDS
        const float* x = args.in[0]; bf16_t* bufA = (bf16_t*)(ws + WS_BUFA); float* ssqA = (float*)(ws + WS_SSQA);
        PrepArgs pa; pa.w_in = args.in[3]; pa.norm_g = args.in[2]; pa.w_out = args.in[14]; pa.ple_g = args.in[15]; pa.w_gate = args.in[16]; pa.w_proj = args.in[17]; pa.w_up = args.in[6]; pa.a_up = args.in[8]; pa.ws = ws;
        prep_tables(ws, bx * NWAVES * 64 + tid, G * NWAVES * 64);
        prep_weights(pa, gw, ngw, (LAS float*)((LAS unsigned char*)lds + wave * 16384), lane, 0, DEPTH);
#ifdef PROBE_PRO
        prep_weights(pa, gw, ngw, (LAS float*)((LAS unsigned char*)lds + wave * 16384), lane, 0, DEPTH);
        for (int m = gw; m < MTOK; m += ngw) x_row_to_bf16(x + (size_t)m * DM, bufA + (size_t)m * DM, ssqA + (size_t)m * 16, lane);
#endif
        for (int m = gw; m < MTOK; m += ngw) x_row_to_bf16(x + (size_t)m * DM, bufA + (size_t)m * DM, ssqA + (size_t)m * 16, lane);
    }
    STAMP_END_BUSY(0);
    GRID_BAR();
    STAMP_END_WALL(0);
    STAMP_BEGIN(1);
#pragma clang loop unroll(full)
    for (int L = 0; L < DEPTH; ++L) {
#define PHASE_PTRS unsigned char* ws = WSP; bf16_t* cur = (bf16_t*)(ws + ((L & 1) ? WS_BUFB : WS_BUFA)); bf16_t* oth = (bf16_t*)(ws + ((L & 1) ? WS_BUFA : WS_BUFB)); const unsigned char* wl = ws + WS_W + (size_t)L * W_LAYER; \
        bf16_t* Z = (bf16_t*)(ws + WS_Z); float* PP = (float*)(ws + WS_Z); bf16_t* PB = (bf16_t*)(ws + WS_PB); float* ssqA = (float*)(ws + WS_SSQA); float* ssqB = (float*)(ws + WS_SSQB); float* out = OUTP; \
        (void)cur; (void)oth; (void)wl; (void)Z; (void)PP; (void)PB; (void)ssqA; (void)ssqB; (void)out;
        {
            PHASE_PTRS
            const float* tab16 = (const float*)(ws + WS_TAB16); const float* tabI = (const float*)(ws + WS_TABI);
            pg8::Gemm g{cur, (const bf16_t*)(wl + W_IN), MTOK, NPAD, K1024}; pg8::StaticOrder S; S.init(MTOK, NPAD, G, bx);
            epi::EpiInProj e; e.Z = Z; e.ssq = ssqA; e.tab16 = tab16; e.tabI = tabI; e.KV = (bf16_t*)(ws + WS_MISC + MISC_KV); e.IKC = (bf16_t*)(ws + WS_MISC + MISC_IKC);
#ifdef PROBE_G1
            pg8::gemm_phase<epi::EpiInProj, pg8::StaticOrder, true, true>((PG8_LAS unsigned char*)lds, g, S, e);
#endif
#ifdef PROBE_G1P
            { epi::EpiPlainZ ep; ep.Z = Z; pg8::gemm_phase<epi::EpiPlainZ, pg8::StaticOrder, true, true>((PG8_LAS unsigned char*)lds, g, S, ep); }
#endif
            pg8::gemm_phase<epi::EpiInProj, pg8::StaticOrder, true, true>((PG8_LAS unsigned char*)lds, g, S, e);
        }
        STAMP_END_BUSY(1);
        GRID_BAR();
        STAMP_END_WALL(1);
        STAMP_BEGIN(2);
        {
            PHASE_PTRS
            MixArgs ma; ma.Z = Z; ma.Y = oth; ma.KV = (const bf16_t*)(ws + WS_MISC + MISC_KV); ma.IKC = (const bf16_t*)(ws + WS_MISC + MISC_IKC); ma.mu = ARGP(4) + L * 1664; ma.w0 = ARGP(5) + L * 384; ma.w_up = ARGP(6) + (size_t)L * 64 * 384; ma.a0 = ARGP(7) + L * 384; ma.a_up = ARGP(8) + (size_t)L * 64 * 384;
            ma.k_k = ARGP(9) + L * 384; ma.k_a = ARGP(10) + L * 384; ma.r_k = ARGP(11) + L * 384; ma.ln_g = ARGP(12) + L * 384; ma.ln_b = ARGP(13) + L * 384;
            rwkv::RArgs ra; ra.mu = ma.mu; ra.w0 = ma.w0; ra.a0 = ma.a0; ra.k_k = ma.k_k; ra.k_a = ma.k_a; ra.r_k = ma.r_k; ra.ln_g = ma.ln_g; ra.ln_b = ma.ln_b;
            ra.wupT = (const bf16_t*)(wl + W_WUPT); ra.aupT = (const bf16_t*)(wl + W_AUPT); ra.RQ = (bf16_t*)out; ra.RM = (bf16_t*)out + (size_t)3072 * 4096;     ra.RN = (bf16_t*)(ws + WS_MISC + MISC_RN); ra.RG = (float*)(ws + WS_MISC + MISC_RG); ra.RB = (float*)(ws + WS_MISC + MISC_RB);
#ifdef PROBE_R1
            for (int rep = 0; rep < 2; ++rep)
#endif
            STAMP_BEGIN(20);
            {
              rwkv::R1Raw raw; const int tid1 = opaque_tid(); const int per = (3072 + G - 1) / G, u0 = bx * per, u1 = min(u0 + per, 3072);
              if (u0 < u1) rwkv::r1_load(ma, raw, tid1, u0 / 192, (u0 / 32) % 6, u0 & 31);
              int hprev = -1;
              for (int u = u0; u < u1; ++u) { const int un = u + 1; const int ck = u & 31, hh = (u / 32) % 6;
                  if (hh != hprev) { __syncthreads(); rwkv::r1_load_params(ra, lds, tid1, hh); __syncthreads(); hprev = hh; }
                  rwkv::rwkv_chunk_unit(ma, ra, lds, u / 192, hh, ck, raw, ck == 0 ? 0 : (u == u0 ? 2 : 1), un < u1, un / 192, (un / 32) % 6, un & 31); } }
            STAMP_END(20); STAMP_BEGIN(21);
            { unsigned* qctr = (unsigned*)(ws + WS_CTL) + CW_Q + L * 8 + (bx & 7);
#define QW_PTR() ({ unsigned a_; asm volatile("s_mov_b32 %0, %1" : "=s"(a_) : "i"(LDSCTL_OFF + 1536)); (volatile LAS unsigned*)(LAS unsigned char*)(lds_base_u32() + a_); })
              for (;;) {
                  if (opaque_tid() == 0) { const unsigned v_ = __hip_atomic_fetch_add(qctr, 1u, __ATOMIC_RELAXED, __HIP_MEMORY_SCOPE_AGENT); QW_PTR()[0] = v_; }
                  __syncthreads();
                  const unsigned qi = QW_PTR()[0];
                  __syncthreads();
                  if (qi >= 64u) break;
                  dsa::dsa_unit(ma, lds, (bx & 7) * 2 + (int)(qi & 1u), 31 - (int)(qi >> 1));
              } }
            __syncthreads();
            STAMP_END(21); STAMP_BEGIN(22);
            float* LQ = (float*)(ws + WS_MISC);
#ifdef PROBE_DIL
            for (int rep = 0; rep < 2; ++rep)
#endif
            for (int u = bx; u < 768; u += G) dil::dil_unit(ma, LQ, lds, u / 48, (u % 48) >> 4, u & 15);
            STAMP_END(22); STAMP_BEGIN(23);
        }
        STAMP_END_BUSY(2);
        GRID_BAR();
        STAMP_END_WALL(2); STAMP_END(23);
        STAMP_BEGIN(3);
        {
            PHASE_PTRS
            MixArgs ma; ma.Z = Z; ma.Y = oth; const float* LQ = (const float*)(ws + WS_MISC); PHASE_IDS
            rwkv::RArgs ra; ra.mu = ARGP(4) + L * 1664; ra.ln_g = ARGP(12) + L * 384; ra.ln_b = ARGP(13) + L * 384;
            ra.RQ = (bf16_t*)out; ra.RM = (bf16_t*)out + (size_t)3072 * 4096;     ra.RN = (bf16_t*)(ws + WS_MISC + MISC_RN); ra.RG = (float*)(ws + WS_MISC + MISC_RG); ra.RB = (float*)(ws + WS_MISC + MISC_RB);
            if (G > 96) {
#ifdef PROBE_R2
                if (bx < 96) rwkv::rwkv_scan_chain<true>(ra, lds, bx / 6, bx % 6);
#endif
                if (bx < 96) { STAMP_BEGIN(40); rwkv::rwkv_scan_chain(ra, lds, bx / 6, bx % 6, (unsigned*)(ws + WS_CTL) + CW_FLAG + (L * 96 + bx) * 64); STAMP_END(40); }
                else { dil::dil_merge(ma, LQ, (bx - 96) * 512 + tid, (G - 96) * 512);
                    const float* src = ARGP(1) + (size_t)L * MTOK * 256;
                    for (size_t i = (size_t)(bx - 96) * 512 + tid; i < (size_t)MTOK * 256 / 8; i += (size_t)(G - 96) * 512) {
                        const f32x4 a = ((const f32x4*)src)[2 * i], b = ((const f32x4*)src)[2 * i + 1];
                        u32x4 w; w.x = pk2(a.x, a.y); w.y = pk2(a.z, a.w); w.z = pk2(b.x, b.y); w.w = pk2(b.z, b.w); ((u32x4*)PB)[i] = w; }
                }
            } else {
                for (int u = bx; u < 96; u += G) rwkv::rwkv_scan_chain(ra, lds, u / 6, u % 6, (unsigned*)(ws + WS_CTL) + CW_FLAG + (L * 96 + u) * 64);
                dil::dil_merge(ma, LQ, bx * 512 + tid, G * 512);
                { const float* src = ARGP(1) + (size_t)L * MTOK * 256;
                  for (size_t i = (size_t)bx * 512 + tid; i < (size_t)MTOK * 256 / 8; i += (size_t)G * 512) {
                      const f32x4 a = ((const f32x4*)src)[2 * i], b = ((const f32x4*)src)[2 * i + 1];
                      u32x4 w; w.x = pk2(a.x, a.y); w.y = pk2(a.z, a.w); w.z = pk2(b.x, b.y); w.w = pk2(b.z, b.w); ((u32x4*)PB)[i] = w; } }
            }
        }
        STAMP_END_BUSY(3);
        GRID_BAR();
        STAMP_END_WALL(3);
        STAMP_BEGIN(4);
        {
            PHASE_PTRS
            MixArgs ma; ma.Z = Z; ma.Y = oth;
            rwkv::RArgs ra; ra.mu = ARGP(4) + L * 1664; ra.ln_g = ARGP(12) + L * 384; ra.ln_b = ARGP(13) + L * 384;
            ra.RQ = (bf16_t*)out; ra.RM = (bf16_t*)out + (size_t)3072 * 4096;     ra.RB = (float*)(ws + WS_MISC + MISC_RB); PHASE_IDS
            for (int u4 = bx; u4 < 768; u4 += G) { const int u = u4 * 4 + (wave >> 1); rwkv::rwkv_out_unit(ma, ra, lds, u / 192, (u / 32) % 6, u & 31); }
        }
        STAMP_END_BUSY(4);
        GRID_BAR();
        STAMP_END_WALL(4);
        STAMP_BEGIN(5);
        {
            PHASE_PTRS
            pg8::Gemm g{oth, (const bf16_t*)(wl + W_OUT), MTOK, DM, K1024}; pg8::StaticOrder S; S.init(MTOK, DM, G, bx);
            epi::EpiOutProj e; e.xb = cur; e.ssq_out = ssqB;
            pg8::Gemm g2{PB, (const bf16_t*)(wl + W_PROJ), MTOK, DM, K256};
            epi::EpiBf16Plain e2; e2.C = (bf16_t*)PP;
            if ((bx >> 3) & 1) {
                pg8::gemm_phase<epi::EpiBf16Plain, pg8::StaticOrder, true, true>((PG8_LAS unsigned char*)lds, g2, S, e2);
                pg8::gemm_phase<epi::EpiOutProj, pg8::StaticOrder, true, true>((PG8_LAS unsigned char*)lds, g, S, e);
            } else {
                pg8::gemm_phase<epi::EpiOutProj, pg8::StaticOrder, true, true>((PG8_LAS unsigned char*)lds, g, S, e);
                pg8::gemm_phase<epi::EpiBf16Plain, pg8::StaticOrder, true, true>((PG8_LAS unsigned char*)lds, g2, S, e2);
            }
        }
        STAMP_END_BUSY(5);
        GRID_BAR();
        STAMP_END_WALL(5);
        STAMP_BEGIN(6);
        {
            PHASE_PTRS
            pg8::Gemm g{cur, (const bf16_t*)(wl + W_GATE), MTOK, DM, K1024}; pg8::StaticOrder S; S.init(MTOK, DM, G, bx);
            epi::EpiGate e; e.x1b = cur; e.pp = (const bf16_t*)PP; e.xb = oth; e.ssq_in = ssqB; e.ssq_out = ssqA;
            pg8::gemm_phase<epi::EpiGate, pg8::StaticOrder, true, true>((PG8_LAS unsigned char*)lds, g, S, e);
        }
        STAMP_END_BUSY(6);
        GRID_BAR();
        STAMP_END_WALL(6);
        STAMP_BEGIN(1); STAMP_BEGIN(7);
    }
    {
        const int L = 0; PHASE_PTRS
        const float* fg = ARGP(18); PHASE_IDS
        const bf16_t* xb = (const bf16_t*)(ws + ((DEPTH & 1) ? WS_BUFB : WS_BUFA));
        for (int m = gw; m < MTOK; m += ngw) { const float rs = row_rstd(ssqA + (size_t)m * 16); f32x4* orow = (f32x4*)(out + (size_t)m * DM);
#pragma unroll
            for (int j = 0; j < 2; ++j) { const int c8 = 64 * j + lane; const u32x4 w = ((const u32x4*)(xb + (size_t)m * DM))[c8]; const f32x4 g0 = ((const f32x4*)fg)[2 * c8], g1 = ((const f32x4*)fg)[2 * c8 + 1];
                const f32x4 a = {bflo(w.x), bfhi(w.x), bflo(w.y), bfhi(w.y)}, b = {bflo(w.z), bfhi(w.z), bflo(w.w), bfhi(w.w)};
                orow[2 * c8] = a * rs * g0; orow[2 * c8 + 1] = b * rs * g1; } }
    }
#ifdef PROBE_T
    if (PROBE_T == 7) { __syncthreads(); STAMP_END(7); }
    if (blockIdx.x == 0 && threadIdx.x == 0) { const unsigned long long t0 = __builtin_amdgcn_s_memrealtime(), w = 4ull * TS_LDS[1]; while (__builtin_amdgcn_s_memrealtime() - t0 < w) __builtin_amdgcn_s_sleep(8); }
#endif
}

extern "C" void kernel_launch(void* const* d_in, const int* in_sizes, int n_in, void* d_out, int out_size, void* d_ws, size_t ws_size, hipStream_t stream) {
    static int grid = 0;
    if (grid == 0) {
        if (n_in != 19 || out_size != MTOK * DM || ws_size < WS_END) { fprintf(stderr, "kernel_launch: unexpected shapes n_in %d out %d ws %zu\n", n_in, out_size, ws_size); grid = -1; return; }
        int dev = 0, cus = 0, per_cu = 0;
        if (hipGetDevice(&dev) != hipSuccess || hipDeviceGetAttribute(&cus, hipDeviceAttributeMultiprocessorCount, dev) != hipSuccess) { grid = -1; return; }
        if (hipFuncSetAttribute((const void*)mega_fwd, hipFuncAttributeMaxDynamicSharedMemorySize, LDS_BYTES) != hipSuccess) { fprintf(stderr, "kernel_launch: hipFuncSetAttribute failed\n"); grid = -1; return; }
        if (hipOccupancyMaxActiveBlocksPerMultiprocessor(&per_cu, (const void*)mega_fwd, NWAVES * 64, LDS_BYTES) != hipSuccess || per_cu < 1) { fprintf(stderr, "kernel_launch: occupancy query says %d blocks per CU\n", per_cu); (void)hipGetLastError(); grid = -1; return; }
        grid = cus;
    }
    if (grid < 0) return;
    if (hipMemsetAsync((char*)d_ws + WS_CTL, 0, 1 * MiB, stream) != hipSuccess) return;
    Args a; memset(&a, 0, sizeof a);
    for (int i = 0; i < 19; ++i) a.in[i] = (const float*)d_in[i];
    a.out = (float*)d_out; a.ws = (unsigned char*)d_ws;
    hipLaunchKernelGGL(mega_fwd, dim3(grid), dim3(NWAVES * 64), LDS_BYTES, stream, a);
}
```

```cpp
#include <hip/hip_runtime.h>
#include <cstdio>
#include <cstdint>
#include <cmath>
#include <cstring>

constexpr int BATCH = 16, SEQ = 2048, DM = 1024, DEPTH = 4, MTOK = BATCH * SEQ;
constexpr int ZP = 4136;
constexpr int NPAD = 4352;
constexpr int ZA_R = 0, ZA_K = 384, ZA_V = 768, ZA_G = 1152, ZA_WD = 1536, ZA_AD = 1600;
constexpr int ZB_Q = 1664, ZB_K = 1920, ZB_V = 1984, ZB_IQ = 2048, ZB_IK = 2304, ZB_IW = 2336, ZB_G = 2344;
constexpr int ZC_Q = 2600, ZC_K = 2984, ZC_V = 3368, ZC_G = 3752;
constexpr float LOG2E = 1.4426950408889634f;
constexpr float QSCALE = 0.125f * LOG2E;
constexpr float IQSCALE = 0.17677669529663687f;
constexpr float IWSCALE = 0.35355339059327373f;
constexpr float NORM_EPS = 1e-6f, GN_EPS = 64e-5f;
constexpr float DECAY_SCALE = 0.6065306597126334f;

typedef unsigned short bf16_t;
typedef short bf16x8 __attribute__((ext_vector_type(8)));
typedef float f32x4 __attribute__((ext_vector_type(4)));
typedef float f32x16 __attribute__((ext_vector_type(16)));
typedef unsigned u32x4 __attribute__((ext_vector_type(4)));
typedef unsigned u32x2 __attribute__((ext_vector_type(2)));

__device__ __forceinline__ unsigned f2bf(float f) { unsigned u = __builtin_bit_cast(unsigned, f); return (u + 0x7fffu + ((u >> 16) & 1u)) >> 16; }
typedef float f32x2_t __attribute__((ext_vector_type(2))); typedef __bf16 bf16x2_t __attribute__((ext_vector_type(2)));
__device__ __forceinline__ unsigned pk2(float lo, float hi) { const f32x2_t v = {lo, hi}; return __builtin_bit_cast(unsigned, __builtin_convertvector(v, bf16x2_t)); }
__device__ __forceinline__ float bf2f(unsigned short b) { return __builtin_bit_cast(float, (unsigned)b << 16); }
__device__ __forceinline__ float bflo(unsigned w) { return __builtin_bit_cast(float, w << 16); }
__device__ __forceinline__ float bfhi(unsigned w) { return __builtin_bit_cast(float, w & 0xffff0000u); }
__device__ __forceinline__ float sigmoidf_(float x) { return __builtin_amdgcn_rcpf(1.0f + __builtin_amdgcn_exp2f(-1.4426950408889634f * x)); }
__device__ __forceinline__ float fexp_(float x) { return __builtin_amdgcn_exp2f(1.4426950408889634f * x); }
__device__ __forceinline__ float tanhf_(float x) { const float e = __builtin_amdgcn_exp2f(fminf(2.8853900817779268f * x, 60.f)); return 1.0f - 2.0f * __builtin_amdgcn_rcpf(e + 1.0f); }
__device__ __forceinline__ int opaque_tid() { int t = threadIdx.x; asm volatile("" : "+v"(t)); return t; }
__device__ __forceinline__ u32x4 zero_u32x4() { unsigned z = 0u; asm volatile("" : "+v"(z)); u32x4 r; r.x = z; r.y = z; r.z = z; r.w = z; return r; }
__device__ __forceinline__ float wave_sum(float v) {
#pragma unroll
    for (int o = 1; o < 64; o <<= 1) v += __shfl_xor(v, o);
    return v;
}
__device__ __forceinline__ float wave_max(float v) {
#pragma unroll
    for (int o = 1; o < 64; o <<= 1) v = fmaxf(v, __shfl_xor(v, o));
    return v;
}

constexpr size_t MiB = 1u << 20;
constexpr size_t WS_CTL = 0;
constexpr size_t WS_TAB16 = 1 * MiB;
constexpr size_t WS_TABI = WS_TAB16 + 128 * 1024;
constexpr size_t WS_SSQA = WS_TABI + 64 * 1024;
constexpr size_t WS_SSQB = WS_SSQA + 2 * MiB;
constexpr size_t WS_W = 6 * MiB;
constexpr size_t W_LAYER = 14 * MiB, W_IN = 0, W_OUT = 8912896, W_GATE = W_OUT + 2 * MiB, W_PROJ = W_GATE + 2 * MiB, W_WUPT = W_PROJ + 512 * 1024, W_AUPT = W_WUPT + 48 * 1024;
constexpr size_t WS_BUFA = 62 * MiB;
constexpr size_t WS_BUFB = 126 * MiB;
constexpr size_t WS_PB = 190 * MiB;
constexpr size_t WS_Z = 206 * MiB;
constexpr size_t WS_Z_END = WS_Z + (size_t)MTOK * ZP * 2;
constexpr size_t WS_MISC = 465 * MiB;
constexpr size_t WS_END = 512 * MiB;
constexpr size_t MISC_LQ = 0, MISC_RG = 1 * MiB, MISC_RN = 2 * MiB, MISC_RB = 26 * MiB, MISC_KV = 27 * MiB, MISC_IKC = 35 * MiB;
static_assert(W_AUPT + 48 * 1024 <= W_LAYER && WS_W + 4 * W_LAYER <= WS_BUFA && WS_Z_END <= WS_MISC, "ws map");
namespace pg8 {
#define PG8_LAS __attribute__((address_space(3)))
typedef unsigned short bf16_t;
typedef short bf16x8 __attribute__((ext_vector_type(8)));
typedef float f32x4 __attribute__((ext_vector_type(4)));
typedef unsigned u32x4 __attribute__((ext_vector_type(4)));
constexpr int BM = 256, BK = 64, HALF = 128, HTB = HALF * BK * 2  , STAGE_BYTES = 8 * HTB, NXCD = 8, WGM = 8;

__host__ __device__ __forceinline__ int lds_byte(int r, int c) { const int st = (r >> 4) * 2 + (c >> 5), rr = r & 15, cc = c & 31, ob = rr * 64 + cc * 2; return st * 1024 + (ob ^ (((ob >> 9) & 1) << 5)); }
__host__ __device__ __forceinline__ void stage_rc(int b, int& R, int& C) { const int st = b / 1024, sb = b % 1024, swz = sb ^ (((sb >> 9) & 1) << 5); R = (st >> 1) * 16 + swz / 64; C = (st & 1) * 32 + (swz % 64) / 2; }
__host__ __device__ __forceinline__ int perm32(int rho) { const int n = rho >> 4, i = rho & 15; return 8 * (i >> 2) + 4 * n + (i & 3); }

struct Unit { int pm, pn; };
struct Gemm { const bf16_t* A; const bf16_t* Bt; int M, N, K; };

struct StaticOrder {
    int nM, nN, nwg, G, c;
    __host__ __device__ void init(int M, int N, int G_, int c_) { nM = M / BM; nN = N / BM; nwg = nM * nN; G = G_; c = c_; }
    __host__ __device__ bool next(int i, Unit& u) const {
        const long L = (long)i * G + c; if (L >= nwg) return false;
        int wgid = (int)L; { const int q = nwg / NXCD, r = nwg % NXCD, xcd = wgid % NXCD, off = wgid / NXCD; wgid = (xcd < r ? xcd * (q + 1) : r * (q + 1) + (xcd - r) * q) + off; }
        const int nig = WGM * nN, gid = wgid / nig, fm = gid * WGM, gsz = (nM - fm) < WGM ? (nM - fm) : WGM;
        u.pm = fm + ((wgid % nig) % gsz); u.pn = (wgid % nig) / gsz; return true;
    }
    __device__ __forceinline__ void a_ready(const Unit&) const {}
    __device__ __forceinline__ void done(const Unit&) const {}
};

__device__ __forceinline__ unsigned cvt_pk_bf16(float lo, float hi) { unsigned r; asm volatile("v_cvt_pk_bf16_f32 %0, %1, %2" : "=v"(r) : "v"(lo), "v"(hi)); return r; }
template <class Epi, class Sched, bool ALIGN_EPI = false, bool SP2 = false>
__device__ __forceinline__ void gemm_phase(PG8_LAS unsigned char* lds, const Gemm g, const Sched& S, const Epi& E) {
    int tid_ = threadIdx.x; asm volatile("" : "+v"(tid_));
    const int tid = tid_, wid = __builtin_amdgcn_readfirstlane(tid >> 6), lane = tid & 63, wr = wid >> 2, wc = wid & 3, fr = lane & 15, fq = lane >> 4;
    const int K = g.K, nt = K / BK;
    unsigned voffA[2], voffB[2];
#pragma unroll
    for (int i = 0; i < 2; ++i) { int R, C; stage_rc(tid * 16 + i * 8192, R, C); const int Rb = Epi::PERM ? ((R & ~31) + perm32(R & 31)) : R;
        voffA[i] = (unsigned)(R * K + C) * 2u; voffB[i] = (unsigned)(Rb * K + C) * 2u; }
    const size_t kstep = (size_t)(BK * 2);
    const size_t hstep = (size_t)HALF * K * 2;
    const size_t tstep = 2 * hstep;
    const unsigned ldsw = (unsigned)wid * 1024u;
    const int aoff = lds_byte(wr * 64 + fr, fq * 8), boff = lds_byte(wc * 32 + fr, fq * 8);
#define PG8_SA(b, h) (((b) * 2 + (h)) * HTB)
#define PG8_SB(b, h) ((4 + (b) * 2 + (h)) * HTB)
#define PG8_STAGE(bufoff, gbase, voff) do { _Pragma("unroll") for (int _i = 0; _i < 2; ++_i) \
        __builtin_amdgcn_global_load_lds((const unsigned*)((const char*)(gbase) + (voff)[_i]), (PG8_LAS unsigned*)(lds + (bufoff) + ldsw + _i * 8192), 16, 0, 0); } while (0)
#define PG8_LDA(dst, b, h) do { _Pragma("unroll") for (int m = 0; m < 4; ++m) _Pragma("unroll") for (int k = 0; k < 2; ++k) dst[m][k] = *(const PG8_LAS bf16x8*)(lds + PG8_SA(b, h) + aoff + m * 2048 + k * 1024); } while (0)
#define PG8_LDB(dst, b, h) do { _Pragma("unroll") for (int n = 0; n < 2; ++n) _Pragma("unroll") for (int k = 0; k < 2; ++k) dst[n][k] = *(const PG8_LAS bf16x8*)(lds + PG8_SB(b, h) + boff + n * 2048 + k * 1024); } while (0)
#define PG8_MMA(ai, bj, At, Bt) do { __builtin_amdgcn_s_setprio(1); _Pragma("unroll") for (int m = 0; m < 4; ++m) _Pragma("unroll") for (int n = 0; n < 2; ++n) _Pragma("unroll") for (int k = 0; k < 2; ++k) \
        acc[ai][bj][m][n] = __builtin_amdgcn_mfma_f32_16x16x32_bf16(Bt[n][k], At[m][k], acc[ai][bj][m][n], 0, 0, 0); __builtin_amdgcn_s_setprio(0); } while (0)
#define PG8_WAIT_V(n) asm volatile("s_waitcnt vmcnt(" #n ")" ::: "memory")
#define PG8_WAIT_L(n) asm volatile("s_waitcnt lgkmcnt(" #n ")" ::: "memory")
#define PG8_BAR __builtin_amdgcn_s_barrier()
#define PG8_SCHED __builtin_amdgcn_sched_barrier(0)
    Unit cur, nxt; int ui = 0;
    if (!S.next(0, cur)) return;
    f32x4 acc[2][2][4][2];
#pragma unroll
    for (int a = 0; a < 2; ++a)
#pragma unroll
        for (int b = 0; b < 2; ++b)
#pragma unroll
            for (int m = 0; m < 4; ++m)
#pragma unroll
                for (int n = 0; n < 2; ++n) acc[a][b][m][n] = (f32x4){0.f, 0.f, 0.f, 0.f};
    bf16x8 At[4][2], B0[2][2], B1[2][2];
    const char* cA = (const char*)g.A + (size_t)cur.pm * tstep; const char* cB = (const char*)g.Bt + (size_t)cur.pn * tstep;
    S.a_ready(cur);
    if constexpr (SP2) {
        PG8_STAGE(PG8_SB(0, 0), cB, voffB); PG8_STAGE(PG8_SB(0, 1), cB + hstep, voffB); PG8_STAGE(PG8_SA(0, 0), cA, voffA); PG8_STAGE(PG8_SA(0, 1), cA + hstep, voffA);
        if (wr == 1) PG8_BAR;
        PG8_WAIT_V(2); PG8_BAR;
        PG8_STAGE(PG8_SB(1, 0), cB + kstep, voffB); PG8_STAGE(PG8_SA(1, 0), cA + kstep, voffA); PG8_STAGE(PG8_SB(1, 1), cB + hstep + kstep, voffB);
        PG8_WAIT_V(6); PG8_BAR;
    } else {
        PG8_STAGE(PG8_SB(0, 0), cB, voffB); PG8_STAGE(PG8_SA(0, 0), cA, voffA); PG8_STAGE(PG8_SB(0, 1), cB + hstep, voffB); PG8_STAGE(PG8_SA(0, 1), cA + hstep, voffA);
        if (wr == 1) PG8_BAR;
        PG8_WAIT_V(4); PG8_BAR;
        PG8_STAGE(PG8_SB(1, 0), cB + kstep, voffB); PG8_STAGE(PG8_SA(1, 0), cA + kstep, voffA); PG8_STAGE(PG8_SB(1, 1), cB + hstep + kstep, voffB);
        PG8_WAIT_V(6); PG8_BAR;
    }
    for (;;) {
        const bool has_next = S.next(ui + 1, nxt);
        const char* nA = has_next ? (const char*)g.A + (size_t)nxt.pm * tstep : cA; const char* nB = has_next ? (const char*)g.Bt + (size_t)nxt.pn * tstep : cB;
        for (int t = 0; t < nt; t += 2) {
            const bool last = (t == nt - 2);
            const char* a1 = cA + (size_t)(t + 1) * kstep;
            const char* a2 = last ? nA : cA + (size_t)(t + 2) * kstep; const char* b2 = last ? nB : cB + (size_t)(t + 2) * kstep;
            const char* a3 = a2 + kstep; const char* b3 = b2 + kstep;
            if (last && has_next) S.a_ready(nxt);
            if constexpr (SP2) {
            PG8_LDB(B0, 0, 0); PG8_LDB(B1, 0, 1); PG8_SCHED; PG8_LDA(At, 0, 0); PG8_STAGE(PG8_SA(1, 1), a1 + hstep, voffA);
            PG8_WAIT_V(8); PG8_WAIT_L(0); PG8_BAR; PG8_MMA(0, 0, At, B0); PG8_MMA(0, 1, At, B1); PG8_BAR; PG8_SCHED;
            PG8_LDA(At, 0, 1); PG8_STAGE(PG8_SB(0, 0), b2, voffB); PG8_STAGE(PG8_SB(0, 1), b2 + hstep, voffB); PG8_STAGE(PG8_SA(0, 0), a2, voffA);
            PG8_WAIT_V(8); PG8_WAIT_L(0); PG8_BAR; PG8_MMA(1, 0, At, B0); PG8_MMA(1, 1, At, B1); PG8_BAR; PG8_SCHED;
            PG8_LDB(B0, 1, 0); PG8_LDB(B1, 1, 1); PG8_SCHED; PG8_LDA(At, 1, 0); PG8_STAGE(PG8_SA(0, 1), a2 + hstep, voffA);
            PG8_WAIT_V(8); PG8_WAIT_L(0); PG8_BAR; PG8_MMA(0, 0, At, B0); PG8_MMA(0, 1, At, B1); PG8_BAR; PG8_SCHED;
            PG8_LDA(At, 1, 1); PG8_STAGE(PG8_SB(1, 0), b3, voffB); PG8_STAGE(PG8_SB(1, 1), b3 + hstep, voffB); PG8_STAGE(PG8_SA(1, 0), a3, voffA);
            PG8_WAIT_V(8); PG8_WAIT_L(0); PG8_BAR; PG8_MMA(1, 0, At, B0); PG8_MMA(1, 1, At, B1); PG8_BAR; PG8_SCHED;
            } else {
            PG8_LDB(B0, 0, 0); PG8_SCHED; PG8_LDA(At, 0, 0); PG8_STAGE(PG8_SA(1, 1), a1 + hstep, voffA);
            PG8_WAIT_L(8); PG8_BAR; PG8_WAIT_L(0); PG8_MMA(0, 0, At, B0); PG8_BAR; PG8_SCHED;
            PG8_LDB(B1, 0, 1); PG8_STAGE(PG8_SB(0, 0), b2, voffB);
            PG8_BAR; PG8_WAIT_L(0); PG8_MMA(0, 1, At, B1); PG8_BAR;
            PG8_LDA(At, 0, 1); PG8_STAGE(PG8_SA(0, 0), a2, voffA);
            PG8_BAR; PG8_WAIT_L(0); PG8_MMA(1, 0, At, B0); PG8_BAR; PG8_SCHED;
            PG8_STAGE(PG8_SB(0, 1), b2 + hstep, voffB);
            PG8_WAIT_V(6); PG8_BAR; PG8_MMA(1, 1, At, B1); PG8_BAR;
            PG8_LDB(B0, 1, 0); PG8_SCHED; PG8_LDA(At, 1, 0); PG8_STAGE(PG8_SA(0, 1), a2 + hstep, voffA);
            PG8_WAIT_L(8); PG8_BAR; PG8_WAIT_L(0); PG8_MMA(0, 0, At, B0); PG8_BAR; PG8_SCHED;
            PG8_LDB(B1, 1, 1); PG8_STAGE(PG8_SB(1, 0), b3, voffB);
            PG8_BAR; PG8_WAIT_L(0); PG8_MMA(0, 1, At, B1); PG8_BAR;
            PG8_LDA(At, 1, 1); PG8_STAGE(PG8_SA(1, 0), a3, voffA);
            PG8_BAR; PG8_WAIT_L(0); PG8_MMA(1, 0, At, B0); PG8_BAR; PG8_SCHED;
            PG8_STAGE(PG8_SB(1, 1), b3 + hstep, voffB);
            PG8_WAIT_V(6); PG8_BAR; PG8_MMA(1, 1, At, B1); PG8_BAR;
            }
        }
        if constexpr (ALIGN_EPI) { if (wr == 0) PG8_BAR; }
        if constexpr (!Epi::AFTER_DRAIN) { E(acc, cur, wr, wc, fr, fq); S.done(cur); }
        if (!has_next) break;
#pragma unroll
        for (int a = 0; a < 2; ++a)
#pragma unroll
            for (int b = 0; b < 2; ++b)
#pragma unroll
                for (int m = 0; m < 4; ++m)
#pragma unroll
                    for (int n = 0; n < 2; ++n) acc[a][b][m][n] = (f32x4){0.f, 0.f, 0.f, 0.f};
        cur = nxt; cA = nA; cB = nB; ++ui;
        if constexpr (ALIGN_EPI) { if (wr == 1) PG8_BAR; }
    }
    PG8_WAIT_V(0);
    if constexpr (!ALIGN_EPI) { if (wr == 0) PG8_BAR; }
    PG8_BAR;
    if constexpr (Epi::AFTER_DRAIN) { E.fused(acc, cur, wr, wc, fr, fq, lds, wid, lane); S.done(cur); }
#undef PG8_SA
#undef PG8_SB
#undef PG8_STAGE
#undef PG8_LDA
#undef PG8_LDB
#undef PG8_MMA
#undef PG8_WAIT_V
#undef PG8_WAIT_L
#undef PG8_BAR
#undef PG8_SCHED
}
}
#define GAS __attribute__((address_space(1)))
#define LAS __attribute__((address_space(3)))

__device__ __forceinline__ int zcol_src(int n, float& sc) {
    sc = 1.f;
    if (n < ZB_Q) return n;
    if (n < ZB_K) { int o = n - ZB_Q, h = o >> 6, d = o & 63; sc = QSCALE; if (d < 16) d = (d >> 1) + 8 * (d & 1); return ZB_Q + h * 64 + d; }
    if (n < ZB_V) { int d = n - ZB_K; if (d < 16) d = (d >> 1) + 8 * (d & 1); return ZB_K + d; }
    if (n < ZB_IQ) return n;
    if (n < ZB_IK) { int o = n - ZB_IQ, h = o >> 5, d = o & 31; sc = IQSCALE; if (d < 8) d = (d >> 1) + 4 * (d & 1); return ZB_IQ + h * 32 + d; }
    if (n < ZB_IW) { int d = n - ZB_IK; if (d < 8) d = (d >> 1) + 4 * (d & 1); return ZB_IK + d; }
    if (n < ZB_G) { sc = IWSCALE; return n; }
    if (n < ZC_Q) return n;
    if (n < ZC_K) { int o = n - ZC_Q, h = o >> 6, d = o & 63; sc = QSCALE; if (d < 16) d = (d >> 1) + 8 * (d & 1); return ZC_Q + h * 64 + d; }
    if (n < ZC_V) { int o = n - ZC_K, h = o >> 6, d = o & 63; if (d < 16) d = (d >> 1) + 8 * (d & 1); return ZC_K + h * 64 + d; }
    return n;
}

template <bool ZMAP>
__device__ __forceinline__ void transpose_item(const float* __restrict__ W, int K, int NW, bf16_t* WT, const float* __restrict__ kscale, LAS float* scr, int item, int nblk, int lane) {
    const int kb = item / nblk, nb = item % nblk, k0 = 64 * kb, n0 = 32 * nb;
    const int c4 = 4 * (lane & 7), ncol = n0 + c4;
    f32x4 v[8];
#pragma unroll
    for (int i = 0; i < 8; ++i) { const int kk = (lane >> 3) + 8 * i; v[i] = (f32x4){0.f, 0.f, 0.f, 0.f}; if (ncol < NW) v[i] = *(const f32x4*)(W + (size_t)(k0 + kk) * NW + ncol); }
#pragma unroll
    for (int i = 0; i < 8; ++i) { const int kk = (lane >> 3) + 8 * i; f32x4 x = v[i]; if (kscale) x = x * kscale[k0 + kk];
        scr[kk * 33 + c4] = x[0]; scr[kk * 33 + c4 + 1] = x[1]; scr[kk * 33 + c4 + 2] = x[2]; scr[kk * 33 + c4 + 3] = x[3]; }
    asm volatile("s_waitcnt lgkmcnt(0)" ::: "memory");
    const int c = lane & 7;
#pragma unroll
    for (int j = 0; j < 4; ++j) { const int n = (lane >> 3) + 8 * j; int sl = n; float sc = 1.f;
        if (ZMAP) { if (n0 + n < NW) sl = zcol_src(n0 + n, sc) - n0; else { sl = n; sc = 0.f; } }
        const LAS float* s = scr + (8 * c) * 33 + sl;
        u32x4 o; o.x = pk2(s[0 * 33] * sc, s[1 * 33] * sc); o.y = pk2(s[2 * 33] * sc, s[3 * 33] * sc); o.z = pk2(s[4 * 33] * sc, s[5 * 33] * sc); o.w = pk2(s[6 * 33] * sc, s[7 * 33] * sc);
        *(u32x4*)(WT + (size_t)(n0 + n) * K + k0 + 8 * c) = o; }
    asm volatile("s_waitcnt lgkmcnt(0)" ::: "memory");
}

struct PrepArgs { const float* w_in; const float* norm_g; const float* w_out; const float* ple_g; const float* w_gate; const float* w_proj; const float* w_up; const float* a_up; unsigned char* ws; };

__device__ __forceinline__ void prep_weights(const PrepArgs& a, int gw, int ngw, LAS float* scr, int lane, int L0, int L1) {
    constexpr int I_IN = 16 * (NPAD / 32), I_SQ = 16 * 32, I_PJ = 4 * 32, I_UP = 12, I_LAYER = I_IN + 2 * I_SQ + I_PJ + 2 * I_UP;
    for (int it = gw; it < (L1 - L0) * I_LAYER; it += ngw) {
        const int L = L0 + it / I_LAYER; int r = it % I_LAYER;
        unsigned char* wl = a.ws + WS_W + (size_t)L * W_LAYER;
        if (r < I_IN) { transpose_item<true>(a.w_in + (size_t)L * DM * ZP, DM, ZP, (bf16_t*)(wl + W_IN), a.norm_g + L * DM, scr, r, NPAD / 32, lane); continue; } r -= I_IN;
        if (r < I_SQ) { transpose_item<false>(a.w_out + (size_t)L * DM * DM, DM, DM, (bf16_t*)(wl + W_OUT), nullptr, scr, r, 32, lane); continue; } r -= I_SQ;
        if (r < I_SQ) { transpose_item<false>(a.w_gate + (size_t)L * DM * DM, DM, DM, (bf16_t*)(wl + W_GATE), a.ple_g + L * DM, scr, r, 32, lane); continue; } r -= I_SQ;
        if (r < I_PJ) { transpose_item<false>(a.w_proj + (size_t)L * 256 * DM, 256, DM, (bf16_t*)(wl + W_PROJ), nullptr, scr, r, 32, lane); continue; } r -= I_PJ;
        if (r < I_UP) { transpose_item<false>(a.w_up + (size_t)L * 64 * 384, 64, 384, (bf16_t*)(wl + W_WUPT), nullptr, scr, r, 12, lane); continue; } r -= I_UP;
        transpose_item<false>(a.a_up + (size_t)L * 64 * 384, 64, 384, (bf16_t*)(wl + W_AUPT), nullptr, scr, r, 12, lane);
    }
}

__device__ __forceinline__ void sincos_d(float ang, float& c, float& s) {
    const double a = (double)ang; const double n = rint(a * 0.63661977236758134308);
    double r = fma(-n, 1.57079632679489655800e+00, a); r = fma(-n, 6.12323399573676603587e-17, r);
    const double r2 = r * r;
    double sp = r2 * (1.0 / 6227020800.0) - 1.0 / 39916800.0; sp = sp * r2 + 1.0 / 362880.0; sp = sp * r2 - 1.0 / 5040.0; sp = sp * r2 + 1.0 / 120.0; sp = sp * r2 - 1.0 / 6.0; sp = sp * r2 * r + r;
    double cp = r2 * (1.0 / 479001600.0) - 1.0 / 3628800.0; cp = cp * r2 + 1.0 / 40320.0; cp = cp * r2 - 1.0 / 720.0; cp = cp * r2 + 1.0 / 24.0; cp = cp * r2 - 0.5; cp = cp * r2 + 1.0;
    const int q = ((int)n) & 3;
    const double sv = (q == 0) ? sp : (q == 1) ? cp : (q == 2) ? -sp : -cp;
    const double cv = (q == 0) ? cp : (q == 1) ? -sp : (q == 2) ? -cp : sp;
    c = (float)cv; s = (float)sv;
}
__device__ __forceinline__ void prep_tables(unsigned char* ws, int gtid, int nthreads) {
    const float inv8[8] = {1.0f, 0.1939227432012558f, 0.03760603070259094f, 0.007292664609849453f, 0.0014142135623842478f, 0.00027424818836152554f, 5.318296098266728e-05f, 1.0313386155758053e-05f};
    float* t16 = (float*)(ws + WS_TAB16); float* tI = (float*)(ws + WS_TABI);
    for (int e = gtid; e < SEQ * 8; e += nthreads) { const int pos = e >> 3, i = e & 7;
        float iv = inv8[0];
#pragma unroll
        for (int j = 1; j < 8; ++j) iv = (i == j) ? inv8[j] : iv;
        float c, s; sincos_d((float)pos * iv, c, s); t16[pos * 16 + i] = c; t16[pos * 16 + 8 + i] = s;
        if ((i & 1) == 0) { const int i4 = i >> 1; tI[pos * 8 + i4] = c; tI[pos * 8 + 4 + i4] = s; }
    }
}
__device__ __forceinline__ void x_row_to_bf16(const float* xrow, bf16_t* orow, float* ssq, int lane) {
    const f32x4* xr = (const f32x4*)xrow + lane;
    unsigned long long* o8 = (unsigned long long*)orow + lane;
#pragma unroll
    for (int j = 0; j < 4; ++j) { const f32x4 v = xr[64 * j];
        float s = (v.x * v.x + v.y * v.y) + (v.z * v.z + v.w * v.w);
        o8[64 * j] = (unsigned long long)pk2(v.x, v.y) | ((unsigned long long)pk2(v.z, v.w) << 32);
        s += __shfl_xor(s, 1); s += __shfl_xor(s, 2); s += __shfl_xor(s, 4); s += __shfl_xor(s, 8);
        if ((lane & 15) == 0) ssq[4 * j + (lane >> 4)] = s; }
}
__device__ __forceinline__ float row_rstd(const float* ssq_row) {
    const f32x4 a = *(const f32x4*)ssq_row, b = *(const f32x4*)(ssq_row + 4), c = *(const f32x4*)(ssq_row + 8), d = *(const f32x4*)(ssq_row + 12);
    const float s = ((a.x + a.y) + (a.z + a.w)) + ((b.x + b.y) + (b.z + b.w)) + ((c.x + c.y) + (c.z + c.w)) + ((d.x + d.y) + (d.z + d.w));
    return __builtin_amdgcn_rsqf(s * (1.0f / DM) + NORM_EPS);
}
namespace epi {
using pg8::Unit; using pg8::BM; using pg8::HALF;
__device__ __forceinline__ u32x4 pack8(const f32x4& a, const f32x4& b) { u32x4 w; w.x = pg8::cvt_pk_bf16(a[0], a[1]); w.y = pg8::cvt_pk_bf16(a[2], a[3]); w.z = pg8::cvt_pk_bf16(b[0], b[1]); w.w = pg8::cvt_pk_bf16(b[2], b[3]); return w; }
__device__ __forceinline__ int rope_class(int c0, int& fb) {
    fb = 0; int o;
    if (c0 >= ZB_Q && c0 < ZB_V) { o = (c0 - ZB_Q) & 63; if (o < 16) { fb = o >> 1; return 1; } return 0; }
    if (c0 >= ZB_IQ && c0 < ZB_IW) { o = (c0 - ZB_IQ) & 31; return o == 0 ? 2 : 0; }
    if (c0 >= ZC_Q && c0 < ZC_V) { o = (c0 - ZC_Q) & 63; if (o < 16) { fb = o >> 1; return 1; } return 0; }
    return 0;
}
struct EpiInProj {
    static constexpr bool PERM = true, AFTER_DRAIN = false;
    bf16_t* Z; const float* ssq; const float* tab16; const float* tabI; bf16_t* KV; bf16_t* IKC;
    __device__ __forceinline__ void operator()(const f32x4 (&acc)[2][2][4][2], const Unit& u, int wr, int wc, int fr, int fq) const {
        const int row0 = u.pm * BM + wr * 64 + fr;
        const int c00 = u.pn * BM + wc * 32 + 8 * fq, c01 = c00 + HALF;
        int fb0, fb1; const int rc0 = rope_class(c00, fb0), rc1 = rope_class(c01, fb1);
#pragma unroll
        for (int ai = 0; ai < 2; ++ai)
#pragma unroll
            for (int m = 0; m < 4; ++m) {
                const int row = row0 + ai * HALF + m * 16;
                const float rs = row_rstd(ssq + (size_t)row * 16);
                const int pos = row & (SEQ - 1);
#pragma unroll
                for (int bj = 0; bj < 2; ++bj) {
                    const int c0 = bj ? c01 : c00, rc = bj ? rc1 : rc0, fb = bj ? fb1 : fb0;
                    if (c0 >= ZP) continue;
                    f32x4 v0 = acc[ai][bj][m][0] * rs, v1 = acc[ai][bj][m][1] * rs;
                    if (rc) {
                        const float* tp = (rc == 1) ? tab16 + pos * 16 + fb : tabI + pos * 8;
                        const f32x4 c = *(const f32x4*)tp, s = *(const f32x4*)(tp + (rc == 1 ? 8 : 4));
                        f32x4 a0, a1;
                        a0[0] = v0[0] * c[0] - v0[1] * s[0]; a0[1] = v0[1] * c[0] + v0[0] * s[0];
                        a0[2] = v0[2] * c[1] - v0[3] * s[1]; a0[3] = v0[3] * c[1] + v0[2] * s[1];
                        a1[0] = v1[0] * c[2] - v1[1] * s[2]; a1[1] = v1[1] * c[2] + v1[0] * s[2];
                        a1[2] = v1[2] * c[3] - v1[3] * s[3]; a1[3] = v1[3] * c[3] + v1[2] * s[3];
                        v0 = a0; v1 = a1;
                    }
                    const u32x4 pk = pack8(v0, v1);
                    if (c0 >= ZB_K && c0 < ZB_IQ) *(u32x4*)(KV + (size_t)row * 128 + (c0 - ZB_K)) = pk;
                    else if (c0 >= ZB_IK && c0 < ZB_IW) *(u32x4*)(IKC + (size_t)row * 32 + (c0 - ZB_IK)) = pk;
                    else *(u32x4*)(Z + (size_t)row * ZP + c0) = pk;
                }
                asm volatile("" ::: "memory");
            }
    }
};
struct EpiPlainZ {
    static constexpr bool PERM = true, AFTER_DRAIN = false;
    bf16_t* Z;
    __device__ __forceinline__ void operator()(const f32x4 (&acc)[2][2][4][2], const Unit& u, int wr, int wc, int fr, int fq) const {
        const int row0 = u.pm * BM + wr * 64 + fr;
#pragma unroll
        for (int ai = 0; ai < 2; ++ai)
#pragma unroll
            for (int m = 0; m < 4; ++m)
#pragma unroll
                for (int bj = 0; bj < 2; ++bj) { const int c0 = u.pn * BM + bj * HALF + wc * 32 + 8 * fq; if (c0 < ZP) *(u32x4*)(Z + (size_t)(row0 + ai * HALF + m * 16) * ZP + c0) = pack8(acc[ai][bj][m][0], acc[ai][bj][m][1]); }
    }
};
struct EpiOutProj {
    static constexpr bool PERM = true, AFTER_DRAIN = false;
    bf16_t* xb; float* ssq_out;
    __device__ __forceinline__ void operator()(const f32x4 (&acc)[2][2][4][2], const Unit& u, int wr, int wc, int fr, int fq) const {
        const int row0 = u.pm * BM + wr * 64 + fr;
#pragma unroll
        for (int ai = 0; ai < 2; ++ai)
#pragma unroll
            for (int m = 0; m < 4; ++m) {
                const int row = row0 + ai * HALF + m * 16; float sq = 0.f;
#pragma unroll
                for (int bj = 0; bj < 2; ++bj) {
                    const size_t off = (size_t)row * DM + u.pn * BM + bj * HALF + wc * 32 + 8 * fq;
                    const u32x4 iw = *(const u32x4*)(xb + off); const f32x4 ia = {bflo(iw.x), bfhi(iw.x), bflo(iw.y), bfhi(iw.y)}, ib = {bflo(iw.z), bfhi(iw.z), bflo(iw.w), bfhi(iw.w)};
                    const f32x4 x0 = ia + acc[ai][bj][m][0], x1 = ib + acc[ai][bj][m][1];
                    *(u32x4*)(xb + off) = pack8(x0, x1);
                    sq += ((x0[0] * x0[0] + x0[1] * x0[1]) + (x0[2] * x0[2] + x0[3] * x0[3])) + ((x1[0] * x1[0] + x1[1] * x1[1]) + (x1[2] * x1[2] + x1[3] * x1[3]));
                }
                sq += __shfl_xor(sq, 16); sq += __shfl_xor(sq, 32);
                if (fq == 0) ssq_out[(size_t)row * 16 + u.pn * 4 + wc] = sq;
            }
    }
};
struct EpiGate {
    static constexpr bool PERM = true, AFTER_DRAIN = false;
    const bf16_t* x1b; const bf16_t* pp; bf16_t* xb; const float* ssq_in; float* ssq_out;
    __device__ __forceinline__ void operator()(const f32x4 (&acc)[2][2][4][2], const Unit& u, int wr, int wc, int fr, int fq) const {
        const int row0 = u.pm * BM + wr * 64 + fr;
#pragma unroll
        for (int ai = 0; ai < 2; ++ai)
#pragma unroll
            for (int m = 0; m < 4; ++m) {
                const int row = row0 + ai * HALF + m * 16; float sq = 0.f;
                const float rs = row_rstd(ssq_in + (size_t)row * 16);
#pragma unroll
                for (int bj = 0; bj < 2; ++bj) {
                    const size_t off = (size_t)row * DM + u.pn * BM + bj * HALF + wc * 32 + 8 * fq;
                    f32x4 g0 = acc[ai][bj][m][0] * rs, g1 = acc[ai][bj][m][1] * rs;
#pragma unroll
                    for (int i = 0; i < 4; ++i) { g0[i] = sigmoidf_(g0[i]); g1[i] = sigmoidf_(g1[i]); }
                    const u32x4 pw = *(const u32x4*)(pp + off); const f32x4 pp0 = {bflo(pw.x), bfhi(pw.x), bflo(pw.y), bfhi(pw.y)}, pp1 = {bflo(pw.z), bfhi(pw.z), bflo(pw.w), bfhi(pw.w)};
                    const u32x4 xw = *(const u32x4*)(x1b + off); const f32x4 xa = {bflo(xw.x), bfhi(xw.x), bflo(xw.y), bfhi(xw.y)}, xc = {bflo(xw.z), bfhi(xw.z), bflo(xw.w), bfhi(xw.w)};
                    const f32x4 x0 = xa + g0 * pp0, x1 = xc + g1 * pp1;
                    *(u32x4*)(xb + off) = pack8(x0, x1);
                    sq += ((x0[0] * x0[0] + x0[1] * x0[1]) + (x0[2] * x0[2] + x0[3] * x0[3])) + ((x1[0] * x1[0] + x1[1] * x1[1]) + (x1[2] * x1[2] + x1[3] * x1[3]));
                }
                sq += __shfl_xor(sq, 16); sq += __shfl_xor(sq, 32);
                if (fq == 0) ssq_out[(size_t)row * 16 + u.pn * 4 + wc] = sq;
            }
    }
};
struct EpiBf16Plain {
    static constexpr bool PERM = true, AFTER_DRAIN = false;
    bf16_t* C;
    __device__ __forceinline__ void operator()(const f32x4 (&acc)[2][2][4][2], const Unit& u, int wr, int wc, int fr, int fq) const {
        const int row0 = u.pm * BM + wr * 64 + fr;
#pragma unroll
        for (int ai = 0; ai < 2; ++ai)
#pragma unroll
            for (int m = 0; m < 4; ++m)
#pragma unroll
                for (int bj = 0; bj < 2; ++bj) {
                    const size_t off = (size_t)(row0 + ai * HALF + m * 16) * DM + u.pn * BM + bj * HALF + wc * 32 + 8 * fq;
                    *(u32x4*)(C + off) = pack8(acc[ai][bj][m][0], acc[ai][bj][m][1]);
                }
    }
};
struct EpiF32 {
    static constexpr bool PERM = true, AFTER_DRAIN = false;
    float* C;
    __device__ __forceinline__ void operator()(const f32x4 (&acc)[2][2][4][2], const Unit& u, int wr, int wc, int fr, int fq) const {
        const int row0 = u.pm * BM + wr * 64 + fr;
#pragma unroll
        for (int ai = 0; ai < 2; ++ai)
#pragma unroll
            for (int m = 0; m < 4; ++m)
#pragma unroll
                for (int bj = 0; bj < 2; ++bj) {
                    const size_t off = (size_t)(row0 + ai * HALF + m * 16) * DM + u.pn * BM + bj * HALF + wc * 32 + 8 * fq;
                    *(f32x4*)(C + off) = acc[ai][bj][m][0]; *(f32x4*)(C + off + 4) = acc[ai][bj][m][1];
                }
    }
};
}
typedef GAS unsigned gu32;
#define RLX_AGENT __ATOMIC_RELAXED, __HIP_MEMORY_SCOPE_AGENT
#define XB_TMO      128
#define XB_XCNT(j)  (256  + 64 * (j))
#define XB_XSUB(j)  (1280 + 64 * (j))
#define XB_XGEN(j)  (2304 + 64 * (j))
#define XB_TOP      3328
#define XB_TOPGEN   3392
#define XCD_BAR_WORDS 3456
#define XB_SPIN_CAP (1u << 27)

__device__ __forceinline__ unsigned xb_ld(unsigned* p)              { return __hip_atomic_load(p, __ATOMIC_RELAXED, __HIP_MEMORY_SCOPE_AGENT); }
__device__ __forceinline__ unsigned xb_add(unsigned* p, unsigned v) { return __hip_atomic_fetch_add(p, v, __ATOMIC_RELAXED, __HIP_MEMORY_SCOPE_AGENT); }
__device__ __forceinline__ unsigned xb_xcc_id() { return (unsigned)__builtin_amdgcn_s_getreg((3 << 11) | 20) & 0xFu; }
#define XB_SPIN(cond, bar) do { unsigned _sp = 0; while (cond) { __builtin_amdgcn_s_sleep(1); \
    if ((++_sp & 255u) == 0u) { if (xb_ld(&(bar)[XB_TMO])) break; if (_sp > XB_SPIN_CAP) { atomicAdd(&(bar)[XB_TMO], 1u); break; } } } } while (0)

struct XcdBarrier {
    unsigned* bar; unsigned x;
    volatile LAS unsigned* st;
};

__device__ __forceinline__ XcdBarrier xcd_barrier_post(unsigned* bar, volatile LAS unsigned* st) {
    XcdBarrier b; b.bar = bar; b.x = xb_xcc_id(); b.st = st;
    if (threadIdx.x == 0) (void)xb_add(&bar[XB_XCNT(b.x)], 1u);
    return b;
}
__device__ __forceinline__ void xcd_barrier_complete(unsigned* bar, unsigned x, unsigned& nloc, unsigned& nx) {
    const unsigned G = gridDim.x * gridDim.y * gridDim.z;
    unsigned sum, cnt, mine, sp = 0u;
    for (;;) {
        sum = 0u; cnt = 0u; mine = 0u;
#pragma unroll
        for (unsigned j = 0; j < 16; ++j) { const unsigned c = xb_ld(&bar[XB_XCNT(j)]); sum += c; cnt += (c > 0u) ? 1u : 0u; mine = (j == x) ? c : mine; }
        if (sum == G) break;
        __builtin_amdgcn_s_sleep(1);
        if ((++sp & 255u) == 0u) { if (xb_ld(&bar[XB_TMO])) break; if (sp > XB_SPIN_CAP) { atomicAdd(&bar[XB_TMO], 1u); break; } }
    }
    nloc = mine > 0u ? mine : 1u; nx = cnt > 0u ? cnt : 1u;
}

__device__ __forceinline__ void xcd_barrier(const XcdBarrier& b) {
    asm volatile("s_waitcnt vmcnt(0)" ::: "memory");
    __syncthreads();
    if (threadIdx.x == 0) {
        unsigned* bar = b.bar;
        __builtin_amdgcn_s_waitcnt(0);
        unsigned nloc = b.st[0], nx = b.st[1];
        if (nloc == 0u) { xcd_barrier_complete(bar, b.x, nloc, nx); b.st[0] = nloc; b.st[1] = nx; }
        const unsigned old = xb_add(&bar[XB_XSUB(b.x)], 1u);
        const unsigned gen = old / nloc;
        if (old + 1u == (gen + 1u) * nloc) {
            __builtin_amdgcn_fence(__ATOMIC_RELEASE, "agent");
            asm volatile("s_waitcnt vmcnt(0)" ::: "memory");
            const unsigned og = xb_add(&bar[XB_TOP], 1u);
            const unsigned tg = og / nx;
            if (og + 1u == (tg + 1u) * nx) xb_add(&bar[XB_TOPGEN], 1u);
            else XB_SPIN(xb_ld(&bar[XB_TOPGEN]) == tg, bar);
            __builtin_amdgcn_fence(__ATOMIC_ACQUIRE, "agent");
            xb_add(&bar[XB_XGEN(b.x)], 1u);
            asm volatile("s_waitcnt vmcnt(0)" ::: "memory");
        } else {
            XB_SPIN(xb_ld(&bar[XB_XGEN(b.x)]) == gen, bar);
            __builtin_amdgcn_fence(__ATOMIC_ACQUIRE, "agent");
            asm volatile("s_waitcnt vmcnt(0)" ::: "memory");
        }
    }
    __syncthreads();
}
struct MixArgs { const bf16_t* Z; bf16_t* Y; const bf16_t* KV; const bf16_t* IKC; const float* mu; const float* w0; const float* w_up; const float* a0; const float* a_up; const float* k_k; const float* k_a; const float* r_k; const float* ln_g; const float* ln_b; };
namespace dsa {
#ifdef PROBE_T
#define DTS ((volatile LAS unsigned long long*)((LAS unsigned char*)ldsb + 131072 + 1024))
#define DSTAMP_B(id) do { if ((id) == PROBE_T && blockIdx.x == 0 && threadIdx.x == 0) DTS[0] = __builtin_amdgcn_s_memrealtime(); } while (0)
#define DSTAMP_E(id) do { if ((id) == PROBE_T && blockIdx.x == 0 && threadIdx.x == 0) DTS[1] += __builtin_amdgcn_s_memrealtime() - DTS[0]; } while (0)
#else
#define DSTAMP_B(id) do {} while (0)
#define DSTAMP_E(id) do {} while (0)
#endif
#define MFMA32(a, b, c) __builtin_amdgcn_mfma_f32_32x32x16_bf16((a), (b), (c), 0, 0, 0)
typedef short v4i16_t __attribute__((ext_vector_type(4)));
typedef short s16x4 __attribute__((ext_vector_type(4)));
constexpr int WAVE_LDS = 2048 + 4096;
constexpr int IKS_OFF = 8 * WAVE_LDS, IKS_BYTES = 65536;
__device__ __forceinline__ unsigned fkey(float f) { const unsigned b = __builtin_bit_cast(unsigned, f); return (b & 0x80000000u) ? ~b : (b | 0x80000000u); }
__device__ __forceinline__ float keyf(unsigned u) { const unsigned b = (u & 0x80000000u) ? (u & 0x7fffffffu) : ~u; return __builtin_bit_cast(float, b); }
__device__ __forceinline__ float relu_(float x) { const int b = __builtin_bit_cast(int, x); return __builtin_bit_cast(float, b > 0 ? b : 0); }
__device__ __forceinline__ s16x4 vtr(const LAS unsigned char* p) { return __builtin_bit_cast(s16x4, __builtin_amdgcn_ds_read_tr16_b64_v4i16((LAS v4i16_t*)p)); }

#define DPP_(v, ctrl) ((unsigned)__builtin_amdgcn_update_dpp((int)(v), (int)(v), (ctrl), 0xf, 0xf, false))
__device__ __forceinline__ unsigned half_min(unsigned v) { v = min(v, DPP_(v, 0xB1)); v = min(v, DPP_(v, 0x4E)); v = min(v, DPP_(v, 0x141)); v = min(v, DPP_(v, 0x140)); return min(v, (unsigned)__builtin_amdgcn_ds_swizzle((int)v, 0x401F)); }
__device__ __forceinline__ unsigned half_max(unsigned v) { v = max(v, DPP_(v, 0xB1)); v = max(v, DPP_(v, 0x4E)); v = max(v, DPP_(v, 0x141)); v = max(v, DPP_(v, 0x140)); return max(v, (unsigned)__builtin_amdgcn_ds_swizzle((int)v, 0x401F)); }
__device__ __forceinline__ int half_sum(int v) { v += (int)DPP_(v, 0xB1); v += (int)DPP_(v, 0x4E); v += (int)DPP_(v, 0x141); v += (int)DPP_(v, 0x140); return v + __builtin_amdgcn_ds_swizzle(v, 0x401F); }
__device__ __forceinline__ unsigned next_pivot(unsigned ulo, unsigned uhi, int clo, int chi, int it) {
    unsigned p;
    const bool hl = clo >= 0, hh = chi >= 0;
    if (it == 0) p = fkey(0.0f);
    else if (!hh) { const float f = keyf(ulo); p = fkey(f >= 0.f ? 2.f * f + 0.25f : 0.5f * f + 0.125f); }
    else if (!hl) { const float f = keyf(uhi); p = fkey(f <= 0.f ? 2.f * f - 0.25f : 0.5f * f - 0.125f); }
    else { const float fl = keyf(ulo), fh = keyf(uhi);
        float fr = ((float)(clo - 256) + 0.5f) * __builtin_amdgcn_rcpf((float)(clo - chi)); fr = fminf(fmaxf(fr, 1.f / 32.f), 31.f / 32.f);
        if (it % 3 == 2) fr = 0.5f;
        p = fkey(fl + (fh - fl) * fr); }
    if (!(p > ulo && p < uhi)) p = ulo + ((uhi - ulo) >> 1);
    return p;
}

__device__ __forceinline__ void dsa_unit(const MixArgs& a, unsigned char* ldsb, int b, int blk) {
    const int tid = opaque_tid(), lane = tid & 63, wave = __builtin_amdgcn_readfirstlane(tid >> 6), r32 = lane & 31, hi = lane >> 5;
    const GAS bf16_t* zb = (const GAS bf16_t*)a.Z + (size_t)b * SEQ * ZP;
    LAS unsigned char* wl = (LAS unsigned char*)ldsb + wave * WAVE_LDS;
    LAS unsigned* bm = (LAS unsigned*)wl;
    LAS unsigned char* vimg = wl + 2048;
    const int tw = blk * 64 + 8 * wave;
    f32x16 zero16;
#pragma unroll
    for (int i = 0; i < 16; ++i) zero16[i] = 0.f;
#ifdef PROBE_SEL
#define NRND 4
#else
#define NRND 2
#endif
#pragma unroll 1
    for (int rnd_ = 0; rnd_ < NRND; ++rnd_) { const int rnd = rnd_ & 1;
        const int tb = tw + 4 * rnd;
        const int qsub = 2 * ((r32 >> 2) & 1) + (r32 >> 4), head = (r32 & 3) + 4 * ((r32 >> 3) & 1);
        const GAS bf16_t* iqp = zb + (size_t)(tb + qsub) * ZP + ZB_IQ + head * 32 + 8 * hi;
        bf16x8 aiq0, aiq1;
        { const u32x4 r0 = *(const GAS u32x4*)iqp, r1 = *(const GAS u32x4*)(iqp + 16); const float wr = bf2f(zb[(size_t)(tb + qsub) * ZP + ZB_IW + head]);
          u32x4 s0, s1;
          s0.x = pk2(bflo(r0.x) * wr, bfhi(r0.x) * wr); s0.y = pk2(bflo(r0.y) * wr, bfhi(r0.y) * wr); s0.z = pk2(bflo(r0.z) * wr, bfhi(r0.z) * wr); s0.w = pk2(bflo(r0.w) * wr, bfhi(r0.w) * wr);
          s1.x = pk2(bflo(r1.x) * wr, bfhi(r1.x) * wr); s1.y = pk2(bflo(r1.y) * wr, bfhi(r1.y) * wr); s1.z = pk2(bflo(r1.z) * wr, bfhi(r1.z) * wr); s1.w = pk2(bflo(r1.w) * wr, bfhi(r1.w) * wr);
          aiq0 = __builtin_bit_cast(bf16x8, s0); aiq1 = __builtin_bit_cast(bf16x8, s1); }
        const int tqA = tb + 2 * hi, tqB = tqA + 1;
        float wA[8], wB[8];
        { const u32x4 ua = *(const GAS u32x4*)(zb + (size_t)tqA * ZP + ZB_IW), ub = *(const GAS u32x4*)(zb + (size_t)tqB * ZP + ZB_IW);
          wA[0] = bflo(ua.x); wA[1] = bfhi(ua.x); wA[2] = bflo(ua.y); wA[3] = bfhi(ua.y); wA[4] = bflo(ua.z); wA[5] = bfhi(ua.z); wA[6] = bflo(ua.w); wA[7] = bfhi(ua.w);
          wB[0] = bflo(ub.x); wB[1] = bfhi(ub.x); wB[2] = bflo(ub.y); wB[3] = bfhi(ub.y); wB[4] = bflo(ub.z); wB[5] = bfhi(ub.z); wB[6] = bflo(ub.w); wB[7] = bfhi(ub.w); }
#pragma unroll
        for (int r = 0; r < 8; ++r) { wA[r] = (wA[r] > 0.f) ? INFINITY : -INFINITY; wB[r] = (wB[r] > 0.f) ? INFINITY : -INFINITY; }
        unsigned scA[64], scB[64];
        const int dA = tqA - 32 * ((tb + 3) >> 5);
        const int Tmax = (tb + 3) >> 5;
        int Tm_s = Tmax, Tm_b = Tmax; asm volatile("" : "+s"(Tm_s), "+s"(Tm_b));
        DSTAMP_B(30);
        const int TmaxU = 2 * blk + 1;
        const int fsw = (r32 >> 2) & 3;
        const LAS unsigned char* ikl = (const LAS unsigned char*)ldsb + IKS_OFF + r32 * 64;
        const int off0 = (hi ^ fsw) * 16, off1 = ((2 + hi) ^ fsw) * 16;
#ifdef PROBE_SCORE
        for (int rep_ = 0; rep_ < 2; ++rep_)
#endif
#pragma unroll
        for (int half = 0; half < 2; ++half) {
            if (32 * half <= TmaxU) {
                __syncthreads();
                { const int nkeys = min(32 * (TmaxU + 1) - 1024 * half, 1024);
                  const GAS bf16_t* src = (const GAS bf16_t*)a.IKC + ((size_t)b * SEQ + 1024 * half) * 32;
                  for (int ch = tid; ch < nkeys * 4; ch += 512) { const int key = ch >> 2, c4 = ch & 3;
                      *(LAS u32x4*)((LAS unsigned char*)ldsb + IKS_OFF + key * 64 + ((c4 ^ ((key >> 2) & 3)) * 16)) = *(const GAS u32x4*)(src + key * 32 + c4 * 8); } }
                asm volatile("s_waitcnt vmcnt(0) lgkmcnt(0)" ::: "memory");
                __syncthreads();
                bf16x8 kb0[2], kb1[2];
#pragma unroll
                for (int i = 0; i < 2; ++i) { if (32 * half + i <= Tm_s) { kb0[i] = *(const LAS bf16x8*)(ikl + i * 2048 + off0); kb1[i] = *(const LAS bf16x8*)(ikl + i * 2048 + off1); } }
#pragma unroll
                for (int i = 0; i < 32; ++i) { const int T = 32 * half + i;
                    if (T <= Tm_s) {
                        f32x16 c = MFMA32(aiq0, kb0[i & 1], zero16); c = MFMA32(aiq1, kb1[i & 1], c);
                        if (i + 2 < 32 && T + 2 <= Tm_s) { kb0[i & 1] = *(const LAS bf16x8*)(ikl + (i + 2) * 2048 + off0); kb1[i & 1] = *(const LAS bf16x8*)(ikl + (i + 2) * 2048 + off1); }
                        float sA = 0.f, sB = 0.f;
#pragma unroll
                        for (int r = 0; r < 8; ++r) { sA += __builtin_amdgcn_fmed3f(c[r], 0.f, wA[r]); sB += __builtin_amdgcn_fmed3f(c[8 + r], 0.f, wB[r]); }
                        const bool last = (T == Tm_s);
                        scA[T] = (!last || r32 <= dA) ? fkey(sA + 0.f) : 0u; scB[T] = (!last || r32 <= dA + 1) ? fkey(sB + 0.f) : 0u;
                    } else { scA[T] = 0u; scB[T] = 0u; }
                }
            } else {
#pragma unroll
                for (int i = 0; i < 32; ++i) { scA[32 * half + i] = 0u; scB[32 * half + i] = 0u; }
            }
        }
        DSTAMP_E(30); DSTAMP_B(31);
        const int nA = tqA + 1, nB = tqB + 1;
        unsigned uloA = 1u, uhiA = 0xffffffffu, uloB = 1u, uhiB = 0xffffffffu; int cloA = -1, chiA = -1, cloB = -1, chiB = -1;
        bool doneA = nA <= 256, doneB = nB <= 256;
        unsigned thA = 1u, thB = 1u; int needA = 0, needB = 0;
        int itn = 0, lim = 128;
        constexpr int CAP = 12;
        LAS unsigned* lstA = (LAS unsigned*)((LAS unsigned char*)ldsb + IKS_OFF + wave * 8192) + lane * (CAP + 1), *lstB = lstA + 64 * (CAP + 1);
        unsigned ca_[CAP], cb_[CAP];
        for (;;) {
            DSTAMP_B(34);
            for (; itn < 200; ++itn) {
                if (!doneA && uhiA - uloA <= 1u) { thA = uhiA; needA = 256 - max(chiA, 0); doneA = true; }
                if (!doneB && uhiB - uloB <= 1u) { thB = uhiB; needB = 256 - max(chiB, 0); doneB = true; }
                const bool actA = !doneA && ((cloA < 0 ? nA : cloA) - max(chiA, 0) > lim), actB = !doneB && ((cloB < 0 ? nB : cloB) - max(chiB, 0) > lim);
                if (!__any(actA || actB)) break;
                const unsigned pA = actA ? next_pivot(uloA, uhiA, cloA, chiA, itn) : 0xffffffffu, pB = actB ? next_pivot(uloB, uhiB, cloB, chiB, itn) : 0xffffffffu;
                int ca = 0, cb = 0;
#pragma unroll
                for (int T = 0; T < 64; ++T)
                    asm("v_cmp_ge_u32 vcc, %2, %3\n\tv_addc_co_u32 %0, vcc, 0, %0, vcc\n\tv_cmp_ge_u32 vcc, %4, %5\n\tv_addc_co_u32 %1, vcc, 0, %1, vcc" : "+v"(ca), "+v"(cb) : "v"(scA[T]), "v"(pA), "v"(scB[T]), "v"(pB) : "vcc");
                const int pk = half_sum(ca | (cb << 16));
                ca = pk & 0xffff; cb = pk >> 16;
                if (actA) { if (ca == 256) { thA = pA; needA = 0; doneA = true; } else if (ca > 256) { uloA = pA; cloA = ca; } else { uhiA = pA; chiA = ca; } }
                if (actB) { if (cb == 256) { thB = pB; needB = 0; doneB = true; } else if (cb > 256) { uloB = pB; cloB = cb; } else { uhiB = pB; chiB = cb; } }
            }
            DSTAMP_E(34);
            if (!__any(!doneA || !doneB)) break;
            DSTAMP_B(35);
            const unsigned wA_ = doneA ? 0u : uhiA - uloA, wB_ = doneB ? 0u : uhiB - uloB;
            int nA_ = 0, nB_ = 0;
#pragma unroll
            for (int T = 0; T < 64; ++T) {
                lstA[min(nA_, CAP)] = scA[T]; lstB[min(nB_, CAP)] = scB[T];
                nA_ += ((scA[T] - uloA) < wA_) ? 1 : 0; nB_ += ((scB[T] - uloB) < wB_) ? 1 : 0;
            }
            asm volatile("s_waitcnt lgkmcnt(0)" ::: "memory");
            if (__any(nA_ > CAP || nB_ > CAP) && itn < 200) { lim >>= 1; continue; }
#pragma unroll
            for (int j = 0; j < CAP; ++j) { ca_[j] = (j < nA_) ? lstA[j] : 0u; cb_[j] = (j < nB_) ? lstB[j] : 0u; }
            DSTAMP_E(35);
            break;
        }
        if (__any(!doneA || !doneB)) {
            DSTAMP_B(36);
            const int baseA = max(chiA, 0), baseB = max(chiB, 0);
            for (; itn < 400; ++itn) {
                unsigned mnA = 0xffffffffu, mxA = 0u, mnB = 0xffffffffu, mxB = 0u;
                const unsigned wa = doneA ? 0u : uhiA - uloA, wb = doneB ? 0u : uhiB - uloB;
#pragma unroll
                for (int j = 0; j < CAP; ++j) { if ((ca_[j] - uloA) < wa) { mnA = min(mnA, ca_[j]); mxA = max(mxA, ca_[j]); } if ((cb_[j] - uloB) < wb) { mnB = min(mnB, cb_[j]); mxB = max(mxB, cb_[j]); } }
                mnA = half_min(mnA); mxA = half_max(mxA); mnB = half_min(mnB); mxB = half_max(mxB);
                if (!doneA) { if (mnA >= mxA) { thA = mxA + 1u; needA = 256 - max(chiA, 0); doneA = true; } else { uloA = mnA; uhiA = mxA + 1u; if (cloA < 0) cloA = nA; if (chiA < 0) chiA = 0; } }
                if (!doneB) { if (mnB >= mxB) { thB = mxB + 1u; needB = 256 - max(chiB, 0); doneB = true; } else { uloB = mnB; uhiB = mxB + 1u; if (cloB < 0) cloB = nB; if (chiB < 0) chiB = 0; } }
                if (!__any(!doneA || !doneB)) break;
                const unsigned pA = doneA ? 0xffffffffu : next_pivot(uloA, uhiA, cloA, chiA, itn | 1), pB = doneB ? 0xffffffffu : next_pivot(uloB, uhiB, cloB, chiB, itn | 1);
                int pk = 0;
#pragma unroll
                for (int j = 0; j < CAP; ++j) pk += ((ca_[j] >= pA) ? 1 : 0) + ((cb_[j] >= pB) ? 0x10000 : 0);
                pk = half_sum(pk);
                const int ca = baseA + (pk & 0xffff), cb = baseB + (pk >> 16);
                if (!doneA) { if (ca == 256) { thA = pA; needA = 0; doneA = true; } else if (ca > 256) { uloA = pA; cloA = ca; } else { uhiA = pA; chiA = ca; } }
                if (!doneB) { if (cb == 256) { thB = pB; needB = 0; doneB = true; } else if (cb > 256) { uloB = pB; cloB = cb; } else { uhiB = pB; chiB = cb; } }
            }
            DSTAMP_E(36);
        }
        DSTAMP_E(31); DSTAMP_B(32);
        int rem0 = __builtin_amdgcn_readlane(needA, 0), rem1 = __builtin_amdgcn_readlane(needB, 0), rem2 = __builtin_amdgcn_readlane(needA, 32), rem3 = __builtin_amdgcn_readlane(needB, 32);
        const bool anytie = (rem0 | rem1 | rem2 | rem3) != 0;
        LAS unsigned* bmr = bm + 4 * rnd; asm volatile("" : "+v"(bmr));
#pragma unroll
        for (int T = 0; T < 64; ++T) {
            if (T <= Tm_b) {
                const unsigned long long mA = __ballot(scA[T] >= thA), mB = __ballot(scB[T] >= thB);
                unsigned m0 = (unsigned)mA, m2 = (unsigned)(mA >> 32), m1 = (unsigned)mB, m3 = (unsigned)(mB >> 32);
                if (anytie) {
                    const unsigned long long eA = __ballot(scA[T] == thA - 1u), eB = __ballot(scB[T] == thB - 1u);
                    unsigned e0 = (unsigned)eA, e2 = (unsigned)(eA >> 32), e1 = (unsigned)eB, e3 = (unsigned)(eB >> 32);
                    while (rem0 > 0 && e0) { const unsigned bit = e0 & (0u - e0); m0 |= bit; e0 ^= bit; --rem0; }
                    while (rem1 > 0 && e1) { const unsigned bit = e1 & (0u - e1); m1 |= bit; e1 ^= bit; --rem1; }
                    while (rem2 > 0 && e2) { const unsigned bit = e2 & (0u - e2); m2 |= bit; e2 ^= bit; --rem2; }
                    while (rem3 > 0 && e3) { const unsigned bit = e3 & (0u - e3); m3 |= bit; e3 ^= bit; --rem3; }
                }
                if (lane == 0) { u32x4 w; w.x = m0; w.y = m1; w.z = m2; w.w = m3; *(LAS u32x4*)(bmr + T * 8) = w; }
            }
        }
        DSTAMP_E(32);
    }
    DSTAMP_B(33);
    asm volatile("s_waitcnt lgkmcnt(0)" ::: "memory");
    const int qc = r32 >> 2, hc = r32 & 3;
    const GAS bf16_t* kvb = (const GAS bf16_t*)a.KV + (size_t)b * SEQ * 128;
    const size_t qrow = (size_t)(b * SEQ + tw + qc);
    bf16x8 bq[4];
#pragma unroll
    for (int s = 0; s < 4; ++s) bq[s] = *(const GAS bf16x8*)((const GAS bf16_t*)a.Z + qrow * ZP + ZB_Q + hc * 64 + 16 * s + 8 * hi);
    f32x16 o0 = zero16, o1 = zero16, lacc = zero16; float lsum = 0.f;
    const bf16x8 ones8 = {(short)0x3f80, (short)0x3f80, (short)0x3f80, (short)0x3f80, (short)0x3f80, (short)0x3f80, (short)0x3f80, (short)0x3f80};
    const int Tend = (tw + 7) >> 5;
    const int g16 = lane >> 4, i16 = lane & 15, q4 = i16 >> 2, p4 = i16 & 3;
    const int vrd = ((g16 >> 1) * 4 + q4) * 64 + (16 * (g16 & 1) + 4 * p4) * 2;
    const int vwr_key = lane >> 3, vwr_ch = lane & 7;
    u32x4 vst[4]; bf16x8 ak[4];
    auto load_tile = [&](int T) {
#pragma unroll
        for (int s = 0; s < 4; ++s) ak[s] = *(const GAS bf16x8*)(kvb + (size_t)(32 * T + r32) * 128 + 16 * s + 8 * hi);
#pragma unroll
        for (int i = 0; i < 4; ++i) vst[i] = *(const GAS u32x4*)(kvb + (size_t)(32 * T + vwr_key + 8 * i) * 128 + 64 + 8 * vwr_ch);
    };
#ifdef PROBE_ATT
    for (int rep_ = 0; rep_ < 2; ++rep_) { o0 = zero16; o1 = zero16; lacc = zero16; lsum = 0.f;
#endif
    load_tile(0);
#pragma unroll 1
    for (int T = 0; T <= Tend; ++T) {
#pragma unroll
        for (int i = 0; i < 4; ++i) *(LAS u32x4*)(vimg + (vwr_ch >> 2) * 2048 + (vwr_key + 8 * i) * 64 + (vwr_ch & 3) * 16) = vst[i];
        f32x16 sacc = MFMA32(ak[0], bq[0], zero16); sacc = MFMA32(ak[1], bq[1], sacc); sacc = MFMA32(ak[2], bq[2], sacc); sacc = MFMA32(ak[3], bq[3], sacc);
        const unsigned mw = bm[T * 8 + qc] >> (4 * hi);
        if (T < Tend) load_tile(T + 1);
        asm volatile("s_waitcnt lgkmcnt(0)" ::: "memory");
        s16x4 va[2][2][2];
#pragma unroll
        for (int dt = 0; dt < 2; ++dt)
#pragma unroll
            for (int s = 0; s < 2; ++s) { va[dt][s][0] = vtr(vimg + dt * 2048 + (16 * s) * 64 + vrd); va[dt][s][1] = vtr(vimg + dt * 2048 + (16 * s + 8) * 64 + vrd); }
        unsigned pw[8];
#pragma unroll
        for (int r = 0; r < 16; r += 2) {
            float m0, m1; asm("v_min_f32 %0, 0x42800000, %1" : "=v"(m0) : "v"(sacc[r])); asm("v_min_f32 %0, 0x42800000, %1" : "=v"(m1) : "v"(sacc[r + 1]));
            const unsigned pkw = pk2(__builtin_amdgcn_exp2f(m0), __builtin_amdgcn_exp2f(m1));
            const int c0 = (r & 3) + 8 * (r >> 2), c1 = ((r + 1) & 3) + 8 * ((r + 1) >> 2);
            const unsigned a_ = (unsigned)__builtin_amdgcn_sbfe((int)mw, c0, 1), b_ = (unsigned)__builtin_amdgcn_sbfe((int)mw, c1, 1);
            pw[r >> 1] = pkw & ((a_ & 0xffffu) | (b_ & 0xffff0000u));
        }
        asm volatile("s_waitcnt lgkmcnt(0)" ::: "memory");
#pragma unroll
        for (int s = 0; s < 2; ++s) {
            u32x4 pv4; pv4.x = pw[4 * s]; pv4.y = pw[4 * s + 1]; pv4.z = pw[4 * s + 2]; pv4.w = pw[4 * s + 3];
            const bf16x8 pb = __builtin_bit_cast(bf16x8, pv4);
            const bf16x8 v0 = __builtin_shufflevector(va[0][s][0], va[0][s][1], 0, 1, 2, 3, 4, 5, 6, 7), v1 = __builtin_shufflevector(va[1][s][0], va[1][s][1], 0, 1, 2, 3, 4, 5, 6, 7);
            o0 = MFMA32(v0, pb, o0); o1 = MFMA32(v1, pb, o1); lacc = MFMA32(ones8, pb, lacc);
        }
    }
#ifdef PROBE_ATT
    }
#endif
    DSTAMP_E(33);
    lsum = lacc[0];
    const float rl = 1.0f / lsum;
    const GAS bf16_t* gp = (const GAS bf16_t*)a.Z + qrow * ZP + ZB_G + hc * 64; GAS bf16_t* yp = (GAS bf16_t*)a.Y + qrow * DM + 384 + hc * 64;
#pragma unroll
    for (int dt = 0; dt < 2; ++dt)
#pragma unroll
        for (int i = 0; i < 4; ++i) {
            const int d = 32 * dt + 8 * i + 4 * hi;
            const u32x2 gw = *(const GAS u32x2*)(gp + d);
            const float g0 = bflo(gw.x), g1 = bfhi(gw.x), g2 = bflo(gw.y), g3 = bfhi(gw.y);
            const f32x16& o = dt ? o1 : o0;
            u32x2 w; w.x = pk2(o[4 * i] * rl * g0 * sigmoidf_(g0), o[4 * i + 1] * rl * g1 * sigmoidf_(g1)); w.y = pk2(o[4 * i + 2] * rl * g2 * sigmoidf_(g2), o[4 * i + 3] * rl * g3 * sigmoidf_(g3));
            *(GAS u32x2*)(yp + d) = w;
        }
}
}
namespace dil {
using dsa::vtr; using dsa::s16x4;
__device__ __forceinline__ void dil_unit(const MixArgs& a, float* LQ, unsigned char* ldsb, int b, int gi, int u16) {
    const int tid = opaque_tid(), lane = tid & 63, wave = __builtin_amdgcn_readfirstlane(tid >> 6), r32 = lane & 31, hi = lane >> 5;
    const int rate = (gi == 0) ? 1 : (gi == 1) ? 4 : 16, nblk = 16 / rate, c = u16 / nblk, qb = u16 % nblk;
    const int head = gi * 2 + (wave >> 2), q0 = 128 * qb + 32 * (wave & 3);
    const GAS bf16_t* zb = (const GAS bf16_t*)a.Z + (size_t)b * SEQ * ZP;
    LAS unsigned char* vimg = (LAS unsigned char*)ldsb + wave * 4096;
    f32x16 zero16;
#pragma unroll
    for (int i = 0; i < 16; ++i) zero16[i] = 0.f;
    const size_t qrow = (size_t)b * SEQ + (size_t)(q0 + r32) * rate + c;
    bf16x8 bq[4];
#pragma unroll
    for (int s = 0; s < 4; ++s) bq[s] = *(const GAS bf16x8*)((const GAS bf16_t*)a.Z + qrow * ZP + ZC_Q + head * 64 + 16 * s + 8 * hi);
    f32x16 o0 = zero16, o1 = zero16; float lsum = 0.f;
    const int g16 = lane >> 4, i16 = lane & 15, q4 = i16 >> 2, p4 = i16 & 3;
    const int vrd = ((g16 >> 1) * 4 + q4) * 64 + (16 * (g16 & 1) + 4 * p4) * 2;
    const int vwr_key = lane >> 3, vwr_ch = lane & 7;
    bf16x8 akr[3][4]; u32x4 vstr[3][4];
#define DIL_LOAD(set, tix) do { const int j0_ = q0 - 128 + 32 * (tix); if (j0_ >= 0) { \
        _Pragma("unroll") for (int s = 0; s < 4; ++s) akr[set][s] = *(const GAS bf16x8*)(zb + ((size_t)(j0_ + r32) * rate + c) * ZP + ZC_K + head * 64 + 16 * s + 8 * hi); \
        _Pragma("unroll") for (int i = 0; i < 4; ++i) vstr[set][i] = *(const GAS u32x4*)(zb + ((size_t)(j0_ + vwr_key + 8 * i) * rate + c) * ZP + ZC_V + head * 64 + 8 * vwr_ch); } } while (0)
    DIL_LOAD(0, 0); DIL_LOAD(1, 1); DIL_LOAD(2, 2);
#pragma unroll
    for (int ti = 0; ti < 5; ++ti) {
        const int j0 = q0 - 128 + 32 * ti;
        if (j0 < 0) { if (ti + 3 < 5) DIL_LOAD(ti % 3, ti + 3); continue; }
        bf16x8 ak[4];
#pragma unroll
        for (int s = 0; s < 4; ++s) ak[s] = akr[ti % 3][s];
#pragma unroll
        for (int i = 0; i < 4; ++i) *(LAS u32x4*)(vimg + (vwr_ch >> 2) * 2048 + (vwr_key + 8 * i) * 64 + (vwr_ch & 3) * 16) = vstr[ti % 3][i];
        f32x16 sacc = MFMA32(ak[0], bq[0], zero16); sacc = MFMA32(ak[1], bq[1], sacc); sacc = MFMA32(ak[2], bq[2], sacc); sacc = MFMA32(ak[3], bq[3], sacc);
        if (ti + 3 < 5) DIL_LOAD(ti % 3, ti + 3);
        asm volatile("s_waitcnt lgkmcnt(0)" ::: "memory");
        s16x4 va[2][2][2];
#pragma unroll
        for (int dt = 0; dt < 2; ++dt)
#pragma unroll
            for (int s = 0; s < 2; ++s) { va[dt][s][0] = vtr(vimg + dt * 2048 + (16 * s) * 64 + vrd); va[dt][s][1] = vtr(vimg + dt * 2048 + (16 * s + 8) * 64 + vrd); }
        const int dbase = q0 + r32 - j0 - 4 * hi;
        unsigned pw[8];
#pragma unroll
        for (int r = 0; r < 16; r += 2) {
            const int d0 = dbase - ((r & 3) + 8 * (r >> 2)), d1 = dbase - (((r + 1) & 3) + 8 * ((r + 1) >> 2));
            float p0 = __builtin_amdgcn_exp2f(fminf(sacc[r], 64.f)), p1 = __builtin_amdgcn_exp2f(fminf(sacc[r + 1], 64.f));
            p0 = ((unsigned)d0 <= 128u) ? p0 : 0.f; p1 = ((unsigned)d1 <= 128u) ? p1 : 0.f;
            lsum += p0 + p1;
            pw[r >> 1] = pk2(p0, p1);
        }
        asm volatile("s_waitcnt lgkmcnt(0)" ::: "memory");
#pragma unroll
        for (int s = 0; s < 2; ++s) {
            u32x4 pv4; pv4.x = pw[4 * s]; pv4.y = pw[4 * s + 1]; pv4.z = pw[4 * s + 2]; pv4.w = pw[4 * s + 3];
            const bf16x8 pb = __builtin_bit_cast(bf16x8, pv4);
            const bf16x8 v0 = __builtin_shufflevector(va[0][s][0], va[0][s][1], 0, 1, 2, 3, 4, 5, 6, 7), v1 = __builtin_shufflevector(va[1][s][0], va[1][s][1], 0, 1, 2, 3, 4, 5, 6, 7);
            o0 = MFMA32(v0, pb, o0); o1 = MFMA32(v1, pb, o1);
        }
    }
    lsum += __shfl_xor(lsum, 32);
    if (hi == 0) LQ[qrow * 8 + head] = lsum;
    GAS bf16_t* yp = (GAS bf16_t*)a.Y + qrow * DM + 640 + head * 64;
#pragma unroll
    for (int dt = 0; dt < 2; ++dt)
#pragma unroll
        for (int i = 0; i < 4; ++i) {
            const int d = 32 * dt + 8 * i + 4 * hi; const f32x16& o = dt ? o1 : o0;
            u32x2 w; w.x = pk2(o[4 * i], o[4 * i + 1]); w.y = pk2(o[4 * i + 2], o[4 * i + 3]);
            *(GAS u32x2*)(yp + d) = w;
        }
}
__device__ __forceinline__ void dil_merge(const MixArgs& a, const float* LQ, int first, int nthreads) {
    constexpr int NCH = MTOK * 48;
    for (int id0 = first; id0 < NCH; id0 += 4 * nthreads) {
        u32x4 ow[4], gw[4]; float rl[4];
#pragma unroll
        for (int j = 0; j < 4; ++j) { const int id = id0 + j * nthreads; if (id < NCH) { const int row = id / 48, ch = id % 48;
            ow[j] = *(const GAS u32x4*)((const GAS bf16_t*)a.Y + (size_t)row * DM + 640 + ch * 8); gw[j] = *(const GAS u32x4*)((const GAS bf16_t*)a.Z + (size_t)row * ZP + ZC_G + ch * 8);
            const float* lq = LQ + (size_t)row * 8 + ((ch >> 3) & 1); rl[j] = lq[0] + lq[2] + lq[4]; } }
#pragma unroll
        for (int j = 0; j < 4; ++j) { const int id = id0 + j * nthreads; if (id < NCH) { const int row = id / 48, ch = id % 48; const float r = __builtin_amdgcn_rcpf(rl[j]);
            const unsigned o4[4] = {ow[j].x, ow[j].y, ow[j].z, ow[j].w}, g4[4] = {gw[j].x, gw[j].y, gw[j].z, gw[j].w}; unsigned w4[4];
#pragma unroll
            for (int k = 0; k < 4; ++k) { const float g0 = bflo(g4[k]), g1 = bfhi(g4[k]); w4[k] = pk2(bflo(o4[k]) * r * g0 * sigmoidf_(g0), bfhi(o4[k]) * r * g1 * sigmoidf_(g1)); }
            u32x4 w; w.x = w4[0]; w.y = w4[1]; w.z = w4[2]; w.w = w4[3]; *(GAS u32x4*)((GAS bf16_t*)a.Y + (size_t)row * DM + 640 + ch * 8) = w; } }
    }
}
}
namespace rwkv {
#ifdef PROBE_T
#define RTS ((volatile LAS unsigned long long*)((LAS unsigned char*)ldsb + 131072 + 1024))
#define RST(id_end, id_begin) do { if (blockIdx.x == 0 && threadIdx.x == 0) { const unsigned long long now_ = __builtin_amdgcn_s_memrealtime(); if ((id_end) == PROBE_T) RTS[1] += now_ - RTS[0]; if ((id_begin) == PROBE_T) RTS[0] = now_; } } while (0)
#else
#define RST(a, b) do {} while (0)
#endif
using dsa::vtr; using dsa::s16x4;
constexpr int IP = 144;
constexpr int IMG = 64 * IP;
constexpr int S_WD = 0 * IMG, S_AD = 1 * IMG, S_V = 2 * IMG, S_AT = 3 * IMG, S_BH = 4 * IMG, S_KH = 5 * IMG, S_RT = 6 * IMG, S_KB = 7 * IMG, S_BB = 8 * IMG, S_ARB = 9 * IMG, S_AH = 10 * IMG, S_UV = 11 * IMG;
constexpr int S_AAK = S_WD, S_ARK = S_AD, S_TT = S_BH, S_W1 = S_KH;
constexpr int F_AAB = 12 * IMG;
constexpr int F_LG = S_ARB;
constexpr int F_TOT = F_AAB + 16384;
static_assert(F_TOT + 512 <= 131072 && F_LG + 16384 <= F_AAB, "rwkv LDS map");

struct RArgs { const float* mu; const float* w0; const float* a0; const float* k_k; const float* k_a; const float* r_k; const float* ln_g; const float* ln_b;
               const bf16_t* wupT; const bf16_t* aupT; bf16_t* RQ; bf16_t* RM; bf16_t* RN; float* RG; float* RB; };

__device__ __forceinline__ bf16x8 rowfrag(const LAS unsigned char* img, int r0, int k0, int r32, int hi) { return *(const LAS bf16x8*)(img + (r0 + r32) * IP + (k0 + 8 * hi) * 2); }
__device__ __forceinline__ bf16x8 colfrag(const LAS unsigned char* img, int c0, int k0, int lane) {
    const int g16 = lane >> 4, i16 = lane & 15;
    const LAS unsigned char* p = img + (k0 + 8 * (g16 >> 1) + (i16 >> 2)) * IP + (c0 + 16 * (g16 & 1) + 4 * (i16 & 3)) * 2;
    const s16x4 lo = vtr(p), hi4 = vtr(p + 4 * IP);
    return __builtin_shufflevector(lo, hi4, 0, 1, 2, 3, 4, 5, 6, 7);
}
__device__ __forceinline__ bf16x8 colfrag_perm(const LAS unsigned char* img, int c0, int k0, int lane) {
    const int g16 = lane >> 4, i16 = lane & 15;
    const LAS unsigned char* p = img + (k0 + 4 * (g16 >> 1) + (i16 >> 2)) * IP + (c0 + 16 * (g16 & 1) + 4 * (i16 & 3)) * 2;
    const s16x4 lo = vtr(p), hi4 = vtr(p + 8 * IP);
    return __builtin_shufflevector(lo, hi4, 0, 1, 2, 3, 4, 5, 6, 7);
}
__device__ __forceinline__ bf16x8 rowfrag_f32(const LAS float* img, int r0, int k0, int r32, int hi) {
    const LAS f32x4* p = (const LAS f32x4*)(img + (r0 + r32) * 64 + k0 + 8 * hi); const f32x4 a = p[0], b = p[1];
    u32x4 w; w.x = pk2(a[0], a[1]); w.y = pk2(a[2], a[3]); w.z = pk2(b[0], b[1]); w.w = pk2(b[2], b[3]); return __builtin_bit_cast(bf16x8, w);
}
__device__ __forceinline__ void store_T(LAS unsigned char* imgT, const f32x16& c, int r0, int c0, int r32, int hi) {
#pragma unroll
    for (int g = 0; g < 4; ++g) { u32x2 w; w.x = pk2(c[4 * g], c[4 * g + 1]); w.y = pk2(c[4 * g + 2], c[4 * g + 3]); *(LAS u32x2*)(imgT + (c0 + r32) * IP + (r0 + 8 * g + 4 * hi) * 2) = w; }
}
__device__ __forceinline__ void store_T_global(GAS bf16_t* gT  , const f32x16& c, int r0, int c0, int r32, int hi) {
#pragma unroll
    for (int g = 0; g < 4; ++g) { u32x2 w; w.x = pk2(c[4 * g], c[4 * g + 1]); w.y = pk2(c[4 * g + 2], c[4 * g + 3]); *(GAS u32x2*)(gT + (c0 + r32) * 64 + r0 + 8 * g + 4 * hi) = w; }
}
__device__ __forceinline__ void store_T_global_wt(GAS bf16_t* gT, const f32x16& c, int r0, int c0, int r32, int hi) {
#pragma unroll
    for (int g = 0; g < 4; ++g) { const unsigned long long w = (unsigned long long)pk2(c[4 * g], c[4 * g + 1]) | ((unsigned long long)pk2(c[4 * g + 2], c[4 * g + 3]) << 32);
        __hip_atomic_store((GAS unsigned long long*)(gT + (c0 + r32) * 64 + r0 + 8 * g + 4 * hi), w, __ATOMIC_RELAXED, __HIP_MEMORY_SCOPE_AGENT); }
}
__device__ __forceinline__ f32x16 zero16() { f32x16 z;
#pragma unroll
    for (int i = 0; i < 16; ++i) z[i] = 0.f;
    return z; }
#define WSYNC() asm volatile("s_waitcnt lgkmcnt(0)" ::: "memory")
#define BAR() do { asm volatile("s_waitcnt lgkmcnt(0)" ::: "memory"); __builtin_amdgcn_s_barrier(); asm volatile("" ::: "memory"); } while (0)

constexpr int R1_STG = S_AT;
constexpr int R1_SAVE = 131072 + 2048, R1_PAR = R1_SAVE + 1024, R1_WUP = R1_PAR + 2560, R1_AUP = R1_WUP + IMG;
struct R1Raw { u32x4 c[5]; };
__device__ __forceinline__ void r1_load(const MixArgs& a, R1Raw& raw, int tid, int b, int h, int ck) {
    const int et = tid >> 3, ec = (tid & 7) * 8, hc = h * 64 + ec;
    const GAS bf16_t* zr = (const GAS bf16_t*)a.Z + ((size_t)b * SEQ + ck * 64 + et) * ZP;
    const int cols[5] = {ZA_R + hc, ZA_K + hc, ZA_V + hc, ZA_WD + ec, ZA_AD + ec};
#pragma unroll
    for (int i = 0; i < 5; ++i) raw.c[i] = *(const GAS u32x4*)(zr + cols[i]);
}
__device__ __forceinline__ void r1_load_params(const RArgs& ra, unsigned char* ldsb, int tid, int h) {
    LAS float* par = (LAS float*)((LAS unsigned char*)ldsb + R1_PAR);
    for (int i = tid; i < 640; i += 512) { const int g = i >> 6, c = i & 63; float v;
        if (g == 0) v = ra.mu[ZA_R + h * 64 + c]; else if (g == 1) v = ra.mu[ZA_K + h * 64 + c]; else if (g == 2) v = ra.mu[ZA_V + h * 64 + c]; else if (g == 3) v = ra.mu[ZA_WD + c]; else if (g == 4) v = ra.mu[ZA_AD + c];
        else if (g == 5) v = ra.w0[h * 64 + c]; else if (g == 6) v = ra.a0[h * 64 + c]; else if (g == 7) v = ra.k_k[h * 64 + c]; else if (g == 8) v = ra.k_a[h * 64 + c]; else v = ra.r_k[h * 64 + c];
        par[i] = v; }
    for (int ch = tid; ch < 1024; ch += 512) { const int m = ch >> 9, row = (ch >> 3) & 63, c8 = ch & 7;
        *(LAS u32x4*)((LAS unsigned char*)ldsb + (m ? R1_AUP : R1_WUP) + row * IP + c8 * 16) = *(const GAS u32x4*)((const GAS bf16_t*)(m ? ra.aupT : ra.wupT) + (size_t)(h * 64 + row) * 64 + c8 * 8); }
}
static_assert(65 * 640 <= 5 * IMG, "staging fits");
__device__ __forceinline__ void rwkv_chunk_unit(const MixArgs& a, const RArgs& ra, unsigned char* ldsb, int b, int h, int ck, R1Raw& raw, int prev_mode, bool has_next, int nb, int nh, int nck) {
    const int tid = opaque_tid(), lane = tid & 63, wave = __builtin_amdgcn_readfirstlane(tid >> 6), r32 = lane & 31, hi = lane >> 5;
    LAS unsigned char* L = (LAS unsigned char*)ldsb;
    LAS float* fETA = (LAS float*)(L + F_AAB); LAS float* fAAB = fETA; LAS float* fLG = (LAS float*)(L + F_LG); LAS float* fTOT = (LAS float*)(L + F_TOT);
    const int t0 = ck * 64;
    const size_t row0 = (size_t)b * SEQ + t0;
    const int unit = (b * 6 + h) * 32 + ck;
    RST(-1, 50);
    const int et = tid >> 3, ec = (tid & 7) * 8, hc = h * 64 + ec;
    const LAS float* par = (const LAS float*)(L + R1_PAR);
    float r8[8], k8[8];
    {
        {
            LAS unsigned char* stg = L + R1_STG;
#pragma unroll
            for (int i = 0; i < 5; ++i) *(LAS u32x4*)(stg + (et + 1) * 640 + i * 128 + (tid & 7) * 16) = raw.c[i];
            if (et == 0) {
                const int hc0 = h * 64 + ec; const int cols[5] = {ZA_R + hc0, ZA_K + hc0, ZA_V + hc0, ZA_WD + ec, ZA_AD + ec};
#pragma unroll
                for (int i = 0; i < 5; ++i) { u32x4 pv = zero_u32x4();
                    if (prev_mode == 1) pv = *(const LAS u32x4*)(L + R1_SAVE + i * 128 + (tid & 7) * 16);
                    else if (prev_mode == 2) pv = *(const GAS u32x4*)((const GAS bf16_t*)a.Z + (row0 - 1) * ZP + cols[i]);
                    *(LAS u32x4*)(stg + i * 128 + (tid & 7) * 16) = pv; }
            }
        }
        BAR();
        if (et == 63) {
#pragma unroll
            for (int i = 0; i < 5; ++i) *(LAS u32x4*)(L + R1_SAVE + i * 128 + (tid & 7) * 16) = raw.c[i];
        }
        auto mix8 = [&](int i, int col, float* out) {
            const u32x4 cw = raw.c[i], pw = *(const LAS u32x4*)(L + R1_STG + et * 640 + i * 128 + (tid & 7) * 16);
            const f32x4 m0 = *(const LAS f32x4*)(par + i * 64 + ec), m1 = *(const LAS f32x4*)(par + i * 64 + ec + 4); (void)col;
            const float cv[8] = {bflo(cw.x), bfhi(cw.x), bflo(cw.y), bfhi(cw.y), bflo(cw.z), bfhi(cw.z), bflo(cw.w), bfhi(cw.w)};
            const float pv[8] = {bflo(pw.x), bfhi(pw.x), bflo(pw.y), bfhi(pw.y), bflo(pw.z), bfhi(pw.z), bflo(pw.w), bfhi(pw.w)};
            const float mv[8] = {m0[0], m0[1], m0[2], m0[3], m1[0], m1[1], m1[2], m1[3]};
#pragma unroll
            for (int j = 0; j < 8; ++j) out[j] = cv[j] + (pv[j] - cv[j]) * mv[j];
        };
        float v8[8], wd8[8], ad8[8];
        mix8(0, ZA_R + hc, r8); mix8(1, ZA_K + hc, k8); mix8(2, ZA_V + hc, v8); mix8(3, ZA_WD + ec, wd8); mix8(4, ZA_AD + ec, ad8);
#pragma unroll
        for (int i = 0; i < 8; ++i) wd8[i] = tanhf_(wd8[i]);
        u32x4 w;
        w.x = pk2(wd8[0], wd8[1]); w.y = pk2(wd8[2], wd8[3]); w.z = pk2(wd8[4], wd8[5]); w.w = pk2(wd8[6], wd8[7]); *(LAS u32x4*)(L + S_WD + et * IP + ec * 2) = w;
        w.x = pk2(ad8[0], ad8[1]); w.y = pk2(ad8[2], ad8[3]); w.z = pk2(ad8[4], ad8[5]); w.w = pk2(ad8[6], ad8[7]); *(LAS u32x4*)(L + S_AD + et * IP + ec * 2) = w;
        w.x = pk2(v8[0], v8[1]); w.y = pk2(v8[2], v8[3]); w.z = pk2(v8[4], v8[5]); w.w = pk2(v8[6], v8[7]); *(LAS u32x4*)(L + S_V + et * IP + ec * 2) = w;
    }
    BAR();
    RST(50, 51);
    const int q = wave & 3, tr = q >> 1, tc = q & 1, grp = wave >> 2;
    {
        const LAS unsigned char* Aimg = L + (grp ? S_AD : S_WD);
        f32x16 acc = zero16();
#pragma unroll
        for (int s = 0; s < 4; ++s) acc = MFMA32(rowfrag(Aimg, 32 * tr, 16 * s, r32, hi), rowfrag(L + (grp ? R1_AUP : R1_WUP), 32 * tc, 16 * s, r32, hi), acc);
        const int c = 32 * tc + r32; const float bias = par[(grp ? 6 : 5) * 64 + c];
        if (grp == 0) {
            float x[16], gs[4];
#pragma unroll
            for (int i = 0; i < 16; ++i) x[i] = -DECAY_SCALE * sigmoidf_(acc[i] + bias);
#pragma unroll
            for (int g = 0; g < 4; ++g) gs[g] = (x[4 * g] + x[4 * g + 1]) + (x[4 * g + 2] + x[4 * g + 3]);
            float run = 0.f;
#pragma unroll
            for (int g = 0; g < 4; ++g) { const float other = __shfl_xor(gs[g], 32); float base = run + (hi ? other : 0.f); run += gs[g] + other;
#pragma unroll
                for (int j = 0; j < 4; ++j) { base += x[4 * g + j]; fLG[(32 * tr + 8 * g + 4 * hi + j) * 64 + c] = base; } }
            if (tr == 0 && hi == 0) fTOT[c] = run;
        } else {
#pragma unroll
            for (int i = 0; i < 16; ++i) fETA[(32 * tr + (i & 3) + 8 * (i >> 2) + 4 * hi) * 64 + c] = sigmoidf_(acc[i] + bias);
        }
    }
    BAR();
    RST(51, 52);
    {
        const f32x4 l0 = *(const LAS f32x4*)(fLG + et * 64 + ec), l1 = *(const LAS f32x4*)(fLG + et * 64 + ec + 4);
        f32x4 p0 = {0.f, 0.f, 0.f, 0.f}, p1 = p0; if (et > 0) { p0 = *(const LAS f32x4*)(fLG + (et - 1) * 64 + ec); p1 = *(const LAS f32x4*)(fLG + (et - 1) * 64 + ec + 4); }
        const f32x4 e0 = *(const LAS f32x4*)(fETA + et * 64 + ec), e1 = *(const LAS f32x4*)(fETA + et * 64 + ec + 4);
        const f32x4 z0 = *(const LAS f32x4*)(fLG + 63 * 64 + ec), z1 = *(const LAS f32x4*)(fLG + 63 * 64 + ec + 4);
        const f32x4 u0 = *(const LAS f32x4*)(fTOT + ec), u1 = *(const LAS f32x4*)(fTOT + ec + 4);
        float lg[8] = {l0[0], l0[1], l0[2], l0[3], l1[0], l1[1], l1[2], l1[3]}, lp[8] = {p0[0], p0[1], p0[2], p0[3], p1[0], p1[1], p1[2], p1[3]};
        const float eta[8] = {e0[0], e0[1], e0[2], e0[3], e1[0], e1[1], e1[2], e1[3]}, tot[8] = {u0[0], u0[1], u0[2], u0[3], u1[0], u1[1], u1[2], u1[3]};
        float lC[8] = {z0[0], z0[1], z0[2], z0[3], z1[0], z1[1], z1[2], z1[3]};
        float kk[8], kp[8], ss = 0.f, bsum = 0.f;
#pragma unroll
        for (int i = 0; i < 8; ++i) {
            if (et >= 32) lg[i] += tot[i]; if (et >= 33) lp[i] += tot[i]; lC[i] += tot[i];
            kk[i] = k8[i] * par[7 * 64 + ec + i]; ss += kk[i] * kk[i];
            kp[i] = k8[i] * (1.f + (eta[i] - 1.f) * par[8 * 64 + ec + i]); bsum += r8[i] * kp[i] * par[9 * 64 + ec + i];
        }
        ss += __shfl_xor(ss, 1); ss += __shfl_xor(ss, 2); ss += __shfl_xor(ss, 4);
        bsum += __shfl_xor(bsum, 1); bsum += __shfl_xor(bsum, 2); bsum += __shfl_xor(bsum, 4);
        const float rn = __builtin_amdgcn_rsqf(fmaxf(ss, 1e-24f));
        if ((tid & 7) == 0) ra.RB[(row0 + et) * 8 + h] = bsum;
        if (et == 63) { f32x4 g0 = {fexp_(lC[0]), fexp_(lC[1]), fexp_(lC[2]), fexp_(lC[3])}, g1 = {fexp_(lC[4]), fexp_(lC[5]), fexp_(lC[6]), fexp_(lC[7])};
            *(f32x4*)(ra.RG + (size_t)unit * 64 + ec) = g0; *(f32x4*)(ra.RG + (size_t)unit * 64 + ec + 4) = g1; }
#pragma unroll
        for (int i = 0; i < 8; i += 2) {
            float vat[2], vbh[2], vkh[2], vrt[2], vkb[2], vbb[2];
#pragma unroll
            for (int j = 0; j < 2; ++j) { const int c = i + j;
                const float kn = kk[c] * rn, bv = kn * eta[c];
                const float ig = fexp_(-lg[c]), gC = fexp_(lC[c] - lg[c]);
                vat[j] = -kn * fexp_(lp[c]); vbh[j] = bv * ig; vkh[j] = kp[c] * ig; vrt[j] = r8[c] * fexp_(lg[c]); vkb[j] = kp[c] * gC; vbb[j] = bv * gC; }
            const int off = et * IP + (ec + i) * 2;
            *(LAS unsigned*)(L + S_AT + off) = pk2(vat[0], vat[1]); *(LAS unsigned*)(L + S_BH + off) = pk2(vbh[0], vbh[1]); *(LAS unsigned*)(L + S_KH + off) = pk2(vkh[0], vkh[1]);
            *(LAS unsigned*)(L + S_RT + off) = pk2(vrt[0], vrt[1]); *(LAS unsigned*)(L + S_KB + off) = pk2(vkb[0], vkb[1]); *(LAS unsigned*)(L + S_BB + off) = pk2(vbb[0], vbb[1]);
        }
    }
    BAR();
    RST(52, 53);
    if (has_next) r1_load(a, raw, tid, nb, nh, nck);
    {
        const LAS unsigned char* Aimg = L + (grp ? S_RT : S_AT);
        f32x16 c1 = zero16(), c2 = zero16();
        if (!(tr == 0 && tc == 1)) {
#pragma unroll
            for (int s = 0; s < 4; ++s) { const bf16x8 af = rowfrag(Aimg, 32 * tr, 16 * s, r32, hi);
                c1 = MFMA32(af, rowfrag(L + S_BH, 32 * tc, 16 * s, r32, hi), c1); c2 = MFMA32(af, rowfrag(L + S_KH, 32 * tc, 16 * s, r32, hi), c2); }
        }
        const int ci = 32 * tc + r32;
#pragma unroll
        for (int i = 0; i < 16; ++i) { const int t = 32 * tr + (i & 3) + 8 * (i >> 2) + 4 * hi; const bool keep = grp ? (ci <= t) : (ci < t); if (!keep) { c1[i] = 0.f; c2[i] = 0.f; } }
        if (grp == 0) {
#pragma unroll
            for (int i = 0; i < 16; ++i) fAAB[(32 * tr + (i & 3) + 8 * (i >> 2) + 4 * hi) * 64 + ci] = c1[i];
            store_T(L + S_AAK, c2, 32 * tr, 32 * tc, r32, hi);
        } else { store_T(L + S_ARB, c1, 32 * tr, 32 * tc, r32, hi); store_T(L + S_ARK, c2, 32 * tr, 32 * tc, r32, hi); }
    }
    BAR();
    RST(53, 54);
    f32x16 nacc = zero16(), yacc = zero16();
    if (grp == 0) {
        const int bk = wave;
        float d[16];
        if (lane < 16) {
#pragma unroll
            for (int t = 0; t < 16; ++t) { float s = (t == lane) ? 1.f : 0.f;
#pragma unroll
                for (int i = 0; i < 16; ++i) if (i < t) s += fAAB[(16 * bk + t) * 64 + 16 * bk + i] * d[i];
                d[t] = s; }
        }
        if (lane < 16) {
            LAS unsigned char* rowp = L + S_TT + (16 * bk + lane) * IP;
#pragma unroll
            for (int cb = 0; cb < 4; ++cb) { u32x4 w0, w1;
                if (cb == bk) { w0.x = pk2(d[0], d[1]); w0.y = pk2(d[2], d[3]); w0.z = pk2(d[4], d[5]); w0.w = pk2(d[6], d[7]); w1.x = pk2(d[8], d[9]); w1.y = pk2(d[10], d[11]); w1.z = pk2(d[12], d[13]); w1.w = pk2(d[14], d[15]); }
                else { w0 = zero_u32x4(); w1 = w0; }
                *(LAS u32x4*)(rowp + cb * 32) = w0; *(LAS u32x4*)(rowp + cb * 32 + 16) = w1; }
        }
    } else {
        f32x16 c = zero16();
#pragma unroll
        for (int s = 0; s < 4; ++s) c = MFMA32(colfrag(L + S_AAK, 32 * tr, 16 * s, lane), colfrag(L + S_V, 32 * tc, 16 * s, lane), c);
        store_T(L + S_W1, c, 32 * tr, 32 * tc, r32, hi);
    }
    BAR();
    if (grp == 0) {
        if (wave < 2) { const int p = 2 * wave;
            f32x16 x = MFMA32(rowfrag_f32(fAAB, 16 * (p + 1), 16 * p, r32, hi), rowfrag(L + S_TT, 16 * p, 16 * p, r32, hi), zero16());
            u32x4 xw; xw.x = pk2(x[0], x[1]); xw.y = pk2(x[2], x[3]); xw.z = pk2(x[4], x[5]); xw.w = pk2(x[6], x[7]);
            const f32x16 tb = MFMA32(colfrag_perm(L + S_TT, 16 * (p + 1), 16 * (p + 1), lane), __builtin_bit_cast(bf16x8, xw), zero16());
            if (r32 < 16) {
#pragma unroll
                for (int g = 0; g < 2; ++g) { u32x2 w; w.x = pk2(tb[4 * g], tb[4 * g + 1]); w.y = pk2(tb[4 * g + 2], tb[4 * g + 3]); *(LAS u32x2*)(L + S_TT + (16 * p + r32) * IP + (16 * (p + 1) + 8 * g + 4 * hi) * 2) = w; } }
        }
    } else {
#pragma unroll
        for (int s = 0; s < 4; ++s) { const bf16x8 vf = colfrag(L + S_V, 32 * tr, 16 * s, lane);
            nacc = MFMA32(colfrag(L + S_KB, 32 * tr, 16 * s, lane), colfrag(L + S_V, 32 * tc, 16 * s, lane), nacc);
            yacc = MFMA32(vf, colfrag(L + S_ARK, 32 * tc, 16 * s, lane), yacc); }
    }
    BAR();
    if (wave == 0) {
        f32x16 x = zero16();
#pragma unroll
        for (int s = 0; s < 2; ++s) x = MFMA32(rowfrag_f32(fAAB, 32, 16 * s, r32, hi), rowfrag(L + S_TT, 0, 16 * s, r32, hi), x);
        f32x16 tb = zero16();
#pragma unroll
        for (int s = 0; s < 2; ++s) { u32x4 xw; xw.x = pk2(x[8 * s], x[8 * s + 1]); xw.y = pk2(x[8 * s + 2], x[8 * s + 3]); xw.z = pk2(x[8 * s + 4], x[8 * s + 5]); xw.w = pk2(x[8 * s + 6], x[8 * s + 7]);
            tb = MFMA32(colfrag_perm(L + S_TT, 32, 32 + 16 * s, lane), __builtin_bit_cast(bf16x8, xw), tb); }
        store_T(L + S_TT, tb, 32, 0, r32, hi);
    }
    BAR();
    RST(54, 55);
    {
        f32x16 c = zero16();
#pragma unroll
        for (int s = 0; s < 4; ++s) { const bf16x8 tf = colfrag(L + S_TT, 32 * tr, 16 * s, lane);
            c = MFMA32(tf, grp ? rowfrag(L + S_W1, 32 * tc, 16 * s, r32, hi) : colfrag(L + S_AT, 32 * tc, 16 * s, lane), c); }
        store_T(L + (grp ? S_UV : S_AH), c, 32 * tr, 32 * tc, r32, hi);
    }
    BAR();
    RST(55, 56);
    {
        const LAS unsigned char* Aimg = L + (grp ? S_UV : S_AH);
        f32x16 c1 = grp ? nacc : zero16(), c2 = grp ? yacc : zero16();
#pragma unroll
        for (int s = 0; s < 4; ++s) { const bf16x8 af = rowfrag(Aimg, 32 * tr, 16 * s, r32, hi);
            if (grp) c1 = MFMA32(colfrag(L + S_BB, 32 * tr, 16 * s, lane), rowfrag(L + S_UV, 32 * tc, 16 * s, r32, hi), c1);
            else c1 = MFMA32(af, colfrag(L + S_BB, 32 * tc, 16 * s, lane), c1);
            c2 = MFMA32(af, colfrag(L + S_ARB, 32 * tc, 16 * s, lane), c2); }
        GAS bf16_t* gq = (GAS bf16_t*)ra.RQ + (size_t)unit * 4096; GAS bf16_t* gm = (GAS bf16_t*)ra.RM + (size_t)unit * 4096; GAS bf16_t* gn = (GAS bf16_t*)ra.RN + (size_t)unit * 4096;
        if (grp == 0) {
            store_T_global(gm, c1, 32 * tr, 32 * tc, r32, hi);
#pragma unroll
            for (int g = 0; g < 4; ++g) { const u32x2 w = *(const LAS u32x2*)(L + S_RT + (32 * tc + r32) * IP + (32 * tr + 8 * g + 4 * hi) * 2);
                c2[4 * g] += bflo(w.x); c2[4 * g + 1] += bfhi(w.x); c2[4 * g + 2] += bflo(w.y); c2[4 * g + 3] += bfhi(w.y); }
            store_T_global(gq, c2, 32 * tr, 32 * tc, r32, hi);
        } else {
            store_T_global(gn, c1, 32 * tr, 32 * tc, r32, hi);
            GAS bf16_t* yp = (GAS bf16_t*)a.Y + (row0 + 32 * tc + r32) * DM + h * 64 + 32 * tr;
#pragma unroll
            for (int g = 0; g < 4; ++g) { u32x2 w; w.x = pk2(c2[4 * g], c2[4 * g + 1]); w.y = pk2(c2[4 * g + 2], c2[4 * g + 3]); *(GAS u32x2*)(yp + 8 * g + 4 * hi) = w; }
        }
    }
    BAR();
    RST(56, -1);
}

constexpr int R2_D = 6, R2_SLOT = 16640, R2_RING = 2 * IMG;
__device__ __forceinline__ void rwkv_scan_chain(const RArgs& ra, unsigned char* ldsb, int b, int h, unsigned* flag  ) {
    const int tid = opaque_tid(), lane = tid & 63, wave = __builtin_amdgcn_readfirstlane(tid >> 6), r32 = lane & 31, hi = lane >> 5;
    LAS unsigned char* L = (LAS unsigned char*)ldsb;
    const int q = wave & 3, tr = q >> 1, tc = q & 1;
    f32x16 st = zero16();
    for (int i = tid; i < 2 * IMG / 16; i += 512) { *(LAS u32x4*)(L + i * 16) = zero_u32x4(); }
    const int ubase = (b * 6 + h) * 32;
    auto issue = [&](int step) {
        const int unit = ubase + step; LAS unsigned char* slot = L + R2_RING + (step % R2_D) * R2_SLOT; const int lw = wave - 4;
        const GAS unsigned char* gm = (const GAS unsigned char*)ra.RM + (size_t)unit * 8192 + lane * 16; const GAS unsigned char* gn = (const GAS unsigned char*)ra.RN + (size_t)unit * 8192 + lane * 16;
#pragma unroll
        for (int p = 0; p < 2; ++p) {
            __builtin_amdgcn_global_load_lds((const GAS unsigned*)(gm + (2 * lw + p) * 1024), (LAS unsigned*)(slot + (2 * lw + p) * 1024), 16, 0, 0);
            __builtin_amdgcn_global_load_lds((const GAS unsigned*)(gn + (2 * lw + p) * 1024), (LAS unsigned*)(slot + 8192 + (2 * lw + p) * 1024), 16, 0, 0);
        }
        if (lw == 0) __builtin_amdgcn_global_load_lds((const GAS unsigned*)((const GAS unsigned char*)ra.RG + (size_t)unit * 256 + lane * 4), (LAS unsigned*)(slot + 16384), 4, 0, 0);
    };
    if (wave >= 4) {
#pragma unroll 1
        for (int s0 = 0; s0 < R2_D - 1; ++s0) issue(s0);
        asm volatile("s_waitcnt vmcnt(0)" ::: "memory");
    }
    asm volatile("s_waitcnt lgkmcnt(0)" ::: "memory"); __builtin_amdgcn_s_barrier();
#pragma unroll 1
    for (int ck = 0; ck < 32; ++ck) {
        const LAS unsigned char* Simg = L + (ck & 1) * IMG; LAS unsigned char* Snew = L + ((ck + 1) & 1) * IMG;
        if (wave < 4) {
            const int unit = ubase + ck; const LAS unsigned char* slot = L + R2_RING + (ck % R2_D) * R2_SLOT;
            f32x16 acc;
#pragma unroll
            for (int g = 0; g < 4; ++g) { const u32x2 nw = *(const LAS u32x2*)(slot + 8192 + (32 * tc + r32) * 128 + (32 * tr + 8 * g + 4 * hi) * 2); const f32x4 gc = *(const LAS f32x4*)(slot + 16384 + (32 * tr + 8 * g + 4 * hi) * 4);
                acc[4 * g] = st[4 * g] * gc[0] + bflo(nw.x); acc[4 * g + 1] = st[4 * g + 1] * gc[1] + bfhi(nw.x); acc[4 * g + 2] = st[4 * g + 2] * gc[2] + bflo(nw.y); acc[4 * g + 3] = st[4 * g + 3] * gc[3] + bfhi(nw.y); }
#pragma unroll
            for (int s = 0; s < 4; ++s) acc = MFMA32(*(const LAS bf16x8*)(slot + (32 * tr + r32) * 128 + (16 * s + 8 * hi) * 2), rowfrag(Simg, 32 * tc, 16 * s, r32, hi), acc);
            store_T_global((GAS bf16_t*)ra.RM + (size_t)unit * 4096, st, 32 * tr, 32 * tc, r32, hi);
            st = acc;
            store_T(Snew, st, 32 * tr, 32 * tc, r32, hi);
            asm volatile("s_waitcnt lgkmcnt(0)" ::: "memory");
        } else {
            if (ck + R2_D - 1 < 32) { issue(ck + R2_D - 1);
                if (wave == 4) asm volatile("s_waitcnt vmcnt(20)" ::: "memory"); else asm volatile("s_waitcnt vmcnt(16)" ::: "memory"); }
            else asm volatile("s_waitcnt vmcnt(0)" ::: "memory");
        }
        __builtin_amdgcn_s_barrier();
    }
    asm volatile("s_waitcnt vmcnt(0) lgkmcnt(0)" ::: "memory"); __syncthreads();
    (void)flag;
}
__device__ __forceinline__ void r3_wait(const unsigned* flags, int chain0, int ck, int tid) {
    if (tid < 64) {
        const unsigned* f = flags + (size_t)(chain0 + (tid & 3)) * 64;
        for (unsigned spins = 0; spins < (1u << 22); ++spins) {
            const bool ok = __hip_atomic_load((const GAS unsigned*)f, __ATOMIC_RELAXED, __HIP_MEMORY_SCOPE_AGENT) > (unsigned)ck;
            if (__all(ok)) break;
            __builtin_amdgcn_s_sleep(4);
        }
        __builtin_amdgcn_fence(__ATOMIC_ACQUIRE, "agent");
        asm volatile("s_waitcnt vmcnt(0)" ::: "memory");
    }
}
constexpr int RP = 136, RTILE = 64 * RP, R3_TEAM_LDS = 3 * RTILE;
__device__ __forceinline__ void rwkv_out_unit(const MixArgs& a, const RArgs& ra, unsigned char* ldsb, int b, int h, int ck) {
    const int tid = opaque_tid(), lane = tid & 63, wave = __builtin_amdgcn_readfirstlane(tid >> 6), r32 = lane & 31, hi = lane >> 5;
    const int tw = wave & 1, tt = tid & 127;
    LAS unsigned char* TL = (LAS unsigned char*)ldsb + (wave >> 1) * R3_TEAM_LDS;
    LAS unsigned char* VM = TL, *SG = TL + RTILE, *YC = TL + 2 * RTILE;
    const int unit = (b * 6 + h) * 32 + ck;
    const size_t row0 = (size_t)b * SEQ + ck * 64;
#pragma unroll
    for (int j = 0; j < 4; ++j) {
        const int c = tt + 128 * j, t = c >> 3, c8 = (c & 7) * 8, hc = h * 64 + c8;
        const GAS bf16_t* zr = (const GAS bf16_t*)a.Z + (row0 + t) * ZP; const bool hp = (ck * 64 + t) > 0;
        const u32x4 vc = *(const GAS u32x4*)(zr + ZA_V + hc), gcw = *(const GAS u32x4*)(zr + ZA_G + hc);
        u32x4 vp = zero_u32x4(), gp = vp; if (hp) { vp = *(const GAS u32x4*)(zr - ZP + ZA_V + hc); gp = *(const GAS u32x4*)(zr - ZP + ZA_G + hc); }
        const u32x4 yc = *(const GAS u32x4*)((const GAS bf16_t*)a.Y + (row0 + t) * DM + hc);
        const f32x4 mv0 = *(const f32x4*)(ra.mu + ZA_V + hc), mv1 = *(const f32x4*)(ra.mu + ZA_V + hc + 4), mg0 = *(const f32x4*)(ra.mu + ZA_G + hc), mg1 = *(const f32x4*)(ra.mu + ZA_G + hc + 4);
        const float vcur[8] = {bflo(vc.x), bfhi(vc.x), bflo(vc.y), bfhi(vc.y), bflo(vc.z), bfhi(vc.z), bflo(vc.w), bfhi(vc.w)}, vprv[8] = {bflo(vp.x), bfhi(vp.x), bflo(vp.y), bfhi(vp.y), bflo(vp.z), bfhi(vp.z), bflo(vp.w), bfhi(vp.w)};
        const float gcur[8] = {bflo(gcw.x), bfhi(gcw.x), bflo(gcw.y), bfhi(gcw.y), bflo(gcw.z), bfhi(gcw.z), bflo(gcw.w), bfhi(gcw.w)}, gprv[8] = {bflo(gp.x), bfhi(gp.x), bflo(gp.y), bfhi(gp.y), bflo(gp.z), bfhi(gp.z), bflo(gp.w), bfhi(gp.w)};
        const float muv[8] = {mv0[0], mv0[1], mv0[2], mv0[3], mv1[0], mv1[1], mv1[2], mv1[3]}, mug[8] = {mg0[0], mg0[1], mg0[2], mg0[3], mg1[0], mg1[1], mg1[2], mg1[3]};
        float vm[8], sg[8];
#pragma unroll
        for (int i = 0; i < 8; ++i) { vm[i] = vcur[i] + (vprv[i] - vcur[i]) * muv[i]; const float gg = gcur[i] + (gprv[i] - gcur[i]) * mug[i]; sg[i] = gg * sigmoidf_(gg); }
        u32x4 w; w.x = pk2(vm[0], vm[1]); w.y = pk2(vm[2], vm[3]); w.z = pk2(vm[4], vm[5]); w.w = pk2(vm[6], vm[7]);
        *(LAS u32x2*)(VM + t * RP + c8 * 2) = (u32x2){w.x, w.y}; *(LAS u32x2*)(VM + t * RP + c8 * 2 + 8) = (u32x2){w.z, w.w};
        w.x = pk2(sg[0], sg[1]); w.y = pk2(sg[2], sg[3]); w.z = pk2(sg[4], sg[5]); w.w = pk2(sg[6], sg[7]);
        *(LAS u32x2*)(SG + t * RP + c8 * 2) = (u32x2){w.x, w.y}; *(LAS u32x2*)(SG + t * RP + c8 * 2 + 8) = (u32x2){w.z, w.w};
        *(LAS u32x2*)(YC + t * RP + c8 * 2) = (u32x2){yc.x, yc.y}; *(LAS u32x2*)(YC + t * RP + c8 * 2 + 8) = (u32x2){yc.z, yc.w};
    }
    const GAS bf16_t* gq = (const GAS bf16_t*)ra.RQ + (size_t)unit * 4096 + (32 * tw + r32) * 64 + 8 * hi;
    const GAS bf16_t* gs = (const GAS bf16_t*)ra.RM + (size_t)unit * 4096 + r32 * 64 + 8 * hi;
    bf16x8 bq[4], a0[4], a1[4];
#pragma unroll
    for (int s = 0; s < 4; ++s) { bq[s] = *(const GAS bf16x8*)(gq + 16 * s); a0[s] = *(const GAS bf16x8*)(gs + 16 * s); a1[s] = *(const GAS bf16x8*)(gs + 32 * 64 + 16 * s); }
    const float beta = ra.RB[(row0 + 32 * tw + r32) * 8 + h];
    BAR();
    const int tl = 32 * tw + r32;
    f32x16 y0, y1;
#pragma unroll
    for (int g = 0; g < 4; ++g) { const u32x2 w0 = *(const LAS u32x2*)(YC + tl * RP + (8 * g + 4 * hi) * 2), w1 = *(const LAS u32x2*)(YC + tl * RP + (32 + 8 * g + 4 * hi) * 2);
        y0[4 * g] = bflo(w0.x); y0[4 * g + 1] = bfhi(w0.x); y0[4 * g + 2] = bflo(w0.y); y0[4 * g + 3] = bfhi(w0.y);
        y1[4 * g] = bflo(w1.x); y1[4 * g + 1] = bfhi(w1.x); y1[4 * g + 2] = bflo(w1.y); y1[4 * g + 3] = bfhi(w1.y); }
#pragma unroll
    for (int s = 0; s < 4; ++s) { y0 = MFMA32(a0[s], bq[s], y0); y1 = MFMA32(a1[s], bq[s], y1); }
    float sm = 0.f;
#pragma unroll
    for (int i = 0; i < 16; ++i) sm += y0[i] + y1[i];
    sm += __shfl_xor(sm, 32); const float mean = sm * (1.f / 64.f);
    float sq = 0.f;
#pragma unroll
    for (int i = 0; i < 16; ++i) { const float d0 = y0[i] - mean, d1 = y1[i] - mean; sq += d0 * d0 + d1 * d1; }
    sq += __shfl_xor(sq, 32); const float rstd = __builtin_amdgcn_rsqf(sq * (1.f / 64.f) + GN_EPS);
#pragma unroll
    for (int half = 0; half < 2; ++half)
#pragma unroll
        for (int g = 0; g < 4; ++g) {
            const int v0 = 32 * half + 8 * g + 4 * hi, hc = h * 64 + v0;
            const u32x2 vw = *(const LAS u32x2*)(VM + tl * RP + v0 * 2), sw = *(const LAS u32x2*)(SG + tl * RP + v0 * 2);
            const f32x4 lg4 = *(const f32x4*)(ra.ln_g + hc), lb4 = *(const f32x4*)(ra.ln_b + hc);
            const float vv[4] = {bflo(vw.x), bfhi(vw.x), bflo(vw.y), bfhi(vw.y)}, ss[4] = {bflo(sw.x), bfhi(sw.x), bflo(sw.y), bfhi(sw.y)};
            float o[4];
#pragma unroll
            for (int j = 0; j < 4; ++j) { const float yv = half ? y1[4 * g + j] : y0[4 * g + j]; o[j] = ((yv - mean) * rstd * lg4[j] + lb4[j] + beta * vv[j]) * ss[j]; }
            u32x2 w; w.x = pk2(o[0], o[1]); w.y = pk2(o[2], o[3]); *(LAS u32x2*)(YC + tl * RP + v0 * 2) = w;
        }
    BAR();
#pragma unroll
    for (int j = 0; j < 4; ++j) { const int c = tt + 128 * j, t = c >> 3, c8 = (c & 7) * 8;
        const u32x2 lo = *(const LAS u32x2*)(YC + t * RP + c8 * 2), hi2 = *(const LAS u32x2*)(YC + t * RP + c8 * 2 + 8);
        u32x4 w; w.x = lo.x; w.y = lo.y; w.z = hi2.x; w.w = hi2.y; *(GAS u32x4*)((GAS bf16_t*)a.Y + (row0 + t) * DM + h * 64 + c8) = w; }
    BAR();
}
}
constexpr int NWAVES = 8;
constexpr int RING_BYTES = 131072, LDSCTL_OFF = RING_BYTES, LDS_BYTES = 163840;
constexpr int CW_BAR = 4096, CW_Q = 2048, CW_FLAG = 65536;
struct Args { const float* in[19]; float* out; unsigned char* ws; };

__device__ __forceinline__ unsigned lds_base_u32() { extern __shared__ __attribute__((aligned(16))) unsigned char lds_[]; return (unsigned)(uintptr_t)(LAS unsigned char*)lds_; }
__device__ __forceinline__ unsigned long long rd_ptr_u(volatile LAS unsigned long long* p) { const unsigned long long v = *p; const unsigned lo = __builtin_amdgcn_readfirstlane((unsigned)v), hi = __builtin_amdgcn_readfirstlane((unsigned)(v >> 32)); return ((unsigned long long)hi << 32) | lo; }
__global__ void __launch_bounds__(NWAVES * 64, 2) mega_fwd(Args args) {
    extern __shared__ __attribute__((aligned(16))) unsigned char lds[];
    const int tid = threadIdx.x, lane = tid & 63, wave = __builtin_amdgcn_readfirstlane(tid >> 6);
    const int G = gridDim.x, bx = blockIdx.x;
    unsigned char* ws = args.ws;
    volatile LAS unsigned* MISC = (volatile LAS unsigned*)((LAS unsigned char*)lds + LDSCTL_OFF);
    for (int u = tid; u < (LDS_BYTES - LDSCTL_OFF) / 4; u += NWAVES * 64) ((LAS unsigned*)((LAS unsigned char*)lds + LDSCTL_OFF))[u] = 0u;
    __syncthreads();
    (void)xcd_barrier_post((unsigned*)(ws + WS_CTL) + CW_BAR, MISC + 8);
    volatile LAS unsigned long long* PTRS = (volatile LAS unsigned long long*)((LAS unsigned char*)lds + LDSCTL_OFF + 256);
    if (tid < 19) PTRS[tid] = (unsigned long long)(uintptr_t)args.in[tid];
    if (tid == 19) PTRS[19] = (unsigned long long)(uintptr_t)args.out;
    if (tid == 20) PTRS[20] = (unsigned long long)(uintptr_t)args.ws;
    __syncthreads();
#define PTRS_RD(i) rd_ptr_u(({ unsigned a_; asm volatile("s_mov_b32 %0, %1" : "=s"(a_) : "i"(LDSCTL_OFF + 256 + 8 * (i))); (volatile LAS unsigned long long*)(LAS unsigned char*)(lds_base_u32() + a_); }))
#define ARGP(i) ((const float*)(uintptr_t)PTRS_RD(i))
#define OUTP ((float*)(uintptr_t)PTRS_RD(19))
#define WSP ((unsigned char*)(uintptr_t)PTRS_RD(20))
#ifdef PROBE_BAR
#define GRID_BAR() do { GRID_BAR1(); GRID_BAR1(); } while (0)
#else
#define GRID_BAR() GRID_BAR1()
#endif
#define GRID_BAR1() do { XcdBarrier b_; b_.bar = (unsigned*)(WSP + WS_CTL) + CW_BAR; b_.x = xb_xcc_id(); b_.st = (volatile LAS unsigned*)((LAS unsigned char*)lds + LDSCTL_OFF) + 8; xcd_barrier(b_); } while (0)
#ifdef PROBE_T
#define TS_LDS ((volatile LAS unsigned long long*)((LAS unsigned char*)lds + LDSCTL_OFF + 1024))
#ifdef PROBE_MAX
#define PROBE_BLK_OK true
#else
#define PROBE_BLK_OK (blockIdx.x == 0)
#endif
#define STAMP_BEGIN(id) do { if ((id) == PROBE_T && PROBE_BLK_OK && threadIdx.x == 0) TS_LDS[0] = __builtin_amdgcn_s_memrealtime(); } while (0)
#define STAMP_END(id) do { if ((id) == PROBE_T && PROBE_BLK_OK && threadIdx.x == 0) TS_LDS[1] += __builtin_amdgcn_s_memrealtime() - TS_LDS[0]; } while (0)
#else
#define STAMP_BEGIN(id) do {} while (0)
#define STAMP_END(id) do {} while (0)
#endif
#ifdef PROBE_TBUSY
#define STAMP_END_BUSY(id) STAMP_END(id)
#define STAMP_END_WALL(id) do {} while (0)
#else
#define STAMP_END_BUSY(id) do {} while (0)
#define STAMP_END_WALL(id) STAMP_END(id)
#endif
#define PHASE_IDS const int tid = opaque_tid(), lane = tid & 63, wave = __builtin_amdgcn_readfirstlane(tid >> 6), gw = bx * NWAVES + wave, ngw = G * NWAVES; (void)lane; (void)gw; (void)ngw; (void)tid; (void)wave;
    int K1024 = DM, K256 = 256; asm volatile("" : "+s"(K1024), "+s"(K256));
    STAMP_BEGIN(0);
    {
        PHASE_IDS
        const float* x = args.in[0]; bf16_t* bufA = (bf16_t*)(ws + WS_BUFA); float* ssqA = (float*)(ws + WS_SSQA);
        PrepArgs pa; pa.w_in = args.in[3]; pa.norm_g = args.in[2]; pa.w_out = args.in[14]; pa.ple_g = args.in[15]; pa.w_gate = args.in[16]; pa.w_proj = args.in[17]; pa.w_up = args.in[6]; pa.a_up = args.in[8]; pa.ws = ws;
        prep_tables(ws, bx * NWAVES * 64 + tid, G * NWAVES * 64);
        prep_weights(pa, gw, ngw, (LAS float*)((LAS unsigned char*)lds + wave * 16384), lane, 0, DEPTH);
#ifdef PROBE_PRO
        prep_weights(pa, gw, ngw, (LAS float*)((LAS unsigned char*)lds + wave * 16384), lane, 0, DEPTH);
        for (int m = gw; m < MTOK; m += ngw) x_row_to_bf16(x + (size_t)m * DM, bufA + (size_t)m * DM, ssqA + (size_t)m * 16, lane);
#endif
        for (int m = gw; m < MTOK; m += ngw) x_row_to_bf16(x + (size_t)m * DM, bufA + (size_t)m * DM, ssqA + (size_t)m * 16, lane);
    }
    STAMP_END_BUSY(0);
    GRID_BAR();
    STAMP_END_WALL(0);
    STAMP_BEGIN(1);
#pragma clang loop unroll(full)
    for (int L = 0; L < DEPTH; ++L) {
#define PHASE_PTRS unsigned char* ws = WSP; bf16_t* cur = (bf16_t*)(ws + ((L & 1) ? WS_BUFB : WS_BUFA)); bf16_t* oth = (bf16_t*)(ws + ((L & 1) ? WS_BUFA : WS_BUFB)); const unsigned char* wl = ws + WS_W + (size_t)L * W_LAYER; \
        bf16_t* Z = (bf16_t*)(ws + WS_Z); float* PP = (float*)(ws + WS_Z); bf16_t* PB = (bf16_t*)(ws + WS_PB); float* ssqA = (float*)(ws + WS_SSQA); float* ssqB = (float*)(ws + WS_SSQB); float* out = OUTP; \
        (void)cur; (void)oth; (void)wl; (void)Z; (void)PP; (void)PB; (void)ssqA; (void)ssqB; (void)out;
        {
            PHASE_PTRS
            const float* tab16 = (const float*)(ws + WS_TAB16); const float* tabI = (const float*)(ws + WS_TABI);
            pg8::Gemm g{cur, (const bf16_t*)(wl + W_IN), MTOK, NPAD, K1024}; pg8::StaticOrder S; S.init(MTOK, NPAD, G, bx);
            epi::EpiInProj e; e.Z = Z; e.ssq = ssqA; e.tab16 = tab16; e.tabI = tabI; e.KV = (bf16_t*)(ws + WS_MISC + MISC_KV); e.IKC = (bf16_t*)(ws + WS_MISC + MISC_IKC);
#ifdef PROBE_G1
            pg8::gemm_phase<epi::EpiInProj, pg8::StaticOrder, true, true>((PG8_LAS unsigned char*)lds, g, S, e);
#endif
#ifdef PROBE_G1P
            { epi::EpiPlainZ ep; ep.Z = Z; pg8::gemm_phase<epi::EpiPlainZ, pg8::StaticOrder, true, true>((PG8_LAS unsigned char*)lds, g, S, ep); }
#endif
            pg8::gemm_phase<epi::EpiInProj, pg8::StaticOrder, true, true>((PG8_LAS unsigned char*)lds, g, S, e);
        }
        STAMP_END_BUSY(1);
        GRID_BAR();
        STAMP_END_WALL(1);
        STAMP_BEGIN(2);
        {
            PHASE_PTRS
            MixArgs ma; ma.Z = Z; ma.Y = oth; ma.KV = (const bf16_t*)(ws + WS_MISC + MISC_KV); ma.IKC = (const bf16_t*)(ws + WS_MISC + MISC_IKC); ma.mu = ARGP(4) + L * 1664; ma.w0 = ARGP(5) + L * 384; ma.w_up = ARGP(6) + (size_t)L * 64 * 384; ma.a0 = ARGP(7) + L * 384; ma.a_up = ARGP(8) + (size_t)L * 64 * 384;
            ma.k_k = ARGP(9) + L * 384; ma.k_a = ARGP(10) + L * 384; ma.r_k = ARGP(11) + L * 384; ma.ln_g = ARGP(12) + L * 384; ma.ln_b = ARGP(13) + L * 384;
            rwkv::RArgs ra; ra.mu = ma.mu; ra.w0 = ma.w0; ra.a0 = ma.a0; ra.k_k = ma.k_k; ra.k_a = ma.k_a; ra.r_k = ma.r_k; ra.ln_g = ma.ln_g; ra.ln_b = ma.ln_b;
            ra.wupT = (const bf16_t*)(wl + W_WUPT); ra.aupT = (const bf16_t*)(wl + W_AUPT); ra.RQ = (bf16_t*)out; ra.RM = (bf16_t*)out + (size_t)3072 * 4096;     ra.RN = (bf16_t*)(ws + WS_MISC + MISC_RN); ra.RG = (float*)(ws + WS_MISC + MISC_RG); ra.RB = (float*)(ws + WS_MISC + MISC_RB);
            STAMP_BEGIN(21);
            { unsigned* qctr = (unsigned*)(ws + WS_CTL) + CW_Q + L * 8 + (bx & 7);
#define QW_PTR() ({ unsigned a_; asm volatile("s_mov_b32 %0, %1" : "=s"(a_) : "i"(LDSCTL_OFF + 1536)); (volatile LAS unsigned*)(LAS unsigned char*)(lds_base_u32() + a_); })
              for (;;) {
                  if (opaque_tid() == 0) { const unsigned v_ = __hip_atomic_fetch_add(qctr, 1u, __ATOMIC_RELAXED, __HIP_MEMORY_SCOPE_AGENT); QW_PTR()[0] = v_; }
                  __syncthreads();
                  const unsigned qi = QW_PTR()[0];
                  __syncthreads();
                  if (qi >= 64u) break;
                  dsa::dsa_unit(ma, lds, (bx & 7) * 2 + (int)(qi & 1u), 31 - (int)(qi >> 1));
              } }
            __syncthreads();
            STAMP_END(21); STAMP_BEGIN(22);
            float* LQ = (float*)(ws + WS_MISC);
#ifdef PROBE_DIL
            for (int rep = 0; rep < 2; ++rep)
#endif
            for (int u = bx; u < 768; u += G) dil::dil_unit(ma, LQ, lds, u / 48, (u % 48) >> 4, u & 15);
            __syncthreads();
            STAMP_END(22); STAMP_BEGIN(20);
            {
              rwkv::R1Raw raw; const int tid1 = opaque_tid(); int hprev = -1;
              for (;;) {
                  if (opaque_tid() == 0) { const unsigned v_ = __hip_atomic_fetch_add((unsigned*)(WSP + WS_CTL) + CW_Q + 64 + L * 16, 1u, __ATOMIC_RELAXED, __HIP_MEMORY_SCOPE_AGENT); QW_PTR()[0] = v_; }
                  __syncthreads();
                  const unsigned qr = QW_PTR()[0];
                  __syncthreads();
                  if (qr >= 1536u) break;
                  const int u0 = qr < 768u ? 3 * (int)qr : 1536 + (int)qr, u1 = qr < 768u ? u0 + 3 : u0 + 1;
                  rwkv::r1_load(ma, raw, tid1, u0 / 192, (u0 / 32) % 6, u0 & 31);
#pragma unroll 1
                  for (int u = u0; u < u1; ++u) { const int un = u + 1; const int ck = u & 31, hh = (u / 32) % 6;
                      if (hh != hprev) { __syncthreads(); rwkv::r1_load_params(ra, lds, tid1, hh); __syncthreads(); hprev = hh; }
                      rwkv::rwkv_chunk_unit(ma, ra, lds, u / 192, hh, ck, raw, ck == 0 ? 0 : (u == u0 ? 2 : 1), un < u1, un / 192, (un / 32) % 6, un & 31); } } }
            STAMP_END(20);
            STAMP_BEGIN(23);
        }
        STAMP_END_BUSY(2);
        GRID_BAR();
        STAMP_END_WALL(2); STAMP_END(23);
        STAMP_BEGIN(3);
        {
            PHASE_PTRS
            MixArgs ma; ma.Z = Z; ma.Y = oth; const float* LQ = (const float*)(ws + WS_MISC); PHASE_IDS
            rwkv::RArgs ra; ra.mu = ARGP(4) + L * 1664; ra.ln_g = ARGP(12) + L * 384; ra.ln_b = ARGP(13) + L * 384;
            ra.RQ = (bf16_t*)out; ra.RM = (bf16_t*)out + (size_t)3072 * 4096;     ra.RN = (bf16_t*)(ws + WS_MISC + MISC_RN); ra.RG = (float*)(ws + WS_MISC + MISC_RG); ra.RB = (float*)(ws + WS_MISC + MISC_RB);
            if (G > 96) {
#ifdef PROBE_R2
                if (bx < 96) rwkv::rwkv_scan_chain<true>(ra, lds, bx / 6, bx % 6);
#endif
                if (bx < 96) { STAMP_BEGIN(40); rwkv::rwkv_scan_chain(ra, lds, bx / 6, bx % 6, (unsigned*)(ws + WS_CTL) + CW_FLAG + (L * 96 + bx) * 64); STAMP_END(40); }
                else { dil::dil_merge(ma, LQ, (bx - 96) * 512 + tid, (G - 96) * 512);
                    const float* src = ARGP(1) + (size_t)L * MTOK * 256;
                    for (size_t i = (size_t)(bx - 96) * 512 + tid; i < (size_t)MTOK * 256 / 8; i += (size_t)(G - 96) * 512) {
                        const f32x4 a = ((const f32x4*)src)[2 * i], b = ((const f32x4*)src)[2 * i + 1];
                        u32x4 w; w.x = pk2(a.x, a.y); w.y = pk2(a.z, a.w); w.z = pk2(b.x, b.y); w.w = pk2(b.z, b.w); ((u32x4*)PB)[i] = w; }
                }
            } else {
                for (int u = bx; u < 96; u += G) rwkv::rwkv_scan_chain(ra, lds, u / 6, u % 6, (unsigned*)(ws + WS_CTL) + CW_FLAG + (L * 96 + u) * 64);
                dil::dil_merge(ma, LQ, bx * 512 + tid, G * 512);
                { const float* src = ARGP(1) + (size_t)L * MTOK * 256;
                  for (size_t i = (size_t)bx * 512 + tid; i < (size_t)MTOK * 256 / 8; i += (size_t)G * 512) {
                      const f32x4 a = ((const f32x4*)src)[2 * i], b = ((const f32x4*)src)[2 * i + 1];
                      u32x4 w; w.x = pk2(a.x, a.y); w.y = pk2(a.z, a.w); w.z = pk2(b.x, b.y); w.w = pk2(b.z, b.w); ((u32x4*)PB)[i] = w; } }
            }
        }
        STAMP_END_BUSY(3);
        GRID_BAR();
        STAMP_END_WALL(3);
        STAMP_BEGIN(4);
        {
            PHASE_PTRS
            MixArgs ma; ma.Z = Z; ma.Y = oth;
            rwkv::RArgs ra; ra.mu = ARGP(4) + L * 1664; ra.ln_g = ARGP(12) + L * 384; ra.ln_b = ARGP(13) + L * 384;
            ra.RQ = (bf16_t*)out; ra.RM = (bf16_t*)out + (size_t)3072 * 4096;     ra.RB = (float*)(ws + WS_MISC + MISC_RB); PHASE_IDS
            for (int u4 = bx; u4 < 768; u4 += G) { const int u = u4 * 4 + (wave >> 1); rwkv::rwkv_out_unit(ma, ra, lds, u / 192, (u / 32) % 6, u & 31); }
        }
        STAMP_END_BUSY(4);
        GRID_BAR();
        STAMP_END_WALL(4);
        STAMP_BEGIN(5);
        {
            PHASE_PTRS
            pg8::Gemm g{oth, (const bf16_t*)(wl + W_OUT), MTOK, DM, K1024}; pg8::StaticOrder S; S.init(MTOK, DM, G, bx);
            epi::EpiOutProj e; e.xb = cur; e.ssq_out = ssqB;
            pg8::Gemm g2{PB, (const bf16_t*)(wl + W_PROJ), MTOK, DM, K256};
            epi::EpiBf16Plain e2; e2.C = (bf16_t*)PP;
            if ((bx >> 3) & 1) {
                pg8::gemm_phase<epi::EpiBf16Plain, pg8::StaticOrder, true, true>((PG8_LAS unsigned char*)lds, g2, S, e2);
                pg8::gemm_phase<epi::EpiOutProj, pg8::StaticOrder, true, true>((PG8_LAS unsigned char*)lds, g, S, e);
            } else {
                pg8::gemm_phase<epi::EpiOutProj, pg8::StaticOrder, true, true>((PG8_LAS unsigned char*)lds, g, S, e);
                pg8::gemm_phase<epi::EpiBf16Plain, pg8::StaticOrder, true, true>((PG8_LAS unsigned char*)lds, g2, S, e2);
            }
        }
        STAMP_END_BUSY(5);
        GRID_BAR();
        STAMP_END_WALL(5);
        STAMP_BEGIN(6);
        {
            PHASE_PTRS
            pg8::Gemm g{cur, (const bf16_t*)(wl + W_GATE), MTOK, DM, K1024}; pg8::StaticOrder S; S.init(MTOK, DM, G, bx);
            epi::EpiGate e; e.x1b = cur; e.pp = (const bf16_t*)PP; e.xb = oth; e.ssq_in = ssqB; e.ssq_out = ssqA;
            pg8::gemm_phase<epi::EpiGate, pg8::StaticOrder, true, true>((PG8_LAS unsigned char*)lds, g, S, e);
        }
        STAMP_END_BUSY(6);
        GRID_BAR();
        STAMP_END_WALL(6);
        STAMP_BEGIN(1); STAMP_BEGIN(7);
    }
    {
        const int L = 0; PHASE_PTRS
        const float* fg = ARGP(18); PHASE_IDS
        const bf16_t* xb = (const bf16_t*)(ws + ((DEPTH & 1) ? WS_BUFB : WS_BUFA));
        for (int m = gw; m < MTOK; m += ngw) { const float rs = row_rstd(ssqA + (size_t)m * 16); f32x4* orow = (f32x4*)(out + (size_t)m * DM);
#pragma unroll
            for (int j = 0; j < 2; ++j) { const int c8 = 64 * j + lane; const u32x4 w = ((const u32x4*)(xb + (size_t)m * DM))[c8]; const f32x4 g0 = ((const f32x4*)fg)[2 * c8], g1 = ((const f32x4*)fg)[2 * c8 + 1];
                const f32x4 a = {bflo(w.x), bfhi(w.x), bflo(w.y), bfhi(w.y)}, b = {bflo(w.z), bfhi(w.z), bflo(w.w), bfhi(w.w)};
                orow[2 * c8] = a * rs * g0; orow[2 * c8 + 1] = b * rs * g1; } }
    }
#ifdef PROBE_T
    if (PROBE_T == 7) { __syncthreads(); STAMP_END(7); }
#ifdef PROBE_MAX
    { unsigned long long* slots = (unsigned long long*)(WSP + 512 * 1024);
      if (threadIdx.x == 0) __hip_atomic_store(slots + blockIdx.x, (unsigned long long)TS_LDS[1], __ATOMIC_RELAXED, __HIP_MEMORY_SCOPE_AGENT);
      GRID_BAR();
      if (blockIdx.x == 0 && threadIdx.x == 0) { unsigned long long mx = 0, mn = ~0ull, sm = 0;
          for (int i = 0; i < (int)gridDim.x; ++i) { const unsigned long long v = __hip_atomic_load(slots + i, __ATOMIC_RELAXED, __HIP_MEMORY_SCOPE_AGENT); mx = v > mx ? v : mx; mn = v < mn ? v : mn; sm += v; }
          TS_LDS[1] = PROBE_MAX == 1 ? mx : (PROBE_MAX == 2 ? mn : sm / gridDim.x); } }
#endif
    if (blockIdx.x == 0 && threadIdx.x == 0) { const unsigned long long t0 = __builtin_amdgcn_s_memrealtime(), w = 4ull * TS_LDS[1]; while (__builtin_amdgcn_s_memrealtime() - t0 < w) __builtin_amdgcn_s_sleep(8); }
#endif
}

extern "C" void kernel_launch(void* const* d_in, const int* in_sizes, int n_in, void* d_out, int out_size, void* d_ws, size_t ws_size, hipStream_t stream) {
    static int grid = 0;
    if (grid == 0) {
        if (n_in != 19 || out_size != MTOK * DM || ws_size < WS_END) { fprintf(stderr, "kernel_launch: unexpected shapes n_in %d out %d ws %zu\n", n_in, out_size, ws_size); grid = -1; return; }
        int dev = 0, cus = 0, per_cu = 0;
        if (hipGetDevice(&dev) != hipSuccess || hipDeviceGetAttribute(&cus, hipDeviceAttributeMultiprocessorCount, dev) != hipSuccess) { grid = -1; return; }
        if (hipFuncSetAttribute((const void*)mega_fwd, hipFuncAttributeMaxDynamicSharedMemorySize, LDS_BYTES) != hipSuccess) { fprintf(stderr, "kernel_launch: hipFuncSetAttribute failed\n"); grid = -1; return; }
        if (hipOccupancyMaxActiveBlocksPerMultiprocessor(&per_cu, (const void*)mega_fwd, NWAVES * 64, LDS_BYTES) != hipSuccess || per_cu < 1) { fprintf(stderr, "kernel_launch: occupancy query says %d blocks per CU\n", per_cu); (void)hipGetLastError(); grid = -1; return; }
        grid = cus;
    }
    if (grid < 0) return;
    if (hipMemsetAsync((char*)d_ws + WS_CTL, 0, 1 * MiB, stream) != hipSuccess) return;
    Args a; memset(&a, 0, sizeof a);
    for (int i = 0; i < 19; ++i) a.in[i] = (const float*)d_in[i];
    a.out = (float*)d_out; a.ws = (unsigned char*)d_ws;
    hipLaunchKernelGGL(mega_fwd, dim3(grid), dim3(NWAVES * 64), LDS_BYTES, stream, a);
}
```

```cpp
#include <hip/hip_runtime.h>
#include <cstdio>
#include <cstdint>
#include <cmath>
#include <cstring>

constexpr int BATCH = 16, SEQ = 2048, DM = 1024, DEPTH = 4, MTOK = BATCH * SEQ;
constexpr int ZP = 4136;
constexpr int NPAD = 4352;
constexpr int ZA_R = 0, ZA_K = 384, ZA_V = 768, ZA_G = 1152, ZA_WD = 1536, ZA_AD = 1600;
constexpr int ZB_Q = 1664, ZB_K = 1920, ZB_V = 1984, ZB_IQ = 2048, ZB_IK = 2304, ZB_IW = 2336, ZB_G = 2344;
constexpr int ZC_Q = 2600, ZC_K = 2984, ZC_V = 3368, ZC_G = 3752;
constexpr float LOG2E = 1.4426950408889634f;
constexpr float QSCALE = 0.125f * LOG2E;
constexpr float IQSCALE = 0.17677669529663687f;
constexpr float IWSCALE = 0.35355339059327373f;
constexpr float NORM_EPS = 1e-6f, GN_EPS = 64e-5f;
constexpr float DECAY_SCALE = 0.6065306597126334f;

typedef unsigned short bf16_t;
typedef short bf16x8 __attribute__((ext_vector_type(8)));
typedef float f32x4 __attribute__((ext_vector_type(4)));
typedef float f32x16 __attribute__((ext_vector_type(16)));
typedef unsigned u32x4 __attribute__((ext_vector_type(4)));
typedef unsigned u32x2 __attribute__((ext_vector_type(2)));

__device__ __forceinline__ unsigned f2bf(float f) { unsigned u = __builtin_bit_cast(unsigned, f); return (u + 0x7fffu + ((u >> 16) & 1u)) >> 16; }
typedef float f32x2_t __attribute__((ext_vector_type(2))); typedef __bf16 bf16x2_t __attribute__((ext_vector_type(2)));
__device__ __forceinline__ unsigned pk2(float lo, float hi) { const f32x2_t v = {lo, hi}; return __builtin_bit_cast(unsigned, __builtin_convertvector(v, bf16x2_t)); }
__device__ __forceinline__ float bf2f(unsigned short b) { return __builtin_bit_cast(float, (unsigned)b << 16); }
__device__ __forceinline__ float bflo(unsigned w) { return __builtin_bit_cast(float, w << 16); }
__device__ __forceinline__ float bfhi(unsigned w) { return __builtin_bit_cast(float, w & 0xffff0000u); }
__device__ __forceinline__ float sigmoidf_(float x) { return __builtin_amdgcn_rcpf(1.0f + __builtin_amdgcn_exp2f(-1.4426950408889634f * x)); }
__device__ __forceinline__ float fexp_(float x) { return __builtin_amdgcn_exp2f(1.4426950408889634f * x); }
__device__ __forceinline__ float tanhf_(float x) { const float e = __builtin_amdgcn_exp2f(fminf(2.8853900817779268f * x, 60.f)); return 1.0f - 2.0f * __builtin_amdgcn_rcpf(e + 1.0f); }
__device__ __forceinline__ int opaque_tid() { int t = threadIdx.x; asm volatile("" : "+v"(t)); return t; }
__device__ __forceinline__ u32x4 zero_u32x4() { unsigned z = 0u; asm volatile("" : "+v"(z)); u32x4 r; r.x = z; r.y = z; r.z = z; r.w = z; return r; }
__device__ __forceinline__ float wave_sum(float v) {
#pragma unroll
    for (int o = 1; o < 64; o <<= 1) v += __shfl_xor(v, o);
    return v;
}
__device__ __forceinline__ float wave_max(float v) {
#pragma unroll
    for (int o = 1; o < 64; o <<= 1) v = fmaxf(v, __shfl_xor(v, o));
    return v;
}

constexpr size_t MiB = 1u << 20;
constexpr size_t WS_CTL = 0;
constexpr size_t WS_TAB16 = 1 * MiB;
constexpr size_t WS_TABI = WS_TAB16 + 128 * 1024;
constexpr size_t WS_SSQA = WS_TABI + 64 * 1024;
constexpr size_t WS_SSQB = WS_SSQA + 2 * MiB;
constexpr size_t WS_W = 6 * MiB;
constexpr size_t W_LAYER = 14 * MiB, W_IN = 0, W_OUT = 8912896, W_GATE = W_OUT + 2 * MiB, W_PROJ = W_GATE + 2 * MiB, W_WUPT = W_PROJ + 512 * 1024, W_AUPT = W_WUPT + 48 * 1024;
constexpr size_t WS_BUFA = 62 * MiB;
constexpr size_t WS_BUFB = 126 * MiB;
constexpr size_t WS_PB = 190 * MiB;
constexpr size_t WS_Z = 206 * MiB;
constexpr size_t WS_Z_END = WS_Z + (size_t)MTOK * ZP * 2;
constexpr size_t WS_MISC = 465 * MiB;
constexpr size_t WS_END = 512 * MiB;
constexpr size_t MISC_LQ = 0, MISC_RG = 1 * MiB, MISC_RN = 2 * MiB, MISC_RB = 26 * MiB, MISC_KV = 27 * MiB, MISC_IKC = 35 * MiB;
static_assert(W_AUPT + 48 * 1024 <= W_LAYER && WS_W + 4 * W_LAYER <= WS_BUFA && WS_Z_END <= WS_MISC, "ws map");
namespace pg8 {
#define PG8_LAS __attribute__((address_space(3)))
typedef unsigned short bf16_t;
typedef short bf16x8 __attribute__((ext_vector_type(8)));
typedef float f32x4 __attribute__((ext_vector_type(4)));
typedef unsigned u32x4 __attribute__((ext_vector_type(4)));
constexpr int BM = 256, BK = 64, HALF = 128, HTB = HALF * BK * 2  , STAGE_BYTES = 8 * HTB, NXCD = 8, WGM = 8;

__host__ __device__ __forceinline__ int lds_byte(int r, int c) { const int st = (r >> 4) * 2 + (c >> 5), rr = r & 15, cc = c & 31, ob = rr * 64 + cc * 2; return st * 1024 + (ob ^ (((ob >> 9) & 1) << 5)); }
__host__ __device__ __forceinline__ void stage_rc(int b, int& R, int& C) { const int st = b / 1024, sb = b % 1024, swz = sb ^ (((sb >> 9) & 1) << 5); R = (st >> 1) * 16 + swz / 64; C = (st & 1) * 32 + (swz % 64) / 2; }
__host__ __device__ __forceinline__ int perm32(int rho) { const int n = rho >> 4, i = rho & 15; return 8 * (i >> 2) + 4 * n + (i & 3); }

struct Unit { int pm, pn; };
struct Gemm { const bf16_t* A; const bf16_t* Bt; int M, N, K; };

struct StaticOrder {
    int nM, nN, nwg, G, c;
    __host__ __device__ void init(int M, int N, int G_, int c_) { nM = M / BM; nN = N / BM; nwg = nM * nN; G = G_; c = c_; }
    __host__ __device__ bool next(int i, Unit& u) const {
        const long L = (long)i * G + c; if (L >= nwg) return false;
        int wgid = (int)L; { const int q = nwg / NXCD, r = nwg % NXCD, xcd = wgid % NXCD, off = wgid / NXCD; wgid = (xcd < r ? xcd * (q + 1) : r * (q + 1) + (xcd - r) * q) + off; }
        const int nig = WGM * nN, gid = wgid / nig, fm = gid * WGM, gsz = (nM - fm) < WGM ? (nM - fm) : WGM;
        u.pm = fm + ((wgid % nig) % gsz); u.pn = (wgid % nig) / gsz; return true;
    }
    __device__ __forceinline__ void a_ready(const Unit&) const {}
    __device__ __forceinline__ void done(const Unit&) const {}
};

__device__ __forceinline__ unsigned cvt_pk_bf16(float lo, float hi) { unsigned r; asm volatile("v_cvt_pk_bf16_f32 %0, %1, %2" : "=v"(r) : "v"(lo), "v"(hi)); return r; }
template <class Epi, class Sched, bool ALIGN_EPI = false, bool SP2 = false>
__device__ __forceinline__ void gemm_phase(PG8_LAS unsigned char* lds, const Gemm g, const Sched& S, const Epi& E) {
    int tid_ = threadIdx.x; asm volatile("" : "+v"(tid_));
    const int tid = tid_, wid = __builtin_amdgcn_readfirstlane(tid >> 6), lane = tid & 63, wr = wid >> 2, wc = wid & 3, fr = lane & 15, fq = lane >> 4;
    const int K = g.K, nt = K / BK;
    unsigned voffA[2], voffB[2];
#pragma unroll
    for (int i = 0; i < 2; ++i) { int R, C; stage_rc(tid * 16 + i * 8192, R, C); const int Rb = Epi::PERM ? ((R & ~31) + perm32(R & 31)) : R;
        voffA[i] = (unsigned)(R * K + C) * 2u; voffB[i] = (unsigned)(Rb * K + C) * 2u; }
    const size_t kstep = (size_t)(BK * 2);
    const size_t hstep = (size_t)HALF * K * 2;
    const size_t tstep = 2 * hstep;
    const unsigned ldsw = (unsigned)wid * 1024u;
    const int aoff = lds_byte(wr * 64 + fr, fq * 8), boff = lds_byte(wc * 32 + fr, fq * 8);
#define PG8_SA(b, h) (((b) * 2 + (h)) * HTB)
#define PG8_SB(b, h) ((4 + (b) * 2 + (h)) * HTB)
#define PG8_STAGE(bufoff, gbase, voff) do { _Pragma("unroll") for (int _i = 0; _i < 2; ++_i) \
        __builtin_amdgcn_global_load_lds((const unsigned*)((const char*)(gbase) + (voff)[_i]), (PG8_LAS unsigned*)(lds + (bufoff) + ldsw + _i * 8192), 16, 0, 0); } while (0)
#define PG8_LDA(dst, b, h) do { _Pragma("unroll") for (int m = 0; m < 4; ++m) _Pragma("unroll") for (int k = 0; k < 2; ++k) dst[m][k] = *(const PG8_LAS bf16x8*)(lds + PG8_SA(b, h) + aoff + m * 2048 + k * 1024); } while (0)
#define PG8_LDB(dst, b, h) do { _Pragma("unroll") for (int n = 0; n < 2; ++n) _Pragma("unroll") for (int k = 0; k < 2; ++k) dst[n][k] = *(const PG8_LAS bf16x8*)(lds + PG8_SB(b, h) + boff + n * 2048 + k * 1024); } while (0)
#define PG8_MMA(ai, bj, At, Bt) do { __builtin_amdgcn_s_setprio(1); _Pragma("unroll") for (int m = 0; m < 4; ++m) _Pragma("unroll") for (int n = 0; n < 2; ++n) _Pragma("unroll") for (int k = 0; k < 2; ++k) \
        acc[ai][bj][m][n] = __builtin_amdgcn_mfma_f32_16x16x32_bf16(Bt[n][k], At[m][k], acc[ai][bj][m][n], 0, 0, 0); __builtin_amdgcn_s_setprio(0); } while (0)
#define PG8_WAIT_V(n) asm volatile("s_waitcnt vmcnt(" #n ")" ::: "memory")
#define PG8_WAIT_L(n) asm volatile("s_waitcnt lgkmcnt(" #n ")" ::: "memory")
#define PG8_BAR __builtin_amdgcn_s_barrier()
#define PG8_SCHED __builtin_amdgcn_sched_barrier(0)
    Unit cur, nxt; int ui = 0;
    if (!S.next(0, cur)) return;
    f32x4 acc[2][2][4][2];
#pragma unroll
    for (int a = 0; a < 2; ++a)
#pragma unroll
        for (int b = 0; b < 2; ++b)
#pragma unroll
            for (int m = 0; m < 4; ++m)
#pragma unroll
                for (int n = 0; n < 2; ++n) acc[a][b][m][n] = (f32x4){0.f, 0.f, 0.f, 0.f};
    bf16x8 At[4][2], B0[2][2], B1[2][2];
    const char* cA = (const char*)g.A + (size_t)cur.pm * tstep; const char* cB = (const char*)g.Bt + (size_t)cur.pn * tstep;
    S.a_ready(cur);
    if constexpr (SP2) {
        PG8_STAGE(PG8_SB(0, 0), cB, voffB); PG8_STAGE(PG8_SB(0, 1), cB + hstep, voffB); PG8_STAGE(PG8_SA(0, 0), cA, voffA); PG8_STAGE(PG8_SA(0, 1), cA + hstep, voffA);
        if (wr == 1) PG8_BAR;
        PG8_WAIT_V(2); PG8_BAR;
        PG8_STAGE(PG8_SB(1, 0), cB + kstep, voffB); PG8_STAGE(PG8_SA(1, 0), cA + kstep, voffA); PG8_STAGE(PG8_SB(1, 1), cB + hstep + kstep, voffB);
        PG8_WAIT_V(6); PG8_BAR;
    } else {
        PG8_STAGE(PG8_SB(0, 0), cB, voffB); PG8_STAGE(PG8_SA(0, 0), cA, voffA); PG8_STAGE(PG8_SB(0, 1), cB + hstep, voffB); PG8_STAGE(PG8_SA(0, 1), cA + hstep, voffA);
        if (wr == 1) PG8_BAR;
        PG8_WAIT_V(4); PG8_BAR;
        PG8_STAGE(PG8_SB(1, 0), cB + kstep, voffB); PG8_STAGE(PG8_SA(1, 0), cA + kstep, voffA); PG8_STAGE(PG8_SB(1, 1), cB + hstep + kstep, voffB);
        PG8_WAIT_V(6); PG8_BAR;
    }
    for (;;) {
        const bool has_next = S.next(ui + 1, nxt);
        const char* nA = has_next ? (const char*)g.A + (size_t)nxt.pm * tstep : cA; const char* nB = has_next ? (const char*)g.Bt + (size_t)nxt.pn * tstep : cB;
        for (int t = 0; t < nt; t += 2) {
            const bool last = (t == nt - 2);
            const char* a1 = cA + (size_t)(t + 1) * kstep;
            const char* a2 = last ? nA : cA + (size_t)(t + 2) * kstep; const char* b2 = last ? nB : cB + (size_t)(t + 2) * kstep;
            const char* a3 = a2 + kstep; const char* b3 = b2 + kstep;
            if (last && has_next) S.a_ready(nxt);
            if constexpr (SP2) {
            PG8_LDB(B0, 0, 0); PG8_LDB(B1, 0, 1); PG8_SCHED; PG8_LDA(At, 0, 0); PG8_STAGE(PG8_SA(1, 1), a1 + hstep, voffA);
            PG8_WAIT_V(8); PG8_WAIT_L(0); PG8_BAR; PG8_MMA(0, 0, At, B0); PG8_MMA(0, 1, At, B1); PG8_BAR; PG8_SCHED;
            PG8_LDA(At, 0, 1); PG8_STAGE(PG8_SB(0, 0), b2, voffB); PG8_STAGE(PG8_SB(0, 1), b2 + hstep, voffB); PG8_STAGE(PG8_SA(0, 0), a2, voffA);
            PG8_WAIT_V(8); PG8_WAIT_L(0); PG8_BAR; PG8_MMA(1, 0, At, B0); PG8_MMA(1, 1, At, B1); PG8_BAR; PG8_SCHED;
            PG8_LDB(B0, 1, 0); PG8_LDB(B1, 1, 1); PG8_SCHED; PG8_LDA(At, 1, 0); PG8_STAGE(PG8_SA(0, 1), a2 + hstep, voffA);
            PG8_WAIT_V(8); PG8_WAIT_L(0); PG8_BAR; PG8_MMA(0, 0, At, B0); PG8_MMA(0, 1, At, B1); PG8_BAR; PG8_SCHED;
            PG8_LDA(At, 1, 1); PG8_STAGE(PG8_SB(1, 0), b3, voffB); PG8_STAGE(PG8_SB(1, 1), b3 + hstep, voffB); PG8_STAGE(PG8_SA(1, 0), a3, voffA);
            PG8_WAIT_V(8); PG8_WAIT_L(0); PG8_BAR; PG8_MMA(1, 0, At, B0); PG8_MMA(1, 1, At, B1); PG8_BAR; PG8_SCHED;
            } else {
            PG8_LDB(B0, 0, 0); PG8_SCHED; PG8_LDA(At, 0, 0); PG8_STAGE(PG8_SA(1, 1), a1 + hstep, voffA);
            PG8_WAIT_L(8); PG8_BAR; PG8_WAIT_L(0); PG8_MMA(0, 0, At, B0); PG8_BAR; PG8_SCHED;
            PG8_LDB(B1, 0, 1); PG8_STAGE(PG8_SB(0, 0), b2, voffB);
            PG8_BAR; PG8_WAIT_L(0); PG8_MMA(0, 1, At, B1); PG8_BAR;
            PG8_LDA(At, 0, 1); PG8_STAGE(PG8_SA(0, 0), a2, voffA);
            PG8_BAR; PG8_WAIT_L(0); PG8_MMA(1, 0, At, B0); PG8_BAR; PG8_SCHED;
            PG8_STAGE(PG8_SB(0, 1), b2 + hstep, voffB);
            PG8_WAIT_V(6); PG8_BAR; PG8_MMA(1, 1, At, B1); PG8_BAR;
            PG8_LDB(B0, 1, 0); PG8_SCHED; PG8_LDA(At, 1, 0); PG8_STAGE(PG8_SA(0, 1), a2 + hstep, voffA);
            PG8_WAIT_L(8); PG8_BAR; PG8_WAIT_L(0); PG8_MMA(0, 0, At, B0); PG8_BAR; PG8_SCHED;
            PG8_LDB(B1, 1, 1); PG8_STAGE(PG8_SB(1, 0), b3, voffB);
            PG8_BAR; PG8_WAIT_L(0); PG8_MMA(0, 1, At, B1); PG8_BAR;
            PG8_LDA(At, 1, 1); PG8_STAGE(PG8_SA(1, 0), a3, voffA);
            PG8_BAR; PG8_WAIT_L(0); PG8_MMA(1, 0, At, B0); PG8_BAR; PG8_SCHED;
            PG8_STAGE(PG8_SB(1, 1), b3 + hstep, voffB);
            PG8_WAIT_V(6); PG8_BAR; PG8_MMA(1, 1, At, B1); PG8_BAR;
            }
        }
        if constexpr (ALIGN_EPI) { if (wr == 0) PG8_BAR; }
        if constexpr (!Epi::AFTER_DRAIN) { E(acc, cur, wr, wc, fr, fq); S.done(cur); }
        if (!has_next) break;
#pragma unroll
        for (int a = 0; a < 2; ++a)
#pragma unroll
            for (int b = 0; b < 2; ++b)
#pragma unroll
                for (int m = 0; m < 4; ++m)
#pragma unroll
                    for (int n = 0; n < 2; ++n) acc[a][b][m][n] = (f32x4){0.f, 0.f, 0.f, 0.f};
        cur = nxt; cA = nA; cB = nB; ++ui;
        if constexpr (ALIGN_EPI) { if (wr == 1) PG8_BAR; }
    }
    PG8_WAIT_V(0);
    if constexpr (!ALIGN_EPI) { if (wr == 0) PG8_BAR; }
    PG8_BAR;
    if constexpr (Epi::AFTER_DRAIN) { E.fused(acc, cur, wr, wc, fr, fq, lds, wid, lane); S.done(cur); }
#undef PG8_SA
#undef PG8_SB
#undef PG8_STAGE
#undef PG8_LDA
#undef PG8_LDB
#undef PG8_MMA
#undef PG8_WAIT_V
#undef PG8_WAIT_L
#undef PG8_BAR
#undef PG8_SCHED
}
}
#define GAS __attribute__((address_space(1)))
#define LAS __attribute__((address_space(3)))

__device__ __forceinline__ int zcol_src(int n, float& sc) {
    sc = 1.f;
    if (n < ZB_Q) return n;
    if (n < ZB_K) { int o = n - ZB_Q, h = o >> 6, d = o & 63; sc = QSCALE; if (d < 16) d = (d >> 1) + 8 * (d & 1); return ZB_Q + h * 64 + d; }
    if (n < ZB_V) { int d = n - ZB_K; if (d < 16) d = (d >> 1) + 8 * (d & 1); return ZB_K + d; }
    if (n < ZB_IQ) return n;
    if (n < ZB_IK) { int o = n - ZB_IQ, h = o >> 5, d = o & 31; sc = IQSCALE; if (d < 8) d = (d >> 1) + 4 * (d & 1); return ZB_IQ + h * 32 + d; }
    if (n < ZB_IW) { int d = n - ZB_IK; if (d < 8) d = (d >> 1) + 4 * (d & 1); return ZB_IK + d; }
    if (n < ZB_G) { sc = IWSCALE; return n; }
    if (n < ZC_Q) return n;
    if (n < ZC_K) { int o = n - ZC_Q, h = o >> 6, d = o & 63; sc = QSCALE; if (d < 16) d = (d >> 1) + 8 * (d & 1); return ZC_Q + h * 64 + d; }
    if (n < ZC_V) { int o = n - ZC_K, h = o >> 6, d = o & 63; if (d < 16) d = (d >> 1) + 8 * (d & 1); return ZC_K + h * 64 + d; }
    return n;
}

template <bool ZMAP>
__device__ __forceinline__ void transpose_item(const float* __restrict__ W, int K, int NW, bf16_t* WT, const float* __restrict__ kscale, LAS float* scr, int item, int nblk, int lane) {
    const int kb = item / nblk, nb = item % nblk, k0 = 64 * kb, n0 = 32 * nb;
    const int c4 = 4 * (lane & 7), ncol = n0 + c4;
    f32x4 v[8];
#pragma unroll
    for (int i = 0; i < 8; ++i) { const int kk = (lane >> 3) + 8 * i; v[i] = (f32x4){0.f, 0.f, 0.f, 0.f}; if (ncol < NW) v[i] = *(const f32x4*)(W + (size_t)(k0 + kk) * NW + ncol); }
#pragma unroll
    for (int i = 0; i < 8; ++i) { const int kk = (lane >> 3) + 8 * i; f32x4 x = v[i]; if (kscale) x = x * kscale[k0 + kk];
        scr[kk * 33 + c4] = x[0]; scr[kk * 33 + c4 + 1] = x[1]; scr[kk * 33 + c4 + 2] = x[2]; scr[kk * 33 + c4 + 3] = x[3]; }
    asm volatile("s_waitcnt lgkmcnt(0)" ::: "memory");
    const int c = lane & 7;
#pragma unroll
    for (int j = 0; j < 4; ++j) { const int n = (lane >> 3) + 8 * j; int sl = n; float sc = 1.f;
        if (ZMAP) { if (n0 + n < NW) sl = zcol_src(n0 + n, sc) - n0; else { sl = n; sc = 0.f; } }
        const LAS float* s = scr + (8 * c) * 33 + sl;
        u32x4 o; o.x = pk2(s[0 * 33] * sc, s[1 * 33] * sc); o.y = pk2(s[2 * 33] * sc, s[3 * 33] * sc); o.z = pk2(s[4 * 33] * sc, s[5 * 33] * sc); o.w = pk2(s[6 * 33] * sc, s[7 * 33] * sc);
        *(u32x4*)(WT + (size_t)(n0 + n) * K + k0 + 8 * c) = o; }
    asm volatile("s_waitcnt lgkmcnt(0)" ::: "memory");
}

struct PrepArgs { const float* w_in; const float* norm_g; const float* w_out; const float* ple_g; const float* w_gate; const float* w_proj; const float* w_up; const float* a_up; unsigned char* ws; };

__device__ __forceinline__ void prep_weights(const PrepArgs& a, int gw, int ngw, LAS float* scr, int lane, int L0, int L1) {
    constexpr int I_IN = 16 * (NPAD / 32), I_SQ = 16 * 32, I_PJ = 4 * 32, I_UP = 12, I_LAYER = I_IN + 2 * I_SQ + I_PJ + 2 * I_UP;
    for (int it = gw; it < (L1 - L0) * I_LAYER; it += ngw) {
        const int L = L0 + it / I_LAYER; int r = it % I_LAYER;
        unsigned char* wl = a.ws + WS_W + (size_t)L * W_LAYER;
        if (r < I_IN) { transpose_item<true>(a.w_in + (size_t)L * DM * ZP, DM, ZP, (bf16_t*)(wl + W_IN), a.norm_g + L * DM, scr, r, NPAD / 32, lane); continue; } r -= I_IN;
        if (r < I_SQ) { transpose_item<false>(a.w_out + (size_t)L * DM * DM, DM, DM, (bf16_t*)(wl + W_OUT), nullptr, scr, r, 32, lane); continue; } r -= I_SQ;
        if (r < I_SQ) { transpose_item<false>(a.w_gate + (size_t)L * DM * DM, DM, DM, (bf16_t*)(wl + W_GATE), a.ple_g + L * DM, scr, r, 32, lane); continue; } r -= I_SQ;
        if (r < I_PJ) { transpose_item<false>(a.w_proj + (size_t)L * 256 * DM, 256, DM, (bf16_t*)(wl + W_PROJ), nullptr, scr, r, 32, lane); continue; } r -= I_PJ;
        if (r < I_UP) { transpose_item<false>(a.w_up + (size_t)L * 64 * 384, 64, 384, (bf16_t*)(wl + W_WUPT), nullptr, scr, r, 12, lane); continue; } r -= I_UP;
        transpose_item<false>(a.a_up + (size_t)L * 64 * 384, 64, 384, (bf16_t*)(wl + W_AUPT), nullptr, scr, r, 12, lane);
    }
}

__device__ __forceinline__ void sincos_d(float ang, float& c, float& s) {
    const double a = (double)ang; const double n = rint(a * 0.63661977236758134308);
    double r = fma(-n, 1.57079632679489655800e+00, a); r = fma(-n, 6.12323399573676603587e-17, r);
    const double r2 = r * r;
    double sp = r2 * (1.0 / 6227020800.0) - 1.0 / 39916800.0; sp = sp * r2 + 1.0 / 362880.0; sp = sp * r2 - 1.0 / 5040.0; sp = sp * r2 + 1.0 / 120.0; sp = sp * r2 - 1.0 / 6.0; sp = sp * r2 * r + r;
    double cp = r2 * (1.0 / 479001600.0) - 1.0 / 3628800.0; cp = cp * r2 + 1.0 / 40320.0; cp = cp * r2 - 1.0 / 720.0; cp = cp * r2 + 1.0 / 24.0; cp = cp * r2 - 0.5; cp = cp * r2 + 1.0;
    const int q = ((int)n) & 3;
    const double sv = (q == 0) ? sp : (q == 1) ? cp : (q == 2) ? -sp : -cp;
    const double cv = (q == 0) ? cp : (q == 1) ? -sp : (q == 2) ? -cp : sp;
    c = (float)cv; s = (float)sv;
}
__device__ __forceinline__ void prep_tables(unsigned char* ws, int gtid, int nthreads) {
    const float inv8[8] = {1.0f, 0.1939227432012558f, 0.03760603070259094f, 0.007292664609849453f, 0.0014142135623842478f, 0.00027424818836152554f, 5.318296098266728e-05f, 1.0313386155758053e-05f};
    float* t16 = (float*)(ws + WS_TAB16); float* tI = (float*)(ws + WS_TABI);
    for (int e = gtid; e < SEQ * 8; e += nthreads) { const int pos = e >> 3, i = e & 7;
        float iv = inv8[0];
#pragma unroll
        for (int j = 1; j < 8; ++j) iv = (i == j) ? inv8[j] : iv;
        float c, s; sincos_d((float)pos * iv, c, s); t16[pos * 16 + i] = c; t16[pos * 16 + 8 + i] = s;
        if ((i & 1) == 0) { const int i4 = i >> 1; tI[pos * 8 + i4] = c; tI[pos * 8 + 4 + i4] = s; }
    }
}
__device__ __forceinline__ void x_row_to_bf16(const float* xrow, bf16_t* orow, float* ssq, int lane) {
    const f32x4* xr = (const f32x4*)xrow + lane;
    unsigned long long* o8 = (unsigned long long*)orow + lane;
    float s = 0.f;
#pragma unroll
    for (int j = 0; j < 4; ++j) { const f32x4 v = xr[64 * j];
        s += (v.x * v.x + v.y * v.y) + (v.z * v.z + v.w * v.w);
        o8[64 * j] = (unsigned long long)pk2(v.x, v.y) | ((unsigned long long)pk2(v.z, v.w) << 32); }
    s += __builtin_bit_cast(float, __builtin_amdgcn_update_dpp(0, __builtin_bit_cast(int, s), 0xB1, 0xf, 0xf, false));
    s += __builtin_bit_cast(float, __builtin_amdgcn_update_dpp(0, __builtin_bit_cast(int, s), 0x4E, 0xf, 0xf, false));
    if ((lane & 3) == 0) ssq[lane >> 2] = s;
}
__device__ __forceinline__ float row_rstd(const float* ssq_row) {
    const f32x4 a = *(const f32x4*)ssq_row, b = *(const f32x4*)(ssq_row + 4), c = *(const f32x4*)(ssq_row + 8), d = *(const f32x4*)(ssq_row + 12);
    const float s = ((a.x + a.y) + (a.z + a.w)) + ((b.x + b.y) + (b.z + b.w)) + ((c.x + c.y) + (c.z + c.w)) + ((d.x + d.y) + (d.z + d.w));
    return __builtin_amdgcn_rsqf(s * (1.0f / DM) + NORM_EPS);
}
namespace epi {
using pg8::Unit; using pg8::BM; using pg8::HALF;
__device__ __forceinline__ u32x4 pack8(const f32x4& a, const f32x4& b) { u32x4 w; w.x = pg8::cvt_pk_bf16(a[0], a[1]); w.y = pg8::cvt_pk_bf16(a[2], a[3]); w.z = pg8::cvt_pk_bf16(b[0], b[1]); w.w = pg8::cvt_pk_bf16(b[2], b[3]); return w; }
__device__ __forceinline__ int rope_class(int c0, int& fb) {
    fb = 0; int o;
    if (c0 >= ZB_Q && c0 < ZB_V) { o = (c0 - ZB_Q) & 63; if (o < 16) { fb = o >> 1; return 1; } return 0; }
    if (c0 >= ZB_IQ && c0 < ZB_IW) { o = (c0 - ZB_IQ) & 31; return o == 0 ? 2 : 0; }
    if (c0 >= ZC_Q && c0 < ZC_V) { o = (c0 - ZC_Q) & 63; if (o < 16) { fb = o >> 1; return 1; } return 0; }
    return 0;
}
struct EpiInProj {
    static constexpr bool PERM = true, AFTER_DRAIN = false;
    bf16_t* Z; const float* ssq; const float* tab16; const float* tabI; bf16_t* KV; bf16_t* IKC;
    __device__ __forceinline__ void operator()(const f32x4 (&acc)[2][2][4][2], const Unit& u, int wr, int wc, int fr, int fq) const {
        const int row0 = u.pm * BM + wr * 64 + fr;
        const int c00 = u.pn * BM + wc * 32 + 8 * fq, c01 = c00 + HALF;
        int fb0, fb1; const int rc0 = rope_class(c00, fb0), rc1 = rope_class(c01, fb1);
#pragma unroll
        for (int ai = 0; ai < 2; ++ai)
#pragma unroll
            for (int m = 0; m < 4; ++m) {
                const int row = row0 + ai * HALF + m * 16;
                const float rs = row_rstd(ssq + (size_t)row * 16);
                const int pos = row & (SEQ - 1);
#pragma unroll
                for (int bj = 0; bj < 2; ++bj) {
                    const int c0 = bj ? c01 : c00, rc = bj ? rc1 : rc0, fb = bj ? fb1 : fb0;
                    if (c0 >= ZP) continue;
                    f32x4 v0 = acc[ai][bj][m][0] * rs, v1 = acc[ai][bj][m][1] * rs;
                    if (rc) {
                        const float* tp = (rc == 1) ? tab16 + pos * 16 + fb : tabI + pos * 8;
                        const f32x4 c = *(const f32x4*)tp, s = *(const f32x4*)(tp + (rc == 1 ? 8 : 4));
                        f32x4 a0, a1;
                        a0[0] = v0[0] * c[0] - v0[1] * s[0]; a0[1] = v0[1] * c[0] + v0[0] * s[0];
                        a0[2] = v0[2] * c[1] - v0[3] * s[1]; a0[3] = v0[3] * c[1] + v0[2] * s[1];
                        a1[0] = v1[0] * c[2] - v1[1] * s[2]; a1[1] = v1[1] * c[2] + v1[0] * s[2];
                        a1[2] = v1[2] * c[3] - v1[3] * s[3]; a1[3] = v1[3] * c[3] + v1[2] * s[3];
                        v0 = a0; v1 = a1;
                    }
                    const u32x4 pk = pack8(v0, v1);
                    if (c0 >= ZB_K && c0 < ZB_IQ) *(u32x4*)(KV + (size_t)row * 128 + (c0 - ZB_K)) = pk;
                    else if (c0 >= ZB_IK && c0 < ZB_IW) *(u32x4*)(IKC + (size_t)row * 32 + (c0 - ZB_IK)) = pk;
                    else *(u32x4*)(Z + (size_t)row * ZP + c0) = pk;
                }
                asm volatile("" ::: "memory");
            }
    }
};
struct EpiPlainZ {
    static constexpr bool PERM = true, AFTER_DRAIN = false;
    bf16_t* Z;
    __device__ __forceinline__ void operator()(const f32x4 (&acc)[2][2][4][2], const Unit& u, int wr, int wc, int fr, int fq) const {
        const int row0 = u.pm * BM + wr * 64 + fr;
#pragma unroll
        for (int ai = 0; ai < 2; ++ai)
#pragma unroll
            for (int m = 0; m < 4; ++m)
#pragma unroll
                for (int bj = 0; bj < 2; ++bj) { const int c0 = u.pn * BM + bj * HALF + wc * 32 + 8 * fq; if (c0 < ZP) *(u32x4*)(Z + (size_t)(row0 + ai * HALF + m * 16) * ZP + c0) = pack8(acc[ai][bj][m][0], acc[ai][bj][m][1]); }
    }
};
struct EpiOutProj {
    static constexpr bool PERM = true, AFTER_DRAIN = false;
    bf16_t* xb; float* ssq_out;
    __device__ __forceinline__ void operator()(const f32x4 (&acc)[2][2][4][2], const Unit& u, int wr, int wc, int fr, int fq) const {
        const int row0 = u.pm * BM + wr * 64 + fr;
#pragma unroll
        for (int ai = 0; ai < 2; ++ai)
#pragma unroll
            for (int m = 0; m < 4; ++m) {
                const int row = row0 + ai * HALF + m * 16; float sq = 0.f;
#pragma unroll
                for (int bj = 0; bj < 2; ++bj) {
                    const size_t off = (size_t)row * DM + u.pn * BM + bj * HALF + wc * 32 + 8 * fq;
                    const u32x4 iw = *(const u32x4*)(xb + off); const f32x4 ia = {bflo(iw.x), bfhi(iw.x), bflo(iw.y), bfhi(iw.y)}, ib = {bflo(iw.z), bfhi(iw.z), bflo(iw.w), bfhi(iw.w)};
                    const f32x4 x0 = ia + acc[ai][bj][m][0], x1 = ib + acc[ai][bj][m][1];
                    *(u32x4*)(xb + off) = pack8(x0, x1);
                    sq += ((x0[0] * x0[0] + x0[1] * x0[1]) + (x0[2] * x0[2] + x0[3] * x0[3])) + ((x1[0] * x1[0] + x1[1] * x1[1]) + (x1[2] * x1[2] + x1[3] * x1[3]));
                }
                sq += __shfl_xor(sq, 16); sq += __shfl_xor(sq, 32);
                if (fq == 0) ssq_out[(size_t)row * 16 + u.pn * 4 + wc] = sq;
            }
    }
};
struct EpiGate {
    static constexpr bool PERM = true, AFTER_DRAIN = false;
    const bf16_t* x1b; const bf16_t* pp; bf16_t* xb; const float* ssq_in; float* ssq_out;
    __device__ __forceinline__ void operator()(const f32x4 (&acc)[2][2][4][2], const Unit& u, int wr, int wc, int fr, int fq) const {
        const int row0 = u.pm * BM + wr * 64 + fr;
#pragma unroll
        for (int ai = 0; ai < 2; ++ai)
#pragma unroll
            for (int m = 0; m < 4; ++m) {
                const int row = row0 + ai * HALF + m * 16; float sq = 0.f;
                const float rs = row_rstd(ssq_in + (size_t)row * 16);
#pragma unroll
                for (int bj = 0; bj < 2; ++bj) {
                    const size_t off = (size_t)row * DM + u.pn * BM + bj * HALF + wc * 32 + 8 * fq;
                    f32x4 g0 = acc[ai][bj][m][0] * rs, g1 = acc[ai][bj][m][1] * rs;
#pragma unroll
                    for (int i = 0; i < 4; ++i) { g0[i] = sigmoidf_(g0[i]); g1[i] = sigmoidf_(g1[i]); }
                    const u32x4 pw = *(const u32x4*)(pp + off); const f32x4 pp0 = {bflo(pw.x), bfhi(pw.x), bflo(pw.y), bfhi(pw.y)}, pp1 = {bflo(pw.z), bfhi(pw.z), bflo(pw.w), bfhi(pw.w)};
                    const u32x4 xw = *(const u32x4*)(x1b + off); const f32x4 xa = {bflo(xw.x), bfhi(xw.x), bflo(xw.y), bfhi(xw.y)}, xc = {bflo(xw.z), bfhi(xw.z), bflo(xw.w), bfhi(xw.w)};
                    const f32x4 x0 = xa + g0 * pp0, x1 = xc + g1 * pp1;
                    *(u32x4*)(xb + off) = pack8(x0, x1);
                    sq += ((x0[0] * x0[0] + x0[1] * x0[1]) + (x0[2] * x0[2] + x0[3] * x0[3])) + ((x1[0] * x1[0] + x1[1] * x1[1]) + (x1[2] * x1[2] + x1[3] * x1[3]));
                }
                sq += __shfl_xor(sq, 16); sq += __shfl_xor(sq, 32);
                if (fq == 0) ssq_out[(size_t)row * 16 + u.pn * 4 + wc] = sq;
            }
    }
};
struct EpiBf16Plain {
    static constexpr bool PERM = true, AFTER_DRAIN = false;
    bf16_t* C;
    __device__ __forceinline__ void operator()(const f32x4 (&acc)[2][2][4][2], const Unit& u, int wr, int wc, int fr, int fq) const {
        const int row0 = u.pm * BM + wr * 64 + fr;
#pragma unroll
        for (int ai = 0; ai < 2; ++ai)
#pragma unroll
            for (int m = 0; m < 4; ++m)
#pragma unroll
                for (int bj = 0; bj < 2; ++bj) {
                    const size_t off = (size_t)(row0 + ai * HALF + m * 16) * DM + u.pn * BM + bj * HALF + wc * 32 + 8 * fq;
                    *(u32x4*)(C + off) = pack8(acc[ai][bj][m][0], acc[ai][bj][m][1]);
                }
    }
};
struct EpiF32 {
    static constexpr bool PERM = true, AFTER_DRAIN = false;
    float* C;
    __device__ __forceinline__ void operator()(const f32x4 (&acc)[2][2][4][2], const Unit& u, int wr, int wc, int fr, int fq) const {
        const int row0 = u.pm * BM + wr * 64 + fr;
#pragma unroll
        for (int ai = 0; ai < 2; ++ai)
#pragma unroll
            for (int m = 0; m < 4; ++m)
#pragma unroll
                for (int bj = 0; bj < 2; ++bj) {
                    const size_t off = (size_t)(row0 + ai * HALF + m * 16) * DM + u.pn * BM + bj * HALF + wc * 32 + 8 * fq;
                    *(f32x4*)(C + off) = acc[ai][bj][m][0]; *(f32x4*)(C + off + 4) = acc[ai][bj][m][1];
                }
    }
};
}
typedef GAS unsigned gu32;
#define RLX_AGENT __ATOMIC_RELAXED, __HIP_MEMORY_SCOPE_AGENT
#define XB_TMO      128
#define XB_XCNT(j)  (256  + 64 * (j))
#define XB_XSUB(j)  (1280 + 64 * (j))
#define XB_XGEN(j)  (2304 + 64 * (j))
#define XB_TOP      3328
#define XB_TOPGEN   3392
#define XCD_BAR_WORDS 3456
#define XB_SPIN_CAP (1u << 27)

__device__ __forceinline__ unsigned xb_ld(unsigned* p)              { return __hip_atomic_load(p, __ATOMIC_RELAXED, __HIP_MEMORY_SCOPE_AGENT); }
__device__ __forceinline__ unsigned xb_add(unsigned* p, unsigned v) { return __hip_atomic_fetch_add(p, v, __ATOMIC_RELAXED, __HIP_MEMORY_SCOPE_AGENT); }
__device__ __forceinline__ unsigned xb_xcc_id() { return (unsigned)__builtin_amdgcn_s_getreg((3 << 11) | 20) & 0xFu; }
#define XB_SPIN(cond, bar) do { unsigned _sp = 0; while (cond) { __builtin_amdgcn_s_sleep(1); \
    if ((++_sp & 255u) == 0u) { if (xb_ld(&(bar)[XB_TMO])) break; if (_sp > XB_SPIN_CAP) { atomicAdd(&(bar)[XB_TMO], 1u); break; } } } } while (0)

struct XcdBarrier {
    unsigned* bar; unsigned x;
    volatile LAS unsigned* st;
};

__device__ __forceinline__ XcdBarrier xcd_barrier_post(unsigned* bar, volatile LAS unsigned* st) {
    XcdBarrier b; b.bar = bar; b.x = xb_xcc_id(); b.st = st;
    if (threadIdx.x == 0) (void)xb_add(&bar[XB_XCNT(b.x)], 1u);
    return b;
}
__device__ __forceinline__ void xcd_barrier_complete(unsigned* bar, unsigned x, unsigned& nloc, unsigned& nx) {
    const unsigned G = gridDim.x * gridDim.y * gridDim.z;
    unsigned sum, cnt, mine, sp = 0u;
    for (;;) {
        sum = 0u; cnt = 0u; mine = 0u;
#pragma unroll
        for (unsigned j = 0; j < 16; ++j) { const unsigned c = xb_ld(&bar[XB_XCNT(j)]); sum += c; cnt += (c > 0u) ? 1u : 0u; mine = (j == x) ? c : mine; }
        if (sum == G) break;
        __builtin_amdgcn_s_sleep(1);
        if ((++sp & 255u) == 0u) { if (xb_ld(&bar[XB_TMO])) break; if (sp > XB_SPIN_CAP) { atomicAdd(&bar[XB_TMO], 1u); break; } }
    }
    nloc = mine > 0u ? mine : 1u; nx = cnt > 0u ? cnt : 1u;
}

__device__ __forceinline__ void xcd_barrier(const XcdBarrier& b) {
    asm volatile("s_waitcnt vmcnt(0)" ::: "memory");
    __syncthreads();
    if (threadIdx.x == 0) {
        unsigned* bar = b.bar;
        __builtin_amdgcn_s_waitcnt(0);
        unsigned nloc = b.st[0], nx = b.st[1];
        if (nloc == 0u) { xcd_barrier_complete(bar, b.x, nloc, nx); b.st[0] = nloc; b.st[1] = nx; }
        const unsigned old = xb_add(&bar[XB_XSUB(b.x)], 1u);
        const unsigned gen = old / nloc;
        if (old + 1u == (gen + 1u) * nloc) {
            __builtin_amdgcn_fence(__ATOMIC_RELEASE, "agent");
            asm volatile("s_waitcnt vmcnt(0)" ::: "memory");
            const unsigned og = xb_add(&bar[XB_TOP], 1u);
            const unsigned tg = og / nx;
            if (og + 1u == (tg + 1u) * nx) xb_add(&bar[XB_TOPGEN], 1u);
            else XB_SPIN(xb_ld(&bar[XB_TOPGEN]) == tg, bar);
            __builtin_amdgcn_fence(__ATOMIC_ACQUIRE, "agent");
            xb_add(&bar[XB_XGEN(b.x)], 1u);
            asm volatile("s_waitcnt vmcnt(0)" ::: "memory");
        } else {
            XB_SPIN(xb_ld(&bar[XB_XGEN(b.x)]) == gen, bar);
            __builtin_amdgcn_fence(__ATOMIC_ACQUIRE, "agent");
            asm volatile("s_waitcnt vmcnt(0)" ::: "memory");
        }
    }
    __syncthreads();
}
struct MixArgs { const bf16_t* Z; bf16_t* Y; const bf16_t* KV; const bf16_t* IKC; const float* mu; const float* w0; const float* w_up; const float* a0; const float* a_up; const float* k_k; const float* k_a; const float* r_k; const float* ln_g; const float* ln_b; };
namespace dsa {
#ifdef PROBE_T
#define DTS ((volatile LAS unsigned long long*)((LAS unsigned char*)ldsb + 131072 + 1024))
#define DSTAMP_B(id) do { if ((id) == PROBE_T && blockIdx.x == 0 && threadIdx.x == 0) DTS[0] = __builtin_amdgcn_s_memrealtime(); } while (0)
#define DSTAMP_E(id) do { if ((id) == PROBE_T && blockIdx.x == 0 && threadIdx.x == 0) DTS[1] += __builtin_amdgcn_s_memrealtime() - DTS[0]; } while (0)
#else
#define DSTAMP_B(id) do {} while (0)
#define DSTAMP_E(id) do {} while (0)
#endif
#define MFMA32(a, b, c) __builtin_amdgcn_mfma_f32_32x32x16_bf16((a), (b), (c), 0, 0, 0)
typedef short v4i16_t __attribute__((ext_vector_type(4)));
typedef short s16x4 __attribute__((ext_vector_type(4)));
constexpr int WAVE_LDS = 2048 + 4096;
constexpr int IKS_OFF = 8 * WAVE_LDS, IKS_BYTES = 65536;
__device__ __forceinline__ unsigned fkey(float f) { const unsigned b = __builtin_bit_cast(unsigned, f); return (b & 0x80000000u) ? ~b : (b | 0x80000000u); }
__device__ __forceinline__ float keyf(unsigned u) { const unsigned b = (u & 0x80000000u) ? (u & 0x7fffffffu) : ~u; return __builtin_bit_cast(float, b); }
__device__ __forceinline__ float relu_(float x) { const int b = __builtin_bit_cast(int, x); return __builtin_bit_cast(float, b > 0 ? b : 0); }
__device__ __forceinline__ s16x4 vtr(const LAS unsigned char* p) { return __builtin_bit_cast(s16x4, __builtin_amdgcn_ds_read_tr16_b64_v4i16((LAS v4i16_t*)p)); }

#define DPP_(v, ctrl) ((unsigned)__builtin_amdgcn_update_dpp((int)(v), (int)(v), (ctrl), 0xf, 0xf, false))
__device__ __forceinline__ unsigned half_min(unsigned v) { v = min(v, DPP_(v, 0xB1)); v = min(v, DPP_(v, 0x4E)); v = min(v, DPP_(v, 0x141)); v = min(v, DPP_(v, 0x140)); return min(v, (unsigned)__builtin_amdgcn_ds_swizzle((int)v, 0x401F)); }
__device__ __forceinline__ unsigned half_max(unsigned v) { v = max(v, DPP_(v, 0xB1)); v = max(v, DPP_(v, 0x4E)); v = max(v, DPP_(v, 0x141)); v = max(v, DPP_(v, 0x140)); return max(v, (unsigned)__builtin_amdgcn_ds_swizzle((int)v, 0x401F)); }
__device__ __forceinline__ int half_sum(int v) { v += (int)DPP_(v, 0xB1); v += (int)DPP_(v, 0x4E); v += (int)DPP_(v, 0x141); v += (int)DPP_(v, 0x140); return v + __builtin_amdgcn_ds_swizzle(v, 0x401F); }
__device__ __forceinline__ unsigned next_pivot(unsigned ulo, unsigned uhi, int clo, int chi, int it) {
    unsigned p;
    const bool hl = clo >= 0, hh = chi >= 0;
    if (it == 0) p = fkey(0.0f);
    else if (!hh) { const float f = keyf(ulo); p = fkey(f >= 0.f ? 2.f * f + 0.25f : 0.5f * f + 0.125f); }
    else if (!hl) { const float f = keyf(uhi); p = fkey(f <= 0.f ? 2.f * f - 0.25f : 0.5f * f - 0.125f); }
    else { const float fl = keyf(ulo), fh = keyf(uhi);
        float fr = ((float)(clo - 256) + 0.5f) * __builtin_amdgcn_rcpf((float)(clo - chi)); fr = fminf(fmaxf(fr, 1.f / 32.f), 31.f / 32.f);
        if (it % 3 == 2) fr = 0.5f;
        p = fkey(fl + (fh - fl) * fr); }
    if (!(p > ulo && p < uhi)) p = ulo + ((uhi - ulo) >> 1);
    return p;
}

__device__ __forceinline__ void dsa_unit(const MixArgs& a, unsigned char* ldsb, int b, int blk) {
    const int tid = opaque_tid(), lane = tid & 63, wave = __builtin_amdgcn_readfirstlane(tid >> 6), r32 = lane & 31, hi = lane >> 5;
    const GAS bf16_t* zb = (const GAS bf16_t*)a.Z + (size_t)b * SEQ * ZP;
    LAS unsigned char* wl = (LAS unsigned char*)ldsb + wave * WAVE_LDS;
    LAS unsigned* bm = (LAS unsigned*)wl;
    LAS unsigned char* vimg = wl + 2048;
    const int tw = blk * 64 + 8 * wave;
    f32x16 zero16;
#pragma unroll
    for (int i = 0; i < 16; ++i) zero16[i] = 0.f;
#ifdef PROBE_SEL
#define NRND 4
#else
#define NRND 2
#endif
#pragma unroll 1
    for (int rnd_ = 0; rnd_ < NRND; ++rnd_) { const int rnd = rnd_ & 1;
        const int tb = tw + 4 * rnd;
        const int qsub = 2 * ((r32 >> 2) & 1) + (r32 >> 4), head = (r32 & 3) + 4 * ((r32 >> 3) & 1);
        const GAS bf16_t* iqp = zb + (size_t)(tb + qsub) * ZP + ZB_IQ + head * 32 + 8 * hi;
        bf16x8 aiq0, aiq1;
        { const u32x4 r0 = *(const GAS u32x4*)iqp, r1 = *(const GAS u32x4*)(iqp + 16); const float wr = bf2f(zb[(size_t)(tb + qsub) * ZP + ZB_IW + head]);
          u32x4 s0, s1;
          s0.x = pk2(bflo(r0.x) * wr, bfhi(r0.x) * wr); s0.y = pk2(bflo(r0.y) * wr, bfhi(r0.y) * wr); s0.z = pk2(bflo(r0.z) * wr, bfhi(r0.z) * wr); s0.w = pk2(bflo(r0.w) * wr, bfhi(r0.w) * wr);
          s1.x = pk2(bflo(r1.x) * wr, bfhi(r1.x) * wr); s1.y = pk2(bflo(r1.y) * wr, bfhi(r1.y) * wr); s1.z = pk2(bflo(r1.z) * wr, bfhi(r1.z) * wr); s1.w = pk2(bflo(r1.w) * wr, bfhi(r1.w) * wr);
          aiq0 = __builtin_bit_cast(bf16x8, s0); aiq1 = __builtin_bit_cast(bf16x8, s1); }
        const int tqA = tb + 2 * hi, tqB = tqA + 1;
        float wA[8], wB[8];
        { const u32x4 ua = *(const GAS u32x4*)(zb + (size_t)tqA * ZP + ZB_IW), ub = *(const GAS u32x4*)(zb + (size_t)tqB * ZP + ZB_IW);
          wA[0] = bflo(ua.x); wA[1] = bfhi(ua.x); wA[2] = bflo(ua.y); wA[3] = bfhi(ua.y); wA[4] = bflo(ua.z); wA[5] = bfhi(ua.z); wA[6] = bflo(ua.w); wA[7] = bfhi(ua.w);
          wB[0] = bflo(ub.x); wB[1] = bfhi(ub.x); wB[2] = bflo(ub.y); wB[3] = bfhi(ub.y); wB[4] = bflo(ub.z); wB[5] = bfhi(ub.z); wB[6] = bflo(ub.w); wB[7] = bfhi(ub.w); }
#pragma unroll
        for (int r = 0; r < 8; ++r) { wA[r] = (wA[r] > 0.f) ? INFINITY : -INFINITY; wB[r] = (wB[r] > 0.f) ? INFINITY : -INFINITY; }
        unsigned scA[64], scB[64];
        const int dA = tqA - 32 * ((tb + 3) >> 5);
        const int Tmax = (tb + 3) >> 5;
        int Tm_s = Tmax, Tm_b = Tmax; asm volatile("" : "+s"(Tm_s), "+s"(Tm_b));
        DSTAMP_B(30);
        const int TmaxU = 2 * blk + 1;
        const int fsw = (r32 >> 2) & 3;
        const LAS unsigned char* ikl = (const LAS unsigned char*)ldsb + IKS_OFF + r32 * 64;
        const int off0 = (hi ^ fsw) * 16, off1 = ((2 + hi) ^ fsw) * 16;
#ifdef PROBE_SCORE
        for (int rep_ = 0; rep_ < 2; ++rep_)
#endif
#pragma unroll
        for (int half = 0; half < 2; ++half) {
            if (32 * half <= TmaxU) {
                __syncthreads();
                { const int nkeys = min(32 * (TmaxU + 1) - 1024 * half, 1024);
                  const GAS bf16_t* src = (const GAS bf16_t*)a.IKC + ((size_t)b * SEQ + 1024 * half) * 32;
                  for (int ch = tid; ch < nkeys * 4; ch += 512) { const int key = ch >> 2, c4 = ch & 3;
                      *(LAS u32x4*)((LAS unsigned char*)ldsb + IKS_OFF + key * 64 + ((c4 ^ ((key >> 2) & 3)) * 16)) = *(const GAS u32x4*)(src + key * 32 + c4 * 8); } }
                asm volatile("s_waitcnt vmcnt(0) lgkmcnt(0)" ::: "memory");
                __syncthreads();
                bf16x8 kb0[2], kb1[2];
#pragma unroll
                for (int i = 0; i < 2; ++i) { if (32 * half + i <= Tm_s) { kb0[i] = *(const LAS bf16x8*)(ikl + i * 2048 + off0); kb1[i] = *(const LAS bf16x8*)(ikl + i * 2048 + off1); } }
#pragma unroll
                for (int i = 0; i < 32; ++i) { const int T = 32 * half + i;
                    if (T <= Tm_s) {
                        f32x16 c = MFMA32(aiq0, kb0[i & 1], zero16); c = MFMA32(aiq1, kb1[i & 1], c);
                        if (i + 2 < 32 && T + 2 <= Tm_s) { kb0[i & 1] = *(const LAS bf16x8*)(ikl + (i + 2) * 2048 + off0); kb1[i & 1] = *(const LAS bf16x8*)(ikl + (i + 2) * 2048 + off1); }
                        float sA = 0.f, sB = 0.f;
#pragma unroll
                        for (int r = 0; r < 8; ++r) { sA += __builtin_amdgcn_fmed3f(c[r], 0.f, wA[r]); sB += __builtin_amdgcn_fmed3f(c[8 + r], 0.f, wB[r]); }
                        const bool last = (T == Tm_s);
                        scA[T] = (!last || r32 <= dA) ? fkey(sA + 0.f) : 0u; scB[T] = (!last || r32 <= dA + 1) ? fkey(sB + 0.f) : 0u;
                    } else { scA[T] = 0u; scB[T] = 0u; }
                }
            } else {
#pragma unroll
                for (int i = 0; i < 32; ++i) { scA[32 * half + i] = 0u; scB[32 * half + i] = 0u; }
            }
        }
        DSTAMP_E(30); DSTAMP_B(31);
        const int nA = tqA + 1, nB = tqB + 1;
        unsigned uloA = 1u, uhiA = 0xffffffffu, uloB = 1u, uhiB = 0xffffffffu; int cloA = -1, chiA = -1, cloB = -1, chiB = -1;
        bool doneA = nA <= 256, doneB = nB <= 256;
        unsigned thA = 1u, thB = 1u; int needA = 0, needB = 0;
        int itn = 0, lim = 128;
        constexpr int CAP = 12;
        LAS unsigned* lstA = (LAS unsigned*)((LAS unsigned char*)ldsb + IKS_OFF + wave * 8192) + lane * (CAP + 1), *lstB = lstA + 64 * (CAP + 1);
        unsigned ca_[CAP], cb_[CAP];
        for (;;) {
            DSTAMP_B(34);
            for (; itn < 200; ++itn) {
                if (!doneA && uhiA - uloA <= 1u) { thA = uhiA; needA = 256 - max(chiA, 0); doneA = true; }
                if (!doneB && uhiB - uloB <= 1u) { thB = uhiB; needB = 256 - max(chiB, 0); doneB = true; }
                const bool actA = !doneA && ((cloA < 0 ? nA : cloA) - max(chiA, 0) > lim), actB = !doneB && ((cloB < 0 ? nB : cloB) - max(chiB, 0) > lim);
                if (!__any(actA || actB)) break;
                const unsigned pA = actA ? next_pivot(uloA, uhiA, cloA, chiA, itn) : 0xffffffffu, pB = actB ? next_pivot(uloB, uhiB, cloB, chiB, itn) : 0xffffffffu;
                int ca = 0, cb = 0;
#pragma unroll
                for (int T = 0; T < 64; ++T)
                    asm("v_cmp_ge_u32 vcc, %2, %3\n\tv_addc_co_u32 %0, vcc, 0, %0, vcc\n\tv_cmp_ge_u32 vcc, %4, %5\n\tv_addc_co_u32 %1, vcc, 0, %1, vcc" : "+v"(ca), "+v"(cb) : "v"(scA[T]), "v"(pA), "v"(scB[T]), "v"(pB) : "vcc");
                const int pk = half_sum(ca | (cb << 16));
                ca = pk & 0xffff; cb = pk >> 16;
                if (actA) { if (ca == 256) { thA = pA; needA = 0; doneA = true; } else if (ca > 256) { uloA = pA; cloA = ca; } else { uhiA = pA; chiA = ca; } }
                if (actB) { if (cb == 256) { thB = pB; needB = 0; doneB = true; } else if (cb > 256) { uloB = pB; cloB = cb; } else { uhiB = pB; chiB = cb; } }
            }
            DSTAMP_E(34);
            if (!__any(!doneA || !doneB)) break;
            DSTAMP_B(35);
            const unsigned wA_ = doneA ? 0u : uhiA - uloA, wB_ = doneB ? 0u : uhiB - uloB;
            int nA_ = 0, nB_ = 0;
#pragma unroll
            for (int T = 0; T < 64; ++T) {
                lstA[min(nA_, CAP)] = scA[T]; lstB[min(nB_, CAP)] = scB[T];
                nA_ += ((scA[T] - uloA) < wA_) ? 1 : 0; nB_ += ((scB[T] - uloB) < wB_) ? 1 : 0;
            }
            asm volatile("s_waitcnt lgkmcnt(0)" ::: "memory");
            if (__any(nA_ > CAP || nB_ > CAP) && itn < 200) { lim >>= 1; continue; }
#pragma unroll
            for (int j = 0; j < CAP; ++j) { ca_[j] = (j < nA_) ? lstA[j] : 0u; cb_[j] = (j < nB_) ? lstB[j] : 0u; }
            DSTAMP_E(35);
            break;
        }
        if (__any(!doneA || !doneB)) {
            DSTAMP_B(36);
            const int baseA = max(chiA, 0), baseB = max(chiB, 0);
            for (; itn < 400; ++itn) {
                unsigned mnA = 0xffffffffu, mxA = 0u, mnB = 0xffffffffu, mxB = 0u;
                const unsigned wa = doneA ? 0u : uhiA - uloA, wb = doneB ? 0u : uhiB - uloB;
#pragma unroll
                for (int j = 0; j < CAP; ++j) { if ((ca_[j] - uloA) < wa) { mnA = min(mnA, ca_[j]); mxA = max(mxA, ca_[j]); } if ((cb_[j] - uloB) < wb) { mnB = min(mnB, cb_[j]); mxB = max(mxB, cb_[j]); } }
                mnA = half_min(mnA); mxA = half_max(mxA); mnB = half_min(mnB); mxB = half_max(mxB);
                if (!doneA) { if (mnA >= mxA) { thA = mxA + 1u; needA = 256 - max(chiA, 0); doneA = true; } else { uloA = mnA; uhiA = mxA + 1u; if (cloA < 0) cloA = nA; if (chiA < 0) chiA = 0; } }
                if (!doneB) { if (mnB >= mxB) { thB = mxB + 1u; needB = 256 - max(chiB, 0); doneB = true; } else { uloB = mnB; uhiB = mxB + 1u; if (cloB < 0) cloB = nB; if (chiB < 0) chiB = 0; } }
                if (!__any(!doneA || !doneB)) break;
                const unsigned pA = doneA ? 0xffffffffu : next_pivot(uloA, uhiA, cloA, chiA, itn | 1), pB = doneB ? 0xffffffffu : next_pivot(uloB, uhiB, cloB, chiB, itn | 1);
                int pk = 0;
#pragma unroll
                for (int j = 0; j < CAP; ++j) pk += ((ca_[j] >= pA) ? 1 : 0) + ((cb_[j] >= pB) ? 0x10000 : 0);
                pk = half_sum(pk);
                const int ca = baseA + (pk & 0xffff), cb = baseB + (pk >> 16);
                if (!doneA) { if (ca == 256) { thA = pA; needA = 0; doneA = true; } else if (ca > 256) { uloA = pA; cloA = ca; } else { uhiA = pA; chiA = ca; } }
                if (!doneB) { if (cb == 256) { thB = pB; needB = 0; doneB = true; } else if (cb > 256) { uloB = pB; cloB = cb; } else { uhiB = pB; chiB = cb; } }
            }
            DSTAMP_E(36);
        }
        DSTAMP_E(31); DSTAMP_B(32);
        int rem0 = __builtin_amdgcn_readlane(needA, 0), rem1 = __builtin_amdgcn_readlane(needB, 0), rem2 = __builtin_amdgcn_readlane(needA, 32), rem3 = __builtin_amdgcn_readlane(needB, 32);
        const bool anytie = (rem0 | rem1 | rem2 | rem3) != 0;
        LAS unsigned* bmr = bm + 4 * rnd; asm volatile("" : "+v"(bmr));
#pragma unroll
        for (int T = 0; T < 64; ++T) {
            if (T <= Tm_b) {
                const unsigned long long mA = __ballot(scA[T] >= thA), mB = __ballot(scB[T] >= thB);
                unsigned m0 = (unsigned)mA, m2 = (unsigned)(mA >> 32), m1 = (unsigned)mB, m3 = (unsigned)(mB >> 32);
                if (anytie) {
                    const unsigned long long eA = __ballot(scA[T] == thA - 1u), eB = __ballot(scB[T] == thB - 1u);
                    unsigned e0 = (unsigned)eA, e2 = (unsigned)(eA >> 32), e1 = (unsigned)eB, e3 = (unsigned)(eB >> 32);
                    while (rem0 > 0 && e0) { const unsigned bit = e0 & (0u - e0); m0 |= bit; e0 ^= bit; --rem0; }
                    while (rem1 > 0 && e1) { const unsigned bit = e1 & (0u - e1); m1 |= bit; e1 ^= bit; --rem1; }
                    while (rem2 > 0 && e2) { const unsigned bit = e2 & (0u - e2); m2 |= bit; e2 ^= bit; --rem2; }
                    while (rem3 > 0 && e3) { const unsigned bit = e3 & (0u - e3); m3 |= bit; e3 ^= bit; --rem3; }
                }
                if (lane == 0) { u32x4 w; w.x = m0; w.y = m1; w.z = m2; w.w = m3; *(LAS u32x4*)(bmr + T * 8) = w; }
            }
        }
        DSTAMP_E(32);
    }
    DSTAMP_B(33);
    asm volatile("s_waitcnt lgkmcnt(0)" ::: "memory");
    const int qc = r32 >> 2, hc = r32 & 3;
    const GAS bf16_t* kvb = (const GAS bf16_t*)a.KV + (size_t)b * SEQ * 128;
    const size_t qrow = (size_t)(b * SEQ + tw + qc);
    bf16x8 bq[4];
#pragma unroll
    for (int s = 0; s < 4; ++s) bq[s] = *(const GAS bf16x8*)((const GAS bf16_t*)a.Z + qrow * ZP + ZB_Q + hc * 64 + 16 * s + 8 * hi);
    f32x16 o0 = zero16, o1 = zero16, lacc = zero16; float lsum = 0.f;
    const bf16x8 ones8 = {(short)0x3f80, (short)0x3f80, (short)0x3f80, (short)0x3f80, (short)0x3f80, (short)0x3f80, (short)0x3f80, (short)0x3f80};
    const int Tend = (tw + 7) >> 5;
    const int g16 = lane >> 4, i16 = lane & 15, q4 = i16 >> 2, p4 = i16 & 3;
    const int vrd = ((g16 >> 1) * 4 + q4) * 64 + (16 * (g16 & 1) + 4 * p4) * 2;
    const int vwr_key = lane >> 3, vwr_ch = lane & 7;
    u32x4 vst[4]; bf16x8 ak[4];
    auto load_tile = [&](int T) {
#pragma unroll
        for (int s = 0; s < 4; ++s) ak[s] = *(const GAS bf16x8*)(kvb + (size_t)(32 * T + r32) * 128 + 16 * s + 8 * hi);
#pragma unroll
        for (int i = 0; i < 4; ++i) vst[i] = *(const GAS u32x4*)(kvb + (size_t)(32 * T + vwr_key + 8 * i) * 128 + 64 + 8 * vwr_ch);
    };
#ifdef PROBE_ATT
    for (int rep_ = 0; rep_ < 2; ++rep_) { o0 = zero16; o1 = zero16; lacc = zero16; lsum = 0.f;
#endif
    load_tile(0);
#pragma unroll 1
    for (int T = 0; T <= Tend; ++T) {
#pragma unroll
        for (int i = 0; i < 4; ++i) *(LAS u32x4*)(vimg + (vwr_ch >> 2) * 2048 + (vwr_key + 8 * i) * 64 + (vwr_ch & 3) * 16) = vst[i];
        f32x16 sacc = MFMA32(ak[0], bq[0], zero16); sacc = MFMA32(ak[1], bq[1], sacc); sacc = MFMA32(ak[2], bq[2], sacc); sacc = MFMA32(ak[3], bq[3], sacc);
        const unsigned mw = bm[T * 8 + qc] >> (4 * hi);
        if (T < Tend) load_tile(T + 1);
        asm volatile("s_waitcnt lgkmcnt(0)" ::: "memory");
        s16x4 va[2][2][2];
#pragma unroll
        for (int dt = 0; dt < 2; ++dt)
#pragma unroll
            for (int s = 0; s < 2; ++s) { va[dt][s][0] = vtr(vimg + dt * 2048 + (16 * s) * 64 + vrd); va[dt][s][1] = vtr(vimg + dt * 2048 + (16 * s + 8) * 64 + vrd); }
        unsigned pw[8];
#pragma unroll
        for (int r = 0; r < 16; r += 2) {
            float m0, m1; asm("v_min_f32 %0, 0x42800000, %1" : "=v"(m0) : "v"(sacc[r])); asm("v_min_f32 %0, 0x42800000, %1" : "=v"(m1) : "v"(sacc[r + 1]));
            const unsigned pkw = pk2(__builtin_amdgcn_exp2f(m0), __builtin_amdgcn_exp2f(m1));
            const int c0 = (r & 3) + 8 * (r >> 2), c1 = ((r + 1) & 3) + 8 * ((r + 1) >> 2);
            const unsigned a_ = (unsigned)__builtin_amdgcn_sbfe((int)mw, c0, 1), b_ = (unsigned)__builtin_amdgcn_sbfe((int)mw, c1, 1);
            pw[r >> 1] = pkw & ((a_ & 0xffffu) | (b_ & 0xffff0000u));
        }
        asm volatile("s_waitcnt lgkmcnt(0)" ::: "memory");
#pragma unroll
        for (int s = 0; s < 2; ++s) {
            u32x4 pv4; pv4.x = pw[4 * s]; pv4.y = pw[4 * s + 1]; pv4.z = pw[4 * s + 2]; pv4.w = pw[4 * s + 3];
            const bf16x8 pb = __builtin_bit_cast(bf16x8, pv4);
            const bf16x8 v0 = __builtin_shufflevector(va[0][s][0], va[0][s][1], 0, 1, 2, 3, 4, 5, 6, 7), v1 = __builtin_shufflevector(va[1][s][0], va[1][s][1], 0, 1, 2, 3, 4, 5, 6, 7);
            o0 = MFMA32(v0, pb, o0); o1 = MFMA32(v1, pb, o1); lacc = MFMA32(ones8, pb, lacc);
        }
    }
#ifdef PROBE_ATT
    }
#endif
    DSTAMP_E(33);
    lsum = lacc[0];
    const float rl = 1.0f / lsum;
    const GAS bf16_t* gp = (const GAS bf16_t*)a.Z + qrow * ZP + ZB_G + hc * 64; GAS bf16_t* yp = (GAS bf16_t*)a.Y + qrow * DM + 384 + hc * 64;
#pragma unroll
    for (int dt = 0; dt < 2; ++dt)
#pragma unroll
        for (int i = 0; i < 4; ++i) {
            const int d = 32 * dt + 8 * i + 4 * hi;
            const u32x2 gw = *(const GAS u32x2*)(gp + d);
            const float g0 = bflo(gw.x), g1 = bfhi(gw.x), g2 = bflo(gw.y), g3 = bfhi(gw.y);
            const f32x16& o = dt ? o1 : o0;
            u32x2 w; w.x = pk2(o[4 * i] * rl * g0 * sigmoidf_(g0), o[4 * i + 1] * rl * g1 * sigmoidf_(g1)); w.y = pk2(o[4 * i + 2] * rl * g2 * sigmoidf_(g2), o[4 * i + 3] * rl * g3 * sigmoidf_(g3));
            *(GAS u32x2*)(yp + d) = w;
        }
}
}
namespace dil {
using dsa::vtr; using dsa::s16x4;
__device__ __forceinline__ void dil_unit(const MixArgs& a, float* LQ, unsigned char* ldsb, int b, int gi, int u16) {
    const int tid = opaque_tid(), lane = tid & 63, wave = __builtin_amdgcn_readfirstlane(tid >> 6), r32 = lane & 31, hi = lane >> 5;
    const int rate = (gi == 0) ? 1 : (gi == 1) ? 4 : 16, nblk = 16 / rate, c = u16 / nblk, qb = u16 % nblk;
    const int head = gi * 2 + (wave >> 2), q0 = 128 * qb + 32 * (wave & 3);
    const GAS bf16_t* zb = (const GAS bf16_t*)a.Z + (size_t)b * SEQ * ZP;
    LAS unsigned char* vimg = (LAS unsigned char*)ldsb + wave * 4096;
    f32x16 zero16;
#pragma unroll
    for (int i = 0; i < 16; ++i) zero16[i] = 0.f;
    const size_t qrow = (size_t)b * SEQ + (size_t)(q0 + r32) * rate + c;
    bf16x8 bq[4];
#pragma unroll
    for (int s = 0; s < 4; ++s) bq[s] = *(const GAS bf16x8*)((const GAS bf16_t*)a.Z + qrow * ZP + ZC_Q + head * 64 + 16 * s + 8 * hi);
    f32x16 o0 = zero16, o1 = zero16; float lsum = 0.f;
    const int g16 = lane >> 4, i16 = lane & 15, q4 = i16 >> 2, p4 = i16 & 3;
    const int vrd = ((g16 >> 1) * 4 + q4) * 64 + (16 * (g16 & 1) + 4 * p4) * 2;
    const int vwr_key = lane >> 3, vwr_ch = lane & 7;
    bf16x8 akr[3][4]; u32x4 vstr[3][4];
#define DIL_LOAD(set, tix) do { const int j0_ = q0 - 128 + 32 * (tix); if (j0_ >= 0) { \
        _Pragma("unroll") for (int s = 0; s < 4; ++s) akr[set][s] = *(const GAS bf16x8*)(zb + ((size_t)(j0_ + r32) * rate + c) * ZP + ZC_K + head * 64 + 16 * s + 8 * hi); \
        _Pragma("unroll") for (int i = 0; i < 4; ++i) vstr[set][i] = *(const GAS u32x4*)(zb + ((size_t)(j0_ + vwr_key + 8 * i) * rate + c) * ZP + ZC_V + head * 64 + 8 * vwr_ch); } } while (0)
    DIL_LOAD(0, 0); DIL_LOAD(1, 1); DIL_LOAD(2, 2);
#pragma unroll
    for (int ti = 0; ti < 5; ++ti) {
        const int j0 = q0 - 128 + 32 * ti;
        if (j0 < 0) { if (ti + 3 < 5) DIL_LOAD(ti % 3, ti + 3); continue; }
        bf16x8 ak[4];
#pragma unroll
        for (int s = 0; s < 4; ++s) ak[s] = akr[ti % 3][s];
#pragma unroll
        for (int i = 0; i < 4; ++i) *(LAS u32x4*)(vimg + (vwr_ch >> 2) * 2048 + (vwr_key + 8 * i) * 64 + (vwr_ch & 3) * 16) = vstr[ti % 3][i];
        f32x16 sacc = MFMA32(ak[0], bq[0], zero16); sacc = MFMA32(ak[1], bq[1], sacc); sacc = MFMA32(ak[2], bq[2], sacc); sacc = MFMA32(ak[3], bq[3], sacc);
        if (ti + 3 < 5) DIL_LOAD(ti % 3, ti + 3);
        asm volatile("s_waitcnt lgkmcnt(0)" ::: "memory");
        s16x4 va[2][2][2];
#pragma unroll
        for (int dt = 0; dt < 2; ++dt)
#pragma unroll
            for (int s = 0; s < 2; ++s) { va[dt][s][0] = vtr(vimg + dt * 2048 + (16 * s) * 64 + vrd); va[dt][s][1] = vtr(vimg + dt * 2048 + (16 * s + 8) * 64 + vrd); }
        const int dbase = q0 + r32 - j0 - 4 * hi;
        unsigned pw[8];
#pragma unroll
        for (int r = 0; r < 16; r += 2) {
            const int d0 = dbase - ((r & 3) + 8 * (r >> 2)), d1 = dbase - (((r + 1) & 3) + 8 * ((r + 1) >> 2));
            float p0 = __builtin_amdgcn_exp2f(fminf(sacc[r], 64.f)), p1 = __builtin_amdgcn_exp2f(fminf(sacc[r + 1], 64.f));
            p0 = ((unsigned)d0 <= 128u) ? p0 : 0.f; p1 = ((unsigned)d1 <= 128u) ? p1 : 0.f;
            lsum += p0 + p1;
            pw[r >> 1] = pk2(p0, p1);
        }
        asm volatile("s_waitcnt lgkmcnt(0)" ::: "memory");
#pragma unroll
        for (int s = 0; s < 2; ++s) {
            u32x4 pv4; pv4.x = pw[4 * s]; pv4.y = pw[4 * s + 1]; pv4.z = pw[4 * s + 2]; pv4.w = pw[4 * s + 3];
            const bf16x8 pb = __builtin_bit_cast(bf16x8, pv4);
            const bf16x8 v0 = __builtin_shufflevector(va[0][s][0], va[0][s][1], 0, 1, 2, 3, 4, 5, 6, 7), v1 = __builtin_shufflevector(va[1][s][0], va[1][s][1], 0, 1, 2, 3, 4, 5, 6, 7);
            o0 = MFMA32(v0, pb, o0); o1 = MFMA32(v1, pb, o1);
        }
    }
    lsum += __shfl_xor(lsum, 32);
    if (hi == 0) LQ[qrow * 8 + head] = lsum;
    GAS bf16_t* yp = (GAS bf16_t*)a.Y + qrow * DM + 640 + head * 64;
#pragma unroll
    for (int dt = 0; dt < 2; ++dt)
#pragma unroll
        for (int i = 0; i < 4; ++i) {
            const int d = 32 * dt + 8 * i + 4 * hi; const f32x16& o = dt ? o1 : o0;
            u32x2 w; w.x = pk2(o[4 * i], o[4 * i + 1]); w.y = pk2(o[4 * i + 2], o[4 * i + 3]);
            *(GAS u32x2*)(yp + d) = w;
        }
}
__device__ __forceinline__ void dil_merge(const MixArgs& a, const float* LQ, int first, int nthreads) {
    constexpr int NCH = MTOK * 48;
    for (int id0 = first; id0 < NCH; id0 += 4 * nthreads) {
        u32x4 ow[4], gw[4]; float rl[4];
#pragma unroll
        for (int j = 0; j < 4; ++j) { const int id = id0 + j * nthreads; if (id < NCH) { const int row = id / 48, ch = id % 48;
            ow[j] = *(const GAS u32x4*)((const GAS bf16_t*)a.Y + (size_t)row * DM + 640 + ch * 8); gw[j] = *(const GAS u32x4*)((const GAS bf16_t*)a.Z + (size_t)row * ZP + ZC_G + ch * 8);
            const float* lq = LQ + (size_t)row * 8 + ((ch >> 3) & 1); rl[j] = lq[0] + lq[2] + lq[4]; } }
#pragma unroll
        for (int j = 0; j < 4; ++j) { const int id = id0 + j * nthreads; if (id < NCH) { const int row = id / 48, ch = id % 48; const float r = __builtin_amdgcn_rcpf(rl[j]);
            const unsigned o4[4] = {ow[j].x, ow[j].y, ow[j].z, ow[j].w}, g4[4] = {gw[j].x, gw[j].y, gw[j].z, gw[j].w}; unsigned w4[4];
#pragma unroll
            for (int k = 0; k < 4; ++k) { const float g0 = bflo(g4[k]), g1 = bfhi(g4[k]); w4[k] = pk2(bflo(o4[k]) * r * g0 * sigmoidf_(g0), bfhi(o4[k]) * r * g1 * sigmoidf_(g1)); }
            u32x4 w; w.x = w4[0]; w.y = w4[1]; w.z = w4[2]; w.w = w4[3]; *(GAS u32x4*)((GAS bf16_t*)a.Y + (size_t)row * DM + 640 + ch * 8) = w; } }
    }
}
}
namespace rwkv {
#ifdef PROBE_T
#define RTS ((volatile LAS unsigned long long*)((LAS unsigned char*)ldsb + 131072 + 1024))
#define RST(id_end, id_begin) do { if (blockIdx.x == 0 && threadIdx.x == 0) { const unsigned long long now_ = __builtin_amdgcn_s_memrealtime(); if ((id_end) == PROBE_T) RTS[1] += now_ - RTS[0]; if ((id_begin) == PROBE_T) RTS[0] = now_; } } while (0)
#else
#define RST(a, b) do {} while (0)
#endif
using dsa::vtr; using dsa::s16x4;
constexpr int IP = 144;
constexpr int IMG = 64 * IP;
constexpr int S_WD = 0 * IMG, S_AD = 1 * IMG, S_V = 2 * IMG, S_AT = 3 * IMG, S_BH = 4 * IMG, S_KH = 5 * IMG, S_RT = 6 * IMG, S_KB = 7 * IMG, S_BB = 8 * IMG, S_ARB = 9 * IMG, S_AH = 10 * IMG, S_UV = 11 * IMG;
constexpr int S_AAK = S_WD, S_ARK = S_AD, S_TT = S_BH, S_W1 = S_KH;
constexpr int F_AAB = 12 * IMG;
constexpr int F_LG = S_ARB;
constexpr int F_TOT = F_AAB + 16384;
static_assert(F_TOT + 512 <= 131072 && F_LG + 16384 <= F_AAB, "rwkv LDS map");

struct RArgs { const float* mu; const float* w0; const float* a0; const float* k_k; const float* k_a; const float* r_k; const float* ln_g; const float* ln_b;
               const bf16_t* wupT; const bf16_t* aupT; bf16_t* RQ; bf16_t* RM; bf16_t* RN; float* RG; float* RB; };

__device__ __forceinline__ bf16x8 rowfrag(const LAS unsigned char* img, int r0, int k0, int r32, int hi) { return *(const LAS bf16x8*)(img + (r0 + r32) * IP + (k0 + 8 * hi) * 2); }
__device__ __forceinline__ bf16x8 colfrag(const LAS unsigned char* img, int c0, int k0, int lane) {
    const int g16 = lane >> 4, i16 = lane & 15;
    const LAS unsigned char* p = img + (k0 + 8 * (g16 >> 1) + (i16 >> 2)) * IP + (c0 + 16 * (g16 & 1) + 4 * (i16 & 3)) * 2;
    const s16x4 lo = vtr(p), hi4 = vtr(p + 4 * IP);
    return __builtin_shufflevector(lo, hi4, 0, 1, 2, 3, 4, 5, 6, 7);
}
__device__ __forceinline__ bf16x8 colfrag_perm(const LAS unsigned char* img, int c0, int k0, int lane) {
    const int g16 = lane >> 4, i16 = lane & 15;
    const LAS unsigned char* p = img + (k0 + 4 * (g16 >> 1) + (i16 >> 2)) * IP + (c0 + 16 * (g16 & 1) + 4 * (i16 & 3)) * 2;
    const s16x4 lo = vtr(p), hi4 = vtr(p + 8 * IP);
    return __builtin_shufflevector(lo, hi4, 0, 1, 2, 3, 4, 5, 6, 7);
}
__device__ __forceinline__ bf16x8 rowfrag_f32(const LAS float* img, int r0, int k0, int r32, int hi) {
    const LAS f32x4* p = (const LAS f32x4*)(img + (r0 + r32) * 64 + k0 + 8 * hi); const f32x4 a = p[0], b = p[1];
    u32x4 w; w.x = pk2(a[0], a[1]); w.y = pk2(a[2], a[3]); w.z = pk2(b[0], b[1]); w.w = pk2(b[2], b[3]); return __builtin_bit_cast(bf16x8, w);
}
__device__ __forceinline__ void store_T(LAS unsigned char* imgT, const f32x16& c, int r0, int c0, int r32, int hi) {
#pragma unroll
    for (int g = 0; g < 4; ++g) { u32x2 w; w.x = pk2(c[4 * g], c[4 * g + 1]); w.y = pk2(c[4 * g + 2], c[4 * g + 3]); *(LAS u32x2*)(imgT + (c0 + r32) * IP + (r0 + 8 * g + 4 * hi) * 2) = w; }
}
__device__ __forceinline__ void store_T_global(GAS bf16_t* gT  , const f32x16& c, int r0, int c0, int r32, int hi) {
#pragma unroll
    for (int g = 0; g < 4; ++g) { u32x2 w; w.x = pk2(c[4 * g], c[4 * g + 1]); w.y = pk2(c[4 * g + 2], c[4 * g + 3]); *(GAS u32x2*)(gT + (c0 + r32) * 64 + r0 + 8 * g + 4 * hi) = w; }
}
__device__ __forceinline__ void store_T_global_wt(GAS bf16_t* gT, const f32x16& c, int r0, int c0, int r32, int hi) {
#pragma unroll
    for (int g = 0; g < 4; ++g) { const unsigned long long w = (unsigned long long)pk2(c[4 * g], c[4 * g + 1]) | ((unsigned long long)pk2(c[4 * g + 2], c[4 * g + 3]) << 32);
        __hip_atomic_store((GAS unsigned long long*)(gT + (c0 + r32) * 64 + r0 + 8 * g + 4 * hi), w, __ATOMIC_RELAXED, __HIP_MEMORY_SCOPE_AGENT); }
}
__device__ __forceinline__ f32x16 zero16() { f32x16 z;
#pragma unroll
    for (int i = 0; i < 16; ++i) z[i] = 0.f;
    return z; }
#define WSYNC() asm volatile("s_waitcnt lgkmcnt(0)" ::: "memory")
#define BAR() do { asm volatile("s_waitcnt lgkmcnt(0)" ::: "memory"); __builtin_amdgcn_s_barrier(); asm volatile("" ::: "memory"); } while (0)

constexpr int R1_STG = S_AT;
constexpr int R1_SAVE = 131072 + 2048, R1_PAR = R1_SAVE + 1024, R1_WUP = R1_PAR + 2560, R1_AUP = R1_WUP + IMG;
struct R1Raw { u32x4 c[5]; };
__device__ __forceinline__ void r1_load(const MixArgs& a, R1Raw& raw, int tid, int b, int h, int ck) {
    const int et = tid >> 3, ec = (tid & 7) * 8, hc = h * 64 + ec;
    const GAS bf16_t* zr = (const GAS bf16_t*)a.Z + ((size_t)b * SEQ + ck * 64 + et) * ZP;
    const int cols[5] = {ZA_R + hc, ZA_K + hc, ZA_V + hc, ZA_WD + ec, ZA_AD + ec};
#pragma unroll
    for (int i = 0; i < 5; ++i) raw.c[i] = *(const GAS u32x4*)(zr + cols[i]);
}
__device__ __forceinline__ void r1_load_params(const RArgs& ra, unsigned char* ldsb, int tid, int h) {
    LAS float* par = (LAS float*)((LAS unsigned char*)ldsb + R1_PAR);
    for (int i = tid; i < 640; i += 512) { const int g = i >> 6, c = i & 63; float v;
        if (g == 0) v = ra.mu[ZA_R + h * 64 + c]; else if (g == 1) v = ra.mu[ZA_K + h * 64 + c]; else if (g == 2) v = ra.mu[ZA_V + h * 64 + c]; else if (g == 3) v = ra.mu[ZA_WD + c]; else if (g == 4) v = ra.mu[ZA_AD + c];
        else if (g == 5) v = ra.w0[h * 64 + c]; else if (g == 6) v = ra.a0[h * 64 + c]; else if (g == 7) v = ra.k_k[h * 64 + c]; else if (g == 8) v = ra.k_a[h * 64 + c]; else v = ra.r_k[h * 64 + c];
        par[i] = v; }
    for (int ch = tid; ch < 1024; ch += 512) { const int m = ch >> 9, row = (ch >> 3) & 63, c8 = ch & 7;
        *(LAS u32x4*)((LAS unsigned char*)ldsb + (m ? R1_AUP : R1_WUP) + row * IP + c8 * 16) = *(const GAS u32x4*)((const GAS bf16_t*)(m ? ra.aupT : ra.wupT) + (size_t)(h * 64 + row) * 64 + c8 * 8); }
}
static_assert(65 * 640 <= 5 * IMG, "staging fits");
__device__ __forceinline__ void rwkv_chunk_unit(const MixArgs& a, const RArgs& ra, unsigned char* ldsb, int b, int h, int ck, R1Raw& raw, int prev_mode, bool has_next, int nb, int nh, int nck) {
    const int tid = opaque_tid(), lane = tid & 63, wave = __builtin_amdgcn_readfirstlane(tid >> 6), r32 = lane & 31, hi = lane >> 5;
    LAS unsigned char* L = (LAS unsigned char*)ldsb;
    LAS float* fETA = (LAS float*)(L + F_AAB); LAS float* fAAB = fETA; LAS float* fLG = (LAS float*)(L + F_LG); LAS float* fTOT = (LAS float*)(L + F_TOT);
    const int t0 = ck * 64;
    const size_t row0 = (size_t)b * SEQ + t0;
    const int unit = (b * 6 + h) * 32 + ck;
    RST(-1, 50);
    const int et = tid >> 3, ec = (tid & 7) * 8, hc = h * 64 + ec;
    const LAS float* par = (const LAS float*)(L + R1_PAR);
    float r8[8], k8[8];
    {
        {
            LAS unsigned char* stg = L + R1_STG;
#pragma unroll
            for (int i = 0; i < 5; ++i) *(LAS u32x4*)(stg + (et + 1) * 640 + i * 128 + (tid & 7) * 16) = raw.c[i];
            if (et == 0) {
                const int hc0 = h * 64 + ec; const int cols[5] = {ZA_R + hc0, ZA_K + hc0, ZA_V + hc0, ZA_WD + ec, ZA_AD + ec};
#pragma unroll
                for (int i = 0; i < 5; ++i) { u32x4 pv = zero_u32x4();
                    if (prev_mode == 1) pv = *(const LAS u32x4*)(L + R1_SAVE + i * 128 + (tid & 7) * 16);
                    else if (prev_mode == 2) pv = *(const GAS u32x4*)((const GAS bf16_t*)a.Z + (row0 - 1) * ZP + cols[i]);
                    *(LAS u32x4*)(stg + i * 128 + (tid & 7) * 16) = pv; }
            }
        }
        BAR();
        if (et == 63) {
#pragma unroll
            for (int i = 0; i < 5; ++i) *(LAS u32x4*)(L + R1_SAVE + i * 128 + (tid & 7) * 16) = raw.c[i];
        }
        auto mix8 = [&](int i, int col, float* out) {
            const u32x4 cw = raw.c[i], pw = *(const LAS u32x4*)(L + R1_STG + et * 640 + i * 128 + (tid & 7) * 16);
            const f32x4 m0 = *(const LAS f32x4*)(par + i * 64 + ec), m1 = *(const LAS f32x4*)(par + i * 64 + ec + 4); (void)col;
            const float cv[8] = {bflo(cw.x), bfhi(cw.x), bflo(cw.y), bfhi(cw.y), bflo(cw.z), bfhi(cw.z), bflo(cw.w), bfhi(cw.w)};
            const float pv[8] = {bflo(pw.x), bfhi(pw.x), bflo(pw.y), bfhi(pw.y), bflo(pw.z), bfhi(pw.z), bflo(pw.w), bfhi(pw.w)};
            const float mv[8] = {m0[0], m0[1], m0[2], m0[3], m1[0], m1[1], m1[2], m1[3]};
#pragma unroll
            for (int j = 0; j < 8; ++j) out[j] = cv[j] + (pv[j] - cv[j]) * mv[j];
        };
        float v8[8], wd8[8], ad8[8];
        mix8(0, ZA_R + hc, r8); mix8(1, ZA_K + hc, k8); mix8(2, ZA_V + hc, v8); mix8(3, ZA_WD + ec, wd8); mix8(4, ZA_AD + ec, ad8);
#pragma unroll
        for (int i = 0; i < 8; ++i) wd8[i] = tanhf_(wd8[i]);
        u32x4 w;
        w.x = pk2(wd8[0], wd8[1]); w.y = pk2(wd8[2], wd8[3]); w.z = pk2(wd8[4], wd8[5]); w.w = pk2(wd8[6], wd8[7]); *(LAS u32x4*)(L + S_WD + et * IP + ec * 2) = w;
        w.x = pk2(ad8[0], ad8[1]); w.y = pk2(ad8[2], ad8[3]); w.z = pk2(ad8[4], ad8[5]); w.w = pk2(ad8[6], ad8[7]); *(LAS u32x4*)(L + S_AD + et * IP + ec * 2) = w;
        w.x = pk2(v8[0], v8[1]); w.y = pk2(v8[2], v8[3]); w.z = pk2(v8[4], v8[5]); w.w = pk2(v8[6], v8[7]); *(LAS u32x4*)(L + S_V + et * IP + ec * 2) = w;
    }
    BAR();
    RST(50, 51);
    const int q = wave & 3, tr = q >> 1, tc = q & 1, grp = wave >> 2;
    {
        const LAS unsigned char* Aimg = L + (grp ? S_AD : S_WD);
        f32x16 acc = zero16();
#pragma unroll
        for (int s = 0; s < 4; ++s) acc = MFMA32(rowfrag(Aimg, 32 * tr, 16 * s, r32, hi), rowfrag(L + (grp ? R1_AUP : R1_WUP), 32 * tc, 16 * s, r32, hi), acc);
        const int c = 32 * tc + r32; const float bias = par[(grp ? 6 : 5) * 64 + c];
        if (grp == 0) {
            float x[16], gs[4];
#pragma unroll
            for (int i = 0; i < 16; ++i) x[i] = -DECAY_SCALE * sigmoidf_(acc[i] + bias);
#pragma unroll
            for (int g = 0; g < 4; ++g) gs[g] = (x[4 * g] + x[4 * g + 1]) + (x[4 * g + 2] + x[4 * g + 3]);
            float run = 0.f;
#pragma unroll
            for (int g = 0; g < 4; ++g) { const float other = __shfl_xor(gs[g], 32); float base = run + (hi ? other : 0.f); run += gs[g] + other;
#pragma unroll
                for (int j = 0; j < 4; ++j) { base += x[4 * g + j]; fLG[(32 * tr + 8 * g + 4 * hi + j) * 64 + c] = base; } }
            if (tr == 0 && hi == 0) fTOT[c] = run;
        } else {
#pragma unroll
            for (int i = 0; i < 16; ++i) fETA[(32 * tr + (i & 3) + 8 * (i >> 2) + 4 * hi) * 64 + c] = sigmoidf_(acc[i] + bias);
        }
    }
    BAR();
    RST(51, 52);
    {
        const f32x4 l0 = *(const LAS f32x4*)(fLG + et * 64 + ec), l1 = *(const LAS f32x4*)(fLG + et * 64 + ec + 4);
        f32x4 p0 = {0.f, 0.f, 0.f, 0.f}, p1 = p0; if (et > 0) { p0 = *(const LAS f32x4*)(fLG + (et - 1) * 64 + ec); p1 = *(const LAS f32x4*)(fLG + (et - 1) * 64 + ec + 4); }
        const f32x4 e0 = *(const LAS f32x4*)(fETA + et * 64 + ec), e1 = *(const LAS f32x4*)(fETA + et * 64 + ec + 4);
        const f32x4 z0 = *(const LAS f32x4*)(fLG + 63 * 64 + ec), z1 = *(const LAS f32x4*)(fLG + 63 * 64 + ec + 4);
        const f32x4 u0 = *(const LAS f32x4*)(fTOT + ec), u1 = *(const LAS f32x4*)(fTOT + ec + 4);
        float lg[8] = {l0[0], l0[1], l0[2], l0[3], l1[0], l1[1], l1[2], l1[3]}, lp[8] = {p0[0], p0[1], p0[2], p0[3], p1[0], p1[1], p1[2], p1[3]};
        const float eta[8] = {e0[0], e0[1], e0[2], e0[3], e1[0], e1[1], e1[2], e1[3]}, tot[8] = {u0[0], u0[1], u0[2], u0[3], u1[0], u1[1], u1[2], u1[3]};
        float lC[8] = {z0[0], z0[1], z0[2], z0[3], z1[0], z1[1], z1[2], z1[3]};
        float kk[8], kp[8], ss = 0.f, bsum = 0.f;
#pragma unroll
        for (int i = 0; i < 8; ++i) {
            if (et >= 32) lg[i] += tot[i]; if (et >= 33) lp[i] += tot[i]; lC[i] += tot[i];
            kk[i] = k8[i] * par[7 * 64 + ec + i]; ss += kk[i] * kk[i];
            kp[i] = k8[i] * (1.f + (eta[i] - 1.f) * par[8 * 64 + ec + i]); bsum += r8[i] * kp[i] * par[9 * 64 + ec + i];
        }
        ss += __shfl_xor(ss, 1); ss += __shfl_xor(ss, 2); ss += __shfl_xor(ss, 4);
        bsum += __shfl_xor(bsum, 1); bsum += __shfl_xor(bsum, 2); bsum += __shfl_xor(bsum, 4);
        const float rn = __builtin_amdgcn_rsqf(fmaxf(ss, 1e-24f));
        if ((tid & 7) == 0) ra.RB[(row0 + et) * 8 + h] = bsum;
        if (et == 63) { f32x4 g0 = {fexp_(lC[0]), fexp_(lC[1]), fexp_(lC[2]), fexp_(lC[3])}, g1 = {fexp_(lC[4]), fexp_(lC[5]), fexp_(lC[6]), fexp_(lC[7])};
            *(f32x4*)(ra.RG + (size_t)unit * 64 + ec) = g0; *(f32x4*)(ra.RG + (size_t)unit * 64 + ec + 4) = g1; }
#pragma unroll
        for (int i = 0; i < 8; i += 2) {
            float vat[2], vbh[2], vkh[2], vrt[2], vkb[2], vbb[2];
#pragma unroll
            for (int j = 0; j < 2; ++j) { const int c = i + j;
                const float kn = kk[c] * rn, bv = kn * eta[c];
                const float ig = fexp_(-lg[c]), gC = fexp_(lC[c] - lg[c]);
                vat[j] = -kn * fexp_(lp[c]); vbh[j] = bv * ig; vkh[j] = kp[c] * ig; vrt[j] = r8[c] * fexp_(lg[c]); vkb[j] = kp[c] * gC; vbb[j] = bv * gC; }
            const int off = et * IP + (ec + i) * 2;
            *(LAS unsigned*)(L + S_AT + off) = pk2(vat[0], vat[1]); *(LAS unsigned*)(L + S_BH + off) = pk2(vbh[0], vbh[1]); *(LAS unsigned*)(L + S_KH + off) = pk2(vkh[0], vkh[1]);
            *(LAS unsigned*)(L + S_RT + off) = pk2(vrt[0], vrt[1]); *(LAS unsigned*)(L + S_KB + off) = pk2(vkb[0], vkb[1]); *(LAS unsigned*)(L + S_BB + off) = pk2(vbb[0], vbb[1]);
        }
    }
    BAR();
    RST(52, 53);
    if (has_next) r1_load(a, raw, tid, nb, nh, nck);
    {
        const LAS unsigned char* Aimg = L + (grp ? S_RT : S_AT);
        f32x16 c1 = zero16(), c2 = zero16();
        if (!(tr == 0 && tc == 1)) {
#pragma unroll
            for (int s = 0; s < 4; ++s) { const bf16x8 af = rowfrag(Aimg, 32 * tr, 16 * s, r32, hi);
                c1 = MFMA32(af, rowfrag(L + S_BH, 32 * tc, 16 * s, r32, hi), c1); c2 = MFMA32(af, rowfrag(L + S_KH, 32 * tc, 16 * s, r32, hi), c2); }
        }
        const int ci = 32 * tc + r32;
#pragma unroll
        for (int i = 0; i < 16; ++i) { const int t = 32 * tr + (i & 3) + 8 * (i >> 2) + 4 * hi; const bool keep = grp ? (ci <= t) : (ci < t); if (!keep) { c1[i] = 0.f; c2[i] = 0.f; } }
        if (grp == 0) {
#pragma unroll
            for (int i = 0; i < 16; ++i) fAAB[(32 * tr + (i & 3) + 8 * (i >> 2) + 4 * hi) * 64 + ci] = c1[i];
            store_T(L + S_AAK, c2, 32 * tr, 32 * tc, r32, hi);
        } else { store_T(L + S_ARB, c1, 32 * tr, 32 * tc, r32, hi); store_T(L + S_ARK, c2, 32 * tr, 32 * tc, r32, hi); }
    }
    BAR();
    RST(53, 54);
    f32x16 nacc = zero16(), yacc = zero16();
    if (grp == 0) {
        const int bk = wave;
        float d[16];
        if (lane < 16) {
#pragma unroll
            for (int t = 0; t < 16; ++t) { float s = (t == lane) ? 1.f : 0.f;
#pragma unroll
                for (int i = 0; i < 16; ++i) if (i < t) s += fAAB[(16 * bk + t) * 64 + 16 * bk + i] * d[i];
                d[t] = s; }
        }
        if (lane < 16) {
            LAS unsigned char* rowp = L + S_TT + (16 * bk + lane) * IP;
#pragma unroll
            for (int cb = 0; cb < 4; ++cb) { u32x4 w0, w1;
                if (cb == bk) { w0.x = pk2(d[0], d[1]); w0.y = pk2(d[2], d[3]); w0.z = pk2(d[4], d[5]); w0.w = pk2(d[6], d[7]); w1.x = pk2(d[8], d[9]); w1.y = pk2(d[10], d[11]); w1.z = pk2(d[12], d[13]); w1.w = pk2(d[14], d[15]); }
                else { w0 = zero_u32x4(); w1 = w0; }
                *(LAS u32x4*)(rowp + cb * 32) = w0; *(LAS u32x4*)(rowp + cb * 32 + 16) = w1; }
        }
    } else {
        f32x16 c = zero16();
#pragma unroll
        for (int s = 0; s < 4; ++s) c = MFMA32(colfrag(L + S_AAK, 32 * tr, 16 * s, lane), colfrag(L + S_V, 32 * tc, 16 * s, lane), c);
        store_T(L + S_W1, c, 32 * tr, 32 * tc, r32, hi);
    }
    BAR();
    if (grp == 0) {
        if (wave < 2) { const int p = 2 * wave;
            f32x16 x = MFMA32(rowfrag_f32(fAAB, 16 * (p + 1), 16 * p, r32, hi), rowfrag(L + S_TT, 16 * p, 16 * p, r32, hi), zero16());
            u32x4 xw; xw.x = pk2(x[0], x[1]); xw.y = pk2(x[2], x[3]); xw.z = pk2(x[4], x[5]); xw.w = pk2(x[6], x[7]);
            const f32x16 tb = MFMA32(colfrag_perm(L + S_TT, 16 * (p + 1), 16 * (p + 1), lane), __builtin_bit_cast(bf16x8, xw), zero16());
            if (r32 < 16) {
#pragma unroll
                for (int g = 0; g < 2; ++g) { u32x2 w; w.x = pk2(tb[4 * g], tb[4 * g + 1]); w.y = pk2(tb[4 * g + 2], tb[4 * g + 3]); *(LAS u32x2*)(L + S_TT + (16 * p + r32) * IP + (16 * (p + 1) + 8 * g + 4 * hi) * 2) = w; } }
        }
    } else {
#pragma unroll
        for (int s = 0; s < 4; ++s) { const bf16x8 vf = colfrag(L + S_V, 32 * tr, 16 * s, lane);
            nacc = MFMA32(colfrag(L + S_KB, 32 * tr, 16 * s, lane), colfrag(L + S_V, 32 * tc, 16 * s, lane), nacc);
            yacc = MFMA32(vf, colfrag(L + S_ARK, 32 * tc, 16 * s, lane), yacc); }
    }
    BAR();
    if (wave == 0) {
        f32x16 x = zero16();
#pragma unroll
        for (int s = 0; s < 2; ++s) x = MFMA32(rowfrag_f32(fAAB, 32, 16 * s, r32, hi), rowfrag(L + S_TT, 0, 16 * s, r32, hi), x);
        f32x16 tb = zero16();
#pragma unroll
        for (int s = 0; s < 2; ++s) { u32x4 xw; xw.x = pk2(x[8 * s], x[8 * s + 1]); xw.y = pk2(x[8 * s + 2], x[8 * s + 3]); xw.z = pk2(x[8 * s + 4], x[8 * s + 5]); xw.w = pk2(x[8 * s + 6], x[8 * s + 7]);
            tb = MFMA32(colfrag_perm(L + S_TT, 32, 32 + 16 * s, lane), __builtin_bit_cast(bf16x8, xw), tb); }
        store_T(L + S_TT, tb, 32, 0, r32, hi);
    }
    BAR();
    RST(54, 55);
    {
        f32x16 c = zero16();
#pragma unroll
        for (int s = 0; s < 4; ++s) { const bf16x8 tf = colfrag(L + S_TT, 32 * tr, 16 * s, lane);
            c = MFMA32(tf, grp ? rowfrag(L + S_W1, 32 * tc, 16 * s, r32, hi) : colfrag(L + S_AT, 32 * tc, 16 * s, lane), c); }
        store_T(L + (grp ? S_UV : S_AH), c, 32 * tr, 32 * tc, r32, hi);
    }
    BAR();
    RST(55, 56);
    {
        const LAS unsigned char* Aimg = L + (grp ? S_UV : S_AH);
        f32x16 c1 = grp ? nacc : zero16(), c2 = grp ? yacc : zero16();
#pragma unroll
        for (int s = 0; s < 4; ++s) { const bf16x8 af = rowfrag(Aimg, 32 * tr, 16 * s, r32, hi);
            if (grp) c1 = MFMA32(colfrag(L + S_BB, 32 * tr, 16 * s, lane), rowfrag(L + S_UV, 32 * tc, 16 * s, r32, hi), c1);
            else c1 = MFMA32(af, colfrag(L + S_BB, 32 * tc, 16 * s, lane), c1);
            c2 = MFMA32(af, colfrag(L + S_ARB, 32 * tc, 16 * s, lane), c2); }
        GAS bf16_t* gq = (GAS bf16_t*)ra.RQ + (size_t)unit * 4096; GAS bf16_t* gm = (GAS bf16_t*)ra.RM + (size_t)unit * 4096; GAS bf16_t* gn = (GAS bf16_t*)ra.RN + (size_t)unit * 4096;
        if (grp == 0) {
            store_T_global(gm, c1, 32 * tr, 32 * tc, r32, hi);
#pragma unroll
            for (int g = 0; g < 4; ++g) { const u32x2 w = *(const LAS u32x2*)(L + S_RT + (32 * tc + r32) * IP + (32 * tr + 8 * g + 4 * hi) * 2);
                c2[4 * g] += bflo(w.x); c2[4 * g + 1] += bfhi(w.x); c2[4 * g + 2] += bflo(w.y); c2[4 * g + 3] += bfhi(w.y); }
            store_T_global(gq, c2, 32 * tr, 32 * tc, r32, hi);
        } else {
            store_T_global(gn, c1, 32 * tr, 32 * tc, r32, hi);
            GAS bf16_t* yp = (GAS bf16_t*)a.Y + (row0 + 32 * tc + r32) * DM + h * 64 + 32 * tr;
#pragma unroll
            for (int g = 0; g < 4; ++g) { u32x2 w; w.x = pk2(c2[4 * g], c2[4 * g + 1]); w.y = pk2(c2[4 * g + 2], c2[4 * g + 3]); *(GAS u32x2*)(yp + 8 * g + 4 * hi) = w; }
        }
    }
    BAR();
    RST(56, -1);
}

constexpr int R2_D = 6, R2_SLOT = 16640, R2_RING = 2 * IMG;
__device__ __forceinline__ void rwkv_scan_chain(const RArgs& ra, unsigned char* ldsb, int b, int h, unsigned* flag  ) {
    const int tid = opaque_tid(), lane = tid & 63, wave = __builtin_amdgcn_readfirstlane(tid >> 6), r32 = lane & 31, hi = lane >> 5;
    LAS unsigned char* L = (LAS unsigned char*)ldsb;
    const int q = wave & 3, tr = q >> 1, tc = q & 1;
    f32x16 st = zero16();
    for (int i = tid; i < 2 * IMG / 16; i += 512) { *(LAS u32x4*)(L + i * 16) = zero_u32x4(); }
    const int ubase = (b * 6 + h) * 32;
    auto issue = [&](int step) {
        const int unit = ubase + step; LAS unsigned char* slot = L + R2_RING + (step % R2_D) * R2_SLOT; const int lw = wave - 4;
        const GAS unsigned char* gm = (const GAS unsigned char*)ra.RM + (size_t)unit * 8192 + lane * 16; const GAS unsigned char* gn = (const GAS unsigned char*)ra.RN + (size_t)unit * 8192 + lane * 16;
#pragma unroll
        for (int p = 0; p < 2; ++p) {
            __builtin_amdgcn_global_load_lds((const GAS unsigned*)(gm + (2 * lw + p) * 1024), (LAS unsigned*)(slot + (2 * lw + p) * 1024), 16, 0, 0);
            __builtin_amdgcn_global_load_lds((const GAS unsigned*)(gn + (2 * lw + p) * 1024), (LAS unsigned*)(slot + 8192 + (2 * lw + p) * 1024), 16, 0, 0);
        }
        if (lw == 0) __builtin_amdgcn_global_load_lds((const GAS unsigned*)((const GAS unsigned char*)ra.RG + (size_t)unit * 256 + lane * 4), (LAS unsigned*)(slot + 16384), 4, 0, 0);
    };
    if (wave >= 4) {
#pragma unroll 1
        for (int s0 = 0; s0 < R2_D - 1; ++s0) issue(s0);
        asm volatile("s_waitcnt vmcnt(0)" ::: "memory");
    }
    asm volatile("s_waitcnt lgkmcnt(0)" ::: "memory"); __builtin_amdgcn_s_barrier();
#pragma unroll 1
    for (int ck = 0; ck < 32; ++ck) {
        const LAS unsigned char* Simg = L + (ck & 1) * IMG; LAS unsigned char* Snew = L + ((ck + 1) & 1) * IMG;
        if (wave < 4) {
            const int unit = ubase + ck; const LAS unsigned char* slot = L + R2_RING + (ck % R2_D) * R2_SLOT;
            f32x16 acc;
#pragma unroll
            for (int g = 0; g < 4; ++g) { const u32x2 nw = *(const LAS u32x2*)(slot + 8192 + (32 * tc + r32) * 128 + (32 * tr + 8 * g + 4 * hi) * 2); const f32x4 gc = *(const LAS f32x4*)(slot + 16384 + (32 * tr + 8 * g + 4 * hi) * 4);
                acc[4 * g] = st[4 * g] * gc[0] + bflo(nw.x); acc[4 * g + 1] = st[4 * g + 1] * gc[1] + bfhi(nw.x); acc[4 * g + 2] = st[4 * g + 2] * gc[2] + bflo(nw.y); acc[4 * g + 3] = st[4 * g + 3] * gc[3] + bfhi(nw.y); }
#pragma unroll
            for (int s = 0; s < 4; ++s) acc = MFMA32(*(const LAS bf16x8*)(slot + (32 * tr + r32) * 128 + (16 * s + 8 * hi) * 2), rowfrag(Simg, 32 * tc, 16 * s, r32, hi), acc);
            store_T_global((GAS bf16_t*)ra.RM + (size_t)unit * 4096, st, 32 * tr, 32 * tc, r32, hi);
            st = acc;
            store_T(Snew, st, 32 * tr, 32 * tc, r32, hi);
            asm volatile("s_waitcnt lgkmcnt(0)" ::: "memory");
        } else {
            if (ck + R2_D - 1 < 32) { issue(ck + R2_D - 1);
                if (wave == 4) asm volatile("s_waitcnt vmcnt(20)" ::: "memory"); else asm volatile("s_waitcnt vmcnt(16)" ::: "memory"); }
            else asm volatile("s_waitcnt vmcnt(0)" ::: "memory");
        }
        __builtin_amdgcn_s_barrier();
    }
    asm volatile("s_waitcnt vmcnt(0) lgkmcnt(0)" ::: "memory"); __syncthreads();
    (void)flag;
}
__device__ __forceinline__ void r3_wait(const unsigned* flags, int chain0, int ck, int tid) {
    if (tid < 64) {
        const unsigned* f = flags + (size_t)(chain0 + (tid & 3)) * 64;
        for (unsigned spins = 0; spins < (1u << 22); ++spins) {
            const bool ok = __hip_atomic_load((const GAS unsigned*)f, __ATOMIC_RELAXED, __HIP_MEMORY_SCOPE_AGENT) > (unsigned)ck;
            if (__all(ok)) break;
            __builtin_amdgcn_s_sleep(4);
        }
        __builtin_amdgcn_fence(__ATOMIC_ACQUIRE, "agent");
        asm volatile("s_waitcnt vmcnt(0)" ::: "memory");
    }
}
constexpr int RP = 136, RTILE = 64 * RP, R3_TEAM_LDS = 3 * RTILE;
__device__ __forceinline__ void rwkv_out_unit(const MixArgs& a, const RArgs& ra, unsigned char* ldsb, int b, int h, int ck) {
    const int tid = opaque_tid(), lane = tid & 63, wave = __builtin_amdgcn_readfirstlane(tid >> 6), r32 = lane & 31, hi = lane >> 5;
    const int tw = wave & 1, tt = tid & 127;
    LAS unsigned char* TL = (LAS unsigned char*)ldsb + (wave >> 1) * R3_TEAM_LDS;
    LAS unsigned char* VM = TL, *SG = TL + RTILE, *YC = TL + 2 * RTILE;
    const int unit = (b * 6 + h) * 32 + ck;
    const size_t row0 = (size_t)b * SEQ + ck * 64;
#pragma unroll
    for (int j = 0; j < 4; ++j) {
        const int c = tt + 128 * j, t = c >> 3, c8 = (c & 7) * 8, hc = h * 64 + c8;
        const GAS bf16_t* zr = (const GAS bf16_t*)a.Z + (row0 + t) * ZP; const bool hp = (ck * 64 + t) > 0;
        const u32x4 vc = *(const GAS u32x4*)(zr + ZA_V + hc), gcw = *(const GAS u32x4*)(zr + ZA_G + hc);
        u32x4 vp = zero_u32x4(), gp = vp; if (hp) { vp = *(const GAS u32x4*)(zr - ZP + ZA_V + hc); gp = *(const GAS u32x4*)(zr - ZP + ZA_G + hc); }
        const u32x4 yc = *(const GAS u32x4*)((const GAS bf16_t*)a.Y + (row0 + t) * DM + hc);
        const f32x4 mv0 = *(const f32x4*)(ra.mu + ZA_V + hc), mv1 = *(const f32x4*)(ra.mu + ZA_V + hc + 4), mg0 = *(const f32x4*)(ra.mu + ZA_G + hc), mg1 = *(const f32x4*)(ra.mu + ZA_G + hc + 4);
        const float vcur[8] = {bflo(vc.x), bfhi(vc.x), bflo(vc.y), bfhi(vc.y), bflo(vc.z), bfhi(vc.z), bflo(vc.w), bfhi(vc.w)}, vprv[8] = {bflo(vp.x), bfhi(vp.x), bflo(vp.y), bfhi(vp.y), bflo(vp.z), bfhi(vp.z), bflo(vp.w), bfhi(vp.w)};
        const float gcur[8] = {bflo(gcw.x), bfhi(gcw.x), bflo(gcw.y), bfhi(gcw.y), bflo(gcw.z), bfhi(gcw.z), bflo(gcw.w), bfhi(gcw.w)}, gprv[8] = {bflo(gp.x), bfhi(gp.x), bflo(gp.y), bfhi(gp.y), bflo(gp.z), bfhi(gp.z), bflo(gp.w), bfhi(gp.w)};
        const float muv[8] = {mv0[0], mv0[1], mv0[2], mv0[3], mv1[0], mv1[1], mv1[2], mv1[3]}, mug[8] = {mg0[0], mg0[1], mg0[2], mg0[3], mg1[0], mg1[1], mg1[2], mg1[3]};
        float vm[8], sg[8];
#pragma unroll
        for (int i = 0; i < 8; ++i) { vm[i] = vcur[i] + (vprv[i] - vcur[i]) * muv[i]; const float gg = gcur[i] + (gprv[i] - gcur[i]) * mug[i]; sg[i] = gg * sigmoidf_(gg); }
        u32x4 w; w.x = pk2(vm[0], vm[1]); w.y = pk2(vm[2], vm[3]); w.z = pk2(vm[4], vm[5]); w.w = pk2(vm[6], vm[7]);
        *(LAS u32x2*)(VM + t * RP + c8 * 2) = (u32x2){w.x, w.y}; *(LAS u32x2*)(VM + t * RP + c8 * 2 + 8) = (u32x2){w.z, w.w};
        w.x = pk2(sg[0], sg[1]); w.y = pk2(sg[2], sg[3]); w.z = pk2(sg[4], sg[5]); w.w = pk2(sg[6], sg[7]);
        *(LAS u32x2*)(SG + t * RP + c8 * 2) = (u32x2){w.x, w.y}; *(LAS u32x2*)(SG + t * RP + c8 * 2 + 8) = (u32x2){w.z, w.w};
        *(LAS u32x2*)(YC + t * RP + c8 * 2) = (u32x2){yc.x, yc.y}; *(LAS u32x2*)(YC + t * RP + c8 * 2 + 8) = (u32x2){yc.z, yc.w};
    }
    const GAS bf16_t* gq = (const GAS bf16_t*)ra.RQ + (size_t)unit * 4096 + (32 * tw + r32) * 64 + 8 * hi;
    const GAS bf16_t* gs = (const GAS bf16_t*)ra.RM + (size_t)unit * 4096 + r32 * 64 + 8 * hi;
    bf16x8 bq[4], a0[4], a1[4];
#pragma unroll
    for (int s = 0; s < 4; ++s) { bq[s] = *(const GAS bf16x8*)(gq + 16 * s); a0[s] = *(const GAS bf16x8*)(gs + 16 * s); a1[s] = *(const GAS bf16x8*)(gs + 32 * 64 + 16 * s); }
    const float beta = ra.RB[(row0 + 32 * tw + r32) * 8 + h];
    BAR();
    const int tl = 32 * tw + r32;
    f32x16 y0, y1;
#pragma unroll
    for (int g = 0; g < 4; ++g) { const u32x2 w0 = *(const LAS u32x2*)(YC + tl * RP + (8 * g + 4 * hi) * 2), w1 = *(const LAS u32x2*)(YC + tl * RP + (32 + 8 * g + 4 * hi) * 2);
        y0[4 * g] = bflo(w0.x); y0[4 * g + 1] = bfhi(w0.x); y0[4 * g + 2] = bflo(w0.y); y0[4 * g + 3] = bfhi(w0.y);
        y1[4 * g] = bflo(w1.x); y1[4 * g + 1] = bfhi(w1.x); y1[4 * g + 2] = bflo(w1.y); y1[4 * g + 3] = bfhi(w1.y); }
#pragma unroll
    for (int s = 0; s < 4; ++s) { y0 = MFMA32(a0[s], bq[s], y0); y1 = MFMA32(a1[s], bq[s], y1); }
    float sm = 0.f;
#pragma unroll
    for (int i = 0; i < 16; ++i) sm += y0[i] + y1[i];
    sm += __shfl_xor(sm, 32); const float mean = sm * (1.f / 64.f);
    float sq = 0.f;
#pragma unroll
    for (int i = 0; i < 16; ++i) { const float d0 = y0[i] - mean, d1 = y1[i] - mean; sq += d0 * d0 + d1 * d1; }
    sq += __shfl_xor(sq, 32); const float rstd = __builtin_amdgcn_rsqf(sq * (1.f / 64.f) + GN_EPS);
#pragma unroll
    for (int half = 0; half < 2; ++half)
#pragma unroll
        for (int g = 0; g < 4; ++g) {
            const int v0 = 32 * half + 8 * g + 4 * hi, hc = h * 64 + v0;
            const u32x2 vw = *(const LAS u32x2*)(VM + tl * RP + v0 * 2), sw = *(const LAS u32x2*)(SG + tl * RP + v0 * 2);
            const f32x4 lg4 = *(const f32x4*)(ra.ln_g + hc), lb4 = *(const f32x4*)(ra.ln_b + hc);
            const float vv[4] = {bflo(vw.x), bfhi(vw.x), bflo(vw.y), bfhi(vw.y)}, ss[4] = {bflo(sw.x), bfhi(sw.x), bflo(sw.y), bfhi(sw.y)};
            float o[4];
#pragma unroll
            for (int j = 0; j < 4; ++j) { const float yv = half ? y1[4 * g + j] : y0[4 * g + j]; o[j] = ((yv - mean) * rstd * lg4[j] + lb4[j] + beta * vv[j]) * ss[j]; }
            u32x2 w; w.x = pk2(o[0], o[1]); w.y = pk2(o[2], o[3]); *(LAS u32x2*)(YC + tl * RP + v0 * 2) = w;
        }
    BAR();
#pragma unroll
    for (int j = 0; j < 4; ++j) { const int c = tt + 128 * j, t = c >> 3, c8 = (c & 7) * 8;
        const u32x2 lo = *(const LAS u32x2*)(YC + t * RP + c8 * 2), hi2 = *(const LAS u32x2*)(YC + t * RP + c8 * 2 + 8);
        u32x4 w; w.x = lo.x; w.y = lo.y; w.z = hi2.x; w.w = hi2.y; *(GAS u32x4*)((GAS bf16_t*)a.Y + (row0 + t) * DM + h * 64 + c8) = w; }
    BAR();
}
}
constexpr int NWAVES = 8;
constexpr int RING_BYTES = 131072, LDSCTL_OFF = RING_BYTES, LDS_BYTES = 163840;
constexpr int CW_BAR = 4096, CW_Q = 2048, CW_FLAG = 65536;
struct Args { const float* in[19]; float* out; unsigned char* ws; };

__device__ __forceinline__ unsigned lds_base_u32() { extern __shared__ __attribute__((aligned(16))) unsigned char lds_[]; return (unsigned)(uintptr_t)(LAS unsigned char*)lds_; }
__device__ __forceinline__ unsigned long long rd_ptr_u(volatile LAS unsigned long long* p) { const unsigned long long v = *p; const unsigned lo = __builtin_amdgcn_readfirstlane((unsigned)v), hi = __builtin_amdgcn_readfirstlane((unsigned)(v >> 32)); return ((unsigned long long)hi << 32) | lo; }
__global__ void __launch_bounds__(NWAVES * 64, 2) mega_fwd(Args args) {
    extern __shared__ __attribute__((aligned(16))) unsigned char lds[];
    const int tid = threadIdx.x, lane = tid & 63, wave = __builtin_amdgcn_readfirstlane(tid >> 6);
    const int G = gridDim.x, bx = blockIdx.x;
    unsigned char* ws = args.ws;
    volatile LAS unsigned* MISC = (volatile LAS unsigned*)((LAS unsigned char*)lds + LDSCTL_OFF);
    for (int u = tid; u < (LDS_BYTES - LDSCTL_OFF) / 4; u += NWAVES * 64) ((LAS unsigned*)((LAS unsigned char*)lds + LDSCTL_OFF))[u] = 0u;
    __syncthreads();
    (void)xcd_barrier_post((unsigned*)(ws + WS_CTL) + CW_BAR, MISC + 8);
    volatile LAS unsigned long long* PTRS = (volatile LAS unsigned long long*)((LAS unsigned char*)lds + LDSCTL_OFF + 256);
    if (tid < 19) PTRS[tid] = (unsigned long long)(uintptr_t)args.in[tid];
    if (tid == 19) PTRS[19] = (unsigned long long)(uintptr_t)args.out;
    if (tid == 20) PTRS[20] = (unsigned long long)(uintptr_t)args.ws;
    __syncthreads();
#define PTRS_RD(i) rd_ptr_u(({ unsigned a_; asm volatile("s_mov_b32 %0, %1" : "=s"(a_) : "i"(LDSCTL_OFF + 256 + 8 * (i))); (volatile LAS unsigned long long*)(LAS unsigned char*)(lds_base_u32() + a_); }))
#define ARGP(i) ((const float*)(uintptr_t)PTRS_RD(i))
#define OUTP ((float*)(uintptr_t)PTRS_RD(19))
#define WSP ((unsigned char*)(uintptr_t)PTRS_RD(20))
#ifdef PROBE_BAR
#define GRID_BAR() do { GRID_BAR1(); GRID_BAR1(); } while (0)
#else
#define GRID_BAR() GRID_BAR1()
#endif
#define GRID_BAR1() do { XcdBarrier b_; b_.bar = (unsigned*)(WSP + WS_CTL) + CW_BAR; b_.x = xb_xcc_id(); b_.st = (volatile LAS unsigned*)((LAS unsigned char*)lds + LDSCTL_OFF) + 8; xcd_barrier(b_); } while (0)
#ifdef PROBE_T
#define TS_LDS ((volatile LAS unsigned long long*)((LAS unsigned char*)lds + LDSCTL_OFF + 1024))
#ifdef PROBE_MAX
#define PROBE_BLK_OK true
#else
#define PROBE_BLK_OK (blockIdx.x == 0)
#endif
#define STAMP_BEGIN(id) do { if ((id) == PROBE_T && PROBE_BLK_OK && threadIdx.x == 0) TS_LDS[0] = __builtin_amdgcn_s_memrealtime(); } while (0)
#define STAMP_END(id) do { if ((id) == PROBE_T && PROBE_BLK_OK && threadIdx.x == 0) TS_LDS[1] += __builtin_amdgcn_s_memrealtime() - TS_LDS[0]; } while (0)
#else
#define STAMP_BEGIN(id) do {} while (0)
#define STAMP_END(id) do {} while (0)
#endif
#ifdef PROBE_TBUSY
#define STAMP_END_BUSY(id) STAMP_END(id)
#define STAMP_END_WALL(id) do {} while (0)
#else
#define STAMP_END_BUSY(id) do {} while (0)
#define STAMP_END_WALL(id) STAMP_END(id)
#endif
#define PHASE_IDS const int tid = opaque_tid(), lane = tid & 63, wave = __builtin_amdgcn_readfirstlane(tid >> 6), gw = bx * NWAVES + wave, ngw = G * NWAVES; (void)lane; (void)gw; (void)ngw; (void)tid; (void)wave;
    int K1024 = DM, K256 = 256; asm volatile("" : "+s"(K1024), "+s"(K256));
    STAMP_BEGIN(0);
    {
        PHASE_IDS
        const float* x = args.in[0]; bf16_t* bufA = (bf16_t*)(ws + WS_BUFA); float* ssqA = (float*)(ws + WS_SSQA);
        PrepArgs pa; pa.w_in = args.in[3]; pa.norm_g = args.in[2]; pa.w_out = args.in[14]; pa.ple_g = args.in[15]; pa.w_gate = args.in[16]; pa.w_proj = args.in[17]; pa.w_up = args.in[6]; pa.a_up = args.in[8]; pa.ws = ws;
        prep_tables(ws, bx * NWAVES * 64 + tid, G * NWAVES * 64);
        prep_weights(pa, gw, ngw, (LAS float*)((LAS unsigned char*)lds + wave * 16384), lane, 0, DEPTH);
#ifdef PROBE_PRO
        prep_weights(pa, gw, ngw, (LAS float*)((LAS unsigned char*)lds + wave * 16384), lane, 0, DEPTH);
        for (int m = gw; m < MTOK; m += ngw) x_row_to_bf16(x + (size_t)m * DM, bufA + (size_t)m * DM, ssqA + (size_t)m * 16, lane);
#endif
#pragma unroll 4
        for (int m = gw; m < MTOK; m += ngw) x_row_to_bf16(x + (size_t)m * DM, bufA + (size_t)m * DM, ssqA + (size_t)m * 16, lane);
    }
    STAMP_END_BUSY(0);
    GRID_BAR();
    STAMP_END_WALL(0);
    STAMP_BEGIN(1);
#pragma clang loop unroll(full)
    for (int L = 0; L < DEPTH; ++L) {
#define PHASE_PTRS unsigned char* ws = WSP; bf16_t* cur = (bf16_t*)(ws + ((L & 1) ? WS_BUFB : WS_BUFA)); bf16_t* oth = (bf16_t*)(ws + ((L & 1) ? WS_BUFA : WS_BUFB)); const unsigned char* wl = ws + WS_W + (size_t)L * W_LAYER; \
        bf16_t* Z = (bf16_t*)(ws + WS_Z); float* PP = (float*)(ws + WS_Z); bf16_t* PB = (bf16_t*)(ws + WS_PB); float* ssqA = (float*)(ws + WS_SSQA); float* ssqB = (float*)(ws + WS_SSQB); float* out = OUTP; \
        (void)cur; (void)oth; (void)wl; (void)Z; (void)PP; (void)PB; (void)ssqA; (void)ssqB; (void)out;
        {
            PHASE_PTRS
            const float* tab16 = (const float*)(ws + WS_TAB16); const float* tabI = (const float*)(ws + WS_TABI);
            pg8::Gemm g{cur, (const bf16_t*)(wl + W_IN), MTOK, NPAD, K1024}; pg8::StaticOrder S; S.init(MTOK, NPAD, G, bx);
            epi::EpiInProj e; e.Z = Z; e.ssq = ssqA; e.tab16 = tab16; e.tabI = tabI; e.KV = (bf16_t*)(ws + WS_MISC + MISC_KV); e.IKC = (bf16_t*)(ws + WS_MISC + MISC_IKC);
#ifdef PROBE_G1
            pg8::gemm_phase<epi::EpiInProj, pg8::StaticOrder, true, true>((PG8_LAS unsigned char*)lds, g, S, e);
#endif
#ifdef PROBE_G1P
            { epi::EpiPlainZ ep; ep.Z = Z; pg8::gemm_phase<epi::EpiPlainZ, pg8::StaticOrder, true, true>((PG8_LAS unsigned char*)lds, g, S, ep); }
#endif
            pg8::gemm_phase<epi::EpiInProj, pg8::StaticOrder, true, true>((PG8_LAS unsigned char*)lds, g, S, e);
        }
        STAMP_END_BUSY(1);
        GRID_BAR();
        STAMP_END_WALL(1);
        STAMP_BEGIN(2);
        {
            PHASE_PTRS
            MixArgs ma; ma.Z = Z; ma.Y = oth; ma.KV = (const bf16_t*)(ws + WS_MISC + MISC_KV); ma.IKC = (const bf16_t*)(ws + WS_MISC + MISC_IKC); ma.mu = ARGP(4) + L * 1664; ma.w0 = ARGP(5) + L * 384; ma.w_up = ARGP(6) + (size_t)L * 64 * 384; ma.a0 = ARGP(7) + L * 384; ma.a_up = ARGP(8) + (size_t)L * 64 * 384;
            ma.k_k = ARGP(9) + L * 384; ma.k_a = ARGP(10) + L * 384; ma.r_k = ARGP(11) + L * 384; ma.ln_g = ARGP(12) + L * 384; ma.ln_b = ARGP(13) + L * 384;
            rwkv::RArgs ra; ra.mu = ma.mu; ra.w0 = ma.w0; ra.a0 = ma.a0; ra.k_k = ma.k_k; ra.k_a = ma.k_a; ra.r_k = ma.r_k; ra.ln_g = ma.ln_g; ra.ln_b = ma.ln_b;
            ra.wupT = (const bf16_t*)(wl + W_WUPT); ra.aupT = (const bf16_t*)(wl + W_AUPT); ra.RQ = (bf16_t*)out; ra.RM = (bf16_t*)out + (size_t)3072 * 4096;     ra.RN = (bf16_t*)(ws + WS_MISC + MISC_RN); ra.RG = (float*)(ws + WS_MISC + MISC_RG); ra.RB = (float*)(ws + WS_MISC + MISC_RB);
            STAMP_BEGIN(21);
            { unsigned* qctr = (unsigned*)(ws + WS_CTL) + CW_Q + L * 8 + (bx & 7);
#define QW_PTR() ({ unsigned a_; asm volatile("s_mov_b32 %0, %1" : "=s"(a_) : "i"(LDSCTL_OFF + 1536)); (volatile LAS unsigned*)(LAS unsigned char*)(lds_base_u32() + a_); })
              for (;;) {
                  if (opaque_tid() == 0) { const unsigned v_ = __hip_atomic_fetch_add(qctr, 1u, __ATOMIC_RELAXED, __HIP_MEMORY_SCOPE_AGENT); QW_PTR()[0] = v_; }
                  __syncthreads();
                  const unsigned qi = QW_PTR()[0];
                  __syncthreads();
                  if (qi >= 64u) break;
                  dsa::dsa_unit(ma, lds, (bx & 7) * 2 + (int)(qi & 1u), 31 - (int)(qi >> 1));
              } }
            __syncthreads();
            STAMP_END(21); STAMP_BEGIN(22);
            float* LQ = (float*)(ws + WS_MISC);
#ifdef PROBE_DIL
            for (int rep = 0; rep < 2; ++rep)
#endif
            for (int u = bx; u < 768; u += G) dil::dil_unit(ma, LQ, lds, u / 48, (u % 48) >> 4, u & 15);
            __syncthreads();
            STAMP_END(22); STAMP_BEGIN(20);
            {
              rwkv::R1Raw raw; const int tid1 = opaque_tid(); int hprev = -1;
              for (;;) {
                  if (opaque_tid() == 0) { const unsigned v_ = __hip_atomic_fetch_add((unsigned*)(WSP + WS_CTL) + CW_Q + 64 + L * 16, 1u, __ATOMIC_RELAXED, __HIP_MEMORY_SCOPE_AGENT); QW_PTR()[0] = v_; }
                  __syncthreads();
                  const unsigned qr = QW_PTR()[0];
                  __syncthreads();
                  if (qr >= 1072u) break;
                  const int u0 = qr < 400u ? 6 * (int)qr : 2000 + (int)qr, u1 = qr < 400u ? u0 + 6 : u0 + 1;
                  rwkv::r1_load(ma, raw, tid1, u0 / 192, (u0 / 32) % 6, u0 & 31);
#pragma unroll 1
                  for (int u = u0; u < u1; ++u) { const int un = u + 1; const int ck = u & 31, hh = (u / 32) % 6;
                      if (hh != hprev) { __syncthreads(); rwkv::r1_load_params(ra, lds, tid1, hh); __syncthreads(); hprev = hh; }
                      rwkv::rwkv_chunk_unit(ma, ra, lds, u / 192, hh, ck, raw, ck == 0 ? 0 : (u == u0 ? 2 : 1), un < u1, un / 192, (un / 32) % 6, un & 31); } } }
            STAMP_END(20);
            STAMP_BEGIN(23);
        }
        STAMP_END_BUSY(2);
        GRID_BAR();
        STAMP_END_WALL(2); STAMP_END(23);
        STAMP_BEGIN(3);
        {
            PHASE_PTRS
            MixArgs ma; ma.Z = Z; ma.Y = oth; const float* LQ = (const float*)(ws + WS_MISC); PHASE_IDS
            rwkv::RArgs ra; ra.mu = ARGP(4) + L * 1664; ra.ln_g = ARGP(12) + L * 384; ra.ln_b = ARGP(13) + L * 384;
            ra.RQ = (bf16_t*)out; ra.RM = (bf16_t*)out + (size_t)3072 * 4096;     ra.RN = (bf16_t*)(ws + WS_MISC + MISC_RN); ra.RG = (float*)(ws + WS_MISC + MISC_RG); ra.RB = (float*)(ws + WS_MISC + MISC_RB);
            if (G > 96) {
#ifdef PROBE_R2
                if (bx < 96) rwkv::rwkv_scan_chain<true>(ra, lds, bx / 6, bx % 6);
#endif
                if (bx < 96) { STAMP_BEGIN(40); rwkv::rwkv_scan_chain(ra, lds, bx / 6, bx % 6, (unsigned*)(ws + WS_CTL) + CW_FLAG + (L * 96 + bx) * 64); STAMP_END(40); }
                else { dil::dil_merge(ma, LQ, (bx - 96) * 512 + tid, (G - 96) * 512);
                    const float* src = ARGP(1) + (size_t)L * MTOK * 256;
                    for (size_t i = (size_t)(bx - 96) * 512 + tid; i < (size_t)MTOK * 256 / 8; i += (size_t)(G - 96) * 512) {
                        const f32x4 a = ((const f32x4*)src)[2 * i], b = ((const f32x4*)src)[2 * i + 1];
                        u32x4 w; w.x = pk2(a.x, a.y); w.y = pk2(a.z, a.w); w.z = pk2(b.x, b.y); w.w = pk2(b.z, b.w); ((u32x4*)PB)[i] = w; }
                }
            } else {
                for (int u = bx; u < 96; u += G) rwkv::rwkv_scan_chain(ra, lds, u / 6, u % 6, (unsigned*)(ws + WS_CTL) + CW_FLAG + (L * 96 + u) * 64);
                dil::dil_merge(ma, LQ, bx * 512 + tid, G * 512);
                { const float* src = ARGP(1) + (size_t)L * MTOK * 256;
                  for (size_t i = (size_t)bx * 512 + tid; i < (size_t)MTOK * 256 / 8; i += (size_t)G * 512) {
                      const f32x4 a = ((const f32x4*)src)[2 * i], b = ((const f32x4*)src)[2 * i + 1];
                      u32x4 w; w.x = pk2(a.x, a.y); w.y = pk2(a.z, a.w); w.z = pk2(b.x, b.y); w.w = pk2(b.z, b.w); ((u32x4*)PB)[i] = w; } }
            }
        }
        STAMP_END_BUSY(3);
        GRID_BAR();
        STAMP_END_WALL(3);
        STAMP_BEGIN(4);
        {
            PHASE_PTRS
            MixArgs ma; ma.Z = Z; ma.Y = oth;
            rwkv::RArgs ra; ra.mu = ARGP(4) + L * 1664; ra.ln_g = ARGP(12) + L * 384; ra.ln_b = ARGP(13) + L * 384;
            ra.RQ = (bf16_t*)out; ra.RM = (bf16_t*)out + (size_t)3072 * 4096;     ra.RB = (float*)(ws + WS_MISC + MISC_RB); PHASE_IDS
            for (int u4 = bx; u4 < 768; u4 += G) { const int u = u4 * 4 + (wave >> 1); rwkv::rwkv_out_unit(ma, ra, lds, u / 192, (u / 32) % 6, u & 31); }
        }
        STAMP_END_BUSY(4);
        GRID_BAR();
        STAMP_END_WALL(4);
        STAMP_BEGIN(5);
        {
            PHASE_PTRS
            pg8::Gemm g{oth, (const bf16_t*)(wl + W_OUT), MTOK, DM, K1024}; pg8::StaticOrder S; S.init(MTOK, DM, G, bx);
            epi::EpiOutProj e; e.xb = cur; e.ssq_out = ssqB;
            pg8::Gemm g2{PB, (const bf16_t*)(wl + W_PROJ), MTOK, DM, K256};
            epi::EpiBf16Plain e2; e2.C = (bf16_t*)PP;
            if ((bx >> 3) & 1) {
                pg8::gemm_phase<epi::EpiBf16Plain, pg8::StaticOrder, true, true>((PG8_LAS unsigned char*)lds, g2, S, e2);
                pg8::gemm_phase<epi::EpiOutProj, pg8::StaticOrder, true, true>((PG8_LAS unsigned char*)lds, g, S, e);
            } else {
                pg8::gemm_phase<epi::EpiOutProj, pg8::StaticOrder, true, true>((PG8_LAS unsigned char*)lds, g, S, e);
                pg8::gemm_phase<epi::EpiBf16Plain, pg8::StaticOrder, true, true>((PG8_LAS unsigned char*)lds, g2, S, e2);
            }
        }
        STAMP_END_BUSY(5);
        GRID_BAR();
        STAMP_END_WALL(5);
        STAMP_BEGIN(6);
        {
            PHASE_PTRS
            pg8::Gemm g{cur, (const bf16_t*)(wl + W_GATE), MTOK, DM, K1024}; pg8::StaticOrder S; S.init(MTOK, DM, G, bx);
            epi::EpiGate e; e.x1b = cur; e.pp = (const bf16_t*)PP; e.xb = oth; e.ssq_in = ssqB; e.ssq_out = ssqA;
            pg8::gemm_phase<epi::EpiGate, pg8::StaticOrder, true, true>((PG8_LAS unsigned char*)lds, g, S, e);
        }
        STAMP_END_BUSY(6);
        GRID_BAR();
        STAMP_END_WALL(6);
        STAMP_BEGIN(1); STAMP_BEGIN(7);
    }
    {
        const int L = 0; PHASE_PTRS
        const float* fg = ARGP(18); PHASE_IDS
        const bf16_t* xb = (const bf16_t*)(ws + ((DEPTH & 1) ? WS_BUFB : WS_BUFA));
        for (int m = gw; m < MTOK; m += ngw) { const float rs = row_rstd(ssqA + (size_t)m * 16); f32x4* orow = (f32x4*)(out + (size_t)m * DM);
#pragma unroll
            for (int j = 0; j < 2; ++j) { const int c8 = 64 * j + lane; const u32x4 w = ((const u32x4*)(xb + (size_t)m * DM))[c8]; const f32x4 g0 = ((const f32x4*)fg)[2 * c8], g1 = ((const f32x4*)fg)[2 * c8 + 1];
                const f32x4 a = {bflo(w.x), bfhi(w.x), bflo(w.y), bfhi(w.y)}, b = {bflo(w.z), bfhi(w.z), bflo(w.w), bfhi(w.w)};
                orow[2 * c8] = a * rs * g0; orow[2 * c8 + 1] = b * rs * g1; } }
    }
#ifdef PROBE_T
    if (PROBE_T == 7) { __syncthreads(); STAMP_END(7); }
#ifdef PROBE_MAX
    { unsigned long long* slots = (unsigned long long*)(WSP + 512 * 1024);
      if (threadIdx.x == 0) __hip_atomic_store(slots + blockIdx.x, (unsigned long long)TS_LDS[1], __ATOMIC_RELAXED, __HIP_MEMORY_SCOPE_AGENT);
      GRID_BAR();
      if (blockIdx.x == 0 && threadIdx.x == 0) { unsigned long long mx = 0, mn = ~0ull, sm = 0;
          for (int i = 0; i < (int)gridDim.x; ++i) { const unsigned long long v = __hip_atomic_load(slots + i, __ATOMIC_RELAXED, __HIP_MEMORY_SCOPE_AGENT); mx = v > mx ? v : mx; mn = v < mn ? v : mn; sm += v; }
          TS_LDS[1] = PROBE_MAX == 1 ? mx : (PROBE_MAX == 2 ? mn : sm / gridDim.x); } }
#endif
    if (blockIdx.x == 0 && threadIdx.x == 0) { const unsigned long long t0 = __builtin_amdgcn_s_memrealtime(), w = 4ull * TS_LDS[1]; while (__builtin_amdgcn_s_memrealtime() - t0 < w) __builtin_amdgcn_s_sleep(8); }
#endif
}

extern "C" void kernel_launch(void* const* d_in, const int* in_sizes, int n_in, void* d_out, int out_size, void* d_ws, size_t ws_size, hipStream_t stream) {
    static int grid = 0;
    if (grid == 0) {
        if (n_in != 19 || out_size != MTOK * DM || ws_size < WS_END) { fprintf(stderr, "kernel_launch: unexpected shapes n_in %d out %d ws %zu\n", n_in, out_size, ws_size); grid = -1; return; }
        int dev = 0, cus = 0, per_cu = 0;
        if (hipGetDevice(&dev) != hipSuccess || hipDeviceGetAttribute(&cus, hipDeviceAttributeMultiprocessorCount, dev) != hipSuccess) { grid = -1; return; }
        if (hipFuncSetAttribute((const void*)mega_fwd, hipFuncAttributeMaxDynamicSharedMemorySize, LDS_BYTES) != hipSuccess) { fprintf(stderr, "kernel_launch: hipFuncSetAttribute failed\n"); grid = -1; return; }
        if (hipOccupancyMaxActiveBlocksPerMultiprocessor(&per_cu, (const void*)mega_fwd, NWAVES * 64, LDS_BYTES) != hipSuccess || per_cu < 1) { fprintf(stderr, "kernel_launch: occupancy query says %d blocks per CU\n", per_cu); (void)hipGetLastError(); grid = -1; return; }
        grid = cus;
    }
    if (grid < 0) return;
    if (hipMemsetAsync((char*)d_ws + WS_CTL, 0, 1 * MiB, stream) != hipSuccess) return;
    Args a; memset(&a, 0, sizeof a);
    for (int i = 0; i < 19; ++i) a.in[i] = (const float*)d_in[i];
    a.out = (float*)d_out; a.ws = (unsigned char*)d_ws;
    hipLaunchKernelGGL(mega_fwd, dim3(grid), dim3(NWAVES * 64), LDS_BYTES, stream, a);
}
```

```cpp
#include <hip/hip_runtime.h>
#include <cstdio>
#include <cstdint>
#include <cmath>
#include <cstring>

constexpr int BATCH = 16, SEQ = 2048, DM = 1024, DEPTH = 4, MTOK = BATCH * SEQ;
constexpr int ZP = 4136;
constexpr int NPAD = 4352;
constexpr int ZA_R = 0, ZA_K = 384, ZA_V = 768, ZA_G = 1152, ZA_WD = 1536, ZA_AD = 1600;
constexpr int ZB_Q = 1664, ZB_K = 1920, ZB_V = 1984, ZB_IQ = 2048, ZB_IK = 2304, ZB_IW = 2336, ZB_G = 2344;
constexpr int ZC_Q = 2600, ZC_K = 2984, ZC_V = 3368, ZC_G = 3752;
constexpr float LOG2E = 1.4426950408889634f;
constexpr float QSCALE = 0.125f * LOG2E;
constexpr float IQSCALE = 0.17677669529663687f;
constexpr float IWSCALE = 0.35355339059327373f;
constexpr float NORM_EPS = 1e-6f, GN_EPS = 64e-5f;
constexpr float DECAY_SCALE = 0.6065306597126334f;

typedef unsigned short bf16_t;
typedef short bf16x8 __attribute__((ext_vector_type(8)));
typedef float f32x4 __attribute__((ext_vector_type(4)));
typedef float f32x16 __attribute__((ext_vector_type(16)));
typedef unsigned u32x4 __attribute__((ext_vector_type(4)));
typedef unsigned u32x2 __attribute__((ext_vector_type(2)));

__device__ __forceinline__ unsigned f2bf(float f) { unsigned u = __builtin_bit_cast(unsigned, f); return (u + 0x7fffu + ((u >> 16) & 1u)) >> 16; }
typedef float f32x2_t __attribute__((ext_vector_type(2))); typedef __bf16 bf16x2_t __attribute__((ext_vector_type(2)));
__device__ __forceinline__ unsigned pk2(float lo, float hi) { const f32x2_t v = {lo, hi}; return __builtin_bit_cast(unsigned, __builtin_convertvector(v, bf16x2_t)); }
__device__ __forceinline__ float bf2f(unsigned short b) { return __builtin_bit_cast(float, (unsigned)b << 16); }
__device__ __forceinline__ float bflo(unsigned w) { return __builtin_bit_cast(float, w << 16); }
__device__ __forceinline__ float bfhi(unsigned w) { return __builtin_bit_cast(float, w & 0xffff0000u); }
__device__ __forceinline__ float sigmoidf_(float x) { return __builtin_amdgcn_rcpf(1.0f + __builtin_amdgcn_exp2f(-1.4426950408889634f * x)); }
__device__ __forceinline__ float fexp_(float x) { return __builtin_amdgcn_exp2f(1.4426950408889634f * x); }
__device__ __forceinline__ float tanhf_(float x) { const float e = __builtin_amdgcn_exp2f(fminf(2.8853900817779268f * x, 60.f)); return 1.0f - 2.0f * __builtin_amdgcn_rcpf(e + 1.0f); }
__device__ __forceinline__ int opaque_tid() { int t = threadIdx.x; asm volatile("" : "+v"(t)); return t; }
__device__ __forceinline__ u32x4 zero_u32x4() { unsigned z = 0u; asm volatile("" : "+v"(z)); u32x4 r; r.x = z; r.y = z; r.z = z; r.w = z; return r; }
__device__ __forceinline__ float wave_sum(float v) {
#pragma unroll
    for (int o = 1; o < 64; o <<= 1) v += __shfl_xor(v, o);
    return v;
}
__device__ __forceinline__ float wave_max(float v) {
#pragma unroll
    for (int o = 1; o < 64; o <<= 1) v = fmaxf(v, __shfl_xor(v, o));
    return v;
}

constexpr size_t MiB = 1u << 20;
constexpr size_t WS_CTL = 0;
constexpr size_t WS_TAB16 = 1 * MiB;
constexpr size_t WS_TABI = WS_TAB16 + 128 * 1024;
constexpr size_t WS_SSQA = WS_TABI + 64 * 1024;
constexpr size_t WS_SSQB = WS_SSQA + 2 * MiB;
constexpr size_t WS_W = 6 * MiB;
constexpr size_t W_LAYER = 14 * MiB, W_IN = 0, W_OUT = 8912896, W_GATE = W_OUT + 2 * MiB, W_PROJ = W_GATE + 2 * MiB, W_WUPT = W_PROJ + 512 * 1024, W_AUPT = W_WUPT + 48 * 1024;
constexpr size_t WS_BUFA = 62 * MiB;
constexpr size_t WS_BUFB = 126 * MiB;
constexpr size_t WS_PB = 190 * MiB;
constexpr size_t WS_Z = 206 * MiB;
constexpr size_t WS_Z_END = WS_Z + (size_t)MTOK * ZP * 2;
constexpr size_t WS_MISC = 465 * MiB;
constexpr size_t WS_END = 512 * MiB;
constexpr size_t MISC_LQ = 0, MISC_RG = 1 * MiB, MISC_RN = 2 * MiB, MISC_RB = 26 * MiB, MISC_KV = 27 * MiB, MISC_IKC = 35 * MiB;
static_assert(W_AUPT + 48 * 1024 <= W_LAYER && WS_W + 4 * W_LAYER <= WS_BUFA && WS_Z_END <= WS_MISC, "ws map");
namespace pg8 {
#define PG8_LAS __attribute__((address_space(3)))
typedef unsigned short bf16_t;
typedef short bf16x8 __attribute__((ext_vector_type(8)));
typedef float f32x4 __attribute__((ext_vector_type(4)));
typedef unsigned u32x4 __attribute__((ext_vector_type(4)));
constexpr int BM = 256, BK = 64, HALF = 128, HTB = HALF * BK * 2  , STAGE_BYTES = 8 * HTB, NXCD = 8, WGM = 8;

__host__ __device__ __forceinline__ int lds_byte(int r, int c) { const int st = (r >> 4) * 2 + (c >> 5), rr = r & 15, cc = c & 31, ob = rr * 64 + cc * 2; return st * 1024 + (ob ^ (((ob >> 9) & 1) << 5)); }
__host__ __device__ __forceinline__ void stage_rc(int b, int& R, int& C) { const int st = b / 1024, sb = b % 1024, swz = sb ^ (((sb >> 9) & 1) << 5); R = (st >> 1) * 16 + swz / 64; C = (st & 1) * 32 + (swz % 64) / 2; }
__host__ __device__ __forceinline__ int perm32(int rho) { const int n = rho >> 4, i = rho & 15; return 8 * (i >> 2) + 4 * n + (i & 3); }

struct Unit { int pm, pn; };
struct Gemm { const bf16_t* A; const bf16_t* Bt; int M, N, K; };

struct StaticOrder {
    int nM, nN, nwg, G, c;
    __host__ __device__ void init(int M, int N, int G_, int c_) { nM = M / BM; nN = N / BM; nwg = nM * nN; G = G_; c = c_; }
    __host__ __device__ bool next(int i, Unit& u) const {
        const long L = (long)i * G + c; if (L >= nwg) return false;
        int wgid = (int)L; { const int q = nwg / NXCD, r = nwg % NXCD, xcd = wgid % NXCD, off = wgid / NXCD; wgid = (xcd < r ? xcd * (q + 1) : r * (q + 1) + (xcd - r) * q) + off; }
        const int nig = WGM * nN, gid = wgid / nig, fm = gid * WGM, gsz = (nM - fm) < WGM ? (nM - fm) : WGM;
        u.pm = fm + ((wgid % nig) % gsz); u.pn = (wgid % nig) / gsz; return true;
    }
    __device__ __forceinline__ void a_ready(const Unit&) const {}
    __device__ __forceinline__ void done(const Unit&) const {}
};

__device__ __forceinline__ unsigned cvt_pk_bf16(float lo, float hi) { unsigned r; asm volatile("v_cvt_pk_bf16_f32 %0, %1, %2" : "=v"(r) : "v"(lo), "v"(hi)); return r; }
template <class Epi, class Sched, bool ALIGN_EPI = false, bool SP2 = false>
__device__ __forceinline__ void gemm_phase(PG8_LAS unsigned char* lds, const Gemm g, const Sched& S, const Epi& E) {
    int tid_ = threadIdx.x; asm volatile("" : "+v"(tid_));
    const int tid = tid_, wid = __builtin_amdgcn_readfirstlane(tid >> 6), lane = tid & 63, wr = wid >> 2, wc = wid & 3, fr = lane & 15, fq = lane >> 4;
    const int K = g.K, nt = K / BK;
    unsigned voffA[2], voffB[2];
#pragma unroll
    for (int i = 0; i < 2; ++i) { int R, C; stage_rc(tid * 16 + i * 8192, R, C); const int Rb = Epi::PERM ? ((R & ~31) + perm32(R & 31)) : R;
        voffA[i] = (unsigned)(R * K + C) * 2u; voffB[i] = (unsigned)(Rb * K + C) * 2u; }
    const size_t kstep = (size_t)(BK * 2);
    const size_t hstep = (size_t)HALF * K * 2;
    const size_t tstep = 2 * hstep;
    const unsigned ldsw = (unsigned)wid * 1024u;
    const int aoff = lds_byte(wr * 64 + fr, fq * 8), boff = lds_byte(wc * 32 + fr, fq * 8);
#define PG8_SA(b, h) (((b) * 2 + (h)) * HTB)
#define PG8_SB(b, h) ((4 + (b) * 2 + (h)) * HTB)
#define PG8_STAGE(bufoff, gbase, voff) do { _Pragma("unroll") for (int _i = 0; _i < 2; ++_i) \
        __builtin_amdgcn_global_load_lds((const unsigned*)((const char*)(gbase) + (voff)[_i]), (PG8_LAS unsigned*)(lds + (bufoff) + ldsw + _i * 8192), 16, 0, 0); } while (0)
#define PG8_LDA(dst, b, h) do { _Pragma("unroll") for (int m = 0; m < 4; ++m) _Pragma("unroll") for (int k = 0; k < 2; ++k) dst[m][k] = *(const PG8_LAS bf16x8*)(lds + PG8_SA(b, h) + aoff + m * 2048 + k * 1024); } while (0)
#define PG8_LDB(dst, b, h) do { _Pragma("unroll") for (int n = 0; n < 2; ++n) _Pragma("unroll") for (int k = 0; k < 2; ++k) dst[n][k] = *(const PG8_LAS bf16x8*)(lds + PG8_SB(b, h) + boff + n * 2048 + k * 1024); } while (0)
#define PG8_MMA(ai, bj, At, Bt) do { __builtin_amdgcn_s_setprio(1); _Pragma("unroll") for (int m = 0; m < 4; ++m) _Pragma("unroll") for (int n = 0; n < 2; ++n) _Pragma("unroll") for (int k = 0; k < 2; ++k) \
        acc[ai][bj][m][n] = __builtin_amdgcn_mfma_f32_16x16x32_bf16(Bt[n][k], At[m][k], acc[ai][bj][m][n], 0, 0, 0); __builtin_amdgcn_s_setprio(0); } while (0)
#define PG8_WAIT_V(n) asm volatile("s_waitcnt vmcnt(" #n ")" ::: "memory")
#define PG8_WAIT_L(n) asm volatile("s_waitcnt lgkmcnt(" #n ")" ::: "memory")
#define PG8_BAR __builtin_amdgcn_s_barrier()
#define PG8_SCHED __builtin_amdgcn_sched_barrier(0)
    Unit cur, nxt; int ui = 0;
    if (!S.next(0, cur)) return;
    f32x4 acc[2][2][4][2];
#pragma unroll
    for (int a = 0; a < 2; ++a)
#pragma unroll
        for (int b = 0; b < 2; ++b)
#pragma unroll
            for (int m = 0; m < 4; ++m)
#pragma unroll
                for (int n = 0; n < 2; ++n) acc[a][b][m][n] = (f32x4){0.f, 0.f, 0.f, 0.f};
    bf16x8 At[4][2], B0[2][2], B1[2][2];
    const char* cA = (const char*)g.A + (size_t)cur.pm * tstep; const char* cB = (const char*)g.Bt + (size_t)cur.pn * tstep;
    S.a_ready(cur);
    if constexpr (SP2) {
        PG8_STAGE(PG8_SB(0, 0), cB, voffB); PG8_STAGE(PG8_SB(0, 1), cB + hstep, voffB); PG8_STAGE(PG8_SA(0, 0), cA, voffA); PG8_STAGE(PG8_SA(0, 1), cA + hstep, voffA);
        if (wr == 1) PG8_BAR;
        PG8_WAIT_V(2); PG8_BAR;
        PG8_STAGE(PG8_SB(1, 0), cB + kstep, voffB); PG8_STAGE(PG8_SA(1, 0), cA + kstep, voffA); PG8_STAGE(PG8_SB(1, 1), cB + hstep + kstep, voffB);
        PG8_WAIT_V(6); PG8_BAR;
    } else {
        PG8_STAGE(PG8_SB(0, 0), cB, voffB); PG8_STAGE(PG8_SA(0, 0), cA, voffA); PG8_STAGE(PG8_SB(0, 1), cB + hstep, voffB); PG8_STAGE(PG8_SA(0, 1), cA + hstep, voffA);
        if (wr == 1) PG8_BAR;
        PG8_WAIT_V(4); PG8_BAR;
        PG8_STAGE(PG8_SB(1, 0), cB + kstep, voffB); PG8_STAGE(PG8_SA(1, 0), cA + kstep, voffA); PG8_STAGE(PG8_SB(1, 1), cB + hstep + kstep, voffB);
        PG8_WAIT_V(6); PG8_BAR;
    }
    for (;;) {
        const bool has_next = S.next(ui + 1, nxt);
        const char* nA = has_next ? (const char*)g.A + (size_t)nxt.pm * tstep : cA; const char* nB = has_next ? (const char*)g.Bt + (size_t)nxt.pn * tstep : cB;
        for (int t = 0; t < nt; t += 2) {
            const bool last = (t == nt - 2);
            const char* a1 = cA + (size_t)(t + 1) * kstep;
            const char* a2 = last ? nA : cA + (size_t)(t + 2) * kstep; const char* b2 = last ? nB : cB + (size_t)(t + 2) * kstep;
            const char* a3 = a2 + kstep; const char* b3 = b2 + kstep;
            if (last && has_next) S.a_ready(nxt);
            if constexpr (SP2) {
            PG8_LDB(B0, 0, 0); PG8_LDB(B1, 0, 1); PG8_SCHED; PG8_LDA(At, 0, 0); PG8_STAGE(PG8_SA(1, 1), a1 + hstep, voffA);
            PG8_WAIT_V(8); PG8_WAIT_L(0); PG8_BAR; PG8_MMA(0, 0, At, B0); PG8_MMA(0, 1, At, B1); PG8_BAR; PG8_SCHED;
            PG8_LDA(At, 0, 1); PG8_STAGE(PG8_SB(0, 0), b2, voffB); PG8_STAGE(PG8_SB(0, 1), b2 + hstep, voffB); PG8_STAGE(PG8_SA(0, 0), a2, voffA);
            PG8_WAIT_V(8); PG8_WAIT_L(0); PG8_BAR; PG8_MMA(1, 0, At, B0); PG8_MMA(1, 1, At, B1); PG8_BAR; PG8_SCHED;
            PG8_LDB(B0, 1, 0); PG8_LDB(B1, 1, 1); PG8_SCHED; PG8_LDA(At, 1, 0); PG8_STAGE(PG8_SA(0, 1), a2 + hstep, voffA);
            PG8_WAIT_V(8); PG8_WAIT_L(0); PG8_BAR; PG8_MMA(0, 0, At, B0); PG8_MMA(0, 1, At, B1); PG8_BAR; PG8_SCHED;
            PG8_LDA(At, 1, 1); PG8_STAGE(PG8_SB(1, 0), b3, voffB); PG8_STAGE(PG8_SB(1, 1), b3 + hstep, voffB); PG8_STAGE(PG8_SA(1, 0), a3, voffA);
            PG8_WAIT_V(8); PG8_WAIT_L(0); PG8_BAR; PG8_MMA(1, 0, At, B0); PG8_MMA(1, 1, At, B1); PG8_BAR; PG8_SCHED;
            } else {
            PG8_LDB(B0, 0, 0); PG8_SCHED; PG8_LDA(At, 0, 0); PG8_STAGE(PG8_SA(1, 1), a1 + hstep, voffA);
            PG8_WAIT_L(8); PG8_BAR; PG8_WAIT_L(0); PG8_MMA(0, 0, At, B0); PG8_BAR; PG8_SCHED;
            PG8_LDB(B1, 0, 1); PG8_STAGE(PG8_SB(0, 0), b2, voffB);
            PG8_BAR; PG8_WAIT_L(0); PG8_MMA(0, 1, At, B1); PG8_BAR;
            PG8_LDA(At, 0, 1); PG8_STAGE(PG8_SA(0, 0), a2, voffA);
            PG8_BAR; PG8_WAIT_L(0); PG8_MMA(1, 0, At, B0); PG8_BAR; PG8_SCHED;
            PG8_STAGE(PG8_SB(0, 1), b2 + hstep, voffB);
            PG8_WAIT_V(6); PG8_BAR; PG8_MMA(1, 1, At, B1); PG8_BAR;
            PG8_LDB(B0, 1, 0); PG8_SCHED; PG8_LDA(At, 1, 0); PG8_STAGE(PG8_SA(0, 1), a2 + hstep, voffA);
            PG8_WAIT_L(8); PG8_BAR; PG8_WAIT_L(0); PG8_MMA(0, 0, At, B0); PG8_BAR; PG8_SCHED;
            PG8_LDB(B1, 1, 1); PG8_STAGE(PG8_SB(1, 0), b3, voffB);
            PG8_BAR; PG8_WAIT_L(0); PG8_MMA(0, 1, At, B1); PG8_BAR;
            PG8_LDA(At, 1, 1); PG8_STAGE(PG8_SA(1, 0), a3, voffA);
            PG8_BAR; PG8_WAIT_L(0); PG8_MMA(1, 0, At, B0); PG8_BAR; PG8_SCHED;
            PG8_STAGE(PG8_SB(1, 1), b3 + hstep, voffB);
            PG8_WAIT_V(6); PG8_BAR; PG8_MMA(1, 1, At, B1); PG8_BAR;
            }
        }
        if constexpr (ALIGN_EPI) { if (wr == 0) PG8_BAR; }
        if constexpr (!Epi::AFTER_DRAIN) { E(acc, cur, wr, wc, fr, fq); S.done(cur); }
        if (!has_next) break;
#pragma unroll
        for (int a = 0; a < 2; ++a)
#pragma unroll
            for (int b = 0; b < 2; ++b)
#pragma unroll
                for (int m = 0; m < 4; ++m)
#pragma unroll
                    for (int n = 0; n < 2; ++n) acc[a][b][m][n] = (f32x4){0.f, 0.f, 0.f, 0.f};
        cur = nxt; cA = nA; cB = nB; ++ui;
        if constexpr (ALIGN_EPI) { if (wr == 1) PG8_BAR; }
    }
    PG8_WAIT_V(0);
    if constexpr (!ALIGN_EPI) { if (wr == 0) PG8_BAR; }
    PG8_BAR;
    if constexpr (Epi::AFTER_DRAIN) { E.fused(acc, cur, wr, wc, fr, fq, lds, wid, lane); S.done(cur); }
#undef PG8_SA
#undef PG8_SB
#undef PG8_STAGE
#undef PG8_LDA
#undef PG8_LDB
#undef PG8_MMA
#undef PG8_WAIT_V
#undef PG8_WAIT_L
#undef PG8_BAR
#undef PG8_SCHED
}
}
#define GAS __attribute__((address_space(1)))
#define LAS __attribute__((address_space(3)))

__device__ __forceinline__ int zcol_src(int n, float& sc) {
    sc = 1.f;
    if (n < ZB_Q) return n;
    if (n < ZB_K) { int o = n - ZB_Q, h = o >> 6, d = o & 63; sc = QSCALE; if (d < 16) d = (d >> 1) + 8 * (d & 1); return ZB_Q + h * 64 + d; }
    if (n < ZB_V) { int d = n - ZB_K; if (d < 16) d = (d >> 1) + 8 * (d & 1); return ZB_K + d; }
    if (n < ZB_IQ) return n;
    if (n < ZB_IK) { int o = n - ZB_IQ, h = o >> 5, d = o & 31; sc = IQSCALE; if (d < 8) d = (d >> 1) + 4 * (d & 1); return ZB_IQ + h * 32 + d; }
    if (n < ZB_IW) { int d = n - ZB_IK; if (d < 8) d = (d >> 1) + 4 * (d & 1); return ZB_IK + d; }
    if (n < ZB_G) { sc = IWSCALE; return n; }
    if (n < ZC_Q) return n;
    if (n < ZC_K) { int o = n - ZC_Q, h = o >> 6, d = o & 63; sc = QSCALE; if (d < 16) d = (d >> 1) + 8 * (d & 1); return ZC_Q + h * 64 + d; }
    if (n < ZC_V) { int o = n - ZC_K, h = o >> 6, d = o & 63; if (d < 16) d = (d >> 1) + 8 * (d & 1); return ZC_K + h * 64 + d; }
    return n;
}

template <bool ZMAP>
__device__ __forceinline__ void transpose_item(const float* __restrict__ W, int K, int NW, bf16_t* WT, const float* __restrict__ kscale, LAS float* scr, int item, int nblk, int lane) {
    const int kb = item / nblk, nb = item % nblk, k0 = 64 * kb, n0 = 32 * nb;
    const int c4 = 4 * (lane & 7), ncol = n0 + c4;
    f32x4 v[8];
#pragma unroll
    for (int i = 0; i < 8; ++i) { const int kk = (lane >> 3) + 8 * i; v[i] = (f32x4){0.f, 0.f, 0.f, 0.f}; if (ncol < NW) v[i] = *(const f32x4*)(W + (size_t)(k0 + kk) * NW + ncol); }
#pragma unroll
    for (int i = 0; i < 8; ++i) { const int kk = (lane >> 3) + 8 * i; f32x4 x = v[i]; if (kscale) x = x * kscale[k0 + kk];
        scr[kk * 33 + c4] = x[0]; scr[kk * 33 + c4 + 1] = x[1]; scr[kk * 33 + c4 + 2] = x[2]; scr[kk * 33 + c4 + 3] = x[3]; }
    asm volatile("s_waitcnt lgkmcnt(0)" ::: "memory");
    const int c = lane & 7;
#pragma unroll
    for (int j = 0; j < 4; ++j) { const int n = (lane >> 3) + 8 * j; int sl = n; float sc = 1.f;
        if (ZMAP) { if (n0 + n < NW) sl = zcol_src(n0 + n, sc) - n0; else { sl = n; sc = 0.f; } }
        const LAS float* s = scr + (8 * c) * 33 + sl;
        u32x4 o; o.x = pk2(s[0 * 33] * sc, s[1 * 33] * sc); o.y = pk2(s[2 * 33] * sc, s[3 * 33] * sc); o.z = pk2(s[4 * 33] * sc, s[5 * 33] * sc); o.w = pk2(s[6 * 33] * sc, s[7 * 33] * sc);
        *(u32x4*)(WT + (size_t)(n0 + n) * K + k0 + 8 * c) = o; }
    asm volatile("s_waitcnt lgkmcnt(0)" ::: "memory");
}

struct PrepArgs { const float* w_in; const float* norm_g; const float* w_out; const float* ple_g; const float* w_gate; const float* w_proj; const float* w_up; const float* a_up; unsigned char* ws; };

__device__ __forceinline__ void prep_weights(const PrepArgs& a, int gw, int ngw, LAS float* scr, int lane, int L0, int L1) {
    constexpr int I_IN = 16 * (NPAD / 32), I_SQ = 16 * 32, I_PJ = 4 * 32, I_UP = 12, I_LAYER = I_IN + 2 * I_SQ + I_PJ + 2 * I_UP;
    for (int it = gw; it < (L1 - L0) * I_LAYER; it += ngw) {
        const int L = L0 + it / I_LAYER; int r = it % I_LAYER;
        unsigned char* wl = a.ws + WS_W + (size_t)L * W_LAYER;
        if (r < I_IN) { transpose_item<true>(a.w_in + (size_t)L * DM * ZP, DM, ZP, (bf16_t*)(wl + W_IN), a.norm_g + L * DM, scr, r, NPAD / 32, lane); continue; } r -= I_IN;
        if (r < I_SQ) { transpose_item<false>(a.w_out + (size_t)L * DM * DM, DM, DM, (bf16_t*)(wl + W_OUT), nullptr, scr, r, 32, lane); continue; } r -= I_SQ;
        if (r < I_SQ) { transpose_item<false>(a.w_gate + (size_t)L * DM * DM, DM, DM, (bf16_t*)(wl + W_GATE), a.ple_g + L * DM, scr, r, 32, lane); continue; } r -= I_SQ;
        if (r < I_PJ) { transpose_item<false>(a.w_proj + (size_t)L * 256 * DM, 256, DM, (bf16_t*)(wl + W_PROJ), nullptr, scr, r, 32, lane); continue; } r -= I_PJ;
        if (r < I_UP) { transpose_item<false>(a.w_up + (size_t)L * 64 * 384, 64, 384, (bf16_t*)(wl + W_WUPT), nullptr, scr, r, 12, lane); continue; } r -= I_UP;
        transpose_item<false>(a.a_up + (size_t)L * 64 * 384, 64, 384, (bf16_t*)(wl + W_AUPT), nullptr, scr, r, 12, lane);
    }
}

__device__ __forceinline__ void sincos_d(float ang, float& c, float& s) {
    const double a = (double)ang; const double n = rint(a * 0.63661977236758134308);
    double r = fma(-n, 1.57079632679489655800e+00, a); r = fma(-n, 6.12323399573676603587e-17, r);
    const double r2 = r * r;
    double sp = r2 * (1.0 / 6227020800.0) - 1.0 / 39916800.0; sp = sp * r2 + 1.0 / 362880.0; sp = sp * r2 - 1.0 / 5040.0; sp = sp * r2 + 1.0 / 120.0; sp = sp * r2 - 1.0 / 6.0; sp = sp * r2 * r + r;
    double cp = r2 * (1.0 / 479001600.0) - 1.0 / 3628800.0; cp = cp * r2 + 1.0 / 40320.0; cp = cp * r2 - 1.0 / 720.0; cp = cp * r2 + 1.0 / 24.0; cp = cp * r2 - 0.5; cp = cp * r2 + 1.0;
    const int q = ((int)n) & 3;
    const double sv = (q == 0) ? sp : (q == 1) ? cp : (q == 2) ? -sp : -cp;
    const double cv = (q == 0) ? cp : (q == 1) ? -sp : (q == 2) ? -cp : sp;
    c = (float)cv; s = (float)sv;
}
__device__ __forceinline__ void prep_tables(unsigned char* ws, int gtid, int nthreads) {
    const float inv8[8] = {1.0f, 0.1939227432012558f, 0.03760603070259094f, 0.007292664609849453f, 0.0014142135623842478f, 0.00027424818836152554f, 5.318296098266728e-05f, 1.0313386155758053e-05f};
    float* t16 = (float*)(ws + WS_TAB16); float* tI = (float*)(ws + WS_TABI);
    for (int e = gtid; e < SEQ * 8; e += nthreads) { const int pos = e >> 3, i = e & 7;
        float iv = inv8[0];
#pragma unroll
        for (int j = 1; j < 8; ++j) iv = (i == j) ? inv8[j] : iv;
        float c, s; sincos_d((float)pos * iv, c, s); t16[pos * 16 + i] = c; t16[pos * 16 + 8 + i] = s;
        if ((i & 1) == 0) { const int i4 = i >> 1; tI[pos * 8 + i4] = c; tI[pos * 8 + 4 + i4] = s; }
    }
}
__device__ __forceinline__ void x_row_to_bf16(const float* xrow, bf16_t* orow, float* ssq, int lane) {
    const f32x4* xr = (const f32x4*)xrow + lane;
    unsigned long long* o8 = (unsigned long long*)orow + lane;
    float s = 0.f;
#pragma unroll
    for (int j = 0; j < 4; ++j) { const f32x4 v = xr[64 * j];
        s += (v.x * v.x + v.y * v.y) + (v.z * v.z + v.w * v.w);
        o8[64 * j] = (unsigned long long)pk2(v.x, v.y) | ((unsigned long long)pk2(v.z, v.w) << 32); }
    s += __builtin_bit_cast(float, __builtin_amdgcn_update_dpp(0, __builtin_bit_cast(int, s), 0xB1, 0xf, 0xf, false));
    s += __builtin_bit_cast(float, __builtin_amdgcn_update_dpp(0, __builtin_bit_cast(int, s), 0x4E, 0xf, 0xf, false));
    if ((lane & 3) == 0) ssq[lane >> 2] = s;
}
__device__ __forceinline__ float row_rstd(const float* ssq_row) {
    const f32x4 a = *(const f32x4*)ssq_row, b = *(const f32x4*)(ssq_row + 4), c = *(const f32x4*)(ssq_row + 8), d = *(const f32x4*)(ssq_row + 12);
    const float s = ((a.x + a.y) + (a.z + a.w)) + ((b.x + b.y) + (b.z + b.w)) + ((c.x + c.y) + (c.z + c.w)) + ((d.x + d.y) + (d.z + d.w));
    return __builtin_amdgcn_rsqf(s * (1.0f / DM) + NORM_EPS);
}
namespace epi {
using pg8::Unit; using pg8::BM; using pg8::HALF;
__device__ __forceinline__ u32x4 pack8(const f32x4& a, const f32x4& b) { u32x4 w; w.x = pg8::cvt_pk_bf16(a[0], a[1]); w.y = pg8::cvt_pk_bf16(a[2], a[3]); w.z = pg8::cvt_pk_bf16(b[0], b[1]); w.w = pg8::cvt_pk_bf16(b[2], b[3]); return w; }
__device__ __forceinline__ int rope_class(int c0, int& fb) {
    fb = 0; int o;
    if (c0 >= ZB_Q && c0 < ZB_V) { o = (c0 - ZB_Q) & 63; if (o < 16) { fb = o >> 1; return 1; } return 0; }
    if (c0 >= ZB_IQ && c0 < ZB_IW) { o = (c0 - ZB_IQ) & 31; return o == 0 ? 2 : 0; }
    if (c0 >= ZC_Q && c0 < ZC_V) { o = (c0 - ZC_Q) & 63; if (o < 16) { fb = o >> 1; return 1; } return 0; }
    return 0;
}
struct EpiInProj {
    static constexpr bool PERM = true, AFTER_DRAIN = false;
    bf16_t* Z; const float* ssq; const float* tab16; const float* tabI; bf16_t* KV; bf16_t* IKC;
    __device__ __forceinline__ void operator()(const f32x4 (&acc)[2][2][4][2], const Unit& u, int wr, int wc, int fr, int fq) const {
        const int row0 = u.pm * BM + wr * 64 + fr;
        const int c00 = u.pn * BM + wc * 32 + 8 * fq, c01 = c00 + HALF;
        int fb0, fb1; const int rc0 = rope_class(c00, fb0), rc1 = rope_class(c01, fb1);
#pragma unroll
        for (int ai = 0; ai < 2; ++ai)
#pragma unroll
            for (int m = 0; m < 4; ++m) {
                const int row = row0 + ai * HALF + m * 16;
                const float rs = row_rstd(ssq + (size_t)row * 16);
                const int pos = row & (SEQ - 1);
#pragma unroll
                for (int bj = 0; bj < 2; ++bj) {
                    const int c0 = bj ? c01 : c00, rc = bj ? rc1 : rc0, fb = bj ? fb1 : fb0;
                    if (c0 >= ZP) continue;
                    f32x4 v0 = acc[ai][bj][m][0] * rs, v1 = acc[ai][bj][m][1] * rs;
                    if (rc) {
                        const float* tp = (rc == 1) ? tab16 + pos * 16 + fb : tabI + pos * 8;
                        const f32x4 c = *(const f32x4*)tp, s = *(const f32x4*)(tp + (rc == 1 ? 8 : 4));
                        f32x4 a0, a1;
                        a0[0] = v0[0] * c[0] - v0[1] * s[0]; a0[1] = v0[1] * c[0] + v0[0] * s[0];
                        a0[2] = v0[2] * c[1] - v0[3] * s[1]; a0[3] = v0[3] * c[1] + v0[2] * s[1];
                        a1[0] = v1[0] * c[2] - v1[1] * s[2]; a1[1] = v1[1] * c[2] + v1[0] * s[2];
                        a1[2] = v1[2] * c[3] - v1[3] * s[3]; a1[3] = v1[3] * c[3] + v1[2] * s[3];
                        v0 = a0; v1 = a1;
                    }
                    const u32x4 pk = pack8(v0, v1);
                    if (c0 >= ZB_K && c0 < ZB_IQ) *(u32x4*)(KV + (size_t)row * 128 + (c0 - ZB_K)) = pk;
                    else if (c0 >= ZB_IK && c0 < ZB_IW) *(u32x4*)(IKC + (size_t)row * 32 + (c0 - ZB_IK)) = pk;
                    else *(u32x4*)(Z + (size_t)row * ZP + c0) = pk;
                }
                asm volatile("" ::: "memory");
            }
    }
};
struct EpiPlainZ {
    static constexpr bool PERM = true, AFTER_DRAIN = false;
    bf16_t* Z;
    __device__ __forceinline__ void operator()(const f32x4 (&acc)[2][2][4][2], const Unit& u, int wr, int wc, int fr, int fq) const {
        const int row0 = u.pm * BM + wr * 64 + fr;
#pragma unroll
        for (int ai = 0; ai < 2; ++ai)
#pragma unroll
            for (int m = 0; m < 4; ++m)
#pragma unroll
                for (int bj = 0; bj < 2; ++bj) { const int c0 = u.pn * BM + bj * HALF + wc * 32 + 8 * fq; if (c0 < ZP) *(u32x4*)(Z + (size_t)(row0 + ai * HALF + m * 16) * ZP + c0) = pack8(acc[ai][bj][m][0], acc[ai][bj][m][1]); }
    }
};
struct EpiOutProj {
    static constexpr bool PERM = true, AFTER_DRAIN = false;
    bf16_t* xb; float* ssq_out;
    __device__ __forceinline__ void operator()(const f32x4 (&acc)[2][2][4][2], const Unit& u, int wr, int wc, int fr, int fq) const {
        const int row0 = u.pm * BM + wr * 64 + fr;
#pragma unroll
        for (int ai = 0; ai < 2; ++ai)
#pragma unroll
            for (int m = 0; m < 4; ++m) {
                const int row = row0 + ai * HALF + m * 16; float sq = 0.f;
#pragma unroll
                for (int bj = 0; bj < 2; ++bj) {
                    const size_t off = (size_t)row * DM + u.pn * BM + bj * HALF + wc * 32 + 8 * fq;
                    const u32x4 iw = *(const u32x4*)(xb + off); const f32x4 ia = {bflo(iw.x), bfhi(iw.x), bflo(iw.y), bfhi(iw.y)}, ib = {bflo(iw.z), bfhi(iw.z), bflo(iw.w), bfhi(iw.w)};
                    const f32x4 x0 = ia + acc[ai][bj][m][0], x1 = ib + acc[ai][bj][m][1];
                    *(u32x4*)(xb + off) = pack8(x0, x1);
                    sq += ((x0[0] * x0[0] + x0[1] * x0[1]) + (x0[2] * x0[2] + x0[3] * x0[3])) + ((x1[0] * x1[0] + x1[1] * x1[1]) + (x1[2] * x1[2] + x1[3] * x1[3]));
                }
                sq += __shfl_xor(sq, 16); sq += __shfl_xor(sq, 32);
                if (fq == 0) ssq_out[(size_t)row * 16 + u.pn * 4 + wc] = sq;
            }
    }
};
struct EpiGate {
    static constexpr bool PERM = true, AFTER_DRAIN = false;
    const bf16_t* x1b; const bf16_t* pp; bf16_t* xb; const float* ssq_in; float* ssq_out;
    __device__ __forceinline__ void operator()(const f32x4 (&acc)[2][2][4][2], const Unit& u, int wr, int wc, int fr, int fq) const {
        const int row0 = u.pm * BM + wr * 64 + fr;
#pragma unroll
        for (int ai = 0; ai < 2; ++ai)
#pragma unroll
            for (int m = 0; m < 4; ++m) {
                const int row = row0 + ai * HALF + m * 16; float sq = 0.f;
                const float rs = row_rstd(ssq_in + (size_t)row * 16);
#pragma unroll
                for (int bj = 0; bj < 2; ++bj) {
                    const size_t off = (size_t)row * DM + u.pn * BM + bj * HALF + wc * 32 + 8 * fq;
                    f32x4 g0 = acc[ai][bj][m][0] * rs, g1 = acc[ai][bj][m][1] * rs;
#pragma unroll
                    for (int i = 0; i < 4; ++i) { g0[i] = sigmoidf_(g0[i]); g1[i] = sigmoidf_(g1[i]); }
                    const u32x4 pw = *(const u32x4*)(pp + off); const f32x4 pp0 = {bflo(pw.x), bfhi(pw.x), bflo(pw.y), bfhi(pw.y)}, pp1 = {bflo(pw.z), bfhi(pw.z), bflo(pw.w), bfhi(pw.w)};
                    const u32x4 xw = *(const u32x4*)(x1b + off); const f32x4 xa = {bflo(xw.x), bfhi(xw.x), bflo(xw.y), bfhi(xw.y)}, xc = {bflo(xw.z), bfhi(xw.z), bflo(xw.w), bfhi(xw.w)};
                    const f32x4 x0 = xa + g0 * pp0, x1 = xc + g1 * pp1;
                    *(u32x4*)(xb + off) = pack8(x0, x1);
                    sq += ((x0[0] * x0[0] + x0[1] * x0[1]) + (x0[2] * x0[2] + x0[3] * x0[3])) + ((x1[0] * x1[0] + x1[1] * x1[1]) + (x1[2] * x1[2] + x1[3] * x1[3]));
                }
                sq += __shfl_xor(sq, 16); sq += __shfl_xor(sq, 32);
                if (fq == 0) ssq_out[(size_t)row * 16 + u.pn * 4 + wc] = sq;
            }
    }
};
struct EpiBf16Plain {
    static constexpr bool PERM = true, AFTER_DRAIN = false;
    bf16_t* C;
    __device__ __forceinline__ void operator()(const f32x4 (&acc)[2][2][4][2], const Unit& u, int wr, int wc, int fr, int fq) const {
        const int row0 = u.pm * BM + wr * 64 + fr;
#pragma unroll
        for (int ai = 0; ai < 2; ++ai)
#pragma unroll
            for (int m = 0; m < 4; ++m)
#pragma unroll
                for (int bj = 0; bj < 2; ++bj) {
                    const size_t off = (size_t)(row0 + ai * HALF + m * 16) * DM + u.pn * BM + bj * HALF + wc * 32 + 8 * fq;
                    *(u32x4*)(C + off) = pack8(acc[ai][bj][m][0], acc[ai][bj][m][1]);
                }
    }
};
struct EpiF32 {
    static constexpr bool PERM = true, AFTER_DRAIN = false;
    float* C;
    __device__ __forceinline__ void operator()(const f32x4 (&acc)[2][2][4][2], const Unit& u, int wr, int wc, int fr, int fq) const {
        const int row0 = u.pm * BM + wr * 64 + fr;
#pragma unroll
        for (int ai = 0; ai < 2; ++ai)
#pragma unroll
            for (int m = 0; m < 4; ++m)
#pragma unroll
                for (int bj = 0; bj < 2; ++bj) {
                    const size_t off = (size_t)(row0 + ai * HALF + m * 16) * DM + u.pn * BM + bj * HALF + wc * 32 + 8 * fq;
                    *(f32x4*)(C + off) = acc[ai][bj][m][0]; *(f32x4*)(C + off + 4) = acc[ai][bj][m][1];
                }
    }
};
}
typedef GAS unsigned gu32;
#define RLX_AGENT __ATOMIC_RELAXED, __HIP_MEMORY_SCOPE_AGENT
#define XB_TMO      128
#define XB_XCNT(j)  (256  + 64 * (j))
#define XB_XSUB(j)  (1280 + 64 * (j))
#define XB_XGEN(j)  (2304 + 64 * (j))
#define XB_TOP      3328
#define XB_TOPGEN   3392
#define XCD_BAR_WORDS 3456
#define XB_SPIN_CAP (1u << 27)

__device__ __forceinline__ unsigned xb_ld(unsigned* p)              { return __hip_atomic_load(p, __ATOMIC_RELAXED, __HIP_MEMORY_SCOPE_AGENT); }
__device__ __forceinline__ unsigned xb_add(unsigned* p, unsigned v) { return __hip_atomic_fetch_add(p, v, __ATOMIC_RELAXED, __HIP_MEMORY_SCOPE_AGENT); }
__device__ __forceinline__ unsigned xb_xcc_id() { return (unsigned)__builtin_amdgcn_s_getreg((3 << 11) | 20) & 0xFu; }
#define XB_SPIN(cond, bar) do { unsigned _sp = 0; while (cond) { __builtin_amdgcn_s_sleep(1); \
    if ((++_sp & 255u) == 0u) { if (xb_ld(&(bar)[XB_TMO])) break; if (_sp > XB_SPIN_CAP) { atomicAdd(&(bar)[XB_TMO], 1u); break; } } } } while (0)

struct XcdBarrier {
    unsigned* bar; unsigned x;
    volatile LAS unsigned* st;
};

__device__ __forceinline__ XcdBarrier xcd_barrier_post(unsigned* bar, volatile LAS unsigned* st) {
    XcdBarrier b; b.bar = bar; b.x = xb_xcc_id(); b.st = st;
    if (threadIdx.x == 0) (void)xb_add(&bar[XB_XCNT(b.x)], 1u);
    return b;
}
__device__ __forceinline__ void xcd_barrier_complete(unsigned* bar, unsigned x, unsigned& nloc, unsigned& nx) {
    const unsigned G = gridDim.x * gridDim.y * gridDim.z;
    unsigned sum, cnt, mine, sp = 0u;
    for (;;) {
        sum = 0u; cnt = 0u; mine = 0u;
#pragma unroll
        for (unsigned j = 0; j < 16; ++j) { const unsigned c = xb_ld(&bar[XB_XCNT(j)]); sum += c; cnt += (c > 0u) ? 1u : 0u; mine = (j == x) ? c : mine; }
        if (sum == G) break;
        __builtin_amdgcn_s_sleep(1);
        if ((++sp & 255u) == 0u) { if (xb_ld(&bar[XB_TMO])) break; if (sp > XB_SPIN_CAP) { atomicAdd(&bar[XB_TMO], 1u); break; } }
    }
    nloc = mine > 0u ? mine : 1u; nx = cnt > 0u ? cnt : 1u;
}

__device__ __forceinline__ void xcd_barrier(const XcdBarrier& b) {
    asm volatile("s_waitcnt vmcnt(0)" ::: "memory");
    __syncthreads();
    if (threadIdx.x == 0) {
        unsigned* bar = b.bar;
        __builtin_amdgcn_s_waitcnt(0);
        unsigned nloc = b.st[0], nx = b.st[1];
        if (nloc == 0u) { xcd_barrier_complete(bar, b.x, nloc, nx); b.st[0] = nloc; b.st[1] = nx; }
        const unsigned old = xb_add(&bar[XB_XSUB(b.x)], 1u);
        const unsigned gen = old / nloc;
        if (old + 1u == (gen + 1u) * nloc) {
            __builtin_amdgcn_fence(__ATOMIC_RELEASE, "agent");
            asm volatile("s_waitcnt vmcnt(0)" ::: "memory");
            const unsigned og = xb_add(&bar[XB_TOP], 1u);
            const unsigned tg = og / nx;
            if (og + 1u == (tg + 1u) * nx) xb_add(&bar[XB_TOPGEN], 1u);
            else XB_SPIN(xb_ld(&bar[XB_TOPGEN]) == tg, bar);
            __builtin_amdgcn_fence(__ATOMIC_ACQUIRE, "agent");
            xb_add(&bar[XB_XGEN(b.x)], 1u);
            asm volatile("s_waitcnt vmcnt(0)" ::: "memory");
        } else {
            XB_SPIN(xb_ld(&bar[XB_XGEN(b.x)]) == gen, bar);
            __builtin_amdgcn_fence(__ATOMIC_ACQUIRE, "agent");
            asm volatile("s_waitcnt vmcnt(0)" ::: "memory");
        }
    }
    __syncthreads();
}
struct MixArgs { const bf16_t* Z; bf16_t* Y; const bf16_t* KV; const bf16_t* IKC; const float* mu; const float* w0; const float* w_up; const float* a0; const float* a_up; const float* k_k; const float* k_a; const float* r_k; const float* ln_g; const float* ln_b; };
namespace dsa {
#ifdef PROBE_T
#define DTS ((volatile LAS unsigned long long*)((LAS unsigned char*)ldsb + 131072 + 1024))
#define DSTAMP_B(id) do { if ((id) == PROBE_T && blockIdx.x == 0 && threadIdx.x == 0) DTS[0] = __builtin_amdgcn_s_memrealtime(); } while (0)
#define DSTAMP_E(id) do { if ((id) == PROBE_T && blockIdx.x == 0 && threadIdx.x == 0) DTS[1] += __builtin_amdgcn_s_memrealtime() - DTS[0]; } while (0)
#else
#define DSTAMP_B(id) do {} while (0)
#define DSTAMP_E(id) do {} while (0)
#endif
#define MFMA32(a, b, c) __builtin_amdgcn_mfma_f32_32x32x16_bf16((a), (b), (c), 0, 0, 0)
typedef short v4i16_t __attribute__((ext_vector_type(4)));
typedef short s16x4 __attribute__((ext_vector_type(4)));
constexpr int WAVE_LDS = 2048 + 4096;
constexpr int IKS_OFF = 8 * WAVE_LDS, IKS_BYTES = 65536;
__device__ __forceinline__ unsigned fkey(float f) { const unsigned b = __builtin_bit_cast(unsigned, f); return (b & 0x80000000u) ? ~b : (b | 0x80000000u); }
__device__ __forceinline__ float keyf(unsigned u) { const unsigned b = (u & 0x80000000u) ? (u & 0x7fffffffu) : ~u; return __builtin_bit_cast(float, b); }
__device__ __forceinline__ float relu_(float x) { const int b = __builtin_bit_cast(int, x); return __builtin_bit_cast(float, b > 0 ? b : 0); }
__device__ __forceinline__ s16x4 vtr(const LAS unsigned char* p) { return __builtin_bit_cast(s16x4, __builtin_amdgcn_ds_read_tr16_b64_v4i16((LAS v4i16_t*)p)); }

#define DPP_(v, ctrl) ((unsigned)__builtin_amdgcn_update_dpp((int)(v), (int)(v), (ctrl), 0xf, 0xf, false))
__device__ __forceinline__ unsigned half_min(unsigned v) { v = min(v, DPP_(v, 0xB1)); v = min(v, DPP_(v, 0x4E)); v = min(v, DPP_(v, 0x141)); v = min(v, DPP_(v, 0x140)); return min(v, (unsigned)__builtin_amdgcn_ds_swizzle((int)v, 0x401F)); }
__device__ __forceinline__ unsigned half_max(unsigned v) { v = max(v, DPP_(v, 0xB1)); v = max(v, DPP_(v, 0x4E)); v = max(v, DPP_(v, 0x141)); v = max(v, DPP_(v, 0x140)); return max(v, (unsigned)__builtin_amdgcn_ds_swizzle((int)v, 0x401F)); }
__device__ __forceinline__ int half_sum(int v) { v += (int)DPP_(v, 0xB1); v += (int)DPP_(v, 0x4E); v += (int)DPP_(v, 0x141); v += (int)DPP_(v, 0x140); return v + __builtin_amdgcn_ds_swizzle(v, 0x401F); }
__device__ __forceinline__ unsigned next_pivot(unsigned ulo, unsigned uhi, int clo, int chi, int it) {
    unsigned p;
    const bool hl = clo >= 0, hh = chi >= 0;
    if (it == 0) p = fkey(0.0f);
    else if (!hh) { const float f = keyf(ulo); p = fkey(f >= 0.f ? 2.f * f + 0.25f : 0.5f * f + 0.125f); }
    else if (!hl) { const float f = keyf(uhi); p = fkey(f <= 0.f ? 2.f * f - 0.25f : 0.5f * f - 0.125f); }
    else { const float fl = keyf(ulo), fh = keyf(uhi);
        float fr = ((float)(clo - 256) + 0.5f) * __builtin_amdgcn_rcpf((float)(clo - chi)); fr = fminf(fmaxf(fr, 1.f / 32.f), 31.f / 32.f);
        if (it % 3 == 2) fr = 0.5f;
        p = fkey(fl + (fh - fl) * fr); }
    if (!(p > ulo && p < uhi)) p = ulo + ((uhi - ulo) >> 1);
    return p;
}

__device__ __forceinline__ void dsa_unit(const MixArgs& a, unsigned char* ldsb, int b, int blk) {
    const int tid = opaque_tid(), lane = tid & 63, wave = __builtin_amdgcn_readfirstlane(tid >> 6), r32 = lane & 31, hi = lane >> 5;
    const GAS bf16_t* zb = (const GAS bf16_t*)a.Z + (size_t)b * SEQ * ZP;
    LAS unsigned char* wl = (LAS unsigned char*)ldsb + wave * WAVE_LDS;
    LAS unsigned* bm = (LAS unsigned*)wl;
    LAS unsigned char* vimg = wl + 2048;
    const int tw = blk * 64 + 8 * wave;
    f32x16 zero16;
#pragma unroll
    for (int i = 0; i < 16; ++i) zero16[i] = 0.f;
#ifdef PROBE_SEL
#define NRND 4
#else
#define NRND 2
#endif
#pragma unroll 1
    for (int rnd_ = 0; rnd_ < NRND; ++rnd_) { const int rnd = rnd_ & 1;
        const int tb = tw + 4 * rnd;
        const int qsub = 2 * ((r32 >> 2) & 1) + (r32 >> 4), head = (r32 & 3) + 4 * ((r32 >> 3) & 1);
        const GAS bf16_t* iqp = zb + (size_t)(tb + qsub) * ZP + ZB_IQ + head * 32 + 8 * hi;
        bf16x8 aiq0, aiq1;
        { const u32x4 r0 = *(const GAS u32x4*)iqp, r1 = *(const GAS u32x4*)(iqp + 16); const float wr = bf2f(zb[(size_t)(tb + qsub) * ZP + ZB_IW + head]);
          u32x4 s0, s1;
          s0.x = pk2(bflo(r0.x) * wr, bfhi(r0.x) * wr); s0.y = pk2(bflo(r0.y) * wr, bfhi(r0.y) * wr); s0.z = pk2(bflo(r0.z) * wr, bfhi(r0.z) * wr); s0.w = pk2(bflo(r0.w) * wr, bfhi(r0.w) * wr);
          s1.x = pk2(bflo(r1.x) * wr, bfhi(r1.x) * wr); s1.y = pk2(bflo(r1.y) * wr, bfhi(r1.y) * wr); s1.z = pk2(bflo(r1.z) * wr, bfhi(r1.z) * wr); s1.w = pk2(bflo(r1.w) * wr, bfhi(r1.w) * wr);
          aiq0 = __builtin_bit_cast(bf16x8, s0); aiq1 = __builtin_bit_cast(bf16x8, s1); }
        const int tqA = tb + 2 * hi, tqB = tqA + 1;
        float wA[8], wB[8];
        { const u32x4 ua = *(const GAS u32x4*)(zb + (size_t)tqA * ZP + ZB_IW), ub = *(const GAS u32x4*)(zb + (size_t)tqB * ZP + ZB_IW);
          wA[0] = bflo(ua.x); wA[1] = bfhi(ua.x); wA[2] = bflo(ua.y); wA[3] = bfhi(ua.y); wA[4] = bflo(ua.z); wA[5] = bfhi(ua.z); wA[6] = bflo(ua.w); wA[7] = bfhi(ua.w);
          wB[0] = bflo(ub.x); wB[1] = bfhi(ub.x); wB[2] = bflo(ub.y); wB[3] = bfhi(ub.y); wB[4] = bflo(ub.z); wB[5] = bfhi(ub.z); wB[6] = bflo(ub.w); wB[7] = bfhi(ub.w); }
#pragma unroll
        for (int r = 0; r < 8; ++r) { wA[r] = (wA[r] > 0.f) ? INFINITY : -INFINITY; wB[r] = (wB[r] > 0.f) ? INFINITY : -INFINITY; }
        unsigned scA[64], scB[64];
        const int dA = tqA - 32 * ((tb + 3) >> 5);
        const int Tmax = (tb + 3) >> 5;
        int Tm_s = Tmax, Tm_b = Tmax; asm volatile("" : "+s"(Tm_s), "+s"(Tm_b));
        DSTAMP_B(30);
        const int TmaxU = 2 * blk + 1;
        const int fsw = (r32 >> 2) & 3;
        const LAS unsigned char* ikl = (const LAS unsigned char*)ldsb + IKS_OFF + r32 * 64;
        const int off0 = (hi ^ fsw) * 16, off1 = ((2 + hi) ^ fsw) * 16;
#ifdef PROBE_SCORE
        for (int rep_ = 0; rep_ < 2; ++rep_)
#endif
#pragma unroll
        for (int half = 0; half < 2; ++half) {
            if (32 * half <= TmaxU) {
                __syncthreads();
                { const int nkeys = min(32 * (TmaxU + 1) - 1024 * half, 1024);
                  const GAS bf16_t* src = (const GAS bf16_t*)a.IKC + ((size_t)b * SEQ + 1024 * half) * 32;
                  for (int ch = tid; ch < nkeys * 4; ch += 512) { const int key = ch >> 2, c4 = ch & 3;
                      *(LAS u32x4*)((LAS unsigned char*)ldsb + IKS_OFF + key * 64 + ((c4 ^ ((key >> 2) & 3)) * 16)) = *(const GAS u32x4*)(src + key * 32 + c4 * 8); } }
                asm volatile("s_waitcnt vmcnt(0) lgkmcnt(0)" ::: "memory");
                __syncthreads();
                bf16x8 kb0[2], kb1[2];
#pragma unroll
                for (int i = 0; i < 2; ++i) { if (32 * half + i <= Tm_s) { kb0[i] = *(const LAS bf16x8*)(ikl + i * 2048 + off0); kb1[i] = *(const LAS bf16x8*)(ikl + i * 2048 + off1); } }
#pragma unroll
                for (int i = 0; i < 32; ++i) { const int T = 32 * half + i;
                    if (T <= Tm_s) {
                        f32x16 c = MFMA32(aiq0, kb0[i & 1], zero16); c = MFMA32(aiq1, kb1[i & 1], c);
                        if (i + 2 < 32 && T + 2 <= Tm_s) { kb0[i & 1] = *(const LAS bf16x8*)(ikl + (i + 2) * 2048 + off0); kb1[i & 1] = *(const LAS bf16x8*)(ikl + (i + 2) * 2048 + off1); }
                        float sA = 0.f, sB = 0.f;
#pragma unroll
                        for (int r = 0; r < 8; ++r) { sA += __builtin_amdgcn_fmed3f(c[r], 0.f, wA[r]); sB += __builtin_amdgcn_fmed3f(c[8 + r], 0.f, wB[r]); }
                        const bool last = (T == Tm_s);
                        scA[T] = (!last || r32 <= dA) ? fkey(sA + 0.f) : 0u; scB[T] = (!last || r32 <= dA + 1) ? fkey(sB + 0.f) : 0u;
                    } else { scA[T] = 0u; scB[T] = 0u; }
                }
            } else {
#pragma unroll
                for (int i = 0; i < 32; ++i) { scA[32 * half + i] = 0u; scB[32 * half + i] = 0u; }
            }
        }
        DSTAMP_E(30); DSTAMP_B(31);
        const int nA = tqA + 1, nB = tqB + 1;
        unsigned uloA = 1u, uhiA = 0xffffffffu, uloB = 1u, uhiB = 0xffffffffu; int cloA = -1, chiA = -1, cloB = -1, chiB = -1;
        bool doneA = nA <= 256, doneB = nB <= 256;
        unsigned thA = 1u, thB = 1u; int needA = 0, needB = 0;
        int itn = 0, lim = 128;
        constexpr int CAP = 12;
        LAS unsigned* lstA = (LAS unsigned*)((LAS unsigned char*)ldsb + IKS_OFF + wave * 8192) + lane * (CAP + 1), *lstB = lstA + 64 * (CAP + 1);
        unsigned ca_[CAP], cb_[CAP];
        for (;;) {
            DSTAMP_B(34);
            for (; itn < 200; ++itn) {
                if (!doneA && uhiA - uloA <= 1u) { thA = uhiA; needA = 256 - max(chiA, 0); doneA = true; }
                if (!doneB && uhiB - uloB <= 1u) { thB = uhiB; needB = 256 - max(chiB, 0); doneB = true; }
                const bool actA = !doneA && ((cloA < 0 ? nA : cloA) - max(chiA, 0) > lim), actB = !doneB && ((cloB < 0 ? nB : cloB) - max(chiB, 0) > lim);
                if (!__any(actA || actB)) break;
                const unsigned pA = actA ? next_pivot(uloA, uhiA, cloA, chiA, itn) : 0xffffffffu, pB = actB ? next_pivot(uloB, uhiB, cloB, chiB, itn) : 0xffffffffu;
                int ca = 0, cb = 0;
#pragma unroll
                for (int T = 0; T < 64; ++T)
                    asm("v_cmp_ge_u32 vcc, %2, %3\n\tv_addc_co_u32 %0, vcc, 0, %0, vcc\n\tv_cmp_ge_u32 vcc, %4, %5\n\tv_addc_co_u32 %1, vcc, 0, %1, vcc" : "+v"(ca), "+v"(cb) : "v"(scA[T]), "v"(pA), "v"(scB[T]), "v"(pB) : "vcc");
                const int pk = half_sum(ca | (cb << 16));
                ca = pk & 0xffff; cb = pk >> 16;
                if (actA) { if (ca == 256) { thA = pA; needA = 0; doneA = true; } else if (ca > 256) { uloA = pA; cloA = ca; } else { uhiA = pA; chiA = ca; } }
                if (actB) { if (cb == 256) { thB = pB; needB = 0; doneB = true; } else if (cb > 256) { uloB = pB; cloB = cb; } else { uhiB = pB; chiB = cb; } }
            }
            DSTAMP_E(34);
            if (!__any(!doneA || !doneB)) break;
            DSTAMP_B(35);
            const unsigned wA_ = doneA ? 0u : uhiA - uloA, wB_ = doneB ? 0u : uhiB - uloB;
            int nA_ = 0, nB_ = 0;
#pragma unroll
            for (int T = 0; T < 64; ++T) {
                lstA[min(nA_, CAP)] = scA[T]; lstB[min(nB_, CAP)] = scB[T];
                nA_ += ((scA[T] - uloA) < wA_) ? 1 : 0; nB_ += ((scB[T] - uloB) < wB_) ? 1 : 0;
            }
            asm volatile("s_waitcnt lgkmcnt(0)" ::: "memory");
            if (__any(nA_ > CAP || nB_ > CAP) && itn < 200) { lim >>= 1; continue; }
#pragma unroll
            for (int j = 0; j < CAP; ++j) { ca_[j] = (j < nA_) ? lstA[j] : 0u; cb_[j] = (j < nB_) ? lstB[j] : 0u; }
            DSTAMP_E(35);
            break;
        }
        if (__any(!doneA || !doneB)) {
            DSTAMP_B(36);
            const int baseA = max(chiA, 0), baseB = max(chiB, 0);
            for (; itn < 400; ++itn) {
                unsigned mnA = 0xffffffffu, mxA = 0u, mnB = 0xffffffffu, mxB = 0u;
                const unsigned wa = doneA ? 0u : uhiA - uloA, wb = doneB ? 0u : uhiB - uloB;
#pragma unroll
                for (int j = 0; j < CAP; ++j) { if ((ca_[j] - uloA) < wa) { mnA = min(mnA, ca_[j]); mxA = max(mxA, ca_[j]); } if ((cb_[j] - uloB) < wb) { mnB = min(mnB, cb_[j]); mxB = max(mxB, cb_[j]); } }
                mnA = half_min(mnA); mxA = half_max(mxA); mnB = half_min(mnB); mxB = half_max(mxB);
                if (!doneA) { if (mnA >= mxA) { thA = mxA + 1u; needA = 256 - max(chiA, 0); doneA = true; } else { uloA = mnA; uhiA = mxA + 1u; if (cloA < 0) cloA = nA; if (chiA < 0) chiA = 0; } }
                if (!doneB) { if (mnB >= mxB) { thB = mxB + 1u; needB = 256 - max(chiB, 0); doneB = true; } else { uloB = mnB; uhiB = mxB + 1u; if (cloB < 0) cloB = nB; if (chiB < 0) chiB = 0; } }
                if (!__any(!doneA || !doneB)) break;
                const unsigned pA = doneA ? 0xffffffffu : next_pivot(uloA, uhiA, cloA, chiA, itn | 1), pB = doneB ? 0xffffffffu : next_pivot(uloB, uhiB, cloB, chiB, itn | 1);
                int pk = 0;
#pragma unroll
                for (int j = 0; j < CAP; ++j) pk += ((ca_[j] >= pA) ? 1 : 0) + ((cb_[j] >= pB) ? 0x10000 : 0);
                pk = half_sum(pk);
                const int ca = baseA + (pk & 0xffff), cb = baseB + (pk >> 16);
                if (!doneA) { if (ca == 256) { thA = pA; needA = 0; doneA = true; } else if (ca > 256) { uloA = pA; cloA = ca; } else { uhiA = pA; chiA = ca; } }
                if (!doneB) { if (cb == 256) { thB = pB; needB = 0; doneB = true; } else if (cb > 256) { uloB = pB; cloB = cb; } else { uhiB = pB; chiB = cb; } }
            }
            DSTAMP_E(36);
        }
        DSTAMP_E(31); DSTAMP_B(32);
        int rem0 = __builtin_amdgcn_readlane(needA, 0), rem1 = __builtin_amdgcn_readlane(needB, 0), rem2 = __builtin_amdgcn_readlane(needA, 32), rem3 = __builtin_amdgcn_readlane(needB, 32);
        const bool anytie = (rem0 | rem1 | rem2 | rem3) != 0;
        LAS unsigned* bmr = bm + 4 * rnd; asm volatile("" : "+v"(bmr));
#pragma unroll
        for (int T = 0; T < 64; ++T) {
            if (T <= Tm_b) {
                const unsigned long long mA = __ballot(scA[T] >= thA), mB = __ballot(scB[T] >= thB);
                unsigned m0 = (unsigned)mA, m2 = (unsigned)(mA >> 32), m1 = (unsigned)mB, m3 = (unsigned)(mB >> 32);
                if (anytie) {
                    const unsigned long long eA = __ballot(scA[T] == thA - 1u), eB = __ballot(scB[T] == thB - 1u);
                    unsigned e0 = (unsigned)eA, e2 = (unsigned)(eA >> 32), e1 = (unsigned)eB, e3 = (unsigned)(eB >> 32);
                    while (rem0 > 0 && e0) { const unsigned bit = e0 & (0u - e0); m0 |= bit; e0 ^= bit; --rem0; }
                    while (rem1 > 0 && e1) { const unsigned bit = e1 & (0u - e1); m1 |= bit; e1 ^= bit; --rem1; }
                    while (rem2 > 0 && e2) { const unsigned bit = e2 & (0u - e2); m2 |= bit; e2 ^= bit; --rem2; }
                    while (rem3 > 0 && e3) { const unsigned bit = e3 & (0u - e3); m3 |= bit; e3 ^= bit; --rem3; }
                }
                if (lane == 0) { u32x4 w; w.x = m0; w.y = m1; w.z = m2; w.w = m3; *(LAS u32x4*)(bmr + T * 8) = w; }
            }
        }
        DSTAMP_E(32);
    }
    DSTAMP_B(33);
    asm volatile("s_waitcnt lgkmcnt(0)" ::: "memory");
    const int qc = r32 >> 2, hc = r32 & 3;
    const GAS bf16_t* kvb = (const GAS bf16_t*)a.KV + (size_t)b * SEQ * 128;
    const size_t qrow = (size_t)(b * SEQ + tw + qc);
    bf16x8 bq[4];
#pragma unroll
    for (int s = 0; s < 4; ++s) bq[s] = *(const GAS bf16x8*)((const GAS bf16_t*)a.Z + qrow * ZP + ZB_Q + hc * 64 + 16 * s + 8 * hi);
    f32x16 o0 = zero16, o1 = zero16, lacc = zero16; float lsum = 0.f;
    const bf16x8 ones8 = {(short)0x3f80, (short)0x3f80, (short)0x3f80, (short)0x3f80, (short)0x3f80, (short)0x3f80, (short)0x3f80, (short)0x3f80};
    const int Tend = (tw + 7) >> 5;
    const int g16 = lane >> 4, i16 = lane & 15, q4 = i16 >> 2, p4 = i16 & 3;
    const int vrd = ((g16 >> 1) * 4 + q4) * 64 + (16 * (g16 & 1) + 4 * p4) * 2;
    const int vwr_key = lane >> 3, vwr_ch = lane & 7;
    LAS unsigned char* kimg = (LAS unsigned char*)ldsb + (wave < 3 ? 114688 + wave * 4608 : 133120 + (wave - 3) * 4608);
    u32x4 vst[4], kst[4];
    auto load_tile = [&](int T) {
#pragma unroll
        for (int i = 0; i < 4; ++i) kst[i] = *(const GAS u32x4*)(kvb + (size_t)(32 * T + vwr_key + 8 * i) * 128 + 8 * vwr_ch);
#pragma unroll
        for (int i = 0; i < 4; ++i) vst[i] = *(const GAS u32x4*)(kvb + (size_t)(32 * T + vwr_key + 8 * i) * 128 + 64 + 8 * vwr_ch);
    };
#ifdef PROBE_ATT
    for (int rep_ = 0; rep_ < 2; ++rep_) { o0 = zero16; o1 = zero16; lacc = zero16; lsum = 0.f;
#endif
    load_tile(0);
#pragma unroll 1
    for (int T = 0; T <= Tend; ++T) {
#pragma unroll
        for (int i = 0; i < 4; ++i) *(LAS u32x4*)(vimg + (vwr_ch >> 2) * 2048 + (vwr_key + 8 * i) * 64 + (vwr_ch & 3) * 16) = vst[i];
#pragma unroll
        for (int i = 0; i < 4; ++i) *(LAS u32x4*)(kimg + (vwr_key + 8 * i) * 144 + vwr_ch * 16) = kst[i];
        asm volatile("s_waitcnt lgkmcnt(0)" ::: "memory");
        bf16x8 ak[4];
#pragma unroll
        for (int s = 0; s < 4; ++s) ak[s] = *(const LAS bf16x8*)(kimg + r32 * 144 + (2 * s + hi) * 16);
        asm volatile("s_waitcnt lgkmcnt(0)" : "+v"(ak[0]), "+v"(ak[1]), "+v"(ak[2]), "+v"(ak[3]) :: "memory");
        f32x16 sacc = MFMA32(ak[0], bq[0], zero16); sacc = MFMA32(ak[1], bq[1], sacc); sacc = MFMA32(ak[2], bq[2], sacc); sacc = MFMA32(ak[3], bq[3], sacc);
        const unsigned mw = bm[T * 8 + qc] >> (4 * hi);
        if (T < Tend) load_tile(T + 1);
        asm volatile("s_waitcnt lgkmcnt(0)" ::: "memory");
        s16x4 va[2][2][2];
#pragma unroll
        for (int dt = 0; dt < 2; ++dt)
#pragma unroll
            for (int s = 0; s < 2; ++s) { va[dt][s][0] = vtr(vimg + dt * 2048 + (16 * s) * 64 + vrd); va[dt][s][1] = vtr(vimg + dt * 2048 + (16 * s + 8) * 64 + vrd); }
        unsigned pw[8];
#pragma unroll
        for (int r = 0; r < 16; r += 2) {
            float m0, m1; asm("v_min_f32 %0, 0x42800000, %1" : "=v"(m0) : "v"(sacc[r])); asm("v_min_f32 %0, 0x42800000, %1" : "=v"(m1) : "v"(sacc[r + 1]));
            const unsigned pkw = pk2(__builtin_amdgcn_exp2f(m0), __builtin_amdgcn_exp2f(m1));
            const int c0 = (r & 3) + 8 * (r >> 2), c1 = ((r + 1) & 3) + 8 * ((r + 1) >> 2);
            const unsigned a_ = (unsigned)__builtin_amdgcn_sbfe((int)mw, c0, 1), b_ = (unsigned)__builtin_amdgcn_sbfe((int)mw, c1, 1);
            pw[r >> 1] = pkw & ((a_ & 0xffffu) | (b_ & 0xffff0000u));
        }
        asm volatile("s_waitcnt lgkmcnt(0)" ::: "memory");
#pragma unroll
        for (int s = 0; s < 2; ++s) {
            u32x4 pv4; pv4.x = pw[4 * s]; pv4.y = pw[4 * s + 1]; pv4.z = pw[4 * s + 2]; pv4.w = pw[4 * s + 3];
            const bf16x8 pb = __builtin_bit_cast(bf16x8, pv4);
            const bf16x8 v0 = __builtin_shufflevector(va[0][s][0], va[0][s][1], 0, 1, 2, 3, 4, 5, 6, 7), v1 = __builtin_shufflevector(va[1][s][0], va[1][s][1], 0, 1, 2, 3, 4, 5, 6, 7);
            o0 = MFMA32(v0, pb, o0); o1 = MFMA32(v1, pb, o1); lacc = MFMA32(ones8, pb, lacc);
        }
    }
#ifdef PROBE_ATT
    }
#endif
    DSTAMP_E(33);
    lsum = lacc[0];
    const float rl = 1.0f / lsum;
    const GAS bf16_t* gp = (const GAS bf16_t*)a.Z + qrow * ZP + ZB_G + hc * 64; GAS bf16_t* yp = (GAS bf16_t*)a.Y + qrow * DM + 384 + hc * 64;
#pragma unroll
    for (int dt = 0; dt < 2; ++dt)
#pragma unroll
        for (int i = 0; i < 4; ++i) {
            const int d = 32 * dt + 8 * i + 4 * hi;
            const u32x2 gw = *(const GAS u32x2*)(gp + d);
            const float g0 = bflo(gw.x), g1 = bfhi(gw.x), g2 = bflo(gw.y), g3 = bfhi(gw.y);
            const f32x16& o = dt ? o1 : o0;
            u32x2 w; w.x = pk2(o[4 * i] * rl * g0 * sigmoidf_(g0), o[4 * i + 1] * rl * g1 * sigmoidf_(g1)); w.y = pk2(o[4 * i + 2] * rl * g2 * sigmoidf_(g2), o[4 * i + 3] * rl * g3 * sigmoidf_(g3));
            *(GAS u32x2*)(yp + d) = w;
        }
}
}
namespace dil {
using dsa::vtr; using dsa::s16x4;
__device__ __forceinline__ void dil_unit(const MixArgs& a, float* LQ, unsigned char* ldsb, int b, int gi, int u16) {
    const int tid = opaque_tid(), lane = tid & 63, wave = __builtin_amdgcn_readfirstlane(tid >> 6), r32 = lane & 31, hi = lane >> 5;
    const int rate = (gi == 0) ? 1 : (gi == 1) ? 4 : 16, nblk = 16 / rate, c = u16 / nblk, qb = u16 % nblk;
    const int head = gi * 2 + (wave >> 2), q0 = 128 * qb + 32 * (wave & 3);
    const GAS bf16_t* zb = (const GAS bf16_t*)a.Z + (size_t)b * SEQ * ZP;
    LAS unsigned char* vimg = (LAS unsigned char*)ldsb + wave * 4096;
    f32x16 zero16;
#pragma unroll
    for (int i = 0; i < 16; ++i) zero16[i] = 0.f;
    const size_t qrow = (size_t)b * SEQ + (size_t)(q0 + r32) * rate + c;
    bf16x8 bq[4];
#pragma unroll
    for (int s = 0; s < 4; ++s) bq[s] = *(const GAS bf16x8*)((const GAS bf16_t*)a.Z + qrow * ZP + ZC_Q + head * 64 + 16 * s + 8 * hi);
    f32x16 o0 = zero16, o1 = zero16; float lsum = 0.f;
    const int g16 = lane >> 4, i16 = lane & 15, q4 = i16 >> 2, p4 = i16 & 3;
    const int vrd = ((g16 >> 1) * 4 + q4) * 64 + (16 * (g16 & 1) + 4 * p4) * 2;
    const int vwr_key = lane >> 3, vwr_ch = lane & 7;
    bf16x8 akr[3][4]; u32x4 vstr[3][4];
#define DIL_LOAD(set, tix) do { const int j0_ = q0 - 128 + 32 * (tix); if (j0_ >= 0) { \
        _Pragma("unroll") for (int s = 0; s < 4; ++s) akr[set][s] = *(const GAS bf16x8*)(zb + ((size_t)(j0_ + r32) * rate + c) * ZP + ZC_K + head * 64 + 16 * s + 8 * hi); \
        _Pragma("unroll") for (int i = 0; i < 4; ++i) vstr[set][i] = *(const GAS u32x4*)(zb + ((size_t)(j0_ + vwr_key + 8 * i) * rate + c) * ZP + ZC_V + head * 64 + 8 * vwr_ch); } } while (0)
    DIL_LOAD(0, 0); DIL_LOAD(1, 1); DIL_LOAD(2, 2);
#pragma unroll
    for (int ti = 0; ti < 5; ++ti) {
        const int j0 = q0 - 128 + 32 * ti;
        if (j0 < 0) { if (ti + 3 < 5) DIL_LOAD(ti % 3, ti + 3); continue; }
        bf16x8 ak[4];
#pragma unroll
        for (int s = 0; s < 4; ++s) ak[s] = akr[ti % 3][s];
#pragma unroll
        for (int i = 0; i < 4; ++i) *(LAS u32x4*)(vimg + (vwr_ch >> 2) * 2048 + (vwr_key + 8 * i) * 64 + (vwr_ch & 3) * 16) = vstr[ti % 3][i];
        f32x16 sacc = MFMA32(ak[0], bq[0], zero16); sacc = MFMA32(ak[1], bq[1], sacc); sacc = MFMA32(ak[2], bq[2], sacc); sacc = MFMA32(ak[3], bq[3], sacc);
        if (ti + 3 < 5) DIL_LOAD(ti % 3, ti + 3);
        asm volatile("s_waitcnt lgkmcnt(0)" ::: "memory");
        s16x4 va[2][2][2];
#pragma unroll
        for (int dt = 0; dt < 2; ++dt)
#pragma unroll
            for (int s = 0; s < 2; ++s) { va[dt][s][0] = vtr(vimg + dt * 2048 + (16 * s) * 64 + vrd); va[dt][s][1] = vtr(vimg + dt * 2048 + (16 * s + 8) * 64 + vrd); }
        const int dbase = q0 + r32 - j0 - 4 * hi;
        unsigned pw[8];
#pragma unroll
        for (int r = 0; r < 16; r += 2) {
            const int d0 = dbase - ((r & 3) + 8 * (r >> 2)), d1 = dbase - (((r + 1) & 3) + 8 * ((r + 1) >> 2));
            float p0 = __builtin_amdgcn_exp2f(fminf(sacc[r], 64.f)), p1 = __builtin_amdgcn_exp2f(fminf(sacc[r + 1], 64.f));
            p0 = ((unsigned)d0 <= 128u) ? p0 : 0.f; p1 = ((unsigned)d1 <= 128u) ? p1 : 0.f;
            lsum += p0 + p1;
            pw[r >> 1] = pk2(p0, p1);
        }
        asm volatile("s_waitcnt lgkmcnt(0)" ::: "memory");
#pragma unroll
        for (int s = 0; s < 2; ++s) {
            u32x4 pv4; pv4.x = pw[4 * s]; pv4.y = pw[4 * s + 1]; pv4.z = pw[4 * s + 2]; pv4.w = pw[4 * s + 3];
            const bf16x8 pb = __builtin_bit_cast(bf16x8, pv4);
            const bf16x8 v0 = __builtin_shufflevector(va[0][s][0], va[0][s][1], 0, 1, 2, 3, 4, 5, 6, 7), v1 = __builtin_shufflevector(va[1][s][0], va[1][s][1], 0, 1, 2, 3, 4, 5, 6, 7);
            o0 = MFMA32(v0, pb, o0); o1 = MFMA32(v1, pb, o1);
        }
    }
    lsum += __shfl_xor(lsum, 32);
    if (hi == 0) LQ[qrow * 8 + head] = lsum;
    GAS bf16_t* yp = (GAS bf16_t*)a.Y + qrow * DM + 640 + head * 64;
#pragma unroll
    for (int dt = 0; dt < 2; ++dt)
#pragma unroll
        for (int i = 0; i < 4; ++i) {
            const int d = 32 * dt + 8 * i + 4 * hi; const f32x16& o = dt ? o1 : o0;
            u32x2 w; w.x = pk2(o[4 * i], o[4 * i + 1]); w.y = pk2(o[4 * i + 2], o[4 * i + 3]);
            *(GAS u32x2*)(yp + d) = w;
        }
}
__device__ __forceinline__ void dil_merge(const MixArgs& a, const float* LQ, int first, int nthreads) {
    constexpr int NCH = MTOK * 48;
    for (int id0 = first; id0 < NCH; id0 += 4 * nthreads) {
        u32x4 ow[4], gw[4]; float rl[4];
#pragma unroll
        for (int j = 0; j < 4; ++j) { const int id = id0 + j * nthreads; if (id < NCH) { const int row = id / 48, ch = id % 48;
            ow[j] = *(const GAS u32x4*)((const GAS bf16_t*)a.Y + (size_t)row * DM + 640 + ch * 8); gw[j] = *(const GAS u32x4*)((const GAS bf16_t*)a.Z + (size_t)row * ZP + ZC_G + ch * 8);
            const float* lq = LQ + (size_t)row * 8 + ((ch >> 3) & 1); rl[j] = lq[0] + lq[2] + lq[4]; } }
#pragma unroll
        for (int j = 0; j < 4; ++j) { const int id = id0 + j * nthreads; if (id < NCH) { const int row = id / 48, ch = id % 48; const float r = __builtin_amdgcn_rcpf(rl[j]);
            const unsigned o4[4] = {ow[j].x, ow[j].y, ow[j].z, ow[j].w}, g4[4] = {gw[j].x, gw[j].y, gw[j].z, gw[j].w}; unsigned w4[4];
#pragma unroll
            for (int k = 0; k < 4; ++k) { const float g0 = bflo(g4[k]), g1 = bfhi(g4[k]); w4[k] = pk2(bflo(o4[k]) * r * g0 * sigmoidf_(g0), bfhi(o4[k]) * r * g1 * sigmoidf_(g1)); }
            u32x4 w; w.x = w4[0]; w.y = w4[1]; w.z = w4[2]; w.w = w4[3]; *(GAS u32x4*)((GAS bf16_t*)a.Y + (size_t)row * DM + 640 + ch * 8) = w; } }
    }
}
}
namespace rwkv {
#ifdef PROBE_T
#define RTS ((volatile LAS unsigned long long*)((LAS unsigned char*)ldsb + 131072 + 1024))
#define RST(id_end, id_begin) do { if (blockIdx.x == 0 && threadIdx.x == 0) { const unsigned long long now_ = __builtin_amdgcn_s_memrealtime(); if ((id_end) == PROBE_T) RTS[1] += now_ - RTS[0]; if ((id_begin) == PROBE_T) RTS[0] = now_; } } while (0)
#else
#define RST(a, b) do {} while (0)
#endif
using dsa::vtr; using dsa::s16x4;
constexpr int IP = 144;
constexpr int IMG = 64 * IP;
constexpr int S_WD = 0 * IMG, S_AD = 1 * IMG, S_V = 2 * IMG, S_AT = 3 * IMG, S_BH = 4 * IMG, S_KH = 5 * IMG, S_RT = 6 * IMG, S_KB = 7 * IMG, S_BB = 8 * IMG, S_ARB = 9 * IMG, S_AH = 10 * IMG, S_UV = 11 * IMG;
constexpr int S_AAK = S_WD, S_ARK = S_AD, S_TT = S_BH, S_W1 = S_KH;
constexpr int F_AAB = 12 * IMG;
constexpr int F_LG = S_ARB;
constexpr int F_TOT = F_AAB + 16384;
static_assert(F_TOT + 512 <= 131072 && F_LG + 16384 <= F_AAB, "rwkv LDS map");

struct RArgs { const float* mu; const float* w0; const float* a0; const float* k_k; const float* k_a; const float* r_k; const float* ln_g; const float* ln_b;
               const bf16_t* wupT; const bf16_t* aupT; bf16_t* RQ; bf16_t* RM; bf16_t* RN; float* RG; float* RB; };

__device__ __forceinline__ bf16x8 rowfrag(const LAS unsigned char* img, int r0, int k0, int r32, int hi) { return *(const LAS bf16x8*)(img + (r0 + r32) * IP + (k0 + 8 * hi) * 2); }
__device__ __forceinline__ bf16x8 colfrag(const LAS unsigned char* img, int c0, int k0, int lane) {
    const int g16 = lane >> 4, i16 = lane & 15;
    const LAS unsigned char* p = img + (k0 + 8 * (g16 >> 1) + (i16 >> 2)) * IP + (c0 + 16 * (g16 & 1) + 4 * (i16 & 3)) * 2;
    const s16x4 lo = vtr(p), hi4 = vtr(p + 4 * IP);
    return __builtin_shufflevector(lo, hi4, 0, 1, 2, 3, 4, 5, 6, 7);
}
__device__ __forceinline__ bf16x8 colfrag_perm(const LAS unsigned char* img, int c0, int k0, int lane) {
    const int g16 = lane >> 4, i16 = lane & 15;
    const LAS unsigned char* p = img + (k0 + 4 * (g16 >> 1) + (i16 >> 2)) * IP + (c0 + 16 * (g16 & 1) + 4 * (i16 & 3)) * 2;
    const s16x4 lo = vtr(p), hi4 = vtr(p + 8 * IP);
    return __builtin_shufflevector(lo, hi4, 0, 1, 2, 3, 4, 5, 6, 7);
}
__device__ __forceinline__ bf16x8 rowfrag_f32(const LAS float* img, int r0, int k0, int r32, int hi) {
    const LAS f32x4* p = (const LAS f32x4*)(img + (r0 + r32) * 64 + k0 + 8 * hi); const f32x4 a = p[0], b = p[1];
    u32x4 w; w.x = pk2(a[0], a[1]); w.y = pk2(a[2], a[3]); w.z = pk2(b[0], b[1]); w.w = pk2(b[2], b[3]); return __builtin_bit_cast(bf16x8, w);
}
__device__ __forceinline__ void store_T(LAS unsigned char* imgT, const f32x16& c, int r0, int c0, int r32, int hi) {
#pragma unroll
    for (int g = 0; g < 4; ++g) { u32x2 w; w.x = pk2(c[4 * g], c[4 * g + 1]); w.y = pk2(c[4 * g + 2], c[4 * g + 3]); *(LAS u32x2*)(imgT + (c0 + r32) * IP + (r0 + 8 * g + 4 * hi) * 2) = w; }
}
__device__ __forceinline__ void store_T_global(GAS bf16_t* gT  , const f32x16& c, int r0, int c0, int r32, int hi) {
#pragma unroll
    for (int g = 0; g < 4; ++g) { u32x2 w; w.x = pk2(c[4 * g], c[4 * g + 1]); w.y = pk2(c[4 * g + 2], c[4 * g + 3]); *(GAS u32x2*)(gT + (c0 + r32) * 64 + r0 + 8 * g + 4 * hi) = w; }
}
__device__ __forceinline__ void store_T_global_wt(GAS bf16_t* gT, const f32x16& c, int r0, int c0, int r32, int hi) {
#pragma unroll
    for (int g = 0; g < 4; ++g) { const unsigned long long w = (unsigned long long)pk2(c[4 * g], c[4 * g + 1]) | ((unsigned long long)pk2(c[4 * g + 2], c[4 * g + 3]) << 32);
        __hip_atomic_store((GAS unsigned long long*)(gT + (c0 + r32) * 64 + r0 + 8 * g + 4 * hi), w, __ATOMIC_RELAXED, __HIP_MEMORY_SCOPE_AGENT); }
}
__device__ __forceinline__ f32x16 zero16() { f32x16 z;
#pragma unroll
    for (int i = 0; i < 16; ++i) z[i] = 0.f;
    return z; }
#define WSYNC() asm volatile("s_waitcnt lgkmcnt(0)" ::: "memory")
#define BAR() do { asm volatile("s_waitcnt lgkmcnt(0)" ::: "memory"); __builtin_amdgcn_s_barrier(); asm volatile("" ::: "memory"); } while (0)

constexpr int R1_STG = S_AT;
constexpr int R1_SAVE = 131072 + 2048, R1_PAR = R1_SAVE + 1024, R1_WUP = R1_PAR + 2560, R1_AUP = R1_WUP + IMG;
struct R1Raw { u32x4 c[5]; };
__device__ __forceinline__ void r1_load(const MixArgs& a, R1Raw& raw, int tid, int b, int h, int ck) {
    const int et = tid >> 3, ec = (tid & 7) * 8, hc = h * 64 + ec;
    const GAS bf16_t* zr = (const GAS bf16_t*)a.Z + ((size_t)b * SEQ + ck * 64 + et) * ZP;
    const int cols[5] = {ZA_R + hc, ZA_K + hc, ZA_V + hc, ZA_WD + ec, ZA_AD + ec};
#pragma unroll
    for (int i = 0; i < 5; ++i) raw.c[i] = *(const GAS u32x4*)(zr + cols[i]);
}
__device__ __forceinline__ void r1_load_params(const RArgs& ra, unsigned char* ldsb, int tid, int h) {
    LAS float* par = (LAS float*)((LAS unsigned char*)ldsb + R1_PAR);
    for (int i = tid; i < 640; i += 512) { const int g = i >> 6, c = i & 63; float v;
        if (g == 0) v = ra.mu[ZA_R + h * 64 + c]; else if (g == 1) v = ra.mu[ZA_K + h * 64 + c]; else if (g == 2) v = ra.mu[ZA_V + h * 64 + c]; else if (g == 3) v = ra.mu[ZA_WD + c]; else if (g == 4) v = ra.mu[ZA_AD + c];
        else if (g == 5) v = ra.w0[h * 64 + c]; else if (g == 6) v = ra.a0[h * 64 + c]; else if (g == 7) v = ra.k_k[h * 64 + c]; else if (g == 8) v = ra.k_a[h * 64 + c]; else v = ra.r_k[h * 64 + c];
        par[i] = v; }
    for (int ch = tid; ch < 1024; ch += 512) { const int m = ch >> 9, row = (ch >> 3) & 63, c8 = ch & 7;
        *(LAS u32x4*)((LAS unsigned char*)ldsb + (m ? R1_AUP : R1_WUP) + row * IP + c8 * 16) = *(const GAS u32x4*)((const GAS bf16_t*)(m ? ra.aupT : ra.wupT) + (size_t)(h * 64 + row) * 64 + c8 * 8); }
}
static_assert(65 * 640 <= 5 * IMG, "staging fits");
__device__ __forceinline__ void rwkv_chunk_unit(const MixArgs& a, const RArgs& ra, unsigned char* ldsb, int b, int h, int ck, R1Raw& raw, int prev_mode, bool has_next, int nb, int nh, int nck) {
    const int tid = opaque_tid(), lane = tid & 63, wave = __builtin_amdgcn_readfirstlane(tid >> 6), r32 = lane & 31, hi = lane >> 5;
    LAS unsigned char* L = (LAS unsigned char*)ldsb;
    LAS float* fETA = (LAS float*)(L + F_AAB); LAS float* fAAB = fETA; LAS float* fLG = (LAS float*)(L + F_LG); LAS float* fTOT = (LAS float*)(L + F_TOT);
    const int t0 = ck * 64;
    const size_t row0 = (size_t)b * SEQ + t0;
    const int unit = (b * 6 + h) * 32 + ck;
    RST(-1, 50);
    const int et = tid >> 3, ec = (tid & 7) * 8, hc = h * 64 + ec;
    const LAS float* par = (const LAS float*)(L + R1_PAR);
    float r8[8], k8[8];
    {
        {
            LAS unsigned char* stg = L + R1_STG;
#pragma unroll
            for (int i = 0; i < 5; ++i) *(LAS u32x4*)(stg + (et + 1) * 640 + i * 128 + (tid & 7) * 16) = raw.c[i];
            if (et == 0) {
                const int hc0 = h * 64 + ec; const int cols[5] = {ZA_R + hc0, ZA_K + hc0, ZA_V + hc0, ZA_WD + ec, ZA_AD + ec};
#pragma unroll
                for (int i = 0; i < 5; ++i) { u32x4 pv = zero_u32x4();
                    if (prev_mode == 1) pv = *(const LAS u32x4*)(L + R1_SAVE + i * 128 + (tid & 7) * 16);
                    else if (prev_mode == 2) pv = *(const GAS u32x4*)((const GAS bf16_t*)a.Z + (row0 - 1) * ZP + cols[i]);
                    *(LAS u32x4*)(stg + i * 128 + (tid & 7) * 16) = pv; }
            }
        }
        BAR();
        if (et == 63) {
#pragma unroll
            for (int i = 0; i < 5; ++i) *(LAS u32x4*)(L + R1_SAVE + i * 128 + (tid & 7) * 16) = raw.c[i];
        }
        auto mix8 = [&](int i, int col, float* out) {
            const u32x4 cw = raw.c[i], pw = *(const LAS u32x4*)(L + R1_STG + et * 640 + i * 128 + (tid & 7) * 16);
            const f32x4 m0 = *(const LAS f32x4*)(par + i * 64 + ec), m1 = *(const LAS f32x4*)(par + i * 64 + ec + 4); (void)col;
            const float cv[8] = {bflo(cw.x), bfhi(cw.x), bflo(cw.y), bfhi(cw.y), bflo(cw.z), bfhi(cw.z), bflo(cw.w), bfhi(cw.w)};
            const float pv[8] = {bflo(pw.x), bfhi(pw.x), bflo(pw.y), bfhi(pw.y), bflo(pw.z), bfhi(pw.z), bflo(pw.w), bfhi(pw.w)};
            const float mv[8] = {m0[0], m0[1], m0[2], m0[3], m1[0], m1[1], m1[2], m1[3]};
#pragma unroll
            for (int j = 0; j < 8; ++j) out[j] = cv[j] + (pv[j] - cv[j]) * mv[j];
        };
        float v8[8], wd8[8], ad8[8];
        mix8(0, ZA_R + hc, r8); mix8(1, ZA_K + hc, k8); mix8(2, ZA_V + hc, v8); mix8(3, ZA_WD + ec, wd8); mix8(4, ZA_AD + ec, ad8);
#pragma unroll
        for (int i = 0; i < 8; ++i) wd8[i] = tanhf_(wd8[i]);
        u32x4 w;
        w.x = pk2(wd8[0], wd8[1]); w.y = pk2(wd8[2], wd8[3]); w.z = pk2(wd8[4], wd8[5]); w.w = pk2(wd8[6], wd8[7]); *(LAS u32x4*)(L + S_WD + et * IP + ec * 2) = w;
        w.x = pk2(ad8[0], ad8[1]); w.y = pk2(ad8[2], ad8[3]); w.z = pk2(ad8[4], ad8[5]); w.w = pk2(ad8[6], ad8[7]); *(LAS u32x4*)(L + S_AD + et * IP + ec * 2) = w;
        w.x = pk2(v8[0], v8[1]); w.y = pk2(v8[2], v8[3]); w.z = pk2(v8[4], v8[5]); w.w = pk2(v8[6], v8[7]); *(LAS u32x4*)(L + S_V + et * IP + ec * 2) = w;
    }
    BAR();
    RST(50, 51);
    const int q = wave & 3, tr = q >> 1, tc = q & 1, grp = wave >> 2;
    {
        const LAS unsigned char* Aimg = L + (grp ? S_AD : S_WD);
        f32x16 acc = zero16();
#pragma unroll
        for (int s = 0; s < 4; ++s) acc = MFMA32(rowfrag(Aimg, 32 * tr, 16 * s, r32, hi), rowfrag(L + (grp ? R1_AUP : R1_WUP), 32 * tc, 16 * s, r32, hi), acc);
        const int c = 32 * tc + r32; const float bias = par[(grp ? 6 : 5) * 64 + c];
        if (grp == 0) {
            float x[16], gs[4];
#pragma unroll
            for (int i = 0; i < 16; ++i) x[i] = -DECAY_SCALE * sigmoidf_(acc[i] + bias);
#pragma unroll
            for (int g = 0; g < 4; ++g) gs[g] = (x[4 * g] + x[4 * g + 1]) + (x[4 * g + 2] + x[4 * g + 3]);
            float run = 0.f;
#pragma unroll
            for (int g = 0; g < 4; ++g) { const float other = __shfl_xor(gs[g], 32); float base = run + (hi ? other : 0.f); run += gs[g] + other;
#pragma unroll
                for (int j = 0; j < 4; ++j) { base += x[4 * g + j]; fLG[(32 * tr + 8 * g + 4 * hi + j) * 64 + c] = base; } }
            if (tr == 0 && hi == 0) fTOT[c] = run;
        } else {
#pragma unroll
            for (int i = 0; i < 16; ++i) fETA[(32 * tr + (i & 3) + 8 * (i >> 2) + 4 * hi) * 64 + c] = sigmoidf_(acc[i] + bias);
        }
    }
    BAR();
    RST(51, 52);
    {
        const f32x4 l0 = *(const LAS f32x4*)(fLG + et * 64 + ec), l1 = *(const LAS f32x4*)(fLG + et * 64 + ec + 4);
        f32x4 p0 = {0.f, 0.f, 0.f, 0.f}, p1 = p0; if (et > 0) { p0 = *(const LAS f32x4*)(fLG + (et - 1) * 64 + ec); p1 = *(const LAS f32x4*)(fLG + (et - 1) * 64 + ec + 4); }
        const f32x4 e0 = *(const LAS f32x4*)(fETA + et * 64 + ec), e1 = *(const LAS f32x4*)(fETA + et * 64 + ec + 4);
        const f32x4 z0 = *(const LAS f32x4*)(fLG + 63 * 64 + ec), z1 = *(const LAS f32x4*)(fLG + 63 * 64 + ec + 4);
        const f32x4 u0 = *(const LAS f32x4*)(fTOT + ec), u1 = *(const LAS f32x4*)(fTOT + ec + 4);
        float lg[8] = {l0[0], l0[1], l0[2], l0[3], l1[0], l1[1], l1[2], l1[3]}, lp[8] = {p0[0], p0[1], p0[2], p0[3], p1[0], p1[1], p1[2], p1[3]};
        const float eta[8] = {e0[0], e0[1], e0[2], e0[3], e1[0], e1[1], e1[2], e1[3]}, tot[8] = {u0[0], u0[1], u0[2], u0[3], u1[0], u1[1], u1[2], u1[3]};
        float lC[8] = {z0[0], z0[1], z0[2], z0[3], z1[0], z1[1], z1[2], z1[3]};
        float kk[8], kp[8], ss = 0.f, bsum = 0.f;
#pragma unroll
        for (int i = 0; i < 8; ++i) {
            if (et >= 32) lg[i] += tot[i]; if (et >= 33) lp[i] += tot[i]; lC[i] += tot[i];
            kk[i] = k8[i] * par[7 * 64 + ec + i]; ss += kk[i] * kk[i];
            kp[i] = k8[i] * (1.f + (eta[i] - 1.f) * par[8 * 64 + ec + i]); bsum += r8[i] * kp[i] * par[9 * 64 + ec + i];
        }
        ss += __shfl_xor(ss, 1); ss += __shfl_xor(ss, 2); ss += __shfl_xor(ss, 4);
        bsum += __shfl_xor(bsum, 1); bsum += __shfl_xor(bsum, 2); bsum += __shfl_xor(bsum, 4);
        const float rn = __builtin_amdgcn_rsqf(fmaxf(ss, 1e-24f));
        if ((tid & 7) == 0) ra.RB[(row0 + et) * 8 + h] = bsum;
        if (et == 63) { f32x4 g0 = {fexp_(lC[0]), fexp_(lC[1]), fexp_(lC[2]), fexp_(lC[3])}, g1 = {fexp_(lC[4]), fexp_(lC[5]), fexp_(lC[6]), fexp_(lC[7])};
            *(f32x4*)(ra.RG + (size_t)unit * 64 + ec) = g0; *(f32x4*)(ra.RG + (size_t)unit * 64 + ec + 4) = g1; }
#pragma unroll
        for (int i = 0; i < 8; i += 2) {
            float vat[2], vbh[2], vkh[2], vrt[2], vkb[2], vbb[2];
#pragma unroll
            for (int j = 0; j < 2; ++j) { const int c = i + j;
                const float kn = kk[c] * rn, bv = kn * eta[c];
                const float ig = fexp_(-lg[c]), gC = fexp_(lC[c] - lg[c]);
                vat[j] = -kn * fexp_(lp[c]); vbh[j] = bv * ig; vkh[j] = kp[c] * ig; vrt[j] = r8[c] * fexp_(lg[c]); vkb[j] = kp[c] * gC; vbb[j] = bv * gC; }
            const int off = et * IP + (ec + i) * 2;
            *(LAS unsigned*)(L + S_AT + off) = pk2(vat[0], vat[1]); *(LAS unsigned*)(L + S_BH + off) = pk2(vbh[0], vbh[1]); *(LAS unsigned*)(L + S_KH + off) = pk2(vkh[0], vkh[1]);
            *(LAS unsigned*)(L + S_RT + off) = pk2(vrt[0], vrt[1]); *(LAS unsigned*)(L + S_KB + off) = pk2(vkb[0], vkb[1]); *(LAS unsigned*)(L + S_BB + off) = pk2(vbb[0], vbb[1]);
        }
    }
    BAR();
    RST(52, 53);
    if (has_next) r1_load(a, raw, tid, nb, nh, nck);
    {
        const LAS unsigned char* Aimg = L + (grp ? S_RT : S_AT);
        f32x16 c1 = zero16(), c2 = zero16();
        if (!(tr == 0 && tc == 1)) {
#pragma unroll
            for (int s = 0; s < 4; ++s) { const bf16x8 af = rowfrag(Aimg, 32 * tr, 16 * s, r32, hi);
                c1 = MFMA32(af, rowfrag(L + S_BH, 32 * tc, 16 * s, r32, hi), c1); c2 = MFMA32(af, rowfrag(L + S_KH, 32 * tc, 16 * s, r32, hi), c2); }
        }
        const int ci = 32 * tc + r32;
#pragma unroll
        for (int i = 0; i < 16; ++i) { const int t = 32 * tr + (i & 3) + 8 * (i >> 2) + 4 * hi; const bool keep = grp ? (ci <= t) : (ci < t); if (!keep) { c1[i] = 0.f; c2[i] = 0.f; } }
        if (grp == 0) {
#pragma unroll
            for (int i = 0; i < 16; ++i) fAAB[(32 * tr + (i & 3) + 8 * (i >> 2) + 4 * hi) * 64 + ci] = c1[i];
            store_T(L + S_AAK, c2, 32 * tr, 32 * tc, r32, hi);
        } else { store_T(L + S_ARB, c1, 32 * tr, 32 * tc, r32, hi); store_T(L + S_ARK, c2, 32 * tr, 32 * tc, r32, hi); }
    }
    BAR();
    RST(53, 54);
    f32x16 nacc = zero16(), yacc = zero16();
    if (grp == 0) {
        const int bk = wave;
        float d[16];
        if (lane < 16) {
#pragma unroll
            for (int t = 0; t < 16; ++t) { float s = (t == lane) ? 1.f : 0.f;
#pragma unroll
                for (int i = 0; i < 16; ++i) if (i < t) s += fAAB[(16 * bk + t) * 64 + 16 * bk + i] * d[i];
                d[t] = s; }
        }
        if (lane < 16) {
            LAS unsigned char* rowp = L + S_TT + (16 * bk + lane) * IP;
#pragma unroll
            for (int cb = 0; cb < 4; ++cb) { u32x4 w0, w1;
                if (cb == bk) { w0.x = pk2(d[0], d[1]); w0.y = pk2(d[2], d[3]); w0.z = pk2(d[4], d[5]); w0.w = pk2(d[6], d[7]); w1.x = pk2(d[8], d[9]); w1.y = pk2(d[10], d[11]); w1.z = pk2(d[12], d[13]); w1.w = pk2(d[14], d[15]); }
                else { w0 = zero_u32x4(); w1 = w0; }
                *(LAS u32x4*)(rowp + cb * 32) = w0; *(LAS u32x4*)(rowp + cb * 32 + 16) = w1; }
        }
    } else {
        f32x16 c = zero16();
#pragma unroll
        for (int s = 0; s < 4; ++s) c = MFMA32(colfrag(L + S_AAK, 32 * tr, 16 * s, lane), colfrag(L + S_V, 32 * tc, 16 * s, lane), c);
        store_T(L + S_W1, c, 32 * tr, 32 * tc, r32, hi);
    }
    BAR();
    if (grp == 0) {
        if (wave < 2) { const int p = 2 * wave;
            f32x16 x = MFMA32(rowfrag_f32(fAAB, 16 * (p + 1), 16 * p, r32, hi), rowfrag(L + S_TT, 16 * p, 16 * p, r32, hi), zero16());
            u32x4 xw; xw.x = pk2(x[0], x[1]); xw.y = pk2(x[2], x[3]); xw.z = pk2(x[4], x[5]); xw.w = pk2(x[6], x[7]);
            const f32x16 tb = MFMA32(colfrag_perm(L + S_TT, 16 * (p + 1), 16 * (p + 1), lane), __builtin_bit_cast(bf16x8, xw), zero16());
            if (r32 < 16) {
#pragma unroll
                for (int g = 0; g < 2; ++g) { u32x2 w; w.x = pk2(tb[4 * g], tb[4 * g + 1]); w.y = pk2(tb[4 * g + 2], tb[4 * g + 3]); *(LAS u32x2*)(L + S_TT + (16 * p + r32) * IP + (16 * (p + 1) + 8 * g + 4 * hi) * 2) = w; } }
        }
    } else {
#pragma unroll
        for (int s = 0; s < 4; ++s) { const bf16x8 vf = colfrag(L + S_V, 32 * tr, 16 * s, lane);
            nacc = MFMA32(colfrag(L + S_KB, 32 * tr, 16 * s, lane), colfrag(L + S_V, 32 * tc, 16 * s, lane), nacc);
            yacc = MFMA32(vf, colfrag(L + S_ARK, 32 * tc, 16 * s, lane), yacc); }
    }
    BAR();
    if (wave == 0) {
        f32x16 x = zero16();
#pragma unroll
        for (int s = 0; s < 2; ++s) x = MFMA32(rowfrag_f32(fAAB, 32, 16 * s, r32, hi), rowfrag(L + S_TT, 0, 16 * s, r32, hi), x);
        f32x16 tb = zero16();
#pragma unroll
        for (int s = 0; s < 2; ++s) { u32x4 xw; xw.x = pk2(x[8 * s], x[8 * s + 1]); xw.y = pk2(x[8 * s + 2], x[8 * s + 3]); xw.z = pk2(x[8 * s + 4], x[8 * s + 5]); xw.w = pk2(x[8 * s + 6], x[8 * s + 7]);
            tb = MFMA32(colfrag_perm(L + S_TT, 32, 32 + 16 * s, lane), __builtin_bit_cast(bf16x8, xw), tb); }
        store_T(L + S_TT, tb, 32, 0, r32, hi);
    }
    BAR();
    RST(54, 55);
    {
        f32x16 c = zero16();
#pragma unroll
        for (int s = 0; s < 4; ++s) { const bf16x8 tf = colfrag(L + S_TT, 32 * tr, 16 * s, lane);
            c = MFMA32(tf, grp ? rowfrag(L + S_W1, 32 * tc, 16 * s, r32, hi) : colfrag(L + S_AT, 32 * tc, 16 * s, lane), c); }
        store_T(L + (grp ? S_UV : S_AH), c, 32 * tr, 32 * tc, r32, hi);
    }
    BAR();
    RST(55, 56);
    {
        const LAS unsigned char* Aimg = L + (grp ? S_UV : S_AH);
        f32x16 c1 = grp ? nacc : zero16(), c2 = grp ? yacc : zero16();
#pragma unroll
        for (int s = 0; s < 4; ++s) { const bf16x8 af = rowfrag(Aimg, 32 * tr, 16 * s, r32, hi);
            if (grp) c1 = MFMA32(colfrag(L + S_BB, 32 * tr, 16 * s, lane), rowfrag(L + S_UV, 32 * tc, 16 * s, r32, hi), c1);
            else c1 = MFMA32(af, colfrag(L + S_BB, 32 * tc, 16 * s, lane), c1);
            c2 = MFMA32(af, colfrag(L + S_ARB, 32 * tc, 16 * s, lane), c2); }
        GAS bf16_t* gq = (GAS bf16_t*)ra.RQ + (size_t)unit * 4096; GAS bf16_t* gm = (GAS bf16_t*)ra.RM + (size_t)unit * 4096; GAS bf16_t* gn = (GAS bf16_t*)ra.RN + (size_t)unit * 4096;
        if (grp == 0) {
            store_T_global(gm, c1, 32 * tr, 32 * tc, r32, hi);
#pragma unroll
            for (int g = 0; g < 4; ++g) { const u32x2 w = *(const LAS u32x2*)(L + S_RT + (32 * tc + r32) * IP + (32 * tr + 8 * g + 4 * hi) * 2);
                c2[4 * g] += bflo(w.x); c2[4 * g + 1] += bfhi(w.x); c2[4 * g + 2] += bflo(w.y); c2[4 * g + 3] += bfhi(w.y); }
            store_T_global(gq, c2, 32 * tr, 32 * tc, r32, hi);
        } else {
            store_T_global(gn, c1, 32 * tr, 32 * tc, r32, hi);
            GAS bf16_t* yp = (GAS bf16_t*)a.Y + (row0 + 32 * tc + r32) * DM + h * 64 + 32 * tr;
#pragma unroll
            for (int g = 0; g < 4; ++g) { u32x2 w; w.x = pk2(c2[4 * g], c2[4 * g + 1]); w.y = pk2(c2[4 * g + 2], c2[4 * g + 3]); *(GAS u32x2*)(yp + 8 * g + 4 * hi) = w; }
        }
    }
    BAR();
    RST(56, -1);
}

constexpr int R2_D = 6, R2_SLOT = 16640, R2_RING = 2 * IMG;
__device__ __forceinline__ void rwkv_scan_chain(const RArgs& ra, unsigned char* ldsb, int b, int h, unsigned* flag  ) {
    const int tid = opaque_tid(), lane = tid & 63, wave = __builtin_amdgcn_readfirstlane(tid >> 6), r32 = lane & 31, hi = lane >> 5;
    LAS unsigned char* L = (LAS unsigned char*)ldsb;
    const int q = wave & 3, tr = q >> 1, tc = q & 1;
    f32x16 st = zero16();
    for (int i = tid; i < 2 * IMG / 16; i += 512) { *(LAS u32x4*)(L + i * 16) = zero_u32x4(); }
    const int ubase = (b * 6 + h) * 32;
    auto issue = [&](int step) {
        const int unit = ubase + step; LAS unsigned char* slot = L + R2_RING + (step % R2_D) * R2_SLOT; const int lw = wave - 4;
        const GAS unsigned char* gm = (const GAS unsigned char*)ra.RM + (size_t)unit * 8192 + lane * 16; const GAS unsigned char* gn = (const GAS unsigned char*)ra.RN + (size_t)unit * 8192 + lane * 16;
#pragma unroll
        for (int p = 0; p < 2; ++p) {
            __builtin_amdgcn_global_load_lds((const GAS unsigned*)(gm + (2 * lw + p) * 1024), (LAS unsigned*)(slot + (2 * lw + p) * 1024), 16, 0, 0);
            __builtin_amdgcn_global_load_lds((const GAS unsigned*)(gn + (2 * lw + p) * 1024), (LAS unsigned*)(slot + 8192 + (2 * lw + p) * 1024), 16, 0, 0);
        }
        if (lw == 0) __builtin_amdgcn_global_load_lds((const GAS unsigned*)((const GAS unsigned char*)ra.RG + (size_t)unit * 256 + lane * 4), (LAS unsigned*)(slot + 16384), 4, 0, 0);
    };
    if (wave >= 4) {
#pragma unroll 1
        for (int s0 = 0; s0 < R2_D - 1; ++s0) issue(s0);
        asm volatile("s_waitcnt vmcnt(0)" ::: "memory");
    }
    asm volatile("s_waitcnt lgkmcnt(0)" ::: "memory"); __builtin_amdgcn_s_barrier();
#pragma unroll 1
    for (int ck = 0; ck < 32; ++ck) {
        const LAS unsigned char* Simg = L + (ck & 1) * IMG; LAS unsigned char* Snew = L + ((ck + 1) & 1) * IMG;
        if (wave < 4) {
            const int unit = ubase + ck; const LAS unsigned char* slot = L + R2_RING + (ck % R2_D) * R2_SLOT;
            f32x16 acc;
#pragma unroll
            for (int g = 0; g < 4; ++g) { const u32x2 nw = *(const LAS u32x2*)(slot + 8192 + (32 * tc + r32) * 128 + (32 * tr + 8 * g + 4 * hi) * 2); const f32x4 gc = *(const LAS f32x4*)(slot + 16384 + (32 * tr + 8 * g + 4 * hi) * 4);
                acc[4 * g] = st[4 * g] * gc[0] + bflo(nw.x); acc[4 * g + 1] = st[4 * g + 1] * gc[1] + bfhi(nw.x); acc[4 * g + 2] = st[4 * g + 2] * gc[2] + bflo(nw.y); acc[4 * g + 3] = st[4 * g + 3] * gc[3] + bfhi(nw.y); }
#pragma unroll
            for (int s = 0; s < 4; ++s) acc = MFMA32(*(const LAS bf16x8*)(slot + (32 * tr + r32) * 128 + (16 * s + 8 * hi) * 2), rowfrag(Simg, 32 * tc, 16 * s, r32, hi), acc);
            store_T_global((GAS bf16_t*)ra.RM + (size_t)unit * 4096, st, 32 * tr, 32 * tc, r32, hi);
            st = acc;
            store_T(Snew, st, 32 * tr, 32 * tc, r32, hi);
            asm volatile("s_waitcnt lgkmcnt(0)" ::: "memory");
        } else {
            if (ck + R2_D - 1 < 32) { issue(ck + R2_D - 1);
                if (wave == 4) asm volatile("s_waitcnt vmcnt(20)" ::: "memory"); else asm volatile("s_waitcnt vmcnt(16)" ::: "memory"); }
            else asm volatile("s_waitcnt vmcnt(0)" ::: "memory");
        }
        __builtin_amdgcn_s_barrier();
    }
    asm volatile("s_waitcnt vmcnt(0) lgkmcnt(0)" ::: "memory"); __syncthreads();
    (void)flag;
}
__device__ __forceinline__ void r3_wait(const unsigned* flags, int chain0, int ck, int tid) {
    if (tid < 64) {
        const unsigned* f = flags + (size_t)(chain0 + (tid & 3)) * 64;
        for (unsigned spins = 0; spins < (1u << 22); ++spins) {
            const bool ok = __hip_atomic_load((const GAS unsigned*)f, __ATOMIC_RELAXED, __HIP_MEMORY_SCOPE_AGENT) > (unsigned)ck;
            if (__all(ok)) break;
            __builtin_amdgcn_s_sleep(4);
        }
        __builtin_amdgcn_fence(__ATOMIC_ACQUIRE, "agent");
        asm volatile("s_waitcnt vmcnt(0)" ::: "memory");
    }
}
constexpr int RP = 136, RTILE = 64 * RP, R3_TEAM_LDS = 3 * RTILE;
__device__ __forceinline__ void rwkv_out_unit(const MixArgs& a, const RArgs& ra, unsigned char* ldsb, int b, int h, int ck) {
    const int tid = opaque_tid(), lane = tid & 63, wave = __builtin_amdgcn_readfirstlane(tid >> 6), r32 = lane & 31, hi = lane >> 5;
    const int tw = wave & 1, tt = tid & 127;
    LAS unsigned char* TL = (LAS unsigned char*)ldsb + (wave >> 1) * R3_TEAM_LDS;
    LAS unsigned char* VM = TL, *SG = TL + RTILE, *YC = TL + 2 * RTILE;
    const int unit = (b * 6 + h) * 32 + ck;
    const size_t row0 = (size_t)b * SEQ + ck * 64;
#pragma unroll
    for (int j = 0; j < 4; ++j) {
        const int c = tt + 128 * j, t = c >> 3, c8 = (c & 7) * 8, hc = h * 64 + c8;
        const GAS bf16_t* zr = (const GAS bf16_t*)a.Z + (row0 + t) * ZP; const bool hp = (ck * 64 + t) > 0;
        const u32x4 vc = *(const GAS u32x4*)(zr + ZA_V + hc), gcw = *(const GAS u32x4*)(zr + ZA_G + hc);
        u32x4 vp = zero_u32x4(), gp = vp; if (hp) { vp = *(const GAS u32x4*)(zr - ZP + ZA_V + hc); gp = *(const GAS u32x4*)(zr - ZP + ZA_G + hc); }
        const u32x4 yc = *(const GAS u32x4*)((const GAS bf16_t*)a.Y + (row0 + t) * DM + hc);
        const f32x4 mv0 = *(const f32x4*)(ra.mu + ZA_V + hc), mv1 = *(const f32x4*)(ra.mu + ZA_V + hc + 4), mg0 = *(const f32x4*)(ra.mu + ZA_G + hc), mg1 = *(const f32x4*)(ra.mu + ZA_G + hc + 4);
        const float vcur[8] = {bflo(vc.x), bfhi(vc.x), bflo(vc.y), bfhi(vc.y), bflo(vc.z), bfhi(vc.z), bflo(vc.w), bfhi(vc.w)}, vprv[8] = {bflo(vp.x), bfhi(vp.x), bflo(vp.y), bfhi(vp.y), bflo(vp.z), bfhi(vp.z), bflo(vp.w), bfhi(vp.w)};
        const float gcur[8] = {bflo(gcw.x), bfhi(gcw.x), bflo(gcw.y), bfhi(gcw.y), bflo(gcw.z), bfhi(gcw.z), bflo(gcw.w), bfhi(gcw.w)}, gprv[8] = {bflo(gp.x), bfhi(gp.x), bflo(gp.y), bfhi(gp.y), bflo(gp.z), bfhi(gp.z), bflo(gp.w), bfhi(gp.w)};
        const float muv[8] = {mv0[0], mv0[1], mv0[2], mv0[3], mv1[0], mv1[1], mv1[2], mv1[3]}, mug[8] = {mg0[0], mg0[1], mg0[2], mg0[3], mg1[0], mg1[1], mg1[2], mg1[3]};
        float vm[8], sg[8];
#pragma unroll
        for (int i = 0; i < 8; ++i) { vm[i] = vcur[i] + (vprv[i] - vcur[i]) * muv[i]; const float gg = gcur[i] + (gprv[i] - gcur[i]) * mug[i]; sg[i] = gg * sigmoidf_(gg); }
        u32x4 w; w.x = pk2(vm[0], vm[1]); w.y = pk2(vm[2], vm[3]); w.z = pk2(vm[4], vm[5]); w.w = pk2(vm[6], vm[7]);
        *(LAS u32x2*)(VM + t * RP + c8 * 2) = (u32x2){w.x, w.y}; *(LAS u32x2*)(VM + t * RP + c8 * 2 + 8) = (u32x2){w.z, w.w};
        w.x = pk2(sg[0], sg[1]); w.y = pk2(sg[2], sg[3]); w.z = pk2(sg[4], sg[5]); w.w = pk2(sg[6], sg[7]);
        *(LAS u32x2*)(SG + t * RP + c8 * 2) = (u32x2){w.x, w.y}; *(LAS u32x2*)(SG + t * RP + c8 * 2 + 8) = (u32x2){w.z, w.w};
        *(LAS u32x2*)(YC + t * RP + c8 * 2) = (u32x2){yc.x, yc.y}; *(LAS u32x2*)(YC + t * RP + c8 * 2 + 8) = (u32x2){yc.z, yc.w};
    }
    const GAS bf16_t* gq = (const GAS bf16_t*)ra.RQ + (size_t)unit * 4096 + (32 * tw + r32) * 64 + 8 * hi;
    const GAS bf16_t* gs = (const GAS bf16_t*)ra.RM + (size_t)unit * 4096 + r32 * 64 + 8 * hi;
    bf16x8 bq[4], a0[4], a1[4];
#pragma unroll
    for (int s = 0; s < 4; ++s) { bq[s] = *(const GAS bf16x8*)(gq + 16 * s); a0[s] = *(const GAS bf16x8*)(gs + 16 * s); a1[s] = *(const GAS bf16x8*)(gs + 32 * 64 + 16 * s); }
    const float beta = ra.RB[(row0 + 32 * tw + r32) * 8 + h];
    BAR();
    const int tl = 32 * tw + r32;
    f32x16 y0, y1;
#pragma unroll
    for (int g = 0; g < 4; ++g) { const u32x2 w0 = *(const LAS u32x2*)(YC + tl * RP + (8 * g + 4 * hi) * 2), w1 = *(const LAS u32x2*)(YC + tl * RP + (32 + 8 * g + 4 * hi) * 2);
        y0[4 * g] = bflo(w0.x); y0[4 * g + 1] = bfhi(w0.x); y0[4 * g + 2] = bflo(w0.y); y0[4 * g + 3] = bfhi(w0.y);
        y1[4 * g] = bflo(w1.x); y1[4 * g + 1] = bfhi(w1.x); y1[4 * g + 2] = bflo(w1.y); y1[4 * g + 3] = bfhi(w1.y); }
#pragma unroll
    for (int s = 0; s < 4; ++s) { y0 = MFMA32(a0[s], bq[s], y0); y1 = MFMA32(a1[s], bq[s], y1); }
    float sm = 0.f;
#pragma unroll
    for (int i = 0; i < 16; ++i) sm += y0[i] + y1[i];
    sm += __shfl_xor(sm, 32); const float mean = sm * (1.f / 64.f);
    float sq = 0.f;
#pragma unroll
    for (int i = 0; i < 16; ++i) { const float d0 = y0[i] - mean, d1 = y1[i] - mean; sq += d0 * d0 + d1 * d1; }
    sq += __shfl_xor(sq, 32); const float rstd = __builtin_amdgcn_rsqf(sq * (1.f / 64.f) + GN_EPS);
#pragma unroll
    for (int half = 0; half < 2; ++half)
#pragma unroll
        for (int g = 0; g < 4; ++g) {
            const int v0 = 32 * half + 8 * g + 4 * hi, hc = h * 64 + v0;
            const u32x2 vw = *(const LAS u32x2*)(VM + tl * RP + v0 * 2), sw = *(const LAS u32x2*)(SG + tl * RP + v0 * 2);
            const f32x4 lg4 = *(const f32x4*)(ra.ln_g + hc), lb4 = *(const f32x4*)(ra.ln_b + hc);
            const float vv[4] = {bflo(vw.x), bfhi(vw.x), bflo(vw.y), bfhi(vw.y)}, ss[4] = {bflo(sw.x), bfhi(sw.x), bflo(sw.y), bfhi(sw.y)};
            float o[4];
#pragma unroll
            for (int j = 0; j < 4; ++j) { const float yv = half ? y1[4 * g + j] : y0[4 * g + j]; o[j] = ((yv - mean) * rstd * lg4[j] + lb4[j] + beta * vv[j]) * ss[j]; }
            u32x2 w; w.x = pk2(o[0], o[1]); w.y = pk2(o[2], o[3]); *(LAS u32x2*)(YC + tl * RP + v0 * 2) = w;
        }
    BAR();
#pragma unroll
    for (int j = 0; j < 4; ++j) { const int c = tt + 128 * j, t = c >> 3, c8 = (c & 7) * 8;
        const u32x2 lo = *(const LAS u32x2*)(YC + t * RP + c8 * 2), hi2 = *(const LAS u32x2*)(YC + t * RP + c8 * 2 + 8);
        u32x4 w; w.x = lo.x; w.y = lo.y; w.z = hi2.x; w.w = hi2.y; *(GAS u32x4*)((GAS bf16_t*)a.Y + (row0 + t) * DM + h * 64 + c8) = w; }
    BAR();
}
}
constexpr int NWAVES = 8;
constexpr int RING_BYTES = 131072, LDSCTL_OFF = RING_BYTES, LDS_BYTES = 163840;
constexpr int CW_BAR = 4096, CW_Q = 2048, CW_FLAG = 65536;
struct Args { const float* in[19]; float* out; unsigned char* ws; };

__device__ __forceinline__ unsigned lds_base_u32() { extern __shared__ __attribute__((aligned(16))) unsigned char lds_[]; return (unsigned)(uintptr_t)(LAS unsigned char*)lds_; }
__device__ __forceinline__ unsigned long long rd_ptr_u(volatile LAS unsigned long long* p) { const unsigned long long v = *p; const unsigned lo = __builtin_amdgcn_readfirstlane((unsigned)v), hi = __builtin_amdgcn_readfirstlane((unsigned)(v >> 32)); return ((unsigned long long)hi << 32) | lo; }
__global__ void __launch_bounds__(NWAVES * 64, 2) mega_fwd(Args args) {
    extern __shared__ __attribute__((aligned(16))) unsigned char lds[];
    const int tid = threadIdx.x, lane = tid & 63, wave = __builtin_amdgcn_readfirstlane(tid >> 6);
    const int G = gridDim.x, bx = blockIdx.x;
    unsigned char* ws = args.ws;
    volatile LAS unsigned* MISC = (volatile LAS unsigned*)((LAS unsigned char*)lds + LDSCTL_OFF);
    for (int u = tid; u < (LDS_BYTES - LDSCTL_OFF) / 4; u += NWAVES * 64) ((LAS unsigned*)((LAS unsigned char*)lds + LDSCTL_OFF))[u] = 0u;
    __syncthreads();
    (void)xcd_barrier_post((unsigned*)(ws + WS_CTL) + CW_BAR, MISC + 8);
    volatile LAS unsigned long long* PTRS = (volatile LAS unsigned long long*)((LAS unsigned char*)lds + LDSCTL_OFF + 256);
    if (tid < 19) PTRS[tid] = (unsigned long long)(uintptr_t)args.in[tid];
    if (tid == 19) PTRS[19] = (unsigned long long)(uintptr_t)args.out;
    if (tid == 20) PTRS[20] = (unsigned long long)(uintptr_t)args.ws;
    __syncthreads();
#define PTRS_RD(i) rd_ptr_u(({ unsigned a_; asm volatile("s_mov_b32 %0, %1" : "=s"(a_) : "i"(LDSCTL_OFF + 256 + 8 * (i))); (volatile LAS unsigned long long*)(LAS unsigned char*)(lds_base_u32() + a_); }))
#define ARGP(i) ((const float*)(uintptr_t)PTRS_RD(i))
#define OUTP ((float*)(uintptr_t)PTRS_RD(19))
#define WSP ((unsigned char*)(uintptr_t)PTRS_RD(20))
#ifdef PROBE_BAR
#define GRID_BAR() do { GRID_BAR1(); GRID_BAR1(); } while (0)
#else
#define GRID_BAR() GRID_BAR1()
#endif
#define GRID_BAR1() do { XcdBarrier b_; b_.bar = (unsigned*)(WSP + WS_CTL) + CW_BAR; b_.x = xb_xcc_id(); b_.st = (volatile LAS unsigned*)((LAS unsigned char*)lds + LDSCTL_OFF) + 8; xcd_barrier(b_); } while (0)
#ifdef PROBE_T
#define TS_LDS ((volatile LAS unsigned long long*)((LAS unsigned char*)lds + LDSCTL_OFF + 1024))
#ifdef PROBE_MAX
#define PROBE_BLK_OK true
#else
#define PROBE_BLK_OK (blockIdx.x == 0)
#endif
#define STAMP_BEGIN(id) do { if ((id) == PROBE_T && PROBE_BLK_OK && threadIdx.x == 0) TS_LDS[0] = __builtin_amdgcn_s_memrealtime(); } while (0)
#define STAMP_END(id) do { if ((id) == PROBE_T && PROBE_BLK_OK && threadIdx.x == 0) TS_LDS[1] += __builtin_amdgcn_s_memrealtime() - TS_LDS[0]; } while (0)
#else
#define STAMP_BEGIN(id) do {} while (0)
#define STAMP_END(id) do {} while (0)
#endif
#ifdef PROBE_TBUSY
#define STAMP_END_BUSY(id) STAMP_END(id)
#define STAMP_END_WALL(id) do {} while (0)
#else
#define STAMP_END_BUSY(id) do {} while (0)
#define STAMP_END_WALL(id) STAMP_END(id)
#endif
#define PHASE_IDS const int tid = opaque_tid(), lane = tid & 63, wave = __builtin_amdgcn_readfirstlane(tid >> 6), gw = bx * NWAVES + wave, ngw = G * NWAVES; (void)lane; (void)gw; (void)ngw; (void)tid; (void)wave;
    int K1024 = DM, K256 = 256; asm volatile("" : "+s"(K1024), "+s"(K256));
    STAMP_BEGIN(0);
    {
        PHASE_IDS
        const float* x = args.in[0]; bf16_t* bufA = (bf16_t*)(ws + WS_BUFA); float* ssqA = (float*)(ws + WS_SSQA);
        PrepArgs pa; pa.w_in = args.in[3]; pa.norm_g = args.in[2]; pa.w_out = args.in[14]; pa.ple_g = args.in[15]; pa.w_gate = args.in[16]; pa.w_proj = args.in[17]; pa.w_up = args.in[6]; pa.a_up = args.in[8]; pa.ws = ws;
        prep_tables(ws, bx * NWAVES * 64 + tid, G * NWAVES * 64);
        prep_weights(pa, gw, ngw, (LAS float*)((LAS unsigned char*)lds + wave * 16384), lane, 0, DEPTH);
#ifdef PROBE_PRO
        prep_weights(pa, gw, ngw, (LAS float*)((LAS unsigned char*)lds + wave * 16384), lane, 0, DEPTH);
        for (int m = gw; m < MTOK; m += ngw) x_row_to_bf16(x + (size_t)m * DM, bufA + (size_t)m * DM, ssqA + (size_t)m * 16, lane);
#endif
#pragma unroll 4
        for (int m = gw; m < MTOK; m += ngw) x_row_to_bf16(x + (size_t)m * DM, bufA + (size_t)m * DM, ssqA + (size_t)m * 16, lane);
    }
    STAMP_END_BUSY(0);
    GRID_BAR();
    STAMP_END_WALL(0);
    STAMP_BEGIN(1);
#pragma clang loop unroll(full)
    for (int L = 0; L < DEPTH; ++L) {
#define PHASE_PTRS unsigned char* ws = WSP; bf16_t* cur = (bf16_t*)(ws + ((L & 1) ? WS_BUFB : WS_BUFA)); bf16_t* oth = (bf16_t*)(ws + ((L & 1) ? WS_BUFA : WS_BUFB)); const unsigned char* wl = ws + WS_W + (size_t)L * W_LAYER; \
        bf16_t* Z = (bf16_t*)(ws + WS_Z); float* PP = (float*)(ws + WS_Z); bf16_t* PB = (bf16_t*)(ws + WS_PB); float* ssqA = (float*)(ws + WS_SSQA); float* ssqB = (float*)(ws + WS_SSQB); float* out = OUTP; \
        (void)cur; (void)oth; (void)wl; (void)Z; (void)PP; (void)PB; (void)ssqA; (void)ssqB; (void)out;
        {
            PHASE_PTRS
            const float* tab16 = (const float*)(ws + WS_TAB16); const float* tabI = (const float*)(ws + WS_TABI);
            pg8::Gemm g{cur, (const bf16_t*)(wl + W_IN), MTOK, NPAD, K1024}; pg8::StaticOrder S; S.init(MTOK, NPAD, G, bx);
            epi::EpiInProj e; e.Z = Z; e.ssq = ssqA; e.tab16 = tab16; e.tabI = tabI; e.KV = (bf16_t*)(ws + WS_MISC + MISC_KV); e.IKC = (bf16_t*)(ws + WS_MISC + MISC_IKC);
#ifdef PROBE_G1
            pg8::gemm_phase<epi::EpiInProj, pg8::StaticOrder, true, true>((PG8_LAS unsigned char*)lds, g, S, e);
#endif
#ifdef PROBE_G1P
            { epi::EpiPlainZ ep; ep.Z = Z; pg8::gemm_phase<epi::EpiPlainZ, pg8::StaticOrder, true, true>((PG8_LAS unsigned char*)lds, g, S, ep); }
#endif
            pg8::gemm_phase<epi::EpiInProj, pg8::StaticOrder, true, true>((PG8_LAS unsigned char*)lds, g, S, e);
        }
        STAMP_END_BUSY(1);
        GRID_BAR();
        STAMP_END_WALL(1);
        STAMP_BEGIN(2);
        {
            PHASE_PTRS
            MixArgs ma; ma.Z = Z; ma.Y = oth; ma.KV = (const bf16_t*)(ws + WS_MISC + MISC_KV); ma.IKC = (const bf16_t*)(ws + WS_MISC + MISC_IKC); ma.mu = ARGP(4) + L * 1664; ma.w0 = ARGP(5) + L * 384; ma.w_up = ARGP(6) + (size_t)L * 64 * 384; ma.a0 = ARGP(7) + L * 384; ma.a_up = ARGP(8) + (size_t)L * 64 * 384;
            ma.k_k = ARGP(9) + L * 384; ma.k_a = ARGP(10) + L * 384; ma.r_k = ARGP(11) + L * 384; ma.ln_g = ARGP(12) + L * 384; ma.ln_b = ARGP(13) + L * 384;
            rwkv::RArgs ra; ra.mu = ma.mu; ra.w0 = ma.w0; ra.a0 = ma.a0; ra.k_k = ma.k_k; ra.k_a = ma.k_a; ra.r_k = ma.r_k; ra.ln_g = ma.ln_g; ra.ln_b = ma.ln_b;
            ra.wupT = (const bf16_t*)(wl + W_WUPT); ra.aupT = (const bf16_t*)(wl + W_AUPT); ra.RQ = (bf16_t*)out; ra.RM = (bf16_t*)out + (size_t)3072 * 4096;     ra.RN = (bf16_t*)(ws + WS_MISC + MISC_RN); ra.RG = (float*)(ws + WS_MISC + MISC_RG); ra.RB = (float*)(ws + WS_MISC + MISC_RB);
            STAMP_BEGIN(21);
            { unsigned* qctr = (unsigned*)(ws + WS_CTL) + CW_Q + L * 8 + (bx & 7);
#define QW_PTR() ({ unsigned a_; asm volatile("s_mov_b32 %0, %1" : "=s"(a_) : "i"(LDSCTL_OFF + 1536)); (volatile LAS unsigned*)(LAS unsigned char*)(lds_base_u32() + a_); })
              for (;;) {
                  if (opaque_tid() == 0) { const unsigned v_ = __hip_atomic_fetch_add(qctr, 1u, __ATOMIC_RELAXED, __HIP_MEMORY_SCOPE_AGENT); QW_PTR()[0] = v_; }
                  __syncthreads();
                  const unsigned qi = QW_PTR()[0];
                  __syncthreads();
                  if (qi >= 64u) break;
                  dsa::dsa_unit(ma, lds, (bx & 7) * 2 + (int)(qi & 1u), 31 - (int)(qi >> 1));
              } }
            __syncthreads();
            STAMP_END(21); STAMP_BEGIN(22);
            float* LQ = (float*)(ws + WS_MISC);
#ifdef PROBE_DIL
            for (int rep = 0; rep < 2; ++rep)
#endif
            for (int u = bx; u < 768; u += G) dil::dil_unit(ma, LQ, lds, u / 48, (u % 48) >> 4, u & 15);
            __syncthreads();
            STAMP_END(22); STAMP_BEGIN(20);
            {
              rwkv::R1Raw raw; const int tid1 = opaque_tid(); int hprev = -1;
              for (;;) {
                  if (opaque_tid() == 0) { const unsigned v_ = __hip_atomic_fetch_add((unsigned*)(WSP + WS_CTL) + CW_Q + 64 + L * 16, 1u, __ATOMIC_RELAXED, __HIP_MEMORY_SCOPE_AGENT); QW_PTR()[0] = v_; }
                  __syncthreads();
                  const unsigned qr = QW_PTR()[0];
                  __syncthreads();
                  if (qr >= 1072u) break;
                  const int u0 = qr < 400u ? 6 * (int)qr : 2000 + (int)qr, u1 = qr < 400u ? u0 + 6 : u0 + 1;
                  rwkv::r1_load(ma, raw, tid1, u0 / 192, (u0 / 32) % 6, u0 & 31);
#pragma unroll 1
                  for (int u = u0; u < u1; ++u) { const int un = u + 1; const int ck = u & 31, hh = (u / 32) % 6;
                      if (hh != hprev) { __syncthreads(); rwkv::r1_load_params(ra, lds, tid1, hh); __syncthreads(); hprev = hh; }
                      rwkv::rwkv_chunk_unit(ma, ra, lds, u / 192, hh, ck, raw, ck == 0 ? 0 : (u == u0 ? 2 : 1), un < u1, un / 192, (un / 32) % 6, un & 31); } } }
            STAMP_END(20);
            STAMP_BEGIN(23);
        }
        STAMP_END_BUSY(2);
        GRID_BAR();
        STAMP_END_WALL(2); STAMP_END(23);
        STAMP_BEGIN(3);
        {
            PHASE_PTRS
            MixArgs ma; ma.Z = Z; ma.Y = oth; const float* LQ = (const float*)(ws + WS_MISC); PHASE_IDS
            rwkv::RArgs ra; ra.mu = ARGP(4) + L * 1664; ra.ln_g = ARGP(12) + L * 384; ra.ln_b = ARGP(13) + L * 384;
            ra.RQ = (bf16_t*)out; ra.RM = (bf16_t*)out + (size_t)3072 * 4096;     ra.RN = (bf16_t*)(ws + WS_MISC + MISC_RN); ra.RG = (float*)(ws + WS_MISC + MISC_RG); ra.RB = (float*)(ws + WS_MISC + MISC_RB);
            if (G > 96) {
#ifdef PROBE_R2
                if (bx < 96) rwkv::rwkv_scan_chain<true>(ra, lds, bx / 6, bx % 6);
#endif
                if (bx < 96) { STAMP_BEGIN(40); rwkv::rwkv_scan_chain(ra, lds, bx / 6, bx % 6, (unsigned*)(ws + WS_CTL) + CW_FLAG + (L * 96 + bx) * 64); STAMP_END(40); }
                else { dil::dil_merge(ma, LQ, (bx - 96) * 512 + tid, (G - 96) * 512);
                    const float* src = ARGP(1) + (size_t)L * MTOK * 256;
                    for (size_t i = (size_t)(bx - 96) * 512 + tid; i < (size_t)MTOK * 256 / 8; i += (size_t)(G - 96) * 512) {
                        const f32x4 a = ((const f32x4*)src)[2 * i], b = ((const f32x4*)src)[2 * i + 1];
                        u32x4 w; w.x = pk2(a.x, a.y); w.y = pk2(a.z, a.w); w.z = pk2(b.x, b.y); w.w = pk2(b.z, b.w); ((u32x4*)PB)[i] = w; }
                }
            } else {
                for (int u = bx; u < 96; u += G) rwkv::rwkv_scan_chain(ra, lds, u / 6, u % 6, (unsigned*)(ws + WS_CTL) + CW_FLAG + (L * 96 + u) * 64);
                dil::dil_merge(ma, LQ, bx * 512 + tid, G * 512);
                { const float* src = ARGP(1) + (size_t)L * MTOK * 256;
                  for (size_t i = (size_t)bx * 512 + tid; i < (size_t)MTOK * 256 / 8; i += (size_t)G * 512) {
                      const f32x4 a = ((const f32x4*)src)[2 * i], b = ((const f32x4*)src)[2 * i + 1];
                      u32x4 w; w.x = pk2(a.x, a.y); w.y = pk2(a.z, a.w); w.z = pk2(b.x, b.y); w.w = pk2(b.z, b.w); ((u32x4*)PB)[i] = w; } }
            }
        }
        STAMP_END_BUSY(3);
        GRID_BAR();
        STAMP_END_WALL(3);
        STAMP_BEGIN(4);
        {
            PHASE_PTRS
            MixArgs ma; ma.Z = Z; ma.Y = oth;
            rwkv::RArgs ra; ra.mu = ARGP(4) + L * 1664; ra.ln_g = ARGP(12) + L * 384; ra.ln_b = ARGP(13) + L * 384;
            ra.RQ = (bf16_t*)out; ra.RM = (bf16_t*)out + (size_t)3072 * 4096;     ra.RB = (float*)(ws + WS_MISC + MISC_RB); PHASE_IDS
            for (int u4 = bx; u4 < 768; u4 += G) { const int u = u4 * 4 + (wave >> 1); rwkv::rwkv_out_unit(ma, ra, lds, u / 192, (u / 32) % 6, u & 31); }
        }
        STAMP_END_BUSY(4);
        GRID_BAR();
        STAMP_END_WALL(4);
        STAMP_BEGIN(5);
        {
            PHASE_PTRS
            pg8::Gemm g{oth, (const bf16_t*)(wl + W_OUT), MTOK, DM, K1024}; pg8::StaticOrder S; S.init(MTOK, DM, G, bx);
            epi::EpiOutProj e; e.xb = cur; e.ssq_out = ssqB;
            pg8::Gemm g2{PB, (const bf16_t*)(wl + W_PROJ), MTOK, DM, K256};
            epi::EpiBf16Plain e2; e2.C = (bf16_t*)PP;
            if ((bx >> 3) & 1) {
                pg8::gemm_phase<epi::EpiBf16Plain, pg8::StaticOrder, true, true>((PG8_LAS unsigned char*)lds, g2, S, e2);
                pg8::gemm_phase<epi::EpiOutProj, pg8::StaticOrder, true, true>((PG8_LAS unsigned char*)lds, g, S, e);
            } else {
                pg8::gemm_phase<epi::EpiOutProj, pg8::StaticOrder, true, true>((PG8_LAS unsigned char*)lds, g, S, e);
                pg8::gemm_phase<epi::EpiBf16Plain, pg8::StaticOrder, true, true>((PG8_LAS unsigned char*)lds, g2, S, e2);
            }
        }
        STAMP_END_BUSY(5);
        GRID_BAR();
        STAMP_END_WALL(5);
        STAMP_BEGIN(6);
        {
            PHASE_PTRS
            pg8::Gemm g{cur, (const bf16_t*)(wl + W_GATE), MTOK, DM, K1024}; pg8::StaticOrder S; S.init(MTOK, DM, G, bx);
            epi::EpiGate e; e.x1b = cur; e.pp = (const bf16_t*)PP; e.xb = oth; e.ssq_in = ssqB; e.ssq_out = ssqA;
            pg8::gemm_phase<epi::EpiGate, pg8::StaticOrder, true, true>((PG8_LAS unsigned char*)lds, g, S, e);
        }
        STAMP_END_BUSY(6);
        GRID_BAR();
        STAMP_END_WALL(6);
        STAMP_BEGIN(1); STAMP_BEGIN(7);
    }
    {
        const int L = 0; PHASE_PTRS
        const float* fg = ARGP(18); PHASE_IDS
        const bf16_t* xb = (const bf16_t*)(ws + ((DEPTH & 1) ? WS_BUFB : WS_BUFA));
        for (int m = gw; m < MTOK; m += ngw) { const float rs = row_rstd(ssqA + (size_t)m * 16); f32x4* orow = (f32x4*)(out + (size_t)m * DM);
#pragma unroll
            for (int j = 0; j < 2; ++j) { const int c8 = 64 * j + lane; const u32x4 w = ((const u32x4*)(xb + (size_t)m * DM))[c8]; const f32x4 g0 = ((const f32x4*)fg)[2 * c8], g1 = ((const f32x4*)fg)[2 * c8 + 1];
                const f32x4 a = {bflo(w.x), bfhi(w.x), bflo(w.y), bfhi(w.y)}, b = {bflo(w.z), bfhi(w.z), bflo(w.w), bfhi(w.w)};
                orow[2 * c8] = a * rs * g0; orow[2 * c8 + 1] = b * rs * g1; } }
    }
#ifdef PROBE_T
    if (PROBE_T == 7) { __syncthreads(); STAMP_END(7); }
#ifdef PROBE_MAX
    { unsigned long long* slots = (unsigned long long*)(WSP + 512 * 1024);
      if (threadIdx.x == 0) __hip_atomic_store(slots + blockIdx.x, (unsigned long long)TS_LDS[1], __ATOMIC_RELAXED, __HIP_MEMORY_SCOPE_AGENT);
      GRID_BAR();
      if (blockIdx.x == 0 && threadIdx.x == 0) { unsigned long long mx = 0, mn = ~0ull, sm = 0;
          for (int i = 0; i < (int)gridDim.x; ++i) { const unsigned long long v = __hip_atomic_load(slots + i, __ATOMIC_RELAXED, __HIP_MEMORY_SCOPE_AGENT); mx = v > mx ? v : mx; mn = v < mn ? v : mn; sm += v; }
          TS_LDS[1] = PROBE_MAX == 1 ? mx : (PROBE_MAX == 2 ? mn : sm / gridDim.x); } }
#endif
    if (blockIdx.x == 0 && threadIdx.x == 0) { const unsigned long long t0 = __builtin_amdgcn_s_memrealtime(), w = 4ull * TS_LDS[1]; while (__builtin_amdgcn_s_memrealtime() - t0 < w) __builtin_amdgcn_s_sleep(8); }
#endif
}

extern "C" void kernel_launch(void* const* d_in, const int* in_sizes, int n_in, void* d_out, int out_size, void* d_ws, size_t ws_size, hipStream_t stream) {
    static int grid = 0;
    if (grid == 0) {
        if (n_in != 19 || out_size != MTOK * DM || ws_size < WS_END) { fprintf(stderr, "kernel_launch: unexpected shapes n_in %d out %d ws %zu\n", n_in, out_size, ws_size); grid = -1; return; }
        int dev = 0, cus = 0, per_cu = 0;
        if (hipGetDevice(&dev) != hipSuccess || hipDeviceGetAttribute(&cus, hipDeviceAttributeMultiprocessorCount, dev) != hipSuccess) { grid = -1; return; }
        if (hipFuncSetAttribute((const void*)mega_fwd, hipFuncAttributeMaxDynamicSharedMemorySize, LDS_BYTES) != hipSuccess) { fprintf(stderr, "kernel_launch: hipFuncSetAttribute failed\n"); grid = -1; return; }
        if (hipOccupancyMaxActiveBlocksPerMultiprocessor(&per_cu, (const void*)mega_fwd, NWAVES * 64, LDS_BYTES) != hipSuccess || per_cu < 1) { fprintf(stderr, "kernel_launch: occupancy query says %d blocks per CU\n", per_cu); (void)hipGetLastError(); grid = -1; return; }
        grid = cus;
    }
    if (grid < 0) return;
    if (hipMemsetAsync((char*)d_ws + WS_CTL, 0, 1 * MiB, stream) != hipSuccess) return;
    Args a; memset(&a, 0, sizeof a);
    for (int i = 0; i < 19; ++i) a.in[i] = (const float*)d_in[i];
    a.out = (float*)d_out; a.ws = (unsigned char*)d_ws;
    hipLaunchKernelGGL(mega_fwd, dim3(grid), dim3(NWAVES * 64), LDS_BYTES, stream, a);
}
```
